# Optimizing an MI355X kernel written in HIP

```python
import numpy as np
import jax
import jax.numpy as jnp
from jax import lax

D_MODEL = 1024
BATCH = 8
SEQ = 4096
DEPTH = 2

HEAD_DIM = 64
ROT_DIM = HEAD_DIM // 4
ROPE_THETA = 500000.0
Q_BLOCK = 128
NEG = -1e30
EPS = 1e-6

NSA_HEADS = 8
NSA_GROUPS = 2
NSA_REP = NSA_HEADS // NSA_GROUPS
CMP_LEN = 32
CMP_STRIDE = 16
CMP_HIDDEN = 256
SEL_LEN = 64
SEL_BLOCKS = 16
WINDOW = 512

DSA_HEADS = 8
IDX_HEADS = 8
IDX_DIM = 64
DSA_TOPK = 256

PEER_HEADS = 8
PEER_QDIM = 256
N_KEYS = 128
N_EXPERTS = N_KEYS * N_KEYS
PEER_HALF_TOPK = 16
PEER_TOPK = 16
PEER_TOKEN_BLOCK = 128

PLE_DIM = 256

MIX_A = NSA_HEADS * HEAD_DIM
MIX_B = DSA_HEADS * HEAD_DIM
IN_SIZES = (
    MIX_A,
    6 * NSA_GROUPS * HEAD_DIM,
    3 * NSA_HEADS,
    MIX_B,
    2 * HEAD_DIM,
    IDX_HEADS * IDX_DIM,
    IDX_DIM,
    IDX_HEADS,
    2 * D_MODEL,
)
IN_COLS = sum(IN_SIZES)

kernel_name = 'hybrid_nsa_dsa_peer_ple'


def _rms(x):
    xf = x.astype(jnp.float32)
    return xf * lax.rsqrt(jnp.mean(xf * xf, axis=-1, keepdims=True) + EPS)


def rms_norm(x, g):
    return (_rms(x) * g.astype(jnp.float32)).astype(x.dtype)


def rope(x, pos):
    half = ROT_DIM // 2
    inv = ROPE_THETA ** (-jnp.arange(half, dtype=jnp.float32) / half)
    ang = pos.astype(jnp.float32)[..., None] * inv
    cos = jnp.cos(ang)[:, :, None, :]
    sin = jnp.sin(ang)[:, :, None, :]
    xf = x.astype(jnp.float32)
    x1, x2, rest = xf[..., :half], xf[..., half:ROT_DIM], xf[..., ROT_DIM:]
    return jnp.concatenate([x1 * cos - x2 * sin, x2 * cos + x1 * sin, rest], axis=-1).astype(x.dtype)


def masked_softmax(s, mask):
    p = jax.nn.softmax(jnp.where(mask, s, NEG), axis=-1)
    return jnp.where(mask, p, 0.0)


def compress(t, pos_emb, w1, w2):
    b, s, g, d = t.shape
    r = CMP_LEN // CMP_STRIDE
    n_chunk = s // CMP_STRIDE
    n_cmp = n_chunk - r + 1
    c = t.reshape(b, n_chunk, CMP_STRIDE, g, d)
    blocks = jnp.concatenate([c[:, j:j + n_cmp] for j in range(r)], axis=2)
    blocks = blocks + pos_emb[None, None, :, None, :].astype(t.dtype)
    flat = blocks.transpose(0, 1, 3, 2, 4).reshape(b, n_cmp, g, CMP_LEN * d)
    return jax.nn.gelu(flat @ w1) @ w2


def nsa_attention(q, kc, vc, ks, vs, kw, vw, gates):
    b, s = q.shape[0], q.shape[1]
    n_cmp = kc.shape[1]
    n_sel_blocks = s // SEL_LEN
    n_top = min(SEL_BLOCKS, n_sel_blocks)
    scale = HEAD_DIM ** -0.5
    dt = q.dtype
    cmp_end = jnp.asarray(np.arange(n_cmp) * CMP_STRIDE + CMP_LEN - 1)
    ci = np.arange(n_cmp)[:, None] * CMP_STRIDE
    sj = np.arange(n_sel_blocks)[None, :] * SEL_LEN
    overlap = jnp.asarray(((ci < sj + SEL_LEN) & (ci + CMP_LEN > sj)).astype(np.float32))
    ks_blk = ks.reshape(b, n_sel_blocks, SEL_LEN, NSA_GROUPS, HEAD_DIM).transpose(0, 3, 1, 2, 4)
    vs_blk = vs.reshape(b, n_sel_blocks, SEL_LEN, NSA_GROUPS, HEAD_DIM).transpose(0, 3, 1, 2, 4)
    kw_pad = jnp.pad(kw, ((0, 0), (WINDOW, 0), (0, 0), (0, 0)))
    vw_pad = jnp.pad(vw, ((0, 0), (WINDOW, 0), (0, 0), (0, 0)))
    bix = jnp.arange(b)[:, None, None, None]
    gix = jnp.arange(NSA_GROUPS)[None, :, None, None]
    blk_ids = jnp.arange(n_sel_blocks)
    in_blk = jnp.arange(SEL_LEN)
    win_off = jnp.arange(WINDOW + Q_BLOCK) - WINDOW

    def block(bi):
        q0 = bi * Q_BLOCK
        t = q0 + jnp.arange(Q_BLOCK)
        qg = lax.dynamic_slice_in_dim(q, q0, Q_BLOCK, 1).reshape(b, Q_BLOCK, NSA_GROUPS, NSA_REP, HEAD_DIM)
        s_c = jnp.einsum('bqgrd,bngd->bgrqn', qg, kc).astype(jnp.float32) * scale
        p_c = masked_softmax(s_c, cmp_end[None, :] <= t[:, None])
        o_c = jnp.einsum('bgrqn,bngd->bqgrd', p_c.astype(dt), vc)
        imp = jnp.einsum('bgrqn,nj->bgqj', p_c, overlap)
        cur = (t // SEL_LEN)[:, None]
        forced = (blk_ids[None] == 0) | (blk_ids[None] == cur) | (blk_ids[None] == cur - 1)
        imp = jnp.where(forced, jnp.inf, imp)
        imp = jnp.where(blk_ids[None] * SEL_LEN <= t[:, None], imp, -jnp.inf)
        _, sel = lax.top_k(imp, n_top)
        k_g = ks_blk[bix, gix, sel].reshape(b, NSA_GROUPS, Q_BLOCK, n_top * SEL_LEN, HEAD_DIM)
        v_g = vs_blk[bix, gix, sel].reshape(b, NSA_GROUPS, Q_BLOCK, n_top * SEL_LEN, HEAD_DIM)
        key_pos = (sel[..., None] * SEL_LEN + in_blk).reshape(b, NSA_GROUPS, 1, Q_BLOCK, n_top * SEL_LEN)
        s_s = jnp.einsum('bqgrd,bgqmd->bgrqm', qg, k_g).astype(jnp.float32) * scale
        p_s = masked_softmax(s_s, key_pos <= t[:, None])
        o_s = jnp.einsum('bgrqm,bgqmd->bqgrd', p_s.astype(dt), v_g)
        k_w = lax.dynamic_slice_in_dim(kw_pad, q0, WINDOW + Q_BLOCK, 1)
        v_w = lax.dynamic_slice_in_dim(vw_pad, q0, WINDOW + Q_BLOCK, 1)
        kpos = q0 + win_off
        diff = t[:, None] - kpos[None, :]
        mask_w = (kpos[None, :] >= 0) & (diff >= 0) & (diff < WINDOW)
        s_w = jnp.einsum('bqgrd,bkgd->bgrqk', qg, k_w).astype(jnp.float32) * scale
        p_w = masked_softmax(s_w, mask_w)
        o_w = jnp.einsum('bgrqk,bkgd->bqgrd', p_w.astype(dt), v_w)
        g = lax.dynamic_slice_in_dim(gates, q0, Q_BLOCK, 1)[..., None]
        o = g[:, :, 0] * o_c + g[:, :, 1] * o_s + g[:, :, 2] * o_w
        return o.reshape(b, Q_BLOCK, MIX_A)

    out = lax.map(block, jnp.arange(s // Q_BLOCK))
    return out.transpose(1, 0, 2, 3).reshape(b, s, MIX_A)


def dsa_attention(q, k, v, iq, ik, iw):
    b, s = q.shape[0], q.shape[1]
    n_keep = min(DSA_TOPK, s // 4)
    scale = HEAD_DIM ** -0.5
    dt = q.dtype
    key_pos = jnp.arange(s)
    bix = jnp.arange(b)[:, None, None]

    def block(bi):
        q0 = bi * Q_BLOCK
        t = q0 + jnp.arange(Q_BLOCK)
        qb = lax.dynamic_slice_in_dim(q, q0, Q_BLOCK, 1)
        iqb = lax.dynamic_slice_in_dim(iq, q0, Q_BLOCK, 1)
        iwb = lax.dynamic_slice_in_dim(iw, q0, Q_BLOCK, 1).astype(jnp.float32) * IDX_HEADS ** -0.5
        logits = jnp.einsum('bqhd,bsd->bqhs', iqb, ik).astype(jnp.float32) * IDX_DIM ** -0.5
        score = jnp.einsum('bqhs,bqh->bqs', jax.nn.relu(logits), iwb)
        score = jnp.where(key_pos[None, None, :] <= t[None, :, None], score, -jnp.inf)
        _, sel = lax.top_k(score, n_keep)
        k_g = k[bix, sel]
        v_g = v[bix, sel]
        att = jnp.einsum('bqhd,bqkd->bhqk', qb, k_g).astype(jnp.float32) * scale
        p = masked_softmax(att, (sel <= t[None, :, None])[:, None])
        o = jnp.einsum('bhqk,bqkd->bqhd', p.astype(dt), v_g)
        return o.reshape(b, Q_BLOCK, MIX_B)

    out = lax.map(block, jnp.arange(s // Q_BLOCK))
    return out.transpose(1, 0, 2, 3).reshape(b, s, MIX_B)


def peer(h, wq, sub_keys, u, v):
    b, s, d = h.shape
    dt = h.dtype
    tok = h.reshape(b * s // PEER_TOKEN_BLOCK, PEER_TOKEN_BLOCK, d)

    def block(xb):
        q = (xb @ wq).reshape(PEER_TOKEN_BLOCK, PEER_HEADS, 2, PEER_QDIM // 2)
        s1 = jnp.einsum('thd,kd->thk', q[:, :, 0], sub_keys[0]).astype(jnp.float32)
        s2 = jnp.einsum('thd,kd->thk', q[:, :, 1], sub_keys[1]).astype(jnp.float32)
        v1, i1 = lax.top_k(s1, PEER_HALF_TOPK)
        v2, i2 = lax.top_k(s2, PEER_HALF_TOPK)
        cand = (v1[..., :, None] + v2[..., None, :]).reshape(PEER_TOKEN_BLOCK, PEER_HEADS, -1)
        cidx = (i1[..., :, None] * N_KEYS + i2[..., None, :]).reshape(PEER_TOKEN_BLOCK, PEER_HEADS, -1)
        top, pos = lax.top_k(cand, PEER_TOPK)
        eidx = jnp.take_along_axis(cidx, pos, axis=-1)
        gate = jax.nn.softmax(top, axis=-1)
        act = jax.nn.gelu(jnp.einsum('td,thkd->thk', xb, u[eidx]).astype(jnp.float32))
        return jnp.einsum('thk,thkd->td', (gate * act).astype(dt), v[eidx])

    return lax.map(block, tok).reshape(b, s, d)


def hybrid_layer(x, p_i, positions, attn_norm, w_in, nsa_qk_gain, cmp_pos, cmp_w1, cmp_w2,
                 dsa_qk_gain, w_branch_a, w_branch_b, w_out, ffn_norm, peer_wq, peer_sub_keys,
                 peer_u, peer_v, ple_w, ple_gate_w, ple_norm):
    b, s, _ = x.shape
    h = rms_norm(x, attn_norm)
    proj = h @ w_in
    cuts = np.cumsum(IN_SIZES)[:-1].tolist()
    nq, nkv, ngate, dq, dkv, iq, ik, iw, mg = jnp.split(proj, cuts, axis=-1)

    qa = rope(rms_norm(nq.reshape(b, s, NSA_HEADS, HEAD_DIM), nsa_qk_gain[0]), positions)
    kv = nkv.reshape(b, s, 6, NSA_GROUPS, HEAD_DIM)
    kc = compress(kv[:, :, 0], cmp_pos[0], cmp_w1[0], cmp_w2[0])
    vc = compress(kv[:, :, 1], cmp_pos[1], cmp_w1[1], cmp_w2[1])
    n_cmp = kc.shape[1]
    cmp_pos_ids = positions[:, CMP_LEN - 1::CMP_STRIDE][:, :n_cmp]
    kc = rope(rms_norm(kc, nsa_qk_gain[1]), cmp_pos_ids)
    ks = rope(rms_norm(kv[:, :, 2], nsa_qk_gain[2]), positions)
    kw = rope(rms_norm(kv[:, :, 4], nsa_qk_gain[3]), positions)
    gates = jax.nn.sigmoid(ngate).reshape(b, s, 3, NSA_GROUPS, NSA_REP)
    ya = nsa_attention(qa, kc, vc, ks, kv[:, :, 3], kw, kv[:, :, 5], gates)

    qb = rope(rms_norm(dq.reshape(b, s, DSA_HEADS, HEAD_DIM), dsa_qk_gain[0]), positions)
    dkv = dkv.reshape(b, s, 2, HEAD_DIM)
    kb = rope(rms_norm(dkv[:, :, :1], dsa_qk_gain[1]), positions)[:, :, 0]
    vb = dkv[:, :, 1]
    iq = rope(iq.reshape(b, s, IDX_HEADS, IDX_DIM), positions)
    ik = rope(ik[:, :, None], positions)[:, :, 0]
    yb = dsa_attention(qb, kb, vb, iq, ik, iw)

    ga, gb = jnp.split(jax.nn.sigmoid(mg), 2, axis=-1)
    x = x + (ga * (ya @ w_branch_a) + gb * (yb @ w_branch_b)) @ w_out

    x = x + peer(rms_norm(x, ffn_norm), peer_wq, peer_sub_keys, peer_u, peer_v)

    gate = jax.nn.sigmoid(_rms(x).astype(x.dtype) @ ple_gate_w)
    return x + gate * rms_norm(p_i @ ple_w, ple_norm)


def setup_inputs(seed: int = 0) -> dict:
    key = jax.random.key(seed)
    ks = jax.random.split(key, 24)
    f32 = jnp.float32
    L = DEPTH

    def nrm(k, shape, scale):
        return jax.random.normal(k, shape, f32) * scale

    def gain(k, shape):
        return 1.0 + 0.05 * jax.random.normal(k, shape, f32)

    offset = jax.random.randint(ks[2], (BATCH, 1), 0, 1024, dtype=jnp.int32)
    positions = offset + jnp.arange(SEQ, dtype=jnp.int32)[None, :]
    return {
        'x': nrm(ks[0], (BATCH, SEQ, D_MODEL), 1.0),
        'p': nrm(ks[1], (DEPTH, BATCH, SEQ, PLE_DIM), 1.0),
        'positions': positions,
        'attn_norm': gain(ks[3], (L, D_MODEL)),
        'w_in': nrm(ks[4], (L, D_MODEL, IN_COLS), D_MODEL ** -0.5),
        'nsa_qk_gain': gain(ks[5], (L, 4, HEAD_DIM)),
        'cmp_pos': nrm(ks[6], (L, 2, CMP_LEN, HEAD_DIM), 0.1),
        'cmp_w1': nrm(ks[7], (L, 2, CMP_LEN * HEAD_DIM, CMP_HIDDEN), (CMP_LEN * HEAD_DIM) ** -0.5),
        'cmp_w2': nrm(ks[8], (L, 2, CMP_HIDDEN, HEAD_DIM), CMP_HIDDEN ** -0.5),
        'dsa_qk_gain': gain(ks[9], (L, 2, HEAD_DIM)),
        'w_branch_a': nrm(ks[10], (L, MIX_A, D_MODEL), MIX_A ** -0.5),
        'w_branch_b': nrm(ks[11], (L, MIX_B, D_MODEL), MIX_B ** -0.5),
        'w_out': nrm(ks[12], (L, D_MODEL, D_MODEL), 0.5 * D_MODEL ** -0.5),
        'ffn_norm': gain(ks[13], (L, D_MODEL)),
        'peer_wq': nrm(ks[14], (L, D_MODEL, PEER_HEADS * PEER_QDIM), D_MODEL ** -0.5),
        'peer_sub_keys': nrm(ks[15], (L, 2, N_KEYS, PEER_QDIM // 2), (PEER_QDIM // 2) ** -0.5),
        'peer_u': nrm(ks[16], (L, N_EXPERTS, D_MODEL), D_MODEL ** -0.5),
        'peer_v': nrm(ks[17], (L, N_EXPERTS, D_MODEL), PEER_HEADS ** -0.5),
        'ple_w': nrm(ks[18], (L, PLE_DIM, D_MODEL), PLE_DIM ** -0.5),
        'ple_gate_w': nrm(ks[19], (L, D_MODEL, D_MODEL), D_MODEL ** -0.5),
        'ple_norm': gain(ks[20], (L, D_MODEL)),
    }


def reference(x, p, positions, attn_norm, w_in, nsa_qk_gain, cmp_pos, cmp_w1, cmp_w2,
              dsa_qk_gain, w_branch_a, w_branch_b, w_out, ffn_norm, peer_wq, peer_sub_keys,
              peer_u, peer_v, ple_w, ple_gate_w, ple_norm):
    for i in range(DEPTH):
        x = hybrid_layer(x, p[i], positions, attn_norm[i], w_in[i], nsa_qk_gain[i], cmp_pos[i],
                         cmp_w1[i], cmp_w2[i], dsa_qk_gain[i], w_branch_a[i], w_branch_b[i],
                         w_out[i], ffn_norm[i], peer_wq[i], peer_sub_keys[i], peer_u[i],
                         peer_v[i], ple_w[i], ple_gate_w[i], ple_norm[i])
    return x
```

```cpp
#include <hip/hip_runtime.h>
#include <hip/hip_cooperative_groups.h>
#include <cstdio>
#include <cstdint>
namespace cg = cooperative_groups;

typedef unsigned short u16;
typedef unsigned int u32;
typedef unsigned long long u64;
using bf16x8 = __attribute__((ext_vector_type(8))) short;
using f32x4 = __attribute__((ext_vector_type(4))) float;
using f32x16 = __attribute__((ext_vector_type(16))) float;
typedef __bf16 bf16x2_t __attribute__((ext_vector_type(2)));

constexpr int D_MODEL = 1024, BATCH = 8, SEQ = 4096, NTOK = BATCH * SEQ;
constexpr int IN_COLS = 4576;
constexpr int C_NQ = 0, C_NKV = 512, C_NG = 1280, C_DQ = 1304, C_DKV = 1816, C_IQ = 1944, C_IK = 2456, C_IW = 2520, C_MG = 2528;
constexpr int NCMP = 255;
constexpr int CROWS = BATCH * NCMP * 2;
constexpr int NEXP = 16384;
constexpr float EPS = 1e-6f;

constexpr size_t AL(size_t x) { return (x + 255) & ~(size_t)255; }
constexpr size_t WO_WIN = 0;
constexpr size_t WO_W1 = WO_WIN + AL((size_t)IN_COLS * 1024 * 2);
constexpr size_t WO_W2 = WO_W1 + AL((size_t)2 * 256 * 2048 * 2);
constexpr size_t WO_WA = WO_W2 + AL((size_t)2 * 64 * 256 * 2);
constexpr size_t WO_WB = WO_WA + AL((size_t)1024 * 512 * 2);
constexpr size_t WO_WO = WO_WB + AL((size_t)1024 * 512 * 2);
constexpr size_t WO_WQ = WO_WO + AL((size_t)1024 * 1024 * 2);
constexpr size_t WO_PW = WO_WQ + AL((size_t)2048 * 1024 * 2);
constexpr size_t WO_PG = WO_PW + AL((size_t)1024 * 256 * 2);
constexpr size_t WO_SK = WO_PG + AL((size_t)1024 * 1024 * 2);
constexpr size_t WO_CB = WO_SK + AL((size_t)2 * 128 * 128 * 2);
constexpr size_t W_LAYER = WO_CB + AL((size_t)2 * 256 * 4);

constexpr size_t OFF_W = 0;
constexpr size_t OFF_ROPE = OFF_W + 2 * W_LAYER;
constexpr size_t OFF_H = OFF_ROPE + AL((size_t)NTOK * 16 * 4);
constexpr size_t OFF_PROJ = OFF_H + AL((size_t)NTOK * 1024 * 2);
constexpr size_t OFF_YAB = OFF_PROJ + AL((size_t)NTOK * IN_COLS * 2);
constexpr size_t OFF_CHID = OFF_YAB + AL((size_t)NTOK * 1024 * 2);
constexpr size_t OFF_CBUF = OFF_CHID + AL((size_t)2 * CROWS * 256 * 2);
constexpr size_t OFF_KCB = OFF_CBUF + AL((size_t)2 * CROWS * 64 * 4);
constexpr size_t OFF_VCB = OFF_KCB + AL((size_t)BATCH * 2 * 256 * 64 * 2);
constexpr size_t OFF_RSTDE = OFF_VCB + AL((size_t)BATCH * 2 * 256 * 64 * 2);
constexpr size_t WS_END = OFF_RSTDE + AL((size_t)NTOK * 4);
constexpr size_t OFF_PQ = OFF_PROJ;
constexpr size_t OFF_UB = OFF_PQ + (size_t)NTOK * 2048 * 2;
constexpr size_t OFF_VB = OFF_UB + (size_t)NEXP * 1024 * 2;
constexpr size_t OFF_EIDX = OFF_VB + (size_t)NEXP * 1024 * 2;
constexpr size_t OFF_GATE = OFF_EIDX + (size_t)NTOK * 128 * 4;
static_assert(OFF_GATE + (size_t)NTOK * 128 * 4 <= OFF_YAB, "alias overflow");

constexpr int LDS_BYTES = 65536 + 2048;

struct Params {
    const float* x; const float* p; const int* positions;
    const float* attn_norm; const float* w_in; const float* nsa_gain; const float* cmp_pos; const float* cmp_w1; const float* cmp_w2;
    const float* dsa_gain; const float* w_a; const float* w_b; const float* w_out; const float* ffn_norm; const float* peer_wq;
    const float* peer_sk; const float* peer_u; const float* peer_v; const float* ple_w; const float* ple_gw; const float* ple_norm;
    float* out; unsigned char* ws;
};

__device__ __forceinline__ u16 f2bf(float f) {
    u32 u = __float_as_uint(f);
    u32 r = u + 0x7FFFu + ((u >> 16) & 1u);
    return (u16)(r >> 16);
}
__device__ __forceinline__ float bf2f(u16 h) { return __uint_as_float(((u32)h) << 16); }
__device__ __forceinline__ float bf_lo(u32 w) { return __uint_as_float(w << 16); }
__device__ __forceinline__ float bf_hi(u32 w) { return __uint_as_float(w & 0xFFFF0000u); }
__device__ __forceinline__ u32 pack2(float a, float b) { return (u32)f2bf(a) | ((u32)f2bf(b) << 16); }
__device__ __forceinline__ float dot2(u32 a, u32 b, float c) {
    return __builtin_amdgcn_fdot2_f32_bf16(__builtin_bit_cast(bf16x2_t, a), __builtin_bit_cast(bf16x2_t, b), c, false);
}
__device__ __forceinline__ float wsum(float v) {
#pragma unroll
    for (int o = 32; o > 0; o >>= 1) v += __shfl_xor(v, o);
    return v;
}
__device__ __forceinline__ float wmax(float v) {
#pragma unroll
    for (int o = 32; o > 0; o >>= 1) v = fmaxf(v, __shfl_xor(v, o));
    return v;
}
__device__ __forceinline__ int wsumi(int v) {
#pragma unroll
    for (int o = 32; o > 0; o >>= 1) v += __shfl_xor(v, o);
    return v;
}
__device__ __forceinline__ float sigmoidf(float x) { return 1.0f / (1.0f + __expf(-x)); }
__device__ __forceinline__ float gelu_tanh(float x) {
    float u = 0.7978845608028654f * (x + 0.044715f * x * x * x);
    return 0.5f * x * (1.0f + tanhf(u));
}
#define WAVE_SYNC() asm volatile("s_waitcnt lgkmcnt(0)" ::: "memory")
template <class T>
__device__ __forceinline__ T* opq(T* p) {
    asm volatile("" : "+s"(p));
    return p;
}
__device__ __forceinline__ int tidx() {
    int t = threadIdx.x;
    asm volatile("" : "+v"(t));
    return t;
}
__device__ __forceinline__ int bidx() {
    int b = blockIdx.x;
    asm volatile("" : "+s"(b));
    return b;
}
__device__ __forceinline__ int gdim() {
    int g = gridDim.x;
    asm volatile("" : "+s"(g));
    return g;
}

template <int AMODE, class Epi>
__device__ __forceinline__ void gemm_tile(const void* __restrict__ Ap, long lda, const u16* __restrict__ BT, long ldb, int M, int N, int K,
                                          int m0, int n0, u16* lds, Epi epi) {
    const int tid = tidx(), lane = tid & 63, w = tid >> 6;
    const int wm = w >> 1, wn = w & 1;
    u16* As = lds;
    u16* Bs = lds + 128 * 40;
    f32x4 acc[4][4];
#pragma unroll
    for (int i = 0; i < 4; ++i)
#pragma unroll
        for (int j = 0; j < 4; ++j) acc[i][j] = f32x4{0.f, 0.f, 0.f, 0.f};

    const int lkc = tid & 3;
    const int lrow0 = tid >> 2, lrow1 = 64 + (tid >> 2);
    long abase0, abase1, bbase0, bbase1;
    {
        int gr0 = m0 + lrow0, gr1 = m0 + lrow1;
        if (gr0 > M - 1) gr0 = M - 1;
        if (gr1 > M - 1) gr1 = M - 1;
        if (AMODE == 1) {
            int b = gr0 / (NCMP * 2);
            int rem = gr0 - b * (NCMP * 2);
            abase0 = ((long)b * SEQ + 16 * (rem >> 1)) * IN_COLS + (rem & 1) * 64;
            b = gr1 / (NCMP * 2);
            rem = gr1 - b * (NCMP * 2);
            abase1 = ((long)b * SEQ + 16 * (rem >> 1)) * IN_COLS + (rem & 1) * 64;
        } else {
            abase0 = (long)gr0 * lda;
            abase1 = (long)gr1 * lda;
        }
        int gn0 = n0 + lrow0, gn1 = n0 + lrow1;
        if (gn0 > N - 1) gn0 = N - 1;
        if (gn1 > N - 1) gn1 = N - 1;
        bbase0 = (long)gn0 * ldb;
        bbase1 = (long)gn1 * ldb;
    }
    uint4 ra0, ra1, rb0, rb1;
#define GEMM_LOAD_A(dst, abase, k)                                                                          \
    do {                                                                                                    \
        if (AMODE == 0) {                                                                                   \
            dst = *(const uint4*)((const u16*)Ap + (abase) + (k));                                          \
        } else if (AMODE == 1) {                                                                            \
            dst = *(const uint4*)((const u16*)Ap + (abase) + (long)((k) >> 6) * IN_COLS + ((k) & 63));      \
        } else {                                                                                            \
            const float* fp_ = (const float*)Ap + (abase) + (k);                                            \
            float4 f0_ = *(const float4*)fp_;                                                               \
            float4 f1_ = *(const float4*)(fp_ + 4);                                                         \
            dst = uint4{pack2(f0_.x, f0_.y), pack2(f0_.z, f0_.w), pack2(f1_.x, f1_.y), pack2(f1_.z, f1_.w)}; \
        }                                                                                                   \
    } while (0)
#define GEMM_LOAD_ALL(k0)                              \
    do {                                               \
        const int k_ = (k0) + lkc * 8;                 \
        GEMM_LOAD_A(ra0, abase0, k_);                  \
        GEMM_LOAD_A(ra1, abase1, k_);                  \
        rb0 = *(const uint4*)(BT + bbase0 + k_);       \
        rb1 = *(const uint4*)(BT + bbase1 + k_);       \
    } while (0)
    const int nk = K / 32;
    GEMM_LOAD_ALL(0);
    for (int kt = 0; kt < nk; ++kt) {
        *(uint4*)(As + lrow0 * 40 + lkc * 8) = ra0;
        *(uint4*)(As + lrow1 * 40 + lkc * 8) = ra1;
        *(uint4*)(Bs + lrow0 * 40 + lkc * 8) = rb0;
        *(uint4*)(Bs + lrow1 * 40 + lkc * 8) = rb1;
        __syncthreads();
        if (kt + 1 < nk) GEMM_LOAD_ALL((kt + 1) * 32);
        bf16x8 af[4], bfr[4];
#pragma unroll
        for (int i = 0; i < 4; ++i) {
            af[i] = *(const bf16x8*)(As + (wm * 64 + i * 16 + (lane & 15)) * 40 + (lane >> 4) * 8);
            bfr[i] = *(const bf16x8*)(Bs + (wn * 64 + i * 16 + (lane & 15)) * 40 + (lane >> 4) * 8);
        }
#pragma unroll
        for (int i = 0; i < 4; ++i)
#pragma unroll
            for (int j = 0; j < 4; ++j) acc[i][j] = __builtin_amdgcn_mfma_f32_16x16x32_bf16(af[i], bfr[j], acc[i][j], 0, 0, 0);
        __syncthreads();
    }
#pragma unroll
    for (int i = 0; i < 4; ++i)
#pragma unroll
        for (int j = 0; j < 4; ++j)
#pragma unroll
            for (int r = 0; r < 4; ++r) {
                int row = m0 + wm * 64 + i * 16 + (lane >> 4) * 4 + r;
                int col = n0 + wn * 64 + j * 16 + (lane & 15);
                if (row < M && col < N) epi(row, col, acc[i][j][r]);
            }
}

template <int AMODE, class Epi>
__device__ __forceinline__ void gemm_phase(const void* Ap, long lda, const u16* BT, long ldb, int M, int N, int K, u16* lds, Epi epi) {
    const int tm = (M + 127) / 128, tn = (N + 127) / 128;
    for (int t = bidx(); t < tm * tn; t += gdim()) {
        int im = t / tn, in = t - im * tn;
        gemm_tile<AMODE>(Ap, lda, BT, ldb, M, N, K, im * 128, in * 128, lds, epi);
    }
}

__device__ __forceinline__ void transpose_cvt(const float* __restrict__ src, u16* __restrict__ dst, int K, int N, float* tile) {
    const int tk = K / 64, tn = (N + 63) / 64;
    const int tx = tidx() & 63, ty = tidx() >> 6;
    for (int t = bidx(); t < tk * tn; t += gdim()) {
        int k0 = (t / tn) * 64, n0 = (t % tn) * 64;
#pragma unroll
        for (int r = 0; r < 16; ++r) {
            int k = ty * 16 + r, n = n0 + tx;
            tile[k * 65 + tx] = (n < N) ? src[(long)(k0 + k) * N + n] : 0.f;
        }
        __syncthreads();
#pragma unroll
        for (int r = 0; r < 16; ++r) {
            int nn = ty * 16 + r, n = n0 + nn;
            if (n < N) dst[(long)n * K + k0 + tx] = f2bf(tile[tx * 65 + nn]);
        }
        __syncthreads();
    }
}

__device__ __forceinline__ void cvt_f32_bf16(const float* __restrict__ src, u16* __restrict__ dst, long n) {
    long i = ((long)bidx() * 256 + tidx()) * 8;
    const long stride = (long)gdim() * 256 * 8;
    for (; i < n; i += stride) {
        float4 a = *(const float4*)(src + i);
        float4 b = *(const float4*)(src + i + 4);
        *(uint4*)(dst + i) = uint4{pack2(a.x, a.y), pack2(a.z, a.w), pack2(b.x, b.y), pack2(b.z, b.w)};
    }
}

__device__ __forceinline__ void rms_rows(const float* __restrict__ x, const float* __restrict__ g, u16* __restrict__ dst, const u16* __restrict__ e,
                         float* __restrict__ rstd_e) {
    const int lane = tidx() & 63;
    const int wid = bidx() * 4 + (tidx() >> 6);
    const int nw = gdim() * 4;
    for (int row = wid; row < NTOK; row += nw) {
        const float* xr = x + (long)row * 1024;
        float4 v[4];
        float ss = 0.f;
#pragma unroll
        for (int i = 0; i < 4; ++i) {
            v[i] = *(const float4*)(xr + i * 256 + lane * 4);
            ss += v[i].x * v[i].x + v[i].y * v[i].y + v[i].z * v[i].z + v[i].w * v[i].w;
        }
        ss = wsum(ss);
        float rstd = rsqrtf(ss * (1.0f / 1024.0f) + EPS);
#pragma unroll
        for (int i = 0; i < 4; ++i) {
            float4 gg = g ? *(const float4*)(g + i * 256 + lane * 4) : float4{1.f, 1.f, 1.f, 1.f};
            uint2 o = uint2{pack2(v[i].x * rstd * gg.x, v[i].y * rstd * gg.y), pack2(v[i].z * rstd * gg.z, v[i].w * rstd * gg.w)};
            *(uint2*)(dst + (long)row * 1024 + i * 256 + lane * 4) = o;
        }
        if (e) {
            const uint4* er = (const uint4*)(e + (long)row * 1024);
            float es = 0.f;
#pragma unroll
            for (int i = 0; i < 2; ++i) {
                uint4 q = er[i * 64 + lane];
                float a;
                a = bf_lo(q.x); es += a * a; a = bf_hi(q.x); es += a * a;
                a = bf_lo(q.y); es += a * a; a = bf_hi(q.y); es += a * a;
                a = bf_lo(q.z); es += a * a; a = bf_hi(q.z); es += a * a;
                a = bf_lo(q.w); es += a * a; a = bf_hi(q.w); es += a * a;
            }
            es = wsum(es);
            if (lane == 0) rstd_e[row] = rsqrtf(es * (1.0f / 1024.0f) + EPS);
        }
    }
}

__device__ __forceinline__ void head_chunk(u16* ptr, const float* gain, bool do_norm, bool do_rope, float scale, const float* cs, const float* sn,
                                           int lane) {
    float v = bf2f(ptr[lane]);
    if (do_norm) {
        float ss = wsum(v * v);
        v = v * rsqrtf(ss * (1.0f / 64.0f) + EPS) * gain[lane];
    }
    if (do_rope) {
        float pv = __shfl_xor(v, 8);
        if (lane < 16) {
            float c = cs[lane & 7], s = sn[lane & 7];
            v = (lane < 8) ? (v * c - pv * s) : (v * c + pv * s);
        }
    }
    ptr[lane] = f2bf(v * scale);
}

__device__ __forceinline__ void post_proj(unsigned char* ws, const float* ng, const float* dg) {
    u16* proj = (u16*)(ws + OFF_PROJ);
    const float* ropec = (const float*)(ws + OFF_ROPE);
    const float* ropes = ropec + (size_t)NTOK * 8;
    const int lane = tidx() & 63;
    const int wid = bidx() * 4 + (tidx() >> 6);
    const int nw = gdim() * 4;
    for (int t = wid; t < NTOK; t += nw) {
        u16* row = proj + (long)t * IN_COLS;
        const float* cs = ropec + (long)t * 8;
        const float* sn = ropes + (long)t * 8;
        for (int h = 0; h < 8; ++h) head_chunk(row + C_NQ + h * 64, ng + 0, true, true, 0.125f, cs, sn, lane);
        for (int g = 0; g < 2; ++g) head_chunk(row + C_NKV + (2 * 2 + g) * 64, ng + 128, true, true, 1.0f, cs, sn, lane);
        for (int g = 0; g < 2; ++g) head_chunk(row + C_NKV + (4 * 2 + g) * 64, ng + 192, true, true, 1.0f, cs, sn, lane);
        for (int h = 0; h < 8; ++h) head_chunk(row + C_DQ + h * 64, dg + 0, true, true, 0.125f, cs, sn, lane);
        head_chunk(row + C_DKV, dg + 64, true, true, 1.0f, cs, sn, lane);
        for (int h = 0; h < 8; ++h) head_chunk(row + C_IQ + h * 64, nullptr, false, true, 0.125f, cs, sn, lane);
        head_chunk(row + C_IK, nullptr, false, true, 1.0f, cs, sn, lane);
        if (lane < 24) row[C_NG + lane] = f2bf(sigmoidf(bf2f(row[C_NG + lane])));
        for (int i = 0; i < 32; ++i) {
            int c = C_MG + i * 64 + lane;
            row[c] = f2bf(sigmoidf(bf2f(row[c])));
        }
    }
}

template <int NH>
__device__ __forceinline__ void qk_chunk(const u16* krow, const u32* qlds, float (&s)[NH]) {
    asm volatile("" ::: "memory");
    uint4 kr[8];
#pragma unroll
    for (int i = 0; i < 8; ++i) kr[i] = ((const uint4*)krow)[i];
#pragma unroll
    for (int h = 0; h < NH; ++h) s[h] = 0.f;
#pragma unroll
    for (int i = 0; i < 8; ++i)
#pragma unroll
        for (int h = 0; h < NH; ++h) {
            uint4 q = *(const uint4*)(qlds + h * 32 + i * 4);
            s[h] = dot2(kr[i].x, q.x, s[h]);
            s[h] = dot2(kr[i].y, q.y, s[h]);
            s[h] = dot2(kr[i].z, q.z, s[h]);
            s[h] = dot2(kr[i].w, q.w, s[h]);
        }
}

template <int NH, class VRow>
__device__ __forceinline__ void pv_chunk(const float* plds, VRow vrow, float (&o)[NH][4], int lane) {
    const int sub = lane >> 4, dq = lane & 15;
#pragma unroll 4
    for (int kk = 0; kk < 16; ++kk) {
        int key = kk * 4 + sub;
        const u16* vp = vrow(key);
        uint2 vv = *(const uint2*)(vp + dq * 4);
        float v0 = bf_lo(vv.x), v1 = bf_hi(vv.x), v2 = bf_lo(vv.y), v3 = bf_hi(vv.y);
#pragma unroll
        for (int h = 0; h < NH; ++h) {
            float ph = plds[key * NH + h];
            o[h][0] += ph * v0;
            o[h][1] += ph * v1;
            o[h][2] += ph * v2;
            o[h][3] += ph * v3;
        }
    }
}

template <int NH, class VRow>
__device__ __forceinline__ void attn_chunk(float (&s)[NH], bool valid, float (&m)[NH], float (&l)[NH], float (&o)[NH][4], float* plds, VRow vrow,
                                           int lane) {
#pragma unroll
    for (int h = 0; h < NH; ++h) {
        float sv = valid ? s[h] : -1e30f;
        float cm = wmax(sv);
        float mn = fmaxf(m[h], cm);
        float alpha = __expf(m[h] - mn);
        float p = valid ? __expf(sv - mn) : 0.f;
        l[h] = l[h] * alpha + wsum(p);
        m[h] = mn;
#pragma unroll
        for (int j = 0; j < 4; ++j) o[h][j] *= alpha;
        plds[lane * NH + h] = p;
    }
    WAVE_SYNC();
    pv_chunk<NH>(plds, vrow, o, lane);
    WAVE_SYNC();
}

__device__ __forceinline__ void nsa_unit(unsigned char* ws, int t, int g, unsigned char* wl) {
    const int lane = tidx() & 63;
    const int b = t / SEQ, tl = t - b * SEQ;
    const u16* proj = (const u16*)(ws + OFF_PROJ);
    const u16* kcb = (const u16*)(ws + OFF_KCB) + (size_t)(b * 2 + g) * 256 * 64;
    const u16* vcb = (const u16*)(ws + OFF_VCB) + (size_t)(b * 2 + g) * 256 * 64;
    u16* ya = (u16*)(ws + OFF_YAB);
    u32* qlds = (u32*)wl;
    float* plds = (float*)(wl + 512);
    float* psum = (float*)(wl + 1536);
    const u16* brow = proj + (long)b * SEQ * IN_COLS;
    const u16* trow = proj + (long)t * IN_COLS;
    {
        const uint2* qsrc = (const uint2*)(trow + C_NQ + g * 256);
        uint2 qq = qsrc[lane];
        qlds[lane * 2] = qq.x;
        qlds[lane * 2 + 1] = qq.y;
    }
    WAVE_SYNC();
    float tot[4][4];
#pragma unroll
    for (int h = 0; h < 4; ++h)
#pragma unroll
        for (int j = 0; j < 4; ++j) tot[h][j] = 0.f;
    float gate[3][4];
#pragma unroll
    for (int br = 0; br < 3; ++br)
#pragma unroll
        for (int h = 0; h < 4; ++h) gate[br][h] = bf2f(trow[C_NG + br * 8 + g * 4 + h]);

    const int nvalid = tl >= 31 ? ((tl - 31) >> 4) + 1 : 0;
    const int nch = (nvalid + 63) >> 6;
    {
        float sc[4][4];
#pragma unroll
        for (int c = 0; c < 4; ++c) {
#pragma unroll
            for (int h = 0; h < 4; ++h) sc[c][h] = -1e30f;
            if (c < nch) {
                int n = 64 * c + lane;
                int nn = n < 254 ? n : 254;
                float s4[4];
                qk_chunk<4>(kcb + (size_t)nn * 64, qlds, s4);
                bool valid = n < nvalid;
#pragma unroll
                for (int h = 0; h < 4; ++h) sc[c][h] = valid ? s4[h] : -1e30f;
            }
        }
        float pc[4][4];
#pragma unroll
        for (int h = 0; h < 4; ++h) {
            float mx = fmaxf(fmaxf(sc[0][h], sc[1][h]), fmaxf(sc[2][h], sc[3][h]));
            mx = wmax(mx);
            float ls = 0.f;
#pragma unroll
            for (int c = 0; c < 4; ++c) {
                pc[c][h] = (sc[c][h] > -1e29f) ? __expf(sc[c][h] - mx) : 0.f;
                ls += pc[c][h];
            }
            ls = wsum(ls);
            float inv = ls > 0.f ? 1.0f / ls : 0.f;
#pragma unroll
            for (int c = 0; c < 4; ++c) pc[c][h] *= inv;
        }
#pragma unroll
        for (int c = 0; c < 4; ++c) psum[64 * c + lane] = pc[c][0] + pc[c][1] + pc[c][2] + pc[c][3];
        float oc[4][4];
#pragma unroll
        for (int h = 0; h < 4; ++h)
#pragma unroll
            for (int j = 0; j < 4; ++j) oc[h][j] = 0.f;
#pragma unroll
        for (int c = 0; c < 4; ++c) {
            if (c < nch) {
#pragma unroll
                for (int h = 0; h < 4; ++h) plds[lane * 4 + h] = pc[c][h];
                WAVE_SYNC();
                pv_chunk<4>(plds, [&](int key) { int n = 64 * c + key; n = n < 254 ? n : 254; return vcb + (size_t)n * 64; }, oc, lane);
                WAVE_SYNC();
            }
        }
#pragma unroll
        for (int h = 0; h < 4; ++h)
#pragma unroll
            for (int j = 0; j < 4; ++j) tot[h][j] += gate[0][h] * oc[h][j];
    }
    WAVE_SYNC();
    const int cur = tl >> 6;
    u64 selmask;
    {
        int j = lane;
        int a = 4 * j - 1;
        float imp = (a >= 0 ? psum[a] : 0.f) + psum[4 * j] + psum[4 * j + 1] + psum[4 * j + 2] + psum[4 * j + 3];
        bool forced = (j == 0) || (j == cur) || (j == cur - 1);
        float v = forced ? __builtin_inff() : imp;
        if (j > cur) v = -__builtin_inff();
        int rank = 0;
        for (int jp = 0; jp < 64; ++jp) {
            float vj = __shfl(v, jp);
            rank += (vj > v || (vj == v && jp < j)) ? 1 : 0;
        }
        selmask = __ballot(rank < 16 && j <= cur);
    }
    {
        float m[4], l[4], o[4][4];
#pragma unroll
        for (int h = 0; h < 4; ++h) {
            m[h] = -1e30f;
            l[h] = 0.f;
#pragma unroll
            for (int j = 0; j < 4; ++j) o[h][j] = 0.f;
        }
        u64 mk = selmask;
        while (mk) {
            int j = __ffsll((long long)mk) - 1;
            mk &= mk - 1;
            int key = 64 * j + lane;
            float s4[4];
            qk_chunk<4>(brow + (long)key * IN_COLS + C_NKV + (2 * 2 + g) * 64, qlds, s4);
            const u16* vb0 = brow + (long)(64 * j) * IN_COLS + C_NKV + (3 * 2 + g) * 64;
            attn_chunk<4>(s4, key <= tl, m, l, o, plds, [&](int kk) { return vb0 + (long)kk * IN_COLS; }, lane);
        }
#pragma unroll
        for (int h = 0; h < 4; ++h) {
            float inv = l[h] > 0.f ? gate[1][h] / l[h] : 0.f;
#pragma unroll
            for (int j = 0; j < 4; ++j) tot[h][j] += inv * o[h][j];
        }
    }
    {
        float m[4], l[4], o[4][4];
#pragma unroll
        for (int h = 0; h < 4; ++h) {
            m[h] = -1e30f;
            l[h] = 0.f;
#pragma unroll
            for (int j = 0; j < 4; ++j) o[h][j] = 0.f;
        }
        for (int c = 0; c < 8; ++c) {
            int base = tl - 511 + 64 * c;
            if (base + 63 < 0) continue;
            int key = base + lane;
            int kc = key < 0 ? 0 : key;
            float s4[4];
            qk_chunk<4>(brow + (long)kc * IN_COLS + C_NKV + (4 * 2 + g) * 64, qlds, s4);
            const u16* vb0 = brow + C_NKV + (5 * 2 + g) * 64;
            attn_chunk<4>(s4, key >= 0, m, l, o, plds,
                          [&](int kk) { int k2 = base + kk; k2 = k2 < 0 ? 0 : k2; return vb0 + (long)k2 * IN_COLS; }, lane);
        }
#pragma unroll
        for (int h = 0; h < 4; ++h) {
            float inv = l[h] > 0.f ? gate[2][h] / l[h] : 0.f;
#pragma unroll
            for (int j = 0; j < 4; ++j) tot[h][j] += inv * o[h][j];
        }
    }
#pragma unroll
    for (int h = 0; h < 4; ++h)
#pragma unroll
        for (int j = 0; j < 4; ++j) {
            float v = tot[h][j];
            v += __shfl_xor(v, 16);
            v += __shfl_xor(v, 32);
            tot[h][j] = v;
        }
    if (lane < 16) {
#pragma unroll
        for (int h = 0; h < 4; ++h) {
            uint2 o2 = uint2{pack2(tot[h][0], tot[h][1]), pack2(tot[h][2], tot[h][3])};
            *(uint2*)(ya + (long)t * 512 + (g * 4 + h) * 64 + lane * 4) = o2;
        }
    }
    WAVE_SYNC();
}

__device__ __forceinline__ void dsa_unit(unsigned char* ws, int unit, unsigned char* smem) {
    const int tid = tidx(), lane = tid & 63, w = tid >> 6;
    const int t0 = unit * 4;
    const int b = t0 / SEQ, tl0 = t0 - b * SEQ;
    const u16* proj = (const u16*)(ws + OFF_PROJ);
    const u16* brow = proj + (long)b * SEQ * IN_COLS;
    u16* yb = (u16*)(ws + OFF_YAB) + (size_t)NTOK * 512;
    float* sc = (float*)smem;
    u16* idxl = (u16*)(smem + 65536);
    __syncthreads();
    {
        const int r = lane & 31, half = lane >> 5;
        const int q = r >> 3, h = r & 7;
        bf16x8 af[4];
#pragma unroll
        for (int ks = 0; ks < 4; ++ks) af[ks] = *(const bf16x8*)(proj + (long)(t0 + q) * IN_COLS + C_IQ + h * 64 + ks * 16 + half * 8);
        float wq[4][4];
#pragma unroll
        for (int qq = 0; qq < 4; ++qq)
#pragma unroll
            for (int i = 0; i < 4; ++i) wq[qq][i] = bf2f(proj[(long)(t0 + qq) * IN_COLS + C_IW + i + 4 * half]) * 0.35355339059327373f;
        const int ntiles = (tl0 + 4 + 31) >> 5;
        for (int tile = w; tile < ntiles; tile += 4) {
            int key = tile * 32 + r;
            bf16x8 bfr[4];
#pragma unroll
            for (int ks = 0; ks < 4; ++ks) bfr[ks] = *(const bf16x8*)(brow + (long)key * IN_COLS + C_IK + ks * 16 + half * 8);
            f32x16 acc;
#pragma unroll
            for (int i = 0; i < 16; ++i) acc[i] = 0.f;
#pragma unroll
            for (int ks = 0; ks < 4; ++ks) acc = __builtin_amdgcn_mfma_f32_32x32x16_bf16(af[ks], bfr[ks], acc, 0, 0, 0);
            float totq[4];
#pragma unroll
            for (int qq = 0; qq < 4; ++qq) {
                float part = 0.f;
#pragma unroll
                for (int i = 0; i < 4; ++i) part += wq[qq][i] * fmaxf(acc[4 * qq + i], 0.f);
                totq[qq] = part + __shfl_xor(part, 32);
            }
            if (half == 0) {
                sc[0 * 4096 + key] = totq[0];
                sc[1 * 4096 + key] = totq[1];
            } else {
                sc[2 * 4096 + key] = totq[2];
                sc[3 * 4096 + key] = totq[3];
            }
        }
    }
    __syncthreads();
    const int t = t0 + w;
    const int tl = tl0 + w;
    const int nvalid = tl + 1;
    int nsel;
    {
        u32 u[64];
        const float* scq = sc + w * 4096;
#pragma unroll
        for (int j = 0; j < 64; ++j) {
            int key = j * 64 + lane;
            u32 v = 0;
            if (key <= tl) {
                u32 bits = __float_as_uint(scq[key]);
                v = bits ^ ((bits >> 31) ? 0xFFFFFFFFu : 0x80000000u);
            }
            u[j] = v;
        }
        u32 K = 0;
        int need = 0;
        if (nvalid > 256) {
            for (int bit = 31; bit >= 0; --bit) {
                u32 cand = K | (1u << bit);
                int cnt = 0;
#pragma unroll
                for (int j = 0; j < 64; ++j) cnt += (u[j] >= cand) ? 1 : 0;
                cnt = wsumi(cnt);
                if (cnt >= 256) K = cand;
            }
            int cgt = 0;
#pragma unroll
            for (int j = 0; j < 64; ++j) cgt += (u[j] > K) ? 1 : 0;
            cgt = wsumi(cgt);
            need = 256 - cgt;
            nsel = 256;
        } else {
            nsel = nvalid;
        }
        const u64 ltmask = (1ull << lane) - 1ull;
        int base = 0, ebase = 0;
        u16* myidx = idxl + w * 256;
#pragma unroll
        for (int j = 0; j < 64; ++j) {
            bool eq = (nvalid > 256) && (u[j] == K);
            u64 em = __ballot(eq);
            int erank = ebase + __popcll(em & ltmask);
            bool take = (u[j] > K) || (eq && erank < need);
            ebase += __popcll(em);
            u64 sm = __ballot(take);
            int pos = base + __popcll(sm & ltmask);
            if (take && pos < 256) myidx[pos] = (u16)(j * 64 + lane);
            base += __popcll(sm);
        }
    }
    WAVE_SYNC();
    {
        u32* qlds = (u32*)(smem + w * 16384);
        float* plds = (float*)(smem + w * 16384 + 1024);
        const u16* myidx = idxl + w * 256;
        const u16* trow = proj + (long)t * IN_COLS;
        {
            const uint4* qsrc = (const uint4*)(trow + C_DQ);
            uint4 qq = qsrc[lane];
            *(uint4*)(qlds + lane * 4) = qq;
        }
        WAVE_SYNC();
        float m[8], l[8], o[8][4];
#pragma unroll
        for (int h = 0; h < 8; ++h) {
            m[h] = -1e30f;
            l[h] = 0.f;
#pragma unroll
            for (int j = 0; j < 4; ++j) o[h][j] = 0.f;
        }
        const int nchunk = (nsel + 63) >> 6;
        for (int c = 0; c < nchunk; ++c) {
            int pos = c * 64 + lane;
            bool valid = pos < nsel;
            int key = myidx[valid ? pos : 0];
            float s8[8];
            qk_chunk<8>(brow + (long)key * IN_COLS + C_DKV, qlds, s8);
            attn_chunk<8>(s8, valid, m, l, o, plds,
                          [&](int kk) { int p2 = c * 64 + kk; p2 = p2 < nsel ? p2 : 0; return brow + (long)myidx[p2] * IN_COLS + C_DKV + 64; }, lane);
        }
#pragma unroll
        for (int h = 0; h < 8; ++h) {
            float inv = l[h] > 0.f ? 1.0f / l[h] : 0.f;
#pragma unroll
            for (int j = 0; j < 4; ++j) {
                float v = o[h][j] * inv;
                v += __shfl_xor(v, 16);
                v += __shfl_xor(v, 32);
                o[h][j] = v;
            }
        }
        if (lane < 16) {
#pragma unroll
            for (int h = 0; h < 8; ++h) {
                uint2 o2 = uint2{pack2(o[h][0], o[h][1]), pack2(o[h][2], o[h][3])};
                *(uint2*)(yb + (long)t * 512 + h * 64 + lane * 4) = o2;
            }
        }
    }
}

__device__ __forceinline__ void peer_route(unsigned char* ws, int layer, unsigned char* smem) {
    const int tid = tidx(), lane = tid & 63, w = tid >> 6;
    const u16* pq = (const u16*)(ws + OFF_PQ);
    const u16* skb = (const u16*)(ws + OFF_W + layer * W_LAYER + WO_SK);
    int* eidx = (int*)(ws + OFF_EIDX);
    float* gate = (float*)(ws + OFF_GATE);
    float* scw = (float*)(smem + w * 12288);
    float* tv = (float*)(smem + w * 12288 + 8192);
    int* ti = (int*)(smem + w * 12288 + 8192 + 2048);
    int pa = 0, pb = lane;
    while (pa < 16 && pb >= 16 / (pa + 1)) { pb -= 16 / (pa + 1); pa++; }
    const bool pvalid = pa < 16;
    const int nunits = NTOK / 16;
    for (int unit = bidx() * 4 + w; unit < nunits; unit += gdim() * 4) {
        const int tok0 = unit * 16;
        for (int h = 0; h < 8; ++h) {
            for (int half = 0; half < 2; ++half) {
                bf16x8 af[4];
#pragma unroll
                for (int ks = 0; ks < 4; ++ks)
                    af[ks] = *(const bf16x8*)(pq + (long)(tok0 + (lane & 15)) * 2048 + h * 256 + half * 128 + ks * 32 + (lane >> 4) * 8);
#pragma unroll
                for (int nt = 0; nt < 8; ++nt) {
                    f32x4 acc = f32x4{0.f, 0.f, 0.f, 0.f};
#pragma unroll
                    for (int ks = 0; ks < 4; ++ks) {
                        bf16x8 bfr = *(const bf16x8*)(skb + (size_t)half * 128 * 128 + (size_t)(nt * 16 + (lane & 15)) * 128 + ks * 32 + (lane >> 4) * 8);
                        acc = __builtin_amdgcn_mfma_f32_16x16x32_bf16(af[ks], bfr, acc, 0, 0, 0);
                    }
#pragma unroll
                    for (int i = 0; i < 4; ++i) scw[((lane >> 4) * 4 + i) * 128 + nt * 16 + (lane & 15)] = acc[i];
                }
                WAVE_SYNC();
                for (int tok = 0; tok < 16; ++tok) {
                    const float* sr = scw + tok * 128;
                    float s0 = sr[lane], s1 = sr[lane + 64];
                    int r0 = 0, r1 = 0;
#pragma unroll 8
                    for (int j4 = 0; j4 < 32; ++j4) {
                        float4 v = *(const float4*)(sr + j4 * 4);
                        float vv[4] = {v.x, v.y, v.z, v.w};
#pragma unroll
                        for (int e = 0; e < 4; ++e) {
                            int j = j4 * 4 + e;
                            r0 += (vv[e] > s0 || (vv[e] == s0 && j < lane)) ? 1 : 0;
                            r1 += (vv[e] > s1 || (vv[e] == s1 && j < lane + 64)) ? 1 : 0;
                        }
                    }
                    if (r0 < 16) { tv[(half * 16 + tok) * 16 + r0] = s0; ti[(half * 16 + tok) * 16 + r0] = lane; }
                    if (r1 < 16) { tv[(half * 16 + tok) * 16 + r1] = s1; ti[(half * 16 + tok) * 16 + r1] = lane + 64; }
                }
                WAVE_SYNC();
            }
            for (int tok = 0; tok < 16; ++tok) {
                float c = -__builtin_inff();
                int pos = 1 << 20, eid = 0;
                if (pvalid) {
                    c = tv[(0 * 16 + tok) * 16 + pa] + tv[(1 * 16 + tok) * 16 + pb];
                    pos = pa * 16 + pb;
                    eid = ti[(0 * 16 + tok) * 16 + pa] * 128 + ti[(1 * 16 + tok) * 16 + pb];
                }
                int rank = 0;
                for (int pp = 0; pp < 50; ++pp) {
                    float cj = __shfl(c, pp);
                    int pj = __shfl(pos, pp);
                    rank += (cj > c || (cj == c && pj < pos)) ? 1 : 0;
                }
                bool sel = pvalid && rank < 16;
                float mx = wmax(sel ? c : -__builtin_inff());
                float ex = sel ? __expf(c - mx) : 0.f;
                float sm = wsum(ex);
                if (sel) {
                    long o = (long)(tok0 + tok) * 128 + h * 16 + rank;
                    eidx[o] = eid;
                    gate[o] = ex / sm;
                }
            }
            WAVE_SYNC();
        }
    }
}

__device__ __forceinline__ void peer_experts(unsigned char* ws, float* xout) {
    const int lane = tidx() & 63, w = tidx() >> 6;
    const u16* hbuf = (const u16*)(ws + OFF_H);
    const u16* ub = (const u16*)(ws + OFF_UB);
    const u16* vb = (const u16*)(ws + OFF_VB);
    const int* eidx = (const int*)(ws + OFF_EIDX);
    const float* gate = (const float*)(ws + OFF_GATE);
    for (int t = bidx() * 4 + w; t < NTOK; t += gdim() * 4) {
        uint4 h0 = *(const uint4*)(hbuf + (long)t * 1024 + lane * 8);
        uint4 h1 = *(const uint4*)(hbuf + (long)t * 1024 + 512 + lane * 8);
        float acc[16];
#pragma unroll
        for (int i = 0; i < 16; ++i) acc[i] = 0.f;
        for (int e0 = 0; e0 < 128; e0 += 4) {
            int id[4];
            float gg[4];
            uint4 u0[4], u1[4], v0[4], v1[4];
#pragma unroll
            for (int k = 0; k < 4; ++k) {
                id[k] = __builtin_amdgcn_readfirstlane(eidx[(long)t * 128 + e0 + k]);
                gg[k] = gate[(long)t * 128 + e0 + k];
                const u16* ur = ub + (long)id[k] * 1024;
                const u16* vr = vb + (long)id[k] * 1024;
                u0[k] = *(const uint4*)(ur + lane * 8);
                u1[k] = *(const uint4*)(ur + 512 + lane * 8);
                v0[k] = *(const uint4*)(vr + lane * 8);
                v1[k] = *(const uint4*)(vr + 512 + lane * 8);
            }
#pragma unroll
            for (int k = 0; k < 4; ++k) {
                float d = 0.f;
                d = dot2(u0[k].x, h0.x, d); d = dot2(u0[k].y, h0.y, d); d = dot2(u0[k].z, h0.z, d); d = dot2(u0[k].w, h0.w, d);
                d = dot2(u1[k].x, h1.x, d); d = dot2(u1[k].y, h1.y, d); d = dot2(u1[k].z, h1.z, d); d = dot2(u1[k].w, h1.w, d);
                d = wsum(d);
                float a = gelu_tanh(d) * gg[k];
                acc[0] += a * bf_lo(v0[k].x); acc[1] += a * bf_hi(v0[k].x);
                acc[2] += a * bf_lo(v0[k].y); acc[3] += a * bf_hi(v0[k].y);
                acc[4] += a * bf_lo(v0[k].z); acc[5] += a * bf_hi(v0[k].z);
                acc[6] += a * bf_lo(v0[k].w); acc[7] += a * bf_hi(v0[k].w);
                acc[8] += a * bf_lo(v1[k].x); acc[9] += a * bf_hi(v1[k].x);
                acc[10] += a * bf_lo(v1[k].y); acc[11] += a * bf_hi(v1[k].y);
                acc[12] += a * bf_lo(v1[k].z); acc[13] += a * bf_hi(v1[k].z);
                acc[14] += a * bf_lo(v1[k].w); acc[15] += a * bf_hi(v1[k].w);
            }
        }
        float* xr = xout + (long)t * 1024;
        float4 a0 = *(float4*)(xr + lane * 8), a1 = *(float4*)(xr + lane * 8 + 4);
        float4 b0 = *(float4*)(xr + 512 + lane * 8), b1 = *(float4*)(xr + 512 + lane * 8 + 4);
        a0.x += acc[0]; a0.y += acc[1]; a0.z += acc[2]; a0.w += acc[3];
        a1.x += acc[4]; a1.y += acc[5]; a1.z += acc[6]; a1.w += acc[7];
        b0.x += acc[8]; b0.y += acc[9]; b0.z += acc[10]; b0.w += acc[11];
        b1.x += acc[12]; b1.y += acc[13]; b1.z += acc[14]; b1.w += acc[15];
        *(float4*)(xr + lane * 8) = a0;
        *(float4*)(xr + lane * 8 + 4) = a1;
        *(float4*)(xr + 512 + lane * 8) = b0;
        *(float4*)(xr + 512 + lane * 8 + 4) = b1;
    }
}

__device__ __forceinline__ void phase_prep(const Params& P, unsigned char* smem) {
    unsigned char* ws = opq(P.ws);
    const long gtid = (long)bidx() * 256 + tidx();
    const long gthreads = (long)gdim() * 256;
    for (int l = 0; l < 2; ++l) {
        unsigned char* wl = ws + OFF_W + l * W_LAYER;
        float* tile = (float*)smem;
        transpose_cvt(P.w_in + (size_t)l * 1024 * IN_COLS, (u16*)(wl + WO_WIN), 1024, IN_COLS, tile);
        for (int c = 0; c < 2; ++c) {
            transpose_cvt(P.cmp_w1 + ((size_t)l * 2 + c) * 2048 * 256, (u16*)(wl + WO_W1) + (size_t)c * 256 * 2048, 2048, 256, tile);
            transpose_cvt(P.cmp_w2 + ((size_t)l * 2 + c) * 256 * 64, (u16*)(wl + WO_W2) + (size_t)c * 64 * 256, 256, 64, tile);
        }
        transpose_cvt(P.w_a + (size_t)l * 512 * 1024, (u16*)(wl + WO_WA), 512, 1024, tile);
        transpose_cvt(P.w_b + (size_t)l * 512 * 1024, (u16*)(wl + WO_WB), 512, 1024, tile);
        transpose_cvt(P.w_out + (size_t)l * 1024 * 1024, (u16*)(wl + WO_WO), 1024, 1024, tile);
        transpose_cvt(P.peer_wq + (size_t)l * 1024 * 2048, (u16*)(wl + WO_WQ), 1024, 2048, tile);
        transpose_cvt(P.ple_w + (size_t)l * 256 * 1024, (u16*)(wl + WO_PW), 256, 1024, tile);
        transpose_cvt(P.ple_gw + (size_t)l * 1024 * 1024, (u16*)(wl + WO_PG), 1024, 1024, tile);
        cvt_f32_bf16(P.peer_sk + (size_t)l * 2 * 128 * 128, (u16*)(wl + WO_SK), 2 * 128 * 128);
        if (gtid < 512) {
            int c = (int)gtid >> 8, col = (int)gtid & 255;
            const float* pos = P.cmp_pos + ((size_t)l * 2 + c) * 2048;
            const float* w1 = P.cmp_w1 + ((size_t)l * 2 + c) * 2048 * 256;
            float s = 0.f;
            for (int k = 0; k < 2048; ++k) s += pos[k] * w1[(size_t)k * 256 + col];
            ((float*)(wl + WO_CB))[c * 256 + col] = s;
        }
    }
    {
        float* ropec = (float*)(ws + OFF_ROPE);
        float* ropes = ropec + (size_t)NTOK * 8;
        for (long i = gtid; i < (long)NTOK * 8; i += gthreads) {
            int t = (int)(i >> 3), k = (int)(i & 7);
            double inv = pow(500000.0, -(double)k / 8.0);
            double ang = (double)P.positions[t] * inv;
            ropec[i] = (float)cos(ang);
            ropes[i] = (float)sin(ang);
        }
    }
    rms_rows(P.x, P.attn_norm, (u16*)(ws + OFF_H), nullptr, nullptr);
}

__device__ __forceinline__ void phase_g1(const Params& P, int layer, unsigned char* smem) {
    unsigned char* ws = opq(P.ws);
    u16* proj = (u16*)(ws + OFF_PROJ);
    gemm_phase<0>((const u16*)(ws + OFF_H), 1024, (const u16*)(ws + OFF_W + layer * W_LAYER + WO_WIN), 1024, NTOK, IN_COLS, 1024, (u16*)smem,
                  [=](int row, int col, float v) { proj[(long)row * IN_COLS + col] = f2bf(v); });
}

__device__ __forceinline__ void phase_c1(const Params& P, int layer, unsigned char* smem) {
    unsigned char* ws = opq(P.ws);
    unsigned char* wl = ws + OFF_W + layer * W_LAYER;
    const u16* proj = (const u16*)(ws + OFF_PROJ);
    u16* chid = (u16*)(ws + OFF_CHID);
    const float* cbias = (const float*)(wl + WO_CB);
    for (int c = 0; c < 2; ++c) {
        u16* ch = chid + (size_t)c * CROWS * 256;
        const float* cb = cbias + c * 256;
        gemm_phase<1>(proj + C_NKV + c * 128, 0, (const u16*)(wl + WO_W1) + (size_t)c * 256 * 2048, 2048, CROWS, 256, 2048, (u16*)smem,
                      [=](int row, int col, float v) { ch[(long)row * 256 + col] = f2bf(gelu_tanh(v + cb[col])); });
    }
}

__device__ __forceinline__ void phase_c2(const Params& P, int layer, unsigned char* smem) {
    unsigned char* ws = opq(P.ws);
    unsigned char* wl = ws + OFF_W + layer * W_LAYER;
    const u16* chid = (const u16*)(ws + OFF_CHID);
    float* cbuf = (float*)(ws + OFF_CBUF);
    for (int c = 0; c < 2; ++c) {
        float* cbo = cbuf + (size_t)c * CROWS * 64;
        gemm_phase<0>(chid + (size_t)c * CROWS * 256, 256, (const u16*)(wl + WO_W2) + (size_t)c * 64 * 256, 256, CROWS, 64, 256, (u16*)smem,
                      [=](int row, int col, float v) { cbo[(long)row * 64 + col] = v; });
    }
}

__device__ __forceinline__ void phase_c3(const Params& P, int layer) {
    unsigned char* ws = opq(P.ws);
    const int lane = tidx() & 63, w = tidx() >> 6;
    const float* cbuf = (const float*)(ws + OFF_CBUF);
    u16* kcb = (u16*)(ws + OFF_KCB);
    u16* vcb = (u16*)(ws + OFF_VCB);
    const float* ropec = (const float*)(ws + OFF_ROPE);
    const float* ropes = ropec + (size_t)NTOK * 8;
    const float* gain = P.nsa_gain + layer * 256 + 64;
    for (int r = bidx() * 4 + w; r < 2 * CROWS; r += gdim() * 4) {
        int c = r / CROWS, rr = r - c * CROWS;
        int b = rr / (NCMP * 2);
        int rem = rr - b * (NCMP * 2);
        int n = rem >> 1, g = rem & 1;
        float v = cbuf[(size_t)r * 64 + lane];
        size_t o = ((size_t)(b * 2 + g) * 256 + n) * 64 + lane;
        if (c == 0) {
            float ss = wsum(v * v);
            v = v * rsqrtf(ss * (1.0f / 64.0f) + EPS) * gain[lane];
            float pv = __shfl_xor(v, 8);
            if (lane < 16) {
                long tt = (long)b * SEQ + 31 + 16 * n;
                float cs = ropec[tt * 8 + (lane & 7)], sn = ropes[tt * 8 + (lane & 7)];
                v = (lane < 8) ? (v * cs - pv * sn) : (v * cs + pv * sn);
            }
            kcb[o] = f2bf(v);
        } else {
            vcb[o] = f2bf(v);
        }
    }
}

__device__ __forceinline__ void phase_att(const Params& P, unsigned char* smem) {
    const int w = tidx() >> 6;
    {
        unsigned char* ws = opq(P.ws);
        for (int u = bidx(); u < NTOK / 4; u += gdim()) dsa_unit(ws, u, smem);
    }
    __syncthreads();
    {
        unsigned char* ws = opq(P.ws);
        for (int u = bidx() * 4 + w; u < NTOK * 2; u += gdim() * 4) nsa_unit(ws, u >> 1, u & 1, smem + w * 2560);
    }
}

__device__ __forceinline__ void phase_merge(const Params& P, int layer, unsigned char* smem) {
    unsigned char* ws = opq(P.ws);
    unsigned char* wl = ws + OFF_W + layer * W_LAYER;
    const u16* proj = (const u16*)(ws + OFF_PROJ);
    u16* hbuf = (u16*)(ws + OFF_H);
    const u16* ya = (const u16*)(ws + OFF_YAB);
    const u16* yb = ya + (size_t)NTOK * 512;
    gemm_phase<0>(ya, 512, (const u16*)(wl + WO_WA), 512, NTOK, 1024, 512, (u16*)smem, [=](int row, int col, float v) {
        float ga = bf2f(proj[(long)row * IN_COLS + C_MG + col]);
        hbuf[(long)row * 1024 + col] = f2bf(ga * v);
    });
    gemm_phase<0>(yb, 512, (const u16*)(wl + WO_WB), 512, NTOK, 1024, 512, (u16*)smem, [=](int row, int col, float v) {
        float gb = bf2f(proj[(long)row * IN_COLS + C_MG + 1024 + col]);
        long o = (long)row * 1024 + col;
        hbuf[o] = f2bf(bf2f(hbuf[o]) + gb * v);
    });
}

__device__ __forceinline__ void phase_outproj(const Params& P, int layer, unsigned char* smem) {
    unsigned char* ws = opq(P.ws);
    unsigned char* wl = ws + OFF_W + layer * W_LAYER;
    float* out = opq(P.out);
    const float* xin = (layer == 0) ? P.x : (const float*)out;
    gemm_phase<0>((const u16*)(ws + OFF_H), 1024, (const u16*)(wl + WO_WO), 1024, NTOK, 1024, 1024, (u16*)smem, [=](int row, int col, float v) {
        long o = (long)row * 1024 + col;
        out[o] = xin[o] + v;
    });
    cvt_f32_bf16(P.peer_u + (size_t)layer * NEXP * 1024, (u16*)(ws + OFF_UB), (long)NEXP * 1024);
    cvt_f32_bf16(P.peer_v + (size_t)layer * NEXP * 1024, (u16*)(ws + OFF_VB), (long)NEXP * 1024);
}

__device__ __forceinline__ void phase_pq(const Params& P, int layer, unsigned char* smem) {
    unsigned char* ws = opq(P.ws);
    unsigned char* wl = ws + OFF_W + layer * W_LAYER;
    u16* pq = (u16*)(ws + OFF_PQ);
    u16* eb = (u16*)(ws + OFF_YAB);
    gemm_phase<0>((const u16*)(ws + OFF_H), 1024, (const u16*)(wl + WO_WQ), 1024, NTOK, 2048, 1024, (u16*)smem,
                  [=](int row, int col, float v) { pq[(long)row * 2048 + col] = f2bf(v); });
    gemm_phase<2>(P.p + (size_t)layer * NTOK * 256, 256, (const u16*)(wl + WO_PW), 256, NTOK, 1024, 256, (u16*)smem,
                  [=](int row, int col, float v) { eb[(long)row * 1024 + col] = f2bf(v); });
}

__device__ __forceinline__ void phase_final(const Params& P, int layer, unsigned char* smem) {
    unsigned char* ws = opq(P.ws);
    unsigned char* wl = ws + OFF_W + layer * W_LAYER;
    float* out = opq(P.out);
    const u16* eb = (const u16*)(ws + OFF_YAB);
    const float* rstde = (const float*)(ws + OFF_RSTDE);
    const float* pn = P.ple_norm + layer * 1024;
    gemm_phase<0>((const u16*)(ws + OFF_H), 1024, (const u16*)(wl + WO_PG), 1024, NTOK, 1024, 1024, (u16*)smem, [=](int row, int col, float v) {
        long o = (long)row * 1024 + col;
        out[o] = out[o] + sigmoidf(v) * (bf2f(eb[o]) * rstde[row] * pn[col]);
    });
}

__global__ void __launch_bounds__(256, 2) fwd_kernel(Params P) {
    cg::grid_group grid = cg::this_grid();
    extern __shared__ __attribute__((aligned(16))) unsigned char smem[];
    phase_prep(P, smem);
    grid.sync();
    for (int layer = 0; layer < 2; ++layer) {
        phase_g1(P, layer, smem);
        grid.sync();
        post_proj(opq(P.ws), P.nsa_gain + layer * 256, P.dsa_gain + layer * 128);
        grid.sync();
        phase_c1(P, layer, smem);
        grid.sync();
        phase_c2(P, layer, smem);
        grid.sync();
        phase_c3(P, layer);
        grid.sync();
        phase_att(P, smem);
        grid.sync();
        phase_merge(P, layer, smem);
        grid.sync();
        phase_outproj(P, layer, smem);
        grid.sync();
        {
            unsigned char* ws = opq(P.ws);
            rms_rows(opq(P.out), P.ffn_norm + layer * 1024, (u16*)(ws + OFF_H), nullptr, nullptr);
        }
        grid.sync();
        phase_pq(P, layer, smem);
        grid.sync();
        peer_route(opq(P.ws), layer, smem);
        grid.sync();
        peer_experts(opq(P.ws), opq(P.out));
        grid.sync();
        {
            unsigned char* ws = opq(P.ws);
            rms_rows(opq(P.out), nullptr, (u16*)(ws + OFF_H), (const u16*)(ws + OFF_YAB), (float*)(ws + OFF_RSTDE));
        }
        grid.sync();
        phase_final(P, layer, smem);
        grid.sync();
        if (layer == 0) {
            unsigned char* ws = opq(P.ws);
            rms_rows(opq(P.out), P.attn_norm + 1024, (u16*)(ws + OFF_H), nullptr, nullptr);
            grid.sync();
        }
    }
}

extern "C" void kernel_launch(void* const* d_in, const int* in_sizes, int n_in, void* d_out, int out_size, void* d_ws, size_t ws_size,
                              hipStream_t stream) {
    static int grid_blocks = 0;
    if (!grid_blocks) {
        int dev = 0, cus = 0, per_cu = 0;
        (void)hipGetDevice(&dev);
        (void)hipDeviceGetAttribute(&cus, hipDeviceAttributeMultiprocessorCount, dev);
        (void)hipFuncSetAttribute((const void*)fwd_kernel, hipFuncAttributeMaxDynamicSharedMemorySize, LDS_BYTES);
        (void)hipOccupancyMaxActiveBlocksPerMultiprocessor(&per_cu, fwd_kernel, 256, LDS_BYTES);
        if (per_cu > 2) per_cu = 2;
        if (per_cu < 1) per_cu = 1;
        grid_blocks = cus * per_cu;
        if (ws_size < WS_END) fprintf(stderr, "kernel_launch: workspace too small: %zu < %zu\n", ws_size, (size_t)WS_END);
    }
    Params P{};
    P.x = (const float*)d_in[0];
    P.p = (const float*)d_in[1];
    P.positions = (const int*)d_in[2];
    P.attn_norm = (const float*)d_in[3];
    P.w_in = (const float*)d_in[4];
    P.nsa_gain = (const float*)d_in[5];
    P.cmp_pos = (const float*)d_in[6];
    P.cmp_w1 = (const float*)d_in[7];
    P.cmp_w2 = (const float*)d_in[8];
    P.dsa_gain = (const float*)d_in[9];
    P.w_a = (const float*)d_in[10];
    P.w_b = (const float*)d_in[11];
    P.w_out = (const float*)d_in[12];
    P.ffn_norm = (const float*)d_in[13];
    P.peer_wq = (const float*)d_in[14];
    P.peer_sk = (const float*)d_in[15];
    P.peer_u = (const float*)d_in[16];
    P.peer_v = (const float*)d_in[17];
    P.ple_w = (const float*)d_in[18];
    P.ple_gw = (const float*)d_in[19];
    P.ple_norm = (const float*)d_in[20];
    P.out = (float*)d_out;
    P.ws = (unsigned char*)d_ws;
    void* args[] = {&P};
    hipError_t e = hipLaunchCooperativeKernel((void*)fwd_kernel, dim3(grid_blocks), dim3(256), args, LDS_BYTES, stream);
    if (e != hipSuccess) fprintf(stderr, "cooperative launch failed: %s (grid %d)\n", hipGetErrorString(e), grid_blocks);
}
```

```cpp
#include <hip/hip_runtime.h>
#include <hip/hip_cooperative_groups.h>
#include <cstdio>
#include <cstdint>
namespace cg = cooperative_groups;

typedef unsigned short u16;
typedef unsigned int u32;
typedef unsigned long long u64;
using bf16x8 = __attribute__((ext_vector_type(8))) short;
using f32x4 = __attribute__((ext_vector_type(4))) float;
using f32x16 = __attribute__((ext_vector_type(16))) float;
typedef __bf16 bf16x2_t __attribute__((ext_vector_type(2)));

constexpr int D_MODEL = 1024, BATCH = 8, SEQ = 4096, NTOK = BATCH * SEQ;
constexpr int IN_COLS = 4576;
constexpr int C_NQ = 0, C_NKV = 512, C_NG = 1280, C_DQ = 1304, C_DKV = 1816, C_IQ = 1944, C_IK = 2456, C_IW = 2520, C_MG = 2528;
constexpr int NCMP = 255;
constexpr int CROWS = BATCH * NCMP * 2;
constexpr int NEXP = 16384;
constexpr float EPS = 1e-6f;

constexpr size_t AL(size_t x) { return (x + 255) & ~(size_t)255; }
constexpr size_t WO_WIN = 0;
constexpr size_t WO_W1 = WO_WIN + AL((size_t)IN_COLS * 1024 * 2);
constexpr size_t WO_W2 = WO_W1 + AL((size_t)2 * 256 * 2048 * 2);
constexpr size_t WO_WA = WO_W2 + AL((size_t)2 * 64 * 256 * 2);
constexpr size_t WO_WB = WO_WA + AL((size_t)1024 * 512 * 2);
constexpr size_t WO_WO = WO_WB + AL((size_t)1024 * 512 * 2);
constexpr size_t WO_WQ = WO_WO + AL((size_t)1024 * 1024 * 2);
constexpr size_t WO_PW = WO_WQ + AL((size_t)2048 * 1024 * 2);
constexpr size_t WO_PG = WO_PW + AL((size_t)1024 * 256 * 2);
constexpr size_t WO_SK = WO_PG + AL((size_t)1024 * 1024 * 2);
constexpr size_t WO_CB = WO_SK + AL((size_t)2 * 128 * 128 * 2);
constexpr size_t W_LAYER = WO_CB + AL((size_t)2 * 256 * 4);

constexpr size_t OFF_W = 0;
constexpr size_t OFF_ROPE = OFF_W + 2 * W_LAYER;
constexpr size_t OFF_H = OFF_ROPE + AL((size_t)NTOK * 16 * 4);
constexpr size_t OFF_PROJ = OFF_H + AL((size_t)NTOK * 1024 * 2);
constexpr size_t OFF_YAB = OFF_PROJ + AL((size_t)NTOK * IN_COLS * 2);
constexpr size_t OFF_CHID = OFF_YAB + AL((size_t)NTOK * 1024 * 2);
constexpr size_t OFF_CBUF = OFF_CHID + AL((size_t)2 * CROWS * 256 * 2);
constexpr size_t OFF_KCB = OFF_CBUF + AL((size_t)2 * CROWS * 64 * 4);
constexpr size_t OFF_VCB = OFF_KCB + AL((size_t)BATCH * 2 * 256 * 64 * 2);
constexpr size_t OFF_RSTDE = OFF_VCB + AL((size_t)BATCH * 2 * 256 * 64 * 2);
constexpr size_t OFF_BITS = OFF_RSTDE + AL((size_t)NTOK * 4);
constexpr size_t WS_END = OFF_BITS + AL((size_t)NTOK * 64 * 8);
constexpr size_t OFF_PQ = OFF_PROJ;
constexpr size_t OFF_UB = OFF_PQ + (size_t)NTOK * 2048 * 2;
constexpr size_t OFF_VB = OFF_UB + (size_t)NEXP * 1024 * 2;
constexpr size_t OFF_EIDX = OFF_VB + (size_t)NEXP * 1024 * 2;
constexpr size_t OFF_GATE = OFF_EIDX + (size_t)NTOK * 128 * 4;
static_assert(OFF_GATE + (size_t)NTOK * 128 * 4 <= OFF_YAB, "alias overflow");

constexpr int LDS_BYTES = 65536 + 2048;

struct Params {
    const float* x; const float* p; const int* positions;
    const float* attn_norm; const float* w_in; const float* nsa_gain; const float* cmp_pos; const float* cmp_w1; const float* cmp_w2;
    const float* dsa_gain; const float* w_a; const float* w_b; const float* w_out; const float* ffn_norm; const float* peer_wq;
    const float* peer_sk; const float* peer_u; const float* peer_v; const float* ple_w; const float* ple_gw; const float* ple_norm;
    float* out; unsigned char* ws;
};

__device__ __forceinline__ u16 f2bf(float f) {
    u32 u = __float_as_uint(f);
    u32 r = u + 0x7FFFu + ((u >> 16) & 1u);
    return (u16)(r >> 16);
}
__device__ __forceinline__ float bf2f(u16 h) { return __uint_as_float(((u32)h) << 16); }
__device__ __forceinline__ float bf_lo(u32 w) { return __uint_as_float(w << 16); }
__device__ __forceinline__ float bf_hi(u32 w) { return __uint_as_float(w & 0xFFFF0000u); }
__device__ __forceinline__ u32 pack2(float a, float b) {
    bf16x2_t v = {(__bf16)a, (__bf16)b};
    return __builtin_bit_cast(u32, v);
}
__device__ __forceinline__ float dot2(u32 a, u32 b, float c) {
    return __builtin_amdgcn_fdot2_f32_bf16(__builtin_bit_cast(bf16x2_t, a), __builtin_bit_cast(bf16x2_t, b), c, false);
}
__device__ __forceinline__ float wsum(float v) {
#pragma unroll
    for (int o = 32; o > 0; o >>= 1) v += __shfl_xor(v, o);
    return v;
}
__device__ __forceinline__ float wmax(float v) {
#pragma unroll
    for (int o = 32; o > 0; o >>= 1) v = fmaxf(v, __shfl_xor(v, o));
    return v;
}
__device__ __forceinline__ int wsumi(int v) {
#pragma unroll
    for (int o = 32; o > 0; o >>= 1) v += __shfl_xor(v, o);
    return v;
}
__device__ __forceinline__ float sigmoidf(float x) { return 1.0f / (1.0f + __expf(-x)); }
__device__ __forceinline__ float gelu_tanh(float x) {
    float u = 0.7978845608028654f * (x + 0.044715f * x * x * x);
    return 0.5f * x * (1.0f + tanhf(u));
}
#define WAVE_SYNC() asm volatile("s_waitcnt lgkmcnt(0)" ::: "memory")
template <class T>
__device__ __forceinline__ T* opq(T* p) {
    asm volatile("" : "+s"(p));
    return p;
}
__device__ __forceinline__ int tidx() {
    int t = threadIdx.x;
    asm volatile("" : "+v"(t));
    return t;
}
__device__ __forceinline__ int bidx() {
    int b = blockIdx.x;
    asm volatile("" : "+s"(b));
    return b;
}
__device__ __forceinline__ int gdim() {
    int g = gridDim.x;
    asm volatile("" : "+s"(g));
    return g;
}

template <int AMODE, class Epi>
__device__ __forceinline__ void gemm_tile(const void* __restrict__ Ap, long lda, const u16* __restrict__ BT, long ldb, int M, int N, int K,
                                          int m0, int n0, u16* lds, Epi epi) {
    const int tid = tidx(), lane = tid & 63, w = tid >> 6;
    const int wm = w >> 1, wn = w & 1;
    u16* As = lds;
    u16* Bs = lds + 128 * 40;
    f32x4 acc[4][4];
#pragma unroll
    for (int i = 0; i < 4; ++i)
#pragma unroll
        for (int j = 0; j < 4; ++j) acc[i][j] = f32x4{0.f, 0.f, 0.f, 0.f};

    const int lkc = tid & 3;
    const int lrow0 = tid >> 2, lrow1 = 64 + (tid >> 2);
    long abase0, abase1, bbase0, bbase1;
    {
        int gr0 = m0 + lrow0, gr1 = m0 + lrow1;
        if (gr0 > M - 1) gr0 = M - 1;
        if (gr1 > M - 1) gr1 = M - 1;
        if (AMODE == 1) {
            int b = gr0 / (NCMP * 2);
            int rem = gr0 - b * (NCMP * 2);
            abase0 = ((long)b * SEQ + 16 * (rem >> 1)) * IN_COLS + (rem & 1) * 64;
            b = gr1 / (NCMP * 2);
            rem = gr1 - b * (NCMP * 2);
            abase1 = ((long)b * SEQ + 16 * (rem >> 1)) * IN_COLS + (rem & 1) * 64;
        } else {
            abase0 = (long)gr0 * lda;
            abase1 = (long)gr1 * lda;
        }
        int gn0 = n0 + lrow0, gn1 = n0 + lrow1;
        if (gn0 > N - 1) gn0 = N - 1;
        if (gn1 > N - 1) gn1 = N - 1;
        bbase0 = (long)gn0 * ldb;
        bbase1 = (long)gn1 * ldb;
    }
    uint4 ra0, ra1, rb0, rb1;
#define GEMM_LOAD_A(dst, abase, k)                                                                          \
    do {                                                                                                    \
        if (AMODE == 0) {                                                                                   \
            dst = *(const uint4*)((const u16*)Ap + (abase) + (k));                                          \
        } else if (AMODE == 1) {                                                                            \
            dst = *(const uint4*)((const u16*)Ap + (abase) + (long)((k) >> 6) * IN_COLS + ((k) & 63));      \
        } else {                                                                                            \
            const float* fp_ = (const float*)Ap + (abase) + (k);                                            \
            float4 f0_ = *(const float4*)fp_;                                                               \
            float4 f1_ = *(const float4*)(fp_ + 4);                                                         \
            dst = uint4{pack2(f0_.x, f0_.y), pack2(f0_.z, f0_.w), pack2(f1_.x, f1_.y), pack2(f1_.z, f1_.w)}; \
        }                                                                                                   \
    } while (0)
#define GEMM_LOAD_ALL(k0)                              \
    do {                                               \
        const int k_ = (k0) + lkc * 8;                 \
        GEMM_LOAD_A(ra0, abase0, k_);                  \
        GEMM_LOAD_A(ra1, abase1, k_);                  \
        rb0 = *(const uint4*)(BT + bbase0 + k_);       \
        rb1 = *(const uint4*)(BT + bbase1 + k_);       \
    } while (0)
    const int nk = K / 32;
    GEMM_LOAD_ALL(0);
    for (int kt = 0; kt < nk; ++kt) {
        *(uint4*)(As + lrow0 * 40 + lkc * 8) = ra0;
        *(uint4*)(As + lrow1 * 40 + lkc * 8) = ra1;
        *(uint4*)(Bs + lrow0 * 40 + lkc * 8) = rb0;
        *(uint4*)(Bs + lrow1 * 40 + lkc * 8) = rb1;
        __syncthreads();
        if (kt + 1 < nk) GEMM_LOAD_ALL((kt + 1) * 32);
        bf16x8 af[4], bfr[4];
#pragma unroll
        for (int i = 0; i < 4; ++i) {
            af[i] = *(const bf16x8*)(As + (wm * 64 + i * 16 + (lane & 15)) * 40 + (lane >> 4) * 8);
            bfr[i] = *(const bf16x8*)(Bs + (wn * 64 + i * 16 + (lane & 15)) * 40 + (lane >> 4) * 8);
        }
#pragma unroll
        for (int i = 0; i < 4; ++i)
#pragma unroll
            for (int j = 0; j < 4; ++j) acc[i][j] = __builtin_amdgcn_mfma_f32_16x16x32_bf16(af[i], bfr[j], acc[i][j], 0, 0, 0);
        __syncthreads();
    }
#pragma unroll
    for (int i = 0; i < 4; ++i)
#pragma unroll
        for (int j = 0; j < 4; ++j)
#pragma unroll
            for (int r = 0; r < 4; ++r) {
                int row = m0 + wm * 64 + i * 16 + (lane >> 4) * 4 + r;
                int col = n0 + wn * 64 + j * 16 + (lane & 15);
                if (row < M && col < N) epi(row, col, acc[i][j][r]);
            }
}

template <int AMODE, class Epi>
__device__ __forceinline__ void gemm_phase(const void* Ap, long lda, const u16* BT, long ldb, int M, int N, int K, u16* lds, Epi epi) {
    const int tm = (M + 127) / 128, tn = (N + 127) / 128;
    for (int t = bidx(); t < tm * tn; t += gdim()) {
        int im = t / tn, in = t - im * tn;
        gemm_tile<AMODE>(Ap, lda, BT, ldb, M, N, K, im * 128, in * 128, lds, epi);
    }
}

__device__ __forceinline__ void transpose_cvt(const float* __restrict__ src, u16* __restrict__ dst, int K, int N, float* tile) {
    const int tk = K / 64, tn = (N + 63) / 64;
    const int tx = tidx() & 63, ty = tidx() >> 6;
    for (int t = bidx(); t < tk * tn; t += gdim()) {
        int k0 = (t / tn) * 64, n0 = (t % tn) * 64;
#pragma unroll
        for (int r = 0; r < 16; ++r) {
            int k = ty * 16 + r, n = n0 + tx;
            tile[k * 65 + tx] = (n < N) ? src[(long)(k0 + k) * N + n] : 0.f;
        }
        __syncthreads();
#pragma unroll
        for (int r = 0; r < 16; ++r) {
            int nn = ty * 16 + r, n = n0 + nn;
            if (n < N) dst[(long)n * K + k0 + tx] = f2bf(tile[tx * 65 + nn]);
        }
        __syncthreads();
    }
}

__device__ __forceinline__ void cvt_f32_bf16(const float* __restrict__ src, u16* __restrict__ dst, long n) {
    long i = ((long)bidx() * 256 + tidx()) * 8;
    const long stride = (long)gdim() * 256 * 8;
    for (; i < n; i += stride) {
        float4 a = *(const float4*)(src + i);
        float4 b = *(const float4*)(src + i + 4);
        *(uint4*)(dst + i) = uint4{pack2(a.x, a.y), pack2(a.z, a.w), pack2(b.x, b.y), pack2(b.z, b.w)};
    }
}

__device__ __forceinline__ void rms_rows(const float* __restrict__ x, const float* __restrict__ g, u16* __restrict__ dst, const u16* __restrict__ e,
                         float* __restrict__ rstd_e) {
    const int lane = tidx() & 63;
    const int wid = bidx() * 4 + (tidx() >> 6);
    const int nw = gdim() * 4;
    for (int row = wid; row < NTOK; row += nw) {
        const float* xr = x + (long)row * 1024;
        float4 v[4];
        float ss = 0.f;
#pragma unroll
        for (int i = 0; i < 4; ++i) {
            v[i] = *(const float4*)(xr + i * 256 + lane * 4);
            ss += v[i].x * v[i].x + v[i].y * v[i].y + v[i].z * v[i].z + v[i].w * v[i].w;
        }
        ss = wsum(ss);
        float rstd = rsqrtf(ss * (1.0f / 1024.0f) + EPS);
#pragma unroll
        for (int i = 0; i < 4; ++i) {
            float4 gg = g ? *(const float4*)(g + i * 256 + lane * 4) : float4{1.f, 1.f, 1.f, 1.f};
            uint2 o = uint2{pack2(v[i].x * rstd * gg.x, v[i].y * rstd * gg.y), pack2(v[i].z * rstd * gg.z, v[i].w * rstd * gg.w)};
            *(uint2*)(dst + (long)row * 1024 + i * 256 + lane * 4) = o;
        }
        if (e) {
            const uint4* er = (const uint4*)(e + (long)row * 1024);
            float es = 0.f;
#pragma unroll
            for (int i = 0; i < 2; ++i) {
                uint4 q = er[i * 64 + lane];
                float a;
                a = bf_lo(q.x); es += a * a; a = bf_hi(q.x); es += a * a;
                a = bf_lo(q.y); es += a * a; a = bf_hi(q.y); es += a * a;
                a = bf_lo(q.z); es += a * a; a = bf_hi(q.z); es += a * a;
                a = bf_lo(q.w); es += a * a; a = bf_hi(q.w); es += a * a;
            }
            es = wsum(es);
            if (lane == 0) rstd_e[row] = rsqrtf(es * (1.0f / 1024.0f) + EPS);
        }
    }
}

__device__ __forceinline__ void head_chunk(u16* ptr, float gain, bool do_norm, float scale, float c, float sn, int lane) {
    float v = bf2f(ptr[lane]);
    if (do_norm) {
        float ss = wsum(v * v);
        v = v * rsqrtf(ss * (1.0f / 64.0f) + EPS) * gain;
    }
    float pv = __shfl_xor(v, 8);
    if (lane < 16) v = (lane < 8) ? (v * c - pv * sn) : (v * c + pv * sn);
    ptr[lane] = f2bf(v * scale);
}
__device__ __forceinline__ u32 sig2(u32 w) { return pack2(sigmoidf(bf_lo(w)), sigmoidf(bf_hi(w))); }

__device__ __forceinline__ void post_proj(unsigned char* ws, const float* ng, const float* dg, unsigned char* smem) {
    u16* proj = (u16*)(ws + OFF_PROJ);
    const float* ropec = (const float*)(ws + OFF_ROPE);
    const float* ropes = ropec + (size_t)NTOK * 8;
    const int lane = tidx() & 63, w = tidx() >> 6;
    u16* lrow = (u16*)(smem + w * 9216);
    const float g_q = ng[lane], g_ks = ng[128 + lane], g_kw = ng[192 + lane], g_dq = dg[lane], g_kb = dg[64 + lane];
    const int wid = bidx() * 4 + w;
    const int nw = gdim() * 4;
    for (int t = wid; t < NTOK; t += nw) {
        uint4* grow = (uint4*)(proj + (long)t * IN_COLS);
        const float c = ropec[(long)t * 8 + (lane & 7)], sn = ropes[(long)t * 8 + (lane & 7)];
#pragma unroll
        for (int i = 0; i < 8; ++i) ((uint4*)lrow)[i * 64 + lane] = grow[i * 64 + lane];
        if (lane < 60) ((uint4*)lrow)[512 + lane] = grow[512 + lane];
        WAVE_SYNC();
        for (int h = 0; h < 8; ++h) head_chunk(lrow + C_NQ + h * 64, g_q, true, 0.125f * 1.4426950408889634f, c, sn, lane);
        for (int g = 0; g < 2; ++g) head_chunk(lrow + C_NKV + (2 * 2 + g) * 64, g_ks, true, 1.0f, c, sn, lane);
        for (int g = 0; g < 2; ++g) head_chunk(lrow + C_NKV + (4 * 2 + g) * 64, g_kw, true, 1.0f, c, sn, lane);
        for (int h = 0; h < 8; ++h) head_chunk(lrow + C_DQ + h * 64, g_dq, true, 0.125f * 1.4426950408889634f, c, sn, lane);
        head_chunk(lrow + C_DKV, g_kb, true, 1.0f, c, sn, lane);
        for (int h = 0; h < 8; ++h) head_chunk(lrow + C_IQ + h * 64, 1.0f, false, 0.125f, c, sn, lane);
        head_chunk(lrow + C_IK, 1.0f, false, 1.0f, c, sn, lane);
        WAVE_SYNC();
#pragma unroll
        for (int i = 0; i < 9; ++i) {
            int idx = i * 64 + lane;
            if (idx < 572) {
                uint4 v = ((const uint4*)lrow)[idx];
                if (idx >= 316 || (idx >= 160 && idx < 163)) v = uint4{sig2(v.x), sig2(v.y), sig2(v.z), sig2(v.w)};
                grow[idx] = v;
            }
        }
        WAVE_SYNC();
    }
}

template <int NH>
__device__ __forceinline__ void qk_chunk(const u16* krow, const u32* qlds, float (&s)[NH]) {
    asm volatile("" ::: "memory");
    uint4 kr[8];
#pragma unroll
    for (int i = 0; i < 8; ++i) kr[i] = ((const uint4*)krow)[i];
#pragma unroll
    for (int h = 0; h < NH; ++h) s[h] = 0.f;
#pragma unroll
    for (int i = 0; i < 8; ++i)
#pragma unroll
        for (int h = 0; h < NH; ++h) {
            uint4 q = *(const uint4*)(qlds + h * 32 + i * 4);
            s[h] = dot2(kr[i].x, q.x, s[h]);
            s[h] = dot2(kr[i].y, q.y, s[h]);
            s[h] = dot2(kr[i].z, q.z, s[h]);
            s[h] = dot2(kr[i].w, q.w, s[h]);
        }
}

template <int NH, class VRow>
__device__ __forceinline__ void pv_chunk(const float* plds, VRow vrow, float (&o)[NH][4], int lane) {
    const int sub = lane >> 4, dq = lane & 15;
#pragma unroll 4
    for (int kk = 0; kk < 16; ++kk) {
        int key = kk * 4 + sub;
        const u16* vp = vrow(key);
        uint2 vv = *(const uint2*)(vp + dq * 4);
        float v0 = bf_lo(vv.x), v1 = bf_hi(vv.x), v2 = bf_lo(vv.y), v3 = bf_hi(vv.y);
#pragma unroll
        for (int h = 0; h < NH; ++h) {
            float ph = plds[key * NH + h];
            o[h][0] += ph * v0;
            o[h][1] += ph * v1;
            o[h][2] += ph * v2;
            o[h][3] += ph * v3;
        }
    }
}

template <int NH, class VRow>
__device__ __forceinline__ void attn_chunk(float (&s)[NH], bool valid, float (&m)[NH], float (&l)[NH], float (&o)[NH][4], float* plds, VRow vrow,
                                           int lane) {
#pragma unroll
    for (int h = 0; h < NH; ++h) {
        float sv = valid ? s[h] : -1e30f;
        float cm = wmax(sv);
        float mn = fmaxf(m[h], cm);
        float alpha = __expf(m[h] - mn);
        float p = valid ? __expf(sv - mn) : 0.f;
        l[h] = l[h] * alpha + wsum(p);
        m[h] = mn;
#pragma unroll
        for (int j = 0; j < 4; ++j) o[h][j] *= alpha;
        plds[lane * NH + h] = p;
    }
    WAVE_SYNC();
    pv_chunk<NH>(plds, vrow, o, lane);
    WAVE_SYNC();
}

#define MFMA32(a, b, c) __builtin_amdgcn_mfma_f32_32x32x16_bf16(a, b, c, 0, 0, 0)
typedef __attribute__((address_space(3))) const char* lds_cptr;
typedef short v4i16_t __attribute__((ext_vector_type(4)));
using s16x4 = __attribute__((ext_vector_type(4))) short;
__device__ __forceinline__ s16x4 vtr(lds_cptr p) {
    return __builtin_bit_cast(s16x4, __builtin_amdgcn_ds_read_tr16_b64_v4i16((__attribute__((address_space(3))) v4i16_t*)p));
}
__device__ __forceinline__ float swap32(float v) { return __shfl_xor(v, 32); }

using u32x4 = __attribute__((ext_vector_type(4))) unsigned;
struct TileRegs { u32x4 k0, k1, v0, v1; };
template <class RowPtr>
__device__ __forceinline__ void tile_load(u32x4& k0, u32x4& k1, u32x4& v0, u32x4& v1, RowPtr rowptr, int w, int lane) {
    const u16 *kp, *vp, *kp2, *vp2;
    rowptr(lane, kp, vp2);
    rowptr(16 * w + (lane >> 2), kp2, vp);
    k0 = *(const u32x4*)(kp + w * 8);
    k1 = *(const u32x4*)(kp + (w + 4) * 8);
    v0 = *(const u32x4*)(vp + (lane & 3) * 8);
    v1 = *(const u32x4*)(vp + 32 + (lane & 3) * 8);
}
__device__ __forceinline__ void tile_store(const u32x4& k0, const u32x4& k1, const u32x4& v0, const u32x4& v1, unsigned char* buf, int w, int lane) {
    *(u32x4*)(buf + w * 1024 + lane * 16) = k0;
    *(u32x4*)(buf + (w + 4) * 1024 + lane * 16) = k1;
    *(u32x4*)(buf + 8192 + (16 * w + (lane >> 2)) * 64 + (lane & 3) * 16) = v0;
    *(u32x4*)(buf + 8192 + 4096 + (16 * w + (lane >> 2)) * 64 + (lane & 3) * 16) = v1;
}
__device__ __forceinline__ void qk_tile(const unsigned char* buf, const bf16x8 (&qr)[4], f32x16& s0, f32x16& s1, int lane) {
    const int r32 = lane & 31, hi = lane >> 5;
    lds_cptr kp = (lds_cptr)buf + hi * 1024 + r32 * 16;
#pragma unroll
    for (int i = 0; i < 16; ++i) { s0[i] = 0.f; s1[i] = 0.f; }
#pragma unroll
    for (int d0 = 0; d0 < 4; ++d0) {
        bf16x8 k0 = *(const __attribute__((address_space(3))) bf16x8*)(kp + d0 * 2048);
        bf16x8 k1 = *(const __attribute__((address_space(3))) bf16x8*)(kp + d0 * 2048 + 512);
        s0 = MFMA32(k0, qr[d0], s0);
        s1 = MFMA32(k1, qr[d0], s1);
    }
}
__device__ __forceinline__ bf16x8 pack8(const f32x16& p, int s) {
    u32 a = pack2(p[8 * s + 0], p[8 * s + 1]), b = pack2(p[8 * s + 2], p[8 * s + 3]);
    u32 c = pack2(p[8 * s + 4], p[8 * s + 5]), d = pack2(p[8 * s + 6], p[8 * s + 7]);
    u32x4 v = u32x4{a, b, c, d};
    return __builtin_bit_cast(bf16x8, v);
}
__device__ __forceinline__ void pv_tile(const unsigned char* buf, const f32x16& p0, const f32x16& p1, f32x16 (&o)[2], int lane) {
    const int hi = lane >> 5;
    lds_cptr vp = (lds_cptr)buf + 8192 + ((lane >> 4) & 1) * 32 + (lane & 3) * 8 + (4 * hi + ((lane & 15) >> 2)) * 64;
    bf16x8 pf[4];
    pf[0] = pack8(p0, 0);
    pf[1] = pack8(p0, 1);
    pf[2] = pack8(p1, 0);
    pf[3] = pack8(p1, 1);
#pragma unroll
    for (int i = 0; i < 8; ++i) {
        const int dh = i >> 2, ks = i & 3;
        s16x4 vlo = vtr(vp + dh * 4096 + ks * 1024);
        s16x4 vhi = vtr(vp + dh * 4096 + ks * 1024 + 512);
        bf16x8 vf = (bf16x8){vlo[0], vlo[1], vlo[2], vlo[3], vhi[0], vhi[1], vhi[2], vhi[3]};
        o[dh] = MFMA32(vf, pf[ks], o[dh]);
    }
}
template <bool BITS>
__device__ __forceinline__ void apply_mask(f32x16& s0, f32x16& s1, int lo, int hi_lim, u64 word, int hi) {
    const u32 wlo = (u32)(word >> (4 * hi)), whi = (u32)(word >> (32 + 4 * hi));
#pragma unroll
    for (int i = 0; i < 16; ++i) {
        const int kc = (i & 3) + 8 * (i >> 2);
        bool v0, v1;
        if (BITS) {
            v0 = (wlo >> kc) & 1u;
            v1 = (whi >> kc) & 1u;
        } else {
            const int kk = kc + 4 * hi;
            v0 = (kk >= lo) && (kk <= hi_lim);
            v1 = (kk + 32 >= lo) && (kk + 32 <= hi_lim);
        }
        s0[i] = v0 ? s0[i] : -1e30f;
        s1[i] = v1 ? s1[i] : -1e30f;
    }
}
__device__ __forceinline__ void softmax_step(f32x16& s0, f32x16& s1, float& m, float& l, f32x16 (&o)[2]) {
    float mx = -1e30f;
#pragma unroll
    for (int i = 0; i < 16; ++i) mx = fmaxf(mx, fmaxf(s0[i], s1[i]));
    mx = fmaxf(mx, swap32(mx));
    const float mn = fmaxf(m, mx);
    const float alpha = __builtin_amdgcn_exp2f(m - mn);
    float sum = 0.f;
#pragma unroll
    for (int i = 0; i < 16; ++i) {
        s0[i] = (s0[i] > -1e29f) ? __builtin_amdgcn_exp2f(s0[i] - mn) : 0.f;
        s1[i] = (s1[i] > -1e29f) ? __builtin_amdgcn_exp2f(s1[i] - mn) : 0.f;
        sum += s0[i] + s1[i];
    }
    sum += swap32(sum);
    l = l * alpha + sum;
    m = mn;
#pragma unroll
    for (int i = 0; i < 16; ++i) { o[0][i] *= alpha; o[1][i] *= alpha; }
}

template <int MODE, bool BITS, class Next, class RowPtr, class MaskFn, class Extra>
__device__ __forceinline__ void flash_run(int first, Next next, RowPtr rowptr, MaskFn maskfn, Extra extra, const bf16x8 (&qr)[4], float& m, float& l,
                                          f32x16 (&o)[2], unsigned char* bufs, int w, int lane) {
    if (first < 0) return;
    u32x4 tk0, tk1, tv0, tv1;
    int cur = first;
    tile_load(tk0, tk1, tv0, tv1, [&](int r, const u16*& kp, const u16*& vp) { rowptr(cur, r, kp, vp); }, w, lane);
    __syncthreads();
    tile_store(tk0, tk1, tv0, tv1, bufs, w, lane);
    __syncthreads();
    int pb = 0;
    while (cur >= 0) {
        const int nxt = next(cur);
        if (nxt >= 0) tile_load(tk0, tk1, tv0, tv1, [&](int r, const u16*& kp, const u16*& vp) { rowptr(nxt, r, kp, vp); }, w, lane);
        const unsigned char* buf = bufs + pb * 16384;
        f32x16 s0, s1;
        qk_tile(buf, qr, s0, s1, lane);
        int lo, hl;
        u64 word;
        maskfn(cur, lo, hl, word);
        apply_mask<BITS>(s0, s1, lo, hl, word, lane >> 5);
        if (MODE == 0) {
            softmax_step(s0, s1, m, l, o);
            pv_tile(buf, s0, s1, o, lane);
        } else if (MODE == 1) {
            f32x16 od[2];
            softmax_step(s0, s1, m, l, od);
        } else {
#pragma unroll
            for (int i = 0; i < 16; ++i) {
                s0[i] = (s0[i] > -1e29f) ? __builtin_amdgcn_exp2f(s0[i] - m) * l : 0.f;
                s1[i] = (s1[i] > -1e29f) ? __builtin_amdgcn_exp2f(s1[i] - m) * l : 0.f;
            }
            extra(cur, s0, s1);
            pv_tile(buf, s0, s1, o, lane);
        }
        if (nxt >= 0) tile_store(tk0, tk1, tv0, tv1, bufs + (pb ^ 1) * 16384, w, lane);
        __syncthreads();
        pb ^= 1;
        cur = nxt;
    }
}

__device__ __forceinline__ void nsa_unit(unsigned char* ws, int b, int g, int qt, unsigned char* smem) {
    const int tid = tidx(), lane = tid & 63, w = tid >> 6;
    const int r32 = lane & 31, hi = lane >> 5;
    const int q0 = qt * 32;
    const int tl = q0 + 8 * w + (r32 >> 2);
    const int rep = r32 & 3;
    const u16* proj = (const u16*)(ws + OFF_PROJ);
    const u16* brow = proj + (long)b * SEQ * IN_COLS;
    const u16* kcb = (const u16*)(ws + OFF_KCB) + (size_t)(b * 2 + g) * 256 * 64;
    const u16* vcb = (const u16*)(ws + OFF_VCB) + (size_t)(b * 2 + g) * 256 * 64;
    u16* ya = (u16*)(ws + OFF_YAB);
    unsigned char* bufs = smem;
    float* imp = (float*)(smem + 32768);
    u64* selm = (u64*)(smem + 32768 + 8192);
    const u16* trow = brow + (long)tl * IN_COLS;
    bf16x8 qr[4];
#pragma unroll
    for (int d0 = 0; d0 < 4; ++d0) qr[d0] = *(const bf16x8*)(trow + C_NQ + (g * 4 + rep) * 64 + d0 * 16 + hi * 8);
    const float gate_c = bf2f(trow[C_NG + 0 * 8 + g * 4 + rep]);
    const float gate_s = bf2f(trow[C_NG + 1 * 8 + g * 4 + rep]);
    const float gate_w = bf2f(trow[C_NG + 2 * 8 + g * 4 + rep]);
    for (int i = tid; i < 32 * 64; i += 256) imp[i] = 0.f;
    f32x16 tot[2];
#pragma unroll
    for (int i = 0; i < 16; ++i) { tot[0][i] = 0.f; tot[1][i] = 0.f; }

    const int nvalid = tl >= 31 ? ((tl - 31) >> 4) + 1 : 0;
    const int nv_max = (q0 + 31 >= 31) ? ((q0 + 31 - 31) >> 4) + 1 : 0;
    const int ntile_c = (nv_max + 63) >> 6;
    auto crows = [&](int tile, int r, const u16*& kp, const u16*& vp) {
        int n = tile * 64 + r;
        n = n < 254 ? n : 254;
        kp = kcb + (size_t)n * 64;
        vp = vcb + (size_t)n * 64;
    };
    auto cnext = [&](int c) { return (c + 1 < ntile_c) ? c + 1 : -1; };
    auto cmask = [&](int tile, int& lo, int& hl, u64& word) { lo = 0; hl = nvalid - 64 * tile - 1; word = 0; };
    {
        float m = -1e30f, l = 0.f;
        f32x16 o[2];
#pragma unroll
        for (int i = 0; i < 16; ++i) { o[0][i] = 0.f; o[1][i] = 0.f; }
        flash_run<1, false>(ntile_c > 0 ? 0 : -1, cnext, crows, cmask, [&](int, f32x16&, f32x16&) {}, qr, m, l, o, bufs, w, lane);
        float invl = l > 0.f ? 1.0f / l : 0.f;
        const int qloc = 8 * w + (r32 >> 2);
        flash_run<2, false>(ntile_c > 0 ? 0 : -1, cnext, crows, cmask,
                            [&](int tile, f32x16& p0, f32x16& p1) {
#pragma unroll
                                for (int a = 0; a < 4; ++a) {
                                    float g0 = p0[4 * a] + p0[4 * a + 1] + p0[4 * a + 2] + p0[4 * a + 3], e0 = p0[4 * a + 3];
                                    float g1 = p1[4 * a] + p1[4 * a + 1] + p1[4 * a + 2] + p1[4 * a + 3], e1 = p1[4 * a + 3];
                                    g0 += __shfl_xor(g0, 1); g0 += __shfl_xor(g0, 2);
                                    e0 += __shfl_xor(e0, 1); e0 += __shfl_xor(e0, 2);
                                    g1 += __shfl_xor(g1, 1); g1 += __shfl_xor(g1, 2);
                                    e1 += __shfl_xor(e1, 1); e1 += __shfl_xor(e1, 2);
                                    if (rep == 0) {
                                        int j0 = 16 * tile + 2 * a + hi, j1 = j0 + 8;
                                        atomicAdd(&imp[qloc * 64 + j0], g0);
                                        if (j0 + 1 < 64) atomicAdd(&imp[qloc * 64 + j0 + 1], e0);
                                        if (j1 < 64) atomicAdd(&imp[qloc * 64 + j1], g1);
                                        if (j1 + 1 < 64) atomicAdd(&imp[qloc * 64 + j1 + 1], e1);
                                    }
                                }
                            },
                            qr, m, invl, o, bufs, w, lane);
#pragma unroll
        for (int i = 0; i < 16; ++i) { tot[0][i] += gate_c * o[0][i]; tot[1][i] += gate_c * o[1][i]; }
    }
    __syncthreads();
    for (int qq = 0; qq < 8; ++qq) {
        const int qi = 8 * w + qq;
        const int tq = q0 + qi;
        const int cur = tq >> 6;
        const int j = lane;
        float v = imp[qi * 64 + j];
        if (j == 0 || j == cur || j == cur - 1) v = __builtin_inff();
        if (j > cur) v = -__builtin_inff();
        int rank = 0;
        for (int jp = 0; jp < 64; ++jp) {
            float vj = __shfl(v, jp);
            rank += (vj > v || (vj == v && jp < j)) ? 1 : 0;
        }
        u64 sm = __ballot(rank < 16 && j <= cur);
        if (lane == 0) selm[qi] = sm;
    }
    __syncthreads();
    const u64 mymask = selm[8 * w + (r32 >> 2)];
    u64 unionm = 0;
    for (int i = 0; i < 32; ++i) unionm |= selm[i];
    unionm = __builtin_amdgcn_readfirstlane((u32)unionm) | ((u64)__builtin_amdgcn_readfirstlane((u32)(unionm >> 32)) << 32);
    {
        float m = -1e30f, l = 0.f;
        f32x16 o[2];
#pragma unroll
        for (int i = 0; i < 16; ++i) { o[0][i] = 0.f; o[1][i] = 0.f; }
        auto snext = [&](int c) {
            u64 rest = (c >= 63) ? 0ull : (unionm >> (c + 1));
            return rest ? (c + 1 + (__ffsll((long long)rest) - 1)) : -1;
        };
        const int first = unionm ? (__ffsll((long long)unionm) - 1) : -1;
        flash_run<0, false>(first, snext,
                            [&](int j, int r, const u16*& kp, const u16*& vp) {
                                const u16* rp = brow + (long)(64 * j + r) * IN_COLS + C_NKV;
                                kp = rp + (2 * 2 + g) * 64;
                                vp = rp + (3 * 2 + g) * 64;
                            },
                            [&](int j, int& lo, int& hl, u64& word) { lo = 0; hl = ((mymask >> j) & 1ull) ? (tl - 64 * j) : -1; word = 0; },
                            [&](int, f32x16&, f32x16&) {}, qr, m, l, o, bufs, w, lane);
        const float sc = l > 0.f ? gate_s / l : 0.f;
#pragma unroll
        for (int i = 0; i < 16; ++i) { tot[0][i] += sc * o[0][i]; tot[1][i] += sc * o[1][i]; }
    }
    {
        float m = -1e30f, l = 0.f;
        f32x16 o[2];
#pragma unroll
        for (int i = 0; i < 16; ++i) { o[0][i] = 0.f; o[1][i] = 0.f; }
        const int jfirst = (q0 - 511) > 0 ? ((q0 - 511) >> 6) : 0;
        const int jlast = (q0 + 31) >> 6;
        flash_run<0, false>(jfirst, [&](int c) { return c + 1 <= jlast ? c + 1 : -1; },
                            [&](int j, int r, const u16*& kp, const u16*& vp) {
                                const u16* rp = brow + (long)(64 * j + r) * IN_COLS + C_NKV;
                                kp = rp + (4 * 2 + g) * 64;
                                vp = rp + (5 * 2 + g) * 64;
                            },
                            [&](int j, int& lo, int& hl, u64& word) { lo = tl - 511 - 64 * j; hl = tl - 64 * j; word = 0; },
                            [&](int, f32x16&, f32x16&) {}, qr, m, l, o, bufs, w, lane);
        const float sc = l > 0.f ? gate_w / l : 0.f;
#pragma unroll
        for (int i = 0; i < 16; ++i) { tot[0][i] += sc * o[0][i]; tot[1][i] += sc * o[1][i]; }
    }
    {
        u16* orow = ya + ((long)b * SEQ + tl) * 512 + (g * 4 + rep) * 64;
#pragma unroll
        for (int dh = 0; dh < 2; ++dh)
#pragma unroll
            for (int a = 0; a < 4; ++a) {
                uint2 v = uint2{pack2(tot[dh][4 * a], tot[dh][4 * a + 1]), pack2(tot[dh][4 * a + 2], tot[dh][4 * a + 3])};
                *(uint2*)(orow + dh * 32 + 8 * a + 4 * hi) = v;
            }
    }
}

__device__ __forceinline__ void dsa_select_unit(unsigned char* ws, int unit, unsigned char* smem) {
    const int tid = tidx(), lane = tid & 63, w = tid >> 6;
    const int t0 = unit * 4;
    const int b = t0 / SEQ, tl0 = t0 - b * SEQ;
    const u16* proj = (const u16*)(ws + OFF_PROJ);
    const u16* brow = proj + (long)b * SEQ * IN_COLS;
    u64* bits = (u64*)(ws + OFF_BITS);
    float* sc = (float*)smem;
    __syncthreads();
    {
        const int r = lane & 31, half = lane >> 5;
        const int q = r >> 3, h = r & 7;
        bf16x8 af[4];
#pragma unroll
        for (int ks = 0; ks < 4; ++ks) af[ks] = *(const bf16x8*)(proj + (long)(t0 + q) * IN_COLS + C_IQ + h * 64 + ks * 16 + half * 8);
        float wq[4][4];
#pragma unroll
        for (int qq = 0; qq < 4; ++qq)
#pragma unroll
            for (int i = 0; i < 4; ++i) wq[qq][i] = bf2f(proj[(long)(t0 + qq) * IN_COLS + C_IW + i + 4 * half]) * 0.35355339059327373f;
        const int ntiles = (tl0 + 4 + 31) >> 5;
        bf16x8 bfr[4];
        if (w < ntiles) {
#pragma unroll
            for (int ks = 0; ks < 4; ++ks) bfr[ks] = *(const bf16x8*)(brow + (long)(w * 32 + r) * IN_COLS + C_IK + ks * 16 + half * 8);
        }
        for (int tile = w; tile < ntiles; tile += 4) {
            int key = tile * 32 + r;
            bf16x8 bcur[4];
#pragma unroll
            for (int ks = 0; ks < 4; ++ks) bcur[ks] = bfr[ks];
            if (tile + 4 < ntiles) {
#pragma unroll
                for (int ks = 0; ks < 4; ++ks) bfr[ks] = *(const bf16x8*)(brow + (long)(key + 128) * IN_COLS + C_IK + ks * 16 + half * 8);
            }
            f32x16 acc;
#pragma unroll
            for (int i = 0; i < 16; ++i) acc[i] = 0.f;
#pragma unroll
            for (int ks = 0; ks < 4; ++ks) acc = MFMA32(af[ks], bcur[ks], acc);
            float totq[4];
#pragma unroll
            for (int qq = 0; qq < 4; ++qq) {
                float part = 0.f;
#pragma unroll
                for (int i = 0; i < 4; ++i) part += wq[qq][i] * fmaxf(acc[4 * qq + i], 0.f);
                totq[qq] = part + __shfl_xor(part, 32);
            }
            if (half == 0) {
                sc[0 * 4096 + key] = totq[0];
                sc[1 * 4096 + key] = totq[1];
            } else {
                sc[2 * 4096 + key] = totq[2];
                sc[3 * 4096 + key] = totq[3];
            }
        }
    }
    __syncthreads();
    const int t = t0 + w;
    const int tl = tl0 + w;
    const int nvalid = tl + 1;
    {
        u32 u[64];
        const float* scq = sc + w * 4096;
#pragma unroll
        for (int j = 0; j < 64; ++j) {
            int key = j * 64 + lane;
            u32 v = 0;
            if (key <= tl) {
                u32 bb = __float_as_uint(scq[key]);
                v = bb ^ ((bb >> 31) ? 0xFFFFFFFFu : 0x80000000u);
            }
            u[j] = v;
        }
        u32 K = 0;
        int need = 0;
        if (nvalid > 256) {
            for (int bit = 31; bit >= 0; --bit) {
                u32 cand = K | (1u << bit);
                int cnt = 0;
#pragma unroll
                for (int j = 0; j < 64; ++j) cnt += (u[j] >= cand) ? 1 : 0;
                cnt = wsumi(cnt);
                if (cnt >= 256) K = cand;
            }
            int cgt = 0;
#pragma unroll
            for (int j = 0; j < 64; ++j) cgt += (u[j] > K) ? 1 : 0;
            cgt = wsumi(cgt);
            need = 256 - cgt;
        }
        const u64 ltmask = (1ull << lane) - 1ull;
        int ebase = 0;
        u64 myword = 0;
#pragma unroll
        for (int j = 0; j < 64; ++j) {
            bool eq = (nvalid > 256) && (u[j] == K);
            u64 em = __ballot(eq);
            int erank = ebase + __popcll(em & ltmask);
            bool take = (u[j] > K) || (eq && erank < need);
            ebase += __popcll(em);
            u64 sm = __ballot(take);
            if (lane == j) myword = sm;
        }
        bits[(long)t * 64 + lane] = myword;
    }
}

__device__ __forceinline__ void dsa_attn_unit(unsigned char* ws, int b, int qt, unsigned char* smem) {
    const int tid = tidx(), lane = tid & 63, w = tid >> 6;
    const int r32 = lane & 31, hi = lane >> 5;
    const int q0 = qt * 16;
    const int qloc = 4 * w + (r32 >> 3);
    const int tl = q0 + qloc;
    const int head = r32 & 7;
    const u16* proj = (const u16*)(ws + OFF_PROJ);
    const u16* brow = proj + (long)b * SEQ * IN_COLS;
    const u64* bits = (const u64*)(ws + OFF_BITS) + ((long)b * SEQ + q0) * 64;
    u16* yb = (u16*)(ws + OFF_YAB) + (size_t)NTOK * 512;
    unsigned char* bufs = smem;
    u64* lbits = (u64*)(smem + 32768);
    __syncthreads();
    for (int i = tid; i < 16 * 64; i += 256) lbits[i] = bits[i];
    const u16* trow = brow + (long)tl * IN_COLS;
    bf16x8 qr[4];
#pragma unroll
    for (int d0 = 0; d0 < 4; ++d0) qr[d0] = *(const bf16x8*)(trow + C_DQ + head * 64 + d0 * 16 + hi * 8);
    float m = -1e30f, l = 0.f;
    f32x16 o[2];
#pragma unroll
    for (int i = 0; i < 16; ++i) { o[0][i] = 0.f; o[1][i] = 0.f; }
    const int jlast = (q0 + 15) >> 6;
    flash_run<0, true>(0, [&](int c) { return c + 1 <= jlast ? c + 1 : -1; },
                       [&](int j, int r, const u16*& kp, const u16*& vp) {
                           const u16* rp = brow + (long)(64 * j + r) * IN_COLS + C_DKV;
                           kp = rp;
                           vp = rp + 64;
                       },
                       [&](int j, int& lo, int& hl, u64& word) { lo = 0; hl = 0; word = lbits[qloc * 64 + j]; },
                       [&](int, f32x16&, f32x16&) {}, qr, m, l, o, bufs, w, lane);
    const float inv = l > 0.f ? 1.0f / l : 0.f;
    u16* orow = yb + ((long)b * SEQ + tl) * 512 + head * 64;
#pragma unroll
    for (int dh = 0; dh < 2; ++dh)
#pragma unroll
        for (int a = 0; a < 4; ++a) {
            uint2 v = uint2{pack2(o[dh][4 * a] * inv, o[dh][4 * a + 1] * inv), pack2(o[dh][4 * a + 2] * inv, o[dh][4 * a + 3] * inv)};
            *(uint2*)(orow + dh * 32 + 8 * a + 4 * hi) = v;
        }
}

__device__ __forceinline__ void peer_route(unsigned char* ws, int layer, unsigned char* smem) {
    const int tid = tidx(), lane = tid & 63, w = tid >> 6;
    const u16* pq = (const u16*)(ws + OFF_PQ);
    const u16* skb = (const u16*)(ws + OFF_W + layer * W_LAYER + WO_SK);
    int* eidx = (int*)(ws + OFF_EIDX);
    float* gate = (float*)(ws + OFF_GATE);
    float* scw = (float*)(smem + w * 12288);
    float* tv = (float*)(smem + w * 12288 + 8192);
    int* ti = (int*)(smem + w * 12288 + 8192 + 2048);
    int pa = 0, pb = lane;
    while (pa < 16 && pb >= 16 / (pa + 1)) { pb -= 16 / (pa + 1); pa++; }
    const bool pvalid = pa < 16;
    const int nunits = NTOK / 16;
    for (int unit = bidx() * 4 + w; unit < nunits; unit += gdim() * 4) {
        const int tok0 = unit * 16;
        for (int h = 0; h < 8; ++h) {
            for (int half = 0; half < 2; ++half) {
                bf16x8 af[4];
#pragma unroll
                for (int ks = 0; ks < 4; ++ks)
                    af[ks] = *(const bf16x8*)(pq + (long)(tok0 + (lane & 15)) * 2048 + h * 256 + half * 128 + ks * 32 + (lane >> 4) * 8);
#pragma unroll
                for (int nt = 0; nt < 8; ++nt) {
                    f32x4 acc = f32x4{0.f, 0.f, 0.f, 0.f};
#pragma unroll
                    for (int ks = 0; ks < 4; ++ks) {
                        bf16x8 bfr = *(const bf16x8*)(skb + (size_t)half * 128 * 128 + (size_t)(nt * 16 + (lane & 15)) * 128 + ks * 32 + (lane >> 4) * 8);
                        acc = __builtin_amdgcn_mfma_f32_16x16x32_bf16(af[ks], bfr, acc, 0, 0, 0);
                    }
#pragma unroll
                    for (int i = 0; i < 4; ++i) scw[((lane >> 4) * 4 + i) * 128 + nt * 16 + (lane & 15)] = acc[i];
                }
                WAVE_SYNC();
                for (int tok = 0; tok < 16; ++tok) {
                    const float* sr = scw + tok * 128;
                    float s0 = sr[lane], s1 = sr[lane + 64];
                    int r0 = 0, r1 = 0;
#pragma unroll 8
                    for (int j4 = 0; j4 < 32; ++j4) {
                        float4 v = *(const float4*)(sr + j4 * 4);
                        float vv[4] = {v.x, v.y, v.z, v.w};
#pragma unroll
                        for (int e = 0; e < 4; ++e) {
                            int j = j4 * 4 + e;
                            r0 += (vv[e] > s0 || (vv[e] == s0 && j < lane)) ? 1 : 0;
                            r1 += (vv[e] > s1 || (vv[e] == s1 && j < lane + 64)) ? 1 : 0;
                        }
                    }
                    if (r0 < 16) { tv[(half * 16 + tok) * 16 + r0] = s0; ti[(half * 16 + tok) * 16 + r0] = lane; }
                    if (r1 < 16) { tv[(half * 16 + tok) * 16 + r1] = s1; ti[(half * 16 + tok) * 16 + r1] = lane + 64; }
                }
                WAVE_SYNC();
            }
            for (int tok = 0; tok < 16; ++tok) {
                float c = -__builtin_inff();
                int pos = 1 << 20, eid = 0;
                if (pvalid) {
                    c = tv[(0 * 16 + tok) * 16 + pa] + tv[(1 * 16 + tok) * 16 + pb];
                    pos = pa * 16 + pb;
                    eid = ti[(0 * 16 + tok) * 16 + pa] * 128 + ti[(1 * 16 + tok) * 16 + pb];
                }
                int rank = 0;
                for (int pp = 0; pp < 50; ++pp) {
                    float cj = __shfl(c, pp);
                    int pj = __shfl(pos, pp);
                    rank += (cj > c || (cj == c && pj < pos)) ? 1 : 0;
                }
                bool sel = pvalid && rank < 16;
                float mx = wmax(sel ? c : -__builtin_inff());
                float ex = sel ? __expf(c - mx) : 0.f;
                float sm = wsum(ex);
                if (sel) {
                    long o = (long)(tok0 + tok) * 128 + h * 16 + rank;
                    eidx[o] = eid;
                    gate[o] = ex / sm;
                }
            }
            WAVE_SYNC();
        }
    }
}

__device__ __forceinline__ void peer_experts(unsigned char* ws, float* xout) {
    const int lane = tidx() & 63, w = tidx() >> 6;
    const u16* hbuf = (const u16*)(ws + OFF_H);
    const u16* ub = (const u16*)(ws + OFF_UB);
    const u16* vb = (const u16*)(ws + OFF_VB);
    const int* eidx = (const int*)(ws + OFF_EIDX);
    const float* gate = (const float*)(ws + OFF_GATE);
    for (int t = bidx() * 4 + w; t < NTOK; t += gdim() * 4) {
        uint4 h0 = *(const uint4*)(hbuf + (long)t * 1024 + lane * 8);
        uint4 h1 = *(const uint4*)(hbuf + (long)t * 1024 + 512 + lane * 8);
        float acc[16];
#pragma unroll
        for (int i = 0; i < 16; ++i) acc[i] = 0.f;
        for (int e0 = 0; e0 < 128; e0 += 4) {
            int id[4];
            float gg[4];
            uint4 u0[4], u1[4], v0[4], v1[4];
#pragma unroll
            for (int k = 0; k < 4; ++k) {
                id[k] = __builtin_amdgcn_readfirstlane(eidx[(long)t * 128 + e0 + k]);
                gg[k] = gate[(long)t * 128 + e0 + k];
                const u16* ur = ub + (long)id[k] * 1024;
                const u16* vr = vb + (long)id[k] * 1024;
                u0[k] = *(const uint4*)(ur + lane * 8);
                u1[k] = *(const uint4*)(ur + 512 + lane * 8);
                v0[k] = *(const uint4*)(vr + lane * 8);
                v1[k] = *(const uint4*)(vr + 512 + lane * 8);
            }
#pragma unroll
            for (int k = 0; k < 4; ++k) {
                float d = 0.f;
                d = dot2(u0[k].x, h0.x, d); d = dot2(u0[k].y, h0.y, d); d = dot2(u0[k].z, h0.z, d); d = dot2(u0[k].w, h0.w, d);
                d = dot2(u1[k].x, h1.x, d); d = dot2(u1[k].y, h1.y, d); d = dot2(u1[k].z, h1.z, d); d = dot2(u1[k].w, h1.w, d);
                d = wsum(d);
                float a = gelu_tanh(d) * gg[k];
                acc[0] += a * bf_lo(v0[k].x); acc[1] += a * bf_hi(v0[k].x);
                acc[2] += a * bf_lo(v0[k].y); acc[3] += a * bf_hi(v0[k].y);
                acc[4] += a * bf_lo(v0[k].z); acc[5] += a * bf_hi(v0[k].z);
                acc[6] += a * bf_lo(v0[k].w); acc[7] += a * bf_hi(v0[k].w);
                acc[8] += a * bf_lo(v1[k].x); acc[9] += a * bf_hi(v1[k].x);
                acc[10] += a * bf_lo(v1[k].y); acc[11] += a * bf_hi(v1[k].y);
                acc[12] += a * bf_lo(v1[k].z); acc[13] += a * bf_hi(v1[k].z);
                acc[14] += a * bf_lo(v1[k].w); acc[15] += a * bf_hi(v1[k].w);
            }
        }
        float* xr = xout + (long)t * 1024;
        float4 a0 = *(float4*)(xr + lane * 8), a1 = *(float4*)(xr + lane * 8 + 4);
        float4 b0 = *(float4*)(xr + 512 + lane * 8), b1 = *(float4*)(xr + 512 + lane * 8 + 4);
        a0.x += acc[0]; a0.y += acc[1]; a0.z += acc[2]; a0.w += acc[3];
        a1.x += acc[4]; a1.y += acc[5]; a1.z += acc[6]; a1.w += acc[7];
        b0.x += acc[8]; b0.y += acc[9]; b0.z += acc[10]; b0.w += acc[11];
        b1.x += acc[12]; b1.y += acc[13]; b1.z += acc[14]; b1.w += acc[15];
        *(float4*)(xr + lane * 8) = a0;
        *(float4*)(xr + lane * 8 + 4) = a1;
        *(float4*)(xr + 512 + lane * 8) = b0;
        *(float4*)(xr + 512 + lane * 8 + 4) = b1;
    }
}

__device__ __forceinline__ void phase_prep(const Params& P, unsigned char* smem) {
    unsigned char* ws = opq(P.ws);
    const long gtid = (long)bidx() * 256 + tidx();
    const long gthreads = (long)gdim() * 256;
    for (int l = 0; l < 2; ++l) {
        unsigned char* wl = ws + OFF_W + l * W_LAYER;
        float* tile = (float*)smem;
        transpose_cvt(P.w_in + (size_t)l * 1024 * IN_COLS, (u16*)(wl + WO_WIN), 1024, IN_COLS, tile);
        for (int c = 0; c < 2; ++c) {
            transpose_cvt(P.cmp_w1 + ((size_t)l * 2 + c) * 2048 * 256, (u16*)(wl + WO_W1) + (size_t)c * 256 * 2048, 2048, 256, tile);
            transpose_cvt(P.cmp_w2 + ((size_t)l * 2 + c) * 256 * 64, (u16*)(wl + WO_W2) + (size_t)c * 64 * 256, 256, 64, tile);
        }
        transpose_cvt(P.w_a + (size_t)l * 512 * 1024, (u16*)(wl + WO_WA), 512, 1024, tile);
        transpose_cvt(P.w_b + (size_t)l * 512 * 1024, (u16*)(wl + WO_WB), 512, 1024, tile);
        transpose_cvt(P.w_out + (size_t)l * 1024 * 1024, (u16*)(wl + WO_WO), 1024, 1024, tile);
        transpose_cvt(P.peer_wq + (size_t)l * 1024 * 2048, (u16*)(wl + WO_WQ), 1024, 2048, tile);
        transpose_cvt(P.ple_w + (size_t)l * 256 * 1024, (u16*)(wl + WO_PW), 256, 1024, tile);
        transpose_cvt(P.ple_gw + (size_t)l * 1024 * 1024, (u16*)(wl + WO_PG), 1024, 1024, tile);
        cvt_f32_bf16(P.peer_sk + (size_t)l * 2 * 128 * 128, (u16*)(wl + WO_SK), 2 * 128 * 128);
        if (gtid < 512) {
            int c = (int)gtid >> 8, col = (int)gtid & 255;
            const float* pos = P.cmp_pos + ((size_t)l * 2 + c) * 2048;
            const float* w1 = P.cmp_w1 + ((size_t)l * 2 + c) * 2048 * 256;
            float s = 0.f;
            for (int k = 0; k < 2048; ++k) s += pos[k] * w1[(size_t)k * 256 + col];
            ((float*)(wl + WO_CB))[c * 256 + col] = s;
        }
    }
    {
        float* ropec = (float*)(ws + OFF_ROPE);
        float* ropes = ropec + (size_t)NTOK * 8;
        for (long i = gtid; i < (long)NTOK * 8; i += gthreads) {
            int t = (int)(i >> 3), k = (int)(i & 7);
            double inv = pow(500000.0, -(double)k / 8.0);
            double ang = (double)P.positions[t] * inv;
            ropec[i] = (float)cos(ang);
            ropes[i] = (float)sin(ang);
        }
    }
    rms_rows(P.x, P.attn_norm, (u16*)(ws + OFF_H), nullptr, nullptr);
}

__device__ __forceinline__ void phase_g1(const Params& P, int layer, unsigned char* smem) {
    unsigned char* ws = opq(P.ws);
    u16* proj = (u16*)(ws + OFF_PROJ);
    gemm_phase<0>((const u16*)(ws + OFF_H), 1024, (const u16*)(ws + OFF_W + layer * W_LAYER + WO_WIN), 1024, NTOK, IN_COLS, 1024, (u16*)smem,
                  [=](int row, int col, float v) { proj[(long)row * IN_COLS + col] = f2bf(v); });
}

__device__ __forceinline__ void phase_c1(const Params& P, int layer, unsigned char* smem) {
    unsigned char* ws = opq(P.ws);
    unsigned char* wl = ws + OFF_W + layer * W_LAYER;
    const u16* proj = (const u16*)(ws + OFF_PROJ);
    u16* chid = (u16*)(ws + OFF_CHID);
    const float* cbias = (const float*)(wl + WO_CB);
    for (int c = 0; c < 2; ++c) {
        u16* ch = chid + (size_t)c * CROWS * 256;
        const float* cb = cbias + c * 256;
        gemm_phase<1>(proj + C_NKV + c * 128, 0, (const u16*)(wl + WO_W1) + (size_t)c * 256 * 2048, 2048, CROWS, 256, 2048, (u16*)smem,
                      [=](int row, int col, float v) { ch[(long)row * 256 + col] = f2bf(gelu_tanh(v + cb[col])); });
    }
}

__device__ __forceinline__ void phase_c2(const Params& P, int layer, unsigned char* smem) {
    unsigned char* ws = opq(P.ws);
    unsigned char* wl = ws + OFF_W + layer * W_LAYER;
    const u16* chid = (const u16*)(ws + OFF_CHID);
    float* cbuf = (float*)(ws + OFF_CBUF);
    for (int c = 0; c < 2; ++c) {
        float* cbo = cbuf + (size_t)c * CROWS * 64;
        gemm_phase<0>(chid + (size_t)c * CROWS * 256, 256, (const u16*)(wl + WO_W2) + (size_t)c * 64 * 256, 256, CROWS, 64, 256, (u16*)smem,
                      [=](int row, int col, float v) { cbo[(long)row * 64 + col] = v; });
    }
}

__device__ __forceinline__ void phase_c3(const Params& P, int layer) {
    unsigned char* ws = opq(P.ws);
    const int lane = tidx() & 63, w = tidx() >> 6;
    const float* cbuf = (const float*)(ws + OFF_CBUF);
    u16* kcb = (u16*)(ws + OFF_KCB);
    u16* vcb = (u16*)(ws + OFF_VCB);
    const float* ropec = (const float*)(ws + OFF_ROPE);
    const float* ropes = ropec + (size_t)NTOK * 8;
    const float* gain = P.nsa_gain + layer * 256 + 64;
    for (int r = bidx() * 4 + w; r < 2 * CROWS; r += gdim() * 4) {
        int c = r / CROWS, rr = r - c * CROWS;
        int b = rr / (NCMP * 2);
        int rem = rr - b * (NCMP * 2);
        int n = rem >> 1, g = rem & 1;
        float v = cbuf[(size_t)r * 64 + lane];
        size_t o = ((size_t)(b * 2 + g) * 256 + n) * 64 + lane;
        if (c == 0) {
            float ss = wsum(v * v);
            v = v * rsqrtf(ss * (1.0f / 64.0f) + EPS) * gain[lane];
            float pv = __shfl_xor(v, 8);
            if (lane < 16) {
                long tt = (long)b * SEQ + 31 + 16 * n;
                float cs = ropec[tt * 8 + (lane & 7)], sn = ropes[tt * 8 + (lane & 7)];
                v = (lane < 8) ? (v * cs - pv * sn) : (v * cs + pv * sn);
            }
            kcb[o] = f2bf(v);
        } else {
            vcb[o] = f2bf(v);
        }
    }
}

__device__ __forceinline__ int balance4(int x, int seg) {
    const int k = x / seg, r = x - k * seg;
    return k == 0 ? r : (k == 1 ? 4 * seg - 1 - r : (k == 2 ? seg + r : 3 * seg - 1 - r));
}
__device__ __forceinline__ void phase_att_a(const Params& P, unsigned char* smem) {
    unsigned char* ws = opq(P.ws);
    for (int u = bidx(); u < NTOK / 4; u += gdim()) dsa_select_unit(ws, u, smem);
}
__device__ __forceinline__ void phase_att_b(const Params& P, unsigned char* smem) {
    {
        unsigned char* ws = opq(P.ws);
        for (int u = bidx(); u < 2048; u += gdim()) dsa_attn_unit(ws, u & 7, balance4(u >> 3, 64), smem);
    }
    {
        unsigned char* ws = opq(P.ws);
        for (int u = bidx(); u < 2048; u += gdim()) nsa_unit(ws, (u & 15) >> 1, u & 1, balance4(u >> 4, 32), smem);
    }
}

__device__ __forceinline__ void phase_merge(const Params& P, int layer, unsigned char* smem) {
    unsigned char* ws = opq(P.ws);
    unsigned char* wl = ws + OFF_W + layer * W_LAYER;
    const u16* proj = (const u16*)(ws + OFF_PROJ);
    u16* hbuf = (u16*)(ws + OFF_H);
    const u16* ya = (const u16*)(ws + OFF_YAB);
    const u16* yb = ya + (size_t)NTOK * 512;
    gemm_phase<0>(ya, 512, (const u16*)(wl + WO_WA), 512, NTOK, 1024, 512, (u16*)smem, [=](int row, int col, float v) {
        float ga = bf2f(proj[(long)row * IN_COLS + C_MG + col]);
        hbuf[(long)row * 1024 + col] = f2bf(ga * v);
    });
    gemm_phase<0>(yb, 512, (const u16*)(wl + WO_WB), 512, NTOK, 1024, 512, (u16*)smem, [=](int row, int col, float v) {
        float gb = bf2f(proj[(long)row * IN_COLS + C_MG + 1024 + col]);
        long o = (long)row * 1024 + col;
        hbuf[o] = f2bf(bf2f(hbuf[o]) + gb * v);
    });
}

__device__ __forceinline__ void phase_outproj(const Params& P, int layer, unsigned char* smem) {
    unsigned char* ws = opq(P.ws);
    unsigned char* wl = ws + OFF_W + layer * W_LAYER;
    float* out = opq(P.out);
    const float* xin = (layer == 0) ? P.x : (const float*)out;
    gemm_phase<0>((const u16*)(ws + OFF_H), 1024, (const u16*)(wl + WO_WO), 1024, NTOK, 1024, 1024, (u16*)smem, [=](int row, int col, float v) {
        long o = (long)row * 1024 + col;
        out[o] = xin[o] + v;
    });
    cvt_f32_bf16(P.peer_u + (size_t)layer * NEXP * 1024, (u16*)(ws + OFF_UB), (long)NEXP * 1024);
    cvt_f32_bf16(P.peer_v + (size_t)layer * NEXP * 1024, (u16*)(ws + OFF_VB), (long)NEXP * 1024);
}

__device__ __forceinline__ void phase_pq(const Params& P, int layer, unsigned char* smem) {
    unsigned char* ws = opq(P.ws);
    unsigned char* wl = ws + OFF_W + layer * W_LAYER;
    u16* pq = (u16*)(ws + OFF_PQ);
    u16* eb = (u16*)(ws + OFF_YAB);
    gemm_phase<0>((const u16*)(ws + OFF_H), 1024, (const u16*)(wl + WO_WQ), 1024, NTOK, 2048, 1024, (u16*)smem,
                  [=](int row, int col, float v) { pq[(long)row * 2048 + col] = f2bf(v); });
    gemm_phase<2>(P.p + (size_t)layer * NTOK * 256, 256, (const u16*)(wl + WO_PW), 256, NTOK, 1024, 256, (u16*)smem,
                  [=](int row, int col, float v) { eb[(long)row * 1024 + col] = f2bf(v); });
}

__device__ __forceinline__ void phase_final(const Params& P, int layer, unsigned char* smem) {
    unsigned char* ws = opq(P.ws);
    unsigned char* wl = ws + OFF_W + layer * W_LAYER;
    float* out = opq(P.out);
    const u16* eb = (const u16*)(ws + OFF_YAB);
    const float* rstde = (const float*)(ws + OFF_RSTDE);
    const float* pn = P.ple_norm + layer * 1024;
    gemm_phase<0>((const u16*)(ws + OFF_H), 1024, (const u16*)(wl + WO_PG), 1024, NTOK, 1024, 1024, (u16*)smem, [=](int row, int col, float v) {
        long o = (long)row * 1024 + col;
        out[o] = out[o] + sigmoidf(v) * (bf2f(eb[o]) * rstde[row] * pn[col]);
    });
}

#ifndef PROBE_MASK
#define PROBE_MASK 0ull
#endif
#ifndef PROBE_MULT
#define PROBE_MULT 4
#endif
#define GSYNC(id)                                                                          \
    do {                                                                                   \
        grid.sync();                                                                       \
        if (PROBE_MASK != 0ull) {                                                          \
            unsigned long long now_ = __builtin_amdgcn_s_memrealtime();                    \
            if ((PROBE_MASK >> (id)) & 1ull) tsel += now_ - tprev;                         \
            tprev = now_;                                                                  \
        }                                                                                  \
    } while (0)

__global__ void __launch_bounds__(256, 2) fwd_kernel(Params P) {
    cg::grid_group grid = cg::this_grid();
    extern __shared__ __attribute__((aligned(16))) unsigned char smem[];
    unsigned long long tprev = 0, tsel = 0;
    if (PROBE_MASK != 0ull) tprev = __builtin_amdgcn_s_memrealtime();
    phase_prep(P, smem);
    GSYNC(0);
    for (int layer = 0; layer < 2; ++layer) {
        const int pb = 1 + 16 * layer;
        phase_g1(P, layer, smem);
        GSYNC(pb + 0);
        post_proj(opq(P.ws), P.nsa_gain + layer * 256, P.dsa_gain + layer * 128, smem);
        GSYNC(pb + 1);
        phase_c1(P, layer, smem);
        GSYNC(pb + 2);
        phase_c2(P, layer, smem);
        GSYNC(pb + 3);
        phase_c3(P, layer);
        GSYNC(pb + 4);
        phase_att_a(P, smem);
        GSYNC(pb + 15);
        phase_att_b(P, smem);
        GSYNC(pb + 5);
        phase_merge(P, layer, smem);
        GSYNC(pb + 6);
        phase_outproj(P, layer, smem);
        GSYNC(pb + 7);
        {
            unsigned char* ws = opq(P.ws);
            rms_rows(opq(P.out), P.ffn_norm + layer * 1024, (u16*)(ws + OFF_H), nullptr, nullptr);
        }
        GSYNC(pb + 8);
        phase_pq(P, layer, smem);
        GSYNC(pb + 9);
        peer_route(opq(P.ws), layer, smem);
        GSYNC(pb + 10);
        peer_experts(opq(P.ws), opq(P.out));
        GSYNC(pb + 11);
        {
            unsigned char* ws = opq(P.ws);
            rms_rows(opq(P.out), nullptr, (u16*)(ws + OFF_H), (const u16*)(ws + OFF_YAB), (float*)(ws + OFF_RSTDE));
        }
        GSYNC(pb + 12);
        phase_final(P, layer, smem);
        GSYNC(pb + 13);
        if (layer == 0) {
            unsigned char* ws = opq(P.ws);
            rms_rows(opq(P.out), P.attn_norm + 1024, (u16*)(ws + OFF_H), nullptr, nullptr);
            GSYNC(pb + 14);
        }
    }
    if (PROBE_MASK != 0ull) {
        if (blockIdx.x == 0 && threadIdx.x == 0) {
            unsigned long long t0 = __builtin_amdgcn_s_memrealtime();
            while (__builtin_amdgcn_s_memrealtime() - t0 < (unsigned long long)PROBE_MULT * tsel) __builtin_amdgcn_s_sleep(32);
        }
    }
}

extern "C" void kernel_launch(void* const* d_in, const int* in_sizes, int n_in, void* d_out, int out_size, void* d_ws, size_t ws_size,
                              hipStream_t stream) {
    static int grid_blocks = 0;
    if (!grid_blocks) {
        int dev = 0, cus = 0, per_cu = 0;
        (void)hipGetDevice(&dev);
        (void)hipDeviceGetAttribute(&cus, hipDeviceAttributeMultiprocessorCount, dev);
        (void)hipFuncSetAttribute((const void*)fwd_kernel, hipFuncAttributeMaxDynamicSharedMemorySize, LDS_BYTES);
        (void)hipOccupancyMaxActiveBlocksPerMultiprocessor(&per_cu, fwd_kernel, 256, LDS_BYTES);
        if (per_cu > 2) per_cu = 2;
        if (per_cu < 1) per_cu = 1;
        grid_blocks = cus * per_cu;
        if (ws_size < WS_END) fprintf(stderr, "kernel_launch: workspace too small: %zu < %zu\n", ws_size, (size_t)WS_END);
    }
    Params P{};
    P.x = (const float*)d_in[0];
    P.p = (const float*)d_in[1];
    P.positions = (const int*)d_in[2];
    P.attn_norm = (const float*)d_in[3];
    P.w_in = (const float*)d_in[4];
    P.nsa_gain = (const float*)d_in[5];
    P.cmp_pos = (const float*)d_in[6];
    P.cmp_w1 = (const float*)d_in[7];
    P.cmp_w2 = (const float*)d_in[8];
    P.dsa_gain = (const float*)d_in[9];
    P.w_a = (const float*)d_in[10];
    P.w_b = (const float*)d_in[11];
    P.w_out = (const float*)d_in[12];
    P.ffn_norm = (const float*)d_in[13];
    P.peer_wq = (const float*)d_in[14];
    P.peer_sk = (const float*)d_in[15];
    P.peer_u = (const float*)d_in[16];
    P.peer_v = (const float*)d_in[17];
    P.ple_w = (const float*)d_in[18];
    P.ple_gw = (const float*)d_in[19];
    P.ple_norm = (const float*)d_in[20];
    P.out = (float*)d_out;
    P.ws = (unsigned char*)d_ws;
    void* args[] = {&P};
    hipError_t e = hipLaunchCooperativeKernel((void*)fwd_kernel, dim3(grid_blocks), dim3(256), args, LDS_BYTES, stream);
    if (e != hipSuccess) fprintf(stderr, "cooperative launch failed: %s (grid %d)\n", hipGetErrorString(e), grid_blocks);
}
```

```cpp
#include <hip/hip_runtime.h>
#include <hip/hip_cooperative_groups.h>
#include <cstdio>
#include <cstdint>
namespace cg = cooperative_groups;

typedef unsigned short u16;
typedef unsigned int u32;
typedef unsigned long long u64;
using bf16x8 = __attribute__((ext_vector_type(8))) short;
using f32x4 = __attribute__((ext_vector_type(4))) float;
using f32x16 = __attribute__((ext_vector_type(16))) float;
typedef __bf16 bf16x2_t __attribute__((ext_vector_type(2)));

constexpr int D_MODEL = 1024, BATCH = 8, SEQ = 4096, NTOK = BATCH * SEQ;
constexpr int IN_COLS = 4576;
constexpr int C_NQ = 0, C_NKV = 512, C_NG = 1280, C_DQ = 1304, C_DKV = 1816, C_IQ = 1944, C_IK = 2456, C_IW = 2520, C_MG = 2528;
constexpr int NCMP = 255;
constexpr int CROWS = BATCH * NCMP * 2;
constexpr int NEXP = 16384;
constexpr float EPS = 1e-6f;

constexpr size_t AL(size_t x) { return (x + 255) & ~(size_t)255; }
constexpr size_t WO_WIN = 0;
constexpr size_t WO_W1 = WO_WIN + AL((size_t)IN_COLS * 1024 * 2);
constexpr size_t WO_W2 = WO_W1 + AL((size_t)2 * 256 * 2048 * 2);
constexpr size_t WO_WA = WO_W2 + AL((size_t)2 * 64 * 256 * 2);
constexpr size_t WO_WB = WO_WA + AL((size_t)1024 * 512 * 2);
constexpr size_t WO_WO = WO_WB + AL((size_t)1024 * 512 * 2);
constexpr size_t WO_WQ = WO_WO + AL((size_t)1024 * 1024 * 2);
constexpr size_t WO_PW = WO_WQ + AL((size_t)2048 * 1024 * 2);
constexpr size_t WO_PG = WO_PW + AL((size_t)1024 * 256 * 2);
constexpr size_t WO_SK = WO_PG + AL((size_t)1024 * 1024 * 2);
constexpr size_t WO_CB = WO_SK + AL((size_t)2 * 128 * 128 * 2);
constexpr size_t W_LAYER = WO_CB + AL((size_t)2 * 256 * 4);

constexpr size_t OFF_W = 0;
constexpr size_t OFF_ROPE = OFF_W + 2 * W_LAYER;
constexpr size_t OFF_H = OFF_ROPE + AL((size_t)NTOK * 16 * 4);
constexpr size_t OFF_PROJ = OFF_H + AL((size_t)NTOK * 1024 * 2);
constexpr size_t OFF_YAB = OFF_PROJ + AL((size_t)NTOK * IN_COLS * 2);
constexpr size_t OFF_CHID = OFF_YAB + AL((size_t)NTOK * 1024 * 2);
constexpr size_t OFF_CBUF = OFF_CHID + AL((size_t)2 * CROWS * 256 * 2);
constexpr size_t OFF_KCB = OFF_CBUF + AL((size_t)2 * CROWS * 64 * 4);
constexpr size_t OFF_VCB = OFF_KCB + AL((size_t)BATCH * 2 * 256 * 64 * 2);
constexpr size_t OFF_RSTDE = OFF_VCB + AL((size_t)BATCH * 2 * 256 * 64 * 2);
constexpr size_t OFF_BITS = OFF_RSTDE + AL((size_t)NTOK * 4);
constexpr size_t WS_END = OFF_BITS + AL((size_t)NTOK * 64 * 8);
constexpr size_t OFF_PQ = OFF_PROJ;
constexpr size_t OFF_UB = OFF_PQ + (size_t)NTOK * 2048 * 2;
constexpr size_t OFF_VB = OFF_UB + (size_t)NEXP * 1024 * 2;
constexpr size_t OFF_EIDX = OFF_VB + (size_t)NEXP * 1024 * 2;
constexpr size_t OFF_GATE = OFF_EIDX + (size_t)NTOK * 128 * 4;
static_assert(OFF_GATE + (size_t)NTOK * 128 * 4 <= OFF_YAB, "alias overflow");

constexpr int LDS_BYTES = 65536 + 2048;

struct Params {
    const float* x; const float* p; const int* positions;
    const float* attn_norm; const float* w_in; const float* nsa_gain; const float* cmp_pos; const float* cmp_w1; const float* cmp_w2;
    const float* dsa_gain; const float* w_a; const float* w_b; const float* w_out; const float* ffn_norm; const float* peer_wq;
    const float* peer_sk; const float* peer_u; const float* peer_v; const float* ple_w; const float* ple_gw; const float* ple_norm;
    float* out; unsigned char* ws;
};

__device__ __forceinline__ u16 f2bf(float f) {
    u32 u = __float_as_uint(f);
    u32 r = u + 0x7FFFu + ((u >> 16) & 1u);
    return (u16)(r >> 16);
}
__device__ __forceinline__ float bf2f(u16 h) { return __uint_as_float(((u32)h) << 16); }
__device__ __forceinline__ float bf_lo(u32 w) { return __uint_as_float(w << 16); }
__device__ __forceinline__ float bf_hi(u32 w) { return __uint_as_float(w & 0xFFFF0000u); }
__device__ __forceinline__ u32 pack2(float a, float b) {
    bf16x2_t v = {(__bf16)a, (__bf16)b};
    return __builtin_bit_cast(u32, v);
}
__device__ __forceinline__ float dot2(u32 a, u32 b, float c) {
    return __builtin_amdgcn_fdot2_f32_bf16(__builtin_bit_cast(bf16x2_t, a), __builtin_bit_cast(bf16x2_t, b), c, false);
}
__device__ __forceinline__ float wsum(float v) {
#pragma unroll
    for (int o = 32; o > 0; o >>= 1) v += __shfl_xor(v, o);
    return v;
}
__device__ __forceinline__ float wmax(float v) {
#pragma unroll
    for (int o = 32; o > 0; o >>= 1) v = fmaxf(v, __shfl_xor(v, o));
    return v;
}
__device__ __forceinline__ int wsumi(int v) {
#pragma unroll
    for (int o = 32; o > 0; o >>= 1) v += __shfl_xor(v, o);
    return v;
}
__device__ __forceinline__ float sigmoidf(float x) { return 1.0f / (1.0f + __expf(-x)); }
__device__ __forceinline__ float gelu_tanh(float x) {
    float u = 0.7978845608028654f * (x + 0.044715f * x * x * x);
    return 0.5f * x * (1.0f + tanhf(u));
}
#define WAVE_SYNC() asm volatile("s_waitcnt lgkmcnt(0)" ::: "memory")
template <class T>
__device__ __forceinline__ T* opq(T* p) {
    asm volatile("" : "+s"(p));
    return p;
}
__device__ __forceinline__ int tidx() {
    int t = threadIdx.x;
    asm volatile("" : "+v"(t));
    return t;
}
__device__ __forceinline__ int bidx() {
    int b = blockIdx.x;
    asm volatile("" : "+s"(b));
    return b;
}
__device__ __forceinline__ int gdim() {
    int g = gridDim.x;
    asm volatile("" : "+s"(g));
    return g;
}

template <int AMODE, class Epi>
__device__ __forceinline__ void gemm_tile(const void* __restrict__ Ap, long lda, const u16* __restrict__ BT, long ldb, int M, int N, int K,
                                          int m0, int n0, u16* lds, Epi epi) {
    const int tid = tidx(), lane = tid & 63, w = tid >> 6;
    const int wm = w >> 1, wn = w & 1;
    u16* As = lds;
    u16* Bs = lds + 128 * 40;
    f32x4 acc[4][4];
#pragma unroll
    for (int i = 0; i < 4; ++i)
#pragma unroll
        for (int j = 0; j < 4; ++j) acc[i][j] = f32x4{0.f, 0.f, 0.f, 0.f};

    const int lkc = tid & 3;
    const int lrow0 = tid >> 2, lrow1 = 64 + (tid >> 2);
    long abase0, abase1, bbase0, bbase1;
    {
        int gr0 = m0 + lrow0, gr1 = m0 + lrow1;
        if (gr0 > M - 1) gr0 = M - 1;
        if (gr1 > M - 1) gr1 = M - 1;
        if (AMODE == 1) {
            int b = gr0 / (NCMP * 2);
            int rem = gr0 - b * (NCMP * 2);
            abase0 = ((long)b * SEQ + 16 * (rem >> 1)) * IN_COLS + (rem & 1) * 64;
            b = gr1 / (NCMP * 2);
            rem = gr1 - b * (NCMP * 2);
            abase1 = ((long)b * SEQ + 16 * (rem >> 1)) * IN_COLS + (rem & 1) * 64;
        } else {
            abase0 = (long)gr0 * lda;
            abase1 = (long)gr1 * lda;
        }
        int gn0 = n0 + lrow0, gn1 = n0 + lrow1;
        if (gn0 > N - 1) gn0 = N - 1;
        if (gn1 > N - 1) gn1 = N - 1;
        bbase0 = (long)gn0 * ldb;
        bbase1 = (long)gn1 * ldb;
    }
    uint4 ra0, ra1, rb0, rb1;
#define GEMM_LOAD_A(dst, abase, k)                                                                          \
    do {                                                                                                    \
        if (AMODE == 0) {                                                                                   \
            dst = *(const uint4*)((const u16*)Ap + (abase) + (k));                                          \
        } else if (AMODE == 1) {                                                                            \
            dst = *(const uint4*)((const u16*)Ap + (abase) + (long)((k) >> 6) * IN_COLS + ((k) & 63));      \
        } else {                                                                                            \
            const float* fp_ = (const float*)Ap + (abase) + (k);                                            \
            float4 f0_ = *(const float4*)fp_;                                                               \
            float4 f1_ = *(const float4*)(fp_ + 4);                                                         \
            dst = uint4{pack2(f0_.x, f0_.y), pack2(f0_.z, f0_.w), pack2(f1_.x, f1_.y), pack2(f1_.z, f1_.w)}; \
        }                                                                                                   \
    } while (0)
#define GEMM_LOAD_ALL(k0)                              \
    do {                                               \
        const int k_ = (k0) + lkc * 8;                 \
        GEMM_LOAD_A(ra0, abase0, k_);                  \
        GEMM_LOAD_A(ra1, abase1, k_);                  \
        rb0 = *(const uint4*)(BT + bbase0 + k_);       \
        rb1 = *(const uint4*)(BT + bbase1 + k_);       \
    } while (0)
    const int nk = K / 32;
    GEMM_LOAD_ALL(0);
    for (int kt = 0; kt < nk; ++kt) {
        *(uint4*)(As + lrow0 * 40 + lkc * 8) = ra0;
        *(uint4*)(As + lrow1 * 40 + lkc * 8) = ra1;
        *(uint4*)(Bs + lrow0 * 40 + lkc * 8) = rb0;
        *(uint4*)(Bs + lrow1 * 40 + lkc * 8) = rb1;
        __syncthreads();
        if (kt + 1 < nk) GEMM_LOAD_ALL((kt + 1) * 32);
        bf16x8 af[4], bfr[4];
#pragma unroll
        for (int i = 0; i < 4; ++i) {
            af[i] = *(const bf16x8*)(As + (wm * 64 + i * 16 + (lane & 15)) * 40 + (lane >> 4) * 8);
            bfr[i] = *(const bf16x8*)(Bs + (wn * 64 + i * 16 + (lane & 15)) * 40 + (lane >> 4) * 8);
        }
#pragma unroll
        for (int i = 0; i < 4; ++i)
#pragma unroll
            for (int j = 0; j < 4; ++j) acc[i][j] = __builtin_amdgcn_mfma_f32_16x16x32_bf16(af[i], bfr[j], acc[i][j], 0, 0, 0);
        __syncthreads();
    }
#pragma unroll
    for (int i = 0; i < 4; ++i)
#pragma unroll
        for (int j = 0; j < 4; ++j)
#pragma unroll
            for (int r = 0; r < 4; ++r) {
                int row = m0 + wm * 64 + i * 16 + (lane >> 4) * 4 + r;
                int col = n0 + wn * 64 + j * 16 + (lane & 15);
                if (row < M && col < N) epi(row, col, acc[i][j][r]);
            }
}

template <int AMODE, class Epi>
__device__ __forceinline__ void gemm_phase(const void* Ap, long lda, const u16* BT, long ldb, int M, int N, int K, u16* lds, Epi epi) {
    const int tm = (M + 127) / 128, tn = (N + 127) / 128;
    for (int t = bidx(); t < tm * tn; t += gdim()) {
        int im = t / tn, in = t - im * tn;
        gemm_tile<AMODE>(Ap, lda, BT, ldb, M, N, K, im * 128, in * 128, lds, epi);
    }
}

__device__ __forceinline__ void transpose_cvt(const float* __restrict__ src, u16* __restrict__ dst, int K, int N, float* tile) {
    const int tk = K / 64, tn = (N + 63) / 64;
    const int tx = tidx() & 63, ty = tidx() >> 6;
    for (int t = bidx(); t < tk * tn; t += gdim()) {
        int k0 = (t / tn) * 64, n0 = (t % tn) * 64;
#pragma unroll
        for (int r = 0; r < 16; ++r) {
            int k = ty * 16 + r, n = n0 + tx;
            tile[k * 65 + tx] = (n < N) ? src[(long)(k0 + k) * N + n] : 0.f;
        }
        __syncthreads();
#pragma unroll
        for (int r = 0; r < 16; ++r) {
            int nn = ty * 16 + r, n = n0 + nn;
            if (n < N) dst[(long)n * K + k0 + tx] = f2bf(tile[tx * 65 + nn]);
        }
        __syncthreads();
    }
}

__device__ __forceinline__ void cvt_f32_bf16(const float* __restrict__ src, u16* __restrict__ dst, long n) {
    long i = ((long)bidx() * 256 + tidx()) * 8;
    const long stride = (long)gdim() * 256 * 8;
    for (; i < n; i += stride) {
        float4 a = *(const float4*)(src + i);
        float4 b = *(const float4*)(src + i + 4);
        *(uint4*)(dst + i) = uint4{pack2(a.x, a.y), pack2(a.z, a.w), pack2(b.x, b.y), pack2(b.z, b.w)};
    }
}

__device__ __forceinline__ void rms_rows(const float* __restrict__ x, const float* __restrict__ g, u16* __restrict__ dst, const u16* __restrict__ e,
                         float* __restrict__ rstd_e) {
    const int lane = tidx() & 63;
    const int wid = bidx() * 4 + (tidx() >> 6);
    const int nw = gdim() * 4;
    for (int row = wid; row < NTOK; row += nw) {
        const float* xr = x + (long)row * 1024;
        float4 v[4];
        float ss = 0.f;
#pragma unroll
        for (int i = 0; i < 4; ++i) {
            v[i] = *(const float4*)(xr + i * 256 + lane * 4);
            ss += v[i].x * v[i].x + v[i].y * v[i].y + v[i].z * v[i].z + v[i].w * v[i].w;
        }
        ss = wsum(ss);
        float rstd = rsqrtf(ss * (1.0f / 1024.0f) + EPS);
#pragma unroll
        for (int i = 0; i < 4; ++i) {
            float4 gg = g ? *(const float4*)(g + i * 256 + lane * 4) : float4{1.f, 1.f, 1.f, 1.f};
            uint2 o = uint2{pack2(v[i].x * rstd * gg.x, v[i].y * rstd * gg.y), pack2(v[i].z * rstd * gg.z, v[i].w * rstd * gg.w)};
            *(uint2*)(dst + (long)row * 1024 + i * 256 + lane * 4) = o;
        }
        if (e) {
            const uint4* er = (const uint4*)(e + (long)row * 1024);
            float es = 0.f;
#pragma unroll
            for (int i = 0; i < 2; ++i) {
                uint4 q = er[i * 64 + lane];
                float a;
                a = bf_lo(q.x); es += a * a; a = bf_hi(q.x); es += a * a;
                a = bf_lo(q.y); es += a * a; a = bf_hi(q.y); es += a * a;
                a = bf_lo(q.z); es += a * a; a = bf_hi(q.z); es += a * a;
                a = bf_lo(q.w); es += a * a; a = bf_hi(q.w); es += a * a;
            }
            es = wsum(es);
            if (lane == 0) rstd_e[row] = rsqrtf(es * (1.0f / 1024.0f) + EPS);
        }
    }
}

__device__ __forceinline__ void head_chunk(u16* ptr, float gain, bool do_norm, float scale, float c, float sn, int lane) {
    float v = bf2f(ptr[lane]);
    if (do_norm) {
        float ss = wsum(v * v);
        v = v * rsqrtf(ss * (1.0f / 64.0f) + EPS) * gain;
    }
    float pv = __shfl_xor(v, 8);
    if (lane < 16) v = (lane < 8) ? (v * c - pv * sn) : (v * c + pv * sn);
    ptr[lane] = f2bf(v * scale);
}
__device__ __forceinline__ u32 sig2(u32 w) { return pack2(sigmoidf(bf_lo(w)), sigmoidf(bf_hi(w))); }

__device__ __forceinline__ void post_proj(unsigned char* ws, const float* ng, const float* dg, unsigned char* smem) {
    u16* proj = (u16*)(ws + OFF_PROJ);
    const float* ropec = (const float*)(ws + OFF_ROPE);
    const float* ropes = ropec + (size_t)NTOK * 8;
    const int lane = tidx() & 63, w = tidx() >> 6;
    u16* lrow = (u16*)(smem + w * 9216);
    const float g_q = ng[lane], g_ks = ng[128 + lane], g_kw = ng[192 + lane], g_dq = dg[lane], g_kb = dg[64 + lane];
    const int wid = bidx() * 4 + w;
    const int nw = gdim() * 4;
    for (int t = wid; t < NTOK; t += nw) {
        uint4* grow = (uint4*)(proj + (long)t * IN_COLS);
        const float c = ropec[(long)t * 8 + (lane & 7)], sn = ropes[(long)t * 8 + (lane & 7)];
#pragma unroll
        for (int i = 0; i < 8; ++i) ((uint4*)lrow)[i * 64 + lane] = grow[i * 64 + lane];
        if (lane < 60) ((uint4*)lrow)[512 + lane] = grow[512 + lane];
        WAVE_SYNC();
        for (int h = 0; h < 8; ++h) head_chunk(lrow + C_NQ + h * 64, g_q, true, 0.125f * 1.4426950408889634f, c, sn, lane);
        for (int g = 0; g < 2; ++g) head_chunk(lrow + C_NKV + (2 * 2 + g) * 64, g_ks, true, 1.0f, c, sn, lane);
        for (int g = 0; g < 2; ++g) head_chunk(lrow + C_NKV + (4 * 2 + g) * 64, g_kw, true, 1.0f, c, sn, lane);
        for (int h = 0; h < 8; ++h) head_chunk(lrow + C_DQ + h * 64, g_dq, true, 0.125f * 1.4426950408889634f, c, sn, lane);
        head_chunk(lrow + C_DKV, g_kb, true, 1.0f, c, sn, lane);
        for (int h = 0; h < 8; ++h) head_chunk(lrow + C_IQ + h * 64, 1.0f, false, 0.125f, c, sn, lane);
        head_chunk(lrow + C_IK, 1.0f, false, 1.0f, c, sn, lane);
        WAVE_SYNC();
#pragma unroll
        for (int i = 0; i < 9; ++i) {
            int idx = i * 64 + lane;
            if (idx < 572) {
                uint4 v = ((const uint4*)lrow)[idx];
                if (idx >= 316 || (idx >= 160 && idx < 163)) v = uint4{sig2(v.x), sig2(v.y), sig2(v.z), sig2(v.w)};
                grow[idx] = v;
            }
        }
        WAVE_SYNC();
    }
}

template <int NH>
__device__ __forceinline__ void qk_chunk(const u16* krow, const u32* qlds, float (&s)[NH]) {
    asm volatile("" ::: "memory");
    uint4 kr[8];
#pragma unroll
    for (int i = 0; i < 8; ++i) kr[i] = ((const uint4*)krow)[i];
#pragma unroll
    for (int h = 0; h < NH; ++h) s[h] = 0.f;
#pragma unroll
    for (int i = 0; i < 8; ++i)
#pragma unroll
        for (int h = 0; h < NH; ++h) {
            uint4 q = *(const uint4*)(qlds + h * 32 + i * 4);
            s[h] = dot2(kr[i].x, q.x, s[h]);
            s[h] = dot2(kr[i].y, q.y, s[h]);
            s[h] = dot2(kr[i].z, q.z, s[h]);
            s[h] = dot2(kr[i].w, q.w, s[h]);
        }
}

template <int NH, class VRow>
__device__ __forceinline__ void pv_chunk(const float* plds, VRow vrow, float (&o)[NH][4], int lane) {
    const int sub = lane >> 4, dq = lane & 15;
#pragma unroll 4
    for (int kk = 0; kk < 16; ++kk) {
        int key = kk * 4 + sub;
        const u16* vp = vrow(key);
        uint2 vv = *(const uint2*)(vp + dq * 4);
        float v0 = bf_lo(vv.x), v1 = bf_hi(vv.x), v2 = bf_lo(vv.y), v3 = bf_hi(vv.y);
#pragma unroll
        for (int h = 0; h < NH; ++h) {
            float ph = plds[key * NH + h];
            o[h][0] += ph * v0;
            o[h][1] += ph * v1;
            o[h][2] += ph * v2;
            o[h][3] += ph * v3;
        }
    }
}

template <int NH, class VRow>
__device__ __forceinline__ void attn_chunk(float (&s)[NH], bool valid, float (&m)[NH], float (&l)[NH], float (&o)[NH][4], float* plds, VRow vrow,
                                           int lane) {
#pragma unroll
    for (int h = 0; h < NH; ++h) {
        float sv = valid ? s[h] : -1e30f;
        float cm = wmax(sv);
        float mn = fmaxf(m[h], cm);
        float alpha = __expf(m[h] - mn);
        float p = valid ? __expf(sv - mn) : 0.f;
        l[h] = l[h] * alpha + wsum(p);
        m[h] = mn;
#pragma unroll
        for (int j = 0; j < 4; ++j) o[h][j] *= alpha;
        plds[lane * NH + h] = p;
    }
    WAVE_SYNC();
    pv_chunk<NH>(plds, vrow, o, lane);
    WAVE_SYNC();
}

#define MFMA32(a, b, c) __builtin_amdgcn_mfma_f32_32x32x16_bf16(a, b, c, 0, 0, 0)
typedef __attribute__((address_space(3))) const char* lds_cptr;
typedef short v4i16_t __attribute__((ext_vector_type(4)));
using s16x4 = __attribute__((ext_vector_type(4))) short;
__device__ __forceinline__ s16x4 vtr(lds_cptr p) {
    return __builtin_bit_cast(s16x4, __builtin_amdgcn_ds_read_tr16_b64_v4i16((__attribute__((address_space(3))) v4i16_t*)p));
}
__device__ __forceinline__ float swap32(float v) { return __shfl_xor(v, 32); }

using u32x4 = __attribute__((ext_vector_type(4))) unsigned;
struct TileRegs { u32x4 k0, k1, v0, v1; };
template <class RowPtr>
__device__ __forceinline__ void tile_load(u32x4& k0, u32x4& k1, u32x4& v0, u32x4& v1, RowPtr rowptr, int w, int lane) {
    const u16 *kp, *vp, *kp2, *vp2;
    rowptr(lane, kp, vp2);
    rowptr(16 * w + (lane >> 2), kp2, vp);
    k0 = *(const u32x4*)(kp + w * 8);
    k1 = *(const u32x4*)(kp + (w + 4) * 8);
    v0 = *(const u32x4*)(vp + (lane & 3) * 8);
    v1 = *(const u32x4*)(vp + 32 + (lane & 3) * 8);
}
__device__ __forceinline__ void tile_store(const u32x4& k0, const u32x4& k1, const u32x4& v0, const u32x4& v1, unsigned char* buf, int w, int lane) {
    *(u32x4*)(buf + w * 1024 + lane * 16) = k0;
    *(u32x4*)(buf + (w + 4) * 1024 + lane * 16) = k1;
    *(u32x4*)(buf + 8192 + (16 * w + (lane >> 2)) * 64 + (lane & 3) * 16) = v0;
    *(u32x4*)(buf + 8192 + 4096 + (16 * w + (lane >> 2)) * 64 + (lane & 3) * 16) = v1;
}
__device__ __forceinline__ void qk_tile(const unsigned char* buf, const bf16x8 (&qr)[4], f32x16& s0, f32x16& s1, int lane) {
    const int r32 = lane & 31, hi = lane >> 5;
    lds_cptr kp = (lds_cptr)buf + hi * 1024 + r32 * 16;
#pragma unroll
    for (int i = 0; i < 16; ++i) { s0[i] = 0.f; s1[i] = 0.f; }
#pragma unroll
    for (int d0 = 0; d0 < 4; ++d0) {
        bf16x8 k0 = *(const __attribute__((address_space(3))) bf16x8*)(kp + d0 * 2048);
        bf16x8 k1 = *(const __attribute__((address_space(3))) bf16x8*)(kp + d0 * 2048 + 512);
        s0 = MFMA32(k0, qr[d0], s0);
        s1 = MFMA32(k1, qr[d0], s1);
    }
}
__device__ __forceinline__ bf16x8 pack8(const f32x16& p, int s) {
    u32 a = pack2(p[8 * s + 0], p[8 * s + 1]), b = pack2(p[8 * s + 2], p[8 * s + 3]);
    u32 c = pack2(p[8 * s + 4], p[8 * s + 5]), d = pack2(p[8 * s + 6], p[8 * s + 7]);
    u32x4 v = u32x4{a, b, c, d};
    return __builtin_bit_cast(bf16x8, v);
}
__device__ __forceinline__ void pv_tile(const unsigned char* buf, const f32x16& p0, const f32x16& p1, f32x16 (&o)[2], int lane) {
    const int hi = lane >> 5;
    lds_cptr vp = (lds_cptr)buf + 8192 + ((lane >> 4) & 1) * 32 + (lane & 3) * 8 + (4 * hi + ((lane & 15) >> 2)) * 64;
    bf16x8 pf[4];
    pf[0] = pack8(p0, 0);
    pf[1] = pack8(p0, 1);
    pf[2] = pack8(p1, 0);
    pf[3] = pack8(p1, 1);
#pragma unroll
    for (int i = 0; i < 8; ++i) {
        const int dh = i >> 2, ks = i & 3;
        s16x4 vlo = vtr(vp + dh * 4096 + ks * 1024);
        s16x4 vhi = vtr(vp + dh * 4096 + ks * 1024 + 512);
        bf16x8 vf = (bf16x8){vlo[0], vlo[1], vlo[2], vlo[3], vhi[0], vhi[1], vhi[2], vhi[3]};
        o[dh] = MFMA32(vf, pf[ks], o[dh]);
    }
}
template <bool BITS>
__device__ __forceinline__ void apply_mask(f32x16& s0, f32x16& s1, int lo, int hi_lim, u64 word, int hi) {
    const u32 wlo = (u32)(word >> (4 * hi)), whi = (u32)(word >> (32 + 4 * hi));
#pragma unroll
    for (int i = 0; i < 16; ++i) {
        const int kc = (i & 3) + 8 * (i >> 2);
        bool v0, v1;
        if (BITS) {
            v0 = (wlo >> kc) & 1u;
            v1 = (whi >> kc) & 1u;
        } else {
            const int kk = kc + 4 * hi;
            v0 = (kk >= lo) && (kk <= hi_lim);
            v1 = (kk + 32 >= lo) && (kk + 32 <= hi_lim);
        }
        s0[i] = v0 ? s0[i] : -1e30f;
        s1[i] = v1 ? s1[i] : -1e30f;
    }
}
__device__ __forceinline__ void softmax_step(f32x16& s0, f32x16& s1, float& m, float& l, f32x16 (&o)[2]) {
    float mx = -1e30f;
#pragma unroll
    for (int i = 0; i < 16; ++i) mx = fmaxf(mx, fmaxf(s0[i], s1[i]));
    mx = fmaxf(mx, swap32(mx));
    const float mn = fmaxf(m, mx);
    const float alpha = __builtin_amdgcn_exp2f(m - mn);
    float sum = 0.f;
#pragma unroll
    for (int i = 0; i < 16; ++i) {
        s0[i] = (s0[i] > -1e29f) ? __builtin_amdgcn_exp2f(s0[i] - mn) : 0.f;
        s1[i] = (s1[i] > -1e29f) ? __builtin_amdgcn_exp2f(s1[i] - mn) : 0.f;
        sum += s0[i] + s1[i];
    }
    sum += swap32(sum);
    l = l * alpha + sum;
    m = mn;
#pragma unroll
    for (int i = 0; i < 16; ++i) { o[0][i] *= alpha; o[1][i] *= alpha; }
}

template <int MODE, bool BITS, class Next, class RowPtr, class MaskFn, class Extra>
__device__ __forceinline__ void flash_run(int first, Next next, RowPtr rowptr, MaskFn maskfn, Extra extra, const bf16x8 (&qr)[4], float& m, float& l,
                                          f32x16 (&o)[2], unsigned char* bufs, int w, int lane) {
    if (first < 0) return;
    u32x4 tk0, tk1, tv0, tv1;
    int cur = first;
    tile_load(tk0, tk1, tv0, tv1, [&](int r, const u16*& kp, const u16*& vp) { rowptr(cur, r, kp, vp); }, w, lane);
    __syncthreads();
    tile_store(tk0, tk1, tv0, tv1, bufs, w, lane);
    __syncthreads();
    int pb = 0;
    while (cur >= 0) {
        const int nxt = next(cur);
        if (nxt >= 0) tile_load(tk0, tk1, tv0, tv1, [&](int r, const u16*& kp, const u16*& vp) { rowptr(nxt, r, kp, vp); }, w, lane);
        const unsigned char* buf = bufs + pb * 16384;
        f32x16 s0, s1;
        qk_tile(buf, qr, s0, s1, lane);
        int lo, hl;
        u64 word;
        maskfn(cur, lo, hl, word);
        apply_mask<BITS>(s0, s1, lo, hl, word, lane >> 5);
        if (MODE == 0) {
            softmax_step(s0, s1, m, l, o);
            pv_tile(buf, s0, s1, o, lane);
        } else if (MODE == 1) {
            f32x16 od[2];
            softmax_step(s0, s1, m, l, od);
        } else {
#pragma unroll
            for (int i = 0; i < 16; ++i) {
                s0[i] = (s0[i] > -1e29f) ? __builtin_amdgcn_exp2f(s0[i] - m) * l : 0.f;
                s1[i] = (s1[i] > -1e29f) ? __builtin_amdgcn_exp2f(s1[i] - m) * l : 0.f;
            }
            extra(cur, s0, s1);
            pv_tile(buf, s0, s1, o, lane);
        }
        if (nxt >= 0) tile_store(tk0, tk1, tv0, tv1, bufs + (pb ^ 1) * 16384, w, lane);
        __syncthreads();
        pb ^= 1;
        cur = nxt;
    }
}

__device__ __forceinline__ void nsa_unit(unsigned char* ws, int b, int g, int qt, unsigned char* smem) {
    const int tid = tidx(), lane = tid & 63, w = tid >> 6;
    const int r32 = lane & 31, hi = lane >> 5;
    const int q0 = qt * 32;
    const int tl = q0 + 8 * w + (r32 >> 2);
    const int rep = r32 & 3;
    const u16* proj = (const u16*)(ws + OFF_PROJ);
    const u16* brow = proj + (long)b * SEQ * IN_COLS;
    const u16* kcb = (const u16*)(ws + OFF_KCB) + (size_t)(b * 2 + g) * 256 * 64;
    const u16* vcb = (const u16*)(ws + OFF_VCB) + (size_t)(b * 2 + g) * 256 * 64;
    u16* ya = (u16*)(ws + OFF_YAB);
    unsigned char* bufs = smem;
    float* imp = (float*)(smem + 32768);
    u64* selm = (u64*)(smem + 32768 + 8192);
    const u16* trow = brow + (long)tl * IN_COLS;
    bf16x8 qr[4];
#pragma unroll
    for (int d0 = 0; d0 < 4; ++d0) qr[d0] = *(const bf16x8*)(trow + C_NQ + (g * 4 + rep) * 64 + d0 * 16 + hi * 8);
    const float gate_c = bf2f(trow[C_NG + 0 * 8 + g * 4 + rep]);
    const float gate_s = bf2f(trow[C_NG + 1 * 8 + g * 4 + rep]);
    const float gate_w = bf2f(trow[C_NG + 2 * 8 + g * 4 + rep]);
    for (int i = tid; i < 32 * 64; i += 256) imp[i] = 0.f;
    f32x16 tot[2];
#pragma unroll
    for (int i = 0; i < 16; ++i) { tot[0][i] = 0.f; tot[1][i] = 0.f; }

    const int nvalid = tl >= 31 ? ((tl - 31) >> 4) + 1 : 0;
    const int nv_max = (q0 + 31 >= 31) ? ((q0 + 31 - 31) >> 4) + 1 : 0;
    const int ntile_c = (nv_max + 63) >> 6;
    auto crows = [&](int tile, int r, const u16*& kp, const u16*& vp) {
        int n = tile * 64 + r;
        n = n < 254 ? n : 254;
        kp = kcb + (size_t)n * 64;
        vp = vcb + (size_t)n * 64;
    };
    auto cnext = [&](int c) { return (c + 1 < ntile_c) ? c + 1 : -1; };
    auto cmask = [&](int tile, int& lo, int& hl, u64& word) { lo = 0; hl = nvalid - 64 * tile - 1; word = 0; };
    {
        float m = -1e30f, l = 0.f;
        f32x16 o[2];
#pragma unroll
        for (int i = 0; i < 16; ++i) { o[0][i] = 0.f; o[1][i] = 0.f; }
        flash_run<1, false>(ntile_c > 0 ? 0 : -1, cnext, crows, cmask, [&](int, f32x16&, f32x16&) {}, qr, m, l, o, bufs, w, lane);
        float invl = l > 0.f ? 1.0f / l : 0.f;
        const int qloc = 8 * w + (r32 >> 2);
        flash_run<2, false>(ntile_c > 0 ? 0 : -1, cnext, crows, cmask,
                            [&](int tile, f32x16& p0, f32x16& p1) {
#pragma unroll
                                for (int a = 0; a < 4; ++a) {
                                    float g0 = p0[4 * a] + p0[4 * a + 1] + p0[4 * a + 2] + p0[4 * a + 3], e0 = p0[4 * a + 3];
                                    float g1 = p1[4 * a] + p1[4 * a + 1] + p1[4 * a + 2] + p1[4 * a + 3], e1 = p1[4 * a + 3];
                                    g0 += __shfl_xor(g0, 1); g0 += __shfl_xor(g0, 2);
                                    e0 += __shfl_xor(e0, 1); e0 += __shfl_xor(e0, 2);
                                    g1 += __shfl_xor(g1, 1); g1 += __shfl_xor(g1, 2);
                                    e1 += __shfl_xor(e1, 1); e1 += __shfl_xor(e1, 2);
                                    if (rep == 0) {
                                        int j0 = 16 * tile + 2 * a + hi, j1 = j0 + 8;
                                        atomicAdd(&imp[qloc * 64 + j0], g0);
                                        if (j0 + 1 < 64) atomicAdd(&imp[qloc * 64 + j0 + 1], e0);
                                        if (j1 < 64) atomicAdd(&imp[qloc * 64 + j1], g1);
                                        if (j1 + 1 < 64) atomicAdd(&imp[qloc * 64 + j1 + 1], e1);
                                    }
                                }
                            },
                            qr, m, invl, o, bufs, w, lane);
#pragma unroll
        for (int i = 0; i < 16; ++i) { tot[0][i] += gate_c * o[0][i]; tot[1][i] += gate_c * o[1][i]; }
    }
    __syncthreads();
    for (int qq = 0; qq < 8; ++qq) {
        const int qi = 8 * w + qq;
        const int tq = q0 + qi;
        const int cur = tq >> 6;
        const int j = lane;
        float v = imp[qi * 64 + j];
        if (j == 0 || j == cur || j == cur - 1) v = __builtin_inff();
        if (j > cur) v = -__builtin_inff();
        int rank = 0;
        for (int jp = 0; jp < 64; ++jp) {
            float vj = __shfl(v, jp);
            rank += (vj > v || (vj == v && jp < j)) ? 1 : 0;
        }
        u64 sm = __ballot(rank < 16 && j <= cur);
        if (lane == 0) selm[qi] = sm;
    }
    __syncthreads();
    const u64 mymask = selm[8 * w + (r32 >> 2)];
    u64 unionm = 0;
    for (int i = 0; i < 32; ++i) unionm |= selm[i];
    unionm = __builtin_amdgcn_readfirstlane((u32)unionm) | ((u64)__builtin_amdgcn_readfirstlane((u32)(unionm >> 32)) << 32);
    {
        float m = -1e30f, l = 0.f;
        f32x16 o[2];
#pragma unroll
        for (int i = 0; i < 16; ++i) { o[0][i] = 0.f; o[1][i] = 0.f; }
        auto snext = [&](int c) {
            u64 rest = (c >= 63) ? 0ull : (unionm >> (c + 1));
            return rest ? (c + 1 + (__ffsll((long long)rest) - 1)) : -1;
        };
        const int first = unionm ? (__ffsll((long long)unionm) - 1) : -1;
        flash_run<0, false>(first, snext,
                            [&](int j, int r, const u16*& kp, const u16*& vp) {
                                const u16* rp = brow + (long)(64 * j + r) * IN_COLS + C_NKV;
                                kp = rp + (2 * 2 + g) * 64;
                                vp = rp + (3 * 2 + g) * 64;
                            },
                            [&](int j, int& lo, int& hl, u64& word) { lo = 0; hl = ((mymask >> j) & 1ull) ? (tl - 64 * j) : -1; word = 0; },
                            [&](int, f32x16&, f32x16&) {}, qr, m, l, o, bufs, w, lane);
        const float sc = l > 0.f ? gate_s / l : 0.f;
#pragma unroll
        for (int i = 0; i < 16; ++i) { tot[0][i] += sc * o[0][i]; tot[1][i] += sc * o[1][i]; }
    }
    {
        float m = -1e30f, l = 0.f;
        f32x16 o[2];
#pragma unroll
        for (int i = 0; i < 16; ++i) { o[0][i] = 0.f; o[1][i] = 0.f; }
        const int jfirst = (q0 - 511) > 0 ? ((q0 - 511) >> 6) : 0;
        const int jlast = (q0 + 31) >> 6;
        flash_run<0, false>(jfirst, [&](int c) { return c + 1 <= jlast ? c + 1 : -1; },
                            [&](int j, int r, const u16*& kp, const u16*& vp) {
                                const u16* rp = brow + (long)(64 * j + r) * IN_COLS + C_NKV;
                                kp = rp + (4 * 2 + g) * 64;
                                vp = rp + (5 * 2 + g) * 64;
                            },
                            [&](int j, int& lo, int& hl, u64& word) { lo = tl - 511 - 64 * j; hl = tl - 64 * j; word = 0; },
                            [&](int, f32x16&, f32x16&) {}, qr, m, l, o, bufs, w, lane);
        const float sc = l > 0.f ? gate_w / l : 0.f;
#pragma unroll
        for (int i = 0; i < 16; ++i) { tot[0][i] += sc * o[0][i]; tot[1][i] += sc * o[1][i]; }
    }
    {
        u16* orow = ya + ((long)b * SEQ + tl) * 512 + (g * 4 + rep) * 64;
#pragma unroll
        for (int dh = 0; dh < 2; ++dh)
#pragma unroll
            for (int a = 0; a < 4; ++a) {
                uint2 v = uint2{pack2(tot[dh][4 * a], tot[dh][4 * a + 1]), pack2(tot[dh][4 * a + 2], tot[dh][4 * a + 3])};
                *(uint2*)(orow + dh * 32 + 8 * a + 4 * hi) = v;
            }
    }
}

__device__ __forceinline__ void dsa_select_unit(unsigned char* ws, int unit, unsigned char* smem) {
    const int tid = tidx(), lane = tid & 63, w = tid >> 6;
    const int t0 = unit * 4;
    const int b = t0 / SEQ, tl0 = t0 - b * SEQ;
    const u16* proj = (const u16*)(ws + OFF_PROJ);
    const u16* brow = proj + (long)b * SEQ * IN_COLS;
    u64* bits = (u64*)(ws + OFF_BITS);
    float* sc = (float*)smem;
    __syncthreads();
    {
        const int r = lane & 31, half = lane >> 5;
        const int q = r >> 3, h = r & 7;
        bf16x8 af[4];
#pragma unroll
        for (int ks = 0; ks < 4; ++ks) af[ks] = *(const bf16x8*)(proj + (long)(t0 + q) * IN_COLS + C_IQ + h * 64 + ks * 16 + half * 8);
        float wq[4][4];
#pragma unroll
        for (int qq = 0; qq < 4; ++qq)
#pragma unroll
            for (int i = 0; i < 4; ++i) wq[qq][i] = bf2f(proj[(long)(t0 + qq) * IN_COLS + C_IW + i + 4 * half]) * 0.35355339059327373f;
        const int ntiles = (tl0 + 4 + 31) >> 5;
        bf16x8 bfr[4];
        if (w < ntiles) {
#pragma unroll
            for (int ks = 0; ks < 4; ++ks) bfr[ks] = *(const bf16x8*)(brow + (long)(w * 32 + r) * IN_COLS + C_IK + ks * 16 + half * 8);
        }
        for (int tile = w; tile < ntiles; tile += 4) {
            int key = tile * 32 + r;
            bf16x8 bcur[4];
#pragma unroll
            for (int ks = 0; ks < 4; ++ks) bcur[ks] = bfr[ks];
            if (tile + 4 < ntiles) {
#pragma unroll
                for (int ks = 0; ks < 4; ++ks) bfr[ks] = *(const bf16x8*)(brow + (long)(key + 128) * IN_COLS + C_IK + ks * 16 + half * 8);
            }
            f32x16 acc;
#pragma unroll
            for (int i = 0; i < 16; ++i) acc[i] = 0.f;
#pragma unroll
            for (int ks = 0; ks < 4; ++ks) acc = MFMA32(af[ks], bcur[ks], acc);
            float totq[4];
#pragma unroll
            for (int qq = 0; qq < 4; ++qq) {
                float part = 0.f;
#pragma unroll
                for (int i = 0; i < 4; ++i) part += wq[qq][i] * fmaxf(acc[4 * qq + i], 0.f);
                totq[qq] = part + __shfl_xor(part, 32);
            }
            if (half == 0) {
                sc[0 * 4096 + key] = totq[0];
                sc[1 * 4096 + key] = totq[1];
            } else {
                sc[2 * 4096 + key] = totq[2];
                sc[3 * 4096 + key] = totq[3];
            }
        }
    }
    __syncthreads();
    const int t = t0 + w;
    const int tl = tl0 + w;
    const int nvalid = tl + 1;
    {
        u32 u[64];
        const float* scq = sc + w * 4096;
#pragma unroll
        for (int j = 0; j < 64; ++j) {
            int key = j * 64 + lane;
            u32 v = 0;
            if (key <= tl) {
                u32 bb = __float_as_uint(scq[key]);
                v = bb ^ ((bb >> 31) ? 0xFFFFFFFFu : 0x80000000u);
            }
            u[j] = v;
        }
        u32 K = 0;
        int need = 0;
        if (nvalid > 256) {
            for (int bit = 31; bit >= 0; --bit) {
                u32 cand = K | (1u << bit);
                int cnt = 0;
#pragma unroll
                for (int j = 0; j < 64; ++j) cnt += (u[j] >= cand) ? 1 : 0;
                cnt = wsumi(cnt);
                if (cnt >= 256) K = cand;
            }
            int cgt = 0;
#pragma unroll
            for (int j = 0; j < 64; ++j) cgt += (u[j] > K) ? 1 : 0;
            cgt = wsumi(cgt);
            need = 256 - cgt;
        }
        const u64 ltmask = (1ull << lane) - 1ull;
        int ebase = 0;
        u64 myword = 0;
#pragma unroll
        for (int j = 0; j < 64; ++j) {
            bool eq = (nvalid > 256) && (u[j] == K);
            u64 em = __ballot(eq);
            int erank = ebase + __popcll(em & ltmask);
            bool take = (u[j] > K) || (eq && erank < need);
            ebase += __popcll(em);
            u64 sm = __ballot(take);
            if (lane == j) myword = sm;
        }
        bits[(long)t * 64 + lane] = myword;
    }
}

__device__ __forceinline__ void dsa_attn_unit(unsigned char* ws, int b, int qt, unsigned char* smem) {
    const int tid = tidx(), lane = tid & 63, w = tid >> 6;
    const int r32 = lane & 31, hi = lane >> 5;
    const int q0 = qt * 16;
    const int qloc = 4 * w + (r32 >> 3);
    const int tl = q0 + qloc;
    const int head = r32 & 7;
    const u16* proj = (const u16*)(ws + OFF_PROJ);
    const u16* brow = proj + (long)b * SEQ * IN_COLS;
    const u64* bits = (const u64*)(ws + OFF_BITS) + ((long)b * SEQ + q0) * 64;
    u16* yb = (u16*)(ws + OFF_YAB) + (size_t)NTOK * 512;
    unsigned char* bufs = smem;
    u64* lbits = (u64*)(smem + 32768);
    __syncthreads();
    for (int i = tid; i < 16 * 64; i += 256) lbits[i] = bits[i];
    const u16* trow = brow + (long)tl * IN_COLS;
    bf16x8 qr[4];
#pragma unroll
    for (int d0 = 0; d0 < 4; ++d0) qr[d0] = *(const bf16x8*)(trow + C_DQ + head * 64 + d0 * 16 + hi * 8);
    float m = -1e30f, l = 0.f;
    f32x16 o[2];
#pragma unroll
    for (int i = 0; i < 16; ++i) { o[0][i] = 0.f; o[1][i] = 0.f; }
    const int jlast = (q0 + 15) >> 6;
    flash_run<0, true>(0, [&](int c) { return c + 1 <= jlast ? c + 1 : -1; },
                       [&](int j, int r, const u16*& kp, const u16*& vp) {
                           const u16* rp = brow + (long)(64 * j + r) * IN_COLS + C_DKV;
                           kp = rp;
                           vp = rp + 64;
                       },
                       [&](int j, int& lo, int& hl, u64& word) { lo = 0; hl = 0; word = lbits[qloc * 64 + j]; },
                       [&](int, f32x16&, f32x16&) {}, qr, m, l, o, bufs, w, lane);
    const float inv = l > 0.f ? 1.0f / l : 0.f;
    u16* orow = yb + ((long)b * SEQ + tl) * 512 + head * 64;
#pragma unroll
    for (int dh = 0; dh < 2; ++dh)
#pragma unroll
        for (int a = 0; a < 4; ++a) {
            uint2 v = uint2{pack2(o[dh][4 * a] * inv, o[dh][4 * a + 1] * inv), pack2(o[dh][4 * a + 2] * inv, o[dh][4 * a + 3] * inv)};
            *(uint2*)(orow + dh * 32 + 8 * a + 4 * hi) = v;
        }
}

template <int CTRL>
__device__ __forceinline__ int dppi(int x) { return __builtin_amdgcn_update_dpp(x, x, CTRL, 0xF, 0xF, false); }
template <int CTRL>
__device__ __forceinline__ float dppf(float x) { return __int_as_float(dppi<CTRL>(__float_as_int(x))); }
__device__ __forceinline__ int row_sum16i(int x) {
    x += dppi<0x128>(x);
    x += dppi<0x124>(x);
    x += dppi<0x122>(x);
    x += dppi<0x121>(x);
    return x;
}
__device__ __forceinline__ float row_sum16f(float x) {
    x += dppf<0x128>(x);
    x += dppf<0x124>(x);
    x += dppf<0x122>(x);
    x += dppf<0x121>(x);
    return x;
}
__device__ __forceinline__ float row_max16f(float x) {
    x = fmaxf(x, dppf<0x128>(x));
    x = fmaxf(x, dppf<0x124>(x));
    x = fmaxf(x, dppf<0x122>(x));
    x = fmaxf(x, dppf<0x121>(x));
    return x;
}
__device__ __forceinline__ u32 sortkey(float f) {
    u32 b = __float_as_uint(f);
    return b ^ ((b >> 31) ? 0xFFFFFFFFu : 0x80000000u);
}

__device__ __forceinline__ void peer_route(unsigned char* ws, int layer, unsigned char* smem) {
    const int tid = tidx(), lane = tid & 63, w = tid >> 6;
    const int grp = lane >> 4, k = lane & 15;
    const u32 ltk = (1u << k) - 1u;
    const u16* pq = (const u16*)(ws + OFF_PQ);
    const u16* skb = (const u16*)(ws + OFF_W + layer * W_LAYER + WO_SK);
    int* eidx = (int*)(ws + OFF_EIDX);
    float* gate = (float*)(ws + OFF_GATE);
    float* tvc = (float*)(smem + w * 4096);
    int* tic = (int*)(smem + w * 4096 + 2048);
    const int nunits = NTOK / 16;
    for (int unit = bidx() * 4 + w; unit < nunits; unit += gdim() * 4) {
        const int tok0 = unit * 16;
        for (int h = 0; h < 8; ++h) {
            for (int half = 0; half < 2; ++half) {
                bf16x8 af[4];
#pragma unroll
                for (int ks = 0; ks < 4; ++ks)
                    af[ks] = *(const bf16x8*)(pq + (long)(tok0 + k) * 2048 + h * 256 + half * 128 + ks * 32 + grp * 8);
                float sc[8][4];
                u32 u[8][4];
#pragma unroll
                for (int nt = 0; nt < 8; ++nt) {
                    f32x4 acc = f32x4{0.f, 0.f, 0.f, 0.f};
#pragma unroll
                    for (int ks = 0; ks < 4; ++ks) {
                        bf16x8 bfr = *(const bf16x8*)(skb + (size_t)half * 128 * 128 + (size_t)(nt * 16 + k) * 128 + ks * 32 + grp * 8);
                        acc = __builtin_amdgcn_mfma_f32_16x16x32_bf16(af[ks], bfr, acc, 0, 0, 0);
                    }
#pragma unroll
                    for (int i = 0; i < 4; ++i) { sc[nt][i] = acc[i]; u[nt][i] = sortkey(acc[i]); }
                }
                u32 K[4] = {0u, 0u, 0u, 0u};
                for (int bit = 31; bit >= 0; --bit) {
                    int packed = 0;
#pragma unroll
                    for (int i = 0; i < 4; ++i) {
                        const u32 cand = K[i] | (1u << bit);
                        int c = 0;
#pragma unroll
                        for (int nt = 0; nt < 8; ++nt) c += (u[nt][i] >= cand) ? 1 : 0;
                        packed |= c << (8 * i);
                    }
                    packed = row_sum16i(packed);
#pragma unroll
                    for (int i = 0; i < 4; ++i)
                        if (((packed >> (8 * i)) & 0xFF) >= 16) K[i] |= (1u << bit);
                }
                int need[4];
                {
                    int packed = 0;
#pragma unroll
                    for (int i = 0; i < 4; ++i) {
                        int c = 0;
#pragma unroll
                        for (int nt = 0; nt < 8; ++nt) c += (u[nt][i] > K[i]) ? 1 : 0;
                        packed |= c << (8 * i);
                    }
                    packed = row_sum16i(packed);
#pragma unroll
                    for (int i = 0; i < 4; ++i) need[i] = 16 - ((packed >> (8 * i)) & 0xFF);
                }
#pragma unroll
                for (int i = 0; i < 4; ++i) {
                    int ebase = 0, pbase = 0;
                    const int tok = 4 * grp + i;
#pragma unroll
                    for (int nt = 0; nt < 8; ++nt) {
                        const bool eq = (u[nt][i] == K[i]);
                        const u32 emg = (u32)(__ballot(eq) >> (lane & 48)) & 0xFFFFu;
                        const int erank = ebase + __popc(emg & ltk);
                        const bool take = (u[nt][i] > K[i]) || (eq && erank < need[i]);
                        ebase += __popc(emg);
                        const u32 tmg = (u32)(__ballot(take) >> (lane & 48)) & 0xFFFFu;
                        const int pos = pbase + __popc(tmg & ltk);
                        if (take) {
                            tvc[(half * 16 + tok) * 16 + pos] = sc[nt][i];
                            tic[(half * 16 + tok) * 16 + pos] = nt * 16 + k;
                        }
                        pbase += __popc(tmg);
                    }
                }
            }
            WAVE_SYNC();
            for (int pass = 0; pass < 4; ++pass) {
                const int tok = 4 * pass + grp;
                const float v1 = tvc[(0 * 16 + tok) * 16 + k];
                const int i1 = tic[(0 * 16 + tok) * 16 + k];
                float c[16];
                u32 uc[16];
#pragma unroll
                for (int r4 = 0; r4 < 4; ++r4) {
                    float4 v2 = *(const float4*)(tvc + (1 * 16 + tok) * 16 + r4 * 4);
                    c[r4 * 4 + 0] = v1 + v2.x;
                    c[r4 * 4 + 1] = v1 + v2.y;
                    c[r4 * 4 + 2] = v1 + v2.z;
                    c[r4 * 4 + 3] = v1 + v2.w;
                }
                float mxl = c[0];
#pragma unroll
                for (int r = 0; r < 16; ++r) { uc[r] = sortkey(c[r]); mxl = fmaxf(mxl, c[r]); }
                const float mx = row_max16f(mxl);
                u32 Kc = 0u;
                for (int bit = 31; bit >= 0; --bit) {
                    const u32 cand = Kc | (1u << bit);
                    int cn = 0;
#pragma unroll
                    for (int r = 0; r < 16; ++r) cn += (uc[r] >= cand) ? 1 : 0;
                    cn = row_sum16i(cn);
                    if (cn >= 16) Kc = cand;
                }
                int cg = 0;
#pragma unroll
                for (int r = 0; r < 16; ++r) cg += (uc[r] > Kc) ? 1 : 0;
                cg = row_sum16i(cg);
                const int needc = 16 - cg;
                bool take[16];
                float ex[16];
                float sl = 0.f;
                int ebase = 0;
#pragma unroll
                for (int r = 0; r < 16; ++r) {
                    const bool eq = (uc[r] == Kc);
                    const u32 emg = (u32)(__ballot(eq) >> (lane & 48)) & 0xFFFFu;
                    const int erank = ebase + __popc(emg & ltk);
                    take[r] = (uc[r] > Kc) || (eq && erank < needc);
                    ebase += __popc(emg);
                    ex[r] = take[r] ? __expf(c[r] - mx) : 0.f;
                    sl += ex[r];
                }
                const float inv = 1.0f / row_sum16f(sl);
                int pbase = 0;
                const long obase = (long)(tok0 + tok) * 128 + h * 16;
#pragma unroll
                for (int r = 0; r < 16; ++r) {
                    const u32 tmg = (u32)(__ballot(take[r]) >> (lane & 48)) & 0xFFFFu;
                    const int pos = pbase + __popc(tmg & ltk);
                    if (take[r]) {
                        eidx[obase + pos] = i1 * 128 + tic[(1 * 16 + tok) * 16 + r];
                        gate[obase + pos] = ex[r] * inv;
                    }
                    pbase += __popc(tmg);
                }
            }
            WAVE_SYNC();
        }
    }
}

__device__ __forceinline__ void peer_experts(unsigned char* ws, float* xout) {
    const int lane = tidx() & 63, w = tidx() >> 6;
    const u16* hbuf = (const u16*)(ws + OFF_H);
    const u16* ub = (const u16*)(ws + OFF_UB);
    const u16* vb = (const u16*)(ws + OFF_VB);
    const int* eidx = (const int*)(ws + OFF_EIDX);
    const float* gate = (const float*)(ws + OFF_GATE);
    for (int t = bidx() * 4 + w; t < NTOK; t += gdim() * 4) {
        uint4 h0 = *(const uint4*)(hbuf + (long)t * 1024 + lane * 8);
        uint4 h1 = *(const uint4*)(hbuf + (long)t * 1024 + 512 + lane * 8);
        float acc[16];
#pragma unroll
        for (int i = 0; i < 16; ++i) acc[i] = 0.f;
        for (int e0 = 0; e0 < 128; e0 += 4) {
            int id[4];
            float gg[4];
            uint4 u0[4], u1[4], v0[4], v1[4];
#pragma unroll
            for (int k = 0; k < 4; ++k) {
                id[k] = __builtin_amdgcn_readfirstlane(eidx[(long)t * 128 + e0 + k]);
                gg[k] = gate[(long)t * 128 + e0 + k];
                const u16* ur = ub + (long)id[k] * 1024;
                const u16* vr = vb + (long)id[k] * 1024;
                u0[k] = *(const uint4*)(ur + lane * 8);
                u1[k] = *(const uint4*)(ur + 512 + lane * 8);
                v0[k] = *(const uint4*)(vr + lane * 8);
                v1[k] = *(const uint4*)(vr + 512 + lane * 8);
            }
#pragma unroll
            for (int k = 0; k < 4; ++k) {
                float d = 0.f;
                d = dot2(u0[k].x, h0.x, d); d = dot2(u0[k].y, h0.y, d); d = dot2(u0[k].z, h0.z, d); d = dot2(u0[k].w, h0.w, d);
                d = dot2(u1[k].x, h1.x, d); d = dot2(u1[k].y, h1.y, d); d = dot2(u1[k].z, h1.z, d); d = dot2(u1[k].w, h1.w, d);
                d = wsum(d);
                float a = gelu_tanh(d) * gg[k];
                acc[0] += a * bf_lo(v0[k].x); acc[1] += a * bf_hi(v0[k].x);
                acc[2] += a * bf_lo(v0[k].y); acc[3] += a * bf_hi(v0[k].y);
                acc[4] += a * bf_lo(v0[k].z); acc[5] += a * bf_hi(v0[k].z);
                acc[6] += a * bf_lo(v0[k].w); acc[7] += a * bf_hi(v0[k].w);
                acc[8] += a * bf_lo(v1[k].x); acc[9] += a * bf_hi(v1[k].x);
                acc[10] += a * bf_lo(v1[k].y); acc[11] += a * bf_hi(v1[k].y);
                acc[12] += a * bf_lo(v1[k].z); acc[13] += a * bf_hi(v1[k].z);
                acc[14] += a * bf_lo(v1[k].w); acc[15] += a * bf_hi(v1[k].w);
            }
        }
        float* xr = xout + (long)t * 1024;
        float4 a0 = *(float4*)(xr + lane * 8), a1 = *(float4*)(xr + lane * 8 + 4);
        float4 b0 = *(float4*)(xr + 512 + lane * 8), b1 = *(float4*)(xr + 512 + lane * 8 + 4);
        a0.x += acc[0]; a0.y += acc[1]; a0.z += acc[2]; a0.w += acc[3];
        a1.x += acc[4]; a1.y += acc[5]; a1.z += acc[6]; a1.w += acc[7];
        b0.x += acc[8]; b0.y += acc[9]; b0.z += acc[10]; b0.w += acc[11];
        b1.x += acc[12]; b1.y += acc[13]; b1.z += acc[14]; b1.w += acc[15];
        *(float4*)(xr + lane * 8) = a0;
        *(float4*)(xr + lane * 8 + 4) = a1;
        *(float4*)(xr + 512 + lane * 8) = b0;
        *(float4*)(xr + 512 + lane * 8 + 4) = b1;
    }
}

__device__ __forceinline__ void phase_prep(const Params& P, unsigned char* smem) {
    unsigned char* ws = opq(P.ws);
    const long gtid = (long)bidx() * 256 + tidx();
    const long gthreads = (long)gdim() * 256;
    for (int l = 0; l < 2; ++l) {
        unsigned char* wl = ws + OFF_W + l * W_LAYER;
        float* tile = (float*)smem;
        transpose_cvt(P.w_in + (size_t)l * 1024 * IN_COLS, (u16*)(wl + WO_WIN), 1024, IN_COLS, tile);
        for (int c = 0; c < 2; ++c) {
            transpose_cvt(P.cmp_w1 + ((size_t)l * 2 + c) * 2048 * 256, (u16*)(wl + WO_W1) + (size_t)c * 256 * 2048, 2048, 256, tile);
            transpose_cvt(P.cmp_w2 + ((size_t)l * 2 + c) * 256 * 64, (u16*)(wl + WO_W2) + (size_t)c * 64 * 256, 256, 64, tile);
        }
        transpose_cvt(P.w_a + (size_t)l * 512 * 1024, (u16*)(wl + WO_WA), 512, 1024, tile);
        transpose_cvt(P.w_b + (size_t)l * 512 * 1024, (u16*)(wl + WO_WB), 512, 1024, tile);
        transpose_cvt(P.w_out + (size_t)l * 1024 * 1024, (u16*)(wl + WO_WO), 1024, 1024, tile);
        transpose_cvt(P.peer_wq + (size_t)l * 1024 * 2048, (u16*)(wl + WO_WQ), 1024, 2048, tile);
        transpose_cvt(P.ple_w + (size_t)l * 256 * 1024, (u16*)(wl + WO_PW), 256, 1024, tile);
        transpose_cvt(P.ple_gw + (size_t)l * 1024 * 1024, (u16*)(wl + WO_PG), 1024, 1024, tile);
        cvt_f32_bf16(P.peer_sk + (size_t)l * 2 * 128 * 128, (u16*)(wl + WO_SK), 2 * 128 * 128);
        if (gtid < 512) {
            int c = (int)gtid >> 8, col = (int)gtid & 255;
            const float* pos = P.cmp_pos + ((size_t)l * 2 + c) * 2048;
            const float* w1 = P.cmp_w1 + ((size_t)l * 2 + c) * 2048 * 256;
            float s = 0.f;
            for (int k = 0; k < 2048; ++k) s += pos[k] * w1[(size_t)k * 256 + col];
            ((float*)(wl + WO_CB))[c * 256 + col] = s;
        }
    }
    {
        float* ropec = (float*)(ws + OFF_ROPE);
        float* ropes = ropec + (size_t)NTOK * 8;
        for (long i = gtid; i < (long)NTOK * 8; i += gthreads) {
            int t = (int)(i >> 3), k = (int)(i & 7);
            double inv = pow(500000.0, -(double)k / 8.0);
            double ang = (double)P.positions[t] * inv;
            ropec[i] = (float)cos(ang);
            ropes[i] = (float)sin(ang);
        }
    }
    rms_rows(P.x, P.attn_norm, (u16*)(ws + OFF_H), nullptr, nullptr);
}

__device__ __forceinline__ void phase_g1(const Params& P, int layer, unsigned char* smem) {
    unsigned char* ws = opq(P.ws);
    u16* proj = (u16*)(ws + OFF_PROJ);
    gemm_phase<0>((const u16*)(ws + OFF_H), 1024, (const u16*)(ws + OFF_W + layer * W_LAYER + WO_WIN), 1024, NTOK, IN_COLS, 1024, (u16*)smem,
                  [=](int row, int col, float v) { proj[(long)row * IN_COLS + col] = f2bf(v); });
}

__device__ __forceinline__ void phase_c1(const Params& P, int layer, unsigned char* smem) {
    unsigned char* ws = opq(P.ws);
    unsigned char* wl = ws + OFF_W + layer * W_LAYER;
    const u16* proj = (const u16*)(ws + OFF_PROJ);
    u16* chid = (u16*)(ws + OFF_CHID);
    const float* cbias = (const float*)(wl + WO_CB);
    for (int c = 0; c < 2; ++c) {
        u16* ch = chid + (size_t)c * CROWS * 256;
        const float* cb = cbias + c * 256;
        gemm_phase<1>(proj + C_NKV + c * 128, 0, (const u16*)(wl + WO_W1) + (size_t)c * 256 * 2048, 2048, CROWS, 256, 2048, (u16*)smem,
                      [=](int row, int col, float v) { ch[(long)row * 256 + col] = f2bf(gelu_tanh(v + cb[col])); });
    }
}

__device__ __forceinline__ void phase_c2(const Params& P, int layer, unsigned char* smem) {
    unsigned char* ws = opq(P.ws);
    unsigned char* wl = ws + OFF_W + layer * W_LAYER;
    const u16* chid = (const u16*)(ws + OFF_CHID);
    float* cbuf = (float*)(ws + OFF_CBUF);
    for (int c = 0; c < 2; ++c) {
        float* cbo = cbuf + (size_t)c * CROWS * 64;
        gemm_phase<0>(chid + (size_t)c * CROWS * 256, 256, (const u16*)(wl + WO_W2) + (size_t)c * 64 * 256, 256, CROWS, 64, 256, (u16*)smem,
                      [=](int row, int col, float v) { cbo[(long)row * 64 + col] = v; });
    }
}

__device__ __forceinline__ void phase_c3(const Params& P, int layer) {
    unsigned char* ws = opq(P.ws);
    const int lane = tidx() & 63, w = tidx() >> 6;
    const float* cbuf = (const float*)(ws + OFF_CBUF);
    u16* kcb = (u16*)(ws + OFF_KCB);
    u16* vcb = (u16*)(ws + OFF_VCB);
    const float* ropec = (const float*)(ws + OFF_ROPE);
    const float* ropes = ropec + (size_t)NTOK * 8;
    const float* gain = P.nsa_gain + layer * 256 + 64;
    for (int r = bidx() * 4 + w; r < 2 * CROWS; r += gdim() * 4) {
        int c = r / CROWS, rr = r - c * CROWS;
        int b = rr / (NCMP * 2);
        int rem = rr - b * (NCMP * 2);
        int n = rem >> 1, g = rem & 1;
        float v = cbuf[(size_t)r * 64 + lane];
        size_t o = ((size_t)(b * 2 + g) * 256 + n) * 64 + lane;
        if (c == 0) {
            float ss = wsum(v * v);
            v = v * rsqrtf(ss * (1.0f / 64.0f) + EPS) * gain[lane];
            float pv = __shfl_xor(v, 8);
            if (lane < 16) {
                long tt = (long)b * SEQ + 31 + 16 * n;
                float cs = ropec[tt * 8 + (lane & 7)], sn = ropes[tt * 8 + (lane & 7)];
                v = (lane < 8) ? (v * cs - pv * sn) : (v * cs + pv * sn);
            }
            kcb[o] = f2bf(v);
        } else {
            vcb[o] = f2bf(v);
        }
    }
}

__device__ __forceinline__ int balance4(int x, int seg) {
    const int k = x / seg, r = x - k * seg;
    return k == 0 ? r : (k == 1 ? 4 * seg - 1 - r : (k == 2 ? seg + r : 3 * seg - 1 - r));
}
__device__ __forceinline__ void phase_att_a(const Params& P, unsigned char* smem) {
    unsigned char* ws = opq(P.ws);
    for (int u = bidx(); u < NTOK / 4; u += gdim()) dsa_select_unit(ws, u, smem);
}
__device__ __forceinline__ void phase_att_b(const Params& P, unsigned char* smem) {
    {
        unsigned char* ws = opq(P.ws);
        for (int u = bidx(); u < 2048; u += gdim()) dsa_attn_unit(ws, u & 7, balance4(u >> 3, 64), smem);
    }
    {
        unsigned char* ws = opq(P.ws);
        for (int u = bidx(); u < 2048; u += gdim()) nsa_unit(ws, (u & 15) >> 1, u & 1, balance4(u >> 4, 32), smem);
    }
}

__device__ __forceinline__ void phase_merge(const Params& P, int layer, unsigned char* smem) {
    unsigned char* ws = opq(P.ws);
    unsigned char* wl = ws + OFF_W + layer * W_LAYER;
    const u16* proj = (const u16*)(ws + OFF_PROJ);
    u16* hbuf = (u16*)(ws + OFF_H);
    const u16* ya = (const u16*)(ws + OFF_YAB);
    const u16* yb = ya + (size_t)NTOK * 512;
    gemm_phase<0>(ya, 512, (const u16*)(wl + WO_WA), 512, NTOK, 1024, 512, (u16*)smem, [=](int row, int col, float v) {
        float ga = bf2f(proj[(long)row * IN_COLS + C_MG + col]);
        hbuf[(long)row * 1024 + col] = f2bf(ga * v);
    });
    gemm_phase<0>(yb, 512, (const u16*)(wl + WO_WB), 512, NTOK, 1024, 512, (u16*)smem, [=](int row, int col, float v) {
        float gb = bf2f(proj[(long)row * IN_COLS + C_MG + 1024 + col]);
        long o = (long)row * 1024 + col;
        hbuf[o] = f2bf(bf2f(hbuf[o]) + gb * v);
    });
}

__device__ __forceinline__ void phase_outproj(const Params& P, int layer, unsigned char* smem) {
    unsigned char* ws = opq(P.ws);
    unsigned char* wl = ws + OFF_W + layer * W_LAYER;
    float* out = opq(P.out);
    const float* xin = (layer == 0) ? P.x : (const float*)out;
    gemm_phase<0>((const u16*)(ws + OFF_H), 1024, (const u16*)(wl + WO_WO), 1024, NTOK, 1024, 1024, (u16*)smem, [=](int row, int col, float v) {
        long o = (long)row * 1024 + col;
        out[o] = xin[o] + v;
    });
    cvt_f32_bf16(P.peer_u + (size_t)layer * NEXP * 1024, (u16*)(ws + OFF_UB), (long)NEXP * 1024);
    cvt_f32_bf16(P.peer_v + (size_t)layer * NEXP * 1024, (u16*)(ws + OFF_VB), (long)NEXP * 1024);
}

__device__ __forceinline__ void phase_pq(const Params& P, int layer, unsigned char* smem) {
    unsigned char* ws = opq(P.ws);
    unsigned char* wl = ws + OFF_W + layer * W_LAYER;
    u16* pq = (u16*)(ws + OFF_PQ);
    u16* eb = (u16*)(ws + OFF_YAB);
    gemm_phase<0>((const u16*)(ws + OFF_H), 1024, (const u16*)(wl + WO_WQ), 1024, NTOK, 2048, 1024, (u16*)smem,
                  [=](int row, int col, float v) { pq[(long)row * 2048 + col] = f2bf(v); });
    gemm_phase<2>(P.p + (size_t)layer * NTOK * 256, 256, (const u16*)(wl + WO_PW), 256, NTOK, 1024, 256, (u16*)smem,
                  [=](int row, int col, float v) { eb[(long)row * 1024 + col] = f2bf(v); });
}

__device__ __forceinline__ void phase_final(const Params& P, int layer, unsigned char* smem) {
    unsigned char* ws = opq(P.ws);
    unsigned char* wl = ws + OFF_W + layer * W_LAYER;
    float* out = opq(P.out);
    const u16* eb = (const u16*)(ws + OFF_YAB);
    const float* rstde = (const float*)(ws + OFF_RSTDE);
    const float* pn = P.ple_norm + layer * 1024;
    gemm_phase<0>((const u16*)(ws + OFF_H), 1024, (const u16*)(wl + WO_PG), 1024, NTOK, 1024, 1024, (u16*)smem, [=](int row, int col, float v) {
        long o = (long)row * 1024 + col;
        out[o] = out[o] + sigmoidf(v) * (bf2f(eb[o]) * rstde[row] * pn[col]);
    });
}

#ifndef PROBE_MASK
#define PROBE_MASK 0ull
#endif
#ifndef PROBE_MULT
#define PROBE_MULT 4
#endif
#define GSYNC(id)                                                                          \
    do {                                                                                   \
        grid.sync();                                                                       \
        if (PROBE_MASK != 0ull) {                                                          \
            unsigned long long now_ = __builtin_amdgcn_s_memrealtime();                    \
            if ((PROBE_MASK >> (id)) & 1ull) tsel += now_ - tprev;                         \
            tprev = now_;                                                                  \
        }                                                                                  \
    } while (0)

__global__ void __launch_bounds__(256, 2) fwd_kernel(Params P) {
    cg::grid_group grid = cg::this_grid();
    extern __shared__ __attribute__((aligned(16))) unsigned char smem[];
    unsigned long long tprev = 0, tsel = 0;
    if (PROBE_MASK != 0ull) tprev = __builtin_amdgcn_s_memrealtime();
    phase_prep(P, smem);
    GSYNC(0);
    for (int layer = 0; layer < 2; ++layer) {
        const int pb = 1 + 16 * layer;
        phase_g1(P, layer, smem);
        GSYNC(pb + 0);
        post_proj(opq(P.ws), P.nsa_gain + layer * 256, P.dsa_gain + layer * 128, smem);
        GSYNC(pb + 1);
        phase_c1(P, layer, smem);
        GSYNC(pb + 2);
        phase_c2(P, layer, smem);
        GSYNC(pb + 3);
        phase_c3(P, layer);
        GSYNC(pb + 4);
        phase_att_a(P, smem);
        GSYNC(pb + 15);
        phase_att_b(P, smem);
        GSYNC(pb + 5);
        phase_merge(P, layer, smem);
        GSYNC(pb + 6);
        phase_outproj(P, layer, smem);
        GSYNC(pb + 7);
        {
            unsigned char* ws = opq(P.ws);
            rms_rows(opq(P.out), P.ffn_norm + layer * 1024, (u16*)(ws + OFF_H), nullptr, nullptr);
        }
        GSYNC(pb + 8);
        phase_pq(P, layer, smem);
        GSYNC(pb + 9);
        peer_route(opq(P.ws), layer, smem);
        GSYNC(pb + 10);
        peer_experts(opq(P.ws), opq(P.out));
        GSYNC(pb + 11);
        {
            unsigned char* ws = opq(P.ws);
            rms_rows(opq(P.out), nullptr, (u16*)(ws + OFF_H), (const u16*)(ws + OFF_YAB), (float*)(ws + OFF_RSTDE));
        }
        GSYNC(pb + 12);
        phase_final(P, layer, smem);
        GSYNC(pb + 13);
        if (layer == 0) {
            unsigned char* ws = opq(P.ws);
            rms_rows(opq(P.out), P.attn_norm + 1024, (u16*)(ws + OFF_H), nullptr, nullptr);
            GSYNC(pb + 14);
        }
    }
    if (PROBE_MASK != 0ull) {
        if (blockIdx.x == 0 && threadIdx.x == 0) {
            unsigned long long t0 = __builtin_amdgcn_s_memrealtime();
            while (__builtin_amdgcn_s_memrealtime() - t0 < (unsigned long long)PROBE_MULT * tsel) __builtin_amdgcn_s_sleep(32);
        }
    }
}

extern "C" void kernel_launch(void* const* d_in, const int* in_sizes, int n_in, void* d_out, int out_size, void* d_ws, size_t ws_size,
                              hipStream_t stream) {
    static int grid_blocks = 0;
    if (!grid_blocks) {
        int dev = 0, cus = 0, per_cu = 0;
        (void)hipGetDevice(&dev);
        (void)hipDeviceGetAttribute(&cus, hipDeviceAttributeMultiprocessorCount, dev);
        (void)hipFuncSetAttribute((const void*)fwd_kernel, hipFuncAttributeMaxDynamicSharedMemorySize, LDS_BYTES);
        (void)hipOccupancyMaxActiveBlocksPerMultiprocessor(&per_cu, fwd_kernel, 256, LDS_BYTES);
        if (per_cu > 2) per_cu = 2;
        if (per_cu < 1) per_cu = 1;
        grid_blocks = cus * per_cu;
        if (ws_size < WS_END) fprintf(stderr, "kernel_launch: workspace too small: %zu < %zu\n", ws_size, (size_t)WS_END);
    }
    Params P{};
    P.x = (const float*)d_in[0];
    P.p = (const float*)d_in[1];
    P.positions = (const int*)d_in[2];
    P.attn_norm = (const float*)d_in[3];
    P.w_in = (const float*)d_in[4];
    P.nsa_gain = (const float*)d_in[5];
    P.cmp_pos = (const float*)d_in[6];
    P.cmp_w1 = (const float*)d_in[7];
    P.cmp_w2 = (const float*)d_in[8];
    P.dsa_gain = (const float*)d_in[9];
    P.w_a = (const float*)d_in[10];
    P.w_b = (const float*)d_in[11];
    P.w_out = (const float*)d_in[12];
    P.ffn_norm = (const float*)d_in[13];
    P.peer_wq = (const float*)d_in[14];
    P.peer_sk = (const float*)d_in[15];
    P.peer_u = (const float*)d_in[16];
    P.peer_v = (const float*)d_in[17];
    P.ple_w = (const float*)d_in[18];
    P.ple_gw = (const float*)d_in[19];
    P.ple_norm = (const float*)d_in[20];
    P.out = (float*)d_out;
    P.ws = (unsigned char*)d_ws;
    void* args[] = {&P};
    hipError_t e = hipLaunchCooperativeKernel((void*)fwd_kernel, dim3(grid_blocks), dim3(256), args, LDS_BYTES, stream);
    if (e != hipSuccess) fprintf(stderr, "cooperative launch failed: %s (grid %d)\n", hipGetErrorString(e), grid_blocks);
}
```

```cpp
#include <hip/hip_runtime.h>
#include <hip/hip_cooperative_groups.h>
#include <cstdio>
#include <cstdint>
namespace cg = cooperative_groups;

typedef unsigned short u16;
typedef unsigned int u32;
typedef unsigned long long u64;
using bf16x8 = __attribute__((ext_vector_type(8))) short;
using f32x4 = __attribute__((ext_vector_type(4))) float;
using f32x16 = __attribute__((ext_vector_type(16))) float;
typedef __bf16 bf16x2_t __attribute__((ext_vector_type(2)));

constexpr int D_MODEL = 1024, BATCH = 8, SEQ = 4096, NTOK = BATCH * SEQ;
constexpr int IN_COLS = 4576;
constexpr int C_NQ = 0, C_NKV = 512, C_NG = 1280, C_DQ = 1304, C_DKV = 1816, C_IQ = 1944, C_IK = 2456, C_IW = 2520, C_MG = 2528;
constexpr int NCMP = 255;
constexpr int CROWS = BATCH * NCMP * 2;
constexpr int NEXP = 16384;
constexpr float EPS = 1e-6f;

constexpr size_t AL(size_t x) { return (x + 255) & ~(size_t)255; }
constexpr size_t WO_WIN = 0;
constexpr size_t WO_W1 = WO_WIN + AL((size_t)IN_COLS * 1024 * 2);
constexpr size_t WO_W2 = WO_W1 + AL((size_t)2 * 256 * 2048 * 2);
constexpr size_t WO_WA = WO_W2 + AL((size_t)2 * 64 * 256 * 2);
constexpr size_t WO_WB = WO_WA + AL((size_t)1024 * 512 * 2);
constexpr size_t WO_WO = WO_WB + AL((size_t)1024 * 512 * 2);
constexpr size_t WO_WQ = WO_WO + AL((size_t)1024 * 1024 * 2);
constexpr size_t WO_PW = WO_WQ + AL((size_t)2048 * 1024 * 2);
constexpr size_t WO_PG = WO_PW + AL((size_t)1024 * 256 * 2);
constexpr size_t WO_SK = WO_PG + AL((size_t)1024 * 1024 * 2);
constexpr size_t WO_CB = WO_SK + AL((size_t)2 * 128 * 128 * 2);
constexpr size_t W_LAYER = WO_CB + AL((size_t)2 * 256 * 4);

constexpr size_t OFF_W = 0;
constexpr size_t OFF_ROPE = OFF_W + 2 * W_LAYER;
constexpr size_t OFF_H = OFF_ROPE + AL((size_t)NTOK * 16 * 4);
constexpr size_t OFF_PROJ = OFF_H + AL((size_t)NTOK * 1024 * 2);
constexpr size_t OFF_YAB = OFF_PROJ + AL((size_t)NTOK * IN_COLS * 2);
constexpr size_t OFF_CHID = OFF_YAB + AL((size_t)NTOK * 1024 * 2);
constexpr size_t OFF_CBUF = OFF_CHID + AL((size_t)2 * CROWS * 256 * 2);
constexpr size_t OFF_KCB = OFF_CBUF + AL((size_t)2 * CROWS * 64 * 4);
constexpr size_t OFF_VCB = OFF_KCB + AL((size_t)BATCH * 2 * 256 * 64 * 2);
constexpr size_t OFF_RSTDE = OFF_VCB + AL((size_t)BATCH * 2 * 256 * 64 * 2);
constexpr size_t OFF_BITS = OFF_RSTDE + AL((size_t)NTOK * 4);
constexpr size_t OFF_BAR = OFF_BITS + AL((size_t)NTOK * 64 * 8);
constexpr size_t WS_END = OFF_BAR + AL(3456 * 4);
constexpr size_t OFF_PQ = OFF_PROJ;
constexpr size_t OFF_UB = OFF_PQ + (size_t)NTOK * 2048 * 2;
constexpr size_t OFF_VB = OFF_UB + (size_t)NEXP * 1024 * 2;
constexpr size_t OFF_EIDX = OFF_VB + (size_t)NEXP * 1024 * 2;
constexpr size_t OFF_GATE = OFF_EIDX + (size_t)NTOK * 128 * 4;
constexpr size_t OFF_ESC = OFF_GATE + (size_t)NTOK * 128 * 4;
static_assert(OFF_ESC + (size_t)2 * NEXP * 4 <= OFF_YAB, "alias overflow");

constexpr int LDS_BYTES = 65536 + 2048;

struct Params {
    const float* x; const float* p; const int* positions;
    const float* attn_norm; const float* w_in; const float* nsa_gain; const float* cmp_pos; const float* cmp_w1; const float* cmp_w2;
    const float* dsa_gain; const float* w_a; const float* w_b; const float* w_out; const float* ffn_norm; const float* peer_wq;
    const float* peer_sk; const float* peer_u; const float* peer_v; const float* ple_w; const float* ple_gw; const float* ple_norm;
    float* out; unsigned char* ws;
};

__device__ __forceinline__ u16 f2bf(float f) {
    u32 u = __float_as_uint(f);
    u32 r = u + 0x7FFFu + ((u >> 16) & 1u);
    return (u16)(r >> 16);
}
__device__ __forceinline__ float bf2f(u16 h) { return __uint_as_float(((u32)h) << 16); }
__device__ __forceinline__ float bf_lo(u32 w) { return __uint_as_float(w << 16); }
__device__ __forceinline__ float bf_hi(u32 w) { return __uint_as_float(w & 0xFFFF0000u); }
__device__ __forceinline__ u32 pack2(float a, float b) {
    bf16x2_t v = {(__bf16)a, (__bf16)b};
    return __builtin_bit_cast(u32, v);
}
__device__ __forceinline__ float dot2(u32 a, u32 b, float c) {
    return __builtin_amdgcn_fdot2_f32_bf16(__builtin_bit_cast(bf16x2_t, a), __builtin_bit_cast(bf16x2_t, b), c, false);
}
__device__ __forceinline__ float wsum(float v) {
#pragma unroll
    for (int o = 32; o > 0; o >>= 1) v += __shfl_xor(v, o);
    return v;
}
__device__ __forceinline__ float wmax(float v) {
#pragma unroll
    for (int o = 32; o > 0; o >>= 1) v = fmaxf(v, __shfl_xor(v, o));
    return v;
}
__device__ __forceinline__ int wsumi(int v) {
#pragma unroll
    for (int o = 32; o > 0; o >>= 1) v += __shfl_xor(v, o);
    return v;
}
__device__ __forceinline__ float sigmoidf(float x) { return 1.0f / (1.0f + __expf(-x)); }
__device__ __forceinline__ float gelu_tanh(float x) {
    float u = 0.7978845608028654f * (x + 0.044715f * x * x * x);
    return 0.5f * x * (1.0f + tanhf(u));
}
#define WAVE_SYNC() asm volatile("s_waitcnt lgkmcnt(0)" ::: "memory")
template <class T>
__device__ __forceinline__ T* opq(T* p) {
    asm volatile("" : "+s"(p));
    return p;
}
__device__ __forceinline__ int tidx() {
    int t = threadIdx.x;
    asm volatile("" : "+v"(t));
    return t;
}
__device__ __forceinline__ int bidx() {
    int b = blockIdx.x;
    asm volatile("" : "+s"(b));
    return b;
}
__device__ __forceinline__ int gdim() {
    int g = gridDim.x;
    asm volatile("" : "+s"(g));
    return g;
}

template <int AMODE, class Epi>
__device__ __forceinline__ void gemm_tile(const void* __restrict__ Ap, long lda, const u16* __restrict__ BT, long ldb, int M, int N, int K,
                                          int m0, int n0, u16* lds, Epi epi) {
    const int tid = tidx(), lane = tid & 63, w = tid >> 6;
    const int wm = w >> 1, wn = w & 1;
    u16* As = lds;
    u16* Bs = lds + 128 * 40;
    f32x4 acc[4][4];
#pragma unroll
    for (int i = 0; i < 4; ++i)
#pragma unroll
        for (int j = 0; j < 4; ++j) acc[i][j] = f32x4{0.f, 0.f, 0.f, 0.f};

    const int lkc = tid & 3;
    const int lrow0 = tid >> 2, lrow1 = 64 + (tid >> 2);
    long abase0, abase1, bbase0, bbase1;
    {
        int gr0 = m0 + lrow0, gr1 = m0 + lrow1;
        if (gr0 > M - 1) gr0 = M - 1;
        if (gr1 > M - 1) gr1 = M - 1;
        if (AMODE == 1) {
            int b = gr0 / (NCMP * 2);
            int rem = gr0 - b * (NCMP * 2);
            abase0 = ((long)b * SEQ + 16 * (rem >> 1)) * IN_COLS + (rem & 1) * 64;
            b = gr1 / (NCMP * 2);
            rem = gr1 - b * (NCMP * 2);
            abase1 = ((long)b * SEQ + 16 * (rem >> 1)) * IN_COLS + (rem & 1) * 64;
        } else {
            abase0 = (long)gr0 * lda;
            abase1 = (long)gr1 * lda;
        }
        int gn0 = n0 + lrow0, gn1 = n0 + lrow1;
        if (gn0 > N - 1) gn0 = N - 1;
        if (gn1 > N - 1) gn1 = N - 1;
        bbase0 = (long)gn0 * ldb;
        bbase1 = (long)gn1 * ldb;
    }
    uint4 ra0, ra1, rb0, rb1;
#define GEMM_LOAD_A(dst, abase, k)                                                                          \
    do {                                                                                                    \
        if (AMODE == 0) {                                                                                   \
            dst = *(const uint4*)((const u16*)Ap + (abase) + (k));                                          \
        } else if (AMODE == 1) {                                                                            \
            dst = *(const uint4*)((const u16*)Ap + (abase) + (long)((k) >> 6) * IN_COLS + ((k) & 63));      \
        } else {                                                                                            \
            const float* fp_ = (const float*)Ap + (abase) + (k);                                            \
            float4 f0_ = *(const float4*)fp_;                                                               \
            float4 f1_ = *(const float4*)(fp_ + 4);                                                         \
            dst = uint4{pack2(f0_.x, f0_.y), pack2(f0_.z, f0_.w), pack2(f1_.x, f1_.y), pack2(f1_.z, f1_.w)}; \
        }                                                                                                   \
    } while (0)
#define GEMM_LOAD_ALL(k0)                              \
    do {                                               \
        const int k_ = (k0) + lkc * 8;                 \
        GEMM_LOAD_A(ra0, abase0, k_);                  \
        GEMM_LOAD_A(ra1, abase1, k_);                  \
        rb0 = *(const uint4*)(BT + bbase0 + k_);       \
        rb1 = *(const uint4*)(BT + bbase1 + k_);       \
    } while (0)
    const int nk = K / 32;
    GEMM_LOAD_ALL(0);
    for (int kt = 0; kt < nk; ++kt) {
        *(uint4*)(As + lrow0 * 40 + lkc * 8) = ra0;
        *(uint4*)(As + lrow1 * 40 + lkc * 8) = ra1;
        *(uint4*)(Bs + lrow0 * 40 + lkc * 8) = rb0;
        *(uint4*)(Bs + lrow1 * 40 + lkc * 8) = rb1;
        __syncthreads();
        if (kt + 1 < nk) GEMM_LOAD_ALL((kt + 1) * 32);
        bf16x8 af[4], bfr[4];
#pragma unroll
        for (int i = 0; i < 4; ++i) {
            af[i] = *(const bf16x8*)(As + (wm * 64 + i * 16 + (lane & 15)) * 40 + (lane >> 4) * 8);
            bfr[i] = *(const bf16x8*)(Bs + (wn * 64 + i * 16 + (lane & 15)) * 40 + (lane >> 4) * 8);
        }
#pragma unroll
        for (int i = 0; i < 4; ++i)
#pragma unroll
            for (int j = 0; j < 4; ++j) acc[i][j] = __builtin_amdgcn_mfma_f32_16x16x32_bf16(af[i], bfr[j], acc[i][j], 0, 0, 0);
        __syncthreads();
    }
#pragma unroll
    for (int i = 0; i < 4; ++i)
#pragma unroll
        for (int j = 0; j < 4; ++j)
#pragma unroll
            for (int r = 0; r < 4; ++r) {
                int row = m0 + wm * 64 + i * 16 + (lane >> 4) * 4 + r;
                int col = n0 + wn * 64 + j * 16 + (lane & 15);
                if (row < M && col < N) epi(row, col, acc[i][j][r]);
            }
}

template <int AMODE, class Epi>
__device__ __forceinline__ void gemm_phase(const void* Ap, long lda, const u16* BT, long ldb, int M, int N, int K, u16* lds, Epi epi) {
    const int tm = (M + 127) / 128, tn = (N + 127) / 128;
    for (int t = bidx(); t < tm * tn; t += gdim()) {
        int im = t / tn, in = t - im * tn;
        gemm_tile<AMODE>(Ap, lda, BT, ldb, M, N, K, im * 128, in * 128, lds, epi);
    }
}

__device__ __forceinline__ void transpose_cvt(const float* __restrict__ src, u16* __restrict__ dst, int K, int N, float* tile) {
    const int tk = K / 64, tn = (N + 63) / 64;
    const int tx = tidx() & 63, ty = tidx() >> 6;
    for (int t = bidx(); t < tk * tn; t += gdim()) {
        int k0 = (t / tn) * 64, n0 = (t % tn) * 64;
#pragma unroll
        for (int r = 0; r < 16; ++r) {
            int k = ty * 16 + r, n = n0 + tx;
            tile[k * 65 + tx] = (n < N) ? src[(long)(k0 + k) * N + n] : 0.f;
        }
        __syncthreads();
#pragma unroll
        for (int r = 0; r < 16; ++r) {
            int nn = ty * 16 + r, n = n0 + nn;
            if (n < N) dst[(long)n * K + k0 + tx] = f2bf(tile[tx * 65 + nn]);
        }
        __syncthreads();
    }
}

__device__ __forceinline__ void cvt_f32_bf16(const float* __restrict__ src, u16* __restrict__ dst, long n) {
    long i = ((long)bidx() * 256 + tidx()) * 8;
    const long stride = (long)gdim() * 256 * 8;
    for (; i < n; i += stride) {
        float4 a = *(const float4*)(src + i);
        float4 b = *(const float4*)(src + i + 4);
        *(uint4*)(dst + i) = uint4{pack2(a.x, a.y), pack2(a.z, a.w), pack2(b.x, b.y), pack2(b.z, b.w)};
    }
}

typedef float f32x2_t __attribute__((ext_vector_type(2)));
__device__ __forceinline__ void cvt_rows_fp8(const float* __restrict__ src, unsigned char* __restrict__ dst, float* __restrict__ scales, int nrows) {
    const int lane = tidx() & 63;
    const int wid = bidx() * 4 + (tidx() >> 6);
    const int nw = gdim() * 4;
    for (int row = wid; row < nrows; row += nw) {
        const float* r = src + (long)row * 1024 + lane * 16;
        float4 q[4];
#pragma unroll
        for (int i = 0; i < 4; ++i) q[i] = *(const float4*)(r + 4 * i);
        float am = 0.f;
#pragma unroll
        for (int i = 0; i < 4; ++i) am = fmaxf(am, fmaxf(fmaxf(fabsf(q[i].x), fabsf(q[i].y)), fmaxf(fabsf(q[i].z), fabsf(q[i].w))));
        am = wmax(am);
        const float inv = am > 0.f ? 448.0f / am : 0.f;
        if (lane == 0) scales[row] = am > 0.f ? am * (1.0f / 448.0f) : 0.f;
        u32 wv[4];
#pragma unroll
        for (int i = 0; i < 4; ++i) {
            int x = 0;
            x = __builtin_amdgcn_cvt_pk_fp8_f32(q[i].x * inv, q[i].y * inv, x, false);
            x = __builtin_amdgcn_cvt_pk_fp8_f32(q[i].z * inv, q[i].w * inv, x, true);
            wv[i] = (u32)x;
        }
        *(uint4*)(dst + (long)row * 1024 + lane * 16) = uint4{wv[0], wv[1], wv[2], wv[3]};
    }
}

__device__ __forceinline__ void rms_rows(const float* __restrict__ x, const float* __restrict__ g, u16* __restrict__ dst, const u16* __restrict__ e,
                         float* __restrict__ rstd_e) {
    const int lane = tidx() & 63;
    const int wid = bidx() * 4 + (tidx() >> 6);
    const int nw = gdim() * 4;
    for (int row = wid; row < NTOK; row += nw) {
        const float* xr = x + (long)row * 1024;
        float4 v[4];
        float ss = 0.f;
#pragma unroll
        for (int i = 0; i < 4; ++i) {
            v[i] = *(const float4*)(xr + i * 256 + lane * 4);
            ss += v[i].x * v[i].x + v[i].y * v[i].y + v[i].z * v[i].z + v[i].w * v[i].w;
        }
        ss = wsum(ss);
        float rstd = rsqrtf(ss * (1.0f / 1024.0f) + EPS);
#pragma unroll
        for (int i = 0; i < 4; ++i) {
            float4 gg = g ? *(const float4*)(g + i * 256 + lane * 4) : float4{1.f, 1.f, 1.f, 1.f};
            uint2 o = uint2{pack2(v[i].x * rstd * gg.x, v[i].y * rstd * gg.y), pack2(v[i].z * rstd * gg.z, v[i].w * rstd * gg.w)};
            *(uint2*)(dst + (long)row * 1024 + i * 256 + lane * 4) = o;
        }
        if (e) {
            const uint4* er = (const uint4*)(e + (long)row * 1024);
            float es = 0.f;
#pragma unroll
            for (int i = 0; i < 2; ++i) {
                uint4 q = er[i * 64 + lane];
                float a;
                a = bf_lo(q.x); es += a * a; a = bf_hi(q.x); es += a * a;
                a = bf_lo(q.y); es += a * a; a = bf_hi(q.y); es += a * a;
                a = bf_lo(q.z); es += a * a; a = bf_hi(q.z); es += a * a;
                a = bf_lo(q.w); es += a * a; a = bf_hi(q.w); es += a * a;
            }
            es = wsum(es);
            if (lane == 0) rstd_e[row] = rsqrtf(es * (1.0f / 1024.0f) + EPS);
        }
    }
}

__device__ __forceinline__ void head_chunk(u16* ptr, float gain, bool do_norm, float scale, float c, float sn, int lane) {
    float v = bf2f(ptr[lane]);
    if (do_norm) {
        float ss = wsum(v * v);
        v = v * rsqrtf(ss * (1.0f / 64.0f) + EPS) * gain;
    }
    float pv = __shfl_xor(v, 8);
    if (lane < 16) v = (lane < 8) ? (v * c - pv * sn) : (v * c + pv * sn);
    ptr[lane] = f2bf(v * scale);
}
__device__ __forceinline__ u32 sig2(u32 w) { return pack2(sigmoidf(bf_lo(w)), sigmoidf(bf_hi(w))); }

__device__ __forceinline__ void post_proj(unsigned char* ws, const float* ng, const float* dg, unsigned char* smem) {
    u16* proj = (u16*)(ws + OFF_PROJ);
    const float* ropec = (const float*)(ws + OFF_ROPE);
    const float* ropes = ropec + (size_t)NTOK * 8;
    const int lane = tidx() & 63, w = tidx() >> 6;
    u16* lrow = (u16*)(smem + w * 9216);
    const float g_q = ng[lane], g_ks = ng[128 + lane], g_kw = ng[192 + lane], g_dq = dg[lane], g_kb = dg[64 + lane];
    const int wid = bidx() * 4 + w;
    const int nw = gdim() * 4;
    for (int t = wid; t < NTOK; t += nw) {
        uint4* grow = (uint4*)(proj + (long)t * IN_COLS);
        const float c = ropec[(long)t * 8 + (lane & 7)], sn = ropes[(long)t * 8 + (lane & 7)];
#pragma unroll
        for (int i = 0; i < 8; ++i) ((uint4*)lrow)[i * 64 + lane] = grow[i * 64 + lane];
        if (lane < 60) ((uint4*)lrow)[512 + lane] = grow[512 + lane];
        WAVE_SYNC();
        for (int h = 0; h < 8; ++h) head_chunk(lrow + C_NQ + h * 64, g_q, true, 0.125f * 1.4426950408889634f, c, sn, lane);
        for (int g = 0; g < 2; ++g) head_chunk(lrow + C_NKV + (2 * 2 + g) * 64, g_ks, true, 1.0f, c, sn, lane);
        for (int g = 0; g < 2; ++g) head_chunk(lrow + C_NKV + (4 * 2 + g) * 64, g_kw, true, 1.0f, c, sn, lane);
        for (int h = 0; h < 8; ++h) head_chunk(lrow + C_DQ + h * 64, g_dq, true, 0.125f * 1.4426950408889634f, c, sn, lane);
        head_chunk(lrow + C_DKV, g_kb, true, 1.0f, c, sn, lane);
        for (int h = 0; h < 8; ++h) head_chunk(lrow + C_IQ + h * 64, 1.0f, false, 0.125f, c, sn, lane);
        head_chunk(lrow + C_IK, 1.0f, false, 1.0f, c, sn, lane);
        WAVE_SYNC();
#pragma unroll
        for (int i = 0; i < 9; ++i) {
            int idx = i * 64 + lane;
            if (idx < 572) {
                uint4 v = ((const uint4*)lrow)[idx];
                if (idx >= 316 || (idx >= 160 && idx < 163)) v = uint4{sig2(v.x), sig2(v.y), sig2(v.z), sig2(v.w)};
                grow[idx] = v;
            }
        }
        WAVE_SYNC();
    }
}

template <int NH>
__device__ __forceinline__ void qk_chunk(const u16* krow, const u32* qlds, float (&s)[NH]) {
    asm volatile("" ::: "memory");
    uint4 kr[8];
#pragma unroll
    for (int i = 0; i < 8; ++i) kr[i] = ((const uint4*)krow)[i];
#pragma unroll
    for (int h = 0; h < NH; ++h) s[h] = 0.f;
#pragma unroll
    for (int i = 0; i < 8; ++i)
#pragma unroll
        for (int h = 0; h < NH; ++h) {
            uint4 q = *(const uint4*)(qlds + h * 32 + i * 4);
            s[h] = dot2(kr[i].x, q.x, s[h]);
            s[h] = dot2(kr[i].y, q.y, s[h]);
            s[h] = dot2(kr[i].z, q.z, s[h]);
            s[h] = dot2(kr[i].w, q.w, s[h]);
        }
}

template <int NH, class VRow>
__device__ __forceinline__ void pv_chunk(const float* plds, VRow vrow, float (&o)[NH][4], int lane) {
    const int sub = lane >> 4, dq = lane & 15;
#pragma unroll 4
    for (int kk = 0; kk < 16; ++kk) {
        int key = kk * 4 + sub;
        const u16* vp = vrow(key);
        uint2 vv = *(const uint2*)(vp + dq * 4);
        float v0 = bf_lo(vv.x), v1 = bf_hi(vv.x), v2 = bf_lo(vv.y), v3 = bf_hi(vv.y);
#pragma unroll
        for (int h = 0; h < NH; ++h) {
            float ph = plds[key * NH + h];
            o[h][0] += ph * v0;
            o[h][1] += ph * v1;
            o[h][2] += ph * v2;
            o[h][3] += ph * v3;
        }
    }
}

template <int NH, class VRow>
__device__ __forceinline__ void attn_chunk(float (&s)[NH], bool valid, float (&m)[NH], float (&l)[NH], float (&o)[NH][4], float* plds, VRow vrow,
                                           int lane) {
#pragma unroll
    for (int h = 0; h < NH; ++h) {
        float sv = valid ? s[h] : -1e30f;
        float cm = wmax(sv);
        float mn = fmaxf(m[h], cm);
        float alpha = __expf(m[h] - mn);
        float p = valid ? __expf(sv - mn) : 0.f;
        l[h] = l[h] * alpha + wsum(p);
        m[h] = mn;
#pragma unroll
        for (int j = 0; j < 4; ++j) o[h][j] *= alpha;
        plds[lane * NH + h] = p;
    }
    WAVE_SYNC();
    pv_chunk<NH>(plds, vrow, o, lane);
    WAVE_SYNC();
}

#define MFMA32(a, b, c) __builtin_amdgcn_mfma_f32_32x32x16_bf16(a, b, c, 0, 0, 0)
typedef __attribute__((address_space(3))) const char* lds_cptr;
typedef short v4i16_t __attribute__((ext_vector_type(4)));
using s16x4 = __attribute__((ext_vector_type(4))) short;
__device__ __forceinline__ s16x4 vtr(lds_cptr p) {
    return __builtin_bit_cast(s16x4, __builtin_amdgcn_ds_read_tr16_b64_v4i16((__attribute__((address_space(3))) v4i16_t*)p));
}
__device__ __forceinline__ float swap32(float v) { return __shfl_xor(v, 32); }

using u32x4 = __attribute__((ext_vector_type(4))) unsigned;
struct TileRegs { u32x4 k0, k1, v0, v1; };
template <class RowPtr>
__device__ __forceinline__ void tile_load(u32x4& k0, u32x4& k1, u32x4& v0, u32x4& v1, RowPtr rowptr, int w, int lane) {
    const u16 *kp, *vp, *kp2, *vp2;
    rowptr(lane, kp, vp2);
    rowptr(16 * w + (lane >> 2), kp2, vp);
    k0 = *(const u32x4*)(kp + w * 8);
    k1 = *(const u32x4*)(kp + (w + 4) * 8);
    v0 = *(const u32x4*)(vp + (lane & 3) * 8);
    v1 = *(const u32x4*)(vp + 32 + (lane & 3) * 8);
}
__device__ __forceinline__ void tile_store(const u32x4& k0, const u32x4& k1, const u32x4& v0, const u32x4& v1, unsigned char* buf, int w, int lane) {
    *(u32x4*)(buf + w * 1024 + lane * 16) = k0;
    *(u32x4*)(buf + (w + 4) * 1024 + lane * 16) = k1;
    *(u32x4*)(buf + 8192 + (16 * w + (lane >> 2)) * 64 + (lane & 3) * 16) = v0;
    *(u32x4*)(buf + 8192 + 4096 + (16 * w + (lane >> 2)) * 64 + (lane & 3) * 16) = v1;
}
__device__ __forceinline__ void qk_tile(const unsigned char* buf, const bf16x8 (&qr)[4], f32x16& s0, f32x16& s1, int lane) {
    const int r32 = lane & 31, hi = lane >> 5;
    lds_cptr kp = (lds_cptr)buf + hi * 1024 + r32 * 16;
#pragma unroll
    for (int i = 0; i < 16; ++i) { s0[i] = 0.f; s1[i] = 0.f; }
#pragma unroll
    for (int d0 = 0; d0 < 4; ++d0) {
        bf16x8 k0 = *(const __attribute__((address_space(3))) bf16x8*)(kp + d0 * 2048);
        bf16x8 k1 = *(const __attribute__((address_space(3))) bf16x8*)(kp + d0 * 2048 + 512);
        s0 = MFMA32(k0, qr[d0], s0);
        s1 = MFMA32(k1, qr[d0], s1);
    }
}
__device__ __forceinline__ bf16x8 pack8(const f32x16& p, int s) {
    u32 a = pack2(p[8 * s + 0], p[8 * s + 1]), b = pack2(p[8 * s + 2], p[8 * s + 3]);
    u32 c = pack2(p[8 * s + 4], p[8 * s + 5]), d = pack2(p[8 * s + 6], p[8 * s + 7]);
    u32x4 v = u32x4{a, b, c, d};
    return __builtin_bit_cast(bf16x8, v);
}
__device__ __forceinline__ void pv_tile(const unsigned char* buf, const f32x16& p0, const f32x16& p1, f32x16 (&o)[2], int lane) {
    const int hi = lane >> 5;
    lds_cptr vp = (lds_cptr)buf + 8192 + ((lane >> 4) & 1) * 32 + (lane & 3) * 8 + (4 * hi + ((lane & 15) >> 2)) * 64;
    bf16x8 pf[4];
    pf[0] = pack8(p0, 0);
    pf[1] = pack8(p0, 1);
    pf[2] = pack8(p1, 0);
    pf[3] = pack8(p1, 1);
#pragma unroll
    for (int i = 0; i < 8; ++i) {
        const int dh = i >> 2, ks = i & 3;
        s16x4 vlo = vtr(vp + dh * 4096 + ks * 1024);
        s16x4 vhi = vtr(vp + dh * 4096 + ks * 1024 + 512);
        bf16x8 vf = (bf16x8){vlo[0], vlo[1], vlo[2], vlo[3], vhi[0], vhi[1], vhi[2], vhi[3]};
        o[dh] = MFMA32(vf, pf[ks], o[dh]);
    }
}
template <bool BITS>
__device__ __forceinline__ void apply_mask(f32x16& s0, f32x16& s1, int lo, int hi_lim, u64 word, int hi) {
    const u32 wlo = (u32)(word >> (4 * hi)), whi = (u32)(word >> (32 + 4 * hi));
#pragma unroll
    for (int i = 0; i < 16; ++i) {
        const int kc = (i & 3) + 8 * (i >> 2);
        bool v0, v1;
        if (BITS) {
            v0 = (wlo >> kc) & 1u;
            v1 = (whi >> kc) & 1u;
        } else {
            const int kk = kc + 4 * hi;
            v0 = (kk >= lo) && (kk <= hi_lim);
            v1 = (kk + 32 >= lo) && (kk + 32 <= hi_lim);
        }
        s0[i] = v0 ? s0[i] : -1e30f;
        s1[i] = v1 ? s1[i] : -1e30f;
    }
}
__device__ __forceinline__ void softmax_step(f32x16& s0, f32x16& s1, float& m, float& l, f32x16 (&o)[2]) {
    float mx = -1e30f;
#pragma unroll
    for (int i = 0; i < 16; ++i) mx = fmaxf(mx, fmaxf(s0[i], s1[i]));
    mx = fmaxf(mx, swap32(mx));
    const float mn = fmaxf(m, mx);
    const float alpha = __builtin_amdgcn_exp2f(m - mn);
    float sum = 0.f;
#pragma unroll
    for (int i = 0; i < 16; ++i) {
        s0[i] = (s0[i] > -1e29f) ? __builtin_amdgcn_exp2f(s0[i] - mn) : 0.f;
        s1[i] = (s1[i] > -1e29f) ? __builtin_amdgcn_exp2f(s1[i] - mn) : 0.f;
        sum += s0[i] + s1[i];
    }
    sum += swap32(sum);
    l = l * alpha + sum;
    m = mn;
#pragma unroll
    for (int i = 0; i < 16; ++i) { o[0][i] *= alpha; o[1][i] *= alpha; }
}

template <int MODE, bool BITS, class Next, class RowPtr, class MaskFn, class Extra>
__device__ __forceinline__ void flash_run(int first, Next next, RowPtr rowptr, MaskFn maskfn, Extra extra, const bf16x8 (&qr)[4], float& m, float& l,
                                          f32x16 (&o)[2], unsigned char* bufs, int w, int lane) {
    if (first < 0) return;
    u32x4 tk0, tk1, tv0, tv1;
    int cur = first;
    tile_load(tk0, tk1, tv0, tv1, [&](int r, const u16*& kp, const u16*& vp) { rowptr(cur, r, kp, vp); }, w, lane);
    __syncthreads();
    tile_store(tk0, tk1, tv0, tv1, bufs, w, lane);
    __syncthreads();
    int pb = 0;
    while (cur >= 0) {
        const int nxt = next(cur);
        if (nxt >= 0) tile_load(tk0, tk1, tv0, tv1, [&](int r, const u16*& kp, const u16*& vp) { rowptr(nxt, r, kp, vp); }, w, lane);
        const unsigned char* buf = bufs + pb * 16384;
        f32x16 s0, s1;
        qk_tile(buf, qr, s0, s1, lane);
        int lo, hl;
        u64 word;
        maskfn(cur, lo, hl, word);
        apply_mask<BITS>(s0, s1, lo, hl, word, lane >> 5);
        if (MODE == 0) {
            softmax_step(s0, s1, m, l, o);
            pv_tile(buf, s0, s1, o, lane);
        } else if (MODE == 1) {
            f32x16 od[2];
            softmax_step(s0, s1, m, l, od);
        } else {
#pragma unroll
            for (int i = 0; i < 16; ++i) {
                s0[i] = (s0[i] > -1e29f) ? __builtin_amdgcn_exp2f(s0[i] - m) * l : 0.f;
                s1[i] = (s1[i] > -1e29f) ? __builtin_amdgcn_exp2f(s1[i] - m) * l : 0.f;
            }
            extra(cur, s0, s1);
            pv_tile(buf, s0, s1, o, lane);
        }
        if (nxt >= 0) tile_store(tk0, tk1, tv0, tv1, bufs + (pb ^ 1) * 16384, w, lane);
        __syncthreads();
        pb ^= 1;
        cur = nxt;
    }
}

__device__ __forceinline__ void nsa_unit(unsigned char* ws, int b, int g, int qt, unsigned char* smem) {
    const int tid = tidx(), lane = tid & 63, w = tid >> 6;
    const int r32 = lane & 31, hi = lane >> 5;
    const int q0 = qt * 32;
    const int tl = q0 + 8 * w + (r32 >> 2);
    const int rep = r32 & 3;
    const u16* proj = (const u16*)(ws + OFF_PROJ);
    const u16* brow = proj + (long)b * SEQ * IN_COLS;
    const u16* kcb = (const u16*)(ws + OFF_KCB) + (size_t)(b * 2 + g) * 256 * 64;
    const u16* vcb = (const u16*)(ws + OFF_VCB) + (size_t)(b * 2 + g) * 256 * 64;
    u16* ya = (u16*)(ws + OFF_YAB);
    unsigned char* bufs = smem;
    float* imp = (float*)(smem + 32768);
    u64* selm = (u64*)(smem + 32768 + 8192);
    const u16* trow = brow + (long)tl * IN_COLS;
    bf16x8 qr[4];
#pragma unroll
    for (int d0 = 0; d0 < 4; ++d0) qr[d0] = *(const bf16x8*)(trow + C_NQ + (g * 4 + rep) * 64 + d0 * 16 + hi * 8);
    const float gate_c = bf2f(trow[C_NG + 0 * 8 + g * 4 + rep]);
    const float gate_s = bf2f(trow[C_NG + 1 * 8 + g * 4 + rep]);
    const float gate_w = bf2f(trow[C_NG + 2 * 8 + g * 4 + rep]);
    for (int i = tid; i < 32 * 64; i += 256) imp[i] = 0.f;
    f32x16 tot[2];
#pragma unroll
    for (int i = 0; i < 16; ++i) { tot[0][i] = 0.f; tot[1][i] = 0.f; }

    const int nvalid = tl >= 31 ? ((tl - 31) >> 4) + 1 : 0;
    const int nv_max = (q0 + 31 >= 31) ? ((q0 + 31 - 31) >> 4) + 1 : 0;
    const int ntile_c = (nv_max + 63) >> 6;
    auto crows = [&](int tile, int r, const u16*& kp, const u16*& vp) {
        int n = tile * 64 + r;
        n = n < 254 ? n : 254;
        kp = kcb + (size_t)n * 64;
        vp = vcb + (size_t)n * 64;
    };
    auto cnext = [&](int c) { return (c + 1 < ntile_c) ? c + 1 : -1; };
    auto cmask = [&](int tile, int& lo, int& hl, u64& word) { lo = 0; hl = nvalid - 64 * tile - 1; word = 0; };
    {
        float m = -1e30f, l = 0.f;
        f32x16 o[2];
#pragma unroll
        for (int i = 0; i < 16; ++i) { o[0][i] = 0.f; o[1][i] = 0.f; }
        flash_run<1, false>(ntile_c > 0 ? 0 : -1, cnext, crows, cmask, [&](int, f32x16&, f32x16&) {}, qr, m, l, o, bufs, w, lane);
        float invl = l > 0.f ? 1.0f / l : 0.f;
        const int qloc = 8 * w + (r32 >> 2);
        flash_run<2, false>(ntile_c > 0 ? 0 : -1, cnext, crows, cmask,
                            [&](int tile, f32x16& p0, f32x16& p1) {
#pragma unroll
                                for (int a = 0; a < 4; ++a) {
                                    float g0 = p0[4 * a] + p0[4 * a + 1] + p0[4 * a + 2] + p0[4 * a + 3], e0 = p0[4 * a + 3];
                                    float g1 = p1[4 * a] + p1[4 * a + 1] + p1[4 * a + 2] + p1[4 * a + 3], e1 = p1[4 * a + 3];
                                    g0 += __shfl_xor(g0, 1); g0 += __shfl_xor(g0, 2);
                                    e0 += __shfl_xor(e0, 1); e0 += __shfl_xor(e0, 2);
                                    g1 += __shfl_xor(g1, 1); g1 += __shfl_xor(g1, 2);
                                    e1 += __shfl_xor(e1, 1); e1 += __shfl_xor(e1, 2);
                                    if (rep == 0) {
                                        int j0 = 16 * tile + 2 * a + hi, j1 = j0 + 8;
                                        atomicAdd(&imp[qloc * 64 + j0], g0);
                                        if (j0 + 1 < 64) atomicAdd(&imp[qloc * 64 + j0 + 1], e0);
                                        if (j1 < 64) atomicAdd(&imp[qloc * 64 + j1], g1);
                                        if (j1 + 1 < 64) atomicAdd(&imp[qloc * 64 + j1 + 1], e1);
                                    }
                                }
                            },
                            qr, m, invl, o, bufs, w, lane);
#pragma unroll
        for (int i = 0; i < 16; ++i) { tot[0][i] += gate_c * o[0][i]; tot[1][i] += gate_c * o[1][i]; }
    }
    __syncthreads();
    for (int qq = 0; qq < 8; ++qq) {
        const int qi = 8 * w + qq;
        const int tq = q0 + qi;
        const int cur = tq >> 6;
        const int j = lane;
        float v = imp[qi * 64 + j];
        if (j == 0 || j == cur || j == cur - 1) v = __builtin_inff();
        if (j > cur) v = -__builtin_inff();
        int rank = 0;
        for (int jp = 0; jp < 64; ++jp) {
            float vj = __shfl(v, jp);
            rank += (vj > v || (vj == v && jp < j)) ? 1 : 0;
        }
        u64 sm = __ballot(rank < 16 && j <= cur);
        if (lane == 0) selm[qi] = sm;
    }
    __syncthreads();
    const u64 mymask = selm[8 * w + (r32 >> 2)];
    u64 unionm = 0;
    for (int i = 0; i < 32; ++i) unionm |= selm[i];
    unionm = __builtin_amdgcn_readfirstlane((u32)unionm) | ((u64)__builtin_amdgcn_readfirstlane((u32)(unionm >> 32)) << 32);
    {
        float m = -1e30f, l = 0.f;
        f32x16 o[2];
#pragma unroll
        for (int i = 0; i < 16; ++i) { o[0][i] = 0.f; o[1][i] = 0.f; }
        auto snext = [&](int c) {
            u64 rest = (c >= 63) ? 0ull : (unionm >> (c + 1));
            return rest ? (c + 1 + (__ffsll((long long)rest) - 1)) : -1;
        };
        const int first = unionm ? (__ffsll((long long)unionm) - 1) : -1;
        flash_run<0, false>(first, snext,
                            [&](int j, int r, const u16*& kp, const u16*& vp) {
                                const u16* rp = brow + (long)(64 * j + r) * IN_COLS + C_NKV;
                                kp = rp + (2 * 2 + g) * 64;
                                vp = rp + (3 * 2 + g) * 64;
                            },
                            [&](int j, int& lo, int& hl, u64& word) { lo = 0; hl = ((mymask >> j) & 1ull) ? (tl - 64 * j) : -1; word = 0; },
                            [&](int, f32x16&, f32x16&) {}, qr, m, l, o, bufs, w, lane);
        const float sc = l > 0.f ? gate_s / l : 0.f;
#pragma unroll
        for (int i = 0; i < 16; ++i) { tot[0][i] += sc * o[0][i]; tot[1][i] += sc * o[1][i]; }
    }
    {
        float m = -1e30f, l = 0.f;
        f32x16 o[2];
#pragma unroll
        for (int i = 0; i < 16; ++i) { o[0][i] = 0.f; o[1][i] = 0.f; }
        const int jfirst = (q0 - 511) > 0 ? ((q0 - 511) >> 6) : 0;
        const int jlast = (q0 + 31) >> 6;
        flash_run<0, false>(jfirst, [&](int c) { return c + 1 <= jlast ? c + 1 : -1; },
                            [&](int j, int r, const u16*& kp, const u16*& vp) {
                                const u16* rp = brow + (long)(64 * j + r) * IN_COLS + C_NKV;
                                kp = rp + (4 * 2 + g) * 64;
                                vp = rp + (5 * 2 + g) * 64;
                            },
                            [&](int j, int& lo, int& hl, u64& word) { lo = tl - 511 - 64 * j; hl = tl - 64 * j; word = 0; },
                            [&](int, f32x16&, f32x16&) {}, qr, m, l, o, bufs, w, lane);
        const float sc = l > 0.f ? gate_w / l : 0.f;
#pragma unroll
        for (int i = 0; i < 16; ++i) { tot[0][i] += sc * o[0][i]; tot[1][i] += sc * o[1][i]; }
    }
    {
        u16* orow = ya + ((long)b * SEQ + tl) * 512 + (g * 4 + rep) * 64;
#pragma unroll
        for (int dh = 0; dh < 2; ++dh)
#pragma unroll
            for (int a = 0; a < 4; ++a) {
                uint2 v = uint2{pack2(tot[dh][4 * a], tot[dh][4 * a + 1]), pack2(tot[dh][4 * a + 2], tot[dh][4 * a + 3])};
                *(uint2*)(orow + dh * 32 + 8 * a + 4 * hi) = v;
            }
    }
}

__device__ __forceinline__ void dsa_select_unit(unsigned char* ws, int unit, unsigned char* smem) {
    const int tid = tidx(), lane = tid & 63, w = tid >> 6;
    const int t0 = unit * 4;
    const int b = t0 / SEQ, tl0 = t0 - b * SEQ;
    const u16* proj = (const u16*)(ws + OFF_PROJ);
    const u16* brow = proj + (long)b * SEQ * IN_COLS;
    u64* bits = (u64*)(ws + OFF_BITS);
    float* sc = (float*)smem;
    __syncthreads();
    {
        const int r = lane & 31, half = lane >> 5;
        const int q = r >> 3, h = r & 7;
        bf16x8 af[4];
#pragma unroll
        for (int ks = 0; ks < 4; ++ks) af[ks] = *(const bf16x8*)(proj + (long)(t0 + q) * IN_COLS + C_IQ + h * 64 + ks * 16 + half * 8);
        float wq[4][4];
#pragma unroll
        for (int qq = 0; qq < 4; ++qq)
#pragma unroll
            for (int i = 0; i < 4; ++i) wq[qq][i] = bf2f(proj[(long)(t0 + qq) * IN_COLS + C_IW + i + 4 * half]) * 0.35355339059327373f;
        const int ntiles = (tl0 + 4 + 31) >> 5;
        bf16x8 bfr[4];
        if (w < ntiles) {
#pragma unroll
            for (int ks = 0; ks < 4; ++ks) bfr[ks] = *(const bf16x8*)(brow + (long)(w * 32 + r) * IN_COLS + C_IK + ks * 16 + half * 8);
        }
        for (int tile = w; tile < ntiles; tile += 4) {
            int key = tile * 32 + r;
            bf16x8 bcur[4];
#pragma unroll
            for (int ks = 0; ks < 4; ++ks) bcur[ks] = bfr[ks];
            if (tile + 4 < ntiles) {
#pragma unroll
                for (int ks = 0; ks < 4; ++ks) bfr[ks] = *(const bf16x8*)(brow + (long)(key + 128) * IN_COLS + C_IK + ks * 16 + half * 8);
            }
            f32x16 acc;
#pragma unroll
            for (int i = 0; i < 16; ++i) acc[i] = 0.f;
#pragma unroll
            for (int ks = 0; ks < 4; ++ks) acc = MFMA32(af[ks], bcur[ks], acc);
            float totq[4];
#pragma unroll
            for (int qq = 0; qq < 4; ++qq) {
                float part = 0.f;
#pragma unroll
                for (int i = 0; i < 4; ++i) part += wq[qq][i] * fmaxf(acc[4 * qq + i], 0.f);
                totq[qq] = part + __shfl_xor(part, 32);
            }
            if (half == 0) {
                sc[0 * 4096 + key] = totq[0];
                sc[1 * 4096 + key] = totq[1];
            } else {
                sc[2 * 4096 + key] = totq[2];
                sc[3 * 4096 + key] = totq[3];
            }
        }
    }
    __syncthreads();
    const int t = t0 + w;
    const int tl = tl0 + w;
    const int nvalid = tl + 1;
    {
        u32 u[64];
        const float* scq = sc + w * 4096;
#pragma unroll
        for (int j = 0; j < 64; ++j) {
            int key = j * 64 + lane;
            u32 v = 0;
            if (key <= tl) {
                u32 bb = __float_as_uint(scq[key]);
                v = bb ^ ((bb >> 31) ? 0xFFFFFFFFu : 0x80000000u);
            }
            u[j] = v;
        }
        u32 K = 0;
        int need = 0;
        if (nvalid > 256) {
            for (int bit = 31; bit >= 0; --bit) {
                u32 cand = K | (1u << bit);
                int cnt = 0;
#pragma unroll
                for (int j = 0; j < 64; ++j) cnt += (u[j] >= cand) ? 1 : 0;
                cnt = wsumi(cnt);
                if (cnt >= 256) K = cand;
            }
            int cgt = 0;
#pragma unroll
            for (int j = 0; j < 64; ++j) cgt += (u[j] > K) ? 1 : 0;
            cgt = wsumi(cgt);
            need = 256 - cgt;
        }
        const u64 ltmask = (1ull << lane) - 1ull;
        int ebase = 0;
        u64 myword = 0;
#pragma unroll
        for (int j = 0; j < 64; ++j) {
            bool eq = (nvalid > 256) && (u[j] == K);
            u64 em = __ballot(eq);
            int erank = ebase + __popcll(em & ltmask);
            bool take = (u[j] > K) || (eq && erank < need);
            ebase += __popcll(em);
            u64 sm = __ballot(take);
            if (lane == j) myword = sm;
        }
        bits[(long)t * 64 + lane] = myword;
    }
}

__device__ __forceinline__ void dsa_attn_unit(unsigned char* ws, int b, int qt, unsigned char* smem) {
    const int tid = tidx(), lane = tid & 63, w = tid >> 6;
    const int r32 = lane & 31, hi = lane >> 5;
    const int q0 = qt * 16;
    const int qloc = 4 * w + (r32 >> 3);
    const int tl = q0 + qloc;
    const int head = r32 & 7;
    const u16* proj = (const u16*)(ws + OFF_PROJ);
    const u16* brow = proj + (long)b * SEQ * IN_COLS;
    const u64* bits = (const u64*)(ws + OFF_BITS) + ((long)b * SEQ + q0) * 64;
    u16* yb = (u16*)(ws + OFF_YAB) + (size_t)NTOK * 512;
    unsigned char* bufs = smem;
    u64* lbits = (u64*)(smem + 32768);
    __syncthreads();
    for (int i = tid; i < 16 * 64; i += 256) lbits[i] = bits[i];
    const u16* trow = brow + (long)tl * IN_COLS;
    bf16x8 qr[4];
#pragma unroll
    for (int d0 = 0; d0 < 4; ++d0) qr[d0] = *(const bf16x8*)(trow + C_DQ + head * 64 + d0 * 16 + hi * 8);
    float m = -1e30f, l = 0.f;
    f32x16 o[2];
#pragma unroll
    for (int i = 0; i < 16; ++i) { o[0][i] = 0.f; o[1][i] = 0.f; }
    const int jlast = (q0 + 15) >> 6;
    flash_run<0, true>(0, [&](int c) { return c + 1 <= jlast ? c + 1 : -1; },
                       [&](int j, int r, const u16*& kp, const u16*& vp) {
                           const u16* rp = brow + (long)(64 * j + r) * IN_COLS + C_DKV;
                           kp = rp;
                           vp = rp + 64;
                       },
                       [&](int j, int& lo, int& hl, u64& word) { lo = 0; hl = 0; word = lbits[qloc * 64 + j]; },
                       [&](int, f32x16&, f32x16&) {}, qr, m, l, o, bufs, w, lane);
    const float inv = l > 0.f ? 1.0f / l : 0.f;
    u16* orow = yb + ((long)b * SEQ + tl) * 512 + head * 64;
#pragma unroll
    for (int dh = 0; dh < 2; ++dh)
#pragma unroll
        for (int a = 0; a < 4; ++a) {
            uint2 v = uint2{pack2(o[dh][4 * a] * inv, o[dh][4 * a + 1] * inv), pack2(o[dh][4 * a + 2] * inv, o[dh][4 * a + 3] * inv)};
            *(uint2*)(orow + dh * 32 + 8 * a + 4 * hi) = v;
        }
}

template <int CTRL>
__device__ __forceinline__ int dppi(int x) { return __builtin_amdgcn_update_dpp(x, x, CTRL, 0xF, 0xF, false); }
template <int CTRL>
__device__ __forceinline__ float dppf(float x) { return __int_as_float(dppi<CTRL>(__float_as_int(x))); }
__device__ __forceinline__ int row_sum16i(int x) {
    x += dppi<0x128>(x);
    x += dppi<0x124>(x);
    x += dppi<0x122>(x);
    x += dppi<0x121>(x);
    return x;
}
__device__ __forceinline__ float row_sum16f(float x) {
    x += dppf<0x128>(x);
    x += dppf<0x124>(x);
    x += dppf<0x122>(x);
    x += dppf<0x121>(x);
    return x;
}
__device__ __forceinline__ float row_max16f(float x) {
    x = fmaxf(x, dppf<0x128>(x));
    x = fmaxf(x, dppf<0x124>(x));
    x = fmaxf(x, dppf<0x122>(x));
    x = fmaxf(x, dppf<0x121>(x));
    return x;
}
__device__ __forceinline__ u32 sortkey(float f) {
    u32 b = __float_as_uint(f);
    return b ^ ((b >> 31) ? 0xFFFFFFFFu : 0x80000000u);
}

__device__ __forceinline__ void peer_route(unsigned char* ws, int layer, unsigned char* smem) {
    const int tid = tidx(), lane = tid & 63, w = tid >> 6;
    const int grp = lane >> 4, k = lane & 15;
    const u32 ltk = (1u << k) - 1u;
    const u16* pq = (const u16*)(ws + OFF_PQ);
    const u16* skb = (const u16*)(ws + OFF_W + layer * W_LAYER + WO_SK);
    int* eidx = (int*)(ws + OFF_EIDX);
    float* gate = (float*)(ws + OFF_GATE);
    float* tvc = (float*)(smem + w * 4096);
    int* tic = (int*)(smem + w * 4096 + 2048);
    const int nunits = NTOK / 16;
    for (int unit = bidx() * 4 + w; unit < nunits; unit += gdim() * 4) {
        const int tok0 = unit * 16;
        for (int h = 0; h < 8; ++h) {
            for (int half = 0; half < 2; ++half) {
                bf16x8 af[4];
#pragma unroll
                for (int ks = 0; ks < 4; ++ks)
                    af[ks] = *(const bf16x8*)(pq + (long)(tok0 + k) * 2048 + h * 256 + half * 128 + ks * 32 + grp * 8);
                float sc[8][4];
                u32 u[8][4];
#pragma unroll
                for (int nt = 0; nt < 8; ++nt) {
                    f32x4 acc = f32x4{0.f, 0.f, 0.f, 0.f};
#pragma unroll
                    for (int ks = 0; ks < 4; ++ks) {
                        bf16x8 bfr = *(const bf16x8*)(skb + (size_t)half * 128 * 128 + (size_t)(nt * 16 + k) * 128 + ks * 32 + grp * 8);
                        acc = __builtin_amdgcn_mfma_f32_16x16x32_bf16(af[ks], bfr, acc, 0, 0, 0);
                    }
#pragma unroll
                    for (int i = 0; i < 4; ++i) { sc[nt][i] = acc[i]; u[nt][i] = sortkey(acc[i]); }
                }
                u32 K[4] = {0u, 0u, 0u, 0u};
                for (int bit = 31; bit >= 0; --bit) {
                    int packed = 0;
#pragma unroll
                    for (int i = 0; i < 4; ++i) {
                        const u32 cand = K[i] | (1u << bit);
                        int c = 0;
#pragma unroll
                        for (int nt = 0; nt < 8; ++nt) c += (u[nt][i] >= cand) ? 1 : 0;
                        packed |= c << (8 * i);
                    }
                    packed = row_sum16i(packed);
#pragma unroll
                    for (int i = 0; i < 4; ++i)
                        if (((packed >> (8 * i)) & 0xFF) >= 16) K[i] |= (1u << bit);
                }
                int need[4];
                {
                    int packed = 0;
#pragma unroll
                    for (int i = 0; i < 4; ++i) {
                        int c = 0;
#pragma unroll
                        for (int nt = 0; nt < 8; ++nt) c += (u[nt][i] > K[i]) ? 1 : 0;
                        packed |= c << (8 * i);
                    }
                    packed = row_sum16i(packed);
#pragma unroll
                    for (int i = 0; i < 4; ++i) need[i] = 16 - ((packed >> (8 * i)) & 0xFF);
                }
#pragma unroll
                for (int i = 0; i < 4; ++i) {
                    int ebase = 0, pbase = 0;
                    const int tok = 4 * grp + i;
#pragma unroll
                    for (int nt = 0; nt < 8; ++nt) {
                        const bool eq = (u[nt][i] == K[i]);
                        const u32 emg = (u32)(__ballot(eq) >> (lane & 48)) & 0xFFFFu;
                        const int erank = ebase + __popc(emg & ltk);
                        const bool take = (u[nt][i] > K[i]) || (eq && erank < need[i]);
                        ebase += __popc(emg);
                        const u32 tmg = (u32)(__ballot(take) >> (lane & 48)) & 0xFFFFu;
                        const int pos = pbase + __popc(tmg & ltk);
                        if (take) {
                            tvc[(half * 16 + tok) * 16 + pos] = sc[nt][i];
                            tic[(half * 16 + tok) * 16 + pos] = nt * 16 + k;
                        }
                        pbase += __popc(tmg);
                    }
                }
            }
            WAVE_SYNC();
            for (int pass = 0; pass < 4; ++pass) {
                const int tok = 4 * pass + grp;
                const float v1 = tvc[(0 * 16 + tok) * 16 + k];
                const int i1 = tic[(0 * 16 + tok) * 16 + k];
                float c[16];
                u32 uc[16];
#pragma unroll
                for (int r4 = 0; r4 < 4; ++r4) {
                    float4 v2 = *(const float4*)(tvc + (1 * 16 + tok) * 16 + r4 * 4);
                    c[r4 * 4 + 0] = v1 + v2.x;
                    c[r4 * 4 + 1] = v1 + v2.y;
                    c[r4 * 4 + 2] = v1 + v2.z;
                    c[r4 * 4 + 3] = v1 + v2.w;
                }
                float mxl = c[0];
#pragma unroll
                for (int r = 0; r < 16; ++r) { uc[r] = sortkey(c[r]); mxl = fmaxf(mxl, c[r]); }
                const float mx = row_max16f(mxl);
                u32 Kc = 0u;
                for (int bit = 31; bit >= 0; --bit) {
                    const u32 cand = Kc | (1u << bit);
                    int cn = 0;
#pragma unroll
                    for (int r = 0; r < 16; ++r) cn += (uc[r] >= cand) ? 1 : 0;
                    cn = row_sum16i(cn);
                    if (cn >= 16) Kc = cand;
                }
                int cg = 0;
#pragma unroll
                for (int r = 0; r < 16; ++r) cg += (uc[r] > Kc) ? 1 : 0;
                cg = row_sum16i(cg);
                const int needc = 16 - cg;
                bool take[16];
                float ex[16];
                float sl = 0.f;
                int ebase = 0;
#pragma unroll
                for (int r = 0; r < 16; ++r) {
                    const bool eq = (uc[r] == Kc);
                    const u32 emg = (u32)(__ballot(eq) >> (lane & 48)) & 0xFFFFu;
                    const int erank = ebase + __popc(emg & ltk);
                    take[r] = (uc[r] > Kc) || (eq && erank < needc);
                    ebase += __popc(emg);
                    ex[r] = take[r] ? __expf(c[r] - mx) : 0.f;
                    sl += ex[r];
                }
                const float inv = 1.0f / row_sum16f(sl);
                int pbase = 0;
                const long obase = (long)(tok0 + tok) * 128 + h * 16;
#pragma unroll
                for (int r = 0; r < 16; ++r) {
                    const u32 tmg = (u32)(__ballot(take[r]) >> (lane & 48)) & 0xFFFFu;
                    const int pos = pbase + __popc(tmg & ltk);
                    if (take[r]) {
                        eidx[obase + pos] = i1 * 128 + tic[(1 * 16 + tok) * 16 + r];
                        gate[obase + pos] = ex[r] * inv;
                    }
                    pbase += __popc(tmg);
                }
            }
            WAVE_SYNC();
        }
    }
}

__device__ __forceinline__ void peer_experts(unsigned char* ws, float* xout) {
    const int lane = tidx() & 63, w = tidx() >> 6;
    const u16* hbuf = (const u16*)(ws + OFF_H);
    const unsigned char* ub = ws + OFF_UB;
    const unsigned char* vb = ws + OFF_VB;
    const float* usc = (const float*)(ws + OFF_ESC);
    const float* vsc = usc + NEXP;
    const int* eidx = (const int*)(ws + OFF_EIDX);
    const float* gate = (const float*)(ws + OFF_GATE);
    for (int t = bidx() * 4 + w; t < NTOK; t += gdim() * 4) {
        float hf[16];
        {
            uint4 h0 = *(const uint4*)(hbuf + (long)t * 1024 + lane * 16);
            uint4 h1 = *(const uint4*)(hbuf + (long)t * 1024 + lane * 16 + 8);
            hf[0] = bf_lo(h0.x); hf[1] = bf_hi(h0.x); hf[2] = bf_lo(h0.y); hf[3] = bf_hi(h0.y);
            hf[4] = bf_lo(h0.z); hf[5] = bf_hi(h0.z); hf[6] = bf_lo(h0.w); hf[7] = bf_hi(h0.w);
            hf[8] = bf_lo(h1.x); hf[9] = bf_hi(h1.x); hf[10] = bf_lo(h1.y); hf[11] = bf_hi(h1.y);
            hf[12] = bf_lo(h1.z); hf[13] = bf_hi(h1.z); hf[14] = bf_lo(h1.w); hf[15] = bf_hi(h1.w);
        }
        float acc[16];
#pragma unroll
        for (int i = 0; i < 16; ++i) acc[i] = 0.f;
        for (int e0 = 0; e0 < 128; e0 += 8) {
            float gg[8], su[8], sv[8];
            uint4 uq[8], vq[8];
#pragma unroll
            for (int k = 0; k < 8; ++k) {
                const int id = __builtin_amdgcn_readfirstlane(eidx[(long)t * 128 + e0 + k]);
                gg[k] = gate[(long)t * 128 + e0 + k];
                su[k] = usc[id];
                sv[k] = vsc[id];
                uq[k] = *(const uint4*)(ub + (long)id * 1024 + lane * 16);
                vq[k] = *(const uint4*)(vb + (long)id * 1024 + lane * 16);
            }
#pragma unroll
            for (int k = 0; k < 8; ++k) {
                const u32 uw[4] = {uq[k].x, uq[k].y, uq[k].z, uq[k].w};
                float d = 0.f;
#pragma unroll
                for (int i = 0; i < 4; ++i) {
                    f32x2_t lo = __builtin_amdgcn_cvt_pk_f32_fp8((int)uw[i], false);
                    f32x2_t hi = __builtin_amdgcn_cvt_pk_f32_fp8((int)uw[i], true);
                    d += hf[4 * i] * lo[0] + hf[4 * i + 1] * lo[1] + hf[4 * i + 2] * hi[0] + hf[4 * i + 3] * hi[1];
                }
                d = wsum(d) * su[k];
                const float a = gelu_tanh(d) * gg[k] * sv[k];
                const u32 vw[4] = {vq[k].x, vq[k].y, vq[k].z, vq[k].w};
#pragma unroll
                for (int i = 0; i < 4; ++i) {
                    f32x2_t lo = __builtin_amdgcn_cvt_pk_f32_fp8((int)vw[i], false);
                    f32x2_t hi = __builtin_amdgcn_cvt_pk_f32_fp8((int)vw[i], true);
                    acc[4 * i] += a * lo[0];
                    acc[4 * i + 1] += a * lo[1];
                    acc[4 * i + 2] += a * hi[0];
                    acc[4 * i + 3] += a * hi[1];
                }
            }
        }
        float* xr = xout + (long)t * 1024 + lane * 16;
#pragma unroll
        for (int i = 0; i < 4; ++i) {
            float4 a = *(float4*)(xr + 4 * i);
            a.x += acc[4 * i]; a.y += acc[4 * i + 1]; a.z += acc[4 * i + 2]; a.w += acc[4 * i + 3];
            *(float4*)(xr + 4 * i) = a;
        }
    }
}

__device__ __forceinline__ void phase_prep(const Params& P, unsigned char* smem) {
    unsigned char* ws = opq(P.ws);
    const long gtid = (long)bidx() * 256 + tidx();
    const long gthreads = (long)gdim() * 256;
    for (int l = 0; l < 2; ++l) {
        unsigned char* wl = ws + OFF_W + l * W_LAYER;
        float* tile = (float*)smem;
        transpose_cvt(P.w_in + (size_t)l * 1024 * IN_COLS, (u16*)(wl + WO_WIN), 1024, IN_COLS, tile);
        for (int c = 0; c < 2; ++c) {
            transpose_cvt(P.cmp_w1 + ((size_t)l * 2 + c) * 2048 * 256, (u16*)(wl + WO_W1) + (size_t)c * 256 * 2048, 2048, 256, tile);
            transpose_cvt(P.cmp_w2 + ((size_t)l * 2 + c) * 256 * 64, (u16*)(wl + WO_W2) + (size_t)c * 64 * 256, 256, 64, tile);
        }
        transpose_cvt(P.w_a + (size_t)l * 512 * 1024, (u16*)(wl + WO_WA), 512, 1024, tile);
        transpose_cvt(P.w_b + (size_t)l * 512 * 1024, (u16*)(wl + WO_WB), 512, 1024, tile);
        transpose_cvt(P.w_out + (size_t)l * 1024 * 1024, (u16*)(wl + WO_WO), 1024, 1024, tile);
        transpose_cvt(P.peer_wq + (size_t)l * 1024 * 2048, (u16*)(wl + WO_WQ), 1024, 2048, tile);
        transpose_cvt(P.ple_w + (size_t)l * 256 * 1024, (u16*)(wl + WO_PW), 256, 1024, tile);
        transpose_cvt(P.ple_gw + (size_t)l * 1024 * 1024, (u16*)(wl + WO_PG), 1024, 1024, tile);
        cvt_f32_bf16(P.peer_sk + (size_t)l * 2 * 128 * 128, (u16*)(wl + WO_SK), 2 * 128 * 128);
        if (gtid < 512) {
            int c = (int)gtid >> 8, col = (int)gtid & 255;
            const float* pos = P.cmp_pos + ((size_t)l * 2 + c) * 2048;
            const float* w1 = P.cmp_w1 + ((size_t)l * 2 + c) * 2048 * 256;
            float s = 0.f;
            for (int k = 0; k < 2048; ++k) s += pos[k] * w1[(size_t)k * 256 + col];
            ((float*)(wl + WO_CB))[c * 256 + col] = s;
        }
    }
    {
        float* ropec = (float*)(ws + OFF_ROPE);
        float* ropes = ropec + (size_t)NTOK * 8;
        for (long i = gtid; i < (long)NTOK * 8; i += gthreads) {
            int t = (int)(i >> 3), k = (int)(i & 7);
            double inv = pow(500000.0, -(double)k / 8.0);
            double ang = (double)P.positions[t] * inv;
            ropec[i] = (float)cos(ang);
            ropes[i] = (float)sin(ang);
        }
    }
    rms_rows(P.x, P.attn_norm, (u16*)(ws + OFF_H), nullptr, nullptr);
}

__device__ __forceinline__ void phase_g1(const Params& P, int layer, unsigned char* smem) {
    unsigned char* ws = opq(P.ws);
    u16* proj = (u16*)(ws + OFF_PROJ);
    gemm_phase<0>((const u16*)(ws + OFF_H), 1024, (const u16*)(ws + OFF_W + layer * W_LAYER + WO_WIN), 1024, NTOK, IN_COLS, 1024, (u16*)smem,
                  [=](int row, int col, float v) { proj[(long)row * IN_COLS + col] = f2bf(v); });
}

__device__ __forceinline__ void phase_c1(const Params& P, int layer, unsigned char* smem) {
    unsigned char* ws = opq(P.ws);
    unsigned char* wl = ws + OFF_W + layer * W_LAYER;
    const u16* proj = (const u16*)(ws + OFF_PROJ);
    u16* chid = (u16*)(ws + OFF_CHID);
    const float* cbias = (const float*)(wl + WO_CB);
    for (int c = 0; c < 2; ++c) {
        u16* ch = chid + (size_t)c * CROWS * 256;
        const float* cb = cbias + c * 256;
        gemm_phase<1>(proj + C_NKV + c * 128, 0, (const u16*)(wl + WO_W1) + (size_t)c * 256 * 2048, 2048, CROWS, 256, 2048, (u16*)smem,
                      [=](int row, int col, float v) { ch[(long)row * 256 + col] = f2bf(gelu_tanh(v + cb[col])); });
    }
}

__device__ __forceinline__ void phase_c2(const Params& P, int layer, unsigned char* smem) {
    unsigned char* ws = opq(P.ws);
    unsigned char* wl = ws + OFF_W + layer * W_LAYER;
    const u16* chid = (const u16*)(ws + OFF_CHID);
    float* cbuf = (float*)(ws + OFF_CBUF);
    for (int c = 0; c < 2; ++c) {
        float* cbo = cbuf + (size_t)c * CROWS * 64;
        gemm_phase<0>(chid + (size_t)c * CROWS * 256, 256, (const u16*)(wl + WO_W2) + (size_t)c * 64 * 256, 256, CROWS, 64, 256, (u16*)smem,
                      [=](int row, int col, float v) { cbo[(long)row * 64 + col] = v; });
    }
}

__device__ __forceinline__ void phase_c3(const Params& P, int layer) {
    unsigned char* ws = opq(P.ws);
    const int lane = tidx() & 63, w = tidx() >> 6;
    const float* cbuf = (const float*)(ws + OFF_CBUF);
    u16* kcb = (u16*)(ws + OFF_KCB);
    u16* vcb = (u16*)(ws + OFF_VCB);
    const float* ropec = (const float*)(ws + OFF_ROPE);
    const float* ropes = ropec + (size_t)NTOK * 8;
    const float* gain = P.nsa_gain + layer * 256 + 64;
    for (int r = bidx() * 4 + w; r < 2 * CROWS; r += gdim() * 4) {
        int c = r / CROWS, rr = r - c * CROWS;
        int b = rr / (NCMP * 2);
        int rem = rr - b * (NCMP * 2);
        int n = rem >> 1, g = rem & 1;
        float v = cbuf[(size_t)r * 64 + lane];
        size_t o = ((size_t)(b * 2 + g) * 256 + n) * 64 + lane;
        if (c == 0) {
            float ss = wsum(v * v);
            v = v * rsqrtf(ss * (1.0f / 64.0f) + EPS) * gain[lane];
            float pv = __shfl_xor(v, 8);
            if (lane < 16) {
                long tt = (long)b * SEQ + 31 + 16 * n;
                float cs = ropec[tt * 8 + (lane & 7)], sn = ropes[tt * 8 + (lane & 7)];
                v = (lane < 8) ? (v * cs - pv * sn) : (v * cs + pv * sn);
            }
            kcb[o] = f2bf(v);
        } else {
            vcb[o] = f2bf(v);
        }
    }
}

__device__ __forceinline__ int balance4(int x, int seg) {
    const int k = x / seg, r = x - k * seg;
    return k == 0 ? r : (k == 1 ? 4 * seg - 1 - r : (k == 2 ? seg + r : 3 * seg - 1 - r));
}
__device__ __forceinline__ void phase_att_a(const Params& P, unsigned char* smem) {
    unsigned char* ws = opq(P.ws);
    for (int u = bidx(); u < NTOK / 4; u += gdim()) dsa_select_unit(ws, u, smem);
}
__device__ __forceinline__ void phase_att_b(const Params& P, unsigned char* smem) {
    {
        unsigned char* ws = opq(P.ws);
        for (int u = bidx(); u < 2048; u += gdim()) dsa_attn_unit(ws, u & 7, balance4(u >> 3, 64), smem);
    }
    {
        unsigned char* ws = opq(P.ws);
        for (int u = bidx(); u < 2048; u += gdim()) nsa_unit(ws, (u & 15) >> 1, u & 1, balance4(u >> 4, 32), smem);
    }
}

__device__ __forceinline__ void phase_merge(const Params& P, int layer, unsigned char* smem) {
    unsigned char* ws = opq(P.ws);
    unsigned char* wl = ws + OFF_W + layer * W_LAYER;
    const u16* proj = (const u16*)(ws + OFF_PROJ);
    u16* hbuf = (u16*)(ws + OFF_H);
    const u16* ya = (const u16*)(ws + OFF_YAB);
    const u16* yb = ya + (size_t)NTOK * 512;
    gemm_phase<0>(ya, 512, (const u16*)(wl + WO_WA), 512, NTOK, 1024, 512, (u16*)smem, [=](int row, int col, float v) {
        float ga = bf2f(proj[(long)row * IN_COLS + C_MG + col]);
        hbuf[(long)row * 1024 + col] = f2bf(ga * v);
    });
    gemm_phase<0>(yb, 512, (const u16*)(wl + WO_WB), 512, NTOK, 1024, 512, (u16*)smem, [=](int row, int col, float v) {
        float gb = bf2f(proj[(long)row * IN_COLS + C_MG + 1024 + col]);
        long o = (long)row * 1024 + col;
        hbuf[o] = f2bf(bf2f(hbuf[o]) + gb * v);
    });
}

__device__ __forceinline__ void phase_outproj(const Params& P, int layer, unsigned char* smem) {
    unsigned char* ws = opq(P.ws);
    unsigned char* wl = ws + OFF_W + layer * W_LAYER;
    float* out = opq(P.out);
    const float* xin = (layer == 0) ? P.x : (const float*)out;
    gemm_phase<0>((const u16*)(ws + OFF_H), 1024, (const u16*)(wl + WO_WO), 1024, NTOK, 1024, 1024, (u16*)smem, [=](int row, int col, float v) {
        long o = (long)row * 1024 + col;
        out[o] = xin[o] + v;
    });
    cvt_rows_fp8(P.peer_u + (size_t)layer * NEXP * 1024, ws + OFF_UB, (float*)(ws + OFF_ESC), NEXP);
    cvt_rows_fp8(P.peer_v + (size_t)layer * NEXP * 1024, ws + OFF_VB, (float*)(ws + OFF_ESC) + NEXP, NEXP);
}

__device__ __forceinline__ void phase_pq(const Params& P, int layer, unsigned char* smem) {
    unsigned char* ws = opq(P.ws);
    unsigned char* wl = ws + OFF_W + layer * W_LAYER;
    u16* pq = (u16*)(ws + OFF_PQ);
    u16* eb = (u16*)(ws + OFF_YAB);
    gemm_phase<0>((const u16*)(ws + OFF_H), 1024, (const u16*)(wl + WO_WQ), 1024, NTOK, 2048, 1024, (u16*)smem,
                  [=](int row, int col, float v) { pq[(long)row * 2048 + col] = f2bf(v); });
    gemm_phase<2>(P.p + (size_t)layer * NTOK * 256, 256, (const u16*)(wl + WO_PW), 256, NTOK, 1024, 256, (u16*)smem,
                  [=](int row, int col, float v) { eb[(long)row * 1024 + col] = f2bf(v); });
}

__device__ __forceinline__ void phase_final(const Params& P, int layer, unsigned char* smem) {
    unsigned char* ws = opq(P.ws);
    unsigned char* wl = ws + OFF_W + layer * W_LAYER;
    float* out = opq(P.out);
    const u16* eb = (const u16*)(ws + OFF_YAB);
    const float* rstde = (const float*)(ws + OFF_RSTDE);
    const float* pn = P.ple_norm + layer * 1024;
    gemm_phase<0>((const u16*)(ws + OFF_H), 1024, (const u16*)(wl + WO_PG), 1024, NTOK, 1024, 1024, (u16*)smem, [=](int row, int col, float v) {
        long o = (long)row * 1024 + col;
        out[o] = out[o] + sigmoidf(v) * (bf2f(eb[o]) * rstde[row] * pn[col]);
    });
}


#define XB_TMO      128
#define XB_XCNT(j)  (256  + 64 * (j))
#define XB_XSUB(j)  (1280 + 64 * (j))
#define XB_XGEN(j)  (2304 + 64 * (j))
#define XB_TOP      3328
#define XB_TOPGEN   3392
#define XCD_BAR_WORDS 3456
#define XB_SPIN_CAP (1u << 22)
#define LAS __attribute__((address_space(3)))
__device__ __forceinline__ unsigned xb_ld(unsigned* p) { return __hip_atomic_load(p, __ATOMIC_RELAXED, __HIP_MEMORY_SCOPE_AGENT); }
__device__ __forceinline__ unsigned xb_add(unsigned* p, unsigned v) { return __hip_atomic_fetch_add(p, v, __ATOMIC_RELAXED, __HIP_MEMORY_SCOPE_AGENT); }
__device__ __forceinline__ unsigned xb_xcc_id() { return (unsigned)__builtin_amdgcn_s_getreg((3 << 11) | 20) & 0xFu; }
#define XB_SPIN(cond, bar) do { unsigned _sp = 0; while (cond) { __builtin_amdgcn_s_sleep(1); \
    if ((++_sp & 255u) == 0u) { if (xb_ld(&(bar)[XB_TMO])) break; if (_sp > XB_SPIN_CAP) { atomicAdd(&(bar)[XB_TMO], 1u); break; } } } } while (0)
struct XcdBarrier {
    unsigned* bar; unsigned x;
    volatile LAS unsigned* st;
};
__device__ __forceinline__ XcdBarrier xcd_barrier_post(unsigned* bar, volatile LAS unsigned* st) {
    XcdBarrier b; b.bar = bar; b.x = xb_xcc_id(); b.st = st;
    if (threadIdx.x == 0) (void)xb_add(&bar[XB_XCNT(b.x)], 1u);
    return b;
}
__device__ __forceinline__ void xcd_barrier_complete(unsigned* bar, unsigned x, unsigned& nloc, unsigned& nx) {
    const unsigned G = gridDim.x * gridDim.y * gridDim.z;
    unsigned sum, cnt, mine, sp = 0u;
    for (;;) {
        sum = 0u; cnt = 0u; mine = 0u;
#pragma unroll
        for (unsigned j = 0; j < 16; ++j) { const unsigned c = xb_ld(&bar[XB_XCNT(j)]); sum += c; cnt += (c > 0u) ? 1u : 0u; mine = (j == x) ? c : mine; }
        if (sum == G) break;
        __builtin_amdgcn_s_sleep(1);
        if ((++sp & 255u) == 0u) { if (xb_ld(&bar[XB_TMO])) break; if (sp > XB_SPIN_CAP) { atomicAdd(&bar[XB_TMO], 1u); break; } }
    }
    nloc = mine > 0u ? mine : 1u; nx = cnt > 0u ? cnt : 1u;
}
__device__ __forceinline__ void xcd_barrier(const XcdBarrier& b) {
    asm volatile("s_waitcnt vmcnt(0)" ::: "memory");
    __syncthreads();
    if (threadIdx.x == 0) {
        unsigned* bar = b.bar;
        __builtin_amdgcn_s_waitcnt(0);
        unsigned nloc = b.st[0], nx = b.st[1];
        if (nloc == 0u) { xcd_barrier_complete(bar, b.x, nloc, nx); b.st[0] = nloc; b.st[1] = nx; }
        const unsigned old = xb_add(&bar[XB_XSUB(b.x)], 1u);
        const unsigned gen = old / nloc;
        if (old + 1u == (gen + 1u) * nloc) {
            __builtin_amdgcn_fence(__ATOMIC_RELEASE, "agent");
            asm volatile("s_waitcnt vmcnt(0)" ::: "memory");
            const unsigned og = xb_add(&bar[XB_TOP], 1u);
            const unsigned tg = og / nx;
            if (og + 1u == (tg + 1u) * nx) xb_add(&bar[XB_TOPGEN], 1u);
            else XB_SPIN(xb_ld(&bar[XB_TOPGEN]) == tg, bar);
            __builtin_amdgcn_fence(__ATOMIC_ACQUIRE, "agent");
            xb_add(&bar[XB_XGEN(b.x)], 1u);
            asm volatile("s_waitcnt vmcnt(0)" ::: "memory");
        } else {
            XB_SPIN(xb_ld(&bar[XB_XGEN(b.x)]) == gen, bar);
            __builtin_amdgcn_fence(__ATOMIC_ACQUIRE, "agent");
            asm volatile("s_waitcnt vmcnt(0)" ::: "memory");
        }
    }
    __syncthreads();
}

#ifndef PROBE_MASK
#define PROBE_MASK 0ull
#endif
#ifndef PROBE_MULT
#define PROBE_MULT 4
#endif
#define GSYNC(id)                                                                          \
    do {                                                                                   \
        xcd_barrier(xb);                                                                   \
        if (PROBE_MASK != 0ull) {                                                          \
            unsigned long long now_ = __builtin_amdgcn_s_memrealtime();                    \
            if ((PROBE_MASK >> (id)) & 1ull) tsel += now_ - tprev;                         \
            tprev = now_;                                                                  \
        }                                                                                  \
    } while (0)

__global__ void __launch_bounds__(256, 2) fwd_kernel(Params P) {
    cg::grid_group grid = cg::this_grid();
    extern __shared__ __attribute__((aligned(16))) unsigned char smem[];
    unsigned long long tprev = 0, tsel = 0;
    if (PROBE_MASK != 0ull) tprev = __builtin_amdgcn_s_memrealtime();
    volatile LAS unsigned* xst = (volatile LAS unsigned*)(smem + LDS_BYTES);
    if (threadIdx.x == 0) { xst[0] = 0u; xst[1] = 0u; xst[2] = 0u; xst[3] = 0u; }
    __syncthreads();
    XcdBarrier xb = xcd_barrier_post((unsigned*)(P.ws + OFF_BAR), xst);
    phase_prep(P, smem);
    grid.sync();
    if (PROBE_MASK != 0ull) {
        unsigned long long now_ = __builtin_amdgcn_s_memrealtime();
        if (PROBE_MASK & 1ull) tsel += now_ - tprev;
        tprev = now_;
    }
    for (int layer = 0; layer < 2; ++layer) {
        const int pb = 1 + 16 * layer;
        phase_g1(P, layer, smem);
        GSYNC(pb + 0);
        post_proj(opq(P.ws), P.nsa_gain + layer * 256, P.dsa_gain + layer * 128, smem);
        GSYNC(pb + 1);
        phase_c1(P, layer, smem);
        GSYNC(pb + 2);
        phase_c2(P, layer, smem);
        GSYNC(pb + 3);
        phase_c3(P, layer);
        GSYNC(pb + 4);
        phase_att_a(P, smem);
        GSYNC(pb + 15);
        phase_att_b(P, smem);
        GSYNC(pb + 5);
        phase_merge(P, layer, smem);
        GSYNC(pb + 6);
        phase_outproj(P, layer, smem);
        GSYNC(pb + 7);
        {
            unsigned char* ws = opq(P.ws);
            rms_rows(opq(P.out), P.ffn_norm + layer * 1024, (u16*)(ws + OFF_H), nullptr, nullptr);
        }
        GSYNC(pb + 8);
        phase_pq(P, layer, smem);
        GSYNC(pb + 9);
        peer_route(opq(P.ws), layer, smem);
        GSYNC(pb + 10);
        peer_experts(opq(P.ws), opq(P.out));
        GSYNC(pb + 11);
        {
            unsigned char* ws = opq(P.ws);
            rms_rows(opq(P.out), nullptr, (u16*)(ws + OFF_H), (const u16*)(ws + OFF_YAB), (float*)(ws + OFF_RSTDE));
        }
        GSYNC(pb + 12);
        phase_final(P, layer, smem);
        GSYNC(pb + 13);
        if (layer == 0) {
            unsigned char* ws = opq(P.ws);
            rms_rows(opq(P.out), P.attn_norm + 1024, (u16*)(ws + OFF_H), nullptr, nullptr);
            GSYNC(pb + 14);
        }
    }
    if (PROBE_MASK != 0ull) {
        if (blockIdx.x == 0 && threadIdx.x == 0) {
            unsigned long long t0 = __builtin_amdgcn_s_memrealtime();
            while (__builtin_amdgcn_s_memrealtime() - t0 < (unsigned long long)PROBE_MULT * tsel) __builtin_amdgcn_s_sleep(32);
        }
    }
}

extern "C" void kernel_launch(void* const* d_in, const int* in_sizes, int n_in, void* d_out, int out_size, void* d_ws, size_t ws_size,
                              hipStream_t stream) {
    static int grid_blocks = 0;
    if (!grid_blocks) {
        int dev = 0, cus = 0, per_cu = 0;
        (void)hipGetDevice(&dev);
        (void)hipDeviceGetAttribute(&cus, hipDeviceAttributeMultiprocessorCount, dev);
        (void)hipFuncSetAttribute((const void*)fwd_kernel, hipFuncAttributeMaxDynamicSharedMemorySize, LDS_BYTES + 16);
        (void)hipOccupancyMaxActiveBlocksPerMultiprocessor(&per_cu, fwd_kernel, 256, LDS_BYTES + 16);
        if (per_cu > 2) per_cu = 2;
        if (per_cu < 1) per_cu = 1;
        grid_blocks = cus * per_cu;
        if (ws_size < WS_END) fprintf(stderr, "kernel_launch: workspace too small: %zu < %zu\n", ws_size, (size_t)WS_END);
    }
    Params P{};
    P.x = (const float*)d_in[0];
    P.p = (const float*)d_in[1];
    P.positions = (const int*)d_in[2];
    P.attn_norm = (const float*)d_in[3];
    P.w_in = (const float*)d_in[4];
    P.nsa_gain = (const float*)d_in[5];
    P.cmp_pos = (const float*)d_in[6];
    P.cmp_w1 = (const float*)d_in[7];
    P.cmp_w2 = (const float*)d_in[8];
    P.dsa_gain = (const float*)d_in[9];
    P.w_a = (const float*)d_in[10];
    P.w_b = (const float*)d_in[11];
    P.w_out = (const float*)d_in[12];
    P.ffn_norm = (const float*)d_in[13];
    P.peer_wq = (const float*)d_in[14];
    P.peer_sk = (const float*)d_in[15];
    P.peer_u = (const float*)d_in[16];
    P.peer_v = (const float*)d_in[17];
    P.ple_w = (const float*)d_in[18];
    P.ple_gw = (const float*)d_in[19];
    P.ple_norm = (const float*)d_in[20];
    P.out = (float*)d_out;
    P.ws = (unsigned char*)d_ws;
    void* args[] = {&P};
    (void)hipMemsetAsync((unsigned char*)d_ws + OFF_BAR, 0, 3456 * 4, stream);
    hipError_t e = hipLaunchCooperativeKernel((void*)fwd_kernel, dim3(grid_blocks), dim3(256), args, LDS_BYTES + 16, stream);
    if (e != hipSuccess) fprintf(stderr, "cooperative launch failed: %s (grid %d)\n", hipGetErrorString(e), grid_blocks);
}
```

```cpp
#include <hip/hip_runtime.h>
#include <hip/hip_cooperative_groups.h>
#include <cstdio>
#include <cstdint>
namespace cg = cooperative_groups;

typedef unsigned short u16;
typedef unsigned int u32;
typedef unsigned long long u64;
using bf16x8 = __attribute__((ext_vector_type(8))) short;
using f32x4 = __attribute__((ext_vector_type(4))) float;
using f32x16 = __attribute__((ext_vector_type(16))) float;
typedef __bf16 bf16x2_t __attribute__((ext_vector_type(2)));

constexpr int D_MODEL = 1024, BATCH = 8, SEQ = 4096, NTOK = BATCH * SEQ;
constexpr int IN_COLS = 4576;
constexpr int C_NQ = 0, C_NKV = 512, C_NG = 1280, C_DQ = 1304, C_DKV = 1816, C_IQ = 1944, C_IK = 2456, C_IW = 2520, C_MG = 2528;
constexpr int NCMP = 255;
constexpr int CROWS = BATCH * NCMP * 2;
constexpr int NEXP = 16384;
constexpr float EPS = 1e-6f;

constexpr size_t AL(size_t x) { return (x + 255) & ~(size_t)255; }
constexpr size_t WO_WIN = 0;
constexpr size_t WO_W1 = WO_WIN + AL((size_t)IN_COLS * 1024 * 2);
constexpr size_t WO_W2 = WO_W1 + AL((size_t)2 * 256 * 2048 * 2);
constexpr size_t WO_WA = WO_W2 + AL((size_t)2 * 64 * 256 * 2);
constexpr size_t WO_WB = WO_WA + AL((size_t)1024 * 512 * 2);
constexpr size_t WO_WO = WO_WB + AL((size_t)1024 * 512 * 2);
constexpr size_t WO_WQ = WO_WO + AL((size_t)1024 * 1024 * 2);
constexpr size_t WO_PW = WO_WQ + AL((size_t)2048 * 1024 * 2);
constexpr size_t WO_PG = WO_PW + AL((size_t)1024 * 256 * 2);
constexpr size_t WO_SK = WO_PG + AL((size_t)1024 * 1024 * 2);
constexpr size_t WO_CB = WO_SK + AL((size_t)2 * 128 * 128 * 2);
constexpr size_t W_LAYER = WO_CB + AL((size_t)2 * 256 * 4);

constexpr size_t OFF_W = 0;
constexpr size_t OFF_ROPE = OFF_W + 2 * W_LAYER;
constexpr size_t OFF_H = OFF_ROPE + AL((size_t)NTOK * 16 * 4);
constexpr size_t OFF_PROJ = OFF_H + AL((size_t)NTOK * 1024 * 2);
constexpr size_t OFF_YAB = OFF_PROJ + AL((size_t)NTOK * IN_COLS * 2);
constexpr size_t OFF_CHID = OFF_YAB + AL((size_t)NTOK * 1024 * 2);
constexpr size_t OFF_CBUF = OFF_CHID + AL((size_t)2 * CROWS * 256 * 2);
constexpr size_t OFF_KCB = OFF_CBUF + AL((size_t)2 * CROWS * 64 * 4);
constexpr size_t OFF_VCB = OFF_KCB + AL((size_t)BATCH * 2 * 256 * 64 * 2);
constexpr size_t OFF_RSTDE = OFF_VCB + AL((size_t)BATCH * 2 * 256 * 64 * 2);
constexpr size_t OFF_BITS = OFF_RSTDE + AL((size_t)NTOK * 4);
constexpr size_t OFF_BAR = OFF_BITS + AL((size_t)NTOK * 64 * 8);
constexpr size_t WS_END = OFF_BAR + AL(3456 * 4);
constexpr size_t OFF_PQ = OFF_PROJ;
constexpr size_t OFF_UB = OFF_PQ + (size_t)NTOK * 2048 * 2;
constexpr size_t OFF_VB = OFF_UB + (size_t)NEXP * 1024 * 2;
constexpr size_t OFF_EIDX = OFF_VB + (size_t)NEXP * 1024 * 2;
constexpr size_t OFF_GATE = OFF_EIDX + (size_t)NTOK * 128 * 4;
constexpr size_t OFF_ESC = OFF_GATE + (size_t)NTOK * 128 * 4;
constexpr size_t OFF_PBF = OFF_ESC + (size_t)2 * NEXP * 4;
static_assert(OFF_PBF + (size_t)NTOK * 256 * 2 <= OFF_YAB, "alias overflow");

constexpr int LDS_BYTES = 65536 + 2048;

struct Params {
    const float* x; const float* p; const int* positions;
    const float* attn_norm; const float* w_in; const float* nsa_gain; const float* cmp_pos; const float* cmp_w1; const float* cmp_w2;
    const float* dsa_gain; const float* w_a; const float* w_b; const float* w_out; const float* ffn_norm; const float* peer_wq;
    const float* peer_sk; const float* peer_u; const float* peer_v; const float* ple_w; const float* ple_gw; const float* ple_norm;
    float* out; unsigned char* ws;
};

__device__ __forceinline__ u16 f2bf(float f) {
    u32 u = __float_as_uint(f);
    u32 r = u + 0x7FFFu + ((u >> 16) & 1u);
    return (u16)(r >> 16);
}
__device__ __forceinline__ float bf2f(u16 h) { return __uint_as_float(((u32)h) << 16); }
__device__ __forceinline__ float bf_lo(u32 w) { return __uint_as_float(w << 16); }
__device__ __forceinline__ float bf_hi(u32 w) { return __uint_as_float(w & 0xFFFF0000u); }
__device__ __forceinline__ u32 pack2(float a, float b) {
    bf16x2_t v = {(__bf16)a, (__bf16)b};
    return __builtin_bit_cast(u32, v);
}
__device__ __forceinline__ float dot2(u32 a, u32 b, float c) {
    return __builtin_amdgcn_fdot2_f32_bf16(__builtin_bit_cast(bf16x2_t, a), __builtin_bit_cast(bf16x2_t, b), c, false);
}
__device__ __forceinline__ float wsum(float v) {
#pragma unroll
    for (int o = 32; o > 0; o >>= 1) v += __shfl_xor(v, o);
    return v;
}
__device__ __forceinline__ float wmax(float v) {
#pragma unroll
    for (int o = 32; o > 0; o >>= 1) v = fmaxf(v, __shfl_xor(v, o));
    return v;
}
__device__ __forceinline__ int wsumi(int v) {
#pragma unroll
    for (int o = 32; o > 0; o >>= 1) v += __shfl_xor(v, o);
    return v;
}
__device__ __forceinline__ float sigmoidf(float x) { return 1.0f / (1.0f + __expf(-x)); }
__device__ __forceinline__ float gelu_tanh(float x) {
    float u = 0.7978845608028654f * (x + 0.044715f * x * x * x);
    return 0.5f * x * (1.0f + tanhf(u));
}
#define WAVE_SYNC() asm volatile("s_waitcnt lgkmcnt(0)" ::: "memory")
template <class T>
__device__ __forceinline__ T* opq(T* p) {
    asm volatile("" : "+s"(p));
    return p;
}
__device__ __forceinline__ int tidx() {
    int t = threadIdx.x;
    asm volatile("" : "+v"(t));
    return t;
}
__device__ __forceinline__ int bidx() {
    int b = blockIdx.x;
    asm volatile("" : "+s"(b));
    return b;
}
__device__ __forceinline__ int gdim() {
    int g = gridDim.x;
    asm volatile("" : "+s"(g));
    return g;
}

template <int AMODE, class Epi>
__device__ __forceinline__ void gemm_tile(const u16* __restrict__ Ap, long lda, const u16* __restrict__ BT, long ldb, int M, int N, int K, int m0,
                                          int n0, unsigned char* lds, Epi epi) {
    const int tid = tidx(), lane = tid & 63, w = tid >> 6;
    const int wm = w >> 1, wn = w & 1;
    f32x4 acc[4][4];
#pragma unroll
    for (int i = 0; i < 4; ++i)
#pragma unroll
        for (int j = 0; j < 4; ++j) acc[i][j] = f32x4{0.f, 0.f, 0.f, 0.f};
    long aoff[4], boff[4];
#pragma unroll
    for (int i = 0; i < 4; ++i) {
        const int row = (w * 4 + i) * 8 + (lane >> 3);
        const int kc = (lane & 7) ^ ((row >> 1) & 7);
        int gr = m0 + row;
        if (gr > M - 1) gr = M - 1;
        if (AMODE == 1) {
            int b = gr / (NCMP * 2);
            int rem = gr - b * (NCMP * 2);
            aoff[i] = ((long)b * SEQ + 16 * (rem >> 1)) * IN_COLS + (rem & 1) * 64 + kc * 8;
        } else {
            aoff[i] = (long)gr * lda + kc * 8;
        }
        int gn = n0 + row;
        if (gn > N - 1) gn = N - 1;
        boff[i] = (long)gn * ldb + kc * 8;
    }
    const int nk = K / 64;
#define GEMM_STAGE(kt, bufsel)                                                                                                        \
    do {                                                                                                                              \
        unsigned char* ab_ = lds + (bufsel) * 32768 + w * 4096 + lane * 16;                                                           \
        const long ka_ = (AMODE == 1) ? (long)(kt) * IN_COLS : (long)(kt) * 64;                                                       \
        _Pragma("unroll") for (int i_ = 0; i_ < 4; ++i_) {                                                                            \
            __builtin_amdgcn_global_load_lds((const unsigned*)(Ap + aoff[i_] + ka_), (unsigned*)(ab_ + i_ * 1024), 16, 0, 0);        \
            __builtin_amdgcn_global_load_lds((const unsigned*)(BT + boff[i_] + (long)(kt) * 64), (unsigned*)(ab_ + 16384 + i_ * 1024), 16, 0, 0); \
        }                                                                                                                             \
    } while (0)
    GEMM_STAGE(0, 0);
    asm volatile("s_waitcnt vmcnt(0)" ::: "memory");
    __syncthreads();
    int fa[4], fb[4];
#pragma unroll
    for (int i = 0; i < 4; ++i) {
        const int ra = wm * 64 + i * 16 + (lane & 15), rb = wn * 64 + i * 16 + (lane & 15);
        fa[i] = ra * 128 + ((ra >> 1) & 7) * 16;
        fb[i] = rb * 128 + ((rb >> 1) & 7) * 16;
    }
    for (int kt = 0; kt < nk; ++kt) {
        if (kt + 1 < nk) GEMM_STAGE(kt + 1, (kt + 1) & 1);
        const unsigned char* Ab = lds + (kt & 1) * 32768;
        const unsigned char* Bb = Ab + 16384;
#pragma unroll
        for (int ks = 0; ks < 2; ++ks) {
            const int kc16 = (ks * 4 + (lane >> 4)) * 16;
            bf16x8 af[4], bfr[4];
#pragma unroll
            for (int i = 0; i < 4; ++i) {
                af[i] = *(const bf16x8*)(Ab + ((fa[i] & ~127) | ((fa[i] & 127) ^ kc16)));
                bfr[i] = *(const bf16x8*)(Bb + ((fb[i] & ~127) | ((fb[i] & 127) ^ kc16)));
            }
#pragma unroll
            for (int i = 0; i < 4; ++i)
#pragma unroll
                for (int j = 0; j < 4; ++j) acc[i][j] = __builtin_amdgcn_mfma_f32_16x16x32_bf16(af[i], bfr[j], acc[i][j], 0, 0, 0);
        }
        asm volatile("s_waitcnt vmcnt(0)" ::: "memory");
        __syncthreads();
    }
#undef GEMM_STAGE
    float* st = (float*)(lds + w * 8704);
#pragma unroll
    for (int hh = 0; hh < 2; ++hh) {
#pragma unroll
        for (int m2 = 0; m2 < 2; ++m2)
#pragma unroll
            for (int j = 0; j < 4; ++j)
#pragma unroll
                for (int r = 0; r < 4; ++r) st[(m2 * 16 + (lane >> 4) * 4 + r) * 68 + j * 16 + (lane & 15)] = acc[hh * 2 + m2][j][r];
        WAVE_SYNC();
#pragma unroll
        for (int c = 0; c < 4; ++c) {
            const int id = c * 64 + lane;
            const int rr = id >> 3, cc = id & 7;
            const float4 v0 = *(const float4*)(st + rr * 68 + cc * 8);
            const float4 v1 = *(const float4*)(st + rr * 68 + cc * 8 + 4);
            const float v[8] = {v0.x, v0.y, v0.z, v0.w, v1.x, v1.y, v1.z, v1.w};
            const int row = m0 + wm * 64 + hh * 32 + rr;
            const int col0 = n0 + wn * 64 + cc * 8;
            if (row < M && col0 < N) epi(row, col0, v);
        }
        WAVE_SYNC();
    }
    __syncthreads();
}

template <int AMODE, class Epi>
__device__ __forceinline__ void gemm_phase(const u16* Ap, long lda, const u16* BT, long ldb, int M, int N, int K, unsigned char* lds, Epi epi) {
    const int tm = (M + 127) / 128, tn = (N + 127) / 128;
    for (int t = bidx(); t < tm * tn; t += gdim()) {
        int im = t / tn, in = t - im * tn;
        gemm_tile<AMODE>(Ap, lda, BT, ldb, M, N, K, im * 128, in * 128, lds, epi);
    }
}
__device__ __forceinline__ void st_bf8(u16* p, const float (&v)[8]) {
    *(uint4*)p = uint4{pack2(v[0], v[1]), pack2(v[2], v[3]), pack2(v[4], v[5]), pack2(v[6], v[7])};
}
__device__ __forceinline__ void ld_bf8(const u16* p, float (&v)[8]) {
    const uint4 q = *(const uint4*)p;
    v[0] = bf_lo(q.x); v[1] = bf_hi(q.x); v[2] = bf_lo(q.y); v[3] = bf_hi(q.y);
    v[4] = bf_lo(q.z); v[5] = bf_hi(q.z); v[6] = bf_lo(q.w); v[7] = bf_hi(q.w);
}

__device__ __forceinline__ void transpose_cvt(const float* __restrict__ src, u16* __restrict__ dst, int K, int N, float* tile) {
    const int tk = K / 64, tn = (N + 63) / 64;
    const int tx = tidx() & 63, ty = tidx() >> 6;
    for (int t = bidx(); t < tk * tn; t += gdim()) {
        int k0 = (t / tn) * 64, n0 = (t % tn) * 64;
#pragma unroll
        for (int r = 0; r < 16; ++r) {
            int k = ty * 16 + r, n = n0 + tx;
            tile[k * 65 + tx] = (n < N) ? src[(long)(k0 + k) * N + n] : 0.f;
        }
        __syncthreads();
#pragma unroll
        for (int r = 0; r < 16; ++r) {
            int nn = ty * 16 + r, n = n0 + nn;
            if (n < N) dst[(long)n * K + k0 + tx] = f2bf(tile[tx * 65 + nn]);
        }
        __syncthreads();
    }
}

__device__ __forceinline__ void cvt_f32_bf16(const float* __restrict__ src, u16* __restrict__ dst, long n) {
    long i = ((long)bidx() * 256 + tidx()) * 8;
    const long stride = (long)gdim() * 256 * 8;
    for (; i < n; i += stride) {
        float4 a = *(const float4*)(src + i);
        float4 b = *(const float4*)(src + i + 4);
        *(uint4*)(dst + i) = uint4{pack2(a.x, a.y), pack2(a.z, a.w), pack2(b.x, b.y), pack2(b.z, b.w)};
    }
}

typedef float f32x2_t __attribute__((ext_vector_type(2)));
__device__ __forceinline__ void cvt_rows_fp8(const float* __restrict__ src, unsigned char* __restrict__ dst, float* __restrict__ scales, int nrows) {
    const int lane = tidx() & 63;
    const int wid = bidx() * 4 + (tidx() >> 6);
    const int nw = gdim() * 4;
    for (int row = wid; row < nrows; row += nw) {
        const float* r = src + (long)row * 1024 + lane * 16;
        float4 q[4];
#pragma unroll
        for (int i = 0; i < 4; ++i) q[i] = *(const float4*)(r + 4 * i);
        float am = 0.f;
#pragma unroll
        for (int i = 0; i < 4; ++i) am = fmaxf(am, fmaxf(fmaxf(fabsf(q[i].x), fabsf(q[i].y)), fmaxf(fabsf(q[i].z), fabsf(q[i].w))));
        am = wmax(am);
        const float inv = am > 0.f ? 448.0f / am : 0.f;
        if (lane == 0) scales[row] = am > 0.f ? am * (1.0f / 448.0f) : 0.f;
        u32 wv[4];
#pragma unroll
        for (int i = 0; i < 4; ++i) {
            int x = 0;
            x = __builtin_amdgcn_cvt_pk_fp8_f32(q[i].x * inv, q[i].y * inv, x, false);
            x = __builtin_amdgcn_cvt_pk_fp8_f32(q[i].z * inv, q[i].w * inv, x, true);
            wv[i] = (u32)x;
        }
        *(uint4*)(dst + (long)row * 1024 + lane * 16) = uint4{wv[0], wv[1], wv[2], wv[3]};
    }
}

__device__ __forceinline__ void rms_rows(const float* __restrict__ x, const float* __restrict__ g, u16* __restrict__ dst, const u16* __restrict__ e,
                         float* __restrict__ rstd_e) {
    const int lane = tidx() & 63;
    const int wid = bidx() * 4 + (tidx() >> 6);
    const int nw = gdim() * 4;
    for (int row = wid; row < NTOK; row += nw) {
        const float* xr = x + (long)row * 1024;
        float4 v[4];
        float ss = 0.f;
#pragma unroll
        for (int i = 0; i < 4; ++i) {
            v[i] = *(const float4*)(xr + i * 256 + lane * 4);
            ss += v[i].x * v[i].x + v[i].y * v[i].y + v[i].z * v[i].z + v[i].w * v[i].w;
        }
        ss = wsum(ss);
        float rstd = rsqrtf(ss * (1.0f / 1024.0f) + EPS);
#pragma unroll
        for (int i = 0; i < 4; ++i) {
            float4 gg = g ? *(const float4*)(g + i * 256 + lane * 4) : float4{1.f, 1.f, 1.f, 1.f};
            uint2 o = uint2{pack2(v[i].x * rstd * gg.x, v[i].y * rstd * gg.y), pack2(v[i].z * rstd * gg.z, v[i].w * rstd * gg.w)};
            *(uint2*)(dst + (long)row * 1024 + i * 256 + lane * 4) = o;
        }
        if (e) {
            const uint4* er = (const uint4*)(e + (long)row * 1024);
            float es = 0.f;
#pragma unroll
            for (int i = 0; i < 2; ++i) {
                uint4 q = er[i * 64 + lane];
                float a;
                a = bf_lo(q.x); es += a * a; a = bf_hi(q.x); es += a * a;
                a = bf_lo(q.y); es += a * a; a = bf_hi(q.y); es += a * a;
                a = bf_lo(q.z); es += a * a; a = bf_hi(q.z); es += a * a;
                a = bf_lo(q.w); es += a * a; a = bf_hi(q.w); es += a * a;
            }
            es = wsum(es);
            if (lane == 0) rstd_e[row] = rsqrtf(es * (1.0f / 1024.0f) + EPS);
        }
    }
}

__device__ __forceinline__ void head_chunk(u16* ptr, float gain, bool do_norm, float scale, float c, float sn, int lane) {
    float v = bf2f(ptr[lane]);
    if (do_norm) {
        float ss = wsum(v * v);
        v = v * rsqrtf(ss * (1.0f / 64.0f) + EPS) * gain;
    }
    float pv = __shfl_xor(v, 8);
    if (lane < 16) v = (lane < 8) ? (v * c - pv * sn) : (v * c + pv * sn);
    ptr[lane] = f2bf(v * scale);
}
__device__ __forceinline__ u32 sig2(u32 w) { return pack2(sigmoidf(bf_lo(w)), sigmoidf(bf_hi(w))); }

__device__ __forceinline__ void post_proj(unsigned char* ws, const float* ng, const float* dg, unsigned char* smem) {
    u16* proj = (u16*)(ws + OFF_PROJ);
    const float* ropec = (const float*)(ws + OFF_ROPE);
    const float* ropes = ropec + (size_t)NTOK * 8;
    const int lane = tidx() & 63, w = tidx() >> 6;
    u16* lrow = (u16*)(smem + w * 9216);
    const float g_q = ng[lane], g_ks = ng[128 + lane], g_kw = ng[192 + lane], g_dq = dg[lane], g_kb = dg[64 + lane];
    const int wid = bidx() * 4 + w;
    const int nw = gdim() * 4;
    for (int t = wid; t < NTOK; t += nw) {
        uint4* grow = (uint4*)(proj + (long)t * IN_COLS);
        const float c = ropec[(long)t * 8 + (lane & 7)], sn = ropes[(long)t * 8 + (lane & 7)];
#pragma unroll
        for (int i = 0; i < 8; ++i) ((uint4*)lrow)[i * 64 + lane] = grow[i * 64 + lane];
        if (lane < 60) ((uint4*)lrow)[512 + lane] = grow[512 + lane];
        WAVE_SYNC();
        for (int h = 0; h < 8; ++h) head_chunk(lrow + C_NQ + h * 64, g_q, true, 0.125f * 1.4426950408889634f, c, sn, lane);
        for (int g = 0; g < 2; ++g) head_chunk(lrow + C_NKV + (2 * 2 + g) * 64, g_ks, true, 1.0f, c, sn, lane);
        for (int g = 0; g < 2; ++g) head_chunk(lrow + C_NKV + (4 * 2 + g) * 64, g_kw, true, 1.0f, c, sn, lane);
        for (int h = 0; h < 8; ++h) head_chunk(lrow + C_DQ + h * 64, g_dq, true, 0.125f * 1.4426950408889634f, c, sn, lane);
        head_chunk(lrow + C_DKV, g_kb, true, 1.0f, c, sn, lane);
        for (int h = 0; h < 8; ++h) head_chunk(lrow + C_IQ + h * 64, 1.0f, false, 0.125f, c, sn, lane);
        head_chunk(lrow + C_IK, 1.0f, false, 1.0f, c, sn, lane);
        WAVE_SYNC();
#pragma unroll
        for (int i = 0; i < 9; ++i) {
            int idx = i * 64 + lane;
            if (idx < 572) {
                uint4 v = ((const uint4*)lrow)[idx];
                if (idx >= 316 || (idx >= 160 && idx < 163)) v = uint4{sig2(v.x), sig2(v.y), sig2(v.z), sig2(v.w)};
                grow[idx] = v;
            }
        }
        WAVE_SYNC();
    }
}

template <int NH>
__device__ __forceinline__ void qk_chunk(const u16* krow, const u32* qlds, float (&s)[NH]) {
    asm volatile("" ::: "memory");
    uint4 kr[8];
#pragma unroll
    for (int i = 0; i < 8; ++i) kr[i] = ((const uint4*)krow)[i];
#pragma unroll
    for (int h = 0; h < NH; ++h) s[h] = 0.f;
#pragma unroll
    for (int i = 0; i < 8; ++i)
#pragma unroll
        for (int h = 0; h < NH; ++h) {
            uint4 q = *(const uint4*)(qlds + h * 32 + i * 4);
            s[h] = dot2(kr[i].x, q.x, s[h]);
            s[h] = dot2(kr[i].y, q.y, s[h]);
            s[h] = dot2(kr[i].z, q.z, s[h]);
            s[h] = dot2(kr[i].w, q.w, s[h]);
        }
}

template <int NH, class VRow>
__device__ __forceinline__ void pv_chunk(const float* plds, VRow vrow, float (&o)[NH][4], int lane) {
    const int sub = lane >> 4, dq = lane & 15;
#pragma unroll 4
    for (int kk = 0; kk < 16; ++kk) {
        int key = kk * 4 + sub;
        const u16* vp = vrow(key);
        uint2 vv = *(const uint2*)(vp + dq * 4);
        float v0 = bf_lo(vv.x), v1 = bf_hi(vv.x), v2 = bf_lo(vv.y), v3 = bf_hi(vv.y);
#pragma unroll
        for (int h = 0; h < NH; ++h) {
            float ph = plds[key * NH + h];
            o[h][0] += ph * v0;
            o[h][1] += ph * v1;
            o[h][2] += ph * v2;
            o[h][3] += ph * v3;
        }
    }
}

template <int NH, class VRow>
__device__ __forceinline__ void attn_chunk(float (&s)[NH], bool valid, float (&m)[NH], float (&l)[NH], float (&o)[NH][4], float* plds, VRow vrow,
                                           int lane) {
#pragma unroll
    for (int h = 0; h < NH; ++h) {
        float sv = valid ? s[h] : -1e30f;
        float cm = wmax(sv);
        float mn = fmaxf(m[h], cm);
        float alpha = __expf(m[h] - mn);
        float p = valid ? __expf(sv - mn) : 0.f;
        l[h] = l[h] * alpha + wsum(p);
        m[h] = mn;
#pragma unroll
        for (int j = 0; j < 4; ++j) o[h][j] *= alpha;
        plds[lane * NH + h] = p;
    }
    WAVE_SYNC();
    pv_chunk<NH>(plds, vrow, o, lane);
    WAVE_SYNC();
}

#define MFMA32(a, b, c) __builtin_amdgcn_mfma_f32_32x32x16_bf16(a, b, c, 0, 0, 0)
typedef __attribute__((address_space(3))) const char* lds_cptr;
typedef short v4i16_t __attribute__((ext_vector_type(4)));
using s16x4 = __attribute__((ext_vector_type(4))) short;
__device__ __forceinline__ s16x4 vtr(lds_cptr p) {
    return __builtin_bit_cast(s16x4, __builtin_amdgcn_ds_read_tr16_b64_v4i16((__attribute__((address_space(3))) v4i16_t*)p));
}
__device__ __forceinline__ float swap32(float v) { return __shfl_xor(v, 32); }

using u32x4 = __attribute__((ext_vector_type(4))) unsigned;
struct TileRegs { u32x4 k0, k1, v0, v1; };
template <class RowPtr>
__device__ __forceinline__ void tile_load(u32x4& k0, u32x4& k1, u32x4& v0, u32x4& v1, RowPtr rowptr, int w, int lane) {
    const u16 *kp, *vp, *kp2, *vp2;
    rowptr(lane, kp, vp2);
    rowptr(16 * w + (lane >> 2), kp2, vp);
    k0 = *(const u32x4*)(kp + w * 8);
    k1 = *(const u32x4*)(kp + (w + 4) * 8);
    v0 = *(const u32x4*)(vp + (lane & 3) * 8);
    v1 = *(const u32x4*)(vp + 32 + (lane & 3) * 8);
}
__device__ __forceinline__ void tile_store(const u32x4& k0, const u32x4& k1, const u32x4& v0, const u32x4& v1, unsigned char* buf, int w, int lane) {
    *(u32x4*)(buf + w * 1024 + lane * 16) = k0;
    *(u32x4*)(buf + (w + 4) * 1024 + lane * 16) = k1;
    *(u32x4*)(buf + 8192 + (16 * w + (lane >> 2)) * 64 + (lane & 3) * 16) = v0;
    *(u32x4*)(buf + 8192 + 4096 + (16 * w + (lane >> 2)) * 64 + (lane & 3) * 16) = v1;
}
__device__ __forceinline__ void qk_tile(const unsigned char* buf, const bf16x8 (&qr)[4], f32x16& s0, f32x16& s1, int lane) {
    const int r32 = lane & 31, hi = lane >> 5;
    lds_cptr kp = (lds_cptr)buf + hi * 1024 + r32 * 16;
#pragma unroll
    for (int i = 0; i < 16; ++i) { s0[i] = 0.f; s1[i] = 0.f; }
#pragma unroll
    for (int d0 = 0; d0 < 4; ++d0) {
        bf16x8 k0 = *(const __attribute__((address_space(3))) bf16x8*)(kp + d0 * 2048);
        bf16x8 k1 = *(const __attribute__((address_space(3))) bf16x8*)(kp + d0 * 2048 + 512);
        s0 = MFMA32(k0, qr[d0], s0);
        s1 = MFMA32(k1, qr[d0], s1);
    }
}
__device__ __forceinline__ bf16x8 pack8(const f32x16& p, int s) {
    u32 a = pack2(p[8 * s + 0], p[8 * s + 1]), b = pack2(p[8 * s + 2], p[8 * s + 3]);
    u32 c = pack2(p[8 * s + 4], p[8 * s + 5]), d = pack2(p[8 * s + 6], p[8 * s + 7]);
    u32x4 v = u32x4{a, b, c, d};
    return __builtin_bit_cast(bf16x8, v);
}
__device__ __forceinline__ void pv_tile(const unsigned char* buf, const f32x16& p0, const f32x16& p1, f32x16 (&o)[2], int lane) {
    const int hi = lane >> 5;
    lds_cptr vp = (lds_cptr)buf + 8192 + ((lane >> 4) & 1) * 32 + (lane & 3) * 8 + (4 * hi + ((lane & 15) >> 2)) * 64;
    bf16x8 pf[4];
    pf[0] = pack8(p0, 0);
    pf[1] = pack8(p0, 1);
    pf[2] = pack8(p1, 0);
    pf[3] = pack8(p1, 1);
#pragma unroll
    for (int i = 0; i < 8; ++i) {
        const int dh = i >> 2, ks = i & 3;
        s16x4 vlo = vtr(vp + dh * 4096 + ks * 1024);
        s16x4 vhi = vtr(vp + dh * 4096 + ks * 1024 + 512);
        bf16x8 vf = (bf16x8){vlo[0], vlo[1], vlo[2], vlo[3], vhi[0], vhi[1], vhi[2], vhi[3]};
        o[dh] = MFMA32(vf, pf[ks], o[dh]);
    }
}
template <bool BITS>
__device__ __forceinline__ void apply_mask(f32x16& s0, f32x16& s1, int lo, int hi_lim, u64 word, int hi) {
    const u32 wlo = (u32)(word >> (4 * hi)), whi = (u32)(word >> (32 + 4 * hi));
#pragma unroll
    for (int i = 0; i < 16; ++i) {
        const int kc = (i & 3) + 8 * (i >> 2);
        bool v0, v1;
        if (BITS) {
            v0 = (wlo >> kc) & 1u;
            v1 = (whi >> kc) & 1u;
        } else {
            const int kk = kc + 4 * hi;
            v0 = (kk >= lo) && (kk <= hi_lim);
            v1 = (kk + 32 >= lo) && (kk + 32 <= hi_lim);
        }
        s0[i] = v0 ? s0[i] : -1e30f;
        s1[i] = v1 ? s1[i] : -1e30f;
    }
}
__device__ __forceinline__ void softmax_step(f32x16& s0, f32x16& s1, float& m, float& l, f32x16 (&o)[2]) {
    float mx = -1e30f;
#pragma unroll
    for (int i = 0; i < 16; ++i) mx = fmaxf(mx, fmaxf(s0[i], s1[i]));
    mx = fmaxf(mx, swap32(mx));
    const float mn = fmaxf(m, mx);
    const float alpha = __builtin_amdgcn_exp2f(m - mn);
    float sum = 0.f;
#pragma unroll
    for (int i = 0; i < 16; ++i) {
        s0[i] = (s0[i] > -1e29f) ? __builtin_amdgcn_exp2f(s0[i] - mn) : 0.f;
        s1[i] = (s1[i] > -1e29f) ? __builtin_amdgcn_exp2f(s1[i] - mn) : 0.f;
        sum += s0[i] + s1[i];
    }
    sum += swap32(sum);
    l = l * alpha + sum;
    m = mn;
#pragma unroll
    for (int i = 0; i < 16; ++i) { o[0][i] *= alpha; o[1][i] *= alpha; }
}

template <int MODE, bool BITS, class Next, class RowPtr, class MaskFn, class Extra>
__device__ __forceinline__ void flash_run(int first, Next next, RowPtr rowptr, MaskFn maskfn, Extra extra, const bf16x8 (&qr)[4], float& m, float& l,
                                          f32x16 (&o)[2], unsigned char* bufs, int w, int lane) {
    if (first < 0) return;
    u32x4 tk0, tk1, tv0, tv1;
    int cur = first;
    tile_load(tk0, tk1, tv0, tv1, [&](int r, const u16*& kp, const u16*& vp) { rowptr(cur, r, kp, vp); }, w, lane);
    __syncthreads();
    tile_store(tk0, tk1, tv0, tv1, bufs, w, lane);
    __syncthreads();
    int pb = 0;
    while (cur >= 0) {
        const int nxt = next(cur);
        if (nxt >= 0) tile_load(tk0, tk1, tv0, tv1, [&](int r, const u16*& kp, const u16*& vp) { rowptr(nxt, r, kp, vp); }, w, lane);
        const unsigned char* buf = bufs + pb * 16384;
        f32x16 s0, s1;
        qk_tile(buf, qr, s0, s1, lane);
        int lo, hl;
        u64 word;
        maskfn(cur, lo, hl, word);
        apply_mask<BITS>(s0, s1, lo, hl, word, lane >> 5);
        if (MODE == 0) {
            softmax_step(s0, s1, m, l, o);
            pv_tile(buf, s0, s1, o, lane);
        } else if (MODE == 1) {
            f32x16 od[2];
            softmax_step(s0, s1, m, l, od);
        } else {
#pragma unroll
            for (int i = 0; i < 16; ++i) {
                s0[i] = (s0[i] > -1e29f) ? __builtin_amdgcn_exp2f(s0[i] - m) * l : 0.f;
                s1[i] = (s1[i] > -1e29f) ? __builtin_amdgcn_exp2f(s1[i] - m) * l : 0.f;
            }
            extra(cur, s0, s1);
            pv_tile(buf, s0, s1, o, lane);
        }
        if (nxt >= 0) tile_store(tk0, tk1, tv0, tv1, bufs + (pb ^ 1) * 16384, w, lane);
        __syncthreads();
        pb ^= 1;
        cur = nxt;
    }
}

__device__ __forceinline__ void nsa_unit(unsigned char* ws, int b, int g, int qt, unsigned char* smem) {
    const int tid = tidx(), lane = tid & 63, w = tid >> 6;
    const int r32 = lane & 31, hi = lane >> 5;
    const int q0 = qt * 32;
    const int tl = q0 + 8 * w + (r32 >> 2);
    const int rep = r32 & 3;
    const u16* proj = (const u16*)(ws + OFF_PROJ);
    const u16* brow = proj + (long)b * SEQ * IN_COLS;
    const u16* kcb = (const u16*)(ws + OFF_KCB) + (size_t)(b * 2 + g) * 256 * 64;
    const u16* vcb = (const u16*)(ws + OFF_VCB) + (size_t)(b * 2 + g) * 256 * 64;
    u16* ya = (u16*)(ws + OFF_YAB);
    unsigned char* bufs = smem;
    float* imp = (float*)(smem + 32768);
    u64* selm = (u64*)(smem + 32768 + 8192);
    const u16* trow = brow + (long)tl * IN_COLS;
    bf16x8 qr[4];
#pragma unroll
    for (int d0 = 0; d0 < 4; ++d0) qr[d0] = *(const bf16x8*)(trow + C_NQ + (g * 4 + rep) * 64 + d0 * 16 + hi * 8);
    const float gate_c = bf2f(trow[C_NG + 0 * 8 + g * 4 + rep]);
    const float gate_s = bf2f(trow[C_NG + 1 * 8 + g * 4 + rep]);
    const float gate_w = bf2f(trow[C_NG + 2 * 8 + g * 4 + rep]);
    for (int i = tid; i < 32 * 64; i += 256) imp[i] = 0.f;
    f32x16 tot[2];
#pragma unroll
    for (int i = 0; i < 16; ++i) { tot[0][i] = 0.f; tot[1][i] = 0.f; }

    const int nvalid = tl >= 31 ? ((tl - 31) >> 4) + 1 : 0;
    const int nv_max = (q0 + 31 >= 31) ? ((q0 + 31 - 31) >> 4) + 1 : 0;
    const int ntile_c = (nv_max + 63) >> 6;
    auto crows = [&](int tile, int r, const u16*& kp, const u16*& vp) {
        int n = tile * 64 + r;
        n = n < 254 ? n : 254;
        kp = kcb + (size_t)n * 64;
        vp = vcb + (size_t)n * 64;
    };
    auto cnext = [&](int c) { return (c + 1 < ntile_c) ? c + 1 : -1; };
    auto cmask = [&](int tile, int& lo, int& hl, u64& word) { lo = 0; hl = nvalid - 64 * tile - 1; word = 0; };
    {
        float m = -1e30f, l = 0.f;
        f32x16 o[2];
#pragma unroll
        for (int i = 0; i < 16; ++i) { o[0][i] = 0.f; o[1][i] = 0.f; }
        flash_run<1, false>(ntile_c > 0 ? 0 : -1, cnext, crows, cmask, [&](int, f32x16&, f32x16&) {}, qr, m, l, o, bufs, w, lane);
        float invl = l > 0.f ? 1.0f / l : 0.f;
        const int qloc = 8 * w + (r32 >> 2);
        flash_run<2, false>(ntile_c > 0 ? 0 : -1, cnext, crows, cmask,
                            [&](int tile, f32x16& p0, f32x16& p1) {
#pragma unroll
                                for (int a = 0; a < 4; ++a) {
                                    float g0 = p0[4 * a] + p0[4 * a + 1] + p0[4 * a + 2] + p0[4 * a + 3], e0 = p0[4 * a + 3];
                                    float g1 = p1[4 * a] + p1[4 * a + 1] + p1[4 * a + 2] + p1[4 * a + 3], e1 = p1[4 * a + 3];
                                    g0 += __shfl_xor(g0, 1); g0 += __shfl_xor(g0, 2);
                                    e0 += __shfl_xor(e0, 1); e0 += __shfl_xor(e0, 2);
                                    g1 += __shfl_xor(g1, 1); g1 += __shfl_xor(g1, 2);
                                    e1 += __shfl_xor(e1, 1); e1 += __shfl_xor(e1, 2);
                                    if (rep == 0) {
                                        int j0 = 16 * tile + 2 * a + hi, j1 = j0 + 8;
                                        atomicAdd(&imp[qloc * 64 + j0], g0);
                                        if (j0 + 1 < 64) atomicAdd(&imp[qloc * 64 + j0 + 1], e0);
                                        if (j1 < 64) atomicAdd(&imp[qloc * 64 + j1], g1);
                                        if (j1 + 1 < 64) atomicAdd(&imp[qloc * 64 + j1 + 1], e1);
                                    }
                                }
                            },
                            qr, m, invl, o, bufs, w, lane);
#pragma unroll
        for (int i = 0; i < 16; ++i) { tot[0][i] += gate_c * o[0][i]; tot[1][i] += gate_c * o[1][i]; }
    }
    __syncthreads();
    for (int qq = 0; qq < 8; ++qq) {
        const int qi = 8 * w + qq;
        const int tq = q0 + qi;
        const int cur = tq >> 6;
        const int j = lane;
        float v = imp[qi * 64 + j];
        if (j == 0 || j == cur || j == cur - 1) v = __builtin_inff();
        if (j > cur) v = -__builtin_inff();
        int rank = 0;
        for (int jp = 0; jp < 64; ++jp) {
            float vj = __shfl(v, jp);
            rank += (vj > v || (vj == v && jp < j)) ? 1 : 0;
        }
        u64 sm = __ballot(rank < 16 && j <= cur);
        if (lane == 0) selm[qi] = sm;
    }
    __syncthreads();
    const u64 mymask = selm[8 * w + (r32 >> 2)];
    u64 unionm = 0;
    for (int i = 0; i < 32; ++i) unionm |= selm[i];
    unionm = __builtin_amdgcn_readfirstlane((u32)unionm) | ((u64)__builtin_amdgcn_readfirstlane((u32)(unionm >> 32)) << 32);
    {
        float m = -1e30f, l = 0.f;
        f32x16 o[2];
#pragma unroll
        for (int i = 0; i < 16; ++i) { o[0][i] = 0.f; o[1][i] = 0.f; }
        auto snext = [&](int c) {
            u64 rest = (c >= 63) ? 0ull : (unionm >> (c + 1));
            return rest ? (c + 1 + (__ffsll((long long)rest) - 1)) : -1;
        };
        const int first = unionm ? (__ffsll((long long)unionm) - 1) : -1;
        flash_run<0, false>(first, snext,
                            [&](int j, int r, const u16*& kp, const u16*& vp) {
                                const u16* rp = brow + (long)(64 * j + r) * IN_COLS + C_NKV;
                                kp = rp + (2 * 2 + g) * 64;
                                vp = rp + (3 * 2 + g) * 64;
                            },
                            [&](int j, int& lo, int& hl, u64& word) { lo = 0; hl = ((mymask >> j) & 1ull) ? (tl - 64 * j) : -1; word = 0; },
                            [&](int, f32x16&, f32x16&) {}, qr, m, l, o, bufs, w, lane);
        const float sc = l > 0.f ? gate_s / l : 0.f;
#pragma unroll
        for (int i = 0; i < 16; ++i) { tot[0][i] += sc * o[0][i]; tot[1][i] += sc * o[1][i]; }
    }
    {
        float m = -1e30f, l = 0.f;
        f32x16 o[2];
#pragma unroll
        for (int i = 0; i < 16; ++i) { o[0][i] = 0.f; o[1][i] = 0.f; }
        const int jfirst = (q0 - 511) > 0 ? ((q0 - 511) >> 6) : 0;
        const int jlast = (q0 + 31) >> 6;
        flash_run<0, false>(jfirst, [&](int c) { return c + 1 <= jlast ? c + 1 : -1; },
                            [&](int j, int r, const u16*& kp, const u16*& vp) {
                                const u16* rp = brow + (long)(64 * j + r) * IN_COLS + C_NKV;
                                kp = rp + (4 * 2 + g) * 64;
                                vp = rp + (5 * 2 + g) * 64;
                            },
                            [&](int j, int& lo, int& hl, u64& word) { lo = tl - 511 - 64 * j; hl = tl - 64 * j; word = 0; },
                            [&](int, f32x16&, f32x16&) {}, qr, m, l, o, bufs, w, lane);
        const float sc = l > 0.f ? gate_w / l : 0.f;
#pragma unroll
        for (int i = 0; i < 16; ++i) { tot[0][i] += sc * o[0][i]; tot[1][i] += sc * o[1][i]; }
    }
    {
        u16* orow = ya + ((long)b * SEQ + tl) * 512 + (g * 4 + rep) * 64;
#pragma unroll
        for (int dh = 0; dh < 2; ++dh)
#pragma unroll
            for (int a = 0; a < 4; ++a) {
                uint2 v = uint2{pack2(tot[dh][4 * a], tot[dh][4 * a + 1]), pack2(tot[dh][4 * a + 2], tot[dh][4 * a + 3])};
                *(uint2*)(orow + dh * 32 + 8 * a + 4 * hi) = v;
            }
    }
}

__device__ __forceinline__ void dsa_select_unit(unsigned char* ws, int unit, unsigned char* smem) {
    const int tid = tidx(), lane = tid & 63, w = tid >> 6;
    const int t0 = unit * 4;
    const int b = t0 / SEQ, tl0 = t0 - b * SEQ;
    const u16* proj = (const u16*)(ws + OFF_PROJ);
    const u16* brow = proj + (long)b * SEQ * IN_COLS;
    u64* bits = (u64*)(ws + OFF_BITS);
    float* sc = (float*)smem;
    __syncthreads();
    {
        const int r = lane & 31, half = lane >> 5;
        const int q = r >> 3, h = r & 7;
        bf16x8 af[4];
#pragma unroll
        for (int ks = 0; ks < 4; ++ks) af[ks] = *(const bf16x8*)(proj + (long)(t0 + q) * IN_COLS + C_IQ + h * 64 + ks * 16 + half * 8);
        float wq[4][4];
#pragma unroll
        for (int qq = 0; qq < 4; ++qq)
#pragma unroll
            for (int i = 0; i < 4; ++i) wq[qq][i] = bf2f(proj[(long)(t0 + qq) * IN_COLS + C_IW + i + 4 * half]) * 0.35355339059327373f;
        const int ntiles = (tl0 + 4 + 31) >> 5;
        bf16x8 bfr[4];
        if (w < ntiles) {
#pragma unroll
            for (int ks = 0; ks < 4; ++ks) bfr[ks] = *(const bf16x8*)(brow + (long)(w * 32 + r) * IN_COLS + C_IK + ks * 16 + half * 8);
        }
        for (int tile = w; tile < ntiles; tile += 4) {
            int key = tile * 32 + r;
            bf16x8 bcur[4];
#pragma unroll
            for (int ks = 0; ks < 4; ++ks) bcur[ks] = bfr[ks];
            if (tile + 4 < ntiles) {
#pragma unroll
                for (int ks = 0; ks < 4; ++ks) bfr[ks] = *(const bf16x8*)(brow + (long)(key + 128) * IN_COLS + C_IK + ks * 16 + half * 8);
            }
            f32x16 acc;
#pragma unroll
            for (int i = 0; i < 16; ++i) acc[i] = 0.f;
#pragma unroll
            for (int ks = 0; ks < 4; ++ks) acc = MFMA32(af[ks], bcur[ks], acc);
            float totq[4];
#pragma unroll
            for (int qq = 0; qq < 4; ++qq) {
                float part = 0.f;
#pragma unroll
                for (int i = 0; i < 4; ++i) part += wq[qq][i] * fmaxf(acc[4 * qq + i], 0.f);
                totq[qq] = part + __shfl_xor(part, 32);
            }
            if (half == 0) {
                sc[0 * 4096 + key] = totq[0];
                sc[1 * 4096 + key] = totq[1];
            } else {
                sc[2 * 4096 + key] = totq[2];
                sc[3 * 4096 + key] = totq[3];
            }
        }
    }
    __syncthreads();
    const int t = t0 + w;
    const int tl = tl0 + w;
    const int nvalid = tl + 1;
    {
        u32 u[64];
        const float* scq = sc + w * 4096;
#pragma unroll
        for (int j = 0; j < 64; ++j) {
            int key = j * 64 + lane;
            u32 v = 0;
            if (key <= tl) {
                u32 bb = __float_as_uint(scq[key]);
                v = bb ^ ((bb >> 31) ? 0xFFFFFFFFu : 0x80000000u);
            }
            u[j] = v;
        }
        u32 K = 0;
        int need = 0;
        if (nvalid > 256) {
            for (int bit = 31; bit >= 0; --bit) {
                u32 cand = K | (1u << bit);
                int cnt = 0;
#pragma unroll
                for (int j = 0; j < 64; ++j) cnt += (u[j] >= cand) ? 1 : 0;
                cnt = wsumi(cnt);
                if (cnt >= 256) K = cand;
            }
            int cgt = 0;
#pragma unroll
            for (int j = 0; j < 64; ++j) cgt += (u[j] > K) ? 1 : 0;
            cgt = wsumi(cgt);
            need = 256 - cgt;
        }
        const u64 ltmask = (1ull << lane) - 1ull;
        int ebase = 0;
        u64 myword = 0;
#pragma unroll
        for (int j = 0; j < 64; ++j) {
            bool eq = (nvalid > 256) && (u[j] == K);
            u64 em = __ballot(eq);
            int erank = ebase + __popcll(em & ltmask);
            bool take = (u[j] > K) || (eq && erank < need);
            ebase += __popcll(em);
            u64 sm = __ballot(take);
            if (lane == j) myword = sm;
        }
        bits[(long)t * 64 + lane] = myword;
    }
}

__device__ __forceinline__ void dsa_attn_unit(unsigned char* ws, int b, int qt, unsigned char* smem) {
    const int tid = tidx(), lane = tid & 63, w = tid >> 6;
    const int r32 = lane & 31, hi = lane >> 5;
    const int q0 = qt * 16;
    const int qloc = 4 * w + (r32 >> 3);
    const int tl = q0 + qloc;
    const int head = r32 & 7;
    const u16* proj = (const u16*)(ws + OFF_PROJ);
    const u16* brow = proj + (long)b * SEQ * IN_COLS;
    const u64* bits = (const u64*)(ws + OFF_BITS) + ((long)b * SEQ + q0) * 64;
    u16* yb = (u16*)(ws + OFF_YAB) + (size_t)NTOK * 512;
    unsigned char* bufs = smem;
    u64* lbits = (u64*)(smem + 32768);
    __syncthreads();
    for (int i = tid; i < 16 * 64; i += 256) lbits[i] = bits[i];
    const u16* trow = brow + (long)tl * IN_COLS;
    bf16x8 qr[4];
#pragma unroll
    for (int d0 = 0; d0 < 4; ++d0) qr[d0] = *(const bf16x8*)(trow + C_DQ + head * 64 + d0 * 16 + hi * 8);
    float m = -1e30f, l = 0.f;
    f32x16 o[2];
#pragma unroll
    for (int i = 0; i < 16; ++i) { o[0][i] = 0.f; o[1][i] = 0.f; }
    const int jlast = (q0 + 15) >> 6;
    flash_run<0, true>(0, [&](int c) { return c + 1 <= jlast ? c + 1 : -1; },
                       [&](int j, int r, const u16*& kp, const u16*& vp) {
                           const u16* rp = brow + (long)(64 * j + r) * IN_COLS + C_DKV;
                           kp = rp;
                           vp = rp + 64;
                       },
                       [&](int j, int& lo, int& hl, u64& word) { lo = 0; hl = 0; word = lbits[qloc * 64 + j]; },
                       [&](int, f32x16&, f32x16&) {}, qr, m, l, o, bufs, w, lane);
    const float inv = l > 0.f ? 1.0f / l : 0.f;
    u16* orow = yb + ((long)b * SEQ + tl) * 512 + head * 64;
#pragma unroll
    for (int dh = 0; dh < 2; ++dh)
#pragma unroll
        for (int a = 0; a < 4; ++a) {
            uint2 v = uint2{pack2(o[dh][4 * a] * inv, o[dh][4 * a + 1] * inv), pack2(o[dh][4 * a + 2] * inv, o[dh][4 * a + 3] * inv)};
            *(uint2*)(orow + dh * 32 + 8 * a + 4 * hi) = v;
        }
}

template <int CTRL>
__device__ __forceinline__ int dppi(int x) { return __builtin_amdgcn_update_dpp(x, x, CTRL, 0xF, 0xF, false); }
template <int CTRL>
__device__ __forceinline__ float dppf(float x) { return __int_as_float(dppi<CTRL>(__float_as_int(x))); }
__device__ __forceinline__ int row_sum16i(int x) {
    x += dppi<0x128>(x);
    x += dppi<0x124>(x);
    x += dppi<0x122>(x);
    x += dppi<0x121>(x);
    return x;
}
__device__ __forceinline__ float row_sum16f(float x) {
    x += dppf<0x128>(x);
    x += dppf<0x124>(x);
    x += dppf<0x122>(x);
    x += dppf<0x121>(x);
    return x;
}
__device__ __forceinline__ float row_max16f(float x) {
    x = fmaxf(x, dppf<0x128>(x));
    x = fmaxf(x, dppf<0x124>(x));
    x = fmaxf(x, dppf<0x122>(x));
    x = fmaxf(x, dppf<0x121>(x));
    return x;
}
__device__ __forceinline__ u32 sortkey(float f) {
    u32 b = __float_as_uint(f);
    return b ^ ((b >> 31) ? 0xFFFFFFFFu : 0x80000000u);
}

__device__ __forceinline__ void peer_route(unsigned char* ws, int layer, unsigned char* smem) {
    const int tid = tidx(), lane = tid & 63, w = tid >> 6;
    const int grp = lane >> 4, k = lane & 15;
    const u32 ltk = (1u << k) - 1u;
    const u16* pq = (const u16*)(ws + OFF_PQ);
    const u16* skb = (const u16*)(ws + OFF_W + layer * W_LAYER + WO_SK);
    int* eidx = (int*)(ws + OFF_EIDX);
    float* gate = (float*)(ws + OFF_GATE);
    float* tvc = (float*)(smem + w * 4096);
    int* tic = (int*)(smem + w * 4096 + 2048);
    const int nunits = NTOK / 16;
    for (int unit = bidx() * 4 + w; unit < nunits; unit += gdim() * 4) {
        const int tok0 = unit * 16;
        for (int h = 0; h < 8; ++h) {
            for (int half = 0; half < 2; ++half) {
                bf16x8 af[4];
#pragma unroll
                for (int ks = 0; ks < 4; ++ks)
                    af[ks] = *(const bf16x8*)(pq + (long)(tok0 + k) * 2048 + h * 256 + half * 128 + ks * 32 + grp * 8);
                float sc[8][4];
                u32 u[8][4];
#pragma unroll
                for (int nt = 0; nt < 8; ++nt) {
                    f32x4 acc = f32x4{0.f, 0.f, 0.f, 0.f};
#pragma unroll
                    for (int ks = 0; ks < 4; ++ks) {
                        bf16x8 bfr = *(const bf16x8*)(skb + (size_t)half * 128 * 128 + (size_t)(nt * 16 + k) * 128 + ks * 32 + grp * 8);
                        acc = __builtin_amdgcn_mfma_f32_16x16x32_bf16(af[ks], bfr, acc, 0, 0, 0);
                    }
#pragma unroll
                    for (int i = 0; i < 4; ++i) { sc[nt][i] = acc[i]; u[nt][i] = sortkey(acc[i]); }
                }
                u32 K[4] = {0u, 0u, 0u, 0u};
                for (int bit = 31; bit >= 0; --bit) {
                    int packed = 0;
#pragma unroll
                    for (int i = 0; i < 4; ++i) {
                        const u32 cand = K[i] | (1u << bit);
                        int c = 0;
#pragma unroll
                        for (int nt = 0; nt < 8; ++nt) c += (u[nt][i] >= cand) ? 1 : 0;
                        packed |= c << (8 * i);
                    }
                    packed = row_sum16i(packed);
#pragma unroll
                    for (int i = 0; i < 4; ++i)
                        if (((packed >> (8 * i)) & 0xFF) >= 16) K[i] |= (1u << bit);
                }
                int need[4];
                {
                    int packed = 0;
#pragma unroll
                    for (int i = 0; i < 4; ++i) {
                        int c = 0;
#pragma unroll
                        for (int nt = 0; nt < 8; ++nt) c += (u[nt][i] > K[i]) ? 1 : 0;
                        packed |= c << (8 * i);
                    }
                    packed = row_sum16i(packed);
#pragma unroll
                    for (int i = 0; i < 4; ++i) need[i] = 16 - ((packed >> (8 * i)) & 0xFF);
                }
#pragma unroll
                for (int i = 0; i < 4; ++i) {
                    int ebase = 0, pbase = 0;
                    const int tok = 4 * grp + i;
#pragma unroll
                    for (int nt = 0; nt < 8; ++nt) {
                        const bool eq = (u[nt][i] == K[i]);
                        const u32 emg = (u32)(__ballot(eq) >> (lane & 48)) & 0xFFFFu;
                        const int erank = ebase + __popc(emg & ltk);
                        const bool take = (u[nt][i] > K[i]) || (eq && erank < need[i]);
                        ebase += __popc(emg);
                        const u32 tmg = (u32)(__ballot(take) >> (lane & 48)) & 0xFFFFu;
                        const int pos = pbase + __popc(tmg & ltk);
                        if (take) {
                            tvc[(half * 16 + tok) * 16 + pos] = sc[nt][i];
                            tic[(half * 16 + tok) * 16 + pos] = nt * 16 + k;
                        }
                        pbase += __popc(tmg);
                    }
                }
            }
            WAVE_SYNC();
            for (int pass = 0; pass < 4; ++pass) {
                const int tok = 4 * pass + grp;
                const float v1 = tvc[(0 * 16 + tok) * 16 + k];
                const int i1 = tic[(0 * 16 + tok) * 16 + k];
                float c[16];
                u32 uc[16];
#pragma unroll
                for (int r4 = 0; r4 < 4; ++r4) {
                    float4 v2 = *(const float4*)(tvc + (1 * 16 + tok) * 16 + r4 * 4);
                    c[r4 * 4 + 0] = v1 + v2.x;
                    c[r4 * 4 + 1] = v1 + v2.y;
                    c[r4 * 4 + 2] = v1 + v2.z;
                    c[r4 * 4 + 3] = v1 + v2.w;
                }
                float mxl = c[0];
#pragma unroll
                for (int r = 0; r < 16; ++r) { uc[r] = sortkey(c[r]); mxl = fmaxf(mxl, c[r]); }
                const float mx = row_max16f(mxl);
                u32 Kc = 0u;
                for (int bit = 31; bit >= 0; --bit) {
                    const u32 cand = Kc | (1u << bit);
                    int cn = 0;
#pragma unroll
                    for (int r = 0; r < 16; ++r) cn += (uc[r] >= cand) ? 1 : 0;
                    cn = row_sum16i(cn);
                    if (cn >= 16) Kc = cand;
                }
                int cg = 0;
#pragma unroll
                for (int r = 0; r < 16; ++r) cg += (uc[r] > Kc) ? 1 : 0;
                cg = row_sum16i(cg);
                const int needc = 16 - cg;
                bool take[16];
                float ex[16];
                float sl = 0.f;
                int ebase = 0;
#pragma unroll
                for (int r = 0; r < 16; ++r) {
                    const bool eq = (uc[r] == Kc);
                    const u32 emg = (u32)(__ballot(eq) >> (lane & 48)) & 0xFFFFu;
                    const int erank = ebase + __popc(emg & ltk);
                    take[r] = (uc[r] > Kc) || (eq && erank < needc);
                    ebase += __popc(emg);
                    ex[r] = take[r] ? __expf(c[r] - mx) : 0.f;
                    sl += ex[r];
                }
                const float inv = 1.0f / row_sum16f(sl);
                int pbase = 0;
                const long obase = (long)(tok0 + tok) * 128 + h * 16;
#pragma unroll
                for (int r = 0; r < 16; ++r) {
                    const u32 tmg = (u32)(__ballot(take[r]) >> (lane & 48)) & 0xFFFFu;
                    const int pos = pbase + __popc(tmg & ltk);
                    if (take[r]) {
                        eidx[obase + pos] = i1 * 128 + tic[(1 * 16 + tok) * 16 + r];
                        gate[obase + pos] = ex[r] * inv;
                    }
                    pbase += __popc(tmg);
                }
            }
            WAVE_SYNC();
        }
    }
}

__device__ __forceinline__ void peer_experts(unsigned char* ws, float* xout) {
    const int lane = tidx() & 63, w = tidx() >> 6;
    const u16* hbuf = (const u16*)(ws + OFF_H);
    const unsigned char* ub = ws + OFF_UB;
    const unsigned char* vb = ws + OFF_VB;
    const float* usc = (const float*)(ws + OFF_ESC);
    const float* vsc = usc + NEXP;
    const int* eidx = (const int*)(ws + OFF_EIDX);
    const float* gate = (const float*)(ws + OFF_GATE);
    for (int t = bidx() * 4 + w; t < NTOK; t += gdim() * 4) {
        float hf[16];
        {
            uint4 h0 = *(const uint4*)(hbuf + (long)t * 1024 + lane * 16);
            uint4 h1 = *(const uint4*)(hbuf + (long)t * 1024 + lane * 16 + 8);
            hf[0] = bf_lo(h0.x); hf[1] = bf_hi(h0.x); hf[2] = bf_lo(h0.y); hf[3] = bf_hi(h0.y);
            hf[4] = bf_lo(h0.z); hf[5] = bf_hi(h0.z); hf[6] = bf_lo(h0.w); hf[7] = bf_hi(h0.w);
            hf[8] = bf_lo(h1.x); hf[9] = bf_hi(h1.x); hf[10] = bf_lo(h1.y); hf[11] = bf_hi(h1.y);
            hf[12] = bf_lo(h1.z); hf[13] = bf_hi(h1.z); hf[14] = bf_lo(h1.w); hf[15] = bf_hi(h1.w);
        }
        float acc[16];
#pragma unroll
        for (int i = 0; i < 16; ++i) acc[i] = 0.f;
        for (int e0 = 0; e0 < 128; e0 += 8) {
            float gg[8], su[8], sv[8];
            uint4 uq[8], vq[8];
#pragma unroll
            for (int k = 0; k < 8; ++k) {
                const int id = __builtin_amdgcn_readfirstlane(eidx[(long)t * 128 + e0 + k]);
                gg[k] = gate[(long)t * 128 + e0 + k];
                su[k] = usc[id];
                sv[k] = vsc[id];
                uq[k] = *(const uint4*)(ub + (long)id * 1024 + lane * 16);
                vq[k] = *(const uint4*)(vb + (long)id * 1024 + lane * 16);
            }
#pragma unroll
            for (int k = 0; k < 8; ++k) {
                const u32 uw[4] = {uq[k].x, uq[k].y, uq[k].z, uq[k].w};
                float d = 0.f;
#pragma unroll
                for (int i = 0; i < 4; ++i) {
                    f32x2_t lo = __builtin_amdgcn_cvt_pk_f32_fp8((int)uw[i], false);
                    f32x2_t hi = __builtin_amdgcn_cvt_pk_f32_fp8((int)uw[i], true);
                    d += hf[4 * i] * lo[0] + hf[4 * i + 1] * lo[1] + hf[4 * i + 2] * hi[0] + hf[4 * i + 3] * hi[1];
                }
                d = wsum(d) * su[k];
                const float a = gelu_tanh(d) * gg[k] * sv[k];
                const u32 vw[4] = {vq[k].x, vq[k].y, vq[k].z, vq[k].w};
#pragma unroll
                for (int i = 0; i < 4; ++i) {
                    f32x2_t lo = __builtin_amdgcn_cvt_pk_f32_fp8((int)vw[i], false);
                    f32x2_t hi = __builtin_amdgcn_cvt_pk_f32_fp8((int)vw[i], true);
                    acc[4 * i] += a * lo[0];
                    acc[4 * i + 1] += a * lo[1];
                    acc[4 * i + 2] += a * hi[0];
                    acc[4 * i + 3] += a * hi[1];
                }
            }
        }
        float* xr = xout + (long)t * 1024 + lane * 16;
#pragma unroll
        for (int i = 0; i < 4; ++i) {
            float4 a = *(float4*)(xr + 4 * i);
            a.x += acc[4 * i]; a.y += acc[4 * i + 1]; a.z += acc[4 * i + 2]; a.w += acc[4 * i + 3];
            *(float4*)(xr + 4 * i) = a;
        }
    }
}

__device__ __forceinline__ void phase_prep(const Params& P, unsigned char* smem) {
    unsigned char* ws = opq(P.ws);
    const long gtid = (long)bidx() * 256 + tidx();
    const long gthreads = (long)gdim() * 256;
    for (int l = 0; l < 2; ++l) {
        unsigned char* wl = ws + OFF_W + l * W_LAYER;
        float* tile = (float*)smem;
        transpose_cvt(P.w_in + (size_t)l * 1024 * IN_COLS, (u16*)(wl + WO_WIN), 1024, IN_COLS, tile);
        for (int c = 0; c < 2; ++c) {
            transpose_cvt(P.cmp_w1 + ((size_t)l * 2 + c) * 2048 * 256, (u16*)(wl + WO_W1) + (size_t)c * 256 * 2048, 2048, 256, tile);
            transpose_cvt(P.cmp_w2 + ((size_t)l * 2 + c) * 256 * 64, (u16*)(wl + WO_W2) + (size_t)c * 64 * 256, 256, 64, tile);
        }
        transpose_cvt(P.w_a + (size_t)l * 512 * 1024, (u16*)(wl + WO_WA), 512, 1024, tile);
        transpose_cvt(P.w_b + (size_t)l * 512 * 1024, (u16*)(wl + WO_WB), 512, 1024, tile);
        transpose_cvt(P.w_out + (size_t)l * 1024 * 1024, (u16*)(wl + WO_WO), 1024, 1024, tile);
        transpose_cvt(P.peer_wq + (size_t)l * 1024 * 2048, (u16*)(wl + WO_WQ), 1024, 2048, tile);
        transpose_cvt(P.ple_w + (size_t)l * 256 * 1024, (u16*)(wl + WO_PW), 256, 1024, tile);
        transpose_cvt(P.ple_gw + (size_t)l * 1024 * 1024, (u16*)(wl + WO_PG), 1024, 1024, tile);
        cvt_f32_bf16(P.peer_sk + (size_t)l * 2 * 128 * 128, (u16*)(wl + WO_SK), 2 * 128 * 128);
        if (gtid < 512) {
            int c = (int)gtid >> 8, col = (int)gtid & 255;
            const float* pos = P.cmp_pos + ((size_t)l * 2 + c) * 2048;
            const float* w1 = P.cmp_w1 + ((size_t)l * 2 + c) * 2048 * 256;
            float s = 0.f;
            for (int k = 0; k < 2048; ++k) s += pos[k] * w1[(size_t)k * 256 + col];
            ((float*)(wl + WO_CB))[c * 256 + col] = s;
        }
    }
    {
        float* ropec = (float*)(ws + OFF_ROPE);
        float* ropes = ropec + (size_t)NTOK * 8;
        for (long i = gtid; i < (long)NTOK * 8; i += gthreads) {
            int t = (int)(i >> 3), k = (int)(i & 7);
            double inv = pow(500000.0, -(double)k / 8.0);
            double ang = (double)P.positions[t] * inv;
            ropec[i] = (float)cos(ang);
            ropes[i] = (float)sin(ang);
        }
    }
    rms_rows(P.x, P.attn_norm, (u16*)(ws + OFF_H), nullptr, nullptr);
}

__device__ __forceinline__ void phase_g1(const Params& P, int layer, unsigned char* smem) {
    unsigned char* ws = opq(P.ws);
    u16* proj = (u16*)(ws + OFF_PROJ);
    gemm_phase<0>((const u16*)(ws + OFF_H), 1024, (const u16*)(ws + OFF_W + layer * W_LAYER + WO_WIN), 1024, NTOK, IN_COLS, 1024, smem,
                  [=](int row, int col, const float (&v)[8]) { st_bf8(proj + (long)row * IN_COLS + col, v); });
}

__device__ __forceinline__ void phase_c1(const Params& P, int layer, unsigned char* smem) {
    unsigned char* ws = opq(P.ws);
    unsigned char* wl = ws + OFF_W + layer * W_LAYER;
    const u16* proj = (const u16*)(ws + OFF_PROJ);
    u16* chid = (u16*)(ws + OFF_CHID);
    const float* cbias = (const float*)(wl + WO_CB);
    for (int c = 0; c < 2; ++c) {
        u16* ch = chid + (size_t)c * CROWS * 256;
        const float* cb = cbias + c * 256;
        gemm_phase<1>(proj + C_NKV + c * 128, 0, (const u16*)(wl + WO_W1) + (size_t)c * 256 * 2048, 2048, CROWS, 256, 2048, smem,
                      [=](int row, int col, const float (&v)[8]) {
                          float o[8];
#pragma unroll
                          for (int j = 0; j < 8; ++j) o[j] = gelu_tanh(v[j] + cb[col + j]);
                          st_bf8(ch + (long)row * 256 + col, o);
                      });
    }
}

__device__ __forceinline__ void phase_c2(const Params& P, int layer, unsigned char* smem) {
    unsigned char* ws = opq(P.ws);
    unsigned char* wl = ws + OFF_W + layer * W_LAYER;
    const u16* chid = (const u16*)(ws + OFF_CHID);
    float* cbuf = (float*)(ws + OFF_CBUF);
    for (int c = 0; c < 2; ++c) {
        float* cbo = cbuf + (size_t)c * CROWS * 64;
        gemm_phase<0>(chid + (size_t)c * CROWS * 256, 256, (const u16*)(wl + WO_W2) + (size_t)c * 64 * 256, 256, CROWS, 64, 256, smem,
                      [=](int row, int col, const float (&v)[8]) {
                          float* o = cbo + (long)row * 64 + col;
                          *(float4*)o = float4{v[0], v[1], v[2], v[3]};
                          *(float4*)(o + 4) = float4{v[4], v[5], v[6], v[7]};
                      });
    }
}

__device__ __forceinline__ void phase_c3(const Params& P, int layer) {
    unsigned char* ws = opq(P.ws);
    const int lane = tidx() & 63, w = tidx() >> 6;
    const float* cbuf = (const float*)(ws + OFF_CBUF);
    u16* kcb = (u16*)(ws + OFF_KCB);
    u16* vcb = (u16*)(ws + OFF_VCB);
    const float* ropec = (const float*)(ws + OFF_ROPE);
    const float* ropes = ropec + (size_t)NTOK * 8;
    const float* gain = P.nsa_gain + layer * 256 + 64;
    for (int r = bidx() * 4 + w; r < 2 * CROWS; r += gdim() * 4) {
        int c = r / CROWS, rr = r - c * CROWS;
        int b = rr / (NCMP * 2);
        int rem = rr - b * (NCMP * 2);
        int n = rem >> 1, g = rem & 1;
        float v = cbuf[(size_t)r * 64 + lane];
        size_t o = ((size_t)(b * 2 + g) * 256 + n) * 64 + lane;
        if (c == 0) {
            float ss = wsum(v * v);
            v = v * rsqrtf(ss * (1.0f / 64.0f) + EPS) * gain[lane];
            float pv = __shfl_xor(v, 8);
            if (lane < 16) {
                long tt = (long)b * SEQ + 31 + 16 * n;
                float cs = ropec[tt * 8 + (lane & 7)], sn = ropes[tt * 8 + (lane & 7)];
                v = (lane < 8) ? (v * cs - pv * sn) : (v * cs + pv * sn);
            }
            kcb[o] = f2bf(v);
        } else {
            vcb[o] = f2bf(v);
        }
    }
}

__device__ __forceinline__ int balance4(int x, int seg) {
    const int k = x / seg, r = x - k * seg;
    return k == 0 ? r : (k == 1 ? 4 * seg - 1 - r : (k == 2 ? seg + r : 3 * seg - 1 - r));
}
__device__ __forceinline__ void phase_att_a(const Params& P, unsigned char* smem) {
    unsigned char* ws = opq(P.ws);
    for (int u = bidx(); u < NTOK / 4; u += gdim()) dsa_select_unit(ws, u, smem);
}
__device__ __forceinline__ void phase_att_b(const Params& P, unsigned char* smem) {
    {
        unsigned char* ws = opq(P.ws);
        for (int u = bidx(); u < 2048; u += gdim()) dsa_attn_unit(ws, u & 7, balance4(u >> 3, 64), smem);
    }
    {
        unsigned char* ws = opq(P.ws);
        for (int u = bidx(); u < 2048; u += gdim()) nsa_unit(ws, (u & 15) >> 1, u & 1, balance4(u >> 4, 32), smem);
    }
}

__device__ __forceinline__ void phase_merge(const Params& P, int layer, unsigned char* smem) {
    unsigned char* ws = opq(P.ws);
    unsigned char* wl = ws + OFF_W + layer * W_LAYER;
    const u16* proj = (const u16*)(ws + OFF_PROJ);
    u16* hbuf = (u16*)(ws + OFF_H);
    const u16* ya = (const u16*)(ws + OFF_YAB);
    const u16* yb = ya + (size_t)NTOK * 512;
    gemm_phase<0>(ya, 512, (const u16*)(wl + WO_WA), 512, NTOK, 1024, 512, smem, [=](int row, int col, const float (&v)[8]) {
        float ga[8], o[8];
        ld_bf8(proj + (long)row * IN_COLS + C_MG + col, ga);
#pragma unroll
        for (int j = 0; j < 8; ++j) o[j] = ga[j] * v[j];
        st_bf8(hbuf + (long)row * 1024 + col, o);
    });
    gemm_phase<0>(yb, 512, (const u16*)(wl + WO_WB), 512, NTOK, 1024, 512, smem, [=](int row, int col, const float (&v)[8]) {
        float gb[8], o[8];
        ld_bf8(proj + (long)row * IN_COLS + C_MG + 1024 + col, gb);
        ld_bf8(hbuf + (long)row * 1024 + col, o);
#pragma unroll
        for (int j = 0; j < 8; ++j) o[j] += gb[j] * v[j];
        st_bf8(hbuf + (long)row * 1024 + col, o);
    });
}

__device__ __forceinline__ void phase_outproj(const Params& P, int layer, unsigned char* smem) {
    unsigned char* ws = opq(P.ws);
    unsigned char* wl = ws + OFF_W + layer * W_LAYER;
    float* out = opq(P.out);
    const float* xin = (layer == 0) ? P.x : (const float*)out;
    gemm_phase<0>((const u16*)(ws + OFF_H), 1024, (const u16*)(wl + WO_WO), 1024, NTOK, 1024, 1024, smem, [=](int row, int col, const float (&v)[8]) {
        const long o = (long)row * 1024 + col;
        const float4 x0 = *(const float4*)(xin + o), x1 = *(const float4*)(xin + o + 4);
        *(float4*)(out + o) = float4{x0.x + v[0], x0.y + v[1], x0.z + v[2], x0.w + v[3]};
        *(float4*)(out + o + 4) = float4{x1.x + v[4], x1.y + v[5], x1.z + v[6], x1.w + v[7]};
    });
    cvt_f32_bf16(P.p + (size_t)layer * NTOK * 256, (u16*)(ws + OFF_PBF), (long)NTOK * 256);
    cvt_rows_fp8(P.peer_u + (size_t)layer * NEXP * 1024, ws + OFF_UB, (float*)(ws + OFF_ESC), NEXP);
    cvt_rows_fp8(P.peer_v + (size_t)layer * NEXP * 1024, ws + OFF_VB, (float*)(ws + OFF_ESC) + NEXP, NEXP);
}

__device__ __forceinline__ void phase_pq(const Params& P, int layer, unsigned char* smem) {
    unsigned char* ws = opq(P.ws);
    unsigned char* wl = ws + OFF_W + layer * W_LAYER;
    u16* pq = (u16*)(ws + OFF_PQ);
    u16* eb = (u16*)(ws + OFF_YAB);
    gemm_phase<0>((const u16*)(ws + OFF_H), 1024, (const u16*)(wl + WO_WQ), 1024, NTOK, 2048, 1024, smem,
                  [=](int row, int col, const float (&v)[8]) { st_bf8(pq + (long)row * 2048 + col, v); });
    gemm_phase<0>((const u16*)(ws + OFF_PBF), 256, (const u16*)(wl + WO_PW), 256, NTOK, 1024, 256, smem,
                  [=](int row, int col, const float (&v)[8]) { st_bf8(eb + (long)row * 1024 + col, v); });
}

__device__ __forceinline__ void phase_final(const Params& P, int layer, unsigned char* smem) {
    unsigned char* ws = opq(P.ws);
    unsigned char* wl = ws + OFF_W + layer * W_LAYER;
    float* out = opq(P.out);
    const u16* eb = (const u16*)(ws + OFF_YAB);
    const float* rstde = (const float*)(ws + OFF_RSTDE);
    const float* pn = P.ple_norm + layer * 1024;
    gemm_phase<0>((const u16*)(ws + OFF_H), 1024, (const u16*)(wl + WO_PG), 1024, NTOK, 1024, 1024, smem, [=](int row, int col, const float (&v)[8]) {
        const long o = (long)row * 1024 + col;
        float e[8];
        ld_bf8(eb + o, e);
        const float rs = rstde[row];
        const float4 x0 = *(const float4*)(out + o), x1 = *(const float4*)(out + o + 4);
        const float4 p0 = *(const float4*)(pn + col), p1 = *(const float4*)(pn + col + 4);
        *(float4*)(out + o) = float4{x0.x + sigmoidf(v[0]) * (e[0] * rs * p0.x), x0.y + sigmoidf(v[1]) * (e[1] * rs * p0.y),
                                     x0.z + sigmoidf(v[2]) * (e[2] * rs * p0.z), x0.w + sigmoidf(v[3]) * (e[3] * rs * p0.w)};
        *(float4*)(out + o + 4) = float4{x1.x + sigmoidf(v[4]) * (e[4] * rs * p1.x), x1.y + sigmoidf(v[5]) * (e[5] * rs * p1.y),
                                         x1.z + sigmoidf(v[6]) * (e[6] * rs * p1.z), x1.w + sigmoidf(v[7]) * (e[7] * rs * p1.w)};
    });
}


#define XB_TMO      128
#define XB_XCNT(j)  (256  + 64 * (j))
#define XB_XSUB(j)  (1280 + 64 * (j))
#define XB_XGEN(j)  (2304 + 64 * (j))
#define XB_TOP      3328
#define XB_TOPGEN   3392
#define XCD_BAR_WORDS 3456
#define XB_SPIN_CAP (1u << 22)
#define LAS __attribute__((address_space(3)))
__device__ __forceinline__ unsigned xb_ld(unsigned* p) { return __hip_atomic_load(p, __ATOMIC_RELAXED, __HIP_MEMORY_SCOPE_AGENT); }
__device__ __forceinline__ unsigned xb_add(unsigned* p, unsigned v) { return __hip_atomic_fetch_add(p, v, __ATOMIC_RELAXED, __HIP_MEMORY_SCOPE_AGENT); }
__device__ __forceinline__ unsigned xb_xcc_id() { return (unsigned)__builtin_amdgcn_s_getreg((3 << 11) | 20) & 0xFu; }
#define XB_SPIN(cond, bar) do { unsigned _sp = 0; while (cond) { __builtin_amdgcn_s_sleep(1); \
    if ((++_sp & 255u) == 0u) { if (xb_ld(&(bar)[XB_TMO])) break; if (_sp > XB_SPIN_CAP) { atomicAdd(&(bar)[XB_TMO], 1u); break; } } } } while (0)
struct XcdBarrier {
    unsigned* bar; unsigned x;
    volatile LAS unsigned* st;
};
__device__ __forceinline__ XcdBarrier xcd_barrier_post(unsigned* bar, volatile LAS unsigned* st) {
    XcdBarrier b; b.bar = bar; b.x = xb_xcc_id(); b.st = st;
    if (threadIdx.x == 0) (void)xb_add(&bar[XB_XCNT(b.x)], 1u);
    return b;
}
__device__ __forceinline__ void xcd_barrier_complete(unsigned* bar, unsigned x, unsigned& nloc, unsigned& nx) {
    const unsigned G = gridDim.x * gridDim.y * gridDim.z;
    unsigned sum, cnt, mine, sp = 0u;
    for (;;) {
        sum = 0u; cnt = 0u; mine = 0u;
#pragma unroll
        for (unsigned j = 0; j < 16; ++j) { const unsigned c = xb_ld(&bar[XB_XCNT(j)]); sum += c; cnt += (c > 0u) ? 1u : 0u; mine = (j == x) ? c : mine; }
        if (sum == G) break;
        __builtin_amdgcn_s_sleep(1);
        if ((++sp & 255u) == 0u) { if (xb_ld(&bar[XB_TMO])) break; if (sp > XB_SPIN_CAP) { atomicAdd(&bar[XB_TMO], 1u); break; } }
    }
    nloc = mine > 0u ? mine : 1u; nx = cnt > 0u ? cnt : 1u;
}
__device__ __forceinline__ void xcd_barrier(const XcdBarrier& b) {
    asm volatile("s_waitcnt vmcnt(0)" ::: "memory");
    __syncthreads();
    if (threadIdx.x == 0) {
        unsigned* bar = b.bar;
        __builtin_amdgcn_s_waitcnt(0);
        unsigned nloc = b.st[0], nx = b.st[1];
        if (nloc == 0u) { xcd_barrier_complete(bar, b.x, nloc, nx); b.st[0] = nloc; b.st[1] = nx; }
        const unsigned old = xb_add(&bar[XB_XSUB(b.x)], 1u);
        const unsigned gen = old / nloc;
        if (old + 1u == (gen + 1u) * nloc) {
            __builtin_amdgcn_fence(__ATOMIC_RELEASE, "agent");
            asm volatile("s_waitcnt vmcnt(0)" ::: "memory");
            const unsigned og = xb_add(&bar[XB_TOP], 1u);
            const unsigned tg = og / nx;
            if (og + 1u == (tg + 1u) * nx) xb_add(&bar[XB_TOPGEN], 1u);
            else XB_SPIN(xb_ld(&bar[XB_TOPGEN]) == tg, bar);
            __builtin_amdgcn_fence(__ATOMIC_ACQUIRE, "agent");
            xb_add(&bar[XB_XGEN(b.x)], 1u);
            asm volatile("s_waitcnt vmcnt(0)" ::: "memory");
        } else {
            XB_SPIN(xb_ld(&bar[XB_XGEN(b.x)]) == gen, bar);
            __builtin_amdgcn_fence(__ATOMIC_ACQUIRE, "agent");
            asm volatile("s_waitcnt vmcnt(0)" ::: "memory");
        }
    }
    __syncthreads();
}

#ifndef PROBE_MASK
#define PROBE_MASK 0ull
#endif
#ifndef PROBE_MULT
#define PROBE_MULT 4
#endif
#define GSYNC(id)                                                                          \
    do {                                                                                   \
        xcd_barrier(xb);                                                                   \
        if (PROBE_MASK != 0ull) {                                                          \
            unsigned long long now_ = __builtin_amdgcn_s_memrealtime();                    \
            if ((PROBE_MASK >> (id)) & 1ull) tsel += now_ - tprev;                         \
            tprev = now_;                                                                  \
        }                                                                                  \
    } while (0)

__global__ void __launch_bounds__(256, 2) fwd_kernel(Params P) {
    cg::grid_group grid = cg::this_grid();
    extern __shared__ __attribute__((aligned(16))) unsigned char smem[];
    unsigned long long tprev = 0, tsel = 0;
    if (PROBE_MASK != 0ull) tprev = __builtin_amdgcn_s_memrealtime();
    volatile LAS unsigned* xst = (volatile LAS unsigned*)(smem + LDS_BYTES);
    if (threadIdx.x == 0) { xst[0] = 0u; xst[1] = 0u; xst[2] = 0u; xst[3] = 0u; }
    __syncthreads();
    XcdBarrier xb = xcd_barrier_post((unsigned*)(P.ws + OFF_BAR), xst);
    phase_prep(P, smem);
    grid.sync();
    if (PROBE_MASK != 0ull) {
        unsigned long long now_ = __builtin_amdgcn_s_memrealtime();
        if (PROBE_MASK & 1ull) tsel += now_ - tprev;
        tprev = now_;
    }
    for (int layer = 0; layer < 2; ++layer) {
        const int pb = 1 + 16 * layer;
        phase_g1(P, layer, smem);
        GSYNC(pb + 0);
        post_proj(opq(P.ws), P.nsa_gain + layer * 256, P.dsa_gain + layer * 128, smem);
        GSYNC(pb + 1);
        phase_c1(P, layer, smem);
        GSYNC(pb + 2);
        phase_c2(P, layer, smem);
        GSYNC(pb + 3);
        phase_c3(P, layer);
        GSYNC(pb + 4);
        phase_att_a(P, smem);
        GSYNC(pb + 15);
        phase_att_b(P, smem);
        GSYNC(pb + 5);
        phase_merge(P, layer, smem);
        GSYNC(pb + 6);
        phase_outproj(P, layer, smem);
        GSYNC(pb + 7);
        {
            unsigned char* ws = opq(P.ws);
            rms_rows(opq(P.out), P.ffn_norm + layer * 1024, (u16*)(ws + OFF_H), nullptr, nullptr);
        }
        GSYNC(pb + 8);
        phase_pq(P, layer, smem);
        GSYNC(pb + 9);
        peer_route(opq(P.ws), layer, smem);
        GSYNC(pb + 10);
        peer_experts(opq(P.ws), opq(P.out));
        GSYNC(pb + 11);
        {
            unsigned char* ws = opq(P.ws);
            rms_rows(opq(P.out), nullptr, (u16*)(ws + OFF_H), (const u16*)(ws + OFF_YAB), (float*)(ws + OFF_RSTDE));
        }
        GSYNC(pb + 12);
        phase_final(P, layer, smem);
        GSYNC(pb + 13);
        if (layer == 0) {
            unsigned char* ws = opq(P.ws);
            rms_rows(opq(P.out), P.attn_norm + 1024, (u16*)(ws + OFF_H), nullptr, nullptr);
            GSYNC(pb + 14);
        }
    }
    if (PROBE_MASK != 0ull) {
        if (blockIdx.x == 0 && threadIdx.x == 0) {
            unsigned long long t0 = __builtin_amdgcn_s_memrealtime();
            while (__builtin_amdgcn_s_memrealtime() - t0 < (unsigned long long)PROBE_MULT * tsel) __builtin_amdgcn_s_sleep(32);
        }
    }
}

extern "C" void kernel_launch(void* const* d_in, const int* in_sizes, int n_in, void* d_out, int out_size, void* d_ws, size_t ws_size,
                              hipStream_t stream) {
    static int grid_blocks = 0;
    if (!grid_blocks) {
        int dev = 0, cus = 0, per_cu = 0;
        (void)hipGetDevice(&dev);
        (void)hipDeviceGetAttribute(&cus, hipDeviceAttributeMultiprocessorCount, dev);
        (void)hipFuncSetAttribute((const void*)fwd_kernel, hipFuncAttributeMaxDynamicSharedMemorySize, LDS_BYTES + 16);
        (void)hipOccupancyMaxActiveBlocksPerMultiprocessor(&per_cu, fwd_kernel, 256, LDS_BYTES + 16);
        if (per_cu > 2) per_cu = 2;
        if (per_cu < 1) per_cu = 1;
        grid_blocks = cus * per_cu;
        if (ws_size < WS_END) fprintf(stderr, "kernel_launch: workspace too small: %zu < %zu\n", ws_size, (size_t)WS_END);
    }
    Params P{};
    P.x = (const float*)d_in[0];
    P.p = (const float*)d_in[1];
    P.positions = (const int*)d_in[2];
    P.attn_norm = (const float*)d_in[3];
    P.w_in = (const float*)d_in[4];
    P.nsa_gain = (const float*)d_in[5];
    P.cmp_pos = (const float*)d_in[6];
    P.cmp_w1 = (const float*)d_in[7];
    P.cmp_w2 = (const float*)d_in[8];
    P.dsa_gain = (const float*)d_in[9];
    P.w_a = (const float*)d_in[10];
    P.w_b = (const float*)d_in[11];
    P.w_out = (const float*)d_in[12];
    P.ffn_norm = (const float*)d_in[13];
    P.peer_wq = (const float*)d_in[14];
    P.peer_sk = (const float*)d_in[15];
    P.peer_u = (const float*)d_in[16];
    P.peer_v = (const float*)d_in[17];
    P.ple_w = (const float*)d_in[18];
    P.ple_gw = (const float*)d_in[19];
    P.ple_norm = (const float*)d_in[20];
    P.out = (float*)d_out;
    P.ws = (unsigned char*)d_ws;
    void* args[] = {&P};
    (void)hipMemsetAsync((unsigned char*)d_ws + OFF_BAR, 0, 3456 * 4, stream);
    hipError_t e = hipLaunchCooperativeKernel((void*)fwd_kernel, dim3(grid_blocks), dim3(256), args, LDS_BYTES + 16, stream);
    if (e != hipSuccess) fprintf(stderr, "cooperative launch failed: %s (grid %d)\n", hipGetErrorString(e), grid_blocks);
}
```

```cpp
#include <hip/hip_runtime.h>
#include <hip/hip_cooperative_groups.h>
#include <cstdio>
#include <cstdint>
namespace cg = cooperative_groups;
#ifndef PROBE_SEC
#define PROBE_SEC 0
#endif
#define SEC_T() (PROBE_SEC ? __builtin_amdgcn_s_memrealtime() : 0ull)
#define SEC_ADD(k, t0) do { if (PROBE_SEC == (k)) { unsigned long long n_ = SEC_T(); tacc += n_ - (t0); } } while (0)

typedef unsigned short u16;
typedef unsigned int u32;
typedef unsigned long long u64;
using bf16x8 = __attribute__((ext_vector_type(8))) short;
using f32x4 = __attribute__((ext_vector_type(4))) float;
using f32x16 = __attribute__((ext_vector_type(16))) float;
typedef __bf16 bf16x2_t __attribute__((ext_vector_type(2)));

constexpr int D_MODEL = 1024, BATCH = 8, SEQ = 4096, NTOK = BATCH * SEQ;
constexpr int IN_COLS = 4576;
constexpr int C_NQ = 0, C_NKV = 512, C_DQ = 1280, C_DKV = 1792, C_IQ = 1920, C_IK = 2432, C_MG = 2496, C_NG = 4544, C_IW = 4568;
__host__ __device__ constexpr int perm_col(int n) {
    return n < 1280 ? n : n < 1304 ? 4544 + (n - 1280) : n < 1816 ? 1280 + (n - 1304) : n < 1944 ? 1792 + (n - 1816)
         : n < 2456 ? 1920 + (n - 1944) : n < 2520 ? 2432 + (n - 2456) : n < 2528 ? 4568 + (n - 2520) : 2496 + (n - 2528);
}
constexpr int NCMP = 255;
constexpr int CROWS = BATCH * NCMP * 2;
constexpr int NEXP = 16384;
constexpr float EPS = 1e-6f;

constexpr size_t AL(size_t x) { return (x + 255) & ~(size_t)255; }
constexpr size_t WO_WIN = 0;
constexpr size_t WO_W1 = WO_WIN + AL((size_t)IN_COLS * 1024 * 2);
constexpr size_t WO_W2 = WO_W1 + AL((size_t)2 * 256 * 2048 * 2);
constexpr size_t WO_WA = WO_W2 + AL((size_t)2 * 64 * 256 * 2);
constexpr size_t WO_WB = WO_WA + AL((size_t)1024 * 512 * 2);
constexpr size_t WO_WO = WO_WB + AL((size_t)1024 * 512 * 2);
constexpr size_t WO_WQ = WO_WO + AL((size_t)1024 * 1024 * 2);
constexpr size_t WO_PW = WO_WQ + AL((size_t)2048 * 1024 * 2);
constexpr size_t WO_PG = WO_PW + AL((size_t)1024 * 256 * 2);
constexpr size_t WO_SK = WO_PG + AL((size_t)1024 * 1024 * 2);
constexpr size_t WO_CB = WO_SK + AL((size_t)2 * 128 * 128 * 2);
constexpr size_t W_LAYER = WO_CB + AL((size_t)2 * 256 * 4);

constexpr size_t OFF_W = 0;
constexpr size_t OFF_ROPE = OFF_W + 2 * W_LAYER;
constexpr size_t OFF_H = OFF_ROPE + AL((size_t)NTOK * 16 * 4);
constexpr size_t OFF_PROJ = OFF_H + AL((size_t)NTOK * 1024 * 2);
constexpr size_t OFF_YAB = OFF_PROJ + AL((size_t)NTOK * IN_COLS * 2);
constexpr size_t OFF_CHID = OFF_YAB + AL((size_t)NTOK * 1024 * 2);
constexpr size_t OFF_CBUF = OFF_CHID + AL((size_t)2 * CROWS * 256 * 2);
constexpr size_t OFF_KCB = OFF_CBUF + AL((size_t)2 * CROWS * 64 * 4);
constexpr size_t OFF_VCB = OFF_KCB + AL((size_t)BATCH * 2 * 256 * 64 * 2);
constexpr size_t OFF_RSTDE = OFF_VCB + AL((size_t)BATCH * 2 * 256 * 64 * 2);
constexpr size_t OFF_SSA = OFF_RSTDE + AL((size_t)NTOK * 4);
constexpr size_t OFF_SSE = OFF_SSA + AL((size_t)2 * NTOK * 16 * 4);
constexpr size_t OFF_BITS = OFF_SSE + AL((size_t)2 * NTOK * 16 * 4);
__device__ __forceinline__ float sum16(const float* p) {
    const float4 a = *(const float4*)p, b = *(const float4*)(p + 4), c = *(const float4*)(p + 8), d = *(const float4*)(p + 12);
    return ((a.x + a.y) + (a.z + a.w)) + ((b.x + b.y) + (b.z + b.w)) + (((c.x + c.y) + (c.z + c.w)) + ((d.x + d.y) + (d.z + d.w)));
}
constexpr size_t OFF_BAR = OFF_BITS + AL((size_t)NTOK * 64 * 8);
constexpr size_t OFF_CTR = OFF_BAR + 3456 * 4;
constexpr int N_CTR = 512;
constexpr size_t WS_END = OFF_CTR + AL(N_CTR * 4);
constexpr size_t OFF_PQ = OFF_PROJ;
constexpr size_t OFF_UB = OFF_PQ + (size_t)NTOK * 2048 * 2;
constexpr size_t OFF_VB = OFF_UB + (size_t)NEXP * 1024 * 2;
constexpr size_t OFF_EIDX = OFF_VB + (size_t)NEXP * 1024 * 2;
constexpr size_t OFF_GATE = OFF_EIDX + (size_t)NTOK * 128 * 4;
constexpr size_t OFF_ESC = OFF_GATE + (size_t)NTOK * 128 * 4;
constexpr size_t OFF_PBF = OFF_ESC + (size_t)2 * NEXP * 4;
constexpr size_t OFF_ESU = OFF_PBF + (size_t)NTOK * 256 * 2;
static_assert(OFF_ESU + (size_t)NTOK * 128 * 4 <= OFF_YAB, "alias overflow");

constexpr int LDS_BYTES = 65536 + 2048;

struct Params {
    const float* x; const float* p; const int* positions;
    const float* attn_norm; const float* w_in; const float* nsa_gain; const float* cmp_pos; const float* cmp_w1; const float* cmp_w2;
    const float* dsa_gain; const float* w_a; const float* w_b; const float* w_out; const float* ffn_norm; const float* peer_wq;
    const float* peer_sk; const float* peer_u; const float* peer_v; const float* ple_w; const float* ple_gw; const float* ple_norm;
    float* out; unsigned char* ws;
};

__device__ __forceinline__ u16 f2bf(float f) {
    u32 u = __float_as_uint(f);
    u32 r = u + 0x7FFFu + ((u >> 16) & 1u);
    return (u16)(r >> 16);
}
__device__ __forceinline__ float bf2f(u16 h) { return __uint_as_float(((u32)h) << 16); }
__device__ __forceinline__ float bf_lo(u32 w) { return __uint_as_float(w << 16); }
__device__ __forceinline__ float bf_hi(u32 w) { return __uint_as_float(w & 0xFFFF0000u); }
__device__ __forceinline__ u32 pack2(float a, float b) {
    bf16x2_t v = {(__bf16)a, (__bf16)b};
    return __builtin_bit_cast(u32, v);
}
__device__ __forceinline__ float dot2(u32 a, u32 b, float c) {
    return __builtin_amdgcn_fdot2_f32_bf16(__builtin_bit_cast(bf16x2_t, a), __builtin_bit_cast(bf16x2_t, b), c, false);
}
template <int CTRL>
__device__ __forceinline__ int dppi(int x) { return __builtin_amdgcn_update_dpp(x, x, CTRL, 0xF, 0xF, false); }
template <int CTRL>
__device__ __forceinline__ float dppf(float x) { return __int_as_float(dppi<CTRL>(__float_as_int(x))); }
__device__ __forceinline__ int row_sum16i(int x) {
    x += dppi<0x128>(x);
    x += dppi<0x124>(x);
    x += dppi<0x122>(x);
    x += dppi<0x121>(x);
    return x;
}
template <int CTRL>
__device__ __forceinline__ int dppi0(int x) { return __builtin_amdgcn_update_dpp(0, x, CTRL, 0xF, 0xF, true); }
__device__ __forceinline__ int row_xscan16i(int x) {
    int s = x;
    s += dppi0<0x111>(s);
    s += dppi0<0x112>(s);
    s += dppi0<0x114>(s);
    s += dppi0<0x118>(s);
    return s - x;
}
__device__ __forceinline__ float row_sum16f(float x) {
    x += dppf<0x128>(x);
    x += dppf<0x124>(x);
    x += dppf<0x122>(x);
    x += dppf<0x121>(x);
    return x;
}
__device__ __forceinline__ float row_max16f(float x) {
    x = fmaxf(x, dppf<0x128>(x));
    x = fmaxf(x, dppf<0x124>(x));
    x = fmaxf(x, dppf<0x122>(x));
    x = fmaxf(x, dppf<0x121>(x));
    return x;
}

__device__ __forceinline__ u32 row_max16u(u32 x) {
    x = max(x, (u32)dppi<0x128>((int)x));
    x = max(x, (u32)dppi<0x124>((int)x));
    x = max(x, (u32)dppi<0x122>((int)x));
    x = max(x, (u32)dppi<0x121>((int)x));
    return x;
}
__device__ __forceinline__ u32 row_min16u(u32 x) {
    x = min(x, (u32)dppi<0x128>((int)x));
    x = min(x, (u32)dppi<0x124>((int)x));
    x = min(x, (u32)dppi<0x122>((int)x));
    x = min(x, (u32)dppi<0x121>((int)x));
    return x;
}
__device__ __forceinline__ float wsum(float v) {
    v = row_sum16f(v);
    const float a = __int_as_float(__builtin_amdgcn_readlane(__float_as_int(v), 0));
    const float b = __int_as_float(__builtin_amdgcn_readlane(__float_as_int(v), 16));
    const float c = __int_as_float(__builtin_amdgcn_readlane(__float_as_int(v), 32));
    const float d = __int_as_float(__builtin_amdgcn_readlane(__float_as_int(v), 48));
    return (a + b) + (c + d);
}
__device__ __forceinline__ float wmax(float v) {
    v = row_max16f(v);
    const float a = __int_as_float(__builtin_amdgcn_readlane(__float_as_int(v), 0));
    const float b = __int_as_float(__builtin_amdgcn_readlane(__float_as_int(v), 16));
    const float c = __int_as_float(__builtin_amdgcn_readlane(__float_as_int(v), 32));
    const float d = __int_as_float(__builtin_amdgcn_readlane(__float_as_int(v), 48));
    return fmaxf(fmaxf(a, b), fmaxf(c, d));
}
__device__ __forceinline__ int wsumi(int v) {
    v = row_sum16i(v);
    return __builtin_amdgcn_readlane(v, 0) + __builtin_amdgcn_readlane(v, 16) + __builtin_amdgcn_readlane(v, 32) + __builtin_amdgcn_readlane(v, 48);
}
__device__ __forceinline__ float sigmoidf(float x) { return 1.0f / (1.0f + __expf(-x)); }
__device__ __forceinline__ float gelu_tanh(float x) {
    float u = 0.7978845608028654f * (x + 0.044715f * x * x * x);
    return 0.5f * x * (1.0f + tanhf(u));
}
__device__ __forceinline__ u32 sortkey(float f) {
    u32 b = __float_as_uint(f);
    return b ^ ((b >> 31) ? 0xFFFFFFFFu : 0x80000000u);
}
#define WAVE_SYNC() asm volatile("s_waitcnt lgkmcnt(0)" ::: "memory")
template <class T>
__device__ __forceinline__ T* opq(T* p) {
    long z = 0;
    asm volatile("" : "+s"(z));
    return (T*)((char*)p + z);
}
__device__ __forceinline__ int tidx() {
    int t = threadIdx.x;
    asm volatile("" : "+v"(t));
    return t;
}
__device__ __forceinline__ int bidx() {
    int b = blockIdx.x;
    asm volatile("" : "+s"(b));
    return b;
}
__device__ __forceinline__ int gdim() {
    int g = gridDim.x;
    asm volatile("" : "+s"(g));
    return g;
}

template <int AMODE, bool HAS_RS, class RowFn, class Epi>
__device__ __forceinline__ void gemm_tile(const u16* __restrict__ Ap, long lda, const u16* __restrict__ BT, long ldb, int M, int N, int K, int m0,
                                          int n0, unsigned char* lds, RowFn rowfn, Epi epi) {
    const int tid = tidx(), lane = tid & 63, w = tid >> 6;
    const int wm = w >> 1, wn = w & 1;
    f32x4 acc[4][4];
#pragma unroll
    for (int i = 0; i < 4; ++i)
#pragma unroll
        for (int j = 0; j < 4; ++j) acc[i][j] = f32x4{0.f, 0.f, 0.f, 0.f};
    long aoff[4], boff[4];
#pragma unroll
    for (int i = 0; i < 4; ++i) {
        const int row = (w * 4 + i) * 8 + (lane >> 3);
        const int kc = (lane & 7) ^ ((row >> 1) & 7);
        int gr = m0 + row;
        if (gr > M - 1) gr = M - 1;
        if (AMODE == 1) {
            int b = gr / (NCMP * 2);
            int rem = gr - b * (NCMP * 2);
            aoff[i] = ((long)b * SEQ + 16 * (rem >> 1)) * IN_COLS + (rem & 1) * 64 + kc * 8;
        } else {
            aoff[i] = (long)gr * lda + kc * 8;
        }
        int gn = n0 + row;
        if (gn > N - 1) gn = N - 1;
        boff[i] = (long)gn * ldb + kc * 8;
    }
    const int nk = K / 64;
#define GEMM_STAGE(kt, bufsel)                                                                                                        \
    do {                                                                                                                              \
        unsigned char* ab_ = lds + (bufsel) * 32768 + w * 4096 + lane * 16;                                                           \
        const long ka_ = (AMODE == 1) ? (long)(kt) * IN_COLS : (long)(kt) * 64;                                                       \
        _Pragma("unroll") for (int i_ = 0; i_ < 4; ++i_) {                                                                            \
            __builtin_amdgcn_global_load_lds((const unsigned*)(Ap + aoff[i_] + ka_), (unsigned*)(ab_ + i_ * 1024), 16, 0, 0);        \
            __builtin_amdgcn_global_load_lds((const unsigned*)(BT + boff[i_] + (long)(kt) * 64), (unsigned*)(ab_ + 16384 + i_ * 1024), 16, 0, 0); \
        }                                                                                                                             \
    } while (0)
    GEMM_STAGE(0, 0);
    asm volatile("s_waitcnt vmcnt(0)" ::: "memory");
    __syncthreads();
    int fa[4], fb[4];
#pragma unroll
    for (int i = 0; i < 4; ++i) {
        const int ra = wm * 64 + i * 16 + (lane & 15), rb = wn * 64 + i * 16 + (lane & 15);
        fa[i] = ra * 128 + ((ra >> 1) & 7) * 16;
        fb[i] = rb * 128 + ((rb >> 1) & 7) * 16;
    }
    for (int kt = 0; kt < nk; ++kt) {
        if (kt + 1 < nk) GEMM_STAGE(kt + 1, (kt + 1) & 1);
        const unsigned char* Ab = lds + (kt & 1) * 32768;
        const unsigned char* Bb = Ab + 16384;
#pragma unroll
        for (int ks = 0; ks < 2; ++ks) {
            const int kc16 = (ks * 4 + (lane >> 4)) * 16;
            bf16x8 af[4], bfr[4];
#pragma unroll
            for (int i = 0; i < 4; ++i) {
                af[i] = *(const bf16x8*)(Ab + ((fa[i] & ~127) | ((fa[i] & 127) ^ kc16)));
                bfr[i] = *(const bf16x8*)(Bb + ((fb[i] & ~127) | ((fb[i] & 127) ^ kc16)));
            }
#pragma unroll
            for (int i = 0; i < 4; ++i)
#pragma unroll
                for (int j = 0; j < 4; ++j) acc[i][j] = __builtin_amdgcn_mfma_f32_16x16x32_bf16(af[i], bfr[j], acc[i][j], 0, 0, 0);
        }
        asm volatile("s_waitcnt vmcnt(0)" ::: "memory");
        __syncthreads();
    }
#undef GEMM_STAGE
    float2* rsl = (float2*)(lds + 34816);
    if (HAS_RS) {
        if (tid < 128) {
            int gr = m0 + tid;
            if (gr > M - 1) gr = M - 1;
            rsl[tid] = rowfn(gr);
        }
        __syncthreads();
    }
    float* st = (float*)(lds + w * 8704);
#pragma unroll
    for (int hh = 0; hh < 2; ++hh) {
#pragma unroll
        for (int m2 = 0; m2 < 2; ++m2)
#pragma unroll
            for (int j = 0; j < 4; ++j)
#pragma unroll
                for (int r = 0; r < 4; ++r) st[(m2 * 16 + (lane >> 4) * 4 + r) * 68 + j * 16 + (lane & 15)] = acc[hh * 2 + m2][j][r];
        WAVE_SYNC();
#pragma unroll
        for (int c = 0; c < 4; ++c) {
            const int id = c * 64 + lane;
            const int rr = id >> 3, cc = id & 7;
            const float4 v0 = *(const float4*)(st + rr * 68 + cc * 8);
            const float4 v1 = *(const float4*)(st + rr * 68 + cc * 8 + 4);
            const float v[8] = {v0.x, v0.y, v0.z, v0.w, v1.x, v1.y, v1.z, v1.w};
            const int row = m0 + wm * 64 + hh * 32 + rr;
            const int col0 = n0 + wn * 64 + cc * 8;
            const float2 rs = HAS_RS ? rsl[wm * 64 + hh * 32 + rr] : float2{1.f, 1.f};
            if (row < M && col0 < N) epi(row, col0, v, rs);
        }
        WAVE_SYNC();
    }
    __syncthreads();
}

template <int AMODE, bool HAS_RS, class RowFn, class Epi>
__device__ __forceinline__ void gemm_phase_rs(const u16* Ap, long lda, const u16* BT, long ldb, int M, int N, int K, unsigned char* lds, RowFn rowfn, Epi epi) {
    const int tm = (M + 127) / 128, tn = (N + 127) / 128;
    const int SW = (tn % 9 == 0) ? 9 : ((tn % 8 == 0) ? 8 : 0);
    const int G = gdim();
    if (SW != 0 && (tm % 8) == 0 && (G % 8) == 0 && (((tm / 8) * (tn / SW)) % 8) == 0) {
        const int nsc = tn / SW;
        const int per = 8 * SW;
        const int nst_x = (tm / 8) * nsc / 8;
        const int x = bidx() & 7, j0 = bidx() >> 3, nper = G >> 3;
        for (int q = j0; q < nst_x * per; q += nper) {
            const int st = (q / per) * 8 + x;
            const int r = q % per;
            const int im = (st / nsc) * 8 + (r % 8), in = (st % nsc) * SW + (r / 8);
            gemm_tile<AMODE, HAS_RS>(Ap, lda, BT, ldb, M, N, K, im * 128, in * 128, lds, rowfn, epi);
        }
    } else {
        for (int t = bidx(); t < tm * tn; t += G) {
            int im = t / tn, in = t - im * tn;
            gemm_tile<AMODE, HAS_RS>(Ap, lda, BT, ldb, M, N, K, im * 128, in * 128, lds, rowfn, epi);
        }
    }
}
template <int AMODE, class Epi>
__device__ __forceinline__ void gemm_phase(const u16* Ap, long lda, const u16* BT, long ldb, int M, int N, int K, unsigned char* lds, Epi epi) {
    gemm_phase_rs<AMODE, false>(Ap, lda, BT, ldb, M, N, K, lds, [](int) { return float2{1.f, 1.f}; },
                                [=](int row, int col, const float (&v)[8], float2) { epi(row, col, v); });
}
__device__ __forceinline__ void st_bf8(u16* p, const float (&v)[8]) {
    *(uint4*)p = uint4{pack2(v[0], v[1]), pack2(v[2], v[3]), pack2(v[4], v[5]), pack2(v[6], v[7])};
}
__device__ __forceinline__ void ld_bf8(const u16* p, float (&v)[8]) {
    const uint4 q = *(const uint4*)p;
    v[0] = bf_lo(q.x); v[1] = bf_hi(q.x); v[2] = bf_lo(q.y); v[3] = bf_hi(q.y);
    v[4] = bf_lo(q.z); v[5] = bf_hi(q.z); v[6] = bf_lo(q.w); v[7] = bf_hi(q.w);
}

template <bool PERM = false>
__device__ __forceinline__ void transpose_cvt(const float* __restrict__ src, u16* __restrict__ dst, int K, int N, float* tile, const float* kgain = nullptr) {
    const int tk = K / 64, tn = (N + 63) / 64;
    const int tid = tidx();
    for (int t = bidx(); t < tk * tn; t += gdim()) {
        const int k0 = (t / tn) * 64, n0 = (t % tn) * 64;
        {
            const int tx = tid & 15, ty = tid >> 4;
#pragma unroll
            for (int i = 0; i < 4; ++i) {
                const int k = ty * 4 + i, n = n0 + tx * 4;
                float4 v = float4{0.f, 0.f, 0.f, 0.f};
                if (n < N) v = *(const float4*)(src + (long)(k0 + k) * N + n);
                const float g = kgain ? kgain[k0 + k] : 1.0f;
                float* trow = tile + k * 65 + tx * 4;
                trow[0] = v.x * g; trow[1] = v.y * g; trow[2] = v.z * g; trow[3] = v.w * g;
            }
        }
        __syncthreads();
        {
            const int kc = tid & 7, nl = tid >> 3;
#pragma unroll
            for (int j = 0; j < 2; ++j) {
                const int nn = nl + 32 * j, n = n0 + nn;
                float v[8];
#pragma unroll
                for (int q = 0; q < 8; ++q) v[q] = tile[(kc * 8 + q) * 65 + nn];
                if (n < N) st_bf8(dst + (long)(PERM ? perm_col(n) : n) * K + k0 + kc * 8, v);
            }
        }
        __syncthreads();
    }
}

__device__ __forceinline__ void cvt_f32_bf16(const float* __restrict__ src, u16* __restrict__ dst, long n) {
    long i = ((long)bidx() * 256 + tidx()) * 8;
    const long stride = (long)gdim() * 256 * 8;
    for (; i < n; i += stride) {
        float4 a = *(const float4*)(src + i);
        float4 b = *(const float4*)(src + i + 4);
        *(uint4*)(dst + i) = uint4{pack2(a.x, a.y), pack2(a.z, a.w), pack2(b.x, b.y), pack2(b.z, b.w)};
    }
}

typedef float f32x2_t __attribute__((ext_vector_type(2)));
__device__ __forceinline__ void cvt_rows_fp8(const float* __restrict__ src, unsigned char* __restrict__ dst, float* __restrict__ scales, int nrows) {
    const int lane = tidx() & 63;
    const int wid = bidx() * 4 + (tidx() >> 6);
    const int nw = gdim() * 4;
    for (int row = wid; row < nrows; row += nw) {
        const float* r = src + (long)row * 1024 + lane * 16;
        float4 q[4];
#pragma unroll
        for (int i = 0; i < 4; ++i) q[i] = *(const float4*)(r + 4 * i);
        float am = 0.f;
#pragma unroll
        for (int i = 0; i < 4; ++i) am = fmaxf(am, fmaxf(fmaxf(fabsf(q[i].x), fabsf(q[i].y)), fmaxf(fabsf(q[i].z), fabsf(q[i].w))));
        am = wmax(am);
        const float inv = am > 0.f ? 448.0f / am : 0.f;
        if (lane == 0) scales[row] = am > 0.f ? am * (1.0f / 448.0f) : 0.f;
        u32 wv[4];
#pragma unroll
        for (int i = 0; i < 4; ++i) {
            int x = 0;
            x = __builtin_amdgcn_cvt_pk_fp8_f32(q[i].x * inv, q[i].y * inv, x, false);
            x = __builtin_amdgcn_cvt_pk_fp8_f32(q[i].z * inv, q[i].w * inv, x, true);
            wv[i] = (u32)x;
        }
        *(uint4*)(dst + (long)row * 1024 + lane * 16) = uint4{wv[0], wv[1], wv[2], wv[3]};
    }
}

__device__ __forceinline__ void rms_rows(const float* __restrict__ x, const float* __restrict__ g, u16* __restrict__ dst, const u16* __restrict__ e,
                         float* __restrict__ rstd_e) {
    const int lane = tidx() & 63;
    const int wid = bidx() * 4 + (tidx() >> 6);
    const int nw = gdim() * 4;
    for (int row = wid; row < NTOK; row += nw) {
        const float* xr = x + (long)row * 1024;
        float4 v[4];
        float ss = 0.f;
#pragma unroll
        for (int i = 0; i < 4; ++i) {
            v[i] = *(const float4*)(xr + i * 256 + lane * 4);
            ss += v[i].x * v[i].x + v[i].y * v[i].y + v[i].z * v[i].z + v[i].w * v[i].w;
        }
        ss = wsum(ss);
        float rstd = rsqrtf(ss * (1.0f / 1024.0f) + EPS);
#pragma unroll
        for (int i = 0; i < 4; ++i) {
            float4 gg = g ? *(const float4*)(g + i * 256 + lane * 4) : float4{1.f, 1.f, 1.f, 1.f};
            uint2 o = uint2{pack2(v[i].x * rstd * gg.x, v[i].y * rstd * gg.y), pack2(v[i].z * rstd * gg.z, v[i].w * rstd * gg.w)};
            *(uint2*)(dst + (long)row * 1024 + i * 256 + lane * 4) = o;
        }
        if (e) {
            const uint4* er = (const uint4*)(e + (long)row * 1024);
            float es = 0.f;
#pragma unroll
            for (int i = 0; i < 2; ++i) {
                uint4 q = er[i * 64 + lane];
                float a;
                a = bf_lo(q.x); es += a * a; a = bf_hi(q.x); es += a * a;
                a = bf_lo(q.y); es += a * a; a = bf_hi(q.y); es += a * a;
                a = bf_lo(q.z); es += a * a; a = bf_hi(q.z); es += a * a;
                a = bf_lo(q.w); es += a * a; a = bf_hi(q.w); es += a * a;
            }
            es = wsum(es);
            if (lane == 0) rstd_e[row] = rsqrtf(es * (1.0f / 1024.0f) + EPS);
        }
    }
}

__device__ __forceinline__ void head_chunk(u16* ptr, float gain, bool do_norm, float scale, float c, float sn, int lane) {
    float v = bf2f(ptr[lane]);
    if (do_norm) {
        float ss = wsum(v * v);
        v = v * rsqrtf(ss * (1.0f / 64.0f) + EPS) * gain;
    }
    float pv = __shfl_xor(v, 8);
    if (lane < 16) v = (lane < 8) ? (v * c - pv * sn) : (v * c + pv * sn);
    ptr[lane] = f2bf(v * scale);
}
__device__ __forceinline__ u32 sig2(u32 w) { return pack2(sigmoidf(bf_lo(w)), sigmoidf(bf_hi(w))); }

__device__ __forceinline__ void post_proj(unsigned char* ws, const float* ng, const float* dg, unsigned char* smem) {
    u16* proj = (u16*)(ws + OFF_PROJ);
    const float* ropec = (const float*)(ws + OFF_ROPE);
    const float* ropes = ropec + (size_t)NTOK * 8;
    const int lane = tidx() & 63, w = tidx() >> 6;
    u16* lrow = (u16*)(smem + w * 9216);
    const float g_q = ng[lane], g_ks = ng[128 + lane], g_kw = ng[192 + lane], g_dq = dg[lane], g_kb = dg[64 + lane];
    const int wid = bidx() * 4 + w;
    const int nw = gdim() * 4;
    for (int t = wid; t < NTOK; t += nw) {
        uint4* grow = (uint4*)(proj + (long)t * IN_COLS);
        const float c = ropec[(long)t * 8 + (lane & 7)], sn = ropes[(long)t * 8 + (lane & 7)];
#pragma unroll
        for (int i = 0; i < 8; ++i) ((uint4*)lrow)[i * 64 + lane] = grow[i * 64 + lane];
        if (lane < 60) ((uint4*)lrow)[512 + lane] = grow[512 + lane];
        WAVE_SYNC();
        for (int h = 0; h < 8; ++h) head_chunk(lrow + C_NQ + h * 64, g_q, true, 0.125f * 1.4426950408889634f, c, sn, lane);
        for (int g = 0; g < 2; ++g) head_chunk(lrow + C_NKV + (2 * 2 + g) * 64, g_ks, true, 1.0f, c, sn, lane);
        for (int g = 0; g < 2; ++g) head_chunk(lrow + C_NKV + (4 * 2 + g) * 64, g_kw, true, 1.0f, c, sn, lane);
        for (int h = 0; h < 8; ++h) head_chunk(lrow + C_DQ + h * 64, g_dq, true, 0.125f * 1.4426950408889634f, c, sn, lane);
        head_chunk(lrow + C_DKV, g_kb, true, 1.0f, c, sn, lane);
        for (int h = 0; h < 8; ++h) head_chunk(lrow + C_IQ + h * 64, 1.0f, false, 0.125f, c, sn, lane);
        head_chunk(lrow + C_IK, 1.0f, false, 1.0f, c, sn, lane);
        WAVE_SYNC();
#pragma unroll
        for (int i = 0; i < 9; ++i) {
            int idx = i * 64 + lane;
            if (idx < 572) {
                uint4 v = ((const uint4*)lrow)[idx];
                if (idx >= 316 || (idx >= 160 && idx < 163)) v = uint4{sig2(v.x), sig2(v.y), sig2(v.z), sig2(v.w)};
                grow[idx] = v;
            }
        }
        WAVE_SYNC();
    }
}

template <int NH>
__device__ __forceinline__ void qk_chunk(const u16* krow, const u32* qlds, float (&s)[NH]) {
    asm volatile("" ::: "memory");
    uint4 kr[8];
#pragma unroll
    for (int i = 0; i < 8; ++i) kr[i] = ((const uint4*)krow)[i];
#pragma unroll
    for (int h = 0; h < NH; ++h) s[h] = 0.f;
#pragma unroll
    for (int i = 0; i < 8; ++i)
#pragma unroll
        for (int h = 0; h < NH; ++h) {
            uint4 q = *(const uint4*)(qlds + h * 32 + i * 4);
            s[h] = dot2(kr[i].x, q.x, s[h]);
            s[h] = dot2(kr[i].y, q.y, s[h]);
            s[h] = dot2(kr[i].z, q.z, s[h]);
            s[h] = dot2(kr[i].w, q.w, s[h]);
        }
}

template <int NH, class VRow>
__device__ __forceinline__ void pv_chunk(const float* plds, VRow vrow, float (&o)[NH][4], int lane) {
    const int sub = lane >> 4, dq = lane & 15;
#pragma unroll 4
    for (int kk = 0; kk < 16; ++kk) {
        int key = kk * 4 + sub;
        const u16* vp = vrow(key);
        uint2 vv = *(const uint2*)(vp + dq * 4);
        float v0 = bf_lo(vv.x), v1 = bf_hi(vv.x), v2 = bf_lo(vv.y), v3 = bf_hi(vv.y);
#pragma unroll
        for (int h = 0; h < NH; ++h) {
            float ph = plds[key * NH + h];
            o[h][0] += ph * v0;
            o[h][1] += ph * v1;
            o[h][2] += ph * v2;
            o[h][3] += ph * v3;
        }
    }
}

template <int NH, class VRow>
__device__ __forceinline__ void attn_chunk(float (&s)[NH], bool valid, float (&m)[NH], float (&l)[NH], float (&o)[NH][4], float* plds, VRow vrow,
                                           int lane) {
#pragma unroll
    for (int h = 0; h < NH; ++h) {
        float sv = valid ? s[h] : -1e30f;
        float cm = wmax(sv);
        float mn = fmaxf(m[h], cm);
        float alpha = __expf(m[h] - mn);
        float p = valid ? __expf(sv - mn) : 0.f;
        l[h] = l[h] * alpha + wsum(p);
        m[h] = mn;
#pragma unroll
        for (int j = 0; j < 4; ++j) o[h][j] *= alpha;
        plds[lane * NH + h] = p;
    }
    WAVE_SYNC();
    pv_chunk<NH>(plds, vrow, o, lane);
    WAVE_SYNC();
}

#define MFMA32(a, b, c) __builtin_amdgcn_mfma_f32_32x32x16_bf16(a, b, c, 0, 0, 0)
typedef __attribute__((address_space(3))) const char* lds_cptr;
typedef short v4i16_t __attribute__((ext_vector_type(4)));
using s16x4 = __attribute__((ext_vector_type(4))) short;
__device__ __forceinline__ s16x4 vtr(lds_cptr p) {
    return __builtin_bit_cast(s16x4, __builtin_amdgcn_ds_read_tr16_b64_v4i16((__attribute__((address_space(3))) v4i16_t*)p));
}
__device__ __forceinline__ float xhalf_sum(float v) {
    auto r = __builtin_amdgcn_permlane32_swap(__float_as_uint(v), __float_as_uint(v), false, false);
    return __uint_as_float(r[0]) + __uint_as_float(r[1]);
}
__device__ __forceinline__ float xhalf_max(float v) {
    auto r = __builtin_amdgcn_permlane32_swap(__float_as_uint(v), __float_as_uint(v), false, false);
    return fmaxf(__uint_as_float(r[0]), __uint_as_float(r[1]));
}

using u32x4 = __attribute__((ext_vector_type(4))) unsigned;
struct TileRegs { u32x4 k0, k1, v0, v1; };
template <class RowPtr>
__device__ __forceinline__ void tile_load(u32x4& k0, u32x4& k1, u32x4& v0, u32x4& v1, RowPtr rowptr, int w, int lane) {
    const u16 *kp, *vp, *kp2, *vp2;
    rowptr(lane, kp, vp2);
    rowptr(16 * w + (lane >> 2), kp2, vp);
    k0 = *(const u32x4*)(kp + w * 8);
    k1 = *(const u32x4*)(kp + (w + 4) * 8);
    v0 = *(const u32x4*)(vp + (lane & 3) * 8);
    v1 = *(const u32x4*)(vp + 32 + (lane & 3) * 8);
}
__device__ __forceinline__ void tile_store(const u32x4& k0, const u32x4& k1, const u32x4& v0, const u32x4& v1, unsigned char* buf, int w, int lane) {
    *(u32x4*)(buf + w * 1024 + lane * 16) = k0;
    *(u32x4*)(buf + (w + 4) * 1024 + lane * 16) = k1;
    *(u32x4*)(buf + 8192 + (16 * w + (lane >> 2)) * 64 + (lane & 3) * 16) = v0;
    *(u32x4*)(buf + 8192 + 4096 + (16 * w + (lane >> 2)) * 64 + (lane & 3) * 16) = v1;
}
template <class RowPtr>
__device__ __forceinline__ void tile_dma(RowPtr rowptr, unsigned char* buf, int w, int lane) {
    const u16 *kp, *vp, *kp2, *vp2;
    rowptr(lane, kp, vp2);
    rowptr(16 * w + (lane >> 2), kp2, vp);
    unsigned char* kd = buf + w * 1024 + lane * 16;
    unsigned char* vd = buf + 8192 + w * 1024 + lane * 16;
    __builtin_amdgcn_global_load_lds((const unsigned*)(kp + w * 8), (unsigned*)kd, 16, 0, 0);
    __builtin_amdgcn_global_load_lds((const unsigned*)(kp + (w + 4) * 8), (unsigned*)(kd + 4096), 16, 0, 0);
    __builtin_amdgcn_global_load_lds((const unsigned*)(vp + (lane & 3) * 8), (unsigned*)vd, 16, 0, 0);
    __builtin_amdgcn_global_load_lds((const unsigned*)(vp + 32 + (lane & 3) * 8), (unsigned*)(vd + 4096), 16, 0, 0);
}
__device__ __forceinline__ void qk_tile(const unsigned char* buf, const bf16x8 (&qr)[4], const f32x16& zero16, f32x16& s0, f32x16& s1, int lane) {
    const int r32 = lane & 31, hi = lane >> 5;
    lds_cptr kp = (lds_cptr)buf + hi * 1024 + r32 * 16;
#pragma unroll
    for (int d0 = 0; d0 < 4; ++d0) {
        bf16x8 k0 = *(const __attribute__((address_space(3))) bf16x8*)(kp + d0 * 2048);
        bf16x8 k1 = *(const __attribute__((address_space(3))) bf16x8*)(kp + d0 * 2048 + 512);
        s0 = MFMA32(k0, qr[d0], d0 == 0 ? zero16 : s0);
        s1 = MFMA32(k1, qr[d0], d0 == 0 ? zero16 : s1);
    }
}
__device__ __forceinline__ bf16x8 pack8(const f32x16& p, int s) {
    u32 a = pack2(p[8 * s + 0], p[8 * s + 1]), b = pack2(p[8 * s + 2], p[8 * s + 3]);
    u32 c = pack2(p[8 * s + 4], p[8 * s + 5]), d = pack2(p[8 * s + 6], p[8 * s + 7]);
    u32x4 v = u32x4{a, b, c, d};
    return __builtin_bit_cast(bf16x8, v);
}
__device__ __forceinline__ void pv_tile(const unsigned char* buf, const f32x16& p0, const f32x16& p1, f32x16 (&o)[2], int lane) {
    const int hi = lane >> 5;
    lds_cptr vp = (lds_cptr)buf + 8192 + ((lane >> 4) & 1) * 32 + (lane & 3) * 8 + (4 * hi + ((lane & 15) >> 2)) * 64;
    bf16x8 pf[4];
    pf[0] = pack8(p0, 0);
    pf[1] = pack8(p0, 1);
    pf[2] = pack8(p1, 0);
    pf[3] = pack8(p1, 1);
#pragma unroll
    for (int dh = 0; dh < 2; ++dh) {
        bf16x8 vf[4];
#pragma unroll
        for (int ks = 0; ks < 4; ++ks) {
            s16x4 vlo = vtr(vp + dh * 4096 + ks * 1024);
            s16x4 vhi = vtr(vp + dh * 4096 + ks * 1024 + 512);
            vf[ks] = (bf16x8){vlo[0], vlo[1], vlo[2], vlo[3], vhi[0], vhi[1], vhi[2], vhi[3]};
        }
        __builtin_amdgcn_sched_barrier(0);
#pragma unroll
        for (int ks = 0; ks < 4; ++ks) o[dh] = MFMA32(vf[ks], pf[ks], o[dh]);
        __builtin_amdgcn_sched_barrier(0);
    }
}
template <bool BITS>
__device__ __forceinline__ void apply_mask(f32x16& s0, f32x16& s1, int lo, int hi_lim, u64 word, int hi) {
    const u32 wlo = (u32)(word >> (4 * hi)), whi = (u32)(word >> (32 + 4 * hi));
#pragma unroll
    for (int i = 0; i < 16; ++i) {
        const int kc = (i & 3) + 8 * (i >> 2);
        bool v0, v1;
        if (BITS) {
            v0 = (wlo >> kc) & 1u;
            v1 = (whi >> kc) & 1u;
        } else {
            const int kk = kc + 4 * hi;
            v0 = (kk >= lo) && (kk <= hi_lim);
            v1 = (kk + 32 >= lo) && (kk + 32 <= hi_lim);
        }
        s0[i] = v0 ? s0[i] : -1e30f;
        s1[i] = v1 ? s1[i] : -1e30f;
    }
}
__device__ __forceinline__ void softmax_step(f32x16& s0, f32x16& s1, float& m, float& l, f32x16 (&o)[2]) {
    float mx = fmaxf(s0[0], s1[0]);
#pragma unroll
    for (int i = 1; i < 16; ++i) mx = fmaxf(fmaxf(mx, s0[i]), s1[i]);
    mx = xhalf_max(mx);
    if (__any(mx > m + 8.0f)) {
        const float mn = fmaxf(m, mx);
        const float alpha = __builtin_amdgcn_exp2f(m - mn);
        l *= alpha;
        m = mn;
#pragma unroll
        for (int i = 0; i < 16; ++i) { o[0][i] *= alpha; o[1][i] *= alpha; }
    }
    const float ms = fmaxf(m, -1e29f);
    float sum = 0.f;
#pragma unroll
    for (int i = 0; i < 16; ++i) {
        s0[i] = __builtin_amdgcn_exp2f(s0[i] - ms);
        s1[i] = __builtin_amdgcn_exp2f(s1[i] - ms);
        sum += s0[i] + s1[i];
    }
    l += xhalf_sum(sum);
}

template <int MODE, bool BITS, class Next, class RowPtr, class MaskFn, class Extra>
__device__ __forceinline__ void flash_run(int first, Next next, RowPtr rowptr, MaskFn maskfn, Extra extra, const bf16x8 (&qr)[4], float& m, float& l,
                                          f32x16 (&o)[2], unsigned char* bufs, int w, int lane) {
    if (first < 0) return;
    int cur = first;
    __syncthreads();
    tile_dma([&](int r, const u16*& kp, const u16*& vp) { rowptr(cur, r, kp, vp); }, bufs, w, lane);
    asm volatile("s_waitcnt vmcnt(0)" ::: "memory");
    __syncthreads();
    int pb = 0;
    f32x16 zero16;
#pragma unroll
    for (int i = 0; i < 16; ++i) zero16[i] = 0.f;
    while (cur >= 0) {
        const int nxt = next(cur);
        if (nxt >= 0) tile_dma([&](int r, const u16*& kp, const u16*& vp) { rowptr(nxt, r, kp, vp); }, bufs + (pb ^ 1) * 16384, w, lane);
        const unsigned char* buf = bufs + pb * 16384;
        f32x16 s0, s1;
        qk_tile(buf, qr, zero16, s0, s1, lane);
        int lo, hl;
        u64 word;
        maskfn(cur, lo, hl, word);
        if (BITS || !__all(lo <= 0 && hl >= 63)) apply_mask<BITS>(s0, s1, lo, hl, word, lane >> 5);
        if (MODE == 0) {
            softmax_step(s0, s1, m, l, o);
            pv_tile(buf, s0, s1, o, lane);
        } else if (MODE == 1) {
            f32x16 od[2];
#pragma unroll
            for (int i = 0; i < 16; ++i) { od[0][i] = 0.f; od[1][i] = 0.f; }
            softmax_step(s0, s1, m, l, od);
        } else {
            const float ms2 = fmaxf(m, -1e29f);
#pragma unroll
            for (int i = 0; i < 16; ++i) {
                s0[i] = __builtin_amdgcn_exp2f(s0[i] - ms2) * l;
                s1[i] = __builtin_amdgcn_exp2f(s1[i] - ms2) * l;
            }
            extra(cur, s0, s1);
            pv_tile(buf, s0, s1, o, lane);
        }
        asm volatile("s_waitcnt vmcnt(0)" ::: "memory");
        __syncthreads();
        pb ^= 1;
        cur = nxt;
    }
}

__device__ __forceinline__ void nsa_unit(unsigned char* ws, int b, int g, int qt, unsigned char* smem) {
    const int tid = tidx(), lane = tid & 63, w = tid >> 6;
    const int r32 = lane & 31, hi = lane >> 5;
    const int q0 = qt * 32;
    const int tl = q0 + 8 * w + (r32 >> 2);
    const int rep = r32 & 3;
    const u16* proj = (const u16*)(ws + OFF_PROJ);
    const u16* brow = proj + (long)b * SEQ * IN_COLS;
    const u16* kcb = (const u16*)(ws + OFF_KCB) + (size_t)(b * 2 + g) * 256 * 64;
    const u16* vcb = (const u16*)(ws + OFF_VCB) + (size_t)(b * 2 + g) * 256 * 64;
    u16* ya = (u16*)(ws + OFF_YAB);
    unsigned char* bufs = smem;
    float* imp = (float*)(smem + 32768);
    u64* selm = (u64*)(smem + 32768 + 8192);
    const u16* trow = brow + (long)tl * IN_COLS;
    bf16x8 qr[4];
#pragma unroll
    for (int d0 = 0; d0 < 4; ++d0) qr[d0] = *(const bf16x8*)(trow + C_NQ + (g * 4 + rep) * 64 + d0 * 16 + hi * 8);
    const float gate_c = bf2f(trow[C_NG + 0 * 8 + g * 4 + rep]);
    const float gate_s = bf2f(trow[C_NG + 1 * 8 + g * 4 + rep]);
    const float gate_w = bf2f(trow[C_NG + 2 * 8 + g * 4 + rep]);
    for (int i = tid; i < 32 * 64; i += 256) imp[i] = 0.f;
    f32x16 tot[2];
#pragma unroll
    for (int i = 0; i < 16; ++i) { tot[0][i] = 0.f; tot[1][i] = 0.f; }

    const int nvalid = tl >= 31 ? ((tl - 31) >> 4) + 1 : 0;
    const int nv_max = (q0 + 31 >= 31) ? ((q0 + 31 - 31) >> 4) + 1 : 0;
    const int ntile_c = (nv_max + 63) >> 6;
    auto crows = [&](int tile, int r, const u16*& kp, const u16*& vp) {
        int n = tile * 64 + r;
        n = n < 254 ? n : 254;
        kp = kcb + (size_t)n * 64;
        vp = vcb + (size_t)n * 64;
    };
    auto cnext = [&](int c) { return (c + 1 < ntile_c) ? c + 1 : -1; };
    auto cmask = [&](int tile, int& lo, int& hl, u64& word) { lo = 0; hl = nvalid - 64 * tile - 1; word = 0; };
    {
        float m = -1e30f, l = 0.f;
        f32x16 o[2];
#pragma unroll
        for (int i = 0; i < 16; ++i) { o[0][i] = 0.f; o[1][i] = 0.f; }
        flash_run<1, false>(ntile_c > 0 ? 0 : -1, cnext, crows, cmask, [&](int, f32x16&, f32x16&) {}, qr, m, l, o, bufs, w, lane);
        float invl = l > 0.f ? 1.0f / l : 0.f;
        const int qloc = 8 * w + (r32 >> 2);
        flash_run<2, false>(ntile_c > 0 ? 0 : -1, cnext, crows, cmask,
                            [&](int tile, f32x16& p0, f32x16& p1) {
#pragma unroll
                                for (int a = 0; a < 4; ++a) {
                                    float g0 = p0[4 * a] + p0[4 * a + 1] + p0[4 * a + 2] + p0[4 * a + 3], e0 = p0[4 * a + 3];
                                    float g1 = p1[4 * a] + p1[4 * a + 1] + p1[4 * a + 2] + p1[4 * a + 3], e1 = p1[4 * a + 3];
                                    g0 += __shfl_xor(g0, 1); g0 += __shfl_xor(g0, 2);
                                    e0 += __shfl_xor(e0, 1); e0 += __shfl_xor(e0, 2);
                                    g1 += __shfl_xor(g1, 1); g1 += __shfl_xor(g1, 2);
                                    e1 += __shfl_xor(e1, 1); e1 += __shfl_xor(e1, 2);
                                    if (rep == 0) {
                                        int j0 = 16 * tile + 2 * a + hi, j1 = j0 + 8;
                                        atomicAdd(&imp[qloc * 64 + j0], g0);
                                        if (j0 + 1 < 64) atomicAdd(&imp[qloc * 64 + j0 + 1], e0);
                                        if (j1 < 64) atomicAdd(&imp[qloc * 64 + j1], g1);
                                        if (j1 + 1 < 64) atomicAdd(&imp[qloc * 64 + j1 + 1], e1);
                                    }
                                }
                            },
                            qr, m, invl, o, bufs, w, lane);
#pragma unroll
        for (int i = 0; i < 16; ++i) { tot[0][i] += gate_c * o[0][i]; tot[1][i] += gate_c * o[1][i]; }
    }
    __syncthreads();
    for (int qq = 0; qq < 8; ++qq) {
        const int qi = 8 * w + qq;
        const int tq = q0 + qi;
        const int cur = tq >> 6;
        const int j = lane;
        float v = imp[qi * 64 + j];
        if (j == 0 || j == cur || j == cur - 1) v = __builtin_inff();
        if (j > cur) v = -__builtin_inff();
        const u32 key = sortkey(v);
        u32 Kq = 0u;
        for (int bit = 31; bit >= 0; --bit) {
            const u32 cand = Kq | (1u << bit);
            const int cnt = __popcll(__ballot(key >= cand));
            if (cnt >= 16) Kq = cand;
            if (cnt == 16) break;
        }
        const int needq = 16 - __popcll(__ballot(key > Kq));
        const u64 emq = __ballot(key == Kq);
        const bool takeq = (key > Kq) || (key == Kq && __popcll(emq & ((1ull << lane) - 1ull)) < needq);
        u64 sm = __ballot(takeq && j <= cur);
        if (lane == 0) selm[qi] = sm;
    }
    __syncthreads();
    const u64 mymask = selm[8 * w + (r32 >> 2)];
    u64 unionm = 0;
    for (int i = 0; i < 32; ++i) unionm |= selm[i];
    unionm = __builtin_amdgcn_readfirstlane((u32)unionm) | ((u64)__builtin_amdgcn_readfirstlane((u32)(unionm >> 32)) << 32);
    {
        float m = -1e30f, l = 0.f;
        f32x16 o[2];
#pragma unroll
        for (int i = 0; i < 16; ++i) { o[0][i] = 0.f; o[1][i] = 0.f; }
        auto snext = [&](int c) {
            u64 rest = (c >= 63) ? 0ull : (unionm >> (c + 1));
            return rest ? (c + 1 + (__ffsll((long long)rest) - 1)) : -1;
        };
        const int first = unionm ? (__ffsll((long long)unionm) - 1) : -1;
        flash_run<0, false>(first, snext,
                            [&](int j, int r, const u16*& kp, const u16*& vp) {
                                const u16* rp = brow + (long)(64 * j + r) * IN_COLS + C_NKV;
                                kp = rp + (2 * 2 + g) * 64;
                                vp = rp + (3 * 2 + g) * 64;
                            },
                            [&](int j, int& lo, int& hl, u64& word) { lo = 0; hl = ((mymask >> j) & 1ull) ? (tl - 64 * j) : -1; word = 0; },
                            [&](int, f32x16&, f32x16&) {}, qr, m, l, o, bufs, w, lane);
        const float sc = l > 0.f ? gate_s / l : 0.f;
#pragma unroll
        for (int i = 0; i < 16; ++i) { tot[0][i] += sc * o[0][i]; tot[1][i] += sc * o[1][i]; }
    }
    {
        float m = -1e30f, l = 0.f;
        f32x16 o[2];
#pragma unroll
        for (int i = 0; i < 16; ++i) { o[0][i] = 0.f; o[1][i] = 0.f; }
        const int jfirst = (q0 - 511) > 0 ? ((q0 - 511) >> 6) : 0;
        const int jlast = (q0 + 31) >> 6;
        flash_run<0, false>(jfirst, [&](int c) { return c + 1 <= jlast ? c + 1 : -1; },
                            [&](int j, int r, const u16*& kp, const u16*& vp) {
                                const u16* rp = brow + (long)(64 * j + r) * IN_COLS + C_NKV;
                                kp = rp + (4 * 2 + g) * 64;
                                vp = rp + (5 * 2 + g) * 64;
                            },
                            [&](int j, int& lo, int& hl, u64& word) { lo = tl - 511 - 64 * j; hl = tl - 64 * j; word = 0; },
                            [&](int, f32x16&, f32x16&) {}, qr, m, l, o, bufs, w, lane);
        const float sc = l > 0.f ? gate_w / l : 0.f;
#pragma unroll
        for (int i = 0; i < 16; ++i) { tot[0][i] += sc * o[0][i]; tot[1][i] += sc * o[1][i]; }
    }
    {
        u16* orow = ya + ((long)b * SEQ + tl) * 512 + (g * 4 + rep) * 64;
#pragma unroll
        for (int dh = 0; dh < 2; ++dh)
#pragma unroll
            for (int a = 0; a < 4; ++a) {
                uint2 v = uint2{pack2(tot[dh][4 * a], tot[dh][4 * a + 1]), pack2(tot[dh][4 * a + 2], tot[dh][4 * a + 3])};
                *(uint2*)(orow + dh * 32 + 8 * a + 4 * hi) = v;
            }
    }
}

__device__ __forceinline__ void dsa_select_unit(unsigned char* ws, int unit, unsigned char* smem, unsigned long long& tacc) {
    const int tid = tidx(), lane = tid & 63, w = tid >> 6;
    const int t0 = unit * 4;
    const int b = t0 / SEQ, tl0 = t0 - b * SEQ;
    const u16* proj = (const u16*)(ws + OFF_PROJ);
    const u16* brow = proj + (long)b * SEQ * IN_COLS;
    u64* bits = (u64*)(ws + OFF_BITS);
    float* sc = (float*)smem;
    __syncthreads();
    unsigned long long ts0 = SEC_T();
#ifndef ATTA_REP_IDX
#define ATTA_REP_IDX 1
#endif
#ifndef ATTA_REP_TOPK
#define ATTA_REP_TOPK 1
#endif
    for (int rep_ = 0; rep_ < ATTA_REP_IDX; ++rep_) {
        const int r16 = lane & 15, g4 = lane >> 4;
        bf16x8 af[2][2];
#pragma unroll
        for (int rb = 0; rb < 2; ++rb)
#pragma unroll
            for (int ks = 0; ks < 2; ++ks)
                af[rb][ks] = *(const bf16x8*)(proj + (long)(t0 + 2 * rb + (r16 >> 3)) * IN_COLS + C_IQ + (r16 & 7) * 64 + ks * 32 + g4 * 8);
        float wq[2][4];
#pragma unroll
        for (int rb = 0; rb < 2; ++rb)
#pragma unroll
            for (int i = 0; i < 4; ++i)
                wq[rb][i] = bf2f(proj[(long)(t0 + 2 * rb + (g4 >> 1)) * IN_COLS + C_IW + (g4 & 1) * 4 + i]) * 0.35355339059327373f;
        const int ntiles = (tl0 + 4 + 31) >> 5;
#define IDX_LD(T, B)                                                                                         \
    do {                                                                                                     \
        _Pragma("unroll") for (int kt = 0; kt < 2; ++kt) {                                                   \
            int key_ = (T) * 32 + kt * 16 + r16;                                                             \
            key_ = key_ < SEQ ? key_ : SEQ - 1;                                                              \
            _Pragma("unroll") for (int ks = 0; ks < 2; ++ks)                                                 \
                B[kt][ks] = *(const bf16x8*)(brow + (long)key_ * IN_COLS + C_IK + ks * 32 + g4 * 8);         \
        }                                                                                                    \
    } while (0)
        bf16x8 bn[2][2];
        if (w < ntiles) IDX_LD(w, bn);
        for (int tile = w; tile < ntiles; tile += 4) {
            bf16x8 bc[2][2];
#pragma unroll
            for (int kt = 0; kt < 2; ++kt)
#pragma unroll
                for (int ks = 0; ks < 2; ++ks) bc[kt][ks] = bn[kt][ks];
            if (tile + 4 < ntiles) IDX_LD(tile + 4, bn);
#pragma unroll
            for (int rb = 0; rb < 2; ++rb)
#pragma unroll
                for (int kt = 0; kt < 2; ++kt) {
                    f32x4 acc = f32x4{0.f, 0.f, 0.f, 0.f};
                    acc = __builtin_amdgcn_mfma_f32_16x16x32_bf16(af[rb][0], bc[kt][0], acc, 0, 0, 0);
                    acc = __builtin_amdgcn_mfma_f32_16x16x32_bf16(af[rb][1], bc[kt][1], acc, 0, 0, 0);
                    float part = 0.f;
#pragma unroll
                    for (int i = 0; i < 4; ++i) part += wq[rb][i] * fmaxf(acc[i], 0.f);
                    auto sw = __builtin_amdgcn_permlane16_swap(__float_as_uint(part), __float_as_uint(part), false, false);
                    const float tot = __uint_as_float(sw[0]) + __uint_as_float(sw[1]);
                    if ((g4 & 1) == 0) sc[(2 * rb + (g4 >> 1)) * 4096 + tile * 32 + kt * 16 + r16] = tot;
                }
        }
#undef IDX_LD
    }
    __syncthreads();
    SEC_ADD(1, ts0);
    ts0 = SEC_T();
    const int t = t0 + w;
    const int tl = tl0 + w;
    const int nvalid = tl + 1;
    for (int rep_ = 0; rep_ < ATTA_REP_TOPK; ++rep_) {
        u32 u[64];
        const float* scq = sc + w * 4096;
#pragma unroll
        for (int j = 0; j < 64; ++j) {
            const int key = j * 64 + lane;
            const u32 kk = sortkey(scq[key]);
            u[j] = (key <= tl) ? kk : 0u;
        }
        SEC_ADD(2, ts0);
        ts0 = SEC_T();
        u32 K = 0;
        int need = 0, ceq = 0;
        if (nvalid > 256) {
            u32 lm0 = u[0], lm1 = u[1], lm2 = u[2], lm3 = u[3];
#pragma unroll
            for (int j = 4; j < 64; j += 4) { lm0 = max(lm0, u[j]); lm1 = max(lm1, u[j + 1]); lm2 = max(lm2, u[j + 2]); lm3 = max(lm3, u[j + 3]); }
            u32 lo = min(min(lm0, lm1), min(lm2, lm3)), hiu = max(max(lm0, lm1), max(lm2, lm3));
            lo = row_min16u(lo);
            hiu = row_max16u(hiu);
            const u32 L = min(min((u32)__builtin_amdgcn_readlane((int)lo, 0), (u32)__builtin_amdgcn_readlane((int)lo, 16)),
                              min((u32)__builtin_amdgcn_readlane((int)lo, 32), (u32)__builtin_amdgcn_readlane((int)lo, 48)));
            const u32 U = max(max((u32)__builtin_amdgcn_readlane((int)hiu, 0), (u32)__builtin_amdgcn_readlane((int)hiu, 16)),
                              max((u32)__builtin_amdgcn_readlane((int)hiu, 32), (u32)__builtin_amdgcn_readlane((int)hiu, 48)));
            const u32 dd = U ^ L;
            const int hb = dd ? 31 - __clz((int)dd) : -1;
            K = dd ? (U & ~((2u << hb) - 1u)) : U;
            bool exact = false;
            for (int bit = hb; bit >= 0; --bit) {
                const u32 cand = K | (1u << bit);
                int cl = 0;
#pragma unroll
                for (int j = 0; j < 64; ++j) cl += (u[j] >= cand) ? 1 : 0;
                const int cnt = wsumi(cl);
                if (cnt >= 256) K = cand;
                if (cnt == 256) { exact = true; break; }
            }
            if (exact) {
                need = 1; ceq = 1;
            } else {
                int cgt = 0, ce = 0;
#pragma unroll
                for (int j = 0; j < 64; ++j) { cgt += __popcll(__ballot(u[j] > K)); ce += __popcll(__ballot(u[j] == K)); }
                need = 256 - cgt;
                ceq = ce;
            }
        }
        SEC_ADD(3, ts0);
        ts0 = SEC_T();
        const u64 ltmask = (1ull << lane) - 1ull;
        u64 myword = 0;
        if (nvalid <= 256 || need == ceq) {
            const u32 Kt = (nvalid > 256) ? K : 1u;
#pragma unroll
            for (int j = 0; j < 64; ++j) {
                const u64 sm = __ballot(u[j] >= Kt);
                myword = (lane == j) ? sm : myword;
            }
        } else {
            int ebase = 0;
#pragma unroll
            for (int j = 0; j < 64; ++j) {
                bool eq = (u[j] == K);
                u64 em = __ballot(eq);
                int erank = ebase + __popcll(em & ltmask);
                bool take = (u[j] > K) || (eq && erank < need);
                ebase += __popcll(em);
                u64 sm = __ballot(take);
                myword = (lane == j) ? sm : myword;
            }
        }
        bits[(long)t * 64 + lane] = myword;
        SEC_ADD(4, ts0);
    }
}

__device__ __forceinline__ void dsa_attn_unit(unsigned char* ws, int b, int qt, unsigned char* smem) {
    const int tid = tidx(), lane = tid & 63, w = tid >> 6;
    const int r32 = lane & 31, hi = lane >> 5;
    const int q0 = qt * 16;
    const int qloc = 4 * w + (r32 >> 3);
    const int tl = q0 + qloc;
    const int head = r32 & 7;
    const u16* proj = (const u16*)(ws + OFF_PROJ);
    const u16* brow = proj + (long)b * SEQ * IN_COLS;
    const u64* bits = (const u64*)(ws + OFF_BITS) + ((long)b * SEQ + q0) * 64;
    u16* yb = (u16*)(ws + OFF_YAB) + (size_t)NTOK * 512;
    unsigned char* bufs = smem;
    u64* lbits = (u64*)(smem + 32768);
    __syncthreads();
    for (int i = tid; i < 16 * 64; i += 256) lbits[i] = bits[i];
    const u16* trow = brow + (long)tl * IN_COLS;
    bf16x8 qr[4];
#pragma unroll
    for (int d0 = 0; d0 < 4; ++d0) qr[d0] = *(const bf16x8*)(trow + C_DQ + head * 64 + d0 * 16 + hi * 8);
    float m = -1e30f, l = 0.f;
    f32x16 o[2];
#pragma unroll
    for (int i = 0; i < 16; ++i) { o[0][i] = 0.f; o[1][i] = 0.f; }
    const int jlast = (q0 + 15) >> 6;
    flash_run<0, true>(0, [&](int c) { return c + 1 <= jlast ? c + 1 : -1; },
                       [&](int j, int r, const u16*& kp, const u16*& vp) {
                           const u16* rp = brow + (long)(64 * j + r) * IN_COLS + C_DKV;
                           kp = rp;
                           vp = rp + 64;
                       },
                       [&](int j, int& lo, int& hl, u64& word) { lo = 0; hl = 0; word = lbits[qloc * 64 + j]; },
                       [&](int, f32x16&, f32x16&) {}, qr, m, l, o, bufs, w, lane);
    const float inv = l > 0.f ? 1.0f / l : 0.f;
    u16* orow = yb + ((long)b * SEQ + tl) * 512 + head * 64;
#pragma unroll
    for (int dh = 0; dh < 2; ++dh)
#pragma unroll
        for (int a = 0; a < 4; ++a) {
            uint2 v = uint2{pack2(o[dh][4 * a] * inv, o[dh][4 * a + 1] * inv), pack2(o[dh][4 * a + 2] * inv, o[dh][4 * a + 3] * inv)};
            *(uint2*)(orow + dh * 32 + 8 * a + 4 * hi) = v;
        }
}

__device__ __forceinline__ int grab_block(unsigned* ctr, int limit, unsigned char* smem) {
    volatile int* slot = (volatile int*)(smem + LDS_BYTES + 8);
    __syncthreads();
    if (threadIdx.x == 0) *slot = (int)__hip_atomic_fetch_add(ctr, 1u, __ATOMIC_RELAXED, __HIP_MEMORY_SCOPE_AGENT);
    __syncthreads();
    const int v = *slot;
    return v < limit ? v : -1;
}
__device__ __forceinline__ int grab_wave(unsigned* ctr, int limit) {
    int v = 0;
    if ((threadIdx.x & 63) == 0) v = (int)__hip_atomic_fetch_add(ctr, 1u, __ATOMIC_RELAXED, __HIP_MEMORY_SCOPE_AGENT);
    v = __builtin_amdgcn_readfirstlane(v);
    return v < limit ? v : -1;
}

#define PE_LOAD(UQ, VQ, E0)                                                                   \
    do {                                                                                      \
        _Pragma("unroll") for (int k_ = 0; k_ < 4; ++k_) {                                    \
            const int e_ = (E0) + k_;                                                         \
            const int id_ = (e_ < 64) ? __builtin_amdgcn_readlane(id0, e_) : __builtin_amdgcn_readlane(id1, e_ - 64); \
            UQ[k_] = *(const u32x4*)(ub + (long)id_ * 1024 + lane * 16);                      \
            VQ[k_] = *(const u32x4*)(vb + (long)id_ * 1024 + lane * 16);                      \
        }                                                                                     \
    } while (0)
#define PE_COMPUTE(UQ, VQ, E0)                                                                \
    do {                                                                                      \
        _Pragma("unroll") for (int k_ = 0; k_ < 4; ++k_) {                                    \
            const int e_ = (E0) + k_;                                                         \
            const float gk_ = __int_as_float((e_ < 64) ? __builtin_amdgcn_readlane(__float_as_int(g0), e_) : __builtin_amdgcn_readlane(__float_as_int(g1), e_ - 64)); \
            const float sk_ = __int_as_float((e_ < 64) ? __builtin_amdgcn_readlane(__float_as_int(s0), e_) : __builtin_amdgcn_readlane(__float_as_int(s1), e_ - 64)); \
            float d_ = 0.f;                                                                   \
            _Pragma("unroll") for (int i_ = 0; i_ < 4; ++i_) {                                \
                f32x2_t lo_ = __builtin_amdgcn_cvt_pk_f32_fp8((int)UQ[k_][i_], false);        \
                f32x2_t hi_ = __builtin_amdgcn_cvt_pk_f32_fp8((int)UQ[k_][i_], true);         \
                d_ += hf[4 * i_] * lo_[0] + hf[4 * i_ + 1] * lo_[1] + hf[4 * i_ + 2] * hi_[0] + hf[4 * i_ + 3] * hi_[1]; \
            }                                                                                 \
            d_ = wsum(d_) * sk_;                                                              \
            const float a_ = gelu_tanh(d_) * gk_;                                             \
            _Pragma("unroll") for (int i_ = 0; i_ < 4; ++i_) {                                \
                f32x2_t lo_ = __builtin_amdgcn_cvt_pk_f32_fp8((int)VQ[k_][i_], false);        \
                f32x2_t hi_ = __builtin_amdgcn_cvt_pk_f32_fp8((int)VQ[k_][i_], true);         \
                acc[4 * i_] += a_ * lo_[0];                                                   \
                acc[4 * i_ + 1] += a_ * lo_[1];                                               \
                acc[4 * i_ + 2] += a_ * hi_[0];                                               \
                acc[4 * i_ + 3] += a_ * hi_[1];                                               \
            }                                                                                 \
        }                                                                                     \
    } while (0)
__device__ __forceinline__ void peer_experts_range(unsigned char* ws, float* xout, int tbeg, int tend) {
    const int lane = tidx() & 63;
    const u16* hbuf = (const u16*)(ws + OFF_H);
    const unsigned char* ub = ws + OFF_UB;
    const unsigned char* vb = ws + OFF_VB;
    const int* eidx = (const int*)(ws + OFF_EIDX);
    const float* gate = (const float*)(ws + OFF_GATE);
    const float* usc = (const float*)(ws + OFF_ESC);
    const float* vsc = usc + NEXP;
    const int tstride = 1;
    int t = tbeg;
    int id0 = 0, id1 = 0;
    float gr0 = 0.f, gr1 = 0.f;
    uint4 h0 = uint4{0u, 0u, 0u, 0u}, h1 = h0;
    if (t < tend) {
        id0 = eidx[(long)t * 128 + lane]; id1 = eidx[(long)t * 128 + 64 + lane];
        gr0 = gate[(long)t * 128 + lane]; gr1 = gate[(long)t * 128 + 64 + lane];
        h0 = *(const uint4*)(hbuf + (long)t * 1024 + lane * 16);
        h1 = *(const uint4*)(hbuf + (long)t * 1024 + lane * 16 + 8);
    }
    while (t < tend) {
        u32x4 ua[4], va[4], ubq[4], vbq[4];
        PE_LOAD(ua, va, 0);
        const float g0 = gr0 * vsc[id0], g1 = gr1 * vsc[id1];
        const float s0 = usc[id0], s1 = usc[id1];
        float* xr = xout + (long)t * 1024 + lane * 16;
        float4 xa[4];
#pragma unroll
        for (int i = 0; i < 4; ++i) xa[i] = *(const float4*)(xr + 4 * i);
        float hf[16];
        hf[0] = bf_lo(h0.x); hf[1] = bf_hi(h0.x); hf[2] = bf_lo(h0.y); hf[3] = bf_hi(h0.y);
        hf[4] = bf_lo(h0.z); hf[5] = bf_hi(h0.z); hf[6] = bf_lo(h0.w); hf[7] = bf_hi(h0.w);
        hf[8] = bf_lo(h1.x); hf[9] = bf_hi(h1.x); hf[10] = bf_lo(h1.y); hf[11] = bf_hi(h1.y);
        hf[12] = bf_lo(h1.z); hf[13] = bf_hi(h1.z); hf[14] = bf_lo(h1.w); hf[15] = bf_hi(h1.w);
        const int tn = t + tstride;
        int idn0 = 0, idn1 = 0;
        float gn0 = 0.f, gn1 = 0.f;
        uint4 hn0 = uint4{0u, 0u, 0u, 0u}, hn1 = hn0;
        if (tn < tend) {
            idn0 = eidx[(long)tn * 128 + lane]; idn1 = eidx[(long)tn * 128 + 64 + lane];
            gn0 = gate[(long)tn * 128 + lane]; gn1 = gate[(long)tn * 128 + 64 + lane];
            hn0 = *(const uint4*)(hbuf + (long)tn * 1024 + lane * 16);
            hn1 = *(const uint4*)(hbuf + (long)tn * 1024 + lane * 16 + 8);
        }
        float acc[16];
#pragma unroll
        for (int i = 0; i < 16; ++i) acc[i] = 0.f;
        for (int e0 = 0; e0 < 128; e0 += 8) {
            PE_LOAD(ubq, vbq, e0 + 4);
            PE_COMPUTE(ua, va, e0);
            if (e0 + 8 < 128) PE_LOAD(ua, va, e0 + 8);
            PE_COMPUTE(ubq, vbq, e0 + 4);
        }
        float ss = 0.f;
        u32 pk[8];
#pragma unroll
        for (int i = 0; i < 4; ++i) {
            float4 a = xa[i];
            a.x += acc[4 * i]; a.y += acc[4 * i + 1]; a.z += acc[4 * i + 2]; a.w += acc[4 * i + 3];
            *(float4*)(xr + 4 * i) = a;
            ss += a.x * a.x + a.y * a.y + a.z * a.z + a.w * a.w;
            pk[2 * i] = pack2(a.x, a.y);
            pk[2 * i + 1] = pack2(a.z, a.w);
        }
        u16* hw = (u16*)(ws + OFF_H) + (long)t * 1024 + lane * 16;
        *(uint4*)hw = uint4{pk[0], pk[1], pk[2], pk[3]};
        *(uint4*)(hw + 8) = uint4{pk[4], pk[5], pk[6], pk[7]};
        ss = wsum(ss);
        if (lane == 0) ((float*)(ws + OFF_RSTDE))[t] = rsqrtf(ss * (1.0f / 1024.0f) + EPS);
        t = tn; id0 = idn0; id1 = idn1; gr0 = gn0; gr1 = gn1; h0 = hn0; h1 = hn1;
    }
}

__device__ __forceinline__ u32 search_bounds(u32 lanemax, int& hb) {
    const u32 U = row_max16u(lanemax), L = row_min16u(lanemax);
    const u32 d = U ^ L;
    hb = d ? 31 - __clz((int)d) : -1;
    return d ? (U & ~((2u << hb) - 1u)) : U;
}
__device__ __forceinline__ void peer_route(unsigned char* ws, float* xout, int layer, unsigned char* smem, unsigned long long& tacc) {
    const int tid = tidx(), lane = tid & 63, w = tid >> 6;
    const int grp = lane >> 4, k = lane & 15;
    const u32 ltk = (1u << k) - 1u;
    const u16* pq = (const u16*)(ws + OFF_PQ);
    const u16* skb = (const u16*)(ws + OFF_W + layer * W_LAYER + WO_SK);
    int* eidx = (int*)(ws + OFF_EIDX);
    float* gate = (float*)(ws + OFF_GATE);
    float* tvc = (float*)(smem + w * 4096);
    int* tic = (int*)(smem + w * 4096 + 2048);
    unsigned* rctr = (unsigned*)(ws + OFF_CTR) + (layer * 8 + 3) * 8;
    for (int unit; (unit = grab_wave(rctr, NTOK / 16)) >= 0;) {
        const int tok0 = unit * 16;
        for (int h = 0; h < 8; ++h) {
            for (int half = 0; half < 2; ++half) {
                unsigned long long tr0 = SEC_T();
                bf16x8 af[4];
#pragma unroll
                for (int ks = 0; ks < 4; ++ks)
                    af[ks] = *(const bf16x8*)(pq + (long)(tok0 + k) * 2048 + h * 256 + half * 128 + ks * 32 + grp * 8);
                float sc[8][4];
                u32 u[8][4];
#pragma unroll
                for (int nt = 0; nt < 8; ++nt) {
                    f32x4 acc = f32x4{0.f, 0.f, 0.f, 0.f};
#pragma unroll
                    for (int ks = 0; ks < 4; ++ks) {
                        bf16x8 bfr = *(const bf16x8*)(skb + (size_t)half * 128 * 128 + (size_t)(nt * 16 + k) * 128 + ks * 32 + grp * 8);
                        acc = __builtin_amdgcn_mfma_f32_16x16x32_bf16(af[ks], bfr, acc, 0, 0, 0);
                    }
#pragma unroll
                    for (int i = 0; i < 4; ++i) { sc[nt][i] = acc[i]; u[nt][i] = sortkey(acc[i]); }
                }
                SEC_ADD(11, tr0);
                tr0 = SEC_T();
                u32 K[4];
                bool dn[4] = {false, false, false, false};
                int hbm = -1;
#pragma unroll
                for (int i = 0; i < 4; ++i) {
                    u32 lm = u[0][i];
#pragma unroll
                    for (int nt = 1; nt < 8; ++nt) lm = max(lm, u[nt][i]);
                    int hb;
                    K[i] = search_bounds(lm, hb);
                    hbm = max(hbm, hb);
                }
                const int bit0 = (int)wmax((float)hbm);
                for (int bit = bit0; bit >= 0; --bit) {
                    int packed = 0;
#pragma unroll
                    for (int i = 0; i < 4; ++i) {
                        const u32 cand = K[i] | (1u << bit);
                        int c = 0;
#pragma unroll
                        for (int nt = 0; nt < 8; ++nt) c += (u[nt][i] >= cand) ? 1 : 0;
                        packed |= c << (8 * i);
                    }
                    packed = row_sum16i(packed);
#pragma unroll
                    for (int i = 0; i < 4; ++i)
                        if (((packed >> (8 * i)) & 0xFF) >= 16) K[i] |= (1u << bit);
                    bool done = true;
#pragma unroll
                    for (int i = 0; i < 4; ++i) {
                        const int ci = (packed >> (8 * i)) & 0xFF;
                        done = done && (ci == 16 || dn[i]);
                        dn[i] = dn[i] || (ci == 16);
                    }
                    if (__all(done)) break;
                }
                SEC_ADD(12, tr0);
                tr0 = SEC_T();
                int need[4];
                {
                    int packed = 0;
#pragma unroll
                    for (int i = 0; i < 4; ++i) {
                        int c = 0;
#pragma unroll
                        for (int nt = 0; nt < 8; ++nt) c += (u[nt][i] > K[i]) ? 1 : 0;
                        packed |= c << (8 * i);
                    }
                    packed = row_sum16i(packed);
#pragma unroll
                    for (int i = 0; i < 4; ++i) need[i] = 16 - ((packed >> (8 * i)) & 0xFF);
                }
#pragma unroll
                for (int i = 0; i < 4; ++i) {
                    int ebase = 0, pbase = 0;
                    const int tok = 4 * grp + i;
#pragma unroll
                    for (int nt = 0; nt < 8; ++nt) {
                        const bool eq = (u[nt][i] == K[i]);
                        const u32 emg = (u32)(__ballot(eq) >> (lane & 48)) & 0xFFFFu;
                        const int erank = ebase + __popc(emg & ltk);
                        const bool take = (u[nt][i] > K[i]) || (eq && erank < need[i]);
                        ebase += __popc(emg);
                        const u32 tmg = (u32)(__ballot(take) >> (lane & 48)) & 0xFFFFu;
                        const int pos = pbase + __popc(tmg & ltk);
                        if (take) {
                            tvc[(half * 16 + tok) * 16 + pos] = sc[nt][i];
                            tic[(half * 16 + tok) * 16 + pos] = nt * 16 + k;
                        }
                        pbase += __popc(tmg);
                    }
                }
                SEC_ADD(13, tr0);
            }
            WAVE_SYNC();
            unsigned long long tr2 = SEC_T();
            for (int pass = 0; pass < 4; ++pass) {
                const int tok = 4 * pass + grp;
                const float v1 = tvc[(0 * 16 + tok) * 16 + k];
                const int i1 = tic[(0 * 16 + tok) * 16 + k];
                float c[16];
                u32 uc[16];
#pragma unroll
                for (int r4 = 0; r4 < 4; ++r4) {
                    float4 v2 = *(const float4*)(tvc + (1 * 16 + tok) * 16 + r4 * 4);
                    c[r4 * 4 + 0] = v1 + v2.x;
                    c[r4 * 4 + 1] = v1 + v2.y;
                    c[r4 * 4 + 2] = v1 + v2.z;
                    c[r4 * 4 + 3] = v1 + v2.w;
                }
                float mxl = c[0];
#pragma unroll
                for (int r = 0; r < 16; ++r) { uc[r] = sortkey(c[r]); mxl = fmaxf(mxl, c[r]); }
                const float mx = row_max16f(mxl);
                int hbc;
                u32 Kc = search_bounds(sortkey(mxl), hbc);
                bool dnc = false;
                const int bitc0 = (int)wmax((float)hbc);
                for (int bit = bitc0; bit >= 0; --bit) {
                    const u32 cand = Kc | (1u << bit);
                    int cn = 0;
#pragma unroll
                    for (int r = 0; r < 16; ++r) cn += (uc[r] >= cand) ? 1 : 0;
                    cn = row_sum16i(cn);
                    if (cn >= 16) Kc = cand;
                    dnc = dnc || (cn == 16);
                    if (__all(dnc)) break;
                }
                int cgl = 0, cel = 0;
#pragma unroll
                for (int r = 0; r < 16; ++r) { cgl += (uc[r] > Kc) ? 1 : 0; cel += (uc[r] == Kc) ? 1 : 0; }
                const int needc = 16 - row_sum16i(cgl);
                const int ebefore = row_xscan16i(cel);
                int tl_ = 0, el_ = 0;
                u32 takem = 0u;
                float ex[16];
                float sl = 0.f;
#pragma unroll
                for (int r = 0; r < 16; ++r) {
                    const bool eq = (uc[r] == Kc);
                    const bool tk = (uc[r] > Kc) || (eq && (ebefore + el_) < needc);
                    el_ += eq ? 1 : 0;
                    tl_ += tk ? 1 : 0;
                    takem |= tk ? (1u << r) : 0u;
                    ex[r] = tk ? __expf(c[r] - mx) : 0.f;
                    sl += ex[r];
                }
                const float inv = 1.0f / row_sum16f(sl);
                int pos = row_xscan16i(tl_);
                const long obase = (long)(tok0 + tok) * 128 + h * 16;
                int i2v[16];
#pragma unroll
                for (int r4 = 0; r4 < 4; ++r4) {
                    const int4 q = *(const int4*)(tic + (1 * 16 + tok) * 16 + r4 * 4);
                    i2v[r4 * 4 + 0] = q.x; i2v[r4 * 4 + 1] = q.y; i2v[r4 * 4 + 2] = q.z; i2v[r4 * 4 + 3] = q.w;
                }
#pragma unroll
                for (int r = 0; r < 16; ++r) {
                    if ((takem >> r) & 1u) {
                        const int eid = i1 * 128 + i2v[r];
                        eidx[obase + pos] = eid;
                        gate[obase + pos] = ex[r] * inv;
                        ++pos;
                    }
                }
            }
            SEC_ADD(14, tr2);
            WAVE_SYNC();
        }
        asm volatile("s_waitcnt vmcnt(0)" ::: "memory");
        peer_experts_range(ws, xout, tok0, tok0 + 16);
    }
}

__device__ __forceinline__ void phase_prep(const Params& P, unsigned char* smem) {
    unsigned char* ws = opq(P.ws);
    const long gtid = (long)bidx() * 256 + tidx();
    const long gthreads = (long)gdim() * 256;
    for (int l = 0; l < 2; ++l) {
        unsigned char* wl = ws + OFF_W + l * W_LAYER;
        float* tile = (float*)smem;
        transpose_cvt<true>(P.w_in + (size_t)l * 1024 * IN_COLS, (u16*)(wl + WO_WIN), 1024, IN_COLS, tile, P.attn_norm + l * 1024);
        for (int c = 0; c < 2; ++c) {
            transpose_cvt(P.cmp_w1 + ((size_t)l * 2 + c) * 2048 * 256, (u16*)(wl + WO_W1) + (size_t)c * 256 * 2048, 2048, 256, tile);
            transpose_cvt(P.cmp_w2 + ((size_t)l * 2 + c) * 256 * 64, (u16*)(wl + WO_W2) + (size_t)c * 64 * 256, 256, 64, tile);
        }
        transpose_cvt(P.w_a + (size_t)l * 512 * 1024, (u16*)(wl + WO_WA), 512, 1024, tile);
        transpose_cvt(P.w_b + (size_t)l * 512 * 1024, (u16*)(wl + WO_WB), 512, 1024, tile);
        transpose_cvt(P.w_out + (size_t)l * 1024 * 1024, (u16*)(wl + WO_WO), 1024, 1024, tile);
        transpose_cvt(P.peer_wq + (size_t)l * 1024 * 2048, (u16*)(wl + WO_WQ), 1024, 2048, tile);
        transpose_cvt(P.ple_w + (size_t)l * 256 * 1024, (u16*)(wl + WO_PW), 256, 1024, tile);
        transpose_cvt(P.ple_gw + (size_t)l * 1024 * 1024, (u16*)(wl + WO_PG), 1024, 1024, tile);
        cvt_f32_bf16(P.peer_sk + (size_t)l * 2 * 128 * 128, (u16*)(wl + WO_SK), 2 * 128 * 128);
    }
    for (int u = bidx(); u < 64; u += gdim()) {
        const int l = u >> 5, c = (u >> 4) & 1, kq = u & 15, col = tidx();
        const float* pos = P.cmp_pos + ((size_t)l * 2 + c) * 2048 + kq * 128;
        const float* w1 = P.cmp_w1 + ((size_t)l * 2 + c) * 2048 * 256 + (size_t)kq * 128 * 256;
        float s = 0.f;
#pragma unroll 16
        for (int k = 0; k < 128; ++k) s += pos[k] * w1[(size_t)k * 256 + col];
        ((float*)(ws + OFF_CHID))[(size_t)u * 256 + col] = s;
    }
    {
        float* ropec = (float*)(ws + OFF_ROPE);
        float* ropes = ropec + (size_t)NTOK * 8;
        for (long i = gtid; i < (long)NTOK * 8; i += gthreads) {
            int t = (int)(i >> 3), k = (int)(i & 7);
            double inv = pow(500000.0, -(double)k / 8.0);
            double ang = (double)P.positions[t] * inv;
            ropec[i] = (float)cos(ang);
            ropes[i] = (float)sin(ang);
        }
    }
    {
        const int lane = tidx() & 63;
        u16* xb = (u16*)(ws + OFF_YAB);
        float* ssa = (float*)(ws + OFF_SSA);
        for (int row = bidx() * 4 + (tidx() >> 6); row < NTOK; row += gdim() * 4) {
            const float* xr = P.x + (long)row * 1024;
            float ss = 0.f;
#pragma unroll
            for (int i = 0; i < 4; ++i) {
                const float4 v = *(const float4*)(xr + i * 256 + lane * 4);
                ss += v.x * v.x + v.y * v.y + v.z * v.z + v.w * v.w;
                *(uint2*)(xb + (long)row * 1024 + i * 256 + lane * 4) = uint2{pack2(v.x, v.y), pack2(v.z, v.w)};
            }
            ss = wsum(ss);
            if (lane < 16) ssa[(long)row * 16 + lane] = lane == 0 ? ss : 0.f;
        }
    }
}

template <int CTRL>
__device__ __forceinline__ float dpp_qf(float x) { return __int_as_float(__builtin_amdgcn_update_dpp(0, __float_as_int(x), CTRL, 0xF, 0xF, false)); }
__device__ __forceinline__ void phase_g1(const Params& P, int layer, unsigned char* smem) {
    unsigned char* ws = opq(P.ws);
    u16* proj = (u16*)(ws + OFF_PROJ);
    const float* ropec = (const float*)(ws + OFF_ROPE);
    const float* ropes = ropec + (size_t)NTOK * 8;
    const float* ng = P.nsa_gain + layer * 256;
    const float* dg = P.dsa_gain + layer * 128;
    if (layer == 0 && bidx() < 4) {
        const int l = bidx() >> 1, c = bidx() & 1, col = tidx();
        const float* part = (const float*)(ws + OFF_CHID) + (size_t)(l * 32 + c * 16) * 256 + col;
        float sacc = 0.f;
#pragma unroll
        for (int kq = 0; kq < 16; ++kq) sacc += part[kq * 256];
        ((float*)(ws + OFF_W + l * W_LAYER + WO_CB))[c * 256 + col] = sacc;
    }
    const float* ssa = (const float*)(ws + OFF_SSA) + (size_t)layer * NTOK * 16;
    gemm_phase_rs<0, true>((const u16*)(ws + OFF_YAB), 1024, (const u16*)(ws + OFF_W + layer * W_LAYER + WO_WIN), 1024, NTOK, IN_COLS, 1024, smem,
                  [=](int row) { return float2{rsqrtf(sum16(ssa + (long)row * 16) * (1.0f / 1024.0f) + EPS), 0.f}; },
                  [=](int row, int col, const float (&v)[8], float2 rs) {
                      const int c64 = col >> 6, cc = (col >> 3) & 7;
                      const float rsx = rs.x;
                      float o[8];
#pragma unroll
                      for (int j = 0; j < 8; ++j) o[j] = v[j] * rsx;
                      const float* gain = nullptr;
                      bool rope = false, sig = false;
                      float scale = 1.0f;
                      if (c64 < 8) { gain = ng; rope = true; scale = 0.125f * 1.4426950408889634f; }
                      else if (c64 < 20) { const int c = (c64 - 8) >> 1; if (c == 2) { gain = ng + 128; rope = true; } else if (c == 4) { gain = ng + 192; rope = true; } }
                      else if (c64 < 28) { gain = dg; rope = true; scale = 0.125f * 1.4426950408889634f; }
                      else if (c64 == 28) { gain = dg + 64; rope = true; }
                      else if (c64 == 29) { }
                      else if (c64 < 38) { rope = true; scale = 0.125f; }
                      else if (c64 == 38) { rope = true; }
                      else if (c64 < 71) { sig = true; }
                      else { sig = (col < C_IW); }
                      if (gain) {
                          float ss = 0.f;
#pragma unroll
                          for (int j = 0; j < 8; ++j) ss += o[j] * o[j];
                          ss += dpp_qf<0xB1>(ss);
                          ss += dpp_qf<0x4E>(ss);
                          ss += __shfl_xor(ss, 4);
                          const float rstd = rsqrtf(ss * (1.0f / 64.0f) + EPS);
                          const float4 g0 = *(const float4*)(gain + cc * 8), g1 = *(const float4*)(gain + cc * 8 + 4);
                          o[0] *= rstd * g0.x; o[1] *= rstd * g0.y; o[2] *= rstd * g0.z; o[3] *= rstd * g0.w;
                          o[4] *= rstd * g1.x; o[5] *= rstd * g1.y; o[6] *= rstd * g1.z; o[7] *= rstd * g1.w;
                      }
                      if (rope) {
                          float pr[8];
#pragma unroll
                          for (int j = 0; j < 8; ++j) pr[j] = dpp_qf<0xB1>(o[j]);
                          if (cc < 2) {
                              const float4 c0 = *(const float4*)(ropec + (long)row * 8), c1 = *(const float4*)(ropec + (long)row * 8 + 4);
                              const float4 s0 = *(const float4*)(ropes + (long)row * 8), s1 = *(const float4*)(ropes + (long)row * 8 + 4);
                              const float cs[8] = {c0.x, c0.y, c0.z, c0.w, c1.x, c1.y, c1.z, c1.w};
                              const float sn[8] = {s0.x, s0.y, s0.z, s0.w, s1.x, s1.y, s1.z, s1.w};
#pragma unroll
                              for (int j = 0; j < 8; ++j) o[j] = (cc == 0) ? (o[j] * cs[j] - pr[j] * sn[j]) : (o[j] * cs[j] + pr[j] * sn[j]);
                          }
                      }
                      if (sig) {
#pragma unroll
                          for (int j = 0; j < 8; ++j) o[j] = sigmoidf(o[j]);
                      }
#pragma unroll
                      for (int j = 0; j < 8; ++j) o[j] *= scale;
                      st_bf8(proj + (long)row * IN_COLS + col, o);
                  });
}

__device__ __forceinline__ void phase_c1(const Params& P, int layer, unsigned char* smem) {
    unsigned char* ws = opq(P.ws);
    unsigned char* wl = ws + OFF_W + layer * W_LAYER;
    const u16* proj = (const u16*)(ws + OFF_PROJ);
    u16* chid = (u16*)(ws + OFF_CHID);
    const float* cbias = (const float*)(wl + WO_CB);
    for (int c = 0; c < 2; ++c) {
        u16* ch = chid + (size_t)c * CROWS * 256;
        const float* cb = cbias + c * 256;
        gemm_phase<1>(proj + C_NKV + c * 128, 0, (const u16*)(wl + WO_W1) + (size_t)c * 256 * 2048, 2048, CROWS, 256, 2048, smem,
                      [=](int row, int col, const float (&v)[8]) {
                          float o[8];
#pragma unroll
                          for (int j = 0; j < 8; ++j) o[j] = gelu_tanh(v[j] + cb[col + j]);
                          st_bf8(ch + (long)row * 256 + col, o);
                      });
    }
}

__device__ __forceinline__ void phase_c2(const Params& P, int layer, unsigned char* smem) {
    unsigned char* ws = opq(P.ws);
    unsigned char* wl = ws + OFF_W + layer * W_LAYER;
    const u16* chid = (const u16*)(ws + OFF_CHID);
    u16* kcb = (u16*)(ws + OFF_KCB);
    u16* vcb = (u16*)(ws + OFF_VCB);
    const float* ropec = (const float*)(ws + OFF_ROPE);
    const float* ropes = ropec + (size_t)NTOK * 8;
    const float* gain = P.nsa_gain + layer * 256 + 64;
    for (int c = 0; c < 2; ++c) {
        u16* dst = c == 0 ? kcb : vcb;
        gemm_phase<0>(chid + (size_t)c * CROWS * 256, 256, (const u16*)(wl + WO_W2) + (size_t)c * 64 * 256, 256, CROWS, 64, 256, smem,
                      [=](int row, int col, const float (&v)[8]) {
                          const int b = row / (NCMP * 2);
                          const int rem = row - b * (NCMP * 2);
                          const int n = rem >> 1, g = rem & 1;
                          const int cc = col >> 3;
                          float o[8];
#pragma unroll
                          for (int j = 0; j < 8; ++j) o[j] = v[j];
                          if (c == 0) {
                              float ss = 0.f;
#pragma unroll
                              for (int j = 0; j < 8; ++j) ss += o[j] * o[j];
                              ss += dpp_qf<0xB1>(ss);
                              ss += dpp_qf<0x4E>(ss);
                              ss += __shfl_xor(ss, 4);
                              const float rstd = rsqrtf(ss * (1.0f / 64.0f) + EPS);
#pragma unroll
                              for (int j = 0; j < 8; ++j) o[j] *= rstd * gain[cc * 8 + j];
                              float pr[8];
#pragma unroll
                              for (int j = 0; j < 8; ++j) pr[j] = dpp_qf<0xB1>(o[j]);
                              if (cc < 2) {
                                  const long tt = (long)b * SEQ + 31 + 16 * n;
#pragma unroll
                                  for (int j = 0; j < 8; ++j) {
                                      const float cs = ropec[tt * 8 + j], sn = ropes[tt * 8 + j];
                                      o[j] = (cc == 0) ? (o[j] * cs - pr[j] * sn) : (o[j] * cs + pr[j] * sn);
                                  }
                              }
                          }
                          st_bf8(dst + ((size_t)(b * 2 + g) * 256 + n) * 64 + col, o);
                      });
    }
}

__device__ __forceinline__ int balance4(int x, int seg) {
    const int k = x / seg, r = x - k * seg;
    return k == 0 ? r : (k == 1 ? 4 * seg - 1 - r : (k == 2 ? seg + r : 3 * seg - 1 - r));
}
__device__ __forceinline__ void phase_att_a(const Params& P, int layer, unsigned char* smem, unsigned long long& tacc) {
    unsigned char* ws = opq(P.ws);
    unsigned* ctr = (unsigned*)(ws + OFF_CTR) + (layer * 8 + 0) * 8;
    const int label = bidx() & 7;
    for (int s8 = 0; s8 < 8; ++s8) {
        const int q = (label + s8) & 7;
        int idx;
        while ((idx = grab_block(ctr + q, 1024, smem)) >= 0) dsa_select_unit(ws, q * 1024 + (1023 - idx), smem, tacc);
    }
}
__device__ __forceinline__ void phase_att_b(const Params& P, int layer, unsigned char* smem) {
    const int label = bidx() & 7;
    {
        unsigned char* ws = opq(P.ws);
        unsigned* ctr = (unsigned*)(ws + OFF_CTR) + (layer * 8 + 1) * 8;
        for (int s8 = 0; s8 < 8; ++s8) {
            const int q = (label + s8) & 7;
            int idx;
            while ((idx = grab_block(ctr + q, 256, smem)) >= 0) dsa_attn_unit(ws, q, 255 - idx, smem);
        }
    }
    {
        unsigned char* ws = opq(P.ws);
        unsigned* ctr = (unsigned*)(ws + OFF_CTR) + (layer * 8 + 2) * 8;
        for (int s8 = 0; s8 < 8; ++s8) {
            const int q = (label + s8) & 7;
            int idx;
            while ((idx = grab_block(ctr + q, 256, smem)) >= 0) {
                const int ub = q + 8 * (idx & 1);
                nsa_unit(ws, ub >> 1, ub & 1, 127 - (idx >> 1), smem);
            }
        }
    }
}

__device__ __forceinline__ void phase_merge(const Params& P, int layer, unsigned char* smem) {
    unsigned char* ws = opq(P.ws);
    unsigned char* wl = ws + OFF_W + layer * W_LAYER;
    const u16* proj = (const u16*)(ws + OFF_PROJ);
    u16* hbuf = (u16*)(ws + OFF_H);
    const u16* ya = (const u16*)(ws + OFF_YAB);
    const u16* yb = ya + (size_t)NTOK * 512;
    gemm_phase<0>(ya, 512, (const u16*)(wl + WO_WA), 512, NTOK, 1024, 512, smem, [=](int row, int col, const float (&v)[8]) {
        float ga[8], o[8];
        ld_bf8(proj + (long)row * IN_COLS + C_MG + col, ga);
#pragma unroll
        for (int j = 0; j < 8; ++j) o[j] = ga[j] * v[j];
        st_bf8(hbuf + (long)row * 1024 + col, o);
    });
    gemm_phase<0>(yb, 512, (const u16*)(wl + WO_WB), 512, NTOK, 1024, 512, smem, [=](int row, int col, const float (&v)[8]) {
        float gb[8], o[8];
        ld_bf8(proj + (long)row * IN_COLS + C_MG + 1024 + col, gb);
        ld_bf8(hbuf + (long)row * 1024 + col, o);
#pragma unroll
        for (int j = 0; j < 8; ++j) o[j] += gb[j] * v[j];
        st_bf8(hbuf + (long)row * 1024 + col, o);
    });
}

__device__ __forceinline__ void phase_outproj(const Params& P, int layer, unsigned char* smem) {
    unsigned char* ws = opq(P.ws);
    unsigned char* wl = ws + OFF_W + layer * W_LAYER;
    float* out = opq(P.out);
    const float* xin = (layer == 0) ? P.x : (const float*)out;
    const bool gemm_first = bidx() < (gdim() >> 1);
    for (int step = 0; step < 2; ++step) {
        if ((step == 0) == gemm_first) {
            gemm_phase<0>((const u16*)(ws + OFF_H), 1024, (const u16*)(wl + WO_WO), 1024, NTOK, 1024, 1024, smem, [=](int row, int col, const float (&v)[8]) {
                const long o = (long)row * 1024 + col;
                const float4 x0 = *(const float4*)(xin + o), x1 = *(const float4*)(xin + o + 4);
                *(float4*)(out + o) = float4{x0.x + v[0], x0.y + v[1], x0.z + v[2], x0.w + v[3]};
                *(float4*)(out + o + 4) = float4{x1.x + v[4], x1.y + v[5], x1.z + v[6], x1.w + v[7]};
            });
        } else {
            cvt_f32_bf16(P.p + (size_t)layer * NTOK * 256, (u16*)(ws + OFF_PBF), (long)NTOK * 256);
            cvt_rows_fp8(P.peer_u + (size_t)layer * NEXP * 1024, ws + OFF_UB, (float*)(ws + OFF_ESC), NEXP);
            cvt_rows_fp8(P.peer_v + (size_t)layer * NEXP * 1024, ws + OFF_VB, (float*)(ws + OFF_ESC) + NEXP, NEXP);
        }
    }
}

__device__ __forceinline__ void phase_pq(const Params& P, int layer, unsigned char* smem) {
    unsigned char* ws = opq(P.ws);
    unsigned char* wl = ws + OFF_W + layer * W_LAYER;
    u16* pq = (u16*)(ws + OFF_PQ);
    u16* eb = (u16*)(ws + OFF_YAB);
    gemm_phase<0>((const u16*)(ws + OFF_H), 1024, (const u16*)(wl + WO_WQ), 1024, NTOK, 2048, 1024, smem,
                  [=](int row, int col, const float (&v)[8]) { st_bf8(pq + (long)row * 2048 + col, v); });
    float* sse = (float*)(ws + OFF_SSE) + (size_t)layer * NTOK * 16;
    gemm_phase<0>((const u16*)(ws + OFF_PBF), 256, (const u16*)(wl + WO_PW), 256, NTOK, 1024, 256, smem,
                  [=](int row, int col, const float (&v)[8]) {
                      st_bf8(eb + (long)row * 1024 + col, v);
                      float ss = 0.f;
#pragma unroll
                      for (int j = 0; j < 8; ++j) ss += v[j] * v[j];
                      ss += dpp_qf<0xB1>(ss);
                      ss += dpp_qf<0x4E>(ss);
                      ss += __shfl_xor(ss, 4);
                      if ((col & 63) == 0) sse[(long)row * 16 + (col >> 6)] = ss;
                  });
}

__device__ __forceinline__ void phase_final(const Params& P, int layer, unsigned char* smem) {
    unsigned char* ws = opq(P.ws);
    unsigned char* wl = ws + OFF_W + layer * W_LAYER;
    float* out = opq(P.out);
    u16* eb = (u16*)(ws + OFF_YAB);
    const float* rstd2 = (const float*)(ws + OFF_RSTDE);
    const float* sse = (const float*)(ws + OFF_SSE) + (size_t)layer * NTOK * 16;
    float* ssn = (float*)(ws + OFF_SSA) + (size_t)NTOK * 16;
    const float* pn = P.ple_norm + layer * 1024;
    const bool more = layer == 0;
    gemm_phase_rs<0, true>((const u16*)(ws + OFF_H), 1024, (const u16*)(wl + WO_PG), 1024, NTOK, 1024, 1024, smem,
        [=](int row) { return float2{rstd2[row], rsqrtf(sum16(sse + (long)row * 16) * (1.0f / 1024.0f) + EPS)}; },
        [=](int row, int col, const float (&v)[8], float2 rs) {
        const long o = (long)row * 1024 + col;
        float e[8];
        ld_bf8(eb + o, e);
        const float rx = rs.x;
        const float re = rs.y;
        const float4 x0 = *(const float4*)(out + o), x1 = *(const float4*)(out + o + 4);
        const float4 p0 = *(const float4*)(pn + col), p1 = *(const float4*)(pn + col + 4);
        const float xs[8] = {x0.x, x0.y, x0.z, x0.w, x1.x, x1.y, x1.z, x1.w};
        const float ps[8] = {p0.x, p0.y, p0.z, p0.w, p1.x, p1.y, p1.z, p1.w};
        float y[8];
        float ss = 0.f;
#pragma unroll
        for (int j = 0; j < 8; ++j) {
            y[j] = xs[j] + sigmoidf(v[j] * rx) * (e[j] * re * ps[j]);
            ss += y[j] * y[j];
        }
        *(float4*)(out + o) = float4{y[0], y[1], y[2], y[3]};
        *(float4*)(out + o + 4) = float4{y[4], y[5], y[6], y[7]};
        if (more) {
            st_bf8(eb + o, y);
            ss += dpp_qf<0xB1>(ss);
            ss += dpp_qf<0x4E>(ss);
            ss += __shfl_xor(ss, 4);
            if ((col & 63) == 0) ssn[(long)row * 16 + (col >> 6)] = ss;
        }
    });
}


#define XB_TMO      128
#define XB_XCNT(j)  (256  + 64 * (j))
#define XB_XSUB(j)  (1280 + 64 * (j))
#define XB_XGEN(j)  (2304 + 64 * (j))
#define XB_TOP      3328
#define XB_TOPGEN   3392
#define XCD_BAR_WORDS 3456
#define XB_SPIN_CAP (1u << 22)
#define LAS __attribute__((address_space(3)))
__device__ __forceinline__ unsigned xb_ld(unsigned* p) { return __hip_atomic_load(p, __ATOMIC_RELAXED, __HIP_MEMORY_SCOPE_AGENT); }
__device__ __forceinline__ unsigned xb_add(unsigned* p, unsigned v) { return __hip_atomic_fetch_add(p, v, __ATOMIC_RELAXED, __HIP_MEMORY_SCOPE_AGENT); }
__device__ __forceinline__ unsigned xb_xcc_id() { return (unsigned)__builtin_amdgcn_s_getreg((3 << 11) | 20) & 0xFu; }
#define XB_SPIN(cond, bar) do { unsigned _sp = 0; while (cond) { __builtin_amdgcn_s_sleep(1); \
    if ((++_sp & 255u) == 0u) { if (xb_ld(&(bar)[XB_TMO])) break; if (_sp > XB_SPIN_CAP) { atomicAdd(&(bar)[XB_TMO], 1u); break; } } } } while (0)
struct XcdBarrier {
    unsigned* bar; unsigned x;
    volatile LAS unsigned* st;
};
__device__ __forceinline__ XcdBarrier xcd_barrier_post(unsigned* bar, volatile LAS unsigned* st) {
    XcdBarrier b; b.bar = bar; b.x = xb_xcc_id(); b.st = st;
    if (threadIdx.x == 0) (void)xb_add(&bar[XB_XCNT(b.x)], 1u);
    return b;
}
__device__ __forceinline__ void xcd_barrier_complete(unsigned* bar, unsigned x, unsigned& nloc, unsigned& nx) {
    const unsigned G = gridDim.x * gridDim.y * gridDim.z;
    unsigned sum, cnt, mine, sp = 0u;
    for (;;) {
        sum = 0u; cnt = 0u; mine = 0u;
#pragma unroll
        for (unsigned j = 0; j < 16; ++j) { const unsigned c = xb_ld(&bar[XB_XCNT(j)]); sum += c; cnt += (c > 0u) ? 1u : 0u; mine = (j == x) ? c : mine; }
        if (sum == G) break;
        __builtin_amdgcn_s_sleep(1);
        if ((++sp & 255u) == 0u) { if (xb_ld(&bar[XB_TMO])) break; if (sp > XB_SPIN_CAP) { atomicAdd(&bar[XB_TMO], 1u); break; } }
    }
    nloc = mine > 0u ? mine : 1u; nx = cnt > 0u ? cnt : 1u;
}
__device__ __forceinline__ void xcd_barrier(const XcdBarrier& b) {
    asm volatile("s_waitcnt vmcnt(0)" ::: "memory");
    __syncthreads();
    if (threadIdx.x == 0) {
        unsigned* bar = b.bar;
        __builtin_amdgcn_s_waitcnt(0);
        unsigned nloc = b.st[0], nx = b.st[1];
        if (nloc == 0u) { xcd_barrier_complete(bar, b.x, nloc, nx); b.st[0] = nloc; b.st[1] = nx; }
        const unsigned old = xb_add(&bar[XB_XSUB(b.x)], 1u);
        const unsigned gen = old / nloc;
        if (old + 1u == (gen + 1u) * nloc) {
            __builtin_amdgcn_fence(__ATOMIC_RELEASE, "agent");
            asm volatile("s_waitcnt vmcnt(0)" ::: "memory");
            const unsigned og = xb_add(&bar[XB_TOP], 1u);
            const unsigned tg = og / nx;
            if (og + 1u == (tg + 1u) * nx) xb_add(&bar[XB_TOPGEN], 1u);
            else XB_SPIN(xb_ld(&bar[XB_TOPGEN]) == tg, bar);
            __builtin_amdgcn_fence(__ATOMIC_ACQUIRE, "agent");
            xb_add(&bar[XB_XGEN(b.x)], 1u);
            asm volatile("s_waitcnt vmcnt(0)" ::: "memory");
        } else {
            XB_SPIN(xb_ld(&bar[XB_XGEN(b.x)]) == gen, bar);
            __builtin_amdgcn_fence(__ATOMIC_ACQUIRE, "agent");
            asm volatile("s_waitcnt vmcnt(0)" ::: "memory");
        }
    }
    __syncthreads();
}

#ifndef PROBE_MASK
#define PROBE_MASK 0ull
#endif
#ifndef PROBE_MULT
#define PROBE_MULT 4
#endif
#define GSYNC(id)                                                                          \
    do {                                                                                   \
        xcd_barrier(xb);                                                                   \
        if (PROBE_MASK != 0ull) {                                                          \
            unsigned long long now_ = __builtin_amdgcn_s_memrealtime();                    \
            if ((PROBE_MASK >> (id)) & 1ull) tsel += now_ - tprev;                         \
            tprev = now_;                                                                  \
        }                                                                                  \
    } while (0)

__global__ void __launch_bounds__(256, 2)
fwd_kernel(const float* a_x, const float* a_p, const int* a_pos, const float* a_an, const float* a_win, const float* a_ng, const float* a_cp,
           const float* a_cw1, const float* a_cw2, const float* a_dg, const float* a_wa, const float* a_wb, const float* a_wo, const float* a_fn,
           const float* a_wq, const float* a_sk, const float* a_pu, const float* a_pv, const float* a_pw, const float* a_pgw, const float* a_pn,
           float* a_out, unsigned char* a_ws) {
    Params P;
    P.x = a_x; P.p = a_p; P.positions = a_pos; P.attn_norm = a_an; P.w_in = a_win; P.nsa_gain = a_ng; P.cmp_pos = a_cp; P.cmp_w1 = a_cw1;
    P.cmp_w2 = a_cw2; P.dsa_gain = a_dg; P.w_a = a_wa; P.w_b = a_wb; P.w_out = a_wo; P.ffn_norm = a_fn; P.peer_wq = a_wq; P.peer_sk = a_sk;
    P.peer_u = a_pu; P.peer_v = a_pv; P.ple_w = a_pw; P.ple_gw = a_pgw; P.ple_norm = a_pn; P.out = a_out; P.ws = a_ws;
    cg::grid_group grid = cg::this_grid();
    extern __shared__ __attribute__((aligned(16))) unsigned char smem[];
    unsigned long long tprev = 0, tsel = 0;
    if (PROBE_MASK != 0ull) tprev = __builtin_amdgcn_s_memrealtime();
    volatile LAS unsigned* xst = (volatile LAS unsigned*)(smem + LDS_BYTES);
    if (threadIdx.x == 0) { xst[0] = 0u; xst[1] = 0u; xst[2] = 0u; xst[3] = 0u; }
    __syncthreads();
    XcdBarrier xb = xcd_barrier_post((unsigned*)(P.ws + OFF_BAR), xst);
    phase_prep(P, smem);
    grid.sync();
    if (PROBE_MASK != 0ull) {
        unsigned long long now_ = __builtin_amdgcn_s_memrealtime();
        if (PROBE_MASK & 1ull) tsel += now_ - tprev;
        tprev = now_;
    }
    for (int layer = 0; layer < 2; ++layer) {
        const int pb = 1 + 16 * layer;
        phase_g1(P, layer, smem);
        GSYNC(pb + 0);
        phase_c1(P, layer, smem);
        phase_att_a(P, layer, smem, tsel);
        GSYNC(pb + 15);
        phase_c2(P, layer, smem);
        GSYNC(pb + 3);
        phase_att_b(P, layer, smem);
        GSYNC(pb + 5);
        phase_merge(P, layer, smem);
        GSYNC(pb + 6);
        phase_outproj(P, layer, smem);
        GSYNC(pb + 7);
        {
            unsigned char* ws = opq(P.ws);
            rms_rows(opq(P.out), P.ffn_norm + layer * 1024, (u16*)(ws + OFF_H), nullptr, nullptr);
        }
        GSYNC(pb + 8);
        phase_pq(P, layer, smem);
        GSYNC(pb + 9);
        peer_route(opq(P.ws), opq(P.out), layer, smem, tsel);
        GSYNC(pb + 11);
        phase_final(P, layer, smem);
        GSYNC(pb + 13);
    }
#ifndef PROBE_BLOCK
#define PROBE_BLOCK 0
#endif
    if (PROBE_MASK != 0ull || PROBE_SEC != 0) {
        if (blockIdx.x == PROBE_BLOCK && threadIdx.x == 0) {
            unsigned long long t0 = __builtin_amdgcn_s_memrealtime();
            while (__builtin_amdgcn_s_memrealtime() - t0 < (unsigned long long)PROBE_MULT * tsel) __builtin_amdgcn_s_sleep(32);
        }
    }
}

extern "C" void kernel_launch(void* const* d_in, const int* in_sizes, int n_in, void* d_out, int out_size, void* d_ws, size_t ws_size,
                              hipStream_t stream) {
    static int grid_blocks = 0;
    if (!grid_blocks) {
        int dev = 0, cus = 0, per_cu = 0;
        (void)hipGetDevice(&dev);
        (void)hipDeviceGetAttribute(&cus, hipDeviceAttributeMultiprocessorCount, dev);
        (void)hipFuncSetAttribute((const void*)fwd_kernel, hipFuncAttributeMaxDynamicSharedMemorySize, LDS_BYTES + 16);
        (void)hipOccupancyMaxActiveBlocksPerMultiprocessor(&per_cu, fwd_kernel, 256, LDS_BYTES + 16);
        if (per_cu > 2) per_cu = 2;
        if (per_cu < 1) per_cu = 1;
        grid_blocks = cus * per_cu;
        if (ws_size < WS_END) fprintf(stderr, "kernel_launch: workspace too small: %zu < %zu\n", ws_size, (size_t)WS_END);
    }
    Params P{};
    P.x = (const float*)d_in[0];
    P.p = (const float*)d_in[1];
    P.positions = (const int*)d_in[2];
    P.attn_norm = (const float*)d_in[3];
    P.w_in = (const float*)d_in[4];
    P.nsa_gain = (const float*)d_in[5];
    P.cmp_pos = (const float*)d_in[6];
    P.cmp_w1 = (const float*)d_in[7];
    P.cmp_w2 = (const float*)d_in[8];
    P.dsa_gain = (const float*)d_in[9];
    P.w_a = (const float*)d_in[10];
    P.w_b = (const float*)d_in[11];
    P.w_out = (const float*)d_in[12];
    P.ffn_norm = (const float*)d_in[13];
    P.peer_wq = (const float*)d_in[14];
    P.peer_sk = (const float*)d_in[15];
    P.peer_u = (const float*)d_in[16];
    P.peer_v = (const float*)d_in[17];
    P.ple_w = (const float*)d_in[18];
    P.ple_gw = (const float*)d_in[19];
    P.ple_norm = (const float*)d_in[20];
    P.out = (float*)d_out;
    P.ws = (unsigned char*)d_ws;
    void* args[] = {(void*)&P.x, (void*)&P.p, (void*)&P.positions, (void*)&P.attn_norm, (void*)&P.w_in, (void*)&P.nsa_gain, (void*)&P.cmp_pos,
                    (void*)&P.cmp_w1, (void*)&P.cmp_w2, (void*)&P.dsa_gain, (void*)&P.w_a, (void*)&P.w_b, (void*)&P.w_out, (void*)&P.ffn_norm,
                    (void*)&P.peer_wq, (void*)&P.peer_sk, (void*)&P.peer_u, (void*)&P.peer_v, (void*)&P.ple_w, (void*)&P.ple_gw,
                    (void*)&P.ple_norm, (void*)&P.out, (void*)&P.ws};
    (void)hipMemsetAsync((unsigned char*)d_ws + OFF_BAR, 0, 3456 * 4 + N_CTR * 4, stream);
    hipError_t e = hipLaunchCooperativeKernel((void*)fwd_kernel, dim3(grid_blocks), dim3(256), args, LDS_BYTES + 16, stream);
    if (e != hipSuccess) fprintf(stderr, "cooperative launch failed: %s (grid %d)\n", hipGetErrorString(e), grid_blocks);
}
```

```cpp
#include <hip/hip_runtime.h>
#include <hip/hip_cooperative_groups.h>
#include <cstdio>
#include <cstdint>
namespace cg = cooperative_groups;
#ifndef PROBE_SEC
#define PROBE_SEC 0
#endif
#define SEC_T() (PROBE_SEC ? __builtin_amdgcn_s_memrealtime() : 0ull)
#define SEC_ADD(k, t0) do { if (PROBE_SEC == (k)) { unsigned long long n_ = SEC_T(); tacc += n_ - (t0); } } while (0)

typedef unsigned short u16;
typedef unsigned int u32;
typedef unsigned long long u64;
using bf16x8 = __attribute__((ext_vector_type(8))) short;
using f32x4 = __attribute__((ext_vector_type(4))) float;
using f32x16 = __attribute__((ext_vector_type(16))) float;
typedef __bf16 bf16x2_t __attribute__((ext_vector_type(2)));

constexpr int D_MODEL = 1024, BATCH = 8, SEQ = 4096, NTOK = BATCH * SEQ;
constexpr int IN_COLS = 4576;
constexpr int C_NQ = 0, C_NKV = 512, C_DQ = 1280, C_DKV = 1792, C_IQ = 1920, C_IK = 2432, C_MG = 2496, C_NG = 4544, C_IW = 4568;
__host__ __device__ constexpr int perm_col(int n) {
    return n < 1280 ? n : n < 1304 ? 4544 + (n - 1280) : n < 1816 ? 1280 + (n - 1304) : n < 1944 ? 1792 + (n - 1816)
         : n < 2456 ? 1920 + (n - 1944) : n < 2520 ? 2432 + (n - 2456) : n < 2528 ? 4568 + (n - 2520) : 2496 + (n - 2528);
}
constexpr int NCMP = 255;
constexpr int CROWS = BATCH * NCMP * 2;
constexpr int NEXP = 16384;
constexpr float EPS = 1e-6f;

constexpr size_t AL(size_t x) { return (x + 255) & ~(size_t)255; }
constexpr size_t WO_WIN = 0;
constexpr size_t WO_W1 = WO_WIN + AL((size_t)IN_COLS * 1024 * 2);
constexpr size_t WO_W2 = WO_W1 + AL((size_t)2 * 256 * 2048 * 2);
constexpr size_t WO_WA = WO_W2 + AL((size_t)2 * 64 * 256 * 2);
constexpr size_t WO_WB = WO_WA + AL((size_t)1024 * 512 * 2);
constexpr size_t WO_WO = WO_WB + AL((size_t)1024 * 512 * 2);
constexpr size_t WO_WQ = WO_WO + AL((size_t)1024 * 1024 * 2);
constexpr size_t WO_PW = WO_WQ + AL((size_t)2048 * 1024 * 2);
constexpr size_t WO_PG = WO_PW + AL((size_t)1024 * 256 * 2);
constexpr size_t WO_SK = WO_PG + AL((size_t)1024 * 1024 * 2);
constexpr size_t WO_CB = WO_SK + AL((size_t)2 * 128 * 128 * 2);
constexpr size_t W_LAYER = WO_CB + AL((size_t)2 * 256 * 4);

constexpr size_t OFF_W = 0;
constexpr size_t OFF_ROPE = OFF_W + 2 * W_LAYER;
constexpr size_t OFF_H = OFF_ROPE + AL((size_t)NTOK * 16 * 4);
constexpr size_t OFF_PROJ = OFF_H + AL((size_t)NTOK * 1024 * 2);
constexpr size_t OFF_YAB = OFF_PROJ + AL((size_t)NTOK * IN_COLS * 2);
constexpr size_t OFF_CHID = OFF_YAB + AL((size_t)NTOK * 1024 * 2);
constexpr size_t OFF_CBUF = OFF_CHID + AL((size_t)2 * CROWS * 256 * 2);
constexpr size_t OFF_KCB = OFF_CBUF + AL((size_t)2 * CROWS * 64 * 4);
constexpr size_t OFF_VCB = OFF_KCB + AL((size_t)BATCH * 2 * 256 * 64 * 2);
constexpr size_t OFF_RSTDE = OFF_VCB + AL((size_t)BATCH * 2 * 256 * 64 * 2);
constexpr size_t OFF_SSA = OFF_RSTDE + AL((size_t)NTOK * 4);
constexpr size_t OFF_SSE = OFF_SSA + AL((size_t)2 * NTOK * 16 * 4);
constexpr size_t OFF_BITS = OFF_SSE + AL((size_t)2 * NTOK * 16 * 4);
__device__ __forceinline__ float sum16(const float* p) {
    const float4 a = *(const float4*)p, b = *(const float4*)(p + 4), c = *(const float4*)(p + 8), d = *(const float4*)(p + 12);
    return ((a.x + a.y) + (a.z + a.w)) + ((b.x + b.y) + (b.z + b.w)) + (((c.x + c.y) + (c.z + c.w)) + ((d.x + d.y) + (d.z + d.w)));
}
constexpr size_t OFF_BAR = OFF_BITS + AL((size_t)NTOK * 64 * 8);
constexpr size_t OFF_CTR = OFF_BAR + 3456 * 4;
constexpr int N_CTR = 512;
constexpr size_t WS_END = OFF_CTR + AL(N_CTR * 4);
constexpr size_t OFF_PQ = OFF_PROJ;
constexpr size_t OFF_UB = OFF_PQ + (size_t)NTOK * 2048 * 2;
constexpr size_t OFF_VB = OFF_UB + (size_t)NEXP * 1024 * 2;
constexpr size_t OFF_EIDX = OFF_VB + (size_t)NEXP * 1024 * 2;
constexpr size_t OFF_GATE = OFF_EIDX + (size_t)NTOK * 128 * 4;
constexpr size_t OFF_ESC = OFF_GATE + (size_t)NTOK * 128 * 4;
constexpr size_t OFF_PBF = OFF_ESC + (size_t)2 * NEXP * 4;
constexpr size_t OFF_ESU = OFF_PBF + (size_t)NTOK * 256 * 2;
static_assert(OFF_ESU + (size_t)NTOK * 128 * 4 <= OFF_YAB, "alias overflow");

constexpr int LDS_BYTES = 65536 + 2048;

struct Params {
    const float* x; const float* p; const int* positions;
    const float* attn_norm; const float* w_in; const float* nsa_gain; const float* cmp_pos; const float* cmp_w1; const float* cmp_w2;
    const float* dsa_gain; const float* w_a; const float* w_b; const float* w_out; const float* ffn_norm; const float* peer_wq;
    const float* peer_sk; const float* peer_u; const float* peer_v; const float* ple_w; const float* ple_gw; const float* ple_norm;
    float* out; unsigned char* ws;
};

__device__ __forceinline__ u16 f2bf(float f) {
    u32 u = __float_as_uint(f);
    u32 r = u + 0x7FFFu + ((u >> 16) & 1u);
    return (u16)(r >> 16);
}
__device__ __forceinline__ float bf2f(u16 h) { return __uint_as_float(((u32)h) << 16); }
__device__ __forceinline__ float bf_lo(u32 w) { return __uint_as_float(w << 16); }
__device__ __forceinline__ float bf_hi(u32 w) { return __uint_as_float(w & 0xFFFF0000u); }
__device__ __forceinline__ u32 pack2(float a, float b) {
    u32 r;
    asm("v_cvt_pk_bf16_f32 %0, %1, %2" : "=v"(r) : "v"(a), "v"(b));
    return r;
}
__device__ __forceinline__ float dot2(u32 a, u32 b, float c) {
    return __builtin_amdgcn_fdot2_f32_bf16(__builtin_bit_cast(bf16x2_t, a), __builtin_bit_cast(bf16x2_t, b), c, false);
}
template <int CTRL>
__device__ __forceinline__ int dppi(int x) { return __builtin_amdgcn_update_dpp(x, x, CTRL, 0xF, 0xF, false); }
template <int CTRL>
__device__ __forceinline__ float dppf(float x) { return __int_as_float(dppi<CTRL>(__float_as_int(x))); }
__device__ __forceinline__ int row_sum16i(int x) {
    x += dppi<0x128>(x);
    x += dppi<0x124>(x);
    x += dppi<0x122>(x);
    x += dppi<0x121>(x);
    return x;
}
template <int CTRL>
__device__ __forceinline__ int dppi0(int x) { return __builtin_amdgcn_update_dpp(0, x, CTRL, 0xF, 0xF, true); }
__device__ __forceinline__ int row_xscan16i(int x) {
    int s = x;
    s += dppi0<0x111>(s);
    s += dppi0<0x112>(s);
    s += dppi0<0x114>(s);
    s += dppi0<0x118>(s);
    return s - x;
}
__device__ __forceinline__ float row_sum16f(float x) {
    x += dppf<0x128>(x);
    x += dppf<0x124>(x);
    x += dppf<0x122>(x);
    x += dppf<0x121>(x);
    return x;
}
__device__ __forceinline__ float row_max16f(float x) {
    x = fmaxf(x, dppf<0x128>(x));
    x = fmaxf(x, dppf<0x124>(x));
    x = fmaxf(x, dppf<0x122>(x));
    x = fmaxf(x, dppf<0x121>(x));
    return x;
}

__device__ __forceinline__ u32 row_max16u(u32 x) {
    x = max(x, (u32)dppi<0x128>((int)x));
    x = max(x, (u32)dppi<0x124>((int)x));
    x = max(x, (u32)dppi<0x122>((int)x));
    x = max(x, (u32)dppi<0x121>((int)x));
    return x;
}
__device__ __forceinline__ u32 row_min16u(u32 x) {
    x = min(x, (u32)dppi<0x128>((int)x));
    x = min(x, (u32)dppi<0x124>((int)x));
    x = min(x, (u32)dppi<0x122>((int)x));
    x = min(x, (u32)dppi<0x121>((int)x));
    return x;
}
template <int CTRL>
__device__ __forceinline__ float dpp_qf(float x) { return __int_as_float(__builtin_amdgcn_update_dpp(0, __float_as_int(x), CTRL, 0xF, 0xF, false)); }
__device__ __forceinline__ float wsum(float v) {
    v = row_sum16f(v);
    const float a = __int_as_float(__builtin_amdgcn_readlane(__float_as_int(v), 0));
    const float b = __int_as_float(__builtin_amdgcn_readlane(__float_as_int(v), 16));
    const float c = __int_as_float(__builtin_amdgcn_readlane(__float_as_int(v), 32));
    const float d = __int_as_float(__builtin_amdgcn_readlane(__float_as_int(v), 48));
    return (a + b) + (c + d);
}
__device__ __forceinline__ float wmax(float v) {
    v = row_max16f(v);
    const float a = __int_as_float(__builtin_amdgcn_readlane(__float_as_int(v), 0));
    const float b = __int_as_float(__builtin_amdgcn_readlane(__float_as_int(v), 16));
    const float c = __int_as_float(__builtin_amdgcn_readlane(__float_as_int(v), 32));
    const float d = __int_as_float(__builtin_amdgcn_readlane(__float_as_int(v), 48));
    return fmaxf(fmaxf(a, b), fmaxf(c, d));
}
__device__ __forceinline__ int wsumi(int v) {
    v = row_sum16i(v);
    return __builtin_amdgcn_readlane(v, 0) + __builtin_amdgcn_readlane(v, 16) + __builtin_amdgcn_readlane(v, 32) + __builtin_amdgcn_readlane(v, 48);
}
__device__ __forceinline__ float sigmoidf(float x) { return 1.0f / (1.0f + __expf(-x)); }
__device__ __forceinline__ float gelu_tanh(float x) {
    float u = 0.7978845608028654f * (x + 0.044715f * x * x * x);
    return 0.5f * x * (1.0f + tanhf(u));
}
__device__ __forceinline__ u32 sortkey(float f) {
    u32 b = __float_as_uint(f);
    return b ^ ((b >> 31) ? 0xFFFFFFFFu : 0x80000000u);
}
#define WAVE_SYNC() asm volatile("s_waitcnt lgkmcnt(0)" ::: "memory")
template <class T>
__device__ __forceinline__ T* opq(T* p) {
    long z = 0;
    asm volatile("" : "+s"(z));
    return (T*)((char*)p + z);
}
__device__ __forceinline__ int tidx() {
    int t = threadIdx.x;
    asm volatile("" : "+v"(t));
    return t;
}
__device__ __forceinline__ int bidx() {
    int b = blockIdx.x;
    asm volatile("" : "+s"(b));
    return b;
}
__device__ __forceinline__ int gdim() {
    int g = gridDim.x;
    asm volatile("" : "+s"(g));
    return g;
}

template <int AMODE, bool HAS_RS, class RowFn, class Epi>
__device__ __forceinline__ void gemm_tile(const u16* __restrict__ Ap, long lda, const u16* __restrict__ BT, long ldb, int M, int N, int K, int m0,
                                          int n0, unsigned char* lds, RowFn rowfn, Epi epi) {
    const int tid = tidx(), lane = tid & 63, w = tid >> 6;
    const int wm = w >> 1, wn = w & 1;
    f32x4 acc[4][4];
#pragma unroll
    for (int i = 0; i < 4; ++i)
#pragma unroll
        for (int j = 0; j < 4; ++j) acc[i][j] = f32x4{0.f, 0.f, 0.f, 0.f};
    long aoff[4], boff[4];
#pragma unroll
    for (int i = 0; i < 4; ++i) {
        const int row = (w * 4 + i) * 8 + (lane >> 3);
        const int kc = (lane & 7) ^ ((row >> 1) & 7);
        int gr = m0 + row;
        if (gr > M - 1) gr = M - 1;
        if (AMODE == 1) {
            int b = gr / (NCMP * 2);
            int rem = gr - b * (NCMP * 2);
            aoff[i] = ((long)b * SEQ + 16 * (rem >> 1)) * IN_COLS + (rem & 1) * 64 + kc * 8;
        } else {
            aoff[i] = (long)gr * lda + kc * 8;
        }
        int gn = n0 + row;
        if (gn > N - 1) gn = N - 1;
        boff[i] = (long)gn * ldb + kc * 8;
    }
    const int nk = K / 64;
#define GEMM_STAGE(kt, bufsel)                                                                                                        \
    do {                                                                                                                              \
        unsigned char* ab_ = lds + (bufsel) * 32768 + w * 4096 + lane * 16;                                                           \
        const long ka_ = (AMODE == 1) ? (long)(kt) * IN_COLS : (long)(kt) * 64;                                                       \
        _Pragma("unroll") for (int i_ = 0; i_ < 4; ++i_) {                                                                            \
            __builtin_amdgcn_global_load_lds((const unsigned*)(Ap + aoff[i_] + ka_), (unsigned*)(ab_ + i_ * 1024), 16, 0, 0);        \
            __builtin_amdgcn_global_load_lds((const unsigned*)(BT + boff[i_] + (long)(kt) * 64), (unsigned*)(ab_ + 16384 + i_ * 1024), 16, 0, 0); \
        }                                                                                                                             \
    } while (0)
    GEMM_STAGE(0, 0);
    asm volatile("s_waitcnt vmcnt(0)" ::: "memory");
    __syncthreads();
    int fa[4], fb[4];
#pragma unroll
    for (int i = 0; i < 4; ++i) {
        const int ra = wm * 64 + i * 16 + (lane & 15), rb = wn * 64 + i * 16 + (lane & 15);
        fa[i] = ra * 128 + ((ra >> 1) & 7) * 16;
        fb[i] = rb * 128 + ((rb >> 1) & 7) * 16;
    }
    for (int kt = 0; kt < nk; ++kt) {
        if (kt + 1 < nk) GEMM_STAGE(kt + 1, (kt + 1) & 1);
        const unsigned char* Ab = lds + (kt & 1) * 32768;
        const unsigned char* Bb = Ab + 16384;
#pragma unroll
        for (int ks = 0; ks < 2; ++ks) {
            const int kc16 = (ks * 4 + (lane >> 4)) * 16;
            bf16x8 af[4], bfr[4];
#pragma unroll
            for (int i = 0; i < 4; ++i) {
                af[i] = *(const bf16x8*)(Ab + ((fa[i] & ~127) | ((fa[i] & 127) ^ kc16)));
                bfr[i] = *(const bf16x8*)(Bb + ((fb[i] & ~127) | ((fb[i] & 127) ^ kc16)));
            }
#pragma unroll
            for (int i = 0; i < 4; ++i)
#pragma unroll
                for (int j = 0; j < 4; ++j) acc[i][j] = __builtin_amdgcn_mfma_f32_16x16x32_bf16(af[i], bfr[j], acc[i][j], 0, 0, 0);
        }
        asm volatile("s_waitcnt vmcnt(0)" ::: "memory");
        __syncthreads();
    }
#undef GEMM_STAGE
    float2* rsl = (float2*)(lds + 34816);
    if (HAS_RS) {
        if (tid < 128) {
            int gr = m0 + tid;
            if (gr > M - 1) gr = M - 1;
            rsl[tid] = rowfn(gr);
        }
        __syncthreads();
    }
    float* st = (float*)(lds + w * 8704);
#pragma unroll
    for (int hh = 0; hh < 2; ++hh) {
#pragma unroll
        for (int m2 = 0; m2 < 2; ++m2)
#pragma unroll
            for (int j = 0; j < 4; ++j)
#pragma unroll
                for (int r = 0; r < 4; ++r) st[(m2 * 16 + (lane >> 4) * 4 + r) * 68 + j * 16 + (lane & 15)] = acc[hh * 2 + m2][j][r];
        WAVE_SYNC();
#pragma unroll
        for (int c = 0; c < 4; ++c) {
            const int id = c * 64 + lane;
            const int rr = id >> 3, cc = id & 7;
            const float4 v0 = *(const float4*)(st + rr * 68 + cc * 8);
            const float4 v1 = *(const float4*)(st + rr * 68 + cc * 8 + 4);
            const float v[8] = {v0.x, v0.y, v0.z, v0.w, v1.x, v1.y, v1.z, v1.w};
            const int row = m0 + wm * 64 + hh * 32 + rr;
            const int col0 = n0 + wn * 64 + cc * 8;
            const float2 rs = HAS_RS ? rsl[wm * 64 + hh * 32 + rr] : float2{1.f, 1.f};
            if (row < M && col0 < N) epi(row, col0, v, rs);
        }
        WAVE_SYNC();
    }
    __syncthreads();
}

template <int AMODE, bool HAS_RS, class RowFn, class Epi>
__device__ __forceinline__ void gemm_phase_rs(const u16* Ap, long lda, const u16* BT, long ldb, int M, int N, int K, unsigned char* lds, RowFn rowfn, Epi epi) {
    const int tm = (M + 127) / 128, tn = (N + 127) / 128;
    const int SW = (tn % 9 == 0) ? 9 : ((tn % 8 == 0) ? 8 : 0);
    const int G = gdim();
    if (SW != 0 && (tm % 8) == 0 && (G % 8) == 0 && (((tm / 8) * (tn / SW)) % 8) == 0) {
        const int nsc = tn / SW;
        const int per = 8 * SW;
        const int nst_x = (tm / 8) * nsc / 8;
        const int x = bidx() & 7, j0 = bidx() >> 3, nper = G >> 3;
        for (int q = j0; q < nst_x * per; q += nper) {
            const int st = (q / per) * 8 + x;
            const int r = q % per;
            const int im = (st / nsc) * 8 + (r % 8), in = (st % nsc) * SW + (r / 8);
            gemm_tile<AMODE, HAS_RS>(Ap, lda, BT, ldb, M, N, K, im * 128, in * 128, lds, rowfn, epi);
        }
    } else {
        for (int t = bidx(); t < tm * tn; t += G) {
            int im = t / tn, in = t - im * tn;
            gemm_tile<AMODE, HAS_RS>(Ap, lda, BT, ldb, M, N, K, im * 128, in * 128, lds, rowfn, epi);
        }
    }
}
template <int AMODE, class Epi>
__device__ __forceinline__ void gemm_phase(const u16* Ap, long lda, const u16* BT, long ldb, int M, int N, int K, unsigned char* lds, Epi epi) {
    gemm_phase_rs<AMODE, false>(Ap, lda, BT, ldb, M, N, K, lds, [](int) { return float2{1.f, 1.f}; },
                                [=](int row, int col, const float (&v)[8], float2) { epi(row, col, v); });
}
__device__ __forceinline__ void st_bf8(u16* p, const float (&v)[8]) {
    *(uint4*)p = uint4{pack2(v[0], v[1]), pack2(v[2], v[3]), pack2(v[4], v[5]), pack2(v[6], v[7])};
}
__device__ __forceinline__ void ld_bf8(const u16* p, float (&v)[8]) {
    const uint4 q = *(const uint4*)p;
    v[0] = bf_lo(q.x); v[1] = bf_hi(q.x); v[2] = bf_lo(q.y); v[3] = bf_hi(q.y);
    v[4] = bf_lo(q.z); v[5] = bf_hi(q.z); v[6] = bf_lo(q.w); v[7] = bf_hi(q.w);
}

template <bool PERM = false>
__device__ __forceinline__ void transpose_cvt(const float* __restrict__ src, u16* __restrict__ dst, int K, int N, float* tile, const float* kgain = nullptr) {
    const int tk = K / 64, tn = (N + 63) / 64;
    const int tid = tidx();
    for (int t = bidx(); t < tk * tn; t += gdim()) {
        const int k0 = (t / tn) * 64, n0 = (t % tn) * 64;
        {
            const int tx = tid & 15, ty = tid >> 4;
#pragma unroll
            for (int i = 0; i < 4; ++i) {
                const int k = ty * 4 + i, n = n0 + tx * 4;
                float4 v = float4{0.f, 0.f, 0.f, 0.f};
                if (n < N) v = *(const float4*)(src + (long)(k0 + k) * N + n);
                const float g = kgain ? kgain[k0 + k] : 1.0f;
                float* trow = tile + k * 65 + tx * 4;
                trow[0] = v.x * g; trow[1] = v.y * g; trow[2] = v.z * g; trow[3] = v.w * g;
            }
        }
        __syncthreads();
        {
            const int kc = tid & 7, nl = tid >> 3;
#pragma unroll
            for (int j = 0; j < 2; ++j) {
                const int nn = nl + 32 * j, n = n0 + nn;
                float v[8];
#pragma unroll
                for (int q = 0; q < 8; ++q) v[q] = tile[(kc * 8 + q) * 65 + nn];
                if (n < N) st_bf8(dst + (long)(PERM ? perm_col(n) : n) * K + k0 + kc * 8, v);
            }
        }
        __syncthreads();
    }
}

__device__ __forceinline__ void cvt_f32_bf16(const float* __restrict__ src, u16* __restrict__ dst, long n) {
    long i = ((long)bidx() * 256 + tidx()) * 8;
    const long stride = (long)gdim() * 256 * 8;
    for (; i < n; i += stride) {
        float4 a = *(const float4*)(src + i);
        float4 b = *(const float4*)(src + i + 4);
        *(uint4*)(dst + i) = uint4{pack2(a.x, a.y), pack2(a.z, a.w), pack2(b.x, b.y), pack2(b.z, b.w)};
    }
}

typedef float f32x2_t __attribute__((ext_vector_type(2)));
__device__ __forceinline__ void cvt_rows_fp8(const float* __restrict__ src, unsigned char* __restrict__ dst, float* __restrict__ scales, int nrows) {
    const int lane = tidx() & 63;
    const int wid = bidx() * 4 + (tidx() >> 6);
    const int nw = gdim() * 4;
    for (int row = wid; row < nrows; row += nw) {
        const float* r = src + (long)row * 1024 + lane * 16;
        float4 q[4];
#pragma unroll
        for (int i = 0; i < 4; ++i) q[i] = *(const float4*)(r + 4 * i);
        float am = 0.f;
#pragma unroll
        for (int i = 0; i < 4; ++i) am = fmaxf(am, fmaxf(fmaxf(fabsf(q[i].x), fabsf(q[i].y)), fmaxf(fabsf(q[i].z), fabsf(q[i].w))));
        am = wmax(am);
        const float inv = am > 0.f ? 448.0f / am : 0.f;
        if (lane == 0) scales[row] = am > 0.f ? am * (1.0f / 448.0f) : 0.f;
        u32 wv[4];
#pragma unroll
        for (int i = 0; i < 4; ++i) {
            int x = 0;
            x = __builtin_amdgcn_cvt_pk_fp8_f32(q[i].x * inv, q[i].y * inv, x, false);
            x = __builtin_amdgcn_cvt_pk_fp8_f32(q[i].z * inv, q[i].w * inv, x, true);
            wv[i] = (u32)x;
        }
        *(uint4*)(dst + (long)row * 1024 + lane * 16) = uint4{wv[0], wv[1], wv[2], wv[3]};
    }
}

__device__ __forceinline__ void rms_rows(const float* __restrict__ x, const float* __restrict__ g, u16* __restrict__ dst, const u16* __restrict__ e,
                         float* __restrict__ rstd_e) {
    const int lane = tidx() & 63;
    const int wid = bidx() * 4 + (tidx() >> 6);
    const int nw = gdim() * 4;
    for (int row = wid; row < NTOK; row += nw) {
        const float* xr = x + (long)row * 1024;
        float4 v[4];
        float ss = 0.f;
#pragma unroll
        for (int i = 0; i < 4; ++i) {
            v[i] = *(const float4*)(xr + i * 256 + lane * 4);
            ss += v[i].x * v[i].x + v[i].y * v[i].y + v[i].z * v[i].z + v[i].w * v[i].w;
        }
        ss = wsum(ss);
        float rstd = rsqrtf(ss * (1.0f / 1024.0f) + EPS);
#pragma unroll
        for (int i = 0; i < 4; ++i) {
            float4 gg = g ? *(const float4*)(g + i * 256 + lane * 4) : float4{1.f, 1.f, 1.f, 1.f};
            uint2 o = uint2{pack2(v[i].x * rstd * gg.x, v[i].y * rstd * gg.y), pack2(v[i].z * rstd * gg.z, v[i].w * rstd * gg.w)};
            *(uint2*)(dst + (long)row * 1024 + i * 256 + lane * 4) = o;
        }
        if (e) {
            const uint4* er = (const uint4*)(e + (long)row * 1024);
            float es = 0.f;
#pragma unroll
            for (int i = 0; i < 2; ++i) {
                uint4 q = er[i * 64 + lane];
                float a;
                a = bf_lo(q.x); es += a * a; a = bf_hi(q.x); es += a * a;
                a = bf_lo(q.y); es += a * a; a = bf_hi(q.y); es += a * a;
                a = bf_lo(q.z); es += a * a; a = bf_hi(q.z); es += a * a;
                a = bf_lo(q.w); es += a * a; a = bf_hi(q.w); es += a * a;
            }
            es = wsum(es);
            if (lane == 0) rstd_e[row] = rsqrtf(es * (1.0f / 1024.0f) + EPS);
        }
    }
}

__device__ __forceinline__ void head_chunk(u16* ptr, float gain, bool do_norm, float scale, float c, float sn, int lane) {
    float v = bf2f(ptr[lane]);
    if (do_norm) {
        float ss = wsum(v * v);
        v = v * rsqrtf(ss * (1.0f / 64.0f) + EPS) * gain;
    }
    float pv = __shfl_xor(v, 8);
    if (lane < 16) v = (lane < 8) ? (v * c - pv * sn) : (v * c + pv * sn);
    ptr[lane] = f2bf(v * scale);
}
__device__ __forceinline__ u32 sig2(u32 w) { return pack2(sigmoidf(bf_lo(w)), sigmoidf(bf_hi(w))); }

__device__ __forceinline__ void post_proj(unsigned char* ws, const float* ng, const float* dg, unsigned char* smem) {
    u16* proj = (u16*)(ws + OFF_PROJ);
    const float* ropec = (const float*)(ws + OFF_ROPE);
    const float* ropes = ropec + (size_t)NTOK * 8;
    const int lane = tidx() & 63, w = tidx() >> 6;
    u16* lrow = (u16*)(smem + w * 9216);
    const float g_q = ng[lane], g_ks = ng[128 + lane], g_kw = ng[192 + lane], g_dq = dg[lane], g_kb = dg[64 + lane];
    const int wid = bidx() * 4 + w;
    const int nw = gdim() * 4;
    for (int t = wid; t < NTOK; t += nw) {
        uint4* grow = (uint4*)(proj + (long)t * IN_COLS);
        const float c = ropec[(long)t * 8 + (lane & 7)], sn = ropes[(long)t * 8 + (lane & 7)];
#pragma unroll
        for (int i = 0; i < 8; ++i) ((uint4*)lrow)[i * 64 + lane] = grow[i * 64 + lane];
        if (lane < 60) ((uint4*)lrow)[512 + lane] = grow[512 + lane];
        WAVE_SYNC();
        for (int h = 0; h < 8; ++h) head_chunk(lrow + C_NQ + h * 64, g_q, true, 0.125f * 1.4426950408889634f, c, sn, lane);
        for (int g = 0; g < 2; ++g) head_chunk(lrow + C_NKV + (2 * 2 + g) * 64, g_ks, true, 1.0f, c, sn, lane);
        for (int g = 0; g < 2; ++g) head_chunk(lrow + C_NKV + (4 * 2 + g) * 64, g_kw, true, 1.0f, c, sn, lane);
        for (int h = 0; h < 8; ++h) head_chunk(lrow + C_DQ + h * 64, g_dq, true, 0.125f * 1.4426950408889634f, c, sn, lane);
        head_chunk(lrow + C_DKV, g_kb, true, 1.0f, c, sn, lane);
        for (int h = 0; h < 8; ++h) head_chunk(lrow + C_IQ + h * 64, 1.0f, false, 0.125f, c, sn, lane);
        head_chunk(lrow + C_IK, 1.0f, false, 1.0f, c, sn, lane);
        WAVE_SYNC();
#pragma unroll
        for (int i = 0; i < 9; ++i) {
            int idx = i * 64 + lane;
            if (idx < 572) {
                uint4 v = ((const uint4*)lrow)[idx];
                if (idx >= 316 || (idx >= 160 && idx < 163)) v = uint4{sig2(v.x), sig2(v.y), sig2(v.z), sig2(v.w)};
                grow[idx] = v;
            }
        }
        WAVE_SYNC();
    }
}

template <int NH>
__device__ __forceinline__ void qk_chunk(const u16* krow, const u32* qlds, float (&s)[NH]) {
    asm volatile("" ::: "memory");
    uint4 kr[8];
#pragma unroll
    for (int i = 0; i < 8; ++i) kr[i] = ((const uint4*)krow)[i];
#pragma unroll
    for (int h = 0; h < NH; ++h) s[h] = 0.f;
#pragma unroll
    for (int i = 0; i < 8; ++i)
#pragma unroll
        for (int h = 0; h < NH; ++h) {
            uint4 q = *(const uint4*)(qlds + h * 32 + i * 4);
            s[h] = dot2(kr[i].x, q.x, s[h]);
            s[h] = dot2(kr[i].y, q.y, s[h]);
            s[h] = dot2(kr[i].z, q.z, s[h]);
            s[h] = dot2(kr[i].w, q.w, s[h]);
        }
}

template <int NH, class VRow>
__device__ __forceinline__ void pv_chunk(const float* plds, VRow vrow, float (&o)[NH][4], int lane) {
    const int sub = lane >> 4, dq = lane & 15;
#pragma unroll 4
    for (int kk = 0; kk < 16; ++kk) {
        int key = kk * 4 + sub;
        const u16* vp = vrow(key);
        uint2 vv = *(const uint2*)(vp + dq * 4);
        float v0 = bf_lo(vv.x), v1 = bf_hi(vv.x), v2 = bf_lo(vv.y), v3 = bf_hi(vv.y);
#pragma unroll
        for (int h = 0; h < NH; ++h) {
            float ph = plds[key * NH + h];
            o[h][0] += ph * v0;
            o[h][1] += ph * v1;
            o[h][2] += ph * v2;
            o[h][3] += ph * v3;
        }
    }
}

template <int NH, class VRow>
__device__ __forceinline__ void attn_chunk(float (&s)[NH], bool valid, float (&m)[NH], float (&l)[NH], float (&o)[NH][4], float* plds, VRow vrow,
                                           int lane) {
#pragma unroll
    for (int h = 0; h < NH; ++h) {
        float sv = valid ? s[h] : -1e30f;
        float cm = wmax(sv);
        float mn = fmaxf(m[h], cm);
        float alpha = __expf(m[h] - mn);
        float p = valid ? __expf(sv - mn) : 0.f;
        l[h] = l[h] * alpha + wsum(p);
        m[h] = mn;
#pragma unroll
        for (int j = 0; j < 4; ++j) o[h][j] *= alpha;
        plds[lane * NH + h] = p;
    }
    WAVE_SYNC();
    pv_chunk<NH>(plds, vrow, o, lane);
    WAVE_SYNC();
}

#define MFMA32(a, b, c) __builtin_amdgcn_mfma_f32_32x32x16_bf16(a, b, c, 0, 0, 0)
typedef __attribute__((address_space(3))) const char* lds_cptr;
typedef short v4i16_t __attribute__((ext_vector_type(4)));
using s16x4 = __attribute__((ext_vector_type(4))) short;
__device__ __forceinline__ s16x4 vtr(lds_cptr p) {
    return __builtin_bit_cast(s16x4, __builtin_amdgcn_ds_read_tr16_b64_v4i16((__attribute__((address_space(3))) v4i16_t*)p));
}
__device__ __forceinline__ float xhalf_sum(float v) {
    auto r = __builtin_amdgcn_permlane32_swap(__float_as_uint(v), __float_as_uint(v), false, false);
    return __uint_as_float(r[0]) + __uint_as_float(r[1]);
}
__device__ __forceinline__ float xhalf_max(float v) {
    auto r = __builtin_amdgcn_permlane32_swap(__float_as_uint(v), __float_as_uint(v), false, false);
    return fmaxf(__uint_as_float(r[0]), __uint_as_float(r[1]));
}

using u32x4 = __attribute__((ext_vector_type(4))) unsigned;
struct TileRegs { u32x4 k0, k1, v0, v1; };
template <class RowPtr>
__device__ __forceinline__ void tile_load(u32x4& k0, u32x4& k1, u32x4& v0, u32x4& v1, RowPtr rowptr, int w, int lane) {
    const u16 *kp, *vp, *kp2, *vp2;
    rowptr(lane, kp, vp2);
    rowptr(16 * w + (lane >> 2), kp2, vp);
    k0 = *(const u32x4*)(kp + w * 8);
    k1 = *(const u32x4*)(kp + (w + 4) * 8);
    v0 = *(const u32x4*)(vp + (lane & 3) * 8);
    v1 = *(const u32x4*)(vp + 32 + (lane & 3) * 8);
}
__device__ __forceinline__ void tile_store(const u32x4& k0, const u32x4& k1, const u32x4& v0, const u32x4& v1, unsigned char* buf, int w, int lane) {
    *(u32x4*)(buf + w * 1024 + lane * 16) = k0;
    *(u32x4*)(buf + (w + 4) * 1024 + lane * 16) = k1;
    *(u32x4*)(buf + 8192 + (16 * w + (lane >> 2)) * 64 + (lane & 3) * 16) = v0;
    *(u32x4*)(buf + 8192 + 4096 + (16 * w + (lane >> 2)) * 64 + (lane & 3) * 16) = v1;
}
__device__ __forceinline__ void glds16(const void* g, unsigned lds_base) {
    unsigned sv;
    asm volatile("s_mov_b32 %0, m0\n\ts_mov_b32 m0, %2\n\ts_nop 0\n\tglobal_load_lds_dwordx4 %1, off\n\ts_mov_b32 m0, %0"
                 : "=&s"(sv)
                 : "v"(g), "s"(lds_base)
                 : "memory");
}
template <class RowPtr>
__device__ __forceinline__ void tile_dma(RowPtr rowptr, unsigned char* buf, int w, int lane) {
    const u16 *kp, *vp, *kp2, *vp2;
    rowptr(lane, kp, vp2);
    rowptr(16 * w + (lane >> 2), kp2, vp);
    const unsigned kd = (unsigned)__builtin_amdgcn_readfirstlane((int)((unsigned)(uintptr_t)buf + (unsigned)(w * 1024)));
    const unsigned vd = kd + 8192u;
    glds16(kp + w * 8, kd);
    glds16(kp + (w + 4) * 8, kd + 4096u);
    glds16(vp + (lane & 3) * 8, vd);
    glds16(vp + 32 + (lane & 3) * 8, vd + 4096u);
}
__device__ __forceinline__ void qk_tile(const unsigned char* buf, const bf16x8 (&qr)[4], const f32x16& zero16, f32x16& s0, f32x16& s1, int lane) {
    const int r32 = lane & 31, hi = lane >> 5;
    lds_cptr kp = (lds_cptr)buf + hi * 1024 + r32 * 16;
#pragma unroll
    for (int d0 = 0; d0 < 4; ++d0) {
        bf16x8 k0 = *(const __attribute__((address_space(3))) bf16x8*)(kp + d0 * 2048);
        bf16x8 k1 = *(const __attribute__((address_space(3))) bf16x8*)(kp + d0 * 2048 + 512);
        s0 = MFMA32(k0, qr[d0], d0 == 0 ? zero16 : s0);
        s1 = MFMA32(k1, qr[d0], d0 == 0 ? zero16 : s1);
    }
}
__device__ __forceinline__ bf16x8 pack8(const f32x16& p, int s) {
    u32 a = pack2(p[8 * s + 0], p[8 * s + 1]), b = pack2(p[8 * s + 2], p[8 * s + 3]);
    u32 c = pack2(p[8 * s + 4], p[8 * s + 5]), d = pack2(p[8 * s + 6], p[8 * s + 7]);
    u32x4 v = u32x4{a, b, c, d};
    return __builtin_bit_cast(bf16x8, v);
}
__device__ __forceinline__ void pv_tile(const unsigned char* buf, const f32x16& p0, const f32x16& p1, f32x16 (&o)[2], int lane) {
    const int hi = lane >> 5;
    lds_cptr vp = (lds_cptr)buf + 8192 + ((lane >> 4) & 1) * 32 + (lane & 3) * 8 + (4 * hi + ((lane & 15) >> 2)) * 64;
    bf16x8 pf[4];
    pf[0] = pack8(p0, 0);
    pf[1] = pack8(p0, 1);
    pf[2] = pack8(p1, 0);
    pf[3] = pack8(p1, 1);
#pragma unroll
    for (int dh = 0; dh < 2; ++dh) {
        bf16x8 vf[4];
#pragma unroll
        for (int ks = 0; ks < 4; ++ks) {
            const uint2 vlo = __builtin_bit_cast(uint2, vtr(vp + dh * 4096 + ks * 1024));
            const uint2 vhi = __builtin_bit_cast(uint2, vtr(vp + dh * 4096 + ks * 1024 + 512));
            const u32x4 vq = u32x4{vlo.x, vlo.y, vhi.x, vhi.y};
            vf[ks] = __builtin_bit_cast(bf16x8, vq);
        }
        __builtin_amdgcn_sched_barrier(0);
#pragma unroll
        for (int ks = 0; ks < 4; ++ks) o[dh] = MFMA32(vf[ks], pf[ks], o[dh]);
        __builtin_amdgcn_sched_barrier(0);
    }
}
template <bool BITS>
__device__ __forceinline__ void apply_mask(f32x16& s0, f32x16& s1, int lo, int hi_lim, u64 word, int hi) {
    const u32 wlo = (u32)(word >> (4 * hi)), whi = (u32)(word >> (32 + 4 * hi));
#pragma unroll
    for (int i = 0; i < 16; ++i) {
        const int kc = (i & 3) + 8 * (i >> 2);
        bool v0, v1;
        if (BITS) {
            v0 = (wlo >> kc) & 1u;
            v1 = (whi >> kc) & 1u;
        } else {
            const int kk = kc + 4 * hi;
            v0 = (kk >= lo) && (kk <= hi_lim);
            v1 = (kk + 32 >= lo) && (kk + 32 <= hi_lim);
        }
        s0[i] = v0 ? s0[i] : -1e30f;
        s1[i] = v1 ? s1[i] : -1e30f;
    }
}
__device__ __forceinline__ void softmax_step(f32x16& s0, f32x16& s1, float& m, float& l, f32x16 (&o)[2]) {
    float mx = fmaxf(s0[0], s1[0]);
#pragma unroll
    for (int i = 1; i < 16; ++i) mx = fmaxf(fmaxf(mx, s0[i]), s1[i]);
    mx = xhalf_max(mx);
    if (__any(mx > m + 8.0f)) {
        const float mn = fmaxf(m, mx);
        const float alpha = __builtin_amdgcn_exp2f(m - mn);
        l *= alpha;
        m = mn;
#pragma unroll
        for (int i = 0; i < 16; ++i) { o[0][i] *= alpha; o[1][i] *= alpha; }
    }
    const float ms = fmaxf(m, -1e29f);
    float sum = 0.f;
#pragma unroll
    for (int i = 0; i < 16; ++i) {
        s0[i] = __builtin_amdgcn_exp2f(s0[i] - ms);
        s1[i] = __builtin_amdgcn_exp2f(s1[i] - ms);
        sum += s0[i] + s1[i];
    }
    l += xhalf_sum(sum);
}

template <int MODE, bool BITS, class Next, class RowPtr, class MaskFn, class Extra>
__device__ __forceinline__ void flash_run(int first, Next next, RowPtr rowptr, MaskFn maskfn, Extra extra, const bf16x8 (&qr)[4], float& m, float& l,
                                          f32x16 (&o)[2], unsigned char* bufs, int w, int lane) {
    if (first < 0) return;
    int cur = first;
    int nxt = next(cur);
    asm volatile("" ::"v"(qr[0]), "v"(qr[1]), "v"(qr[2]), "v"(qr[3]));
    __syncthreads();
    tile_dma([&](int r, const u16*& kp, const u16*& vp) { rowptr(cur, r, kp, vp); }, bufs, w, lane);
    if (nxt >= 0) tile_dma([&](int r, const u16*& kp, const u16*& vp) { rowptr(nxt, r, kp, vp); }, bufs + 16384, w, lane);
    int pb = 0, pb2 = 2;
    f32x16 zero16;
#pragma unroll
    for (int i = 0; i < 16; ++i) zero16[i] = 0.f;
    while (cur >= 0) {
        if (nxt >= 0) asm volatile("s_waitcnt vmcnt(4)" ::: "memory");
        else asm volatile("s_waitcnt vmcnt(0)" ::: "memory");
        asm volatile("s_waitcnt lgkmcnt(0)" ::: "memory");
        __builtin_amdgcn_s_barrier();
        const int nn = nxt >= 0 ? next(nxt) : -1;
        if (nn >= 0) tile_dma([&](int r, const u16*& kp, const u16*& vp) { rowptr(nn, r, kp, vp); }, bufs + pb2 * 16384, w, lane);
        const unsigned char* buf = bufs + pb * 16384;
        f32x16 s0, s1;
        qk_tile(buf, qr, zero16, s0, s1, lane);
        int lo, hl;
        u64 word;
        maskfn(cur, lo, hl, word);
        if (BITS || !__all(lo <= 0 && hl >= 63)) apply_mask<BITS>(s0, s1, lo, hl, word, lane >> 5);
        if (MODE == 0) {
            softmax_step(s0, s1, m, l, o);
            pv_tile(buf, s0, s1, o, lane);
        } else if (MODE == 1) {
            f32x16 od[2];
#pragma unroll
            for (int i = 0; i < 16; ++i) { od[0][i] = 0.f; od[1][i] = 0.f; }
            softmax_step(s0, s1, m, l, od);
        } else {
            const float ms2 = fmaxf(m, -1e29f);
#pragma unroll
            for (int i = 0; i < 16; ++i) {
                s0[i] = __builtin_amdgcn_exp2f(s0[i] - ms2) * l;
                s1[i] = __builtin_amdgcn_exp2f(s1[i] - ms2) * l;
            }
            extra(cur, s0, s1);
            pv_tile(buf, s0, s1, o, lane);
        }
        pb = (pb == 2) ? 0 : pb + 1;
        pb2 = (pb2 == 2) ? 0 : pb2 + 1;
        cur = nxt;
        nxt = nn;
    }
}

__device__ __forceinline__ void nsa_unit(unsigned char* ws, int b, int g, int qt, unsigned char* smem) {
    const int tid = tidx(), lane = tid & 63, w = tid >> 6;
    const int r32 = lane & 31, hi = lane >> 5;
    const int q0 = qt * 32;
    const int tl = q0 + 8 * w + (r32 >> 2);
    const int rep = r32 & 3;
    const u16* proj = (const u16*)(ws + OFF_PROJ);
    const u16* brow = proj + (long)b * SEQ * IN_COLS;
    const u16* kcb = (const u16*)(ws + OFF_KCB) + (size_t)(b * 2 + g) * 256 * 64;
    const u16* vcb = (const u16*)(ws + OFF_VCB) + (size_t)(b * 2 + g) * 256 * 64;
    u16* ya = (u16*)(ws + OFF_YAB);
    unsigned char* bufs = smem;
    float* imp = (float*)(smem + 49152);
    u64* selm = (u64*)(smem + 49152 + 8192);
    const u16* trow = brow + (long)tl * IN_COLS;
    bf16x8 qr[4];
#pragma unroll
    for (int d0 = 0; d0 < 4; ++d0) qr[d0] = *(const bf16x8*)(trow + C_NQ + (g * 4 + rep) * 64 + d0 * 16 + hi * 8);
    const float gate_c = bf2f(trow[C_NG + 0 * 8 + g * 4 + rep]);
    const float gate_s = bf2f(trow[C_NG + 1 * 8 + g * 4 + rep]);
    const float gate_w = bf2f(trow[C_NG + 2 * 8 + g * 4 + rep]);
    for (int i = tid; i < 32 * 64; i += 256) imp[i] = 0.f;
    f32x16 tot[2];
#pragma unroll
    for (int i = 0; i < 16; ++i) { tot[0][i] = 0.f; tot[1][i] = 0.f; }

    const int nvalid = tl >= 31 ? ((tl - 31) >> 4) + 1 : 0;
    const int nv_max = (q0 + 31 >= 31) ? ((q0 + 31 - 31) >> 4) + 1 : 0;
    const int ntile_c = (nv_max + 63) >> 6;
    auto crows = [&](int tile, int r, const u16*& kp, const u16*& vp) {
        int n = tile * 64 + r;
        n = n < 254 ? n : 254;
        kp = kcb + (size_t)n * 64;
        vp = vcb + (size_t)n * 64;
    };
    auto cnext = [&](int c) { return (c + 1 < ntile_c) ? c + 1 : -1; };
    auto cmask = [&](int tile, int& lo, int& hl, u64& word) { lo = 0; hl = nvalid - 64 * tile - 1; word = 0; };
    {
        float m = -1e30f, l = 0.f;
        f32x16 o[2];
#pragma unroll
        for (int i = 0; i < 16; ++i) { o[0][i] = 0.f; o[1][i] = 0.f; }
        flash_run<1, false>(ntile_c > 0 ? 0 : -1, cnext, crows, cmask, [&](int, f32x16&, f32x16&) {}, qr, m, l, o, bufs, w, lane);
        float invl = l > 0.f ? 1.0f / l : 0.f;
        const int qloc = 8 * w + (r32 >> 2);
        flash_run<2, false>(ntile_c > 0 ? 0 : -1, cnext, crows, cmask,
                            [&](int tile, f32x16& p0, f32x16& p1) {
#pragma unroll
                                for (int a = 0; a < 4; ++a) {
                                    float g0 = p0[4 * a] + p0[4 * a + 1] + p0[4 * a + 2] + p0[4 * a + 3], e0 = p0[4 * a + 3];
                                    float g1 = p1[4 * a] + p1[4 * a + 1] + p1[4 * a + 2] + p1[4 * a + 3], e1 = p1[4 * a + 3];
                                    g0 += __shfl_xor(g0, 1); g0 += __shfl_xor(g0, 2);
                                    e0 += __shfl_xor(e0, 1); e0 += __shfl_xor(e0, 2);
                                    g1 += __shfl_xor(g1, 1); g1 += __shfl_xor(g1, 2);
                                    e1 += __shfl_xor(e1, 1); e1 += __shfl_xor(e1, 2);
                                    if (rep == 0) {
                                        int j0 = 16 * tile + 2 * a + hi, j1 = j0 + 8;
                                        atomicAdd(&imp[qloc * 64 + j0], g0);
                                        if (j0 + 1 < 64) atomicAdd(&imp[qloc * 64 + j0 + 1], e0);
                                        if (j1 < 64) atomicAdd(&imp[qloc * 64 + j1], g1);
                                        if (j1 + 1 < 64) atomicAdd(&imp[qloc * 64 + j1 + 1], e1);
                                    }
                                }
                            },
                            qr, m, invl, o, bufs, w, lane);
#pragma unroll
        for (int i = 0; i < 16; ++i) { tot[0][i] += gate_c * o[0][i]; tot[1][i] += gate_c * o[1][i]; }
    }
    __syncthreads();
    for (int qq = 0; qq < 8; ++qq) {
        const int qi = 8 * w + qq;
        const int tq = q0 + qi;
        const int cur = tq >> 6;
        const int j = lane;
        float v = imp[qi * 64 + j];
        if (j == 0 || j == cur || j == cur - 1) v = __builtin_inff();
        if (j > cur) v = -__builtin_inff();
        const u32 key = sortkey(v);
        u32 Kq = 0u;
        for (int bit = 31; bit >= 0; --bit) {
            const u32 cand = Kq | (1u << bit);
            const int cnt = __popcll(__ballot(key >= cand));
            if (cnt >= 16) Kq = cand;
            if (cnt == 16) break;
        }
        const int needq = 16 - __popcll(__ballot(key > Kq));
        const u64 emq = __ballot(key == Kq);
        const bool takeq = (key > Kq) || (key == Kq && __popcll(emq & ((1ull << lane) - 1ull)) < needq);
        u64 sm = __ballot(takeq && j <= cur);
        if (lane == 0) selm[qi] = sm;
    }
    __syncthreads();
    const u64 mymask = selm[8 * w + (r32 >> 2)];
    u64 unionm = 0;
    for (int i = 0; i < 32; ++i) unionm |= selm[i];
    unionm = __builtin_amdgcn_readfirstlane((u32)unionm) | ((u64)__builtin_amdgcn_readfirstlane((u32)(unionm >> 32)) << 32);
    {
        float m = -1e30f, l = 0.f;
        f32x16 o[2];
#pragma unroll
        for (int i = 0; i < 16; ++i) { o[0][i] = 0.f; o[1][i] = 0.f; }
        auto snext = [&](int c) {
            u64 rest = (c >= 63) ? 0ull : (unionm >> (c + 1));
            return rest ? (c + 1 + (__ffsll((long long)rest) - 1)) : -1;
        };
        const int first = unionm ? (__ffsll((long long)unionm) - 1) : -1;
        flash_run<0, false>(first, snext,
                            [&](int j, int r, const u16*& kp, const u16*& vp) {
                                const u16* rp = brow + (long)(64 * j + r) * IN_COLS + C_NKV;
                                kp = rp + (2 * 2 + g) * 64;
                                vp = rp + (3 * 2 + g) * 64;
                            },
                            [&](int j, int& lo, int& hl, u64& word) { lo = 0; hl = ((mymask >> j) & 1ull) ? (tl - 64 * j) : -1; word = 0; },
                            [&](int, f32x16&, f32x16&) {}, qr, m, l, o, bufs, w, lane);
        const float sc = l > 0.f ? gate_s / l : 0.f;
#pragma unroll
        for (int i = 0; i < 16; ++i) { tot[0][i] += sc * o[0][i]; tot[1][i] += sc * o[1][i]; }
    }
    {
        float m = -1e30f, l = 0.f;
        f32x16 o[2];
#pragma unroll
        for (int i = 0; i < 16; ++i) { o[0][i] = 0.f; o[1][i] = 0.f; }
        const int jfirst = (q0 - 511) > 0 ? ((q0 - 511) >> 6) : 0;
        const int jlast = (q0 + 31) >> 6;
        flash_run<0, false>(jfirst, [&](int c) { return c + 1 <= jlast ? c + 1 : -1; },
                            [&](int j, int r, const u16*& kp, const u16*& vp) {
                                const u16* rp = brow + (long)(64 * j + r) * IN_COLS + C_NKV;
                                kp = rp + (4 * 2 + g) * 64;
                                vp = rp + (5 * 2 + g) * 64;
                            },
                            [&](int j, int& lo, int& hl, u64& word) { lo = tl - 511 - 64 * j; hl = tl - 64 * j; word = 0; },
                            [&](int, f32x16&, f32x16&) {}, qr, m, l, o, bufs, w, lane);
        const float sc = l > 0.f ? gate_w / l : 0.f;
#pragma unroll
        for (int i = 0; i < 16; ++i) { tot[0][i] += sc * o[0][i]; tot[1][i] += sc * o[1][i]; }
    }
    {
        u16* orow = ya + ((long)b * SEQ + tl) * 512 + (g * 4 + rep) * 64;
#pragma unroll
        for (int dh = 0; dh < 2; ++dh)
#pragma unroll
            for (int a = 0; a < 4; ++a) {
                uint2 v = uint2{pack2(tot[dh][4 * a], tot[dh][4 * a + 1]), pack2(tot[dh][4 * a + 2], tot[dh][4 * a + 3])};
                *(uint2*)(orow + dh * 32 + 8 * a + 4 * hi) = v;
            }
    }
}

__device__ __forceinline__ void dsa_select_unit(unsigned char* ws, int unit, unsigned char* smem, unsigned long long& tacc) {
    const int tid = tidx(), lane = tid & 63, w = tid >> 6;
    const int t0 = unit * 4;
    const int b = t0 / SEQ, tl0 = t0 - b * SEQ;
    const u16* proj = (const u16*)(ws + OFF_PROJ);
    const u16* brow = proj + (long)b * SEQ * IN_COLS;
    u64* bits = (u64*)(ws + OFF_BITS);
    float* sc = (float*)smem;
    __syncthreads();
    unsigned long long ts0 = SEC_T();
#ifndef ATTA_REP_IDX
#define ATTA_REP_IDX 1
#endif
#ifndef ATTA_REP_TOPK
#define ATTA_REP_TOPK 1
#endif
    for (int rep_ = 0; rep_ < ATTA_REP_IDX; ++rep_) {
        const int r16 = lane & 15, g4 = lane >> 4;
        bf16x8 af[2][2];
#pragma unroll
        for (int rb = 0; rb < 2; ++rb)
#pragma unroll
            for (int ks = 0; ks < 2; ++ks)
                af[rb][ks] = *(const bf16x8*)(proj + (long)(t0 + 2 * rb + (r16 >> 3)) * IN_COLS + C_IQ + (r16 & 7) * 64 + ks * 32 + g4 * 8);
        float wq[2][4];
#pragma unroll
        for (int rb = 0; rb < 2; ++rb)
#pragma unroll
            for (int i = 0; i < 4; ++i)
                wq[rb][i] = bf2f(proj[(long)(t0 + 2 * rb + (g4 >> 1)) * IN_COLS + C_IW + (g4 & 1) * 4 + i]) * 0.35355339059327373f;
        const int ntiles = (tl0 + 4 + 31) >> 5;
#define IDX_LD(T, B)                                                                                         \
    do {                                                                                                     \
        _Pragma("unroll") for (int kt = 0; kt < 2; ++kt) {                                                   \
            int key_ = (T) * 32 + kt * 16 + r16;                                                             \
            key_ = key_ < SEQ ? key_ : SEQ - 1;                                                              \
            _Pragma("unroll") for (int ks = 0; ks < 2; ++ks)                                                 \
                B[kt][ks] = *(const bf16x8*)(brow + (long)key_ * IN_COLS + C_IK + ks * 32 + g4 * 8);         \
        }                                                                                                    \
    } while (0)
        bf16x8 bn[2][2];
        if (w < ntiles) IDX_LD(w, bn);
        for (int tile = w; tile < ntiles; tile += 4) {
            bf16x8 bc[2][2];
#pragma unroll
            for (int kt = 0; kt < 2; ++kt)
#pragma unroll
                for (int ks = 0; ks < 2; ++ks) bc[kt][ks] = bn[kt][ks];
            if (tile + 4 < ntiles) IDX_LD(tile + 4, bn);
#pragma unroll
            for (int rb = 0; rb < 2; ++rb)
#pragma unroll
                for (int kt = 0; kt < 2; ++kt) {
                    f32x4 acc = f32x4{0.f, 0.f, 0.f, 0.f};
                    acc = __builtin_amdgcn_mfma_f32_16x16x32_bf16(af[rb][0], bc[kt][0], acc, 0, 0, 0);
                    acc = __builtin_amdgcn_mfma_f32_16x16x32_bf16(af[rb][1], bc[kt][1], acc, 0, 0, 0);
                    float part = 0.f;
#pragma unroll
                    for (int i = 0; i < 4; ++i) part += wq[rb][i] * fmaxf(acc[i], 0.f);
                    auto sw = __builtin_amdgcn_permlane16_swap(__float_as_uint(part), __float_as_uint(part), false, false);
                    const float tot = __uint_as_float(sw[0]) + __uint_as_float(sw[1]);
                    if ((g4 & 1) == 0) sc[(2 * rb + (g4 >> 1)) * 4096 + tile * 32 + kt * 16 + r16] = tot;
                }
        }
#undef IDX_LD
    }
    __syncthreads();
    SEC_ADD(1, ts0);
    ts0 = SEC_T();
    const int t = t0 + w;
    const int tl = tl0 + w;
    const int nvalid = tl + 1;
    for (int rep_ = 0; rep_ < ATTA_REP_TOPK; ++rep_) {
        u32 u[64];
        const float* scq = sc + w * 4096;
#pragma unroll
        for (int j = 0; j < 64; ++j) {
            const int key = j * 64 + lane;
            const u32 kk = sortkey(scq[key]);
            u[j] = (key <= tl) ? kk : 0u;
        }
        SEC_ADD(2, ts0);
        ts0 = SEC_T();
        u32 K = 0;
        int need = 0, ceq = 0;
        if (nvalid > 256) {
            u32 lm0 = u[0], lm1 = u[1], lm2 = u[2], lm3 = u[3];
#pragma unroll
            for (int j = 4; j < 64; j += 4) { lm0 = max(lm0, u[j]); lm1 = max(lm1, u[j + 1]); lm2 = max(lm2, u[j + 2]); lm3 = max(lm3, u[j + 3]); }
            u32 lo = min(min(lm0, lm1), min(lm2, lm3)), hiu = max(max(lm0, lm1), max(lm2, lm3));
            lo = row_min16u(lo);
            hiu = row_max16u(hiu);
            const u32 L = min(min((u32)__builtin_amdgcn_readlane((int)lo, 0), (u32)__builtin_amdgcn_readlane((int)lo, 16)),
                              min((u32)__builtin_amdgcn_readlane((int)lo, 32), (u32)__builtin_amdgcn_readlane((int)lo, 48)));
            const u32 U = max(max((u32)__builtin_amdgcn_readlane((int)hiu, 0), (u32)__builtin_amdgcn_readlane((int)hiu, 16)),
                              max((u32)__builtin_amdgcn_readlane((int)hiu, 32), (u32)__builtin_amdgcn_readlane((int)hiu, 48)));
            const u32 dd = U ^ L;
            const int hb = dd ? 31 - __clz((int)dd) : -1;
            K = dd ? (U & ~((2u << hb) - 1u)) : U;
            bool exact = false;
            for (int bit = hb; bit >= 0; --bit) {
                const u32 cand = K | (1u << bit);
                int cl = 0;
#pragma unroll
                for (int j = 0; j < 64; ++j) cl += (u[j] >= cand) ? 1 : 0;
                const int cnt = wsumi(cl);
                if (cnt >= 256) K = cand;
                if (cnt == 256) { exact = true; break; }
            }
            if (exact) {
                need = 1; ceq = 1;
            } else {
                int cgt = 0, ce = 0;
#pragma unroll
                for (int j = 0; j < 64; ++j) { cgt += __popcll(__ballot(u[j] > K)); ce += __popcll(__ballot(u[j] == K)); }
                need = 256 - cgt;
                ceq = ce;
            }
        }
        SEC_ADD(3, ts0);
        ts0 = SEC_T();
        const u64 ltmask = (1ull << lane) - 1ull;
        u64 myword = 0;
        if (nvalid <= 256 || need == ceq) {
            const u32 Kt = (nvalid > 256) ? K : 1u;
#pragma unroll
            for (int j = 0; j < 64; ++j) {
                const u64 sm = __ballot(u[j] >= Kt);
                myword = (lane == j) ? sm : myword;
            }
        } else {
            int ebase = 0;
#pragma unroll
            for (int j = 0; j < 64; ++j) {
                bool eq = (u[j] == K);
                u64 em = __ballot(eq);
                int erank = ebase + __popcll(em & ltmask);
                bool take = (u[j] > K) || (eq && erank < need);
                ebase += __popcll(em);
                u64 sm = __ballot(take);
                myword = (lane == j) ? sm : myword;
            }
        }
        bits[(long)t * 64 + lane] = myword;
        SEC_ADD(4, ts0);
    }
}

__device__ __forceinline__ void dsa_attn_unit(unsigned char* ws, int b, int qt, unsigned char* smem) {
    const int tid = tidx(), lane = tid & 63, w = tid >> 6;
    const int r32 = lane & 31, hi = lane >> 5;
    const int q0 = qt * 16;
    const int qloc = 4 * w + (r32 >> 3);
    const int tl = q0 + qloc;
    const int head = r32 & 7;
    const u16* proj = (const u16*)(ws + OFF_PROJ);
    const u16* brow = proj + (long)b * SEQ * IN_COLS;
    const u64* bits = (const u64*)(ws + OFF_BITS) + ((long)b * SEQ + q0) * 64;
    u16* yb = (u16*)(ws + OFF_YAB) + (size_t)NTOK * 512;
    unsigned char* bufs = smem;
    u64* lbits = (u64*)(smem + 49152);
    __syncthreads();
    for (int i = tid; i < 16 * 64; i += 256) lbits[i] = bits[i];
    const u16* trow = brow + (long)tl * IN_COLS;
    bf16x8 qr[4];
#pragma unroll
    for (int d0 = 0; d0 < 4; ++d0) qr[d0] = *(const bf16x8*)(trow + C_DQ + head * 64 + d0 * 16 + hi * 8);
    float m = -1e30f, l = 0.f;
    f32x16 o[2];
#pragma unroll
    for (int i = 0; i < 16; ++i) { o[0][i] = 0.f; o[1][i] = 0.f; }
    const int jlast = (q0 + 15) >> 6;
    flash_run<0, true>(0, [&](int c) { return c + 1 <= jlast ? c + 1 : -1; },
                       [&](int j, int r, const u16*& kp, const u16*& vp) {
                           const u16* rp = brow + (long)(64 * j + r) * IN_COLS + C_DKV;
                           kp = rp;
                           vp = rp + 64;
                       },
                       [&](int j, int& lo, int& hl, u64& word) { lo = 0; hl = 0; word = lbits[qloc * 64 + j]; },
                       [&](int, f32x16&, f32x16&) {}, qr, m, l, o, bufs, w, lane);
    const float inv = l > 0.f ? 1.0f / l : 0.f;
    u16* orow = yb + ((long)b * SEQ + tl) * 512 + head * 64;
#pragma unroll
    for (int dh = 0; dh < 2; ++dh)
#pragma unroll
        for (int a = 0; a < 4; ++a) {
            uint2 v = uint2{pack2(o[dh][4 * a] * inv, o[dh][4 * a + 1] * inv), pack2(o[dh][4 * a + 2] * inv, o[dh][4 * a + 3] * inv)};
            *(uint2*)(orow + dh * 32 + 8 * a + 4 * hi) = v;
        }
}

__device__ __forceinline__ int grab_block(unsigned* ctr, int limit, unsigned char* smem) {
    volatile int* slot = (volatile int*)(smem + LDS_BYTES + 8);
    __syncthreads();
    if (threadIdx.x == 0) *slot = (int)__hip_atomic_fetch_add(ctr, 1u, __ATOMIC_RELAXED, __HIP_MEMORY_SCOPE_AGENT);
    __syncthreads();
    const int v = *slot;
    return v < limit ? v : -1;
}
__device__ __forceinline__ int grab_wave(unsigned* ctr, int limit) {
    int v = 0;
    if ((threadIdx.x & 63) == 0) v = (int)__hip_atomic_fetch_add(ctr, 1u, __ATOMIC_RELAXED, __HIP_MEMORY_SCOPE_AGENT);
    v = __builtin_amdgcn_readfirstlane(v);
    return v < limit ? v : -1;
}

#define PE_LD(Q, TB, E0)                                                                      \
    do {                                                                                      \
        asm volatile("" ::: "memory");                                                        \
        _Pragma("unroll") for (int k_ = 0; k_ < 4; ++k_) {                                    \
            const int e_ = (E0) + k_;                                                         \
            const int id_ = (e_ < 64) ? __builtin_amdgcn_readlane(id0, e_) : __builtin_amdgcn_readlane(id1, e_ - 64); \
            Q[k_] = *(const u32x4*)((TB) + (long)id_ * 1024 + lane * 16);                     \
        }                                                                                     \
        asm volatile("" ::: "memory");                                                        \
    } while (0)
#define PE_DOT(Q, PB)                                                                         \
    do {                                                                                      \
        _Pragma("unroll") for (int k_ = 0; k_ < 4; ++k_) {                                    \
            f32x2_t d2_ = {0.f, 0.f};     \
            _Pragma("unroll") for (int i_ = 0; i_ < 4; ++i_) {                                \
                f32x2_t lo_ = __builtin_amdgcn_cvt_pk_f32_fp8((int)Q[k_][i_], false);         \
                f32x2_t hi_ = __builtin_amdgcn_cvt_pk_f32_fp8((int)Q[k_][i_], true);          \
                d2_ += hf2[2 * i_] * lo_;                                                     \
                d2_ += hf2[2 * i_ + 1] * hi_;                                                 \
            }                                                                                 \
            pp[(PB) + k_] = d2_[0] + d2_[1];                                                  \
        }                                                                                     \
    } while (0)
#define PE_AXPY(Q, E0)                                                                        \
    do {                                                                                      \
        _Pragma("unroll") for (int k_ = 0; k_ < 4; ++k_) {                                    \
            const int e_ = (E0) + k_;                                                         \
            const float a_ = __int_as_float((e_ < 64) ? __builtin_amdgcn_readlane(__float_as_int(act0), e_)   \
                                                      : __builtin_amdgcn_readlane(__float_as_int(act1), e_ - 64)); \
            const f32x2_t a2_ = {a_, a_};                                                     \
            _Pragma("unroll") for (int i_ = 0; i_ < 4; ++i_) {                                \
                f32x2_t lo_ = __builtin_amdgcn_cvt_pk_f32_fp8((int)Q[k_][i_], false);         \
                f32x2_t hi_ = __builtin_amdgcn_cvt_pk_f32_fp8((int)Q[k_][i_], true);          \
                acc2[2 * i_] += a2_ * lo_;                                                    \
                acc2[2 * i_ + 1] += a2_ * hi_;                                                \
            }                                                                                 \
        }                                                                                     \
    } while (0)
template <int CTRL>
__device__ __forceinline__ float comb_q(float A, float B, bool bit) {
    const float keep = bit ? B : A, send = bit ? A : B;
    return keep + dpp_qf<CTRL>(send);
}
__device__ __forceinline__ float comb_x(float A, float B, bool bit, int xr) {
    const float keep = bit ? B : A, send = bit ? A : B;
    return keep + __shfl_xor(send, xr);
}
__device__ __forceinline__ float reduce32(float (&pp)[32], int lane) {
    const bool b0 = lane & 1, b1 = lane & 2, b2 = lane & 4, b3 = lane & 8;
#pragma unroll
    for (int j = 0; j < 16; ++j) pp[j] = comb_q<0xB1>(pp[2 * j], pp[2 * j + 1], b0);
#pragma unroll
    for (int j = 0; j < 8; ++j) pp[j] = comb_q<0x4E>(pp[2 * j], pp[2 * j + 1], b1);
#pragma unroll
    for (int j = 0; j < 4; ++j) pp[j] = comb_x(pp[2 * j], pp[2 * j + 1], b2, 4);
#pragma unroll
    for (int j = 0; j < 2; ++j) pp[j] = comb_x(pp[2 * j], pp[2 * j + 1], b3, 8);
    auto sw = __builtin_amdgcn_permlane16_swap(__float_as_uint(pp[0]), __float_as_uint(pp[1]), false, false);
    return xhalf_sum(__uint_as_float(sw[0]) + __uint_as_float(sw[1]));
}
__device__ __forceinline__ void peer_experts_range(unsigned char* ws, float* xout, int tbeg, int tend) {
    const int lane = tidx() & 63;
    const u16* hbuf = (const u16*)(ws + OFF_H);
    const unsigned char* ub = ws + OFF_UB;
    const unsigned char* vb = ws + OFF_VB;
    const int* eidx = (const int*)(ws + OFF_EIDX);
    const float* gate = (const float*)(ws + OFF_GATE);
    const float* usc = (const float*)(ws + OFF_ESC);
    const float* vsc = usc + NEXP;
    int t = tbeg;
    int id0 = 0, id1 = 0;
    float gr0 = 0.f, gr1 = 0.f;
    uint4 h0 = uint4{0u, 0u, 0u, 0u}, h1 = h0;
    u32x4 ua[4], ubq[4];
    if (t < tend) {
        id0 = eidx[(long)t * 128 + lane]; id1 = eidx[(long)t * 128 + 64 + lane];
        gr0 = gate[(long)t * 128 + lane]; gr1 = gate[(long)t * 128 + 64 + lane];
        h0 = *(const uint4*)(hbuf + (long)t * 1024 + lane * 16);
        h1 = *(const uint4*)(hbuf + (long)t * 1024 + lane * 16 + 8);
        PE_LD(ua, ub, 0);
    }
    while (t < tend) {
        const float g0 = gr0 * vsc[id0], g1 = gr1 * vsc[id1];
        const float s0 = usc[id0], s1 = usc[id1];
        float* xr = xout + (long)t * 1024 + lane * 16;
        f32x2_t hf2[8];
        hf2[0] = f32x2_t{bf_lo(h0.x), bf_hi(h0.x)}; hf2[1] = f32x2_t{bf_lo(h0.y), bf_hi(h0.y)};
        hf2[2] = f32x2_t{bf_lo(h0.z), bf_hi(h0.z)}; hf2[3] = f32x2_t{bf_lo(h0.w), bf_hi(h0.w)};
        hf2[4] = f32x2_t{bf_lo(h1.x), bf_hi(h1.x)}; hf2[5] = f32x2_t{bf_lo(h1.y), bf_hi(h1.y)};
        hf2[6] = f32x2_t{bf_lo(h1.z), bf_hi(h1.z)}; hf2[7] = f32x2_t{bf_lo(h1.w), bf_hi(h1.w)};
        const int tn = t + 1;
        int idn0 = 0, idn1 = 0;
        float gn0 = 0.f, gn1 = 0.f;
        uint4 hn0 = uint4{0u, 0u, 0u, 0u}, hn1 = hn0;
        if (tn < tend) {
            idn0 = eidx[(long)tn * 128 + lane]; idn1 = eidx[(long)tn * 128 + 64 + lane];
            gn0 = gate[(long)tn * 128 + lane]; gn1 = gate[(long)tn * 128 + 64 + lane];
            hn0 = *(const uint4*)(hbuf + (long)tn * 1024 + lane * 16);
            hn1 = *(const uint4*)(hbuf + (long)tn * 1024 + lane * 16 + 8);
        }
        float dq0 = 0.f, dq1 = 0.f, dq2 = 0.f, dq3 = 0.f;
        for (int gq = 0; gq < 4; ++gq) {
            const int e = 32 * gq;
            float pp[32];
#pragma unroll
            for (int q4 = 0; q4 < 32; q4 += 8) {
                PE_LD(ubq, ub, e + q4 + 4);
                PE_DOT(ua, q4);
                if (q4 + 8 < 32 || gq < 3) PE_LD(ua, ub, e + q4 + 8);
                else PE_LD(ua, vb, 0);
                PE_DOT(ubq, q4 + 4);
            }
            const float r = reduce32(pp, lane);
            dq0 = gq == 0 ? r : dq0;
            dq1 = gq == 1 ? r : dq1;
            dq2 = gq == 2 ? r : dq2;
            dq3 = gq == 3 ? r : dq3;
        }
        const float act0 = gelu_tanh((lane < 32 ? dq0 : dq1) * s0) * g0;
        const float act1 = gelu_tanh((lane < 32 ? dq2 : dq3) * s1) * g1;
        f32x2_t acc2[8];
#pragma unroll
        for (int i = 0; i < 8; ++i) acc2[i] = f32x2_t{0.f, 0.f};
        for (int b = 0; b < 32; b += 2) {
            PE_LD(ubq, vb, 4 * (b + 1));
            PE_AXPY(ua, 4 * b);
            if (b + 2 < 32) {
                PE_LD(ua, vb, 4 * (b + 2));
            } else if (tn < tend) {
                id0 = idn0; id1 = idn1;
                PE_LD(ua, ub, 0);
            }
            PE_AXPY(ubq, 4 * (b + 1));
        }
        float ss = 0.f;
        u32 pk[8];
#pragma unroll
        for (int i = 0; i < 4; ++i) {
            float4 a = *(const float4*)(xr + 4 * i);
            a.x += acc2[2 * i][0]; a.y += acc2[2 * i][1]; a.z += acc2[2 * i + 1][0]; a.w += acc2[2 * i + 1][1];
            *(float4*)(xr + 4 * i) = a;
            ss += a.x * a.x + a.y * a.y + a.z * a.z + a.w * a.w;
            pk[2 * i] = pack2(a.x, a.y);
            pk[2 * i + 1] = pack2(a.z, a.w);
        }
        u16* hw = (u16*)(ws + OFF_H) + (long)t * 1024 + lane * 16;
        *(uint4*)hw = uint4{pk[0], pk[1], pk[2], pk[3]};
        *(uint4*)(hw + 8) = uint4{pk[4], pk[5], pk[6], pk[7]};
        ss = wsum(ss);
        if (lane == 0) ((float*)(ws + OFF_RSTDE))[t] = rsqrtf(ss * (1.0f / 1024.0f) + EPS);
        t = tn; id0 = idn0; id1 = idn1; gr0 = gn0; gr1 = gn1; h0 = hn0; h1 = hn1;
    }
}

__device__ __forceinline__ u32 search_bounds(u32 lanemax, int& hb) {
    const u32 U = row_max16u(lanemax), L = row_min16u(lanemax);
    const u32 d = U ^ L;
    hb = d ? 31 - __clz((int)d) : -1;
    return d ? (U & ~((2u << hb) - 1u)) : U;
}
__device__ __forceinline__ void peer_route(unsigned char* ws, float* xout, int layer, unsigned char* smem, unsigned long long& tacc) {
    const int tid = tidx(), lane = tid & 63, w = tid >> 6;
    const int grp = lane >> 4, k = lane & 15;
    const u32 ltk = (1u << k) - 1u;
    const u16* pq = (const u16*)(ws + OFF_PQ);
    const u16* skb = (const u16*)(ws + OFF_W + layer * W_LAYER + WO_SK);
    int* eidx = (int*)(ws + OFF_EIDX);
    float* gate = (float*)(ws + OFF_GATE);
    float* tvc = (float*)(smem + w * 4096);
    int* tic = (int*)(smem + w * 4096 + 2048);
    unsigned* rctr = (unsigned*)(ws + OFF_CTR) + (layer * 8 + 3) * 8;
    for (int unit; (unit = grab_wave(rctr, NTOK / 16)) >= 0;) {
        const int tok0 = unit * 16;
        for (int h = 0; h < 8; ++h) {
            for (int half = 0; half < 2; ++half) {
                unsigned long long tr0 = SEC_T();
                bf16x8 af[4];
#pragma unroll
                for (int ks = 0; ks < 4; ++ks)
                    af[ks] = *(const bf16x8*)(pq + (long)(tok0 + k) * 2048 + h * 256 + half * 128 + ks * 32 + grp * 8);
                float sc[8][4];
                u32 u[8][4];
#pragma unroll
                for (int nt = 0; nt < 8; ++nt) {
                    f32x4 acc = f32x4{0.f, 0.f, 0.f, 0.f};
#pragma unroll
                    for (int ks = 0; ks < 4; ++ks) {
                        bf16x8 bfr = *(const bf16x8*)(skb + (size_t)half * 128 * 128 + (size_t)(nt * 16 + k) * 128 + ks * 32 + grp * 8);
                        acc = __builtin_amdgcn_mfma_f32_16x16x32_bf16(af[ks], bfr, acc, 0, 0, 0);
                    }
#pragma unroll
                    for (int i = 0; i < 4; ++i) { sc[nt][i] = acc[i]; u[nt][i] = sortkey(acc[i]); }
                }
                SEC_ADD(11, tr0);
                tr0 = SEC_T();
                u32 K[4];
                bool dn[4] = {false, false, false, false};
                int hbm = -1;
#pragma unroll
                for (int i = 0; i < 4; ++i) {
                    u32 lm = u[0][i];
#pragma unroll
                    for (int nt = 1; nt < 8; ++nt) lm = max(lm, u[nt][i]);
                    int hb;
                    K[i] = search_bounds(lm, hb);
                    hbm = max(hbm, hb);
                }
                const int bit0 = (int)wmax((float)hbm);
                for (int bit = bit0; bit >= 0; --bit) {
                    int packed = 0;
#pragma unroll
                    for (int i = 0; i < 4; ++i) {
                        const u32 cand = K[i] | (1u << bit);
                        int c = 0;
#pragma unroll
                        for (int nt = 0; nt < 8; ++nt) c += (u[nt][i] >= cand) ? 1 : 0;
                        packed |= c << (8 * i);
                    }
                    packed = row_sum16i(packed);
#pragma unroll
                    for (int i = 0; i < 4; ++i)
                        if (((packed >> (8 * i)) & 0xFF) >= 16) K[i] |= (1u << bit);
                    bool done = true;
#pragma unroll
                    for (int i = 0; i < 4; ++i) {
                        const int ci = (packed >> (8 * i)) & 0xFF;
                        done = done && (ci == 16 || dn[i]);
                        dn[i] = dn[i] || (ci == 16);
                    }
                    if (__all(done)) break;
                }
                SEC_ADD(12, tr0);
                tr0 = SEC_T();
                int need[4];
                {
                    int packed = 0;
#pragma unroll
                    for (int i = 0; i < 4; ++i) {
                        int c = 0;
#pragma unroll
                        for (int nt = 0; nt < 8; ++nt) c += (u[nt][i] > K[i]) ? 1 : 0;
                        packed |= c << (8 * i);
                    }
                    packed = row_sum16i(packed);
#pragma unroll
                    for (int i = 0; i < 4; ++i) need[i] = 16 - ((packed >> (8 * i)) & 0xFF);
                }
#pragma unroll
                for (int i = 0; i < 4; ++i) {
                    int ebase = 0, pbase = 0;
                    const int tok = 4 * grp + i;
#pragma unroll
                    for (int nt = 0; nt < 8; ++nt) {
                        const bool eq = (u[nt][i] == K[i]);
                        const u32 emg = (u32)(__ballot(eq) >> (lane & 48)) & 0xFFFFu;
                        const int erank = ebase + __popc(emg & ltk);
                        const bool take = (u[nt][i] > K[i]) || (eq && erank < need[i]);
                        ebase += __popc(emg);
                        const u32 tmg = (u32)(__ballot(take) >> (lane & 48)) & 0xFFFFu;
                        const int pos = pbase + __popc(tmg & ltk);
                        if (take) {
                            tvc[(half * 16 + tok) * 16 + pos] = sc[nt][i];
                            tic[(half * 16 + tok) * 16 + pos] = nt * 16 + k;
                        }
                        pbase += __popc(tmg);
                    }
                }
                SEC_ADD(13, tr0);
            }
            WAVE_SYNC();
            unsigned long long tr2 = SEC_T();
            for (int pass = 0; pass < 4; ++pass) {
                const int tok = 4 * pass + grp;
                const float v1 = tvc[(0 * 16 + tok) * 16 + k];
                const int i1 = tic[(0 * 16 + tok) * 16 + k];
                float c[16];
                u32 uc[16];
#pragma unroll
                for (int r4 = 0; r4 < 4; ++r4) {
                    float4 v2 = *(const float4*)(tvc + (1 * 16 + tok) * 16 + r4 * 4);
                    c[r4 * 4 + 0] = v1 + v2.x;
                    c[r4 * 4 + 1] = v1 + v2.y;
                    c[r4 * 4 + 2] = v1 + v2.z;
                    c[r4 * 4 + 3] = v1 + v2.w;
                }
                float mxl = c[0];
#pragma unroll
                for (int r = 0; r < 16; ++r) { uc[r] = sortkey(c[r]); mxl = fmaxf(mxl, c[r]); }
                const float mx = row_max16f(mxl);
                int hbc;
                u32 Kc = search_bounds(sortkey(mxl), hbc);
                bool dnc = false;
                const int bitc0 = (int)wmax((float)hbc);
                for (int bit = bitc0; bit >= 0; --bit) {
                    const u32 cand = Kc | (1u << bit);
                    int cn = 0;
#pragma unroll
                    for (int r = 0; r < 16; ++r) cn += (uc[r] >= cand) ? 1 : 0;
                    cn = row_sum16i(cn);
                    if (cn >= 16) Kc = cand;
                    dnc = dnc || (cn == 16);
                    if (__all(dnc)) break;
                }
                int cgl = 0, cel = 0;
#pragma unroll
                for (int r = 0; r < 16; ++r) { cgl += (uc[r] > Kc) ? 1 : 0; cel += (uc[r] == Kc) ? 1 : 0; }
                const int needc = 16 - row_sum16i(cgl);
                const int ebefore = row_xscan16i(cel);
                int tl_ = 0, el_ = 0;
                u32 takem = 0u;
                float ex[16];
                float sl = 0.f;
#pragma unroll
                for (int r = 0; r < 16; ++r) {
                    const bool eq = (uc[r] == Kc);
                    const bool tk = (uc[r] > Kc) || (eq && (ebefore + el_) < needc);
                    el_ += eq ? 1 : 0;
                    tl_ += tk ? 1 : 0;
                    takem |= tk ? (1u << r) : 0u;
                    ex[r] = tk ? __expf(c[r] - mx) : 0.f;
                    sl += ex[r];
                }
                const float inv = 1.0f / row_sum16f(sl);
                int pos = row_xscan16i(tl_);
                const long obase = (long)(tok0 + tok) * 128 + h * 16;
                int i2v[16];
#pragma unroll
                for (int r4 = 0; r4 < 4; ++r4) {
                    const int4 q = *(const int4*)(tic + (1 * 16 + tok) * 16 + r4 * 4);
                    i2v[r4 * 4 + 0] = q.x; i2v[r4 * 4 + 1] = q.y; i2v[r4 * 4 + 2] = q.z; i2v[r4 * 4 + 3] = q.w;
                }
#pragma unroll
                for (int r = 0; r < 16; ++r) {
                    if ((takem >> r) & 1u) {
                        const int eid = i1 * 128 + i2v[r];
                        eidx[obase + pos] = eid;
                        gate[obase + pos] = ex[r] * inv;
                        ++pos;
                    }
                }
            }
            SEC_ADD(14, tr2);
            WAVE_SYNC();
        }
        asm volatile("s_waitcnt vmcnt(0)" ::: "memory");
        peer_experts_range(ws, xout, tok0, tok0 + 16);
    }
}

__device__ __forceinline__ void phase_prep(const Params& P, unsigned char* smem) {
    unsigned char* ws = opq(P.ws);
    const long gtid = (long)bidx() * 256 + tidx();
    const long gthreads = (long)gdim() * 256;
    for (int l = 0; l < 2; ++l) {
        unsigned char* wl = ws + OFF_W + l * W_LAYER;
        float* tile = (float*)smem;
        transpose_cvt<true>(P.w_in + (size_t)l * 1024 * IN_COLS, (u16*)(wl + WO_WIN), 1024, IN_COLS, tile, P.attn_norm + l * 1024);
        for (int c = 0; c < 2; ++c) {
            transpose_cvt(P.cmp_w1 + ((size_t)l * 2 + c) * 2048 * 256, (u16*)(wl + WO_W1) + (size_t)c * 256 * 2048, 2048, 256, tile);
            transpose_cvt(P.cmp_w2 + ((size_t)l * 2 + c) * 256 * 64, (u16*)(wl + WO_W2) + (size_t)c * 64 * 256, 256, 64, tile);
        }
        transpose_cvt(P.w_a + (size_t)l * 512 * 1024, (u16*)(wl + WO_WA), 512, 1024, tile);
        transpose_cvt(P.w_b + (size_t)l * 512 * 1024, (u16*)(wl + WO_WB), 512, 1024, tile);
        transpose_cvt(P.w_out + (size_t)l * 1024 * 1024, (u16*)(wl + WO_WO), 1024, 1024, tile);
        transpose_cvt(P.peer_wq + (size_t)l * 1024 * 2048, (u16*)(wl + WO_WQ), 1024, 2048, tile);
        transpose_cvt(P.ple_w + (size_t)l * 256 * 1024, (u16*)(wl + WO_PW), 256, 1024, tile);
        transpose_cvt(P.ple_gw + (size_t)l * 1024 * 1024, (u16*)(wl + WO_PG), 1024, 1024, tile);
        cvt_f32_bf16(P.peer_sk + (size_t)l * 2 * 128 * 128, (u16*)(wl + WO_SK), 2 * 128 * 128);
    }
    for (int u = bidx(); u < 64; u += gdim()) {
        const int l = u >> 5, c = (u >> 4) & 1, kq = u & 15, col = tidx();
        const float* pos = P.cmp_pos + ((size_t)l * 2 + c) * 2048 + kq * 128;
        const float* w1 = P.cmp_w1 + ((size_t)l * 2 + c) * 2048 * 256 + (size_t)kq * 128 * 256;
        float s = 0.f;
#pragma unroll 16
        for (int k = 0; k < 128; ++k) s += pos[k] * w1[(size_t)k * 256 + col];
        ((float*)(ws + OFF_CHID))[(size_t)u * 256 + col] = s;
    }
    {
        float* ropec = (float*)(ws + OFF_ROPE);
        float* ropes = ropec + (size_t)NTOK * 8;
        for (long i = gtid; i < (long)NTOK * 8; i += gthreads) {
            int t = (int)(i >> 3), k = (int)(i & 7);
            double inv = pow(500000.0, -(double)k / 8.0);
            double ang = (double)P.positions[t] * inv;
            ropec[i] = (float)cos(ang);
            ropes[i] = (float)sin(ang);
        }
    }
    {
        const int lane = tidx() & 63;
        u16* xb = (u16*)(ws + OFF_YAB);
        float* ssa = (float*)(ws + OFF_SSA);
        for (int row = bidx() * 4 + (tidx() >> 6); row < NTOK; row += gdim() * 4) {
            const float* xr = P.x + (long)row * 1024;
            float ss = 0.f;
#pragma unroll
            for (int i = 0; i < 4; ++i) {
                const float4 v = *(const float4*)(xr + i * 256 + lane * 4);
                ss += v.x * v.x + v.y * v.y + v.z * v.z + v.w * v.w;
                *(uint2*)(xb + (long)row * 1024 + i * 256 + lane * 4) = uint2{pack2(v.x, v.y), pack2(v.z, v.w)};
            }
            ss = wsum(ss);
            if (lane < 16) ssa[(long)row * 16 + lane] = lane == 0 ? ss : 0.f;
        }
    }
}

__device__ __forceinline__ void phase_g1(const Params& P, int layer, unsigned char* smem) {
    unsigned char* ws = opq(P.ws);
    u16* proj = (u16*)(ws + OFF_PROJ);
    const float* ropec = (const float*)(ws + OFF_ROPE);
    const float* ropes = ropec + (size_t)NTOK * 8;
    const float* ng = P.nsa_gain + layer * 256;
    const float* dg = P.dsa_gain + layer * 128;
    if (layer == 0 && bidx() < 4) {
        const int l = bidx() >> 1, c = bidx() & 1, col = tidx();
        const float* part = (const float*)(ws + OFF_CHID) + (size_t)(l * 32 + c * 16) * 256 + col;
        float sacc = 0.f;
#pragma unroll
        for (int kq = 0; kq < 16; ++kq) sacc += part[kq * 256];
        ((float*)(ws + OFF_W + l * W_LAYER + WO_CB))[c * 256 + col] = sacc;
    }
    const float* ssa = (const float*)(ws + OFF_SSA) + (size_t)layer * NTOK * 16;
    gemm_phase_rs<0, true>((const u16*)(ws + OFF_YAB), 1024, (const u16*)(ws + OFF_W + layer * W_LAYER + WO_WIN), 1024, NTOK, IN_COLS, 1024, smem,
                  [=](int row) { return float2{rsqrtf(sum16(ssa + (long)row * 16) * (1.0f / 1024.0f) + EPS), 0.f}; },
                  [=](int row, int col, const float (&v)[8], float2 rs) {
                      const int c64 = col >> 6, cc = (col >> 3) & 7;
                      const float rsx = rs.x;
                      float o[8];
#pragma unroll
                      for (int j = 0; j < 8; ++j) o[j] = v[j] * rsx;
                      const float* gain = nullptr;
                      bool rope = false, sig = false;
                      float scale = 1.0f;
                      if (c64 < 8) { gain = ng; rope = true; scale = 0.125f * 1.4426950408889634f; }
                      else if (c64 < 20) { const int c = (c64 - 8) >> 1; if (c == 2) { gain = ng + 128; rope = true; } else if (c == 4) { gain = ng + 192; rope = true; } }
                      else if (c64 < 28) { gain = dg; rope = true; scale = 0.125f * 1.4426950408889634f; }
                      else if (c64 == 28) { gain = dg + 64; rope = true; }
                      else if (c64 == 29) { }
                      else if (c64 < 38) { rope = true; scale = 0.125f; }
                      else if (c64 == 38) { rope = true; }
                      else if (c64 < 71) { sig = true; }
                      else { sig = (col < C_IW); }
                      if (gain) {
                          float ss = 0.f;
#pragma unroll
                          for (int j = 0; j < 8; ++j) ss += o[j] * o[j];
                          ss += dpp_qf<0xB1>(ss);
                          ss += dpp_qf<0x4E>(ss);
                          ss += __shfl_xor(ss, 4);
                          const float rstd = rsqrtf(ss * (1.0f / 64.0f) + EPS);
                          const float4 g0 = *(const float4*)(gain + cc * 8), g1 = *(const float4*)(gain + cc * 8 + 4);
                          o[0] *= rstd * g0.x; o[1] *= rstd * g0.y; o[2] *= rstd * g0.z; o[3] *= rstd * g0.w;
                          o[4] *= rstd * g1.x; o[5] *= rstd * g1.y; o[6] *= rstd * g1.z; o[7] *= rstd * g1.w;
                      }
                      if (rope) {
                          float pr[8];
#pragma unroll
                          for (int j = 0; j < 8; ++j) pr[j] = dpp_qf<0xB1>(o[j]);
                          if (cc < 2) {
                              const float4 c0 = *(const float4*)(ropec + (long)row * 8), c1 = *(const float4*)(ropec + (long)row * 8 + 4);
                              const float4 s0 = *(const float4*)(ropes + (long)row * 8), s1 = *(const float4*)(ropes + (long)row * 8 + 4);
                              const float cs[8] = {c0.x, c0.y, c0.z, c0.w, c1.x, c1.y, c1.z, c1.w};
                              const float sn[8] = {s0.x, s0.y, s0.z, s0.w, s1.x, s1.y, s1.z, s1.w};
#pragma unroll
                              for (int j = 0; j < 8; ++j) o[j] = (cc == 0) ? (o[j] * cs[j] - pr[j] * sn[j]) : (o[j] * cs[j] + pr[j] * sn[j]);
                          }
                      }
                      if (sig) {
#pragma unroll
                          for (int j = 0; j < 8; ++j) o[j] = sigmoidf(o[j]);
                      }
#pragma unroll
                      for (int j = 0; j < 8; ++j) o[j] *= scale;
                      st_bf8(proj + (long)row * IN_COLS + col, o);
                  });
}

__device__ __forceinline__ void phase_c1(const Params& P, int layer, unsigned char* smem) {
    unsigned char* ws = opq(P.ws);
    unsigned char* wl = ws + OFF_W + layer * W_LAYER;
    const u16* proj = (const u16*)(ws + OFF_PROJ);
    u16* chid = (u16*)(ws + OFF_CHID);
    const float* cbias = (const float*)(wl + WO_CB);
    for (int c = 0; c < 2; ++c) {
        u16* ch = chid + (size_t)c * CROWS * 256;
        const float* cb = cbias + c * 256;
        gemm_phase<1>(proj + C_NKV + c * 128, 0, (const u16*)(wl + WO_W1) + (size_t)c * 256 * 2048, 2048, CROWS, 256, 2048, smem,
                      [=](int row, int col, const float (&v)[8]) {
                          float o[8];
#pragma unroll
                          for (int j = 0; j < 8; ++j) o[j] = gelu_tanh(v[j] + cb[col + j]);
                          st_bf8(ch + (long)row * 256 + col, o);
                      });
    }
}

__device__ __forceinline__ void phase_c2(const Params& P, int layer, unsigned char* smem) {
    unsigned char* ws = opq(P.ws);
    unsigned char* wl = ws + OFF_W + layer * W_LAYER;
    const u16* chid = (const u16*)(ws + OFF_CHID);
    u16* kcb = (u16*)(ws + OFF_KCB);
    u16* vcb = (u16*)(ws + OFF_VCB);
    const float* ropec = (const float*)(ws + OFF_ROPE);
    const float* ropes = ropec + (size_t)NTOK * 8;
    const float* gain = P.nsa_gain + layer * 256 + 64;
    for (int c = 0; c < 2; ++c) {
        u16* dst = c == 0 ? kcb : vcb;
        gemm_phase<0>(chid + (size_t)c * CROWS * 256, 256, (const u16*)(wl + WO_W2) + (size_t)c * 64 * 256, 256, CROWS, 64, 256, smem,
                      [=](int row, int col, const float (&v)[8]) {
                          const int b = row / (NCMP * 2);
                          const int rem = row - b * (NCMP * 2);
                          const int n = rem >> 1, g = rem & 1;
                          const int cc = col >> 3;
                          float o[8];
#pragma unroll
                          for (int j = 0; j < 8; ++j) o[j] = v[j];
                          if (c == 0) {
                              float ss = 0.f;
#pragma unroll
                              for (int j = 0; j < 8; ++j) ss += o[j] * o[j];
                              ss += dpp_qf<0xB1>(ss);
                              ss += dpp_qf<0x4E>(ss);
                              ss += __shfl_xor(ss, 4);
                              const float rstd = rsqrtf(ss * (1.0f / 64.0f) + EPS);
#pragma unroll
                              for (int j = 0; j < 8; ++j) o[j] *= rstd * gain[cc * 8 + j];
                              float pr[8];
#pragma unroll
                              for (int j = 0; j < 8; ++j) pr[j] = dpp_qf<0xB1>(o[j]);
                              if (cc < 2) {
                                  const long tt = (long)b * SEQ + 31 + 16 * n;
#pragma unroll
                                  for (int j = 0; j < 8; ++j) {
                                      const float cs = ropec[tt * 8 + j], sn = ropes[tt * 8 + j];
                                      o[j] = (cc == 0) ? (o[j] * cs - pr[j] * sn) : (o[j] * cs + pr[j] * sn);
                                  }
                              }
                          }
                          st_bf8(dst + ((size_t)(b * 2 + g) * 256 + n) * 64 + col, o);
                      });
    }
}

__device__ __forceinline__ int balance4(int x, int seg) {
    const int k = x / seg, r = x - k * seg;
    return k == 0 ? r : (k == 1 ? 4 * seg - 1 - r : (k == 2 ? seg + r : 3 * seg - 1 - r));
}
__device__ __forceinline__ void phase_att_a(const Params& P, int layer, unsigned char* smem, unsigned long long& tacc) {
    unsigned char* ws = opq(P.ws);
    unsigned* ctr = (unsigned*)(ws + OFF_CTR) + (layer * 8 + 0) * 8;
    const int label = bidx() & 7;
    for (int s8 = 0; s8 < 8; ++s8) {
        const int q = (label + s8) & 7;
        int idx;
        while ((idx = grab_block(ctr + q, 1024, smem)) >= 0) dsa_select_unit(ws, q * 1024 + (1023 - idx), smem, tacc);
    }
}
__device__ __forceinline__ void phase_att_b(const Params& P, int layer, unsigned char* smem) {
    const int label = bidx() & 7;
    {
        unsigned char* ws = opq(P.ws);
        unsigned* ctr = (unsigned*)(ws + OFF_CTR) + (layer * 8 + 1) * 8;
        for (int s8 = 0; s8 < 8; ++s8) {
            const int q = (label + s8) & 7;
            int idx;
            while ((idx = grab_block(ctr + q, 256, smem)) >= 0) dsa_attn_unit(ws, q, 255 - idx, smem);
        }
    }
    {
        unsigned char* ws = opq(P.ws);
        unsigned* ctr = (unsigned*)(ws + OFF_CTR) + (layer * 8 + 2) * 8;
        for (int s8 = 0; s8 < 8; ++s8) {
            const int q = (label + s8) & 7;
            int idx;
            while ((idx = grab_block(ctr + q, 256, smem)) >= 0) {
                const int ub = q + 8 * (idx & 1);
                nsa_unit(ws, ub >> 1, ub & 1, 127 - (idx >> 1), smem);
            }
        }
    }
}

__device__ __forceinline__ void phase_merge(const Params& P, int layer, unsigned char* smem) {
    unsigned char* ws = opq(P.ws);
    unsigned char* wl = ws + OFF_W + layer * W_LAYER;
    const u16* proj = (const u16*)(ws + OFF_PROJ);
    u16* hbuf = (u16*)(ws + OFF_H);
    const u16* ya = (const u16*)(ws + OFF_YAB);
    const u16* yb = ya + (size_t)NTOK * 512;
    gemm_phase<0>(ya, 512, (const u16*)(wl + WO_WA), 512, NTOK, 1024, 512, smem, [=](int row, int col, const float (&v)[8]) {
        float ga[8], o[8];
        ld_bf8(proj + (long)row * IN_COLS + C_MG + col, ga);
#pragma unroll
        for (int j = 0; j < 8; ++j) o[j] = ga[j] * v[j];
        st_bf8(hbuf + (long)row * 1024 + col, o);
    });
    gemm_phase<0>(yb, 512, (const u16*)(wl + WO_WB), 512, NTOK, 1024, 512, smem, [=](int row, int col, const float (&v)[8]) {
        float gb[8], o[8];
        ld_bf8(proj + (long)row * IN_COLS + C_MG + 1024 + col, gb);
        ld_bf8(hbuf + (long)row * 1024 + col, o);
#pragma unroll
        for (int j = 0; j < 8; ++j) o[j] += gb[j] * v[j];
        st_bf8(hbuf + (long)row * 1024 + col, o);
    });
}

__device__ __forceinline__ void phase_outproj(const Params& P, int layer, unsigned char* smem) {
    unsigned char* ws = opq(P.ws);
    unsigned char* wl = ws + OFF_W + layer * W_LAYER;
    float* out = opq(P.out);
    const float* xin = (layer == 0) ? P.x : (const float*)out;
    const bool gemm_first = bidx() < (gdim() >> 1);
    for (int step = 0; step < 2; ++step) {
        if ((step == 0) == gemm_first) {
            gemm_phase<0>((const u16*)(ws + OFF_H), 1024, (const u16*)(wl + WO_WO), 1024, NTOK, 1024, 1024, smem, [=](int row, int col, const float (&v)[8]) {
                const long o = (long)row * 1024 + col;
                const float4 x0 = *(const float4*)(xin + o), x1 = *(const float4*)(xin + o + 4);
                *(float4*)(out + o) = float4{x0.x + v[0], x0.y + v[1], x0.z + v[2], x0.w + v[3]};
                *(float4*)(out + o + 4) = float4{x1.x + v[4], x1.y + v[5], x1.z + v[6], x1.w + v[7]};
            });
        } else {
            cvt_f32_bf16(P.p + (size_t)layer * NTOK * 256, (u16*)(ws + OFF_PBF), (long)NTOK * 256);
            cvt_rows_fp8(P.peer_u + (size_t)layer * NEXP * 1024, ws + OFF_UB, (float*)(ws + OFF_ESC), NEXP);
            cvt_rows_fp8(P.peer_v + (size_t)layer * NEXP * 1024, ws + OFF_VB, (float*)(ws + OFF_ESC) + NEXP, NEXP);
        }
    }
}

__device__ __forceinline__ void phase_pq(const Params& P, int layer, unsigned char* smem) {
    unsigned char* ws = opq(P.ws);
    unsigned char* wl = ws + OFF_W + layer * W_LAYER;
    u16* pq = (u16*)(ws + OFF_PQ);
    u16* eb = (u16*)(ws + OFF_YAB);
    gemm_phase<0>((const u16*)(ws + OFF_H), 1024, (const u16*)(wl + WO_WQ), 1024, NTOK, 2048, 1024, smem,
                  [=](int row, int col, const float (&v)[8]) { st_bf8(pq + (long)row * 2048 + col, v); });
    float* sse = (float*)(ws + OFF_SSE) + (size_t)layer * NTOK * 16;
    gemm_phase<0>((const u16*)(ws + OFF_PBF), 256, (const u16*)(wl + WO_PW), 256, NTOK, 1024, 256, smem,
                  [=](int row, int col, const float (&v)[8]) {
                      st_bf8(eb + (long)row * 1024 + col, v);
                      float ss = 0.f;
#pragma unroll
                      for (int j = 0; j < 8; ++j) ss += v[j] * v[j];
                      ss += dpp_qf<0xB1>(ss);
                      ss += dpp_qf<0x4E>(ss);
                      ss += __shfl_xor(ss, 4);
                      if ((col & 63) == 0) sse[(long)row * 16 + (col >> 6)] = ss;
                  });
}

__device__ __forceinline__ void phase_final(const Params& P, int layer, unsigned char* smem) {
    unsigned char* ws = opq(P.ws);
    unsigned char* wl = ws + OFF_W + layer * W_LAYER;
    float* out = opq(P.out);
    u16* eb = (u16*)(ws + OFF_YAB);
    const float* rstd2 = (const float*)(ws + OFF_RSTDE);
    const float* sse = (const float*)(ws + OFF_SSE) + (size_t)layer * NTOK * 16;
    float* ssn = (float*)(ws + OFF_SSA) + (size_t)NTOK * 16;
    const float* pn = P.ple_norm + layer * 1024;
    const bool more = layer == 0;
    gemm_phase_rs<0, true>((const u16*)(ws + OFF_H), 1024, (const u16*)(wl + WO_PG), 1024, NTOK, 1024, 1024, smem,
        [=](int row) { return float2{rstd2[row], rsqrtf(sum16(sse + (long)row * 16) * (1.0f / 1024.0f) + EPS)}; },
        [=](int row, int col, const float (&v)[8], float2 rs) {
        const long o = (long)row * 1024 + col;
        float e[8];
        ld_bf8(eb + o, e);
        const float rx = rs.x;
        const float re = rs.y;
        const float4 x0 = *(const float4*)(out + o), x1 = *(const float4*)(out + o + 4);
        const float4 p0 = *(const float4*)(pn + col), p1 = *(const float4*)(pn + col + 4);
        const float xs[8] = {x0.x, x0.y, x0.z, x0.w, x1.x, x1.y, x1.z, x1.w};
        const float ps[8] = {p0.x, p0.y, p0.z, p0.w, p1.x, p1.y, p1.z, p1.w};
        float y[8];
        float ss = 0.f;
#pragma unroll
        for (int j = 0; j < 8; ++j) {
            y[j] = xs[j] + sigmoidf(v[j] * rx) * (e[j] * re * ps[j]);
            ss += y[j] * y[j];
        }
        *(float4*)(out + o) = float4{y[0], y[1], y[2], y[3]};
        *(float4*)(out + o + 4) = float4{y[4], y[5], y[6], y[7]};
        if (more) {
            st_bf8(eb + o, y);
            ss += dpp_qf<0xB1>(ss);
            ss += dpp_qf<0x4E>(ss);
            ss += __shfl_xor(ss, 4);
            if ((col & 63) == 0) ssn[(long)row * 16 + (col >> 6)] = ss;
        }
    });
}


#define XB_TMO      128
#define XB_XCNT(j)  (256  + 64 * (j))
#define XB_XSUB(j)  (1280 + 64 * (j))
#define XB_XGEN(j)  (2304 + 64 * (j))
#define XB_TOP      3328
#define XB_TOPGEN   3392
#define XCD_BAR_WORDS 3456
#define XB_SPIN_CAP (1u << 22)
#define LAS __attribute__((address_space(3)))
__device__ __forceinline__ unsigned xb_ld(unsigned* p) { return __hip_atomic_load(p, __ATOMIC_RELAXED, __HIP_MEMORY_SCOPE_AGENT); }
__device__ __forceinline__ unsigned xb_add(unsigned* p, unsigned v) { return __hip_atomic_fetch_add(p, v, __ATOMIC_RELAXED, __HIP_MEMORY_SCOPE_AGENT); }
__device__ __forceinline__ unsigned xb_xcc_id() { return (unsigned)__builtin_amdgcn_s_getreg((3 << 11) | 20) & 0xFu; }
#define XB_SPIN(cond, bar) do { unsigned _sp = 0; while (cond) { __builtin_amdgcn_s_sleep(1); \
    if ((++_sp & 255u) == 0u) { if (xb_ld(&(bar)[XB_TMO])) break; if (_sp > XB_SPIN_CAP) { atomicAdd(&(bar)[XB_TMO], 1u); break; } } } } while (0)
struct XcdBarrier {
    unsigned* bar; unsigned x;
    volatile LAS unsigned* st;
};
__device__ __forceinline__ XcdBarrier xcd_barrier_post(unsigned* bar, volatile LAS unsigned* st) {
    XcdBarrier b; b.bar = bar; b.x = xb_xcc_id(); b.st = st;
    if (threadIdx.x == 0) (void)xb_add(&bar[XB_XCNT(b.x)], 1u);
    return b;
}
__device__ __forceinline__ void xcd_barrier_complete(unsigned* bar, unsigned x, unsigned& nloc, unsigned& nx) {
    const unsigned G = gridDim.x * gridDim.y * gridDim.z;
    unsigned sum, cnt, mine, sp = 0u;
    for (;;) {
        sum = 0u; cnt = 0u; mine = 0u;
#pragma unroll
        for (unsigned j = 0; j < 16; ++j) { const unsigned c = xb_ld(&bar[XB_XCNT(j)]); sum += c; cnt += (c > 0u) ? 1u : 0u; mine = (j == x) ? c : mine; }
        if (sum == G) break;
        __builtin_amdgcn_s_sleep(1);
        if ((++sp & 255u) == 0u) { if (xb_ld(&bar[XB_TMO])) break; if (sp > XB_SPIN_CAP) { atomicAdd(&bar[XB_TMO], 1u); break; } }
    }
    nloc = mine > 0u ? mine : 1u; nx = cnt > 0u ? cnt : 1u;
}
__device__ __forceinline__ void xcd_barrier(const XcdBarrier& b) {
    asm volatile("s_waitcnt vmcnt(0)" ::: "memory");
    __syncthreads();
    if (threadIdx.x == 0) {
        unsigned* bar = b.bar;
        __builtin_amdgcn_s_waitcnt(0);
        unsigned nloc = b.st[0], nx = b.st[1];
        if (nloc == 0u) { xcd_barrier_complete(bar, b.x, nloc, nx); b.st[0] = nloc; b.st[1] = nx; }
        const unsigned old = xb_add(&bar[XB_XSUB(b.x)], 1u);
        const unsigned gen = old / nloc;
        if (old + 1u == (gen + 1u) * nloc) {
            __builtin_amdgcn_fence(__ATOMIC_RELEASE, "agent");
            asm volatile("s_waitcnt vmcnt(0)" ::: "memory");
            const unsigned og = xb_add(&bar[XB_TOP], 1u);
            const unsigned tg = og / nx;
            if (og + 1u == (tg + 1u) * nx) xb_add(&bar[XB_TOPGEN], 1u);
            else XB_SPIN(xb_ld(&bar[XB_TOPGEN]) == tg, bar);
            __builtin_amdgcn_fence(__ATOMIC_ACQUIRE, "agent");
            xb_add(&bar[XB_XGEN(b.x)], 1u);
            asm volatile("s_waitcnt vmcnt(0)" ::: "memory");
        } else {
            XB_SPIN(xb_ld(&bar[XB_XGEN(b.x)]) == gen, bar);
            __builtin_amdgcn_fence(__ATOMIC_ACQUIRE, "agent");
            asm volatile("s_waitcnt vmcnt(0)" ::: "memory");
        }
    }
    __syncthreads();
}

#ifndef PROBE_MASK
#define PROBE_MASK 0ull
#endif
#ifndef PROBE_MULT
#define PROBE_MULT 4
#endif
#define GSYNC(id)                                                                          \
    do {                                                                                   \
        xcd_barrier(xb);                                                                   \
        if (PROBE_MASK != 0ull) {                                                          \
            unsigned long long now_ = __builtin_amdgcn_s_memrealtime();                    \
            if ((PROBE_MASK >> (id)) & 1ull) tsel += now_ - tprev;                         \
            tprev = now_;                                                                  \
        }                                                                                  \
    } while (0)

__global__ void __launch_bounds__(256, 2)
fwd_kernel(const float* a_x, const float* a_p, const int* a_pos, const float* a_an, const float* a_win, const float* a_ng, const float* a_cp,
           const float* a_cw1, const float* a_cw2, const float* a_dg, const float* a_wa, const float* a_wb, const float* a_wo, const float* a_fn,
           const float* a_wq, const float* a_sk, const float* a_pu, const float* a_pv, const float* a_pw, const float* a_pgw, const float* a_pn,
           float* a_out, unsigned char* a_ws) {
    Params P;
    P.x = a_x; P.p = a_p; P.positions = a_pos; P.attn_norm = a_an; P.w_in = a_win; P.nsa_gain = a_ng; P.cmp_pos = a_cp; P.cmp_w1 = a_cw1;
    P.cmp_w2 = a_cw2; P.dsa_gain = a_dg; P.w_a = a_wa; P.w_b = a_wb; P.w_out = a_wo; P.ffn_norm = a_fn; P.peer_wq = a_wq; P.peer_sk = a_sk;
    P.peer_u = a_pu; P.peer_v = a_pv; P.ple_w = a_pw; P.ple_gw = a_pgw; P.ple_norm = a_pn; P.out = a_out; P.ws = a_ws;
    cg::grid_group grid = cg::this_grid();
    extern __shared__ __attribute__((aligned(16))) unsigned char smem[];
    unsigned long long tprev = 0, tsel = 0;
    if (PROBE_MASK != 0ull) tprev = __builtin_amdgcn_s_memrealtime();
    volatile LAS unsigned* xst = (volatile LAS unsigned*)(smem + LDS_BYTES);
    if (threadIdx.x == 0) { xst[0] = 0u; xst[1] = 0u; xst[2] = 0u; xst[3] = 0u; }
    __syncthreads();
    XcdBarrier xb = xcd_barrier_post((unsigned*)(P.ws + OFF_BAR), xst);
    phase_prep(P, smem);
    grid.sync();
    if (PROBE_MASK != 0ull) {
        unsigned long long now_ = __builtin_amdgcn_s_memrealtime();
        if (PROBE_MASK & 1ull) tsel += now_ - tprev;
        tprev = now_;
    }
    for (int layer = 0; layer < 2; ++layer) {
        const int pb = 1 + 16 * layer;
        phase_g1(P, layer, smem);
        GSYNC(pb + 0);
        phase_c1(P, layer, smem);
        phase_att_a(P, layer, smem, tsel);
        GSYNC(pb + 15);
        phase_c2(P, layer, smem);
        GSYNC(pb + 3);
        phase_att_b(P, layer, smem);
        GSYNC(pb + 5);
        phase_merge(P, layer, smem);
        GSYNC(pb + 6);
        phase_outproj(P, layer, smem);
        GSYNC(pb + 7);
        {
            unsigned char* ws = opq(P.ws);
            rms_rows(opq(P.out), P.ffn_norm + layer * 1024, (u16*)(ws + OFF_H), nullptr, nullptr);
        }
        GSYNC(pb + 8);
        phase_pq(P, layer, smem);
        GSYNC(pb + 9);
        peer_route(opq(P.ws), opq(P.out), layer, smem, tsel);
        GSYNC(pb + 11);
        phase_final(P, layer, smem);
        GSYNC(pb + 13);
    }
#ifndef PROBE_BLOCK
#define PROBE_BLOCK 0
#endif
    if (PROBE_MASK != 0ull || PROBE_SEC != 0) {
        if (blockIdx.x == PROBE_BLOCK && threadIdx.x == 0) {
            unsigned long long t0 = __builtin_amdgcn_s_memrealtime();
            while (__builtin_amdgcn_s_memrealtime() - t0 < (unsigned long long)PROBE_MULT * tsel) __builtin_amdgcn_s_sleep(32);
        }
    }
}

extern "C" void kernel_launch(void* const* d_in, const int* in_sizes, int n_in, void* d_out, int out_size, void* d_ws, size_t ws_size,
                              hipStream_t stream) {
    static int grid_blocks = 0;
    if (!grid_blocks) {
        int dev = 0, cus = 0, per_cu = 0;
        (void)hipGetDevice(&dev);
        (void)hipDeviceGetAttribute(&cus, hipDeviceAttributeMultiprocessorCount, dev);
        (void)hipFuncSetAttribute((const void*)fwd_kernel, hipFuncAttributeMaxDynamicSharedMemorySize, LDS_BYTES + 16);
        (void)hipOccupancyMaxActiveBlocksPerMultiprocessor(&per_cu, fwd_kernel, 256, LDS_BYTES + 16);
        if (per_cu > 2) per_cu = 2;
        if (per_cu < 1) per_cu = 1;
        grid_blocks = cus * per_cu;
        if (ws_size < WS_END) fprintf(stderr, "kernel_launch: workspace too small: %zu < %zu\n", ws_size, (size_t)WS_END);
    }
    Params P{};
    P.x = (const float*)d_in[0];
    P.p = (const float*)d_in[1];
    P.positions = (const int*)d_in[2];
    P.attn_norm = (const float*)d_in[3];
    P.w_in = (const float*)d_in[4];
    P.nsa_gain = (const float*)d_in[5];
    P.cmp_pos = (const float*)d_in[6];
    P.cmp_w1 = (const float*)d_in[7];
    P.cmp_w2 = (const float*)d_in[8];
    P.dsa_gain = (const float*)d_in[9];
    P.w_a = (const float*)d_in[10];
    P.w_b = (const float*)d_in[11];
    P.w_out = (const float*)d_in[12];
    P.ffn_norm = (const float*)d_in[13];
    P.peer_wq = (const float*)d_in[14];
    P.peer_sk = (const float*)d_in[15];
    P.peer_u = (const float*)d_in[16];
    P.peer_v = (const float*)d_in[17];
    P.ple_w = (const float*)d_in[18];
    P.ple_gw = (const float*)d_in[19];
    P.ple_norm = (const float*)d_in[20];
    P.out = (float*)d_out;
    P.ws = (unsigned char*)d_ws;
    void* args[] = {(void*)&P.x, (void*)&P.p, (void*)&P.positions, (void*)&P.attn_norm, (void*)&P.w_in, (void*)&P.nsa_gain, (void*)&P.cmp_pos,
                    (void*)&P.cmp_w1, (void*)&P.cmp_w2, (void*)&P.dsa_gain, (void*)&P.w_a, (void*)&P.w_b, (void*)&P.w_out, (void*)&P.ffn_norm,
                    (void*)&P.peer_wq, (void*)&P.peer_sk, (void*)&P.peer_u, (void*)&P.peer_v, (void*)&P.ple_w, (void*)&P.ple_gw,
                    (void*)&P.ple_norm, (void*)&P.out, (void*)&P.ws};
    (void)hipMemsetAsync((unsigned char*)d_ws + OFF_BAR, 0, 3456 * 4 + N_CTR * 4, stream);
    hipError_t e = hipLaunchCooperativeKernel((void*)fwd_kernel, dim3(grid_blocks), dim3(256), args, LDS_BYTES + 16, stream);
    if (e != hipSuccess) fprintf(stderr, "cooperative launch failed: %s (grid %d)\n", hipGetErrorString(e), grid_blocks);
}
```

```cpp
#include <hip/hip_runtime.h>
#include <hip/hip_cooperative_groups.h>
#include <cstdio>
#include <cstdint>
namespace cg = cooperative_groups;
#ifndef PROBE_SEC
#define PROBE_SEC 0
#endif
#define SEC_T() (PROBE_SEC ? __builtin_amdgcn_s_memrealtime() : 0ull)
#define SEC_ADD(k, t0) do { if (PROBE_SEC == (k)) { unsigned long long n_ = SEC_T(); tacc += n_ - (t0); } } while (0)

typedef unsigned short u16;
typedef unsigned int u32;
typedef unsigned long long u64;
using bf16x8 = __attribute__((ext_vector_type(8))) short;
using f32x4 = __attribute__((ext_vector_type(4))) float;
using f32x16 = __attribute__((ext_vector_type(16))) float;
typedef __bf16 bf16x2_t __attribute__((ext_vector_type(2)));

constexpr int D_MODEL = 1024, BATCH = 8, SEQ = 4096, NTOK = BATCH * SEQ;
constexpr int IN_COLS = 4576;
constexpr int C_NQ = 0, C_NKV = 512, C_DQ = 1280, C_DKV = 1792, C_IQ = 1920, C_IK = 2432, C_MG = 2496, C_NG = 4544, C_IW = 4568;
__host__ __device__ constexpr int perm_col(int n) {
    return n < 1280 ? n : n < 1304 ? 4544 + (n - 1280) : n < 1816 ? 1280 + (n - 1304) : n < 1944 ? 1792 + (n - 1816)
         : n < 2456 ? 1920 + (n - 1944) : n < 2520 ? 2432 + (n - 2456) : n < 2528 ? 4568 + (n - 2520) : 2496 + (n - 2528);
}
constexpr int NCMP = 255;
constexpr int CROWS = BATCH * NCMP * 2;
constexpr int NEXP = 16384;
constexpr float EPS = 1e-6f;

constexpr size_t AL(size_t x) { return (x + 255) & ~(size_t)255; }
constexpr size_t WO_WIN = 0;
constexpr size_t WO_W1 = WO_WIN + AL((size_t)IN_COLS * 1024 * 2);
constexpr size_t WO_W2 = WO_W1 + AL((size_t)2 * 256 * 2048 * 2);
constexpr size_t WO_WA = WO_W2 + AL((size_t)2 * 64 * 256 * 2);
constexpr size_t WO_WB = WO_WA + AL((size_t)1024 * 512 * 2);
constexpr size_t WO_WO = WO_WB + AL((size_t)1024 * 512 * 2);
constexpr size_t WO_WQ = WO_WO + AL((size_t)1024 * 1024 * 2);
constexpr size_t WO_PW = WO_WQ + AL((size_t)2048 * 1024 * 2);
constexpr size_t WO_PG = WO_PW + AL((size_t)1024 * 256 * 2);
constexpr size_t WO_SK = WO_PG + AL((size_t)1024 * 1024 * 2);
constexpr size_t WO_CB = WO_SK + AL((size_t)2 * 128 * 128 * 2);
constexpr size_t W_LAYER = WO_CB + AL((size_t)2 * 256 * 4);

constexpr size_t OFF_W = 0;
constexpr size_t OFF_ROPE = OFF_W + 2 * W_LAYER;
constexpr size_t OFF_H = OFF_ROPE + AL((size_t)NTOK * 16 * 4);
constexpr size_t OFF_PROJ = OFF_H + AL((size_t)NTOK * 1024 * 2);
constexpr size_t OFF_YAB = OFF_PROJ + AL((size_t)NTOK * IN_COLS * 2);
constexpr size_t OFF_CHID = OFF_YAB + AL((size_t)NTOK * 1024 * 2);
constexpr size_t OFF_CBUF = OFF_CHID + AL((size_t)2 * CROWS * 256 * 2);
constexpr size_t OFF_KCB = OFF_CBUF + AL((size_t)2 * CROWS * 64 * 4);
constexpr size_t OFF_VCB = OFF_KCB + AL((size_t)BATCH * 2 * 256 * 64 * 2);
constexpr size_t OFF_RSTDE = OFF_VCB + AL((size_t)BATCH * 2 * 256 * 64 * 2);
constexpr size_t OFF_SSA = OFF_RSTDE + AL((size_t)NTOK * 4);
constexpr size_t OFF_SSE = OFF_SSA + AL((size_t)2 * NTOK * 16 * 4);
constexpr size_t OFF_SS1 = OFF_SSE + AL((size_t)2 * NTOK * 16 * 4);
constexpr size_t OFF_BITS = OFF_SS1 + AL((size_t)NTOK * 16 * 4);
__device__ __forceinline__ float sum16(const float* p) {
    const float4 a = *(const float4*)p, b = *(const float4*)(p + 4), c = *(const float4*)(p + 8), d = *(const float4*)(p + 12);
    return ((a.x + a.y) + (a.z + a.w)) + ((b.x + b.y) + (b.z + b.w)) + (((c.x + c.y) + (c.z + c.w)) + ((d.x + d.y) + (d.z + d.w)));
}
constexpr size_t OFF_BAR = OFF_BITS + AL((size_t)NTOK * 64 * 8);
constexpr size_t OFF_CTR = OFF_BAR + 3456 * 4;
constexpr int N_CTR = 512;
constexpr size_t WS_END = OFF_CTR + AL(N_CTR * 4);
constexpr size_t OFF_PQ = OFF_PROJ;
constexpr size_t OFF_UB = OFF_PQ + (size_t)NTOK * 2048 * 2;
constexpr size_t OFF_VB = OFF_UB + (size_t)NEXP * 1024 * 2;
constexpr size_t OFF_EIDX = OFF_VB + (size_t)NEXP * 1024 * 2;
constexpr size_t OFF_GATE = OFF_EIDX + (size_t)NTOK * 128 * 4;
constexpr size_t OFF_ESC = OFF_GATE + (size_t)NTOK * 128 * 4;
constexpr size_t OFF_PBF = OFF_ESC + (size_t)2 * NEXP * 4;
constexpr size_t OFF_ESU = OFF_PBF + (size_t)NTOK * 256 * 2;
static_assert(OFF_ESU + (size_t)NTOK * 128 * 4 <= OFF_YAB, "alias overflow");

constexpr int LDS_BYTES = 65536 + 2048;

struct Params {
    const float* x; const float* p; const int* positions;
    const float* attn_norm; const float* w_in; const float* nsa_gain; const float* cmp_pos; const float* cmp_w1; const float* cmp_w2;
    const float* dsa_gain; const float* w_a; const float* w_b; const float* w_out; const float* ffn_norm; const float* peer_wq;
    const float* peer_sk; const float* peer_u; const float* peer_v; const float* ple_w; const float* ple_gw; const float* ple_norm;
    float* out; unsigned char* ws;
};

__device__ __forceinline__ u16 f2bf(float f) {
    u32 u = __float_as_uint(f);
    u32 r = u + 0x7FFFu + ((u >> 16) & 1u);
    return (u16)(r >> 16);
}
__device__ __forceinline__ float bf2f(u16 h) { return __uint_as_float(((u32)h) << 16); }
__device__ __forceinline__ float bf_lo(u32 w) { return __uint_as_float(w << 16); }
__device__ __forceinline__ float bf_hi(u32 w) { return __uint_as_float(w & 0xFFFF0000u); }
__device__ __forceinline__ u32 pack2(float a, float b) {
    u32 r;
    asm("v_cvt_pk_bf16_f32 %0, %1, %2" : "=v"(r) : "v"(a), "v"(b));
    return r;
}
__device__ __forceinline__ float dot2(u32 a, u32 b, float c) {
    return __builtin_amdgcn_fdot2_f32_bf16(__builtin_bit_cast(bf16x2_t, a), __builtin_bit_cast(bf16x2_t, b), c, false);
}
template <int CTRL>
__device__ __forceinline__ int dppi(int x) { return __builtin_amdgcn_update_dpp(x, x, CTRL, 0xF, 0xF, false); }
template <int CTRL>
__device__ __forceinline__ float dppf(float x) { return __int_as_float(dppi<CTRL>(__float_as_int(x))); }
__device__ __forceinline__ int row_sum16i(int x) {
    x += dppi<0x128>(x);
    x += dppi<0x124>(x);
    x += dppi<0x122>(x);
    x += dppi<0x121>(x);
    return x;
}
template <int CTRL>
__device__ __forceinline__ int dppi0(int x) { return __builtin_amdgcn_update_dpp(0, x, CTRL, 0xF, 0xF, true); }
__device__ __forceinline__ int row_xscan16i(int x) {
    int s = x;
    s += dppi0<0x111>(s);
    s += dppi0<0x112>(s);
    s += dppi0<0x114>(s);
    s += dppi0<0x118>(s);
    return s - x;
}
__device__ __forceinline__ float row_sum16f(float x) {
    x += dppf<0x128>(x);
    x += dppf<0x124>(x);
    x += dppf<0x122>(x);
    x += dppf<0x121>(x);
    return x;
}
__device__ __forceinline__ float row_max16f(float x) {
    x = fmaxf(x, dppf<0x128>(x));
    x = fmaxf(x, dppf<0x124>(x));
    x = fmaxf(x, dppf<0x122>(x));
    x = fmaxf(x, dppf<0x121>(x));
    return x;
}

__device__ __forceinline__ u32 row_max16u(u32 x) {
    x = max(x, (u32)dppi<0x128>((int)x));
    x = max(x, (u32)dppi<0x124>((int)x));
    x = max(x, (u32)dppi<0x122>((int)x));
    x = max(x, (u32)dppi<0x121>((int)x));
    return x;
}
__device__ __forceinline__ u32 row_min16u(u32 x) {
    x = min(x, (u32)dppi<0x128>((int)x));
    x = min(x, (u32)dppi<0x124>((int)x));
    x = min(x, (u32)dppi<0x122>((int)x));
    x = min(x, (u32)dppi<0x121>((int)x));
    return x;
}
template <int CTRL>
__device__ __forceinline__ float dpp_qf(float x) { return __int_as_float(__builtin_amdgcn_update_dpp(0, __float_as_int(x), CTRL, 0xF, 0xF, false)); }
__device__ __forceinline__ float wsum(float v) {
    v = row_sum16f(v);
    const float a = __int_as_float(__builtin_amdgcn_readlane(__float_as_int(v), 0));
    const float b = __int_as_float(__builtin_amdgcn_readlane(__float_as_int(v), 16));
    const float c = __int_as_float(__builtin_amdgcn_readlane(__float_as_int(v), 32));
    const float d = __int_as_float(__builtin_amdgcn_readlane(__float_as_int(v), 48));
    return (a + b) + (c + d);
}
__device__ __forceinline__ float wmax(float v) {
    v = row_max16f(v);
    const float a = __int_as_float(__builtin_amdgcn_readlane(__float_as_int(v), 0));
    const float b = __int_as_float(__builtin_amdgcn_readlane(__float_as_int(v), 16));
    const float c = __int_as_float(__builtin_amdgcn_readlane(__float_as_int(v), 32));
    const float d = __int_as_float(__builtin_amdgcn_readlane(__float_as_int(v), 48));
    return fmaxf(fmaxf(a, b), fmaxf(c, d));
}
__device__ __forceinline__ int wsumi(int v) {
    v = row_sum16i(v);
    return __builtin_amdgcn_readlane(v, 0) + __builtin_amdgcn_readlane(v, 16) + __builtin_amdgcn_readlane(v, 32) + __builtin_amdgcn_readlane(v, 48);
}
__device__ __forceinline__ float sigmoidf(float x) { return 1.0f / (1.0f + __expf(-x)); }
__device__ __forceinline__ float gelu_tanh(float x) {
    float u = 0.7978845608028654f * (x + 0.044715f * x * x * x);
    return 0.5f * x * (1.0f + tanhf(u));
}
__device__ __forceinline__ u32 sortkey(float f) {
    u32 b = __float_as_uint(f);
    return b ^ ((b >> 31) ? 0xFFFFFFFFu : 0x80000000u);
}
#define WAVE_SYNC() asm volatile("s_waitcnt lgkmcnt(0)" ::: "memory")
template <class T>
__device__ __forceinline__ T* opq(T* p) {
    long z = 0;
    asm volatile("" : "+s"(z));
    return (T*)((char*)p + z);
}
__device__ __forceinline__ int tidx() {
    int t = threadIdx.x;
    asm volatile("" : "+v"(t));
    return t;
}
__device__ __forceinline__ int bidx() {
    int b = blockIdx.x;
    asm volatile("" : "+s"(b));
    return b;
}
__device__ __forceinline__ int gdim() {
    int g = gridDim.x;
    asm volatile("" : "+s"(g));
    return g;
}

template <int AMODE, bool HAS_RS, class RowFn, class Epi>
__device__ __forceinline__ void gemm_tile(const u16* __restrict__ Ap, long lda, const u16* __restrict__ BT, long ldb, int M, int N, int K, int m0,
                                          int n0, unsigned char* lds, RowFn rowfn, Epi epi) {
    const int tid = tidx(), lane = tid & 63, w = tid >> 6;
    const int wm = w >> 1, wn = w & 1;
    f32x4 acc[4][4];
#pragma unroll
    for (int i = 0; i < 4; ++i)
#pragma unroll
        for (int j = 0; j < 4; ++j) acc[i][j] = f32x4{0.f, 0.f, 0.f, 0.f};
    long aoff[4], boff[4];
#pragma unroll
    for (int i = 0; i < 4; ++i) {
        const int row = (w * 4 + i) * 8 + (lane >> 3);
        const int kc = (lane & 7) ^ ((row >> 1) & 7);
        int gr = m0 + row;
        if (gr > M - 1) gr = M - 1;
        if (AMODE == 1) {
            int b = gr / (NCMP * 2);
            int rem = gr - b * (NCMP * 2);
            aoff[i] = ((long)b * SEQ + 16 * (rem >> 1)) * IN_COLS + (rem & 1) * 64 + kc * 8;
        } else {
            aoff[i] = (long)gr * lda + kc * 8;
        }
        int gn = n0 + row;
        if (gn > N - 1) gn = N - 1;
        boff[i] = (long)gn * ldb + kc * 8;
    }
    const int nk = K / 64;
#define GEMM_STAGE(kt, bufsel)                                                                                                        \
    do {                                                                                                                              \
        unsigned char* ab_ = lds + (bufsel) * 32768 + w * 4096 + lane * 16;                                                           \
        const long ka_ = (AMODE == 1) ? (long)(kt) * IN_COLS : (long)(kt) * 64;                                                       \
        _Pragma("unroll") for (int i_ = 0; i_ < 4; ++i_) {                                                                            \
            __builtin_amdgcn_global_load_lds((const unsigned*)(Ap + aoff[i_] + ka_), (unsigned*)(ab_ + i_ * 1024), 16, 0, 0);        \
            __builtin_amdgcn_global_load_lds((const unsigned*)(BT + boff[i_] + (long)(kt) * 64), (unsigned*)(ab_ + 16384 + i_ * 1024), 16, 0, 0); \
        }                                                                                                                             \
    } while (0)
    GEMM_STAGE(0, 0);
    asm volatile("s_waitcnt vmcnt(0)" ::: "memory");
    __syncthreads();
    int fa[4], fb[4];
#pragma unroll
    for (int i = 0; i < 4; ++i) {
        const int ra = wm * 64 + i * 16 + (lane & 15), rb = wn * 64 + i * 16 + (lane & 15);
        fa[i] = ra * 128 + ((ra >> 1) & 7) * 16;
        fb[i] = rb * 128 + ((rb >> 1) & 7) * 16;
    }
    for (int kt = 0; kt < nk; ++kt) {
        if (kt + 1 < nk) GEMM_STAGE(kt + 1, (kt + 1) & 1);
        const unsigned char* Ab = lds + (kt & 1) * 32768;
        const unsigned char* Bb = Ab + 16384;
#pragma unroll
        for (int ks = 0; ks < 2; ++ks) {
            const int kc16 = (ks * 4 + (lane >> 4)) * 16;
            bf16x8 af[4], bfr[4];
#pragma unroll
            for (int i = 0; i < 4; ++i) {
                af[i] = *(const bf16x8*)(Ab + ((fa[i] & ~127) | ((fa[i] & 127) ^ kc16)));
                bfr[i] = *(const bf16x8*)(Bb + ((fb[i] & ~127) | ((fb[i] & 127) ^ kc16)));
            }
#pragma unroll
            for (int i = 0; i < 4; ++i)
#pragma unroll
                for (int j = 0; j < 4; ++j) acc[i][j] = __builtin_amdgcn_mfma_f32_16x16x32_bf16(af[i], bfr[j], acc[i][j], 0, 0, 0);
        }
        asm volatile("s_waitcnt vmcnt(0)" ::: "memory");
        __syncthreads();
    }
#undef GEMM_STAGE
    float2* rsl = (float2*)(lds + 34816);
    if (HAS_RS) {
        if (tid < 128) {
            int gr = m0 + tid;
            if (gr > M - 1) gr = M - 1;
            rsl[tid] = rowfn(gr);
        }
        __syncthreads();
    }
    float* st = (float*)(lds + w * 8704);
#pragma unroll
    for (int hh = 0; hh < 2; ++hh) {
#pragma unroll
        for (int m2 = 0; m2 < 2; ++m2)
#pragma unroll
            for (int j = 0; j < 4; ++j)
#pragma unroll
                for (int r = 0; r < 4; ++r) st[(m2 * 16 + (lane >> 4) * 4 + r) * 68 + j * 16 + (lane & 15)] = acc[hh * 2 + m2][j][r];
        WAVE_SYNC();
#pragma unroll
        for (int c = 0; c < 4; ++c) {
            const int id = c * 64 + lane;
            const int rr = id >> 3, cc = id & 7;
            const float4 v0 = *(const float4*)(st + rr * 68 + cc * 8);
            const float4 v1 = *(const float4*)(st + rr * 68 + cc * 8 + 4);
            const float v[8] = {v0.x, v0.y, v0.z, v0.w, v1.x, v1.y, v1.z, v1.w};
            const int row = m0 + wm * 64 + hh * 32 + rr;
            const int col0 = n0 + wn * 64 + cc * 8;
            const float2 rs = HAS_RS ? rsl[wm * 64 + hh * 32 + rr] : float2{1.f, 1.f};
            if (row < M && col0 < N) epi(row, col0, v, rs);
        }
        WAVE_SYNC();
    }
    __syncthreads();
}

template <int AMODE, bool HAS_RS, class RowFn, class Epi>
__device__ __forceinline__ void gemm_phase_rs(const u16* Ap, long lda, const u16* BT, long ldb, int M, int N, int K, unsigned char* lds, RowFn rowfn, Epi epi) {
    const int tm = (M + 127) / 128, tn = (N + 127) / 128;
    const int SW = (tn % 9 == 0) ? 9 : ((tn % 8 == 0) ? 8 : 0);
    const int G = gdim();
    if (SW != 0 && (tm % 8) == 0 && (G % 8) == 0 && (((tm / 8) * (tn / SW)) % 8) == 0) {
        const int nsc = tn / SW;
        const int per = 8 * SW;
        const int nst_x = (tm / 8) * nsc / 8;
        const int x = bidx() & 7, j0 = bidx() >> 3, nper = G >> 3;
        for (int q = j0; q < nst_x * per; q += nper) {
            const int st = (q / per) * 8 + x;
            const int r = q % per;
            const int im = (st / nsc) * 8 + (r % 8), in = (st % nsc) * SW + (r / 8);
            gemm_tile<AMODE, HAS_RS>(Ap, lda, BT, ldb, M, N, K, im * 128, in * 128, lds, rowfn, epi);
        }
    } else {
        for (int t = bidx(); t < tm * tn; t += G) {
            int im = t / tn, in = t - im * tn;
            gemm_tile<AMODE, HAS_RS>(Ap, lda, BT, ldb, M, N, K, im * 128, in * 128, lds, rowfn, epi);
        }
    }
}
template <int AMODE, class Epi>
__device__ __forceinline__ void gemm_phase(const u16* Ap, long lda, const u16* BT, long ldb, int M, int N, int K, unsigned char* lds, Epi epi) {
    gemm_phase_rs<AMODE, false>(Ap, lda, BT, ldb, M, N, K, lds, [](int) { return float2{1.f, 1.f}; },
                                [=](int row, int col, const float (&v)[8], float2) { epi(row, col, v); });
}
__device__ __forceinline__ void st_bf8(u16* p, const float (&v)[8]) {
    *(uint4*)p = uint4{pack2(v[0], v[1]), pack2(v[2], v[3]), pack2(v[4], v[5]), pack2(v[6], v[7])};
}
__device__ __forceinline__ void ld_bf8(const u16* p, float (&v)[8]) {
    const uint4 q = *(const uint4*)p;
    v[0] = bf_lo(q.x); v[1] = bf_hi(q.x); v[2] = bf_lo(q.y); v[3] = bf_hi(q.y);
    v[4] = bf_lo(q.z); v[5] = bf_hi(q.z); v[6] = bf_lo(q.w); v[7] = bf_hi(q.w);
}

template <bool PERM = false>
__device__ __forceinline__ void transpose_cvt(const float* __restrict__ src, u16* __restrict__ dst, int K, int N, float* tile, const float* kgain = nullptr) {
    const int tk = K / 64, tn = (N + 63) / 64;
    const int tid = tidx();
    for (int t = bidx(); t < tk * tn; t += gdim()) {
        const int k0 = (t / tn) * 64, n0 = (t % tn) * 64;
        {
            const int tx = tid & 15, ty = tid >> 4;
#pragma unroll
            for (int i = 0; i < 4; ++i) {
                const int k = ty * 4 + i, n = n0 + tx * 4;
                float4 v = float4{0.f, 0.f, 0.f, 0.f};
                if (n < N) v = *(const float4*)(src + (long)(k0 + k) * N + n);
                const float g = kgain ? kgain[k0 + k] : 1.0f;
                float* trow = tile + k * 65 + tx * 4;
                trow[0] = v.x * g; trow[1] = v.y * g; trow[2] = v.z * g; trow[3] = v.w * g;
            }
        }
        __syncthreads();
        {
            const int kc = tid & 7, nl = tid >> 3;
#pragma unroll
            for (int j = 0; j < 2; ++j) {
                const int nn = nl + 32 * j, n = n0 + nn;
                float v[8];
#pragma unroll
                for (int q = 0; q < 8; ++q) v[q] = tile[(kc * 8 + q) * 65 + nn];
                if (n < N) st_bf8(dst + (long)(PERM ? perm_col(n) : n) * K + k0 + kc * 8, v);
            }
        }
        __syncthreads();
    }
}

__device__ __forceinline__ void cvt_f32_bf16(const float* __restrict__ src, u16* __restrict__ dst, long n) {
    long i = ((long)bidx() * 256 + tidx()) * 8;
    const long stride = (long)gdim() * 256 * 8;
    for (; i < n; i += stride) {
        float4 a = *(const float4*)(src + i);
        float4 b = *(const float4*)(src + i + 4);
        *(uint4*)(dst + i) = uint4{pack2(a.x, a.y), pack2(a.z, a.w), pack2(b.x, b.y), pack2(b.z, b.w)};
    }
}

typedef float f32x2_t __attribute__((ext_vector_type(2)));
__device__ __forceinline__ void cvt_rows_fp8(const float* __restrict__ src, unsigned char* __restrict__ dst, float* __restrict__ scales, int nrows, const float* colgain = nullptr) {
    const int lane = tidx() & 63;
    const int wid = bidx() * 4 + (tidx() >> 6);
    const int nw = gdim() * 4;
    for (int row = wid; row < nrows; row += nw) {
        const float* r = src + (long)row * 1024 + lane * 16;
        float4 q[4];
#pragma unroll
        for (int i = 0; i < 4; ++i) {
            q[i] = *(const float4*)(r + 4 * i);
            if (colgain) {
                const float4 g = *(const float4*)(colgain + lane * 16 + 4 * i);
                q[i].x *= g.x; q[i].y *= g.y; q[i].z *= g.z; q[i].w *= g.w;
            }
        }
        float am = 0.f;
#pragma unroll
        for (int i = 0; i < 4; ++i) am = fmaxf(am, fmaxf(fmaxf(fabsf(q[i].x), fabsf(q[i].y)), fmaxf(fabsf(q[i].z), fabsf(q[i].w))));
        am = wmax(am);
        const float inv = am > 0.f ? 448.0f / am : 0.f;
        if (lane == 0) scales[row] = am > 0.f ? am * (1.0f / 448.0f) : 0.f;
        u32 wv[4];
#pragma unroll
        for (int i = 0; i < 4; ++i) {
            int x = 0;
            x = __builtin_amdgcn_cvt_pk_fp8_f32(q[i].x * inv, q[i].y * inv, x, false);
            x = __builtin_amdgcn_cvt_pk_fp8_f32(q[i].z * inv, q[i].w * inv, x, true);
            wv[i] = (u32)x;
        }
        *(uint4*)(dst + (long)row * 1024 + lane * 16) = uint4{wv[0], wv[1], wv[2], wv[3]};
    }
}

__device__ __forceinline__ void rms_rows(const float* __restrict__ x, const float* __restrict__ g, u16* __restrict__ dst, const u16* __restrict__ e,
                         float* __restrict__ rstd_e) {
    const int lane = tidx() & 63;
    const int wid = bidx() * 4 + (tidx() >> 6);
    const int nw = gdim() * 4;
    for (int row = wid; row < NTOK; row += nw) {
        const float* xr = x + (long)row * 1024;
        float4 v[4];
        float ss = 0.f;
#pragma unroll
        for (int i = 0; i < 4; ++i) {
            v[i] = *(const float4*)(xr + i * 256 + lane * 4);
            ss += v[i].x * v[i].x + v[i].y * v[i].y + v[i].z * v[i].z + v[i].w * v[i].w;
        }
        ss = wsum(ss);
        float rstd = rsqrtf(ss * (1.0f / 1024.0f) + EPS);
#pragma unroll
        for (int i = 0; i < 4; ++i) {
            float4 gg = g ? *(const float4*)(g + i * 256 + lane * 4) : float4{1.f, 1.f, 1.f, 1.f};
            uint2 o = uint2{pack2(v[i].x * rstd * gg.x, v[i].y * rstd * gg.y), pack2(v[i].z * rstd * gg.z, v[i].w * rstd * gg.w)};
            *(uint2*)(dst + (long)row * 1024 + i * 256 + lane * 4) = o;
        }
        if (e) {
            const uint4* er = (const uint4*)(e + (long)row * 1024);
            float es = 0.f;
#pragma unroll
            for (int i = 0; i < 2; ++i) {
                uint4 q = er[i * 64 + lane];
                float a;
                a = bf_lo(q.x); es += a * a; a = bf_hi(q.x); es += a * a;
                a = bf_lo(q.y); es += a * a; a = bf_hi(q.y); es += a * a;
                a = bf_lo(q.z); es += a * a; a = bf_hi(q.z); es += a * a;
                a = bf_lo(q.w); es += a * a; a = bf_hi(q.w); es += a * a;
            }
            es = wsum(es);
            if (lane == 0) rstd_e[row] = rsqrtf(es * (1.0f / 1024.0f) + EPS);
        }
    }
}

__device__ __forceinline__ void head_chunk(u16* ptr, float gain, bool do_norm, float scale, float c, float sn, int lane) {
    float v = bf2f(ptr[lane]);
    if (do_norm) {
        float ss = wsum(v * v);
        v = v * rsqrtf(ss * (1.0f / 64.0f) + EPS) * gain;
    }
    float pv = __shfl_xor(v, 8);
    if (lane < 16) v = (lane < 8) ? (v * c - pv * sn) : (v * c + pv * sn);
    ptr[lane] = f2bf(v * scale);
}
__device__ __forceinline__ u32 sig2(u32 w) { return pack2(sigmoidf(bf_lo(w)), sigmoidf(bf_hi(w))); }

__device__ __forceinline__ void post_proj(unsigned char* ws, const float* ng, const float* dg, unsigned char* smem) {
    u16* proj = (u16*)(ws + OFF_PROJ);
    const float* ropec = (const float*)(ws + OFF_ROPE);
    const float* ropes = ropec + (size_t)NTOK * 8;
    const int lane = tidx() & 63, w = tidx() >> 6;
    u16* lrow = (u16*)(smem + w * 9216);
    const float g_q = ng[lane], g_ks = ng[128 + lane], g_kw = ng[192 + lane], g_dq = dg[lane], g_kb = dg[64 + lane];
    const int wid = bidx() * 4 + w;
    const int nw = gdim() * 4;
    for (int t = wid; t < NTOK; t += nw) {
        uint4* grow = (uint4*)(proj + (long)t * IN_COLS);
        const float c = ropec[(long)t * 8 + (lane & 7)], sn = ropes[(long)t * 8 + (lane & 7)];
#pragma unroll
        for (int i = 0; i < 8; ++i) ((uint4*)lrow)[i * 64 + lane] = grow[i * 64 + lane];
        if (lane < 60) ((uint4*)lrow)[512 + lane] = grow[512 + lane];
        WAVE_SYNC();
        for (int h = 0; h < 8; ++h) head_chunk(lrow + C_NQ + h * 64, g_q, true, 0.125f * 1.4426950408889634f, c, sn, lane);
        for (int g = 0; g < 2; ++g) head_chunk(lrow + C_NKV + (2 * 2 + g) * 64, g_ks, true, 1.0f, c, sn, lane);
        for (int g = 0; g < 2; ++g) head_chunk(lrow + C_NKV + (4 * 2 + g) * 64, g_kw, true, 1.0f, c, sn, lane);
        for (int h = 0; h < 8; ++h) head_chunk(lrow + C_DQ + h * 64, g_dq, true, 0.125f * 1.4426950408889634f, c, sn, lane);
        head_chunk(lrow + C_DKV, g_kb, true, 1.0f, c, sn, lane);
        for (int h = 0; h < 8; ++h) head_chunk(lrow + C_IQ + h * 64, 1.0f, false, 0.125f, c, sn, lane);
        head_chunk(lrow + C_IK, 1.0f, false, 1.0f, c, sn, lane);
        WAVE_SYNC();
#pragma unroll
        for (int i = 0; i < 9; ++i) {
            int idx = i * 64 + lane;
            if (idx < 572) {
                uint4 v = ((const uint4*)lrow)[idx];
                if (idx >= 316 || (idx >= 160 && idx < 163)) v = uint4{sig2(v.x), sig2(v.y), sig2(v.z), sig2(v.w)};
                grow[idx] = v;
            }
        }
        WAVE_SYNC();
    }
}

template <int NH>
__device__ __forceinline__ void qk_chunk(const u16* krow, const u32* qlds, float (&s)[NH]) {
    asm volatile("" ::: "memory");
    uint4 kr[8];
#pragma unroll
    for (int i = 0; i < 8; ++i) kr[i] = ((const uint4*)krow)[i];
#pragma unroll
    for (int h = 0; h < NH; ++h) s[h] = 0.f;
#pragma unroll
    for (int i = 0; i < 8; ++i)
#pragma unroll
        for (int h = 0; h < NH; ++h) {
            uint4 q = *(const uint4*)(qlds + h * 32 + i * 4);
            s[h] = dot2(kr[i].x, q.x, s[h]);
            s[h] = dot2(kr[i].y, q.y, s[h]);
            s[h] = dot2(kr[i].z, q.z, s[h]);
            s[h] = dot2(kr[i].w, q.w, s[h]);
        }
}

template <int NH, class VRow>
__device__ __forceinline__ void pv_chunk(const float* plds, VRow vrow, float (&o)[NH][4], int lane) {
    const int sub = lane >> 4, dq = lane & 15;
#pragma unroll 4
    for (int kk = 0; kk < 16; ++kk) {
        int key = kk * 4 + sub;
        const u16* vp = vrow(key);
        uint2 vv = *(const uint2*)(vp + dq * 4);
        float v0 = bf_lo(vv.x), v1 = bf_hi(vv.x), v2 = bf_lo(vv.y), v3 = bf_hi(vv.y);
#pragma unroll
        for (int h = 0; h < NH; ++h) {
            float ph = plds[key * NH + h];
            o[h][0] += ph * v0;
            o[h][1] += ph * v1;
            o[h][2] += ph * v2;
            o[h][3] += ph * v3;
        }
    }
}

template <int NH, class VRow>
__device__ __forceinline__ void attn_chunk(float (&s)[NH], bool valid, float (&m)[NH], float (&l)[NH], float (&o)[NH][4], float* plds, VRow vrow,
                                           int lane) {
#pragma unroll
    for (int h = 0; h < NH; ++h) {
        float sv = valid ? s[h] : -1e30f;
        float cm = wmax(sv);
        float mn = fmaxf(m[h], cm);
        float alpha = __expf(m[h] - mn);
        float p = valid ? __expf(sv - mn) : 0.f;
        l[h] = l[h] * alpha + wsum(p);
        m[h] = mn;
#pragma unroll
        for (int j = 0; j < 4; ++j) o[h][j] *= alpha;
        plds[lane * NH + h] = p;
    }
    WAVE_SYNC();
    pv_chunk<NH>(plds, vrow, o, lane);
    WAVE_SYNC();
}

#define MFMA32(a, b, c) __builtin_amdgcn_mfma_f32_32x32x16_bf16(a, b, c, 0, 0, 0)
typedef __attribute__((address_space(3))) const char* lds_cptr;
typedef short v4i16_t __attribute__((ext_vector_type(4)));
using s16x4 = __attribute__((ext_vector_type(4))) short;
__device__ __forceinline__ s16x4 vtr(lds_cptr p) {
    return __builtin_bit_cast(s16x4, __builtin_amdgcn_ds_read_tr16_b64_v4i16((__attribute__((address_space(3))) v4i16_t*)p));
}
__device__ __forceinline__ float xhalf_sum(float v) {
    auto r = __builtin_amdgcn_permlane32_swap(__float_as_uint(v), __float_as_uint(v), false, false);
    return __uint_as_float(r[0]) + __uint_as_float(r[1]);
}
__device__ __forceinline__ float xhalf_max(float v) {
    auto r = __builtin_amdgcn_permlane32_swap(__float_as_uint(v), __float_as_uint(v), false, false);
    return fmaxf(__uint_as_float(r[0]), __uint_as_float(r[1]));
}

using u32x4 = __attribute__((ext_vector_type(4))) unsigned;
struct TileRegs { u32x4 k0, k1, v0, v1; };
template <class RowPtr>
__device__ __forceinline__ void tile_load(u32x4& k0, u32x4& k1, u32x4& v0, u32x4& v1, RowPtr rowptr, int w, int lane) {
    const u16 *kp, *vp, *kp2, *vp2;
    rowptr(lane, kp, vp2);
    rowptr(16 * w + (lane >> 2), kp2, vp);
    k0 = *(const u32x4*)(kp + w * 8);
    k1 = *(const u32x4*)(kp + (w + 4) * 8);
    v0 = *(const u32x4*)(vp + (lane & 3) * 8);
    v1 = *(const u32x4*)(vp + 32 + (lane & 3) * 8);
}
__device__ __forceinline__ void tile_store(const u32x4& k0, const u32x4& k1, const u32x4& v0, const u32x4& v1, unsigned char* buf, int w, int lane) {
    *(u32x4*)(buf + w * 1024 + lane * 16) = k0;
    *(u32x4*)(buf + (w + 4) * 1024 + lane * 16) = k1;
    *(u32x4*)(buf + 8192 + (16 * w + (lane >> 2)) * 64 + (lane & 3) * 16) = v0;
    *(u32x4*)(buf + 8192 + 4096 + (16 * w + (lane >> 2)) * 64 + (lane & 3) * 16) = v1;
}
__device__ __forceinline__ void glds16(const void* g, unsigned lds_base) {
    unsigned sv;
    asm volatile("s_mov_b32 %0, m0\n\ts_mov_b32 m0, %2\n\ts_nop 0\n\tglobal_load_lds_dwordx4 %1, off\n\ts_mov_b32 m0, %0"
                 : "=&s"(sv)
                 : "v"(g), "s"(lds_base)
                 : "memory");
}
template <class RowPtr>
__device__ __forceinline__ void tile_dma(RowPtr rowptr, unsigned char* buf, int w, int lane) {
    const u16 *kp, *vp, *kp2, *vp2;
    rowptr(lane, kp, vp2);
    rowptr(16 * w + (lane >> 2), kp2, vp);
    const unsigned kd = (unsigned)__builtin_amdgcn_readfirstlane((int)((unsigned)(uintptr_t)buf + (unsigned)(w * 1024)));
    const unsigned vd = kd + 8192u;
    glds16(kp + w * 8, kd);
    glds16(kp + (w + 4) * 8, kd + 4096u);
    glds16(vp + (lane & 3) * 8, vd);
    glds16(vp + 32 + (lane & 3) * 8, vd + 4096u);
}
__device__ __forceinline__ void qk_tile(const unsigned char* buf, const bf16x8 (&qr)[4], const f32x16& zero16, f32x16& s0, f32x16& s1, int lane) {
    const int r32 = lane & 31, hi = lane >> 5;
    lds_cptr kp = (lds_cptr)buf + hi * 1024 + r32 * 16;
#pragma unroll
    for (int d0 = 0; d0 < 4; ++d0) {
        bf16x8 k0 = *(const __attribute__((address_space(3))) bf16x8*)(kp + d0 * 2048);
        bf16x8 k1 = *(const __attribute__((address_space(3))) bf16x8*)(kp + d0 * 2048 + 512);
        s0 = MFMA32(k0, qr[d0], d0 == 0 ? zero16 : s0);
        s1 = MFMA32(k1, qr[d0], d0 == 0 ? zero16 : s1);
    }
}
__device__ __forceinline__ bf16x8 pack8(const f32x16& p, int s) {
    u32 a = pack2(p[8 * s + 0], p[8 * s + 1]), b = pack2(p[8 * s + 2], p[8 * s + 3]);
    u32 c = pack2(p[8 * s + 4], p[8 * s + 5]), d = pack2(p[8 * s + 6], p[8 * s + 7]);
    u32x4 v = u32x4{a, b, c, d};
    return __builtin_bit_cast(bf16x8, v);
}
__device__ __forceinline__ void pv_tile(const unsigned char* buf, const f32x16& p0, const f32x16& p1, f32x16 (&o)[2], int lane) {
    const int hi = lane >> 5;
    lds_cptr vp = (lds_cptr)buf + 8192 + ((lane >> 4) & 1) * 32 + (lane & 3) * 8 + (4 * hi + ((lane & 15) >> 2)) * 64;
    bf16x8 pf[4];
    pf[0] = pack8(p0, 0);
    pf[1] = pack8(p0, 1);
    pf[2] = pack8(p1, 0);
    pf[3] = pack8(p1, 1);
#pragma unroll
    for (int dh = 0; dh < 2; ++dh) {
        bf16x8 vf[4];
#pragma unroll
        for (int ks = 0; ks < 4; ++ks) {
            const uint2 vlo = __builtin_bit_cast(uint2, vtr(vp + dh * 4096 + ks * 1024));
            const uint2 vhi = __builtin_bit_cast(uint2, vtr(vp + dh * 4096 + ks * 1024 + 512));
            const u32x4 vq = u32x4{vlo.x, vlo.y, vhi.x, vhi.y};
            vf[ks] = __builtin_bit_cast(bf16x8, vq);
        }
        __builtin_amdgcn_sched_barrier(0);
#pragma unroll
        for (int ks = 0; ks < 4; ++ks) o[dh] = MFMA32(vf[ks], pf[ks], o[dh]);
        __builtin_amdgcn_sched_barrier(0);
    }
}
template <bool BITS>
__device__ __forceinline__ void apply_mask(f32x16& s0, f32x16& s1, int lo, int hi_lim, u64 word, int hi) {
    const u32 wlo = (u32)(word >> (4 * hi)), whi = (u32)(word >> (32 + 4 * hi));
#pragma unroll
    for (int i = 0; i < 16; ++i) {
        const int kc = (i & 3) + 8 * (i >> 2);
        bool v0, v1;
        if (BITS) {
            v0 = (wlo >> kc) & 1u;
            v1 = (whi >> kc) & 1u;
        } else {
            const int kk = kc + 4 * hi;
            v0 = (kk >= lo) && (kk <= hi_lim);
            v1 = (kk + 32 >= lo) && (kk + 32 <= hi_lim);
        }
        s0[i] = v0 ? s0[i] : -1e30f;
        s1[i] = v1 ? s1[i] : -1e30f;
    }
}
__device__ __forceinline__ void softmax_step(f32x16& s0, f32x16& s1, float& m, float& l, f32x16 (&o)[2]) {
    float mx = fmaxf(s0[0], s1[0]);
#pragma unroll
    for (int i = 1; i < 16; ++i) mx = fmaxf(fmaxf(mx, s0[i]), s1[i]);
    mx = xhalf_max(mx);
    if (__any(mx > m + 8.0f)) {
        const float mn = fmaxf(m, mx);
        const float alpha = __builtin_amdgcn_exp2f(m - mn);
        l *= alpha;
        m = mn;
#pragma unroll
        for (int i = 0; i < 16; ++i) { o[0][i] *= alpha; o[1][i] *= alpha; }
    }
    const float ms = fmaxf(m, -1e29f);
    float sum = 0.f;
#pragma unroll
    for (int i = 0; i < 16; ++i) {
        s0[i] = __builtin_amdgcn_exp2f(s0[i] - ms);
        s1[i] = __builtin_amdgcn_exp2f(s1[i] - ms);
        sum += s0[i] + s1[i];
    }
    l += xhalf_sum(sum);
}

template <int MODE, bool BITS, class Next, class RowPtr, class MaskFn, class Extra>
__device__ __forceinline__ void flash_run(int first, Next next, RowPtr rowptr, MaskFn maskfn, Extra extra, const bf16x8 (&qr)[4], float& m, float& l,
                                          f32x16 (&o)[2], unsigned char* bufs, int w, int lane) {
    if (first < 0) return;
    int cur = first;
    int nxt = next(cur);
    asm volatile("" ::"v"(qr[0]), "v"(qr[1]), "v"(qr[2]), "v"(qr[3]));
    __syncthreads();
    tile_dma([&](int r, const u16*& kp, const u16*& vp) { rowptr(cur, r, kp, vp); }, bufs, w, lane);
    if (nxt >= 0) tile_dma([&](int r, const u16*& kp, const u16*& vp) { rowptr(nxt, r, kp, vp); }, bufs + 16384, w, lane);
    int pb = 0, pb2 = 2;
    f32x16 zero16;
#pragma unroll
    for (int i = 0; i < 16; ++i) zero16[i] = 0.f;
    while (cur >= 0) {
        if (nxt >= 0) asm volatile("s_waitcnt vmcnt(4)" ::: "memory");
        else asm volatile("s_waitcnt vmcnt(0)" ::: "memory");
        asm volatile("s_waitcnt lgkmcnt(0)" ::: "memory");
        __builtin_amdgcn_s_barrier();
        const int nn = nxt >= 0 ? next(nxt) : -1;
        if (nn >= 0) tile_dma([&](int r, const u16*& kp, const u16*& vp) { rowptr(nn, r, kp, vp); }, bufs + pb2 * 16384, w, lane);
        const unsigned char* buf = bufs + pb * 16384;
        f32x16 s0, s1;
        qk_tile(buf, qr, zero16, s0, s1, lane);
        int lo, hl;
        u64 word;
        maskfn(cur, lo, hl, word);
        if (BITS || !__all(lo <= 0 && hl >= 63)) apply_mask<BITS>(s0, s1, lo, hl, word, lane >> 5);
        if (MODE == 0) {
            softmax_step(s0, s1, m, l, o);
            pv_tile(buf, s0, s1, o, lane);
        } else if (MODE == 1) {
            f32x16 od[2];
#pragma unroll
            for (int i = 0; i < 16; ++i) { od[0][i] = 0.f; od[1][i] = 0.f; }
            softmax_step(s0, s1, m, l, od);
        } else {
            const float ms2 = fmaxf(m, -1e29f);
#pragma unroll
            for (int i = 0; i < 16; ++i) {
                s0[i] = __builtin_amdgcn_exp2f(s0[i] - ms2) * l;
                s1[i] = __builtin_amdgcn_exp2f(s1[i] - ms2) * l;
            }
            extra(cur, s0, s1);
            pv_tile(buf, s0, s1, o, lane);
        }
        pb = (pb == 2) ? 0 : pb + 1;
        pb2 = (pb2 == 2) ? 0 : pb2 + 1;
        cur = nxt;
        nxt = nn;
    }
}

__device__ __forceinline__ void nsa_unit(unsigned char* ws, int b, int g, int qt, unsigned char* smem) {
    const int tid = tidx(), lane = tid & 63, w = tid >> 6;
    const int r32 = lane & 31, hi = lane >> 5;
    const int q0 = qt * 32;
    const int tl = q0 + 8 * w + (r32 >> 2);
    const int rep = r32 & 3;
    const u16* proj = (const u16*)(ws + OFF_PROJ);
    const u16* brow = proj + (long)b * SEQ * IN_COLS;
    const u16* kcb = (const u16*)(ws + OFF_KCB) + (size_t)(b * 2 + g) * 256 * 64;
    const u16* vcb = (const u16*)(ws + OFF_VCB) + (size_t)(b * 2 + g) * 256 * 64;
    u16* ya = (u16*)(ws + OFF_YAB);
    unsigned char* bufs = smem;
    float* imp = (float*)(smem + 49152);
    u64* selm = (u64*)(smem + 49152 + 8192);
    const u16* trow = brow + (long)tl * IN_COLS;
    bf16x8 qr[4];
#pragma unroll
    for (int d0 = 0; d0 < 4; ++d0) qr[d0] = *(const bf16x8*)(trow + C_NQ + (g * 4 + rep) * 64 + d0 * 16 + hi * 8);
    const float gate_c = bf2f(trow[C_NG + 0 * 8 + g * 4 + rep]);
    const float gate_s = bf2f(trow[C_NG + 1 * 8 + g * 4 + rep]);
    const float gate_w = bf2f(trow[C_NG + 2 * 8 + g * 4 + rep]);
    for (int i = tid; i < 32 * 64; i += 256) imp[i] = 0.f;
    f32x16 tot[2];
#pragma unroll
    for (int i = 0; i < 16; ++i) { tot[0][i] = 0.f; tot[1][i] = 0.f; }

    const int nvalid = tl >= 31 ? ((tl - 31) >> 4) + 1 : 0;
    const int nv_max = (q0 + 31 >= 31) ? ((q0 + 31 - 31) >> 4) + 1 : 0;
    const int ntile_c = (nv_max + 63) >> 6;
    auto crows = [&](int tile, int r, const u16*& kp, const u16*& vp) {
        int n = tile * 64 + r;
        n = n < 254 ? n : 254;
        kp = kcb + (size_t)n * 64;
        vp = vcb + (size_t)n * 64;
    };
    auto cnext = [&](int c) { return (c + 1 < ntile_c) ? c + 1 : -1; };
    auto cmask = [&](int tile, int& lo, int& hl, u64& word) { lo = 0; hl = nvalid - 64 * tile - 1; word = 0; };
    {
        float m = -1e30f, l = 0.f;
        f32x16 o[2];
#pragma unroll
        for (int i = 0; i < 16; ++i) { o[0][i] = 0.f; o[1][i] = 0.f; }
        flash_run<1, false>(ntile_c > 0 ? 0 : -1, cnext, crows, cmask, [&](int, f32x16&, f32x16&) {}, qr, m, l, o, bufs, w, lane);
        float invl = l > 0.f ? 1.0f / l : 0.f;
        const int qloc = 8 * w + (r32 >> 2);
        flash_run<2, false>(ntile_c > 0 ? 0 : -1, cnext, crows, cmask,
                            [&](int tile, f32x16& p0, f32x16& p1) {
#pragma unroll
                                for (int a = 0; a < 4; ++a) {
                                    float g0 = p0[4 * a] + p0[4 * a + 1] + p0[4 * a + 2] + p0[4 * a + 3], e0 = p0[4 * a + 3];
                                    float g1 = p1[4 * a] + p1[4 * a + 1] + p1[4 * a + 2] + p1[4 * a + 3], e1 = p1[4 * a + 3];
                                    g0 += __shfl_xor(g0, 1); g0 += __shfl_xor(g0, 2);
                                    e0 += __shfl_xor(e0, 1); e0 += __shfl_xor(e0, 2);
                                    g1 += __shfl_xor(g1, 1); g1 += __shfl_xor(g1, 2);
                                    e1 += __shfl_xor(e1, 1); e1 += __shfl_xor(e1, 2);
                                    if (rep == 0) {
                                        int j0 = 16 * tile + 2 * a + hi, j1 = j0 + 8;
                                        atomicAdd(&imp[qloc * 64 + j0], g0);
                                        if (j0 + 1 < 64) atomicAdd(&imp[qloc * 64 + j0 + 1], e0);
                                        if (j1 < 64) atomicAdd(&imp[qloc * 64 + j1], g1);
                                        if (j1 + 1 < 64) atomicAdd(&imp[qloc * 64 + j1 + 1], e1);
                                    }
                                }
                            },
                            qr, m, invl, o, bufs, w, lane);
#pragma unroll
        for (int i = 0; i < 16; ++i) { tot[0][i] += gate_c * o[0][i]; tot[1][i] += gate_c * o[1][i]; }
    }
    __syncthreads();
    for (int qq = 0; qq < 8; ++qq) {
        const int qi = 8 * w + qq;
        const int tq = q0 + qi;
        const int cur = tq >> 6;
        const int j = lane;
        float v = imp[qi * 64 + j];
        if (j == 0 || j == cur || j == cur - 1) v = __builtin_inff();
        if (j > cur) v = -__builtin_inff();
        const u32 key = sortkey(v);
        u32 Kq = 0u;
        for (int bit = 31; bit >= 0; --bit) {
            const u32 cand = Kq | (1u << bit);
            const int cnt = __popcll(__ballot(key >= cand));
            if (cnt >= 16) Kq = cand;
            if (cnt == 16) break;
        }
        const int needq = 16 - __popcll(__ballot(key > Kq));
        const u64 emq = __ballot(key == Kq);
        const bool takeq = (key > Kq) || (key == Kq && __popcll(emq & ((1ull << lane) - 1ull)) < needq);
        u64 sm = __ballot(takeq && j <= cur);
        if (lane == 0) selm[qi] = sm;
    }
    __syncthreads();
    const u64 mymask = selm[8 * w + (r32 >> 2)];
    u64 unionm = 0;
    for (int i = 0; i < 32; ++i) unionm |= selm[i];
    unionm = __builtin_amdgcn_readfirstlane((u32)unionm) | ((u64)__builtin_amdgcn_readfirstlane((u32)(unionm >> 32)) << 32);
    {
        float m = -1e30f, l = 0.f;
        f32x16 o[2];
#pragma unroll
        for (int i = 0; i < 16; ++i) { o[0][i] = 0.f; o[1][i] = 0.f; }
        auto snext = [&](int c) {
            u64 rest = (c >= 63) ? 0ull : (unionm >> (c + 1));
            return rest ? (c + 1 + (__ffsll((long long)rest) - 1)) : -1;
        };
        const int first = unionm ? (__ffsll((long long)unionm) - 1) : -1;
        flash_run<0, false>(first, snext,
                            [&](int j, int r, const u16*& kp, const u16*& vp) {
                                const u16* rp = brow + (long)(64 * j + r) * IN_COLS + C_NKV;
                                kp = rp + (2 * 2 + g) * 64;
                                vp = rp + (3 * 2 + g) * 64;
                            },
                            [&](int j, int& lo, int& hl, u64& word) { lo = 0; hl = ((mymask >> j) & 1ull) ? (tl - 64 * j) : -1; word = 0; },
                            [&](int, f32x16&, f32x16&) {}, qr, m, l, o, bufs, w, lane);
        const float sc = l > 0.f ? gate_s / l : 0.f;
#pragma unroll
        for (int i = 0; i < 16; ++i) { tot[0][i] += sc * o[0][i]; tot[1][i] += sc * o[1][i]; }
    }
    {
        float m = -1e30f, l = 0.f;
        f32x16 o[2];
#pragma unroll
        for (int i = 0; i < 16; ++i) { o[0][i] = 0.f; o[1][i] = 0.f; }
        const int jfirst = (q0 - 511) > 0 ? ((q0 - 511) >> 6) : 0;
        const int jlast = (q0 + 31) >> 6;
        flash_run<0, false>(jfirst, [&](int c) { return c + 1 <= jlast ? c + 1 : -1; },
                            [&](int j, int r, const u16*& kp, const u16*& vp) {
                                const u16* rp = brow + (long)(64 * j + r) * IN_COLS + C_NKV;
                                kp = rp + (4 * 2 + g) * 64;
                                vp = rp + (5 * 2 + g) * 64;
                            },
                            [&](int j, int& lo, int& hl, u64& word) { lo = tl - 511 - 64 * j; hl = tl - 64 * j; word = 0; },
                            [&](int, f32x16&, f32x16&) {}, qr, m, l, o, bufs, w, lane);
        const float sc = l > 0.f ? gate_w / l : 0.f;
#pragma unroll
        for (int i = 0; i < 16; ++i) { tot[0][i] += sc * o[0][i]; tot[1][i] += sc * o[1][i]; }
    }
    {
        u16* orow = ya + ((long)b * SEQ + tl) * 512 + (g * 4 + rep) * 64;
#pragma unroll
        for (int dh = 0; dh < 2; ++dh)
#pragma unroll
            for (int a = 0; a < 4; ++a) {
                uint2 v = uint2{pack2(tot[dh][4 * a], tot[dh][4 * a + 1]), pack2(tot[dh][4 * a + 2], tot[dh][4 * a + 3])};
                *(uint2*)(orow + dh * 32 + 8 * a + 4 * hi) = v;
            }
    }
}

__device__ __forceinline__ void dsa_select_unit(unsigned char* ws, int unit, unsigned char* smem, unsigned long long& tacc) {
    const int tid = tidx(), lane = tid & 63, w = tid >> 6;
    const int t0 = unit * 4;
    const int b = t0 / SEQ, tl0 = t0 - b * SEQ;
    const u16* proj = (const u16*)(ws + OFF_PROJ);
    const u16* brow = proj + (long)b * SEQ * IN_COLS;
    u64* bits = (u64*)(ws + OFF_BITS);
    float* sc = (float*)smem;
    __syncthreads();
    unsigned long long ts0 = SEC_T();
#ifndef ATTA_REP_IDX
#define ATTA_REP_IDX 1
#endif
#ifndef ATTA_REP_TOPK
#define ATTA_REP_TOPK 1
#endif
    for (int rep_ = 0; rep_ < ATTA_REP_IDX; ++rep_) {
        const int r16 = lane & 15, g4 = lane >> 4;
        bf16x8 af[2][2];
#pragma unroll
        for (int rb = 0; rb < 2; ++rb)
#pragma unroll
            for (int ks = 0; ks < 2; ++ks)
                af[rb][ks] = *(const bf16x8*)(proj + (long)(t0 + 2 * rb + (r16 >> 3)) * IN_COLS + C_IQ + (r16 & 7) * 64 + ks * 32 + g4 * 8);
        float wq[2][4];
#pragma unroll
        for (int rb = 0; rb < 2; ++rb)
#pragma unroll
            for (int i = 0; i < 4; ++i)
                wq[rb][i] = bf2f(proj[(long)(t0 + 2 * rb + (g4 >> 1)) * IN_COLS + C_IW + (g4 & 1) * 4 + i]) * 0.35355339059327373f;
        const int ntiles = (tl0 + 4 + 31) >> 5;
#define IDX_LD(T, B)                                                                                         \
    do {                                                                                                     \
        _Pragma("unroll") for (int kt = 0; kt < 2; ++kt) {                                                   \
            int key_ = (T) * 32 + kt * 16 + r16;                                                             \
            key_ = key_ < SEQ ? key_ : SEQ - 1;                                                              \
            _Pragma("unroll") for (int ks = 0; ks < 2; ++ks)                                                 \
                B[kt][ks] = *(const bf16x8*)(brow + (long)key_ * IN_COLS + C_IK + ks * 32 + g4 * 8);         \
        }                                                                                                    \
    } while (0)
        bf16x8 bn[2][2];
        if (w < ntiles) IDX_LD(w, bn);
        for (int tile = w; tile < ntiles; tile += 4) {
            bf16x8 bc[2][2];
#pragma unroll
            for (int kt = 0; kt < 2; ++kt)
#pragma unroll
                for (int ks = 0; ks < 2; ++ks) bc[kt][ks] = bn[kt][ks];
            if (tile + 4 < ntiles) IDX_LD(tile + 4, bn);
#pragma unroll
            for (int rb = 0; rb < 2; ++rb)
#pragma unroll
                for (int kt = 0; kt < 2; ++kt) {
                    f32x4 acc = f32x4{0.f, 0.f, 0.f, 0.f};
                    acc = __builtin_amdgcn_mfma_f32_16x16x32_bf16(af[rb][0], bc[kt][0], acc, 0, 0, 0);
                    acc = __builtin_amdgcn_mfma_f32_16x16x32_bf16(af[rb][1], bc[kt][1], acc, 0, 0, 0);
                    float part = 0.f;
#pragma unroll
                    for (int i = 0; i < 4; ++i) part += wq[rb][i] * fmaxf(acc[i], 0.f);
                    auto sw = __builtin_amdgcn_permlane16_swap(__float_as_uint(part), __float_as_uint(part), false, false);
                    const float tot = __uint_as_float(sw[0]) + __uint_as_float(sw[1]);
                    if ((g4 & 1) == 0) sc[(2 * rb + (g4 >> 1)) * 4096 + tile * 32 + kt * 16 + r16] = tot;
                }
        }
#undef IDX_LD
    }
    __syncthreads();
    SEC_ADD(1, ts0);
    ts0 = SEC_T();
    const int t = t0 + w;
    const int tl = tl0 + w;
    const int nvalid = tl + 1;
    for (int rep_ = 0; rep_ < ATTA_REP_TOPK; ++rep_) {
        u32 u[64];
        const float* scq = sc + w * 4096;
#pragma unroll
        for (int j = 0; j < 64; ++j) {
            const int key = j * 64 + lane;
            const u32 kk = sortkey(scq[key]);
            u[j] = (key <= tl) ? kk : 0u;
        }
        SEC_ADD(2, ts0);
        ts0 = SEC_T();
        u32 K = 0;
        int need = 0, ceq = 0;
        if (nvalid > 256) {
            u32 lm0 = u[0], lm1 = u[1], lm2 = u[2], lm3 = u[3];
#pragma unroll
            for (int j = 4; j < 64; j += 4) { lm0 = max(lm0, u[j]); lm1 = max(lm1, u[j + 1]); lm2 = max(lm2, u[j + 2]); lm3 = max(lm3, u[j + 3]); }
            u32 lo = min(min(lm0, lm1), min(lm2, lm3)), hiu = max(max(lm0, lm1), max(lm2, lm3));
            lo = row_min16u(lo);
            hiu = row_max16u(hiu);
            const u32 L = min(min((u32)__builtin_amdgcn_readlane((int)lo, 0), (u32)__builtin_amdgcn_readlane((int)lo, 16)),
                              min((u32)__builtin_amdgcn_readlane((int)lo, 32), (u32)__builtin_amdgcn_readlane((int)lo, 48)));
            const u32 U = max(max((u32)__builtin_amdgcn_readlane((int)hiu, 0), (u32)__builtin_amdgcn_readlane((int)hiu, 16)),
                              max((u32)__builtin_amdgcn_readlane((int)hiu, 32), (u32)__builtin_amdgcn_readlane((int)hiu, 48)));
            const u32 dd = U ^ L;
            const int hb = dd ? 31 - __clz((int)dd) : -1;
            K = dd ? (U & ~((2u << hb) - 1u)) : U;
            bool exact = false;
            for (int bit = hb; bit >= 0; --bit) {
                const u32 cand = K | (1u << bit);
                int cl = 0;
#pragma unroll
                for (int j = 0; j < 64; ++j) cl += (u[j] >= cand) ? 1 : 0;
                const int cnt = wsumi(cl);
                if (cnt >= 256) K = cand;
                if (cnt == 256) { exact = true; break; }
            }
            if (exact) {
                need = 1; ceq = 1;
            } else {
                int cgt = 0, ce = 0;
#pragma unroll
                for (int j = 0; j < 64; ++j) { cgt += __popcll(__ballot(u[j] > K)); ce += __popcll(__ballot(u[j] == K)); }
                need = 256 - cgt;
                ceq = ce;
            }
        }
        SEC_ADD(3, ts0);
        ts0 = SEC_T();
        const u64 ltmask = (1ull << lane) - 1ull;
        u64 myword = 0;
        if (nvalid <= 256 || need == ceq) {
            const u32 Kt = (nvalid > 256) ? K : 1u;
#pragma unroll
            for (int j = 0; j < 64; ++j) {
                const u64 sm = __ballot(u[j] >= Kt);
                myword = (lane == j) ? sm : myword;
            }
        } else {
            int ebase = 0;
#pragma unroll
            for (int j = 0; j < 64; ++j) {
                bool eq = (u[j] == K);
                u64 em = __ballot(eq);
                int erank = ebase + __popcll(em & ltmask);
                bool take = (u[j] > K) || (eq && erank < need);
                ebase += __popcll(em);
                u64 sm = __ballot(take);
                myword = (lane == j) ? sm : myword;
            }
        }
        bits[(long)t * 64 + lane] = myword;
        SEC_ADD(4, ts0);
    }
}

__device__ __forceinline__ void dsa_attn_unit(unsigned char* ws, int b, int qt, unsigned char* smem) {
    const int tid = tidx(), lane = tid & 63, w = tid >> 6;
    const int r32 = lane & 31, hi = lane >> 5;
    const int q0 = qt * 16;
    const int qloc = 4 * w + (r32 >> 3);
    const int tl = q0 + qloc;
    const int head = r32 & 7;
    const u16* proj = (const u16*)(ws + OFF_PROJ);
    const u16* brow = proj + (long)b * SEQ * IN_COLS;
    const u64* bits = (const u64*)(ws + OFF_BITS) + ((long)b * SEQ + q0) * 64;
    u16* yb = (u16*)(ws + OFF_YAB) + (size_t)NTOK * 512;
    unsigned char* bufs = smem;
    u64* lbits = (u64*)(smem + 49152);
    __syncthreads();
    for (int i = tid; i < 16 * 64; i += 256) lbits[i] = bits[i];
    const u16* trow = brow + (long)tl * IN_COLS;
    bf16x8 qr[4];
#pragma unroll
    for (int d0 = 0; d0 < 4; ++d0) qr[d0] = *(const bf16x8*)(trow + C_DQ + head * 64 + d0 * 16 + hi * 8);
    float m = -1e30f, l = 0.f;
    f32x16 o[2];
#pragma unroll
    for (int i = 0; i < 16; ++i) { o[0][i] = 0.f; o[1][i] = 0.f; }
    const int jlast = (q0 + 15) >> 6;
    flash_run<0, true>(0, [&](int c) { return c + 1 <= jlast ? c + 1 : -1; },
                       [&](int j, int r, const u16*& kp, const u16*& vp) {
                           const u16* rp = brow + (long)(64 * j + r) * IN_COLS + C_DKV;
                           kp = rp;
                           vp = rp + 64;
                       },
                       [&](int j, int& lo, int& hl, u64& word) { lo = 0; hl = 0; word = lbits[qloc * 64 + j]; },
                       [&](int, f32x16&, f32x16&) {}, qr, m, l, o, bufs, w, lane);
    const float inv = l > 0.f ? 1.0f / l : 0.f;
    u16* orow = yb + ((long)b * SEQ + tl) * 512 + head * 64;
#pragma unroll
    for (int dh = 0; dh < 2; ++dh)
#pragma unroll
        for (int a = 0; a < 4; ++a) {
            uint2 v = uint2{pack2(o[dh][4 * a] * inv, o[dh][4 * a + 1] * inv), pack2(o[dh][4 * a + 2] * inv, o[dh][4 * a + 3] * inv)};
            *(uint2*)(orow + dh * 32 + 8 * a + 4 * hi) = v;
        }
}

__device__ __forceinline__ int grab_block(unsigned* ctr, int limit, unsigned char* smem) {
    volatile int* slot = (volatile int*)(smem + LDS_BYTES + 8);
    __syncthreads();
    if (threadIdx.x == 0) *slot = (int)__hip_atomic_fetch_add(ctr, 1u, __ATOMIC_RELAXED, __HIP_MEMORY_SCOPE_AGENT);
    __syncthreads();
    const int v = *slot;
    return v < limit ? v : -1;
}
__device__ __forceinline__ int grab_wave(unsigned* ctr, int limit) {
    int v = 0;
    if ((threadIdx.x & 63) == 0) v = (int)__hip_atomic_fetch_add(ctr, 1u, __ATOMIC_RELAXED, __HIP_MEMORY_SCOPE_AGENT);
    v = __builtin_amdgcn_readfirstlane(v);
    return v < limit ? v : -1;
}

#define PE_LD(Q, TB, E0)                                                                      \
    do {                                                                                      \
        asm volatile("" ::: "memory");                                                        \
        _Pragma("unroll") for (int k_ = 0; k_ < 4; ++k_) {                                    \
            const int e_ = (E0) + k_;                                                         \
            const int id_ = (e_ < 64) ? __builtin_amdgcn_readlane(id0, e_) : __builtin_amdgcn_readlane(id1, e_ - 64); \
            Q[k_] = *(const u32x4*)((TB) + (long)id_ * 1024 + lane * 16);                     \
        }                                                                                     \
        asm volatile("" ::: "memory");                                                        \
    } while (0)
#define PE_DOT(Q, PB)                                                                         \
    do {                                                                                      \
        _Pragma("unroll") for (int k_ = 0; k_ < 4; ++k_) {                                    \
            f32x2_t d2_ = {0.f, 0.f};     \
            _Pragma("unroll") for (int i_ = 0; i_ < 4; ++i_) {                                \
                f32x2_t lo_ = __builtin_amdgcn_cvt_pk_f32_fp8((int)Q[k_][i_], false);         \
                f32x2_t hi_ = __builtin_amdgcn_cvt_pk_f32_fp8((int)Q[k_][i_], true);          \
                d2_ += hf2[2 * i_] * lo_;                                                     \
                d2_ += hf2[2 * i_ + 1] * hi_;                                                 \
            }                                                                                 \
            pp[(PB) + k_] = d2_[0] + d2_[1];                                                  \
        }                                                                                     \
    } while (0)
#define PE_AXPY(Q, E0)                                                                        \
    do {                                                                                      \
        _Pragma("unroll") for (int k_ = 0; k_ < 4; ++k_) {                                    \
            const int e_ = (E0) + k_;                                                         \
            const float a_ = __int_as_float((e_ < 64) ? __builtin_amdgcn_readlane(__float_as_int(act0), e_)   \
                                                      : __builtin_amdgcn_readlane(__float_as_int(act1), e_ - 64)); \
            const f32x2_t a2_ = {a_, a_};                                                     \
            _Pragma("unroll") for (int i_ = 0; i_ < 4; ++i_) {                                \
                f32x2_t lo_ = __builtin_amdgcn_cvt_pk_f32_fp8((int)Q[k_][i_], false);         \
                f32x2_t hi_ = __builtin_amdgcn_cvt_pk_f32_fp8((int)Q[k_][i_], true);          \
                acc2[2 * i_] += a2_ * lo_;                                                    \
                acc2[2 * i_ + 1] += a2_ * hi_;                                                \
            }                                                                                 \
        }                                                                                     \
    } while (0)
template <int CTRL>
__device__ __forceinline__ float comb_q(float A, float B, bool bit) {
    const float keep = bit ? B : A, send = bit ? A : B;
    return keep + dpp_qf<CTRL>(send);
}
__device__ __forceinline__ float comb_x(float A, float B, bool bit, int xr) {
    const float keep = bit ? B : A, send = bit ? A : B;
    return keep + __shfl_xor(send, xr);
}
__device__ __forceinline__ float reduce32(float (&pp)[32], int lane) {
    const bool b0 = lane & 1, b1 = lane & 2, b2 = lane & 4, b3 = lane & 8;
#pragma unroll
    for (int j = 0; j < 16; ++j) pp[j] = comb_q<0xB1>(pp[2 * j], pp[2 * j + 1], b0);
#pragma unroll
    for (int j = 0; j < 8; ++j) pp[j] = comb_q<0x4E>(pp[2 * j], pp[2 * j + 1], b1);
#pragma unroll
    for (int j = 0; j < 4; ++j) pp[j] = comb_x(pp[2 * j], pp[2 * j + 1], b2, 4);
#pragma unroll
    for (int j = 0; j < 2; ++j) pp[j] = comb_x(pp[2 * j], pp[2 * j + 1], b3, 8);
    auto sw = __builtin_amdgcn_permlane16_swap(__float_as_uint(pp[0]), __float_as_uint(pp[1]), false, false);
    return xhalf_sum(__uint_as_float(sw[0]) + __uint_as_float(sw[1]));
}
__device__ __forceinline__ void peer_experts_range(unsigned char* ws_, float* xout_, const float* ffn_g, int tbeg, int tend) {
    unsigned char* ws = opq(ws_);
    float* xout = opq(xout_);
    const int lane = tidx() & 63;
    const u16* hbuf = (const u16*)(ws + OFF_YAB);
    const float* ss1 = (const float*)(ws + OFF_SS1);
    const unsigned char* ub = ws + OFF_UB;
    const unsigned char* vb = ws + OFF_VB;
    const int* eidx = (const int*)(ws + OFF_EIDX);
    const float* gate = (const float*)(ws + OFF_GATE);
    const float* usc = (const float*)(ws + OFF_ESC);
    const float* vsc = usc + NEXP;
    int t = tbeg;
    int id0 = 0, id1 = 0;
    float gr0 = 0.f, gr1 = 0.f;
    uint4 h0 = uint4{0u, 0u, 0u, 0u}, h1 = h0;
    u32x4 ua[4], ubq[4];
    if (t < tend) {
        id0 = eidx[(long)t * 128 + lane]; id1 = eidx[(long)t * 128 + 64 + lane];
        gr0 = gate[(long)t * 128 + lane]; gr1 = gate[(long)t * 128 + 64 + lane];
        h0 = *(const uint4*)(hbuf + (long)t * 1024 + lane * 16);
        h1 = *(const uint4*)(hbuf + (long)t * 1024 + lane * 16 + 8);
        PE_LD(ua, ub, 0);
    }
    while (t < tend) {
        const float g0 = gr0 * vsc[id0], g1 = gr1 * vsc[id1];
        const float s0 = usc[id0], s1 = usc[id1];
        float* xr = xout + (long)t * 1024 + lane * 16;
        const float rs1 = rsqrtf(sum16(ss1 + (long)t * 16) * (1.0f / 1024.0f) + EPS);
        f32x2_t hf2[8];
        hf2[0] = f32x2_t{bf_lo(h0.x), bf_hi(h0.x)}; hf2[1] = f32x2_t{bf_lo(h0.y), bf_hi(h0.y)};
        hf2[2] = f32x2_t{bf_lo(h0.z), bf_hi(h0.z)}; hf2[3] = f32x2_t{bf_lo(h0.w), bf_hi(h0.w)};
        hf2[4] = f32x2_t{bf_lo(h1.x), bf_hi(h1.x)}; hf2[5] = f32x2_t{bf_lo(h1.y), bf_hi(h1.y)};
        hf2[6] = f32x2_t{bf_lo(h1.z), bf_hi(h1.z)}; hf2[7] = f32x2_t{bf_lo(h1.w), bf_hi(h1.w)};
        const int tn = t + 1;
        int idn0 = 0, idn1 = 0;
        float gn0 = 0.f, gn1 = 0.f;
        uint4 hn0 = uint4{0u, 0u, 0u, 0u}, hn1 = hn0;
        if (tn < tend) {
            idn0 = eidx[(long)tn * 128 + lane]; idn1 = eidx[(long)tn * 128 + 64 + lane];
            gn0 = gate[(long)tn * 128 + lane]; gn1 = gate[(long)tn * 128 + 64 + lane];
            hn0 = *(const uint4*)(hbuf + (long)tn * 1024 + lane * 16);
            hn1 = *(const uint4*)(hbuf + (long)tn * 1024 + lane * 16 + 8);
        }
        float dq0 = 0.f, dq1 = 0.f, dq2 = 0.f, dq3 = 0.f;
        for (int gq = 0; gq < 4; ++gq) {
            const int e = 32 * gq;
            float pp[32];
#pragma unroll
            for (int q4 = 0; q4 < 32; q4 += 8) {
                PE_LD(ubq, ub, e + q4 + 4);
                PE_DOT(ua, q4);
                if (q4 + 8 < 32 || gq < 3) PE_LD(ua, ub, e + q4 + 8);
                else PE_LD(ua, vb, 0);
                PE_DOT(ubq, q4 + 4);
            }
            const float r = reduce32(pp, lane);
            dq0 = gq == 0 ? r : dq0;
            dq1 = gq == 1 ? r : dq1;
            dq2 = gq == 2 ? r : dq2;
            dq3 = gq == 3 ? r : dq3;
        }
        const float act0 = gelu_tanh((lane < 32 ? dq0 : dq1) * (s0 * rs1)) * g0;
        const float act1 = gelu_tanh((lane < 32 ? dq2 : dq3) * (s1 * rs1)) * g1;
        f32x2_t acc2[8];
#pragma unroll
        for (int i = 0; i < 8; ++i) acc2[i] = f32x2_t{0.f, 0.f};
        for (int b = 0; b < 32; b += 2) {
            PE_LD(ubq, vb, 4 * (b + 1));
            PE_AXPY(ua, 4 * b);
            if (b + 2 < 32) {
                PE_LD(ua, vb, 4 * (b + 2));
            } else if (tn < tend) {
                id0 = idn0; id1 = idn1;
                PE_LD(ua, ub, 0);
            }
            PE_AXPY(ubq, 4 * (b + 1));
        }
        float ss = 0.f;
        u32 pk[8];
#pragma unroll
        for (int i = 0; i < 4; ++i) {
            float4 a = *(const float4*)(xr + 4 * i);
            a.x += acc2[2 * i][0]; a.y += acc2[2 * i][1]; a.z += acc2[2 * i + 1][0]; a.w += acc2[2 * i + 1][1];
            *(float4*)(xr + 4 * i) = a;
            ss += a.x * a.x + a.y * a.y + a.z * a.z + a.w * a.w;
            pk[2 * i] = pack2(a.x, a.y);
            pk[2 * i + 1] = pack2(a.z, a.w);
        }
        u16* hw = (u16*)(ws + OFF_YAB) + (long)t * 1024 + lane * 16;
        *(uint4*)hw = uint4{pk[0], pk[1], pk[2], pk[3]};
        *(uint4*)(hw + 8) = uint4{pk[4], pk[5], pk[6], pk[7]};
        ss = wsum(ss);
        if (lane == 0) ((float*)(ws + OFF_RSTDE))[t] = rsqrtf(ss * (1.0f / 1024.0f) + EPS);
        t = tn; id0 = idn0; id1 = idn1; gr0 = gn0; gr1 = gn1; h0 = hn0; h1 = hn1;
    }
}

__device__ __forceinline__ u32 search_bounds(u32 lanemax, int& hb) {
    const u32 U = row_max16u(lanemax), L = row_min16u(lanemax);
    const u32 d = U ^ L;
    hb = d ? 31 - __clz((int)d) : -1;
    return d ? (U & ~((2u << hb) - 1u)) : U;
}
__device__ __forceinline__ void peer_route(unsigned char* ws, float* xout, const float* ffn_g, int layer, unsigned char* smem, unsigned long long& tacc) {
    const int tid = tidx(), lane = tid & 63, w = tid >> 6;
    const int grp = lane >> 4, k = lane & 15;
    const u32 ltk = (1u << k) - 1u;
    float* tvc = (float*)(smem + w * 4096);
    int* tic = (int*)(smem + w * 4096 + 2048);
    unsigned* rctr = (unsigned*)(ws + OFF_CTR) + (layer * 8 + 3) * 8;
    for (int unit; (unit = grab_wave(rctr, NTOK / 16)) >= 0;) {
        const int tok0 = unit * 16;
        unsigned char* wsu = opq(ws);
        const u16* pq = (const u16*)(wsu + OFF_PQ);
        const u16* skb = (const u16*)(wsu + OFF_W + layer * W_LAYER + WO_SK);
        int* eidx = (int*)(wsu + OFF_EIDX);
        float* gate = (float*)(wsu + OFF_GATE);
        for (int h = 0; h < 8; ++h) {
            for (int half = 0; half < 2; ++half) {
                unsigned long long tr0 = SEC_T();
                bf16x8 af[4];
#pragma unroll
                for (int ks = 0; ks < 4; ++ks)
                    af[ks] = *(const bf16x8*)(pq + (long)(tok0 + k) * 2048 + h * 256 + half * 128 + ks * 32 + grp * 8);
                float sc[8][4];
                u32 u[8][4];
#pragma unroll
                for (int nt = 0; nt < 8; ++nt) {
                    f32x4 acc = f32x4{0.f, 0.f, 0.f, 0.f};
#pragma unroll
                    for (int ks = 0; ks < 4; ++ks) {
                        bf16x8 bfr = *(const bf16x8*)(skb + (size_t)half * 128 * 128 + (size_t)(nt * 16 + k) * 128 + ks * 32 + grp * 8);
                        acc = __builtin_amdgcn_mfma_f32_16x16x32_bf16(af[ks], bfr, acc, 0, 0, 0);
                    }
#pragma unroll
                    for (int i = 0; i < 4; ++i) { sc[nt][i] = acc[i]; u[nt][i] = sortkey(acc[i]); }
                }
                SEC_ADD(11, tr0);
                tr0 = SEC_T();
                u32 K[4];
                bool dn[4] = {false, false, false, false};
                int hbm = -1;
#pragma unroll
                for (int i = 0; i < 4; ++i) {
                    u32 lm = u[0][i];
#pragma unroll
                    for (int nt = 1; nt < 8; ++nt) lm = max(lm, u[nt][i]);
                    int hb;
                    K[i] = search_bounds(lm, hb);
                    hbm = max(hbm, hb);
                }
                const int bit0 = (int)wmax((float)hbm);
                for (int bit = bit0; bit >= 0; --bit) {
                    int packed = 0;
#pragma unroll
                    for (int i = 0; i < 4; ++i) {
                        const u32 cand = K[i] | (1u << bit);
                        int c = 0;
#pragma unroll
                        for (int nt = 0; nt < 8; ++nt) c += (u[nt][i] >= cand) ? 1 : 0;
                        packed |= c << (8 * i);
                    }
                    packed = row_sum16i(packed);
#pragma unroll
                    for (int i = 0; i < 4; ++i)
                        if (((packed >> (8 * i)) & 0xFF) >= 16) K[i] |= (1u << bit);
                    bool done = true;
#pragma unroll
                    for (int i = 0; i < 4; ++i) {
                        const int ci = (packed >> (8 * i)) & 0xFF;
                        done = done && (ci == 16 || dn[i]);
                        dn[i] = dn[i] || (ci == 16);
                    }
                    if (__all(done)) break;
                }
                SEC_ADD(12, tr0);
                tr0 = SEC_T();
                int need[4];
                {
                    int packed = 0;
#pragma unroll
                    for (int i = 0; i < 4; ++i) {
                        int c = 0;
#pragma unroll
                        for (int nt = 0; nt < 8; ++nt) c += (u[nt][i] > K[i]) ? 1 : 0;
                        packed |= c << (8 * i);
                    }
                    packed = row_sum16i(packed);
#pragma unroll
                    for (int i = 0; i < 4; ++i) need[i] = 16 - ((packed >> (8 * i)) & 0xFF);
                }
#pragma unroll
                for (int i = 0; i < 4; ++i) {
                    int ebase = 0, pbase = 0;
                    const int tok = 4 * grp + i;
#pragma unroll
                    for (int nt = 0; nt < 8; ++nt) {
                        const bool eq = (u[nt][i] == K[i]);
                        const u32 emg = (u32)(__ballot(eq) >> (lane & 48)) & 0xFFFFu;
                        const int erank = ebase + __popc(emg & ltk);
                        const bool take = (u[nt][i] > K[i]) || (eq && erank < need[i]);
                        ebase += __popc(emg);
                        const u32 tmg = (u32)(__ballot(take) >> (lane & 48)) & 0xFFFFu;
                        const int pos = pbase + __popc(tmg & ltk);
                        if (take) {
                            tvc[(half * 16 + tok) * 16 + pos] = sc[nt][i];
                            tic[(half * 16 + tok) * 16 + pos] = nt * 16 + k;
                        }
                        pbase += __popc(tmg);
                    }
                }
                SEC_ADD(13, tr0);
            }
            WAVE_SYNC();
            unsigned long long tr2 = SEC_T();
            for (int pass = 0; pass < 4; ++pass) {
                const int tok = 4 * pass + grp;
                const float v1 = tvc[(0 * 16 + tok) * 16 + k];
                const int i1 = tic[(0 * 16 + tok) * 16 + k];
                float c[16];
                u32 uc[16];
#pragma unroll
                for (int r4 = 0; r4 < 4; ++r4) {
                    float4 v2 = *(const float4*)(tvc + (1 * 16 + tok) * 16 + r4 * 4);
                    c[r4 * 4 + 0] = v1 + v2.x;
                    c[r4 * 4 + 1] = v1 + v2.y;
                    c[r4 * 4 + 2] = v1 + v2.z;
                    c[r4 * 4 + 3] = v1 + v2.w;
                }
                float mxl = c[0];
#pragma unroll
                for (int r = 0; r < 16; ++r) { uc[r] = sortkey(c[r]); mxl = fmaxf(mxl, c[r]); }
                const float mx = row_max16f(mxl);
                int hbc;
                u32 Kc = search_bounds(sortkey(mxl), hbc);
                bool dnc = false;
                const int bitc0 = (int)wmax((float)hbc);
                for (int bit = bitc0; bit >= 0; --bit) {
                    const u32 cand = Kc | (1u << bit);
                    int cn = 0;
#pragma unroll
                    for (int r = 0; r < 16; ++r) cn += (uc[r] >= cand) ? 1 : 0;
                    cn = row_sum16i(cn);
                    if (cn >= 16) Kc = cand;
                    dnc = dnc || (cn == 16);
                    if (__all(dnc)) break;
                }
                int cgl = 0, cel = 0;
#pragma unroll
                for (int r = 0; r < 16; ++r) { cgl += (uc[r] > Kc) ? 1 : 0; cel += (uc[r] == Kc) ? 1 : 0; }
                const int needc = 16 - row_sum16i(cgl);
                const int ebefore = row_xscan16i(cel);
                int tl_ = 0, el_ = 0;
                u32 takem = 0u;
                float ex[16];
                float sl = 0.f;
#pragma unroll
                for (int r = 0; r < 16; ++r) {
                    const bool eq = (uc[r] == Kc);
                    const bool tk = (uc[r] > Kc) || (eq && (ebefore + el_) < needc);
                    el_ += eq ? 1 : 0;
                    tl_ += tk ? 1 : 0;
                    takem |= tk ? (1u << r) : 0u;
                    ex[r] = tk ? __expf(c[r] - mx) : 0.f;
                    sl += ex[r];
                }
                const float inv = 1.0f / row_sum16f(sl);
                int pos = row_xscan16i(tl_);
                const long obase = (long)(tok0 + tok) * 128 + h * 16;
                int i2v[16];
#pragma unroll
                for (int r4 = 0; r4 < 4; ++r4) {
                    const int4 q = *(const int4*)(tic + (1 * 16 + tok) * 16 + r4 * 4);
                    i2v[r4 * 4 + 0] = q.x; i2v[r4 * 4 + 1] = q.y; i2v[r4 * 4 + 2] = q.z; i2v[r4 * 4 + 3] = q.w;
                }
#pragma unroll
                for (int r = 0; r < 16; ++r) {
                    if ((takem >> r) & 1u) {
                        const int eid = i1 * 128 + i2v[r];
                        eidx[obase + pos] = eid;
                        gate[obase + pos] = ex[r] * inv;
                        ++pos;
                    }
                }
            }
            SEC_ADD(14, tr2);
            WAVE_SYNC();
        }
        asm volatile("s_waitcnt vmcnt(0)" ::: "memory");
        peer_experts_range(ws, xout, ffn_g, tok0, tok0 + 16);
    }
}

__device__ __forceinline__ void phase_prep(const Params& P, unsigned char* smem) {
    unsigned char* ws = opq(P.ws);
    const long gtid = (long)bidx() * 256 + tidx();
    const long gthreads = (long)gdim() * 256;
    for (int l = 0; l < 2; ++l) {
        unsigned char* wl = ws + OFF_W + l * W_LAYER;
        float* tile = (float*)smem;
        transpose_cvt<true>(P.w_in + (size_t)l * 1024 * IN_COLS, (u16*)(wl + WO_WIN), 1024, IN_COLS, tile, P.attn_norm + l * 1024);
        for (int c = 0; c < 2; ++c) {
            transpose_cvt(P.cmp_w1 + ((size_t)l * 2 + c) * 2048 * 256, (u16*)(wl + WO_W1) + (size_t)c * 256 * 2048, 2048, 256, tile);
            transpose_cvt(P.cmp_w2 + ((size_t)l * 2 + c) * 256 * 64, (u16*)(wl + WO_W2) + (size_t)c * 64 * 256, 256, 64, tile);
        }
        transpose_cvt(P.w_a + (size_t)l * 512 * 1024, (u16*)(wl + WO_WA), 512, 1024, tile);
        transpose_cvt(P.w_b + (size_t)l * 512 * 1024, (u16*)(wl + WO_WB), 512, 1024, tile);
        transpose_cvt(P.w_out + (size_t)l * 1024 * 1024, (u16*)(wl + WO_WO), 1024, 1024, tile);
        transpose_cvt(P.peer_wq + (size_t)l * 1024 * 2048, (u16*)(wl + WO_WQ), 1024, 2048, tile, P.ffn_norm + l * 1024);
        transpose_cvt(P.ple_w + (size_t)l * 256 * 1024, (u16*)(wl + WO_PW), 256, 1024, tile);
        transpose_cvt(P.ple_gw + (size_t)l * 1024 * 1024, (u16*)(wl + WO_PG), 1024, 1024, tile);
        cvt_f32_bf16(P.peer_sk + (size_t)l * 2 * 128 * 128, (u16*)(wl + WO_SK), 2 * 128 * 128);
    }
    for (int u = bidx(); u < 64; u += gdim()) {
        const int l = u >> 5, c = (u >> 4) & 1, kq = u & 15, col = tidx();
        const float* pos = P.cmp_pos + ((size_t)l * 2 + c) * 2048 + kq * 128;
        const float* w1 = P.cmp_w1 + ((size_t)l * 2 + c) * 2048 * 256 + (size_t)kq * 128 * 256;
        float s = 0.f;
#pragma unroll 16
        for (int k = 0; k < 128; ++k) s += pos[k] * w1[(size_t)k * 256 + col];
        ((float*)(ws + OFF_CHID))[(size_t)u * 256 + col] = s;
    }
    {
        float* ropec = (float*)(ws + OFF_ROPE);
        float* ropes = ropec + (size_t)NTOK * 8;
        for (long i = gtid; i < (long)NTOK * 8; i += gthreads) {
            int t = (int)(i >> 3), k = (int)(i & 7);
            double inv = pow(500000.0, -(double)k / 8.0);
            double ang = (double)P.positions[t] * inv;
            ropec[i] = (float)cos(ang);
            ropes[i] = (float)sin(ang);
        }
    }
    {
        const int lane = tidx() & 63;
        u16* xb = (u16*)(ws + OFF_H);
        float* ssa = (float*)(ws + OFF_SSA);
        for (int row = bidx() * 4 + (tidx() >> 6); row < NTOK; row += gdim() * 4) {
            const float* xr = P.x + (long)row * 1024;
            float ss = 0.f;
#pragma unroll
            for (int i = 0; i < 4; ++i) {
                const float4 v = *(const float4*)(xr + i * 256 + lane * 4);
                ss += v.x * v.x + v.y * v.y + v.z * v.z + v.w * v.w;
                *(uint2*)(xb + (long)row * 1024 + i * 256 + lane * 4) = uint2{pack2(v.x, v.y), pack2(v.z, v.w)};
            }
            ss = wsum(ss);
            if (lane < 16) ssa[(long)row * 16 + lane] = lane == 0 ? ss : 0.f;
        }
    }
}

__device__ __forceinline__ void phase_g1(const Params& P, int layer, unsigned char* smem) {
    unsigned char* ws = opq(P.ws);
    u16* proj = (u16*)(ws + OFF_PROJ);
    const float* ropec = (const float*)(ws + OFF_ROPE);
    const float* ropes = ropec + (size_t)NTOK * 8;
    const float* ng = P.nsa_gain + layer * 256;
    const float* dg = P.dsa_gain + layer * 128;
    if (layer == 0 && bidx() < 4) {
        const int l = bidx() >> 1, c = bidx() & 1, col = tidx();
        const float* part = (const float*)(ws + OFF_CHID) + (size_t)(l * 32 + c * 16) * 256 + col;
        float sacc = 0.f;
#pragma unroll
        for (int kq = 0; kq < 16; ++kq) sacc += part[kq * 256];
        ((float*)(ws + OFF_W + l * W_LAYER + WO_CB))[c * 256 + col] = sacc;
    }
    const float* ssa = (const float*)(ws + OFF_SSA) + (size_t)layer * NTOK * 16;
    gemm_phase_rs<0, true>((const u16*)(ws + OFF_H), 1024, (const u16*)(ws + OFF_W + layer * W_LAYER + WO_WIN), 1024, NTOK, IN_COLS, 1024, smem,
                  [=](int row) { return float2{rsqrtf(sum16(ssa + (long)row * 16) * (1.0f / 1024.0f) + EPS), 0.f}; },
                  [=](int row, int col, const float (&v)[8], float2 rs) {
                      const int c64 = __builtin_amdgcn_readfirstlane(col >> 6), cc = (col >> 3) & 7;
                      const float rsx = rs.x;
                      float o[8];
#pragma unroll
                      for (int j = 0; j < 8; ++j) o[j] = v[j] * rsx;
                      const float* gain = nullptr;
                      bool rope = false, sig = false;
                      float scale = 1.0f;
                      if (c64 < 8) { gain = ng; rope = true; scale = 0.125f * 1.4426950408889634f; }
                      else if (c64 < 20) { const int c = (c64 - 8) >> 1; if (c == 2) { gain = ng + 128; rope = true; } else if (c == 4) { gain = ng + 192; rope = true; } }
                      else if (c64 < 28) { gain = dg; rope = true; scale = 0.125f * 1.4426950408889634f; }
                      else if (c64 == 28) { gain = dg + 64; rope = true; }
                      else if (c64 == 29) { }
                      else if (c64 < 38) { rope = true; scale = 0.125f; }
                      else if (c64 == 38) { rope = true; }
                      else if (c64 < 71) { sig = true; }
                      else { sig = (col < C_IW); }
                      if (gain) {
                          float ss = 0.f;
#pragma unroll
                          for (int j = 0; j < 8; ++j) ss += o[j] * o[j];
                          ss += dpp_qf<0xB1>(ss);
                          ss += dpp_qf<0x4E>(ss);
                          ss += __shfl_xor(ss, 4);
                          const float rstd = rsqrtf(ss * (1.0f / 64.0f) + EPS);
                          const float4 g0 = *(const float4*)(gain + cc * 8), g1 = *(const float4*)(gain + cc * 8 + 4);
                          o[0] *= rstd * g0.x; o[1] *= rstd * g0.y; o[2] *= rstd * g0.z; o[3] *= rstd * g0.w;
                          o[4] *= rstd * g1.x; o[5] *= rstd * g1.y; o[6] *= rstd * g1.z; o[7] *= rstd * g1.w;
                      }
                      if (rope) {
                          float pr[8];
#pragma unroll
                          for (int j = 0; j < 8; ++j) pr[j] = dpp_qf<0xB1>(o[j]);
                          if (cc < 2) {
                              const float4 c0 = *(const float4*)(ropec + (long)row * 8), c1 = *(const float4*)(ropec + (long)row * 8 + 4);
                              const float4 s0 = *(const float4*)(ropes + (long)row * 8), s1 = *(const float4*)(ropes + (long)row * 8 + 4);
                              const float cs[8] = {c0.x, c0.y, c0.z, c0.w, c1.x, c1.y, c1.z, c1.w};
                              const float sn[8] = {s0.x, s0.y, s0.z, s0.w, s1.x, s1.y, s1.z, s1.w};
#pragma unroll
                              for (int j = 0; j < 8; ++j) o[j] = (cc == 0) ? (o[j] * cs[j] - pr[j] * sn[j]) : (o[j] * cs[j] + pr[j] * sn[j]);
                          }
                      }
                      if (sig) {
#pragma unroll
                          for (int j = 0; j < 8; ++j) o[j] = sigmoidf(o[j]);
                      }
#pragma unroll
                      for (int j = 0; j < 8; ++j) o[j] *= scale;
                      st_bf8(proj + (long)row * IN_COLS + col, o);
                  });
}

__device__ __forceinline__ void phase_c1(const Params& P, int layer, unsigned char* smem) {
    unsigned char* ws = opq(P.ws);
    unsigned char* wl = ws + OFF_W + layer * W_LAYER;
    const u16* proj = (const u16*)(ws + OFF_PROJ);
    u16* chid = (u16*)(ws + OFF_CHID);
    const float* cbias = (const float*)(wl + WO_CB);
    for (int c = 0; c < 2; ++c) {
        u16* ch = chid + (size_t)c * CROWS * 256;
        const float* cb = cbias + c * 256;
        gemm_phase<1>(proj + C_NKV + c * 128, 0, (const u16*)(wl + WO_W1) + (size_t)c * 256 * 2048, 2048, CROWS, 256, 2048, smem,
                      [=](int row, int col, const float (&v)[8]) {
                          float o[8];
#pragma unroll
                          for (int j = 0; j < 8; ++j) o[j] = gelu_tanh(v[j] + cb[col + j]);
                          st_bf8(ch + (long)row * 256 + col, o);
                      });
    }
}

__device__ __forceinline__ void phase_c2(const Params& P, int layer, unsigned char* smem) {
    unsigned char* ws = opq(P.ws);
    unsigned char* wl = ws + OFF_W + layer * W_LAYER;
    const u16* chid = (const u16*)(ws + OFF_CHID);
    u16* kcb = (u16*)(ws + OFF_KCB);
    u16* vcb = (u16*)(ws + OFF_VCB);
    const float* ropec = (const float*)(ws + OFF_ROPE);
    const float* ropes = ropec + (size_t)NTOK * 8;
    const float* gain = P.nsa_gain + layer * 256 + 64;
    for (int c = 0; c < 2; ++c) {
        u16* dst = c == 0 ? kcb : vcb;
        gemm_phase<0>(chid + (size_t)c * CROWS * 256, 256, (const u16*)(wl + WO_W2) + (size_t)c * 64 * 256, 256, CROWS, 64, 256, smem,
                      [=](int row, int col, const float (&v)[8]) {
                          const int b = row / (NCMP * 2);
                          const int rem = row - b * (NCMP * 2);
                          const int n = rem >> 1, g = rem & 1;
                          const int cc = col >> 3;
                          float o[8];
#pragma unroll
                          for (int j = 0; j < 8; ++j) o[j] = v[j];
                          if (c == 0) {
                              float ss = 0.f;
#pragma unroll
                              for (int j = 0; j < 8; ++j) ss += o[j] * o[j];
                              ss += dpp_qf<0xB1>(ss);
                              ss += dpp_qf<0x4E>(ss);
                              ss += __shfl_xor(ss, 4);
                              const float rstd = rsqrtf(ss * (1.0f / 64.0f) + EPS);
#pragma unroll
                              for (int j = 0; j < 8; ++j) o[j] *= rstd * gain[cc * 8 + j];
                              float pr[8];
#pragma unroll
                              for (int j = 0; j < 8; ++j) pr[j] = dpp_qf<0xB1>(o[j]);
                              if (cc < 2) {
                                  const long tt = (long)b * SEQ + 31 + 16 * n;
#pragma unroll
                                  for (int j = 0; j < 8; ++j) {
                                      const float cs = ropec[tt * 8 + j], sn = ropes[tt * 8 + j];
                                      o[j] = (cc == 0) ? (o[j] * cs - pr[j] * sn) : (o[j] * cs + pr[j] * sn);
                                  }
                              }
                          }
                          st_bf8(dst + ((size_t)(b * 2 + g) * 256 + n) * 64 + col, o);
                      });
    }
}

__device__ __forceinline__ int balance4(int x, int seg) {
    const int k = x / seg, r = x - k * seg;
    return k == 0 ? r : (k == 1 ? 4 * seg - 1 - r : (k == 2 ? seg + r : 3 * seg - 1 - r));
}
__device__ __forceinline__ void phase_att_a(const Params& P, int layer, unsigned char* smem, unsigned long long& tacc) {
    unsigned char* ws = opq(P.ws);
    unsigned* ctr = (unsigned*)(ws + OFF_CTR) + (layer * 8 + 0) * 8;
    const int label = bidx() & 7;
    for (int s8 = 0; s8 < 8; ++s8) {
        const int q = (label + s8) & 7;
        int idx;
        while ((idx = grab_block(ctr + q, 1024, smem)) >= 0) dsa_select_unit(ws, q * 1024 + (1023 - idx), smem, tacc);
    }
}
__device__ __forceinline__ void phase_att_b(const Params& P, int layer, unsigned char* smem) {
    const int label = bidx() & 7;
    {
        unsigned char* ws = opq(P.ws);
        unsigned* ctr = (unsigned*)(ws + OFF_CTR) + (layer * 8 + 1) * 8;
        for (int s8 = 0; s8 < 8; ++s8) {
            const int q = (label + s8) & 7;
            int idx;
            while ((idx = grab_block(ctr + q, 256, smem)) >= 0) dsa_attn_unit(ws, q, 255 - idx, smem);
        }
    }
    {
        unsigned char* ws = opq(P.ws);
        unsigned* ctr = (unsigned*)(ws + OFF_CTR) + (layer * 8 + 2) * 8;
        for (int s8 = 0; s8 < 8; ++s8) {
            const int q = (label + s8) & 7;
            int idx;
            while ((idx = grab_block(ctr + q, 256, smem)) >= 0) {
                const int ub = q + 8 * (idx & 1);
                nsa_unit(ws, ub >> 1, ub & 1, 127 - (idx >> 1), smem);
            }
        }
    }
}

__device__ __forceinline__ void phase_merge(const Params& P, int layer, unsigned char* smem) {
    unsigned char* ws = opq(P.ws);
    unsigned char* wl = ws + OFF_W + layer * W_LAYER;
    const u16* proj = (const u16*)(ws + OFF_PROJ);
    u16* hbuf = (u16*)(ws + OFF_H);
    const u16* ya = (const u16*)(ws + OFF_YAB);
    const u16* yb = ya + (size_t)NTOK * 512;
    gemm_phase<0>(ya, 512, (const u16*)(wl + WO_WA), 512, NTOK, 1024, 512, smem, [=](int row, int col, const float (&v)[8]) {
        float ga[8], o[8];
        ld_bf8(proj + (long)row * IN_COLS + C_MG + col, ga);
#pragma unroll
        for (int j = 0; j < 8; ++j) o[j] = ga[j] * v[j];
        st_bf8(hbuf + (long)row * 1024 + col, o);
    });
    gemm_phase<0>(yb, 512, (const u16*)(wl + WO_WB), 512, NTOK, 1024, 512, smem, [=](int row, int col, const float (&v)[8]) {
        float gb[8], o[8];
        ld_bf8(proj + (long)row * IN_COLS + C_MG + 1024 + col, gb);
        ld_bf8(hbuf + (long)row * 1024 + col, o);
#pragma unroll
        for (int j = 0; j < 8; ++j) o[j] += gb[j] * v[j];
        st_bf8(hbuf + (long)row * 1024 + col, o);
    });
}

__device__ __forceinline__ void phase_outproj(const Params& P, int layer, unsigned char* smem) {
    unsigned char* ws = opq(P.ws);
    unsigned char* wl = ws + OFF_W + layer * W_LAYER;
    float* out = opq(P.out);
    const float* xin = (layer == 0) ? P.x : (const float*)out;
    const bool gemm_first = bidx() < (gdim() >> 1);
    for (int step = 0; step < 2; ++step) {
        if ((step == 0) == gemm_first) {
            u16* xb1 = (u16*)(ws + OFF_YAB);
            float* ss1 = (float*)(ws + OFF_SS1);
            gemm_phase<0>((const u16*)(ws + OFF_H), 1024, (const u16*)(wl + WO_WO), 1024, NTOK, 1024, 1024, smem, [=](int row, int col, const float (&v)[8]) {
                const long o = (long)row * 1024 + col;
                const float4 x0 = *(const float4*)(xin + o), x1 = *(const float4*)(xin + o + 4);
                const float y[8] = {x0.x + v[0], x0.y + v[1], x0.z + v[2], x0.w + v[3], x1.x + v[4], x1.y + v[5], x1.z + v[6], x1.w + v[7]};
                *(float4*)(out + o) = float4{y[0], y[1], y[2], y[3]};
                *(float4*)(out + o + 4) = float4{y[4], y[5], y[6], y[7]};
                st_bf8(xb1 + o, y);
                float ss = 0.f;
#pragma unroll
                for (int j = 0; j < 8; ++j) ss += y[j] * y[j];
                ss += dpp_qf<0xB1>(ss);
                ss += dpp_qf<0x4E>(ss);
                ss += __shfl_xor(ss, 4);
                if ((col & 63) == 0) ss1[(long)row * 16 + (col >> 6)] = ss;
            });
        } else {
            cvt_f32_bf16(P.p + (size_t)layer * NTOK * 256, (u16*)(ws + OFF_PBF), (long)NTOK * 256);
            cvt_rows_fp8(P.peer_u + (size_t)layer * NEXP * 1024, ws + OFF_UB, (float*)(ws + OFF_ESC), NEXP, P.ffn_norm + layer * 1024);
            cvt_rows_fp8(P.peer_v + (size_t)layer * NEXP * 1024, ws + OFF_VB, (float*)(ws + OFF_ESC) + NEXP, NEXP);
        }
    }
}

__device__ __forceinline__ void phase_pq(const Params& P, int layer, unsigned char* smem) {
    unsigned char* ws = opq(P.ws);
    unsigned char* wl = ws + OFF_W + layer * W_LAYER;
    u16* pq = (u16*)(ws + OFF_PQ);
    u16* eb = (u16*)(ws + OFF_H);
    const float* ss1 = (const float*)(ws + OFF_SS1);
    gemm_phase_rs<0, true>((const u16*)(ws + OFF_YAB), 1024, (const u16*)(wl + WO_WQ), 1024, NTOK, 2048, 1024, smem,
                  [=](int row) { return float2{rsqrtf(sum16(ss1 + (long)row * 16) * (1.0f / 1024.0f) + EPS), 0.f}; },
                  [=](int row, int col, const float (&v)[8], float2 rs) {
                      float o[8];
#pragma unroll
                      for (int j = 0; j < 8; ++j) o[j] = v[j] * rs.x;
                      st_bf8(pq + (long)row * 2048 + col, o);
                  });
    float* sse = (float*)(ws + OFF_SSE) + (size_t)layer * NTOK * 16;
    gemm_phase<0>((const u16*)(ws + OFF_PBF), 256, (const u16*)(wl + WO_PW), 256, NTOK, 1024, 256, smem,
                  [=](int row, int col, const float (&v)[8]) {
                      st_bf8(eb + (long)row * 1024 + col, v);
                      float ss = 0.f;
#pragma unroll
                      for (int j = 0; j < 8; ++j) ss += v[j] * v[j];
                      ss += dpp_qf<0xB1>(ss);
                      ss += dpp_qf<0x4E>(ss);
                      ss += __shfl_xor(ss, 4);
                      if ((col & 63) == 0) sse[(long)row * 16 + (col >> 6)] = ss;
                  });
}

__device__ __forceinline__ void phase_final(const Params& P, int layer, unsigned char* smem) {
    unsigned char* ws = opq(P.ws);
    unsigned char* wl = ws + OFF_W + layer * W_LAYER;
    float* out = opq(P.out);
    u16* eb = (u16*)(ws + OFF_H);
    const float* rstd2 = (const float*)(ws + OFF_RSTDE);
    const float* sse = (const float*)(ws + OFF_SSE) + (size_t)layer * NTOK * 16;
    float* ssn = (float*)(ws + OFF_SSA) + (size_t)NTOK * 16;
    const float* pn = P.ple_norm + layer * 1024;
    const bool more = layer == 0;
    gemm_phase_rs<0, true>((const u16*)(ws + OFF_YAB), 1024, (const u16*)(wl + WO_PG), 1024, NTOK, 1024, 1024, smem,
        [=](int row) { return float2{rstd2[row], rsqrtf(sum16(sse + (long)row * 16) * (1.0f / 1024.0f) + EPS)}; },
        [=](int row, int col, const float (&v)[8], float2 rs) {
        const long o = (long)row * 1024 + col;
        float e[8];
        ld_bf8(eb + o, e);
        const float rx = rs.x;
        const float re = rs.y;
        const float4 x0 = *(const float4*)(out + o), x1 = *(const float4*)(out + o + 4);
        const float4 p0 = *(const float4*)(pn + col), p1 = *(const float4*)(pn + col + 4);
        const float xs[8] = {x0.x, x0.y, x0.z, x0.w, x1.x, x1.y, x1.z, x1.w};
        const float ps[8] = {p0.x, p0.y, p0.z, p0.w, p1.x, p1.y, p1.z, p1.w};
        float y[8];
        float ss = 0.f;
#pragma unroll
        for (int j = 0; j < 8; ++j) {
            y[j] = xs[j] + sigmoidf(v[j] * rx) * (e[j] * re * ps[j]);
            ss += y[j] * y[j];
        }
        *(float4*)(out + o) = float4{y[0], y[1], y[2], y[3]};
        *(float4*)(out + o + 4) = float4{y[4], y[5], y[6], y[7]};
        if (more) {
            st_bf8(eb + o, y);
            ss += dpp_qf<0xB1>(ss);
            ss += dpp_qf<0x4E>(ss);
            ss += __shfl_xor(ss, 4);
            if ((col & 63) == 0) ssn[(long)row * 16 + (col >> 6)] = ss;
        }
    });
}


#define XB_TMO      128
#define XB_XCNT(j)  (256  + 64 * (j))
#define XB_XSUB(j)  (1280 + 64 * (j))
#define XB_XGEN(j)  (2304 + 64 * (j))
#define XB_TOP      3328
#define XB_TOPGEN   3392
#define XCD_BAR_WORDS 3456
#define XB_SPIN_CAP (1u << 22)
#define LAS __attribute__((address_space(3)))
__device__ __forceinline__ unsigned xb_ld(unsigned* p) { return __hip_atomic_load(p, __ATOMIC_RELAXED, __HIP_MEMORY_SCOPE_AGENT); }
__device__ __forceinline__ unsigned xb_add(unsigned* p, unsigned v) { return __hip_atomic_fetch_add(p, v, __ATOMIC_RELAXED, __HIP_MEMORY_SCOPE_AGENT); }
__device__ __forceinline__ unsigned xb_xcc_id() { return (unsigned)__builtin_amdgcn_s_getreg((3 << 11) | 20) & 0xFu; }
#define XB_SPIN(cond, bar) do { unsigned _sp = 0; while (cond) { __builtin_amdgcn_s_sleep(1); \
    if ((++_sp & 255u) == 0u) { if (xb_ld(&(bar)[XB_TMO])) break; if (_sp > XB_SPIN_CAP) { atomicAdd(&(bar)[XB_TMO], 1u); break; } } } } while (0)
struct XcdBarrier {
    unsigned* bar; unsigned x;
    volatile LAS unsigned* st;
};
__device__ __forceinline__ XcdBarrier xcd_barrier_post(unsigned* bar, volatile LAS unsigned* st) {
    XcdBarrier b; b.bar = bar; b.x = xb_xcc_id(); b.st = st;
    if (threadIdx.x == 0) (void)xb_add(&bar[XB_XCNT(b.x)], 1u);
    return b;
}
__device__ __forceinline__ void xcd_barrier_complete(unsigned* bar, unsigned x, unsigned& nloc, unsigned& nx) {
    const unsigned G = gridDim.x * gridDim.y * gridDim.z;
    unsigned sum, cnt, mine, sp = 0u;
    for (;;) {
        sum = 0u; cnt = 0u; mine = 0u;
#pragma unroll
        for (unsigned j = 0; j < 16; ++j) { const unsigned c = xb_ld(&bar[XB_XCNT(j)]); sum += c; cnt += (c > 0u) ? 1u : 0u; mine = (j == x) ? c : mine; }
        if (sum == G) break;
        __builtin_amdgcn_s_sleep(1);
        if ((++sp & 255u) == 0u) { if (xb_ld(&bar[XB_TMO])) break; if (sp > XB_SPIN_CAP) { atomicAdd(&bar[XB_TMO], 1u); break; } }
    }
    nloc = mine > 0u ? mine : 1u; nx = cnt > 0u ? cnt : 1u;
}
__device__ __forceinline__ void xcd_barrier(const XcdBarrier& b) {
    asm volatile("s_waitcnt vmcnt(0)" ::: "memory");
    __syncthreads();
    if (threadIdx.x == 0) {
        unsigned* bar = b.bar;
        __builtin_amdgcn_s_waitcnt(0);
        unsigned nloc = b.st[0], nx = b.st[1];
        if (nloc == 0u) { xcd_barrier_complete(bar, b.x, nloc, nx); b.st[0] = nloc; b.st[1] = nx; }
        const unsigned old = xb_add(&bar[XB_XSUB(b.x)], 1u);
        const unsigned gen = old / nloc;
        if (old + 1u == (gen + 1u) * nloc) {
            __builtin_amdgcn_fence(__ATOMIC_RELEASE, "agent");
            asm volatile("s_waitcnt vmcnt(0)" ::: "memory");
            const unsigned og = xb_add(&bar[XB_TOP], 1u);
            const unsigned tg = og / nx;
            if (og + 1u == (tg + 1u) * nx) xb_add(&bar[XB_TOPGEN], 1u);
            else XB_SPIN(xb_ld(&bar[XB_TOPGEN]) == tg, bar);
            __builtin_amdgcn_fence(__ATOMIC_ACQUIRE, "agent");
            xb_add(&bar[XB_XGEN(b.x)], 1u);
            asm volatile("s_waitcnt vmcnt(0)" ::: "memory");
        } else {
            XB_SPIN(xb_ld(&bar[XB_XGEN(b.x)]) == gen, bar);
            __builtin_amdgcn_fence(__ATOMIC_ACQUIRE, "agent");
            asm volatile("s_waitcnt vmcnt(0)" ::: "memory");
        }
    }
    __syncthreads();
}

#ifndef PROBE_MASK
#define PROBE_MASK 0ull
#endif
#ifndef PROBE_MULT
#define PROBE_MULT 4
#endif
#define GSYNC(id)                                                                          \
    do {                                                                                   \
        xcd_barrier(xb);                                                                   \
        if (PROBE_MASK != 0ull) {                                                          \
            unsigned long long now_ = __builtin_amdgcn_s_memrealtime();                    \
            if ((PROBE_MASK >> (id)) & 1ull) tsel += now_ - tprev;                         \
            tprev = now_;                                                                  \
        }                                                                                  \
    } while (0)

__global__ void __launch_bounds__(256, 2)
fwd_kernel(const float* a_x, const float* a_p, const int* a_pos, const float* a_an, const float* a_win, const float* a_ng, const float* a_cp,
           const float* a_cw1, const float* a_cw2, const float* a_dg, const float* a_wa, const float* a_wb, const float* a_wo, const float* a_fn,
           const float* a_wq, const float* a_sk, const float* a_pu, const float* a_pv, const float* a_pw, const float* a_pgw, const float* a_pn,
           float* a_out, unsigned char* a_ws) {
    Params P;
    P.x = a_x; P.p = a_p; P.positions = a_pos; P.attn_norm = a_an; P.w_in = a_win; P.nsa_gain = a_ng; P.cmp_pos = a_cp; P.cmp_w1 = a_cw1;
    P.cmp_w2 = a_cw2; P.dsa_gain = a_dg; P.w_a = a_wa; P.w_b = a_wb; P.w_out = a_wo; P.ffn_norm = a_fn; P.peer_wq = a_wq; P.peer_sk = a_sk;
    P.peer_u = a_pu; P.peer_v = a_pv; P.ple_w = a_pw; P.ple_gw = a_pgw; P.ple_norm = a_pn; P.out = a_out; P.ws = a_ws;
    cg::grid_group grid = cg::this_grid();
    extern __shared__ __attribute__((aligned(16))) unsigned char smem[];
    unsigned long long tprev = 0, tsel = 0;
    if (PROBE_MASK != 0ull) tprev = __builtin_amdgcn_s_memrealtime();
    volatile LAS unsigned* xst = (volatile LAS unsigned*)(smem + LDS_BYTES);
    if (threadIdx.x == 0) { xst[0] = 0u; xst[1] = 0u; xst[2] = 0u; xst[3] = 0u; }
    __syncthreads();
    XcdBarrier xb = xcd_barrier_post((unsigned*)(P.ws + OFF_BAR), xst);
    phase_prep(P, smem);
    grid.sync();
    if (PROBE_MASK != 0ull) {
        unsigned long long now_ = __builtin_amdgcn_s_memrealtime();
        if (PROBE_MASK & 1ull) tsel += now_ - tprev;
        tprev = now_;
    }
    for (int layer = 0; layer < 2; ++layer) {
        const int pb = 1 + 16 * layer;
        phase_g1(P, layer, smem);
        GSYNC(pb + 0);
        phase_c1(P, layer, smem);
        phase_att_a(P, layer, smem, tsel);
        GSYNC(pb + 15);
        phase_c2(P, layer, smem);
        GSYNC(pb + 3);
        phase_att_b(P, layer, smem);
        GSYNC(pb + 5);
        phase_merge(P, layer, smem);
        GSYNC(pb + 6);
        phase_outproj(P, layer, smem);
        GSYNC(pb + 7);
        phase_pq(P, layer, smem);
        GSYNC(pb + 9);
        peer_route(opq(P.ws), opq(P.out), P.ffn_norm + layer * 1024, layer, smem, tsel);
        GSYNC(pb + 11);
        phase_final(P, layer, smem);
        GSYNC(pb + 13);
    }
#ifndef PROBE_BLOCK
#define PROBE_BLOCK 0
#endif
    if (PROBE_MASK != 0ull || PROBE_SEC != 0) {
        if (blockIdx.x == PROBE_BLOCK && threadIdx.x == 0) {
            unsigned long long t0 = __builtin_amdgcn_s_memrealtime();
            while (__builtin_amdgcn_s_memrealtime() - t0 < (unsigned long long)PROBE_MULT * tsel) __builtin_amdgcn_s_sleep(32);
        }
    }
}

extern "C" void kernel_launch(void* const* d_in, const int* in_sizes, int n_in, void* d_out, int out_size, void* d_ws, size_t ws_size,
                              hipStream_t stream) {
    static int grid_blocks = 0;
    if (!grid_blocks) {
        int dev = 0, cus = 0, per_cu = 0;
        (void)hipGetDevice(&dev);
        (void)hipDeviceGetAttribute(&cus, hipDeviceAttributeMultiprocessorCount, dev);
        (void)hipFuncSetAttribute((const void*)fwd_kernel, hipFuncAttributeMaxDynamicSharedMemorySize, LDS_BYTES + 16);
        (void)hipOccupancyMaxActiveBlocksPerMultiprocessor(&per_cu, fwd_kernel, 256, LDS_BYTES + 16);
        if (per_cu > 2) per_cu = 2;
        if (per_cu < 1) per_cu = 1;
        grid_blocks = cus * per_cu;
        if (ws_size < WS_END) fprintf(stderr, "kernel_launch: workspace too small: %zu < %zu\n", ws_size, (size_t)WS_END);
    }
    Params P{};
    P.x = (const float*)d_in[0];
    P.p = (const float*)d_in[1];
    P.positions = (const int*)d_in[2];
    P.attn_norm = (const float*)d_in[3];
    P.w_in = (const float*)d_in[4];
    P.nsa_gain = (const float*)d_in[5];
    P.cmp_pos = (const float*)d_in[6];
    P.cmp_w1 = (const float*)d_in[7];
    P.cmp_w2 = (const float*)d_in[8];
    P.dsa_gain = (const float*)d_in[9];
    P.w_a = (const float*)d_in[10];
    P.w_b = (const float*)d_in[11];
    P.w_out = (const float*)d_in[12];
    P.ffn_norm = (const float*)d_in[13];
    P.peer_wq = (const float*)d_in[14];
    P.peer_sk = (const float*)d_in[15];
    P.peer_u = (const float*)d_in[16];
    P.peer_v = (const float*)d_in[17];
    P.ple_w = (const float*)d_in[18];
    P.ple_gw = (const float*)d_in[19];
    P.ple_norm = (const float*)d_in[20];
    P.out = (float*)d_out;
    P.ws = (unsigned char*)d_ws;
    void* args[] = {(void*)&P.x, (void*)&P.p, (void*)&P.positions, (void*)&P.attn_norm, (void*)&P.w_in, (void*)&P.nsa_gain, (void*)&P.cmp_pos,
                    (void*)&P.cmp_w1, (void*)&P.cmp_w2, (void*)&P.dsa_gain, (void*)&P.w_a, (void*)&P.w_b, (void*)&P.w_out, (void*)&P.ffn_norm,
                    (void*)&P.peer_wq, (void*)&P.peer_sk, (void*)&P.peer_u, (void*)&P.peer_v, (void*)&P.ple_w, (void*)&P.ple_gw,
                    (void*)&P.ple_norm, (void*)&P.out, (void*)&P.ws};
    (void)hipMemsetAsync((unsigned char*)d_ws + OFF_BAR, 0, 3456 * 4 + N_CTR * 4, stream);
    hipError_t e = hipLaunchCooperativeKernel((void*)fwd_kernel, dim3(grid_blocks), dim3(256), args, LDS_BYTES + 16, stream);
    if (e != hipSuccess) fprintf(stderr, "cooperative launch failed: %s (grid %d)\n", hipGetErrorString(e), grid_blocks);
}
```

```cpp
#include <hip/hip_runtime.h>
#include <hip/hip_cooperative_groups.h>
#include <cstdio>
#include <cstdint>
namespace cg = cooperative_groups;
#ifndef PROBE_SEC
#define PROBE_SEC 0
#endif
#define SEC_T() (PROBE_SEC ? __builtin_amdgcn_s_memrealtime() : 0ull)
#define SEC_ADD(k, t0) do { if (PROBE_SEC == (k)) { unsigned long long n_ = SEC_T(); tacc += n_ - (t0); } } while (0)

typedef unsigned short u16;
typedef unsigned int u32;
typedef unsigned long long u64;
using bf16x8 = __attribute__((ext_vector_type(8))) short;
using f32x4 = __attribute__((ext_vector_type(4))) float;
using f32x16 = __attribute__((ext_vector_type(16))) float;
typedef __bf16 bf16x2_t __attribute__((ext_vector_type(2)));

constexpr int D_MODEL = 1024, BATCH = 8, SEQ = 4096, NTOK = BATCH * SEQ;
constexpr int IN_COLS = 4576;
constexpr int C_NQ = 0, C_NKV = 512, C_DQ = 1280, C_DKV = 1792, C_IQ = 1920, C_IK = 2432, C_MG = 2496, C_NG = 4544, C_IW = 4568;
__host__ __device__ constexpr int perm_col(int n) {
    return n < 1280 ? n : n < 1304 ? 4544 + (n - 1280) : n < 1816 ? 1280 + (n - 1304) : n < 1944 ? 1792 + (n - 1816)
         : n < 2456 ? 1920 + (n - 1944) : n < 2520 ? 2432 + (n - 2456) : n < 2528 ? 4568 + (n - 2520) : 2496 + (n - 2528);
}
constexpr int NCMP = 255;
constexpr int CROWS = BATCH * NCMP * 2;
constexpr int NEXP = 16384;
constexpr float EPS = 1e-6f;

constexpr size_t AL(size_t x) { return (x + 255) & ~(size_t)255; }
constexpr size_t WO_WIN = 0;
constexpr size_t WO_W1 = WO_WIN + AL((size_t)IN_COLS * 1024 * 2);
constexpr size_t WO_W2 = WO_W1 + AL((size_t)2 * 256 * 2048 * 2);
constexpr size_t WO_WA = WO_W2 + AL((size_t)2 * 64 * 256 * 2);
constexpr size_t WO_WB = WO_WA + AL((size_t)1024 * 512 * 2);
constexpr size_t WO_WO = WO_WB + AL((size_t)1024 * 512 * 2);
constexpr size_t WO_WQ = WO_WO + AL((size_t)1024 * 1024 * 2);
constexpr size_t WO_PW = WO_WQ + AL((size_t)2048 * 1024 * 2);
constexpr size_t WO_PG = WO_PW + AL((size_t)1024 * 256 * 2);
constexpr size_t WO_SK = WO_PG + AL((size_t)1024 * 1024 * 2);
constexpr size_t WO_CB = WO_SK + AL((size_t)2 * 128 * 128 * 2);
constexpr size_t W_LAYER = WO_CB + AL((size_t)2 * 256 * 4);

constexpr size_t OFF_W = 0;
constexpr size_t OFF_ROPE = OFF_W + 2 * W_LAYER;
constexpr size_t OFF_H = OFF_ROPE + AL((size_t)NTOK * 16 * 4);
constexpr size_t OFF_PROJ = OFF_H + AL((size_t)NTOK * 1024 * 2);
constexpr size_t OFF_YAB = OFF_PROJ + AL((size_t)NTOK * IN_COLS * 2);
constexpr size_t OFF_CHID = OFF_YAB + AL((size_t)NTOK * 1024 * 2);
constexpr size_t OFF_CBUF = OFF_CHID + AL((size_t)2 * CROWS * 256 * 2);
constexpr size_t OFF_KCB = OFF_CBUF + AL((size_t)2 * CROWS * 64 * 4);
constexpr size_t OFF_VCB = OFF_KCB + AL((size_t)BATCH * 2 * 256 * 64 * 2);
constexpr size_t OFF_RSTDE = OFF_VCB + AL((size_t)BATCH * 2 * 256 * 64 * 2);
constexpr size_t OFF_SSA = OFF_RSTDE + AL((size_t)NTOK * 4);
constexpr size_t OFF_SSE = OFF_SSA + AL((size_t)2 * NTOK * 16 * 4);
constexpr size_t OFF_SS1 = OFF_SSE + AL((size_t)2 * NTOK * 16 * 4);
constexpr size_t OFF_BITS = OFF_SS1 + AL((size_t)NTOK * 16 * 4);
__device__ __forceinline__ float sum16(const float* p) {
    const float4 a = *(const float4*)p, b = *(const float4*)(p + 4), c = *(const float4*)(p + 8), d = *(const float4*)(p + 12);
    return ((a.x + a.y) + (a.z + a.w)) + ((b.x + b.y) + (b.z + b.w)) + (((c.x + c.y) + (c.z + c.w)) + ((d.x + d.y) + (d.z + d.w)));
}
constexpr size_t OFF_BAR = OFF_BITS + AL((size_t)NTOK * 64 * 8);
constexpr size_t OFF_CTR = OFF_BAR + 3456 * 4;
constexpr int N_CTR = 512;
constexpr size_t WS_END = OFF_CTR + AL(N_CTR * 4);
constexpr size_t OFF_PQ = OFF_PROJ;
constexpr size_t OFF_UB = OFF_PQ + (size_t)NTOK * 2048 * 2;
constexpr size_t OFF_VB = OFF_UB + (size_t)NEXP * 1024 * 2;
constexpr size_t OFF_EIDX = OFF_VB + (size_t)NEXP * 1024 * 2;
constexpr size_t OFF_GATE = OFF_EIDX + (size_t)NTOK * 128 * 4;
constexpr size_t OFF_ESC = OFF_GATE + (size_t)NTOK * 128 * 4;
constexpr size_t OFF_PBF = OFF_ESC + (size_t)2 * NEXP * 4;
constexpr size_t OFF_ESU = OFF_PBF + (size_t)NTOK * 256 * 2;
static_assert(OFF_ESU + (size_t)NTOK * 128 * 4 <= OFF_YAB, "alias overflow");

constexpr int LDS_BYTES = 65536 + 2048;

struct Params {
    const float* x; const float* p; const int* positions;
    const float* attn_norm; const float* w_in; const float* nsa_gain; const float* cmp_pos; const float* cmp_w1; const float* cmp_w2;
    const float* dsa_gain; const float* w_a; const float* w_b; const float* w_out; const float* ffn_norm; const float* peer_wq;
    const float* peer_sk; const float* peer_u; const float* peer_v; const float* ple_w; const float* ple_gw; const float* ple_norm;
    float* out; unsigned char* ws;
};

__device__ __forceinline__ u16 f2bf(float f) {
    u32 u = __float_as_uint(f);
    u32 r = u + 0x7FFFu + ((u >> 16) & 1u);
    return (u16)(r >> 16);
}
__device__ __forceinline__ float bf2f(u16 h) { return __uint_as_float(((u32)h) << 16); }
__device__ __forceinline__ float bf_lo(u32 w) { return __uint_as_float(w << 16); }
__device__ __forceinline__ float bf_hi(u32 w) { return __uint_as_float(w & 0xFFFF0000u); }
__device__ __forceinline__ u32 pack2(float a, float b) {
    u32 r;
    asm("v_cvt_pk_bf16_f32 %0, %1, %2" : "=v"(r) : "v"(a), "v"(b));
    return r;
}
__device__ __forceinline__ float dot2(u32 a, u32 b, float c) {
    return __builtin_amdgcn_fdot2_f32_bf16(__builtin_bit_cast(bf16x2_t, a), __builtin_bit_cast(bf16x2_t, b), c, false);
}
template <int CTRL>
__device__ __forceinline__ int dppi(int x) { return __builtin_amdgcn_update_dpp(x, x, CTRL, 0xF, 0xF, false); }
template <int CTRL>
__device__ __forceinline__ float dppf(float x) { return __int_as_float(dppi<CTRL>(__float_as_int(x))); }
__device__ __forceinline__ int row_sum16i(int x) {
    x += dppi<0x128>(x);
    x += dppi<0x124>(x);
    x += dppi<0x122>(x);
    x += dppi<0x121>(x);
    return x;
}
template <int CTRL>
__device__ __forceinline__ int dppi0(int x) { return __builtin_amdgcn_update_dpp(0, x, CTRL, 0xF, 0xF, true); }
__device__ __forceinline__ int row_xscan16i(int x) {
    int s = x;
    s += dppi0<0x111>(s);
    s += dppi0<0x112>(s);
    s += dppi0<0x114>(s);
    s += dppi0<0x118>(s);
    return s - x;
}
__device__ __forceinline__ float row_sum16f(float x) {
    x += dppf<0x128>(x);
    x += dppf<0x124>(x);
    x += dppf<0x122>(x);
    x += dppf<0x121>(x);
    return x;
}
__device__ __forceinline__ float row_max16f(float x) {
    x = fmaxf(x, dppf<0x128>(x));
    x = fmaxf(x, dppf<0x124>(x));
    x = fmaxf(x, dppf<0x122>(x));
    x = fmaxf(x, dppf<0x121>(x));
    return x;
}

__device__ __forceinline__ u32 row_max16u(u32 x) {
    x = max(x, (u32)dppi<0x128>((int)x));
    x = max(x, (u32)dppi<0x124>((int)x));
    x = max(x, (u32)dppi<0x122>((int)x));
    x = max(x, (u32)dppi<0x121>((int)x));
    return x;
}
__device__ __forceinline__ u32 row_min16u(u32 x) {
    x = min(x, (u32)dppi<0x128>((int)x));
    x = min(x, (u32)dppi<0x124>((int)x));
    x = min(x, (u32)dppi<0x122>((int)x));
    x = min(x, (u32)dppi<0x121>((int)x));
    return x;
}
template <int CTRL>
__device__ __forceinline__ float dpp_qf(float x) { return __int_as_float(__builtin_amdgcn_update_dpp(0, __float_as_int(x), CTRL, 0xF, 0xF, false)); }
__device__ __forceinline__ float wsum(float v) {
    v = row_sum16f(v);
    const float a = __int_as_float(__builtin_amdgcn_readlane(__float_as_int(v), 0));
    const float b = __int_as_float(__builtin_amdgcn_readlane(__float_as_int(v), 16));
    const float c = __int_as_float(__builtin_amdgcn_readlane(__float_as_int(v), 32));
    const float d = __int_as_float(__builtin_amdgcn_readlane(__float_as_int(v), 48));
    return (a + b) + (c + d);
}
__device__ __forceinline__ float wmax(float v) {
    v = row_max16f(v);
    const float a = __int_as_float(__builtin_amdgcn_readlane(__float_as_int(v), 0));
    const float b = __int_as_float(__builtin_amdgcn_readlane(__float_as_int(v), 16));
    const float c = __int_as_float(__builtin_amdgcn_readlane(__float_as_int(v), 32));
    const float d = __int_as_float(__builtin_amdgcn_readlane(__float_as_int(v), 48));
    return fmaxf(fmaxf(a, b), fmaxf(c, d));
}
__device__ __forceinline__ int wsumi(int v) {
    v = row_sum16i(v);
    return __builtin_amdgcn_readlane(v, 0) + __builtin_amdgcn_readlane(v, 16) + __builtin_amdgcn_readlane(v, 32) + __builtin_amdgcn_readlane(v, 48);
}
__device__ __forceinline__ float sigmoidf(float x) { return 1.0f / (1.0f + __expf(-x)); }
__device__ __forceinline__ float gelu_tanh(float x) {
    float u = 0.7978845608028654f * (x + 0.044715f * x * x * x);
    return 0.5f * x * (1.0f + tanhf(u));
}
__device__ __forceinline__ u32 sortkey(float f) {
    u32 b = __float_as_uint(f);
    return b ^ ((b >> 31) ? 0xFFFFFFFFu : 0x80000000u);
}
#define WAVE_SYNC() asm volatile("s_waitcnt lgkmcnt(0)" ::: "memory")
template <class T>
__device__ __forceinline__ T* opq(T* p) {
    long z = 0;
    asm volatile("" : "+s"(z));
    return (T*)((char*)p + z);
}
__device__ __forceinline__ int tidx() {
    int t = threadIdx.x;
    asm volatile("" : "+v"(t));
    return t;
}
__device__ __forceinline__ int bidx() {
    int b = blockIdx.x;
    asm volatile("" : "+s"(b));
    return b;
}
__device__ __forceinline__ int gdim() {
    int g = gridDim.x;
    asm volatile("" : "+s"(g));
    return g;
}

template <int AMODE, bool HAS_RS, class RowFn, class Epi>
__device__ __forceinline__ void gemm_tile(const u16* __restrict__ Ap, long lda, const u16* __restrict__ BT, long ldb, int M, int N, int K, int m0,
                                          int n0, unsigned char* lds, RowFn rowfn, Epi epi) {
    const int tid = tidx(), lane = tid & 63, w = tid >> 6;
    const int wm = w >> 1, wn = w & 1;
    f32x4 acc[4][4];
#pragma unroll
    for (int i = 0; i < 4; ++i)
#pragma unroll
        for (int j = 0; j < 4; ++j) acc[i][j] = f32x4{0.f, 0.f, 0.f, 0.f};
    long aoff[4], boff[4];
#pragma unroll
    for (int i = 0; i < 4; ++i) {
        const int row = (w * 4 + i) * 8 + (lane >> 3);
        const int kc = (lane & 7) ^ ((row >> 1) & 7);
        int gr = m0 + row;
        if (gr > M - 1) gr = M - 1;
        if (AMODE == 1) {
            int b = gr / (NCMP * 2);
            int rem = gr - b * (NCMP * 2);
            aoff[i] = ((long)b * SEQ + 16 * (rem >> 1)) * IN_COLS + (rem & 1) * 64 + kc * 8;
        } else {
            aoff[i] = (long)gr * lda + kc * 8;
        }
        int gn = n0 + row;
        if (gn > N - 1) gn = N - 1;
        boff[i] = (long)gn * ldb + kc * 8;
    }
    const int nk = K / 64;
#define GEMM_STAGE(kt, bufsel)                                                                                                        \
    do {                                                                                                                              \
        unsigned char* ab_ = lds + (bufsel) * 32768 + w * 4096 + lane * 16;                                                           \
        const long ka_ = (AMODE == 1) ? (long)(kt) * IN_COLS : (long)(kt) * 64;                                                       \
        _Pragma("unroll") for (int i_ = 0; i_ < 4; ++i_) {                                                                            \
            __builtin_amdgcn_global_load_lds((const unsigned*)(Ap + aoff[i_] + ka_), (unsigned*)(ab_ + i_ * 1024), 16, 0, 0);        \
            __builtin_amdgcn_global_load_lds((const unsigned*)(BT + boff[i_] + (long)(kt) * 64), (unsigned*)(ab_ + 16384 + i_ * 1024), 16, 0, 0); \
        }                                                                                                                             \
    } while (0)
    GEMM_STAGE(0, 0);
    asm volatile("s_waitcnt vmcnt(0)" ::: "memory");
    __syncthreads();
    int fa[4], fb[4];
#pragma unroll
    for (int i = 0; i < 4; ++i) {
        const int ra = wm * 64 + i * 16 + (lane & 15), rb = wn * 64 + i * 16 + (lane & 15);
        fa[i] = ra * 128 + ((ra >> 1) & 7) * 16;
        fb[i] = rb * 128 + ((rb >> 1) & 7) * 16;
    }
    for (int kt = 0; kt < nk; ++kt) {
        if (kt + 1 < nk) GEMM_STAGE(kt + 1, (kt + 1) & 1);
        const unsigned char* Ab = lds + (kt & 1) * 32768;
        const unsigned char* Bb = Ab + 16384;
#pragma unroll
        for (int ks = 0; ks < 2; ++ks) {
            const int kc16 = (ks * 4 + (lane >> 4)) * 16;
            bf16x8 af[4], bfr[4];
#pragma unroll
            for (int i = 0; i < 4; ++i) {
                af[i] = *(const bf16x8*)(Ab + ((fa[i] & ~127) | ((fa[i] & 127) ^ kc16)));
                bfr[i] = *(const bf16x8*)(Bb + ((fb[i] & ~127) | ((fb[i] & 127) ^ kc16)));
            }
#pragma unroll
            for (int i = 0; i < 4; ++i)
#pragma unroll
                for (int j = 0; j < 4; ++j) acc[i][j] = __builtin_amdgcn_mfma_f32_16x16x32_bf16(af[i], bfr[j], acc[i][j], 0, 0, 0);
        }
        asm volatile("s_waitcnt vmcnt(0)" ::: "memory");
        __syncthreads();
    }
#undef GEMM_STAGE
    float2* rsl = (float2*)(lds + 34816);
    if (HAS_RS) {
        if (tid < 128) {
            int gr = m0 + tid;
            if (gr > M - 1) gr = M - 1;
            rsl[tid] = rowfn(gr);
        }
        __syncthreads();
    }
    float* st = (float*)(lds + w * 8704);
#pragma unroll
    for (int hh = 0; hh < 2; ++hh) {
#pragma unroll
        for (int m2 = 0; m2 < 2; ++m2)
#pragma unroll
            for (int j = 0; j < 4; ++j)
#pragma unroll
                for (int r = 0; r < 4; ++r) st[(m2 * 16 + (lane >> 4) * 4 + r) * 68 + j * 16 + (lane & 15)] = acc[hh * 2 + m2][j][r];
        WAVE_SYNC();
#pragma unroll
        for (int c = 0; c < 4; ++c) {
            const int id = c * 64 + lane;
            const int rr = id >> 3, cc = id & 7;
            const float4 v0 = *(const float4*)(st + rr * 68 + cc * 8);
            const float4 v1 = *(const float4*)(st + rr * 68 + cc * 8 + 4);
            const float v[8] = {v0.x, v0.y, v0.z, v0.w, v1.x, v1.y, v1.z, v1.w};
            const int row = m0 + wm * 64 + hh * 32 + rr;
            const int col0 = n0 + wn * 64 + cc * 8;
            const float2 rs = HAS_RS ? rsl[wm * 64 + hh * 32 + rr] : float2{1.f, 1.f};
            if (row < M && col0 < N) epi(row, col0, v, rs);
        }
        WAVE_SYNC();
    }
    __syncthreads();
}

template <int AMODE, bool HAS_RS, class RowFn, class Epi>
__device__ __forceinline__ void gemm_phase_rs(const u16* Ap, long lda, const u16* BT, long ldb, int M, int N, int K, unsigned char* lds, RowFn rowfn, Epi epi) {
    const int tm = (M + 127) / 128, tn = (N + 127) / 128;
    const int SW = (tn % 9 == 0) ? 9 : ((tn % 8 == 0) ? 8 : 0);
    const int G = gdim();
    if (SW != 0 && (tm % 8) == 0 && (G % 8) == 0 && (((tm / 8) * (tn / SW)) % 8) == 0) {
        const int nsc = tn / SW;
        const int per = 8 * SW;
        const int nst_x = (tm / 8) * nsc / 8;
        const int x = bidx() & 7, j0 = bidx() >> 3, nper = G >> 3;
        for (int q = j0; q < nst_x * per; q += nper) {
            const int st = (q / per) * 8 + x;
            const int r = q % per;
            const int im = (st / nsc) * 8 + (r % 8), in = (st % nsc) * SW + (r / 8);
            gemm_tile<AMODE, HAS_RS>(Ap, lda, BT, ldb, M, N, K, im * 128, in * 128, lds, rowfn, epi);
        }
    } else {
        for (int t = bidx(); t < tm * tn; t += G) {
            int im = t / tn, in = t - im * tn;
            gemm_tile<AMODE, HAS_RS>(Ap, lda, BT, ldb, M, N, K, im * 128, in * 128, lds, rowfn, epi);
        }
    }
}
template <int AMODE, class Epi>
__device__ __forceinline__ void gemm_phase(const u16* Ap, long lda, const u16* BT, long ldb, int M, int N, int K, unsigned char* lds, Epi epi) {
    gemm_phase_rs<AMODE, false>(Ap, lda, BT, ldb, M, N, K, lds, [](int) { return float2{1.f, 1.f}; },
                                [=](int row, int col, const float (&v)[8], float2) { epi(row, col, v); });
}
__device__ __forceinline__ void st_bf8(u16* p, const float (&v)[8]) {
    *(uint4*)p = uint4{pack2(v[0], v[1]), pack2(v[2], v[3]), pack2(v[4], v[5]), pack2(v[6], v[7])};
}
__device__ __forceinline__ void ld_bf8(const u16* p, float (&v)[8]) {
    const uint4 q = *(const uint4*)p;
    v[0] = bf_lo(q.x); v[1] = bf_hi(q.x); v[2] = bf_lo(q.y); v[3] = bf_hi(q.y);
    v[4] = bf_lo(q.z); v[5] = bf_hi(q.z); v[6] = bf_lo(q.w); v[7] = bf_hi(q.w);
}

template <bool PERM = false>
__device__ __forceinline__ void transpose_cvt(const float* __restrict__ src, u16* __restrict__ dst, int K, int N, float* tile, const float* kgain = nullptr) {
    const int tk = K / 64, tn = (N + 63) / 64;
    const int tid = tidx();
    for (int t = bidx(); t < tk * tn; t += gdim()) {
        const int k0 = (t / tn) * 64, n0 = (t % tn) * 64;
        {
            const int tx = tid & 15, ty = tid >> 4;
#pragma unroll
            for (int i = 0; i < 4; ++i) {
                const int k = ty * 4 + i, n = n0 + tx * 4;
                float4 v = float4{0.f, 0.f, 0.f, 0.f};
                if (n < N) v = *(const float4*)(src + (long)(k0 + k) * N + n);
                const float g = kgain ? kgain[k0 + k] : 1.0f;
                float* trow = tile + k * 65 + tx * 4;
                trow[0] = v.x * g; trow[1] = v.y * g; trow[2] = v.z * g; trow[3] = v.w * g;
            }
        }
        __syncthreads();
        {
            const int kc = tid & 7, nl = tid >> 3;
#pragma unroll
            for (int j = 0; j < 2; ++j) {
                const int nn = nl + 32 * j, n = n0 + nn;
                float v[8];
#pragma unroll
                for (int q = 0; q < 8; ++q) v[q] = tile[(kc * 8 + q) * 65 + nn];
                if (n < N) st_bf8(dst + (long)(PERM ? perm_col(n) : n) * K + k0 + kc * 8, v);
            }
        }
        __syncthreads();
    }
}

__device__ __forceinline__ void cvt_f32_bf16(const float* __restrict__ src, u16* __restrict__ dst, long n) {
    long i = ((long)bidx() * 256 + tidx()) * 8;
    const long stride = (long)gdim() * 256 * 8;
    for (; i < n; i += stride) {
        float4 a = *(const float4*)(src + i);
        float4 b = *(const float4*)(src + i + 4);
        *(uint4*)(dst + i) = uint4{pack2(a.x, a.y), pack2(a.z, a.w), pack2(b.x, b.y), pack2(b.z, b.w)};
    }
}

typedef float f32x2_t __attribute__((ext_vector_type(2)));
__device__ __forceinline__ void cvt_rows_fp8(const float* __restrict__ src, unsigned char* __restrict__ dst, float* __restrict__ scales, int nrows, const float* colgain = nullptr) {
    const int lane = tidx() & 63;
    const int wid = bidx() * 4 + (tidx() >> 6);
    const int nw = gdim() * 4;
    for (int row = wid; row < nrows; row += nw) {
        const float* r = src + (long)row * 1024 + lane * 16;
        float4 q[4];
#pragma unroll
        for (int i = 0; i < 4; ++i) {
            q[i] = *(const float4*)(r + 4 * i);
            if (colgain) {
                const float4 g = *(const float4*)(colgain + lane * 16 + 4 * i);
                q[i].x *= g.x; q[i].y *= g.y; q[i].z *= g.z; q[i].w *= g.w;
            }
        }
        float am = 0.f;
#pragma unroll
        for (int i = 0; i < 4; ++i) am = fmaxf(am, fmaxf(fmaxf(fabsf(q[i].x), fabsf(q[i].y)), fmaxf(fabsf(q[i].z), fabsf(q[i].w))));
        am = wmax(am);
        const float inv = am > 0.f ? 448.0f / am : 0.f;
        if (lane == 0) scales[row] = am > 0.f ? am * (1.0f / 448.0f) : 0.f;
        u32 wv[4];
#pragma unroll
        for (int i = 0; i < 4; ++i) {
            int x = 0;
            x = __builtin_amdgcn_cvt_pk_fp8_f32(q[i].x * inv, q[i].y * inv, x, false);
            x = __builtin_amdgcn_cvt_pk_fp8_f32(q[i].z * inv, q[i].w * inv, x, true);
            wv[i] = (u32)x;
        }
        *(uint4*)(dst + (long)row * 1024 + lane * 16) = uint4{wv[0], wv[1], wv[2], wv[3]};
    }
}

__device__ __forceinline__ void rms_rows(const float* __restrict__ x, const float* __restrict__ g, u16* __restrict__ dst, const u16* __restrict__ e,
                         float* __restrict__ rstd_e) {
    const int lane = tidx() & 63;
    const int wid = bidx() * 4 + (tidx() >> 6);
    const int nw = gdim() * 4;
    for (int row = wid; row < NTOK; row += nw) {
        const float* xr = x + (long)row * 1024;
        float4 v[4];
        float ss = 0.f;
#pragma unroll
        for (int i = 0; i < 4; ++i) {
            v[i] = *(const float4*)(xr + i * 256 + lane * 4);
            ss += v[i].x * v[i].x + v[i].y * v[i].y + v[i].z * v[i].z + v[i].w * v[i].w;
        }
        ss = wsum(ss);
        float rstd = rsqrtf(ss * (1.0f / 1024.0f) + EPS);
#pragma unroll
        for (int i = 0; i < 4; ++i) {
            float4 gg = g ? *(const float4*)(g + i * 256 + lane * 4) : float4{1.f, 1.f, 1.f, 1.f};
            uint2 o = uint2{pack2(v[i].x * rstd * gg.x, v[i].y * rstd * gg.y), pack2(v[i].z * rstd * gg.z, v[i].w * rstd * gg.w)};
            *(uint2*)(dst + (long)row * 1024 + i * 256 + lane * 4) = o;
        }
        if (e) {
            const uint4* er = (const uint4*)(e + (long)row * 1024);
            float es = 0.f;
#pragma unroll
            for (int i = 0; i < 2; ++i) {
                uint4 q = er[i * 64 + lane];
                float a;
                a = bf_lo(q.x); es += a * a; a = bf_hi(q.x); es += a * a;
                a = bf_lo(q.y); es += a * a; a = bf_hi(q.y); es += a * a;
                a = bf_lo(q.z); es += a * a; a = bf_hi(q.z); es += a * a;
                a = bf_lo(q.w); es += a * a; a = bf_hi(q.w); es += a * a;
            }
            es = wsum(es);
            if (lane == 0) rstd_e[row] = rsqrtf(es * (1.0f / 1024.0f) + EPS);
        }
    }
}

__device__ __forceinline__ void head_chunk(u16* ptr, float gain, bool do_norm, float scale, float c, float sn, int lane) {
    float v = bf2f(ptr[lane]);
    if (do_norm) {
        float ss = wsum(v * v);
        v = v * rsqrtf(ss * (1.0f / 64.0f) + EPS) * gain;
    }
    float pv = __shfl_xor(v, 8);
    if (lane < 16) v = (lane < 8) ? (v * c - pv * sn) : (v * c + pv * sn);
    ptr[lane] = f2bf(v * scale);
}
__device__ __forceinline__ u32 sig2(u32 w) { return pack2(sigmoidf(bf_lo(w)), sigmoidf(bf_hi(w))); }

__device__ __forceinline__ void post_proj(unsigned char* ws, const float* ng, const float* dg, unsigned char* smem) {
    u16* proj = (u16*)(ws + OFF_PROJ);
    const float* ropec = (const float*)(ws + OFF_ROPE);
    const float* ropes = ropec + (size_t)NTOK * 8;
    const int lane = tidx() & 63, w = tidx() >> 6;
    u16* lrow = (u16*)(smem + w * 9216);
    const float g_q = ng[lane], g_ks = ng[128 + lane], g_kw = ng[192 + lane], g_dq = dg[lane], g_kb = dg[64 + lane];
    const int wid = bidx() * 4 + w;
    const int nw = gdim() * 4;
    for (int t = wid; t < NTOK; t += nw) {
        uint4* grow = (uint4*)(proj + (long)t * IN_COLS);
        const float c = ropec[(long)t * 8 + (lane & 7)], sn = ropes[(long)t * 8 + (lane & 7)];
#pragma unroll
        for (int i = 0; i < 8; ++i) ((uint4*)lrow)[i * 64 + lane] = grow[i * 64 + lane];
        if (lane < 60) ((uint4*)lrow)[512 + lane] = grow[512 + lane];
        WAVE_SYNC();
        for (int h = 0; h < 8; ++h) head_chunk(lrow + C_NQ + h * 64, g_q, true, 0.125f * 1.4426950408889634f, c, sn, lane);
        for (int g = 0; g < 2; ++g) head_chunk(lrow + C_NKV + (2 * 2 + g) * 64, g_ks, true, 1.0f, c, sn, lane);
        for (int g = 0; g < 2; ++g) head_chunk(lrow + C_NKV + (4 * 2 + g) * 64, g_kw, true, 1.0f, c, sn, lane);
        for (int h = 0; h < 8; ++h) head_chunk(lrow + C_DQ + h * 64, g_dq, true, 0.125f * 1.4426950408889634f, c, sn, lane);
        head_chunk(lrow + C_DKV, g_kb, true, 1.0f, c, sn, lane);
        for (int h = 0; h < 8; ++h) head_chunk(lrow + C_IQ + h * 64, 1.0f, false, 0.125f, c, sn, lane);
        head_chunk(lrow + C_IK, 1.0f, false, 1.0f, c, sn, lane);
        WAVE_SYNC();
#pragma unroll
        for (int i = 0; i < 9; ++i) {
            int idx = i * 64 + lane;
            if (idx < 572) {
                uint4 v = ((const uint4*)lrow)[idx];
                if (idx >= 316 || (idx >= 160 && idx < 163)) v = uint4{sig2(v.x), sig2(v.y), sig2(v.z), sig2(v.w)};
                grow[idx] = v;
            }
        }
        WAVE_SYNC();
    }
}

template <int NH>
__device__ __forceinline__ void qk_chunk(const u16* krow, const u32* qlds, float (&s)[NH]) {
    asm volatile("" ::: "memory");
    uint4 kr[8];
#pragma unroll
    for (int i = 0; i < 8; ++i) kr[i] = ((const uint4*)krow)[i];
#pragma unroll
    for (int h = 0; h < NH; ++h) s[h] = 0.f;
#pragma unroll
    for (int i = 0; i < 8; ++i)
#pragma unroll
        for (int h = 0; h < NH; ++h) {
            uint4 q = *(const uint4*)(qlds + h * 32 + i * 4);
            s[h] = dot2(kr[i].x, q.x, s[h]);
            s[h] = dot2(kr[i].y, q.y, s[h]);
            s[h] = dot2(kr[i].z, q.z, s[h]);
            s[h] = dot2(kr[i].w, q.w, s[h]);
        }
}

template <int NH, class VRow>
__device__ __forceinline__ void pv_chunk(const float* plds, VRow vrow, float (&o)[NH][4], int lane) {
    const int sub = lane >> 4, dq = lane & 15;
#pragma unroll 4
    for (int kk = 0; kk < 16; ++kk) {
        int key = kk * 4 + sub;
        const u16* vp = vrow(key);
        uint2 vv = *(const uint2*)(vp + dq * 4);
        float v0 = bf_lo(vv.x), v1 = bf_hi(vv.x), v2 = bf_lo(vv.y), v3 = bf_hi(vv.y);
#pragma unroll
        for (int h = 0; h < NH; ++h) {
            float ph = plds[key * NH + h];
            o[h][0] += ph * v0;
            o[h][1] += ph * v1;
            o[h][2] += ph * v2;
            o[h][3] += ph * v3;
        }
    }
}

template <int NH, class VRow>
__device__ __forceinline__ void attn_chunk(float (&s)[NH], bool valid, float (&m)[NH], float (&l)[NH], float (&o)[NH][4], float* plds, VRow vrow,
                                           int lane) {
#pragma unroll
    for (int h = 0; h < NH; ++h) {
        float sv = valid ? s[h] : -1e30f;
        float cm = wmax(sv);
        float mn = fmaxf(m[h], cm);
        float alpha = __expf(m[h] - mn);
        float p = valid ? __expf(sv - mn) : 0.f;
        l[h] = l[h] * alpha + wsum(p);
        m[h] = mn;
#pragma unroll
        for (int j = 0; j < 4; ++j) o[h][j] *= alpha;
        plds[lane * NH + h] = p;
    }
    WAVE_SYNC();
    pv_chunk<NH>(plds, vrow, o, lane);
    WAVE_SYNC();
}

#define MFMA32(a, b, c) __builtin_amdgcn_mfma_f32_32x32x16_bf16(a, b, c, 0, 0, 0)
typedef __attribute__((address_space(3))) const char* lds_cptr;
typedef short v4i16_t __attribute__((ext_vector_type(4)));
using s16x4 = __attribute__((ext_vector_type(4))) short;
__device__ __forceinline__ s16x4 vtr(lds_cptr p) {
    return __builtin_bit_cast(s16x4, __builtin_amdgcn_ds_read_tr16_b64_v4i16((__attribute__((address_space(3))) v4i16_t*)p));
}
__device__ __forceinline__ float xhalf_sum(float v) {
    auto r = __builtin_amdgcn_permlane32_swap(__float_as_uint(v), __float_as_uint(v), false, false);
    return __uint_as_float(r[0]) + __uint_as_float(r[1]);
}
__device__ __forceinline__ float xhalf_max(float v) {
    auto r = __builtin_amdgcn_permlane32_swap(__float_as_uint(v), __float_as_uint(v), false, false);
    return fmaxf(__uint_as_float(r[0]), __uint_as_float(r[1]));
}

using u32x4 = __attribute__((ext_vector_type(4))) unsigned;
struct TileRegs { u32x4 k0, k1, v0, v1; };
template <class RowPtr>
__device__ __forceinline__ void tile_load(u32x4& k0, u32x4& k1, u32x4& v0, u32x4& v1, RowPtr rowptr, int w, int lane) {
    const u16 *kp, *vp, *kp2, *vp2;
    rowptr(lane, kp, vp2);
    rowptr(16 * w + (lane >> 2), kp2, vp);
    k0 = *(const u32x4*)(kp + w * 8);
    k1 = *(const u32x4*)(kp + (w + 4) * 8);
    v0 = *(const u32x4*)(vp + (lane & 3) * 8);
    v1 = *(const u32x4*)(vp + 32 + (lane & 3) * 8);
}
__device__ __forceinline__ void tile_store(const u32x4& k0, const u32x4& k1, const u32x4& v0, const u32x4& v1, unsigned char* buf, int w, int lane) {
    *(u32x4*)(buf + w * 1024 + lane * 16) = k0;
    *(u32x4*)(buf + (w + 4) * 1024 + lane * 16) = k1;
    *(u32x4*)(buf + 8192 + (16 * w + (lane >> 2)) * 64 + (lane & 3) * 16) = v0;
    *(u32x4*)(buf + 8192 + 4096 + (16 * w + (lane >> 2)) * 64 + (lane & 3) * 16) = v1;
}
__device__ __forceinline__ void glds16(const void* g, unsigned lds_base) {
    unsigned sv;
    asm volatile("s_mov_b32 %0, m0\n\ts_mov_b32 m0, %2\n\ts_nop 0\n\tglobal_load_lds_dwordx4 %1, off\n\ts_mov_b32 m0, %0"
                 : "=&s"(sv)
                 : "v"(g), "s"(lds_base)
                 : "memory");
}
template <class RowPtr>
__device__ __forceinline__ void tile_dma(RowPtr rowptr, unsigned char* buf, int w, int lane) {
    const u16 *kp, *vp, *kp2, *vp2;
    rowptr(lane, kp, vp2);
    rowptr(16 * w + (lane >> 2), kp2, vp);
    const unsigned kd = (unsigned)__builtin_amdgcn_readfirstlane((int)((unsigned)(uintptr_t)buf + (unsigned)(w * 1024)));
    const unsigned vd = kd + 8192u;
    glds16(kp + w * 8, kd);
    glds16(kp + (w + 4) * 8, kd + 4096u);
    glds16(vp + (lane & 3) * 8, vd);
    glds16(vp + 32 + (lane & 3) * 8, vd + 4096u);
}
__device__ __forceinline__ void qk_tile(const unsigned char* buf, const bf16x8 (&qr)[4], const f32x16& zero16, f32x16& s0, f32x16& s1, int lane) {
    const int r32 = lane & 31, hi = lane >> 5;
    lds_cptr kp = (lds_cptr)buf + hi * 1024 + r32 * 16;
#pragma unroll
    for (int d0 = 0; d0 < 4; ++d0) {
        bf16x8 k0 = *(const __attribute__((address_space(3))) bf16x8*)(kp + d0 * 2048);
        bf16x8 k1 = *(const __attribute__((address_space(3))) bf16x8*)(kp + d0 * 2048 + 512);
        s0 = MFMA32(k0, qr[d0], d0 == 0 ? zero16 : s0);
        s1 = MFMA32(k1, qr[d0], d0 == 0 ? zero16 : s1);
    }
}
__device__ __forceinline__ bf16x8 pack8(const f32x16& p, int s) {
    u32 a = pack2(p[8 * s + 0], p[8 * s + 1]), b = pack2(p[8 * s + 2], p[8 * s + 3]);
    u32 c = pack2(p[8 * s + 4], p[8 * s + 5]), d = pack2(p[8 * s + 6], p[8 * s + 7]);
    u32x4 v = u32x4{a, b, c, d};
    return __builtin_bit_cast(bf16x8, v);
}
__device__ __forceinline__ void pv_tile(const unsigned char* buf, const f32x16& p0, const f32x16& p1, f32x16 (&o)[2], int lane) {
    const int hi = lane >> 5;
    lds_cptr vp = (lds_cptr)buf + 8192 + ((lane >> 4) & 1) * 32 + (lane & 3) * 8 + (4 * hi + ((lane & 15) >> 2)) * 64;
    bf16x8 pf[4];
    pf[0] = pack8(p0, 0);
    pf[1] = pack8(p0, 1);
    pf[2] = pack8(p1, 0);
    pf[3] = pack8(p1, 1);
#pragma unroll
    for (int dh = 0; dh < 2; ++dh) {
        bf16x8 vf[4];
#pragma unroll
        for (int ks = 0; ks < 4; ++ks) {
            const uint2 vlo = __builtin_bit_cast(uint2, vtr(vp + dh * 4096 + ks * 1024));
            const uint2 vhi = __builtin_bit_cast(uint2, vtr(vp + dh * 4096 + ks * 1024 + 512));
            const u32x4 vq = u32x4{vlo.x, vlo.y, vhi.x, vhi.y};
            vf[ks] = __builtin_bit_cast(bf16x8, vq);
        }
        __builtin_amdgcn_sched_barrier(0);
#pragma unroll
        for (int ks = 0; ks < 4; ++ks) o[dh] = MFMA32(vf[ks], pf[ks], o[dh]);
        __builtin_amdgcn_sched_barrier(0);
    }
}
template <bool BITS>
__device__ __forceinline__ void apply_mask(f32x16& s0, f32x16& s1, int lo, int hi_lim, u64 word, int hi) {
    const u32 wlo = (u32)(word >> (4 * hi)), whi = (u32)(word >> (32 + 4 * hi));
#pragma unroll
    for (int i = 0; i < 16; ++i) {
        const int kc = (i & 3) + 8 * (i >> 2);
        bool v0, v1;
        if (BITS) {
            v0 = (wlo >> kc) & 1u;
            v1 = (whi >> kc) & 1u;
        } else {
            const int kk = kc + 4 * hi;
            v0 = (kk >= lo) && (kk <= hi_lim);
            v1 = (kk + 32 >= lo) && (kk + 32 <= hi_lim);
        }
        s0[i] = v0 ? s0[i] : -1e30f;
        s1[i] = v1 ? s1[i] : -1e30f;
    }
}
__device__ __forceinline__ void softmax_step(f32x16& s0, f32x16& s1, float& m, float& l, f32x16 (&o)[2]) {
    float mx = fmaxf(s0[0], s1[0]);
#pragma unroll
    for (int i = 1; i < 16; ++i) mx = fmaxf(fmaxf(mx, s0[i]), s1[i]);
    mx = xhalf_max(mx);
    if (__any(mx > m + 8.0f)) {
        const float mn = fmaxf(m, mx);
        const float alpha = __builtin_amdgcn_exp2f(m - mn);
        l *= alpha;
        m = mn;
#pragma unroll
        for (int i = 0; i < 16; ++i) { o[0][i] *= alpha; o[1][i] *= alpha; }
    }
    const float ms = fmaxf(m, -1e29f);
    float sum = 0.f;
#pragma unroll
    for (int i = 0; i < 16; ++i) {
        s0[i] = __builtin_amdgcn_exp2f(s0[i] - ms);
        s1[i] = __builtin_amdgcn_exp2f(s1[i] - ms);
        sum += s0[i] + s1[i];
    }
    l += xhalf_sum(sum);
}

template <int MODE, bool BITS, class Next, class RowPtr, class MaskFn, class Extra>
__device__ __forceinline__ void flash_run(int first, Next next, RowPtr rowptr, MaskFn maskfn, Extra extra, const bf16x8 (&qr)[4], float& m, float& l,
                                          f32x16 (&o)[2], unsigned char* bufs, int w, int lane) {
    if (first < 0) return;
    int cur = first;
    int nxt = next(cur);
    asm volatile("" ::"v"(qr[0]), "v"(qr[1]), "v"(qr[2]), "v"(qr[3]));
    __syncthreads();
    tile_dma([&](int r, const u16*& kp, const u16*& vp) { rowptr(cur, r, kp, vp); }, bufs, w, lane);
    if (nxt >= 0) tile_dma([&](int r, const u16*& kp, const u16*& vp) { rowptr(nxt, r, kp, vp); }, bufs + 16384, w, lane);
    int pb = 0, pb2 = 2;
    f32x16 zero16;
#pragma unroll
    for (int i = 0; i < 16; ++i) zero16[i] = 0.f;
    while (cur >= 0) {
        if (nxt >= 0) asm volatile("s_waitcnt vmcnt(4)" ::: "memory");
        else asm volatile("s_waitcnt vmcnt(0)" ::: "memory");
        asm volatile("s_waitcnt lgkmcnt(0)" ::: "memory");
        __builtin_amdgcn_s_barrier();
        const int nn = nxt >= 0 ? next(nxt) : -1;
        if (nn >= 0) tile_dma([&](int r, const u16*& kp, const u16*& vp) { rowptr(nn, r, kp, vp); }, bufs + pb2 * 16384, w, lane);
        const unsigned char* buf = bufs + pb * 16384;
        f32x16 s0, s1;
        qk_tile(buf, qr, zero16, s0, s1, lane);
        int lo, hl;
        u64 word;
        maskfn(cur, lo, hl, word);
        if (BITS || !__all(lo <= 0 && hl >= 63)) apply_mask<BITS>(s0, s1, lo, hl, word, lane >> 5);
        if (MODE == 0) {
            softmax_step(s0, s1, m, l, o);
            pv_tile(buf, s0, s1, o, lane);
        } else if (MODE == 1) {
            f32x16 od[2];
#pragma unroll
            for (int i = 0; i < 16; ++i) { od[0][i] = 0.f; od[1][i] = 0.f; }
            softmax_step(s0, s1, m, l, od);
        } else {
            const float ms2 = fmaxf(m, -1e29f);
#pragma unroll
            for (int i = 0; i < 16; ++i) {
                s0[i] = __builtin_amdgcn_exp2f(s0[i] - ms2) * l;
                s1[i] = __builtin_amdgcn_exp2f(s1[i] - ms2) * l;
            }
            extra(cur, s0, s1);
            pv_tile(buf, s0, s1, o, lane);
        }
        pb = (pb == 2) ? 0 : pb + 1;
        pb2 = (pb2 == 2) ? 0 : pb2 + 1;
        cur = nxt;
        nxt = nn;
    }
}

__device__ __forceinline__ void nsa_unit(unsigned char* ws, int b, int g, int qt, unsigned char* smem) {
    const int tid = tidx(), lane = tid & 63, w = tid >> 6;
    const int r32 = lane & 31, hi = lane >> 5;
    const int q0 = qt * 32;
    const int tl = q0 + 8 * w + (r32 >> 2);
    const int rep = r32 & 3;
    const u16* proj = (const u16*)(ws + OFF_PROJ);
    const u16* brow = proj + (long)b * SEQ * IN_COLS;
    const u16* kcb = (const u16*)(ws + OFF_KCB) + (size_t)(b * 2 + g) * 256 * 64;
    const u16* vcb = (const u16*)(ws + OFF_VCB) + (size_t)(b * 2 + g) * 256 * 64;
    u16* ya = (u16*)(ws + OFF_YAB);
    unsigned char* bufs = smem;
    float* imp = (float*)(smem + 49152);
    u64* selm = (u64*)(smem + 49152 + 8192);
    const u16* trow = brow + (long)tl * IN_COLS;
    bf16x8 qr[4];
#pragma unroll
    for (int d0 = 0; d0 < 4; ++d0) qr[d0] = *(const bf16x8*)(trow + C_NQ + (g * 4 + rep) * 64 + d0 * 16 + hi * 8);
    const float gate_c = bf2f(trow[C_NG + 0 * 8 + g * 4 + rep]);
    const float gate_s = bf2f(trow[C_NG + 1 * 8 + g * 4 + rep]);
    const float gate_w = bf2f(trow[C_NG + 2 * 8 + g * 4 + rep]);
    for (int i = tid; i < 32 * 64; i += 256) imp[i] = 0.f;
    f32x16 tot[2];
#pragma unroll
    for (int i = 0; i < 16; ++i) { tot[0][i] = 0.f; tot[1][i] = 0.f; }

    const int nvalid = tl >= 31 ? ((tl - 31) >> 4) + 1 : 0;
    const int nv_max = (q0 + 31 >= 31) ? ((q0 + 31 - 31) >> 4) + 1 : 0;
    const int ntile_c = (nv_max + 63) >> 6;
    auto crows = [&](int tile, int r, const u16*& kp, const u16*& vp) {
        int n = tile * 64 + r;
        n = n < 254 ? n : 254;
        kp = kcb + (size_t)n * 64;
        vp = vcb + (size_t)n * 64;
    };
    auto cnext = [&](int c) { return (c + 1 < ntile_c) ? c + 1 : -1; };
    auto cmask = [&](int tile, int& lo, int& hl, u64& word) { lo = 0; hl = nvalid - 64 * tile - 1; word = 0; };
    {
        float m = -1e30f, l = 0.f;
        f32x16 o[2];
#pragma unroll
        for (int i = 0; i < 16; ++i) { o[0][i] = 0.f; o[1][i] = 0.f; }
        flash_run<1, false>(ntile_c > 0 ? 0 : -1, cnext, crows, cmask, [&](int, f32x16&, f32x16&) {}, qr, m, l, o, bufs, w, lane);
        float invl = l > 0.f ? 1.0f / l : 0.f;
        const int qloc = 8 * w + (r32 >> 2);
        flash_run<2, false>(ntile_c > 0 ? 0 : -1, cnext, crows, cmask,
                            [&](int tile, f32x16& p0, f32x16& p1) {
#pragma unroll
                                for (int a = 0; a < 4; ++a) {
                                    float g0 = p0[4 * a] + p0[4 * a + 1] + p0[4 * a + 2] + p0[4 * a + 3], e0 = p0[4 * a + 3];
                                    float g1 = p1[4 * a] + p1[4 * a + 1] + p1[4 * a + 2] + p1[4 * a + 3], e1 = p1[4 * a + 3];
                                    g0 += __shfl_xor(g0, 1); g0 += __shfl_xor(g0, 2);
                                    e0 += __shfl_xor(e0, 1); e0 += __shfl_xor(e0, 2);
                                    g1 += __shfl_xor(g1, 1); g1 += __shfl_xor(g1, 2);
                                    e1 += __shfl_xor(e1, 1); e1 += __shfl_xor(e1, 2);
                                    if (rep == 0) {
                                        int j0 = 16 * tile + 2 * a + hi, j1 = j0 + 8;
                                        atomicAdd(&imp[qloc * 64 + j0], g0);
                                        if (j0 + 1 < 64) atomicAdd(&imp[qloc * 64 + j0 + 1], e0);
                                        if (j1 < 64) atomicAdd(&imp[qloc * 64 + j1], g1);
                                        if (j1 + 1 < 64) atomicAdd(&imp[qloc * 64 + j1 + 1], e1);
                                    }
                                }
                            },
                            qr, m, invl, o, bufs, w, lane);
#pragma unroll
        for (int i = 0; i < 16; ++i) { tot[0][i] += gate_c * o[0][i]; tot[1][i] += gate_c * o[1][i]; }
    }
    __syncthreads();
    for (int qq = 0; qq < 8; ++qq) {
        const int qi = 8 * w + qq;
        const int tq = q0 + qi;
        const int cur = tq >> 6;
        const int j = lane;
        float v = imp[qi * 64 + j];
        if (j == 0 || j == cur || j == cur - 1) v = __builtin_inff();
        if (j > cur) v = -__builtin_inff();
        const u32 key = sortkey(v);
        u32 Kq = 0u;
        for (int bit = 31; bit >= 0; --bit) {
            const u32 cand = Kq | (1u << bit);
            const int cnt = __popcll(__ballot(key >= cand));
            if (cnt >= 16) Kq = cand;
            if (cnt == 16) break;
        }
        const int needq = 16 - __popcll(__ballot(key > Kq));
        const u64 emq = __ballot(key == Kq);
        const bool takeq = (key > Kq) || (key == Kq && __popcll(emq & ((1ull << lane) - 1ull)) < needq);
        u64 sm = __ballot(takeq && j <= cur);
        if (lane == 0) selm[qi] = sm;
    }
    __syncthreads();
    const u64 mymask = selm[8 * w + (r32 >> 2)];
    u64 unionm = 0;
    for (int i = 0; i < 32; ++i) unionm |= selm[i];
    unionm = __builtin_amdgcn_readfirstlane((u32)unionm) | ((u64)__builtin_amdgcn_readfirstlane((u32)(unionm >> 32)) << 32);
    {
        float m = -1e30f, l = 0.f;
        f32x16 o[2];
#pragma unroll
        for (int i = 0; i < 16; ++i) { o[0][i] = 0.f; o[1][i] = 0.f; }
        auto snext = [&](int c) {
            u64 rest = (c >= 63) ? 0ull : (unionm >> (c + 1));
            return rest ? (c + 1 + (__ffsll((long long)rest) - 1)) : -1;
        };
        const int first = unionm ? (__ffsll((long long)unionm) - 1) : -1;
        flash_run<0, false>(first, snext,
                            [&](int j, int r, const u16*& kp, const u16*& vp) {
                                const u16* rp = brow + (long)(64 * j + r) * IN_COLS + C_NKV;
                                kp = rp + (2 * 2 + g) * 64;
                                vp = rp + (3 * 2 + g) * 64;
                            },
                            [&](int j, int& lo, int& hl, u64& word) { lo = 0; hl = ((mymask >> j) & 1ull) ? (tl - 64 * j) : -1; word = 0; },
                            [&](int, f32x16&, f32x16&) {}, qr, m, l, o, bufs, w, lane);
        const float sc = l > 0.f ? gate_s / l : 0.f;
#pragma unroll
        for (int i = 0; i < 16; ++i) { tot[0][i] += sc * o[0][i]; tot[1][i] += sc * o[1][i]; }
    }
    {
        float m = -1e30f, l = 0.f;
        f32x16 o[2];
#pragma unroll
        for (int i = 0; i < 16; ++i) { o[0][i] = 0.f; o[1][i] = 0.f; }
        const int jfirst = (q0 - 511) > 0 ? ((q0 - 511) >> 6) : 0;
        const int jlast = (q0 + 31) >> 6;
        flash_run<0, false>(jfirst, [&](int c) { return c + 1 <= jlast ? c + 1 : -1; },
                            [&](int j, int r, const u16*& kp, const u16*& vp) {
                                const u16* rp = brow + (long)(64 * j + r) * IN_COLS + C_NKV;
                                kp = rp + (4 * 2 + g) * 64;
                                vp = rp + (5 * 2 + g) * 64;
                            },
                            [&](int j, int& lo, int& hl, u64& word) { lo = tl - 511 - 64 * j; hl = tl - 64 * j; word = 0; },
                            [&](int, f32x16&, f32x16&) {}, qr, m, l, o, bufs, w, lane);
        const float sc = l > 0.f ? gate_w / l : 0.f;
#pragma unroll
        for (int i = 0; i < 16; ++i) { tot[0][i] += sc * o[0][i]; tot[1][i] += sc * o[1][i]; }
    }
    {
        u16* orow = ya + ((long)b * SEQ + tl) * 512 + (g * 4 + rep) * 64;
#pragma unroll
        for (int dh = 0; dh < 2; ++dh)
#pragma unroll
            for (int a = 0; a < 4; ++a) {
                uint2 v = uint2{pack2(tot[dh][4 * a], tot[dh][4 * a + 1]), pack2(tot[dh][4 * a + 2], tot[dh][4 * a + 3])};
                *(uint2*)(orow + dh * 32 + 8 * a + 4 * hi) = v;
            }
    }
}

__device__ __forceinline__ void dsa_select_unit(unsigned char* ws, int unit, unsigned char* smem, unsigned long long& tacc) {
    const int tid = tidx(), lane = tid & 63, w = tid >> 6;
    const int t0 = unit * 4;
    const int b = t0 / SEQ, tl0 = t0 - b * SEQ;
    const u16* proj = (const u16*)(ws + OFF_PROJ);
    const u16* brow = proj + (long)b * SEQ * IN_COLS;
    u64* bits = (u64*)(ws + OFF_BITS);
    float* sc = (float*)smem;
    __syncthreads();
    unsigned long long ts0 = SEC_T();
#ifndef ATTA_REP_IDX
#define ATTA_REP_IDX 1
#endif
#ifndef ATTA_REP_TOPK
#define ATTA_REP_TOPK 1
#endif
    for (int rep_ = 0; rep_ < ATTA_REP_IDX; ++rep_) {
        const int r16 = lane & 15, g4 = lane >> 4;
        bf16x8 af[2][2];
#pragma unroll
        for (int rb = 0; rb < 2; ++rb)
#pragma unroll
            for (int ks = 0; ks < 2; ++ks)
                af[rb][ks] = *(const bf16x8*)(proj + (long)(t0 + 2 * rb + (r16 >> 3)) * IN_COLS + C_IQ + (r16 & 7) * 64 + ks * 32 + g4 * 8);
        float wq[2][4];
#pragma unroll
        for (int rb = 0; rb < 2; ++rb)
#pragma unroll
            for (int i = 0; i < 4; ++i)
                wq[rb][i] = bf2f(proj[(long)(t0 + 2 * rb + (g4 >> 1)) * IN_COLS + C_IW + (g4 & 1) * 4 + i]) * 0.35355339059327373f;
        const int ntiles = (tl0 + 4 + 31) >> 5;
#define IDX_LD(T, B)                                                                                         \
    do {                                                                                                     \
        _Pragma("unroll") for (int kt = 0; kt < 2; ++kt) {                                                   \
            int key_ = (T) * 32 + kt * 16 + r16;                                                             \
            key_ = key_ < SEQ ? key_ : SEQ - 1;                                                              \
            _Pragma("unroll") for (int ks = 0; ks < 2; ++ks)                                                 \
                B[kt][ks] = *(const bf16x8*)(brow + (long)key_ * IN_COLS + C_IK + ks * 32 + g4 * 8);         \
        }                                                                                                    \
    } while (0)
        asm volatile("" ::"v"(af[0][0]), "v"(af[0][1]), "v"(af[1][0]), "v"(af[1][1]));
        asm volatile("" ::"v"(wq[0][0]), "v"(wq[0][1]), "v"(wq[0][2]), "v"(wq[0][3]), "v"(wq[1][0]), "v"(wq[1][1]), "v"(wq[1][2]), "v"(wq[1][3]));
        bf16x8 bn[2][2];
        if (w < ntiles) IDX_LD(w, bn);
        for (int tile = w; tile < ntiles; tile += 4) {
            bf16x8 bc[2][2];
#pragma unroll
            for (int kt = 0; kt < 2; ++kt)
#pragma unroll
                for (int ks = 0; ks < 2; ++ks) bc[kt][ks] = bn[kt][ks];
            if (tile + 4 < ntiles) IDX_LD(tile + 4, bn);
#pragma unroll
            for (int rb = 0; rb < 2; ++rb)
#pragma unroll
                for (int kt = 0; kt < 2; ++kt) {
                    f32x4 acc = f32x4{0.f, 0.f, 0.f, 0.f};
                    acc = __builtin_amdgcn_mfma_f32_16x16x32_bf16(af[rb][0], bc[kt][0], acc, 0, 0, 0);
                    acc = __builtin_amdgcn_mfma_f32_16x16x32_bf16(af[rb][1], bc[kt][1], acc, 0, 0, 0);
                    float part = 0.f;
#pragma unroll
                    for (int i = 0; i < 4; ++i) part += wq[rb][i] * fmaxf(acc[i], 0.f);
                    auto sw = __builtin_amdgcn_permlane16_swap(__float_as_uint(part), __float_as_uint(part), false, false);
                    const float tot = __uint_as_float(sw[0]) + __uint_as_float(sw[1]);
                    if ((g4 & 1) == 0) sc[(2 * rb + (g4 >> 1)) * 4096 + tile * 32 + kt * 16 + r16] = tot;
                }
        }
#undef IDX_LD
    }
    __syncthreads();
    SEC_ADD(1, ts0);
    ts0 = SEC_T();
    const int t = t0 + w;
    const int tl = tl0 + w;
    const int nvalid = tl + 1;
    for (int rep_ = 0; rep_ < ATTA_REP_TOPK; ++rep_) {
        u32 u[64];
        const float* scq = sc + w * 4096;
#pragma unroll
        for (int j = 0; j < 64; ++j) {
            const int key = j * 64 + lane;
            const u32 kk = sortkey(scq[key]);
            u[j] = (key <= tl) ? kk : 0u;
        }
        SEC_ADD(2, ts0);
        ts0 = SEC_T();
        u32 K = 0;
        int need = 0, ceq = 0;
        if (nvalid > 256) {
            u32 lm0 = u[0], lm1 = u[1], lm2 = u[2], lm3 = u[3];
#pragma unroll
            for (int j = 4; j < 64; j += 4) { lm0 = max(lm0, u[j]); lm1 = max(lm1, u[j + 1]); lm2 = max(lm2, u[j + 2]); lm3 = max(lm3, u[j + 3]); }
            u32 lo = min(min(lm0, lm1), min(lm2, lm3)), hiu = max(max(lm0, lm1), max(lm2, lm3));
            lo = row_min16u(lo);
            hiu = row_max16u(hiu);
            const u32 L = min(min((u32)__builtin_amdgcn_readlane((int)lo, 0), (u32)__builtin_amdgcn_readlane((int)lo, 16)),
                              min((u32)__builtin_amdgcn_readlane((int)lo, 32), (u32)__builtin_amdgcn_readlane((int)lo, 48)));
            const u32 U = max(max((u32)__builtin_amdgcn_readlane((int)hiu, 0), (u32)__builtin_amdgcn_readlane((int)hiu, 16)),
                              max((u32)__builtin_amdgcn_readlane((int)hiu, 32), (u32)__builtin_amdgcn_readlane((int)hiu, 48)));
            const u32 dd = U ^ L;
            const int hb = dd ? 31 - __clz((int)dd) : -1;
            K = dd ? (U & ~((2u << hb) - 1u)) : U;
            bool exact = false;
            for (int bit = hb; bit >= 0; --bit) {
                const u32 cand = K | (1u << bit);
                int cl = 0;
#pragma unroll
                for (int j = 0; j < 64; ++j) cl += (u[j] >= cand) ? 1 : 0;
                const int cnt = wsumi(cl);
                if (cnt >= 256) K = cand;
                if (cnt == 256) { exact = true; break; }
            }
            if (exact) {
                need = 1; ceq = 1;
            } else {
                int cgt = 0, ce = 0;
#pragma unroll
                for (int j = 0; j < 64; ++j) { cgt += __popcll(__ballot(u[j] > K)); ce += __popcll(__ballot(u[j] == K)); }
                need = 256 - cgt;
                ceq = ce;
            }
        }
        SEC_ADD(3, ts0);
        ts0 = SEC_T();
        const u64 ltmask = (1ull << lane) - 1ull;
        u64 myword = 0;
        if (nvalid <= 256 || need == ceq) {
            const u32 Kt = (nvalid > 256) ? K : 1u;
#pragma unroll
            for (int j = 0; j < 64; ++j) {
                const u64 sm = __ballot(u[j] >= Kt);
                myword = (lane == j) ? sm : myword;
            }
        } else {
            int ebase = 0;
#pragma unroll
            for (int j = 0; j < 64; ++j) {
                bool eq = (u[j] == K);
                u64 em = __ballot(eq);
                int erank = ebase + __popcll(em & ltmask);
                bool take = (u[j] > K) || (eq && erank < need);
                ebase += __popcll(em);
                u64 sm = __ballot(take);
                myword = (lane == j) ? sm : myword;
            }
        }
        bits[(long)t * 64 + lane] = myword;
        SEC_ADD(4, ts0);
    }
}

__device__ __forceinline__ void dsa_attn_unit(unsigned char* ws, int b, int qt, unsigned char* smem) {
    const int tid = tidx(), lane = tid & 63, w = tid >> 6;
    const int r32 = lane & 31, hi = lane >> 5;
    const int q0 = qt * 16;
    const int qloc = 4 * w + (r32 >> 3);
    const int tl = q0 + qloc;
    const int head = r32 & 7;
    const u16* proj = (const u16*)(ws + OFF_PROJ);
    const u16* brow = proj + (long)b * SEQ * IN_COLS;
    const u64* bits = (const u64*)(ws + OFF_BITS) + ((long)b * SEQ + q0) * 64;
    u16* yb = (u16*)(ws + OFF_YAB) + (size_t)NTOK * 512;
    unsigned char* bufs = smem;
    u64* lbits = (u64*)(smem + 49152);
    __syncthreads();
    for (int i = tid; i < 16 * 64; i += 256) lbits[i] = bits[i];
    const u16* trow = brow + (long)tl * IN_COLS;
    bf16x8 qr[4];
#pragma unroll
    for (int d0 = 0; d0 < 4; ++d0) qr[d0] = *(const bf16x8*)(trow + C_DQ + head * 64 + d0 * 16 + hi * 8);
    float m = -1e30f, l = 0.f;
    f32x16 o[2];
#pragma unroll
    for (int i = 0; i < 16; ++i) { o[0][i] = 0.f; o[1][i] = 0.f; }
    const int jlast = (q0 + 15) >> 6;
    flash_run<0, true>(0, [&](int c) { return c + 1 <= jlast ? c + 1 : -1; },
                       [&](int j, int r, const u16*& kp, const u16*& vp) {
                           const u16* rp = brow + (long)(64 * j + r) * IN_COLS + C_DKV;
                           kp = rp;
                           vp = rp + 64;
                       },
                       [&](int j, int& lo, int& hl, u64& word) { lo = 0; hl = 0; word = lbits[qloc * 64 + j]; },
                       [&](int, f32x16&, f32x16&) {}, qr, m, l, o, bufs, w, lane);
    const float inv = l > 0.f ? 1.0f / l : 0.f;
    u16* orow = yb + ((long)b * SEQ + tl) * 512 + head * 64;
#pragma unroll
    for (int dh = 0; dh < 2; ++dh)
#pragma unroll
        for (int a = 0; a < 4; ++a) {
            uint2 v = uint2{pack2(o[dh][4 * a] * inv, o[dh][4 * a + 1] * inv), pack2(o[dh][4 * a + 2] * inv, o[dh][4 * a + 3] * inv)};
            *(uint2*)(orow + dh * 32 + 8 * a + 4 * hi) = v;
        }
}

__device__ __forceinline__ int grab_block(unsigned* ctr, int limit, unsigned char* smem) {
    volatile int* slot = (volatile int*)(smem + LDS_BYTES + 8);
    __syncthreads();
    if (threadIdx.x == 0) *slot = (int)__hip_atomic_fetch_add(ctr, 1u, __ATOMIC_RELAXED, __HIP_MEMORY_SCOPE_AGENT);
    __syncthreads();
    const int v = *slot;
    return v < limit ? v : -1;
}
__device__ __forceinline__ int grab_wave(unsigned* ctr, int limit) {
    int v = 0;
    if ((threadIdx.x & 63) == 0) v = (int)__hip_atomic_fetch_add(ctr, 1u, __ATOMIC_RELAXED, __HIP_MEMORY_SCOPE_AGENT);
    v = __builtin_amdgcn_readfirstlane(v);
    return v < limit ? v : -1;
}

#define PE_LD(Q, TB, E0)                                                                      \
    do {                                                                                      \
        asm volatile("" ::: "memory");                                                        \
        _Pragma("unroll") for (int k_ = 0; k_ < 4; ++k_) {                                    \
            const int e_ = (E0) + k_;                                                         \
            const int id_ = (e_ < 64) ? __builtin_amdgcn_readlane(id0, e_) : __builtin_amdgcn_readlane(id1, e_ - 64); \
            Q[k_] = *(const u32x4*)((TB) + (long)id_ * 1024 + lane * 16);                     \
        }                                                                                     \
        asm volatile("" ::: "memory");                                                        \
    } while (0)
#define PE_DOT(Q, PB)                                                                         \
    do {                                                                                      \
        _Pragma("unroll") for (int k_ = 0; k_ < 4; ++k_) {                                    \
            f32x2_t d2_ = {0.f, 0.f};     \
            _Pragma("unroll") for (int i_ = 0; i_ < 4; ++i_) {                                \
                f32x2_t lo_ = __builtin_amdgcn_cvt_pk_f32_fp8((int)Q[k_][i_], false);         \
                f32x2_t hi_ = __builtin_amdgcn_cvt_pk_f32_fp8((int)Q[k_][i_], true);          \
                d2_ += hf2[2 * i_] * lo_;                                                     \
                d2_ += hf2[2 * i_ + 1] * hi_;                                                 \
            }                                                                                 \
            pp[(PB) + k_] = d2_[0] + d2_[1];                                                  \
        }                                                                                     \
    } while (0)
#define PE_AXPY(Q, E0)                                                                        \
    do {                                                                                      \
        _Pragma("unroll") for (int k_ = 0; k_ < 4; ++k_) {                                    \
            const int e_ = (E0) + k_;                                                         \
            const float a_ = __int_as_float((e_ < 64) ? __builtin_amdgcn_readlane(__float_as_int(act0), e_)   \
                                                      : __builtin_amdgcn_readlane(__float_as_int(act1), e_ - 64)); \
            const f32x2_t a2_ = {a_, a_};                                                     \
            _Pragma("unroll") for (int i_ = 0; i_ < 4; ++i_) {                                \
                f32x2_t lo_ = __builtin_amdgcn_cvt_pk_f32_fp8((int)Q[k_][i_], false);         \
                f32x2_t hi_ = __builtin_amdgcn_cvt_pk_f32_fp8((int)Q[k_][i_], true);          \
                acc2[2 * i_] += a2_ * lo_;                                                    \
                acc2[2 * i_ + 1] += a2_ * hi_;                                                \
            }                                                                                 \
        }                                                                                     \
    } while (0)
template <int CTRL>
__device__ __forceinline__ float comb_q(float A, float B, bool bit) {
    const float keep = bit ? B : A, send = bit ? A : B;
    return keep + dpp_qf<CTRL>(send);
}
__device__ __forceinline__ float comb_x(float A, float B, bool bit, int xr) {
    const float keep = bit ? B : A, send = bit ? A : B;
    return keep + __shfl_xor(send, xr);
}
__device__ __forceinline__ float reduce32(float (&pp)[32], int lane) {
    const bool b0 = lane & 1, b1 = lane & 2, b2 = lane & 4, b3 = lane & 8;
#pragma unroll
    for (int j = 0; j < 16; ++j) pp[j] = comb_q<0xB1>(pp[2 * j], pp[2 * j + 1], b0);
#pragma unroll
    for (int j = 0; j < 8; ++j) pp[j] = comb_q<0x4E>(pp[2 * j], pp[2 * j + 1], b1);
#pragma unroll
    for (int j = 0; j < 4; ++j) pp[j] = comb_x(pp[2 * j], pp[2 * j + 1], b2, 4);
#pragma unroll
    for (int j = 0; j < 2; ++j) pp[j] = comb_x(pp[2 * j], pp[2 * j + 1], b3, 8);
    auto sw = __builtin_amdgcn_permlane16_swap(__float_as_uint(pp[0]), __float_as_uint(pp[1]), false, false);
    return xhalf_sum(__uint_as_float(sw[0]) + __uint_as_float(sw[1]));
}
__device__ __forceinline__ void peer_experts_range(unsigned char* ws_, float* xout_, const float* ffn_g, int tbeg, int tend) {
    unsigned char* ws = opq(ws_);
    float* xout = opq(xout_);
    const int lane = tidx() & 63;
    const u16* hbuf = (const u16*)(ws + OFF_YAB);
    const float* ss1 = (const float*)(ws + OFF_SS1);
    const unsigned char* ub = ws + OFF_UB;
    const unsigned char* vb = ws + OFF_VB;
    const int* eidx = (const int*)(ws + OFF_EIDX);
    const float* gate = (const float*)(ws + OFF_GATE);
    const float* usc = (const float*)(ws + OFF_ESC);
    const float* vsc = usc + NEXP;
    int t = tbeg;
    int id0 = 0, id1 = 0;
    float gr0 = 0.f, gr1 = 0.f;
    uint4 h0 = uint4{0u, 0u, 0u, 0u}, h1 = h0;
    u32x4 ua[4], ubq[4];
    if (t < tend) {
        id0 = eidx[(long)t * 128 + lane]; id1 = eidx[(long)t * 128 + 64 + lane];
        gr0 = gate[(long)t * 128 + lane]; gr1 = gate[(long)t * 128 + 64 + lane];
        h0 = *(const uint4*)(hbuf + (long)t * 1024 + lane * 16);
        h1 = *(const uint4*)(hbuf + (long)t * 1024 + lane * 16 + 8);
        PE_LD(ua, ub, 0);
    }
    while (t < tend) {
        const float g0 = gr0 * vsc[id0], g1 = gr1 * vsc[id1];
        const float s0 = usc[id0], s1 = usc[id1];
        float* xr = xout + (long)t * 1024 + lane * 16;
        const float rs1 = rsqrtf(sum16(ss1 + (long)t * 16) * (1.0f / 1024.0f) + EPS);
        f32x2_t hf2[8];
        hf2[0] = f32x2_t{bf_lo(h0.x), bf_hi(h0.x)}; hf2[1] = f32x2_t{bf_lo(h0.y), bf_hi(h0.y)};
        hf2[2] = f32x2_t{bf_lo(h0.z), bf_hi(h0.z)}; hf2[3] = f32x2_t{bf_lo(h0.w), bf_hi(h0.w)};
        hf2[4] = f32x2_t{bf_lo(h1.x), bf_hi(h1.x)}; hf2[5] = f32x2_t{bf_lo(h1.y), bf_hi(h1.y)};
        hf2[6] = f32x2_t{bf_lo(h1.z), bf_hi(h1.z)}; hf2[7] = f32x2_t{bf_lo(h1.w), bf_hi(h1.w)};
        const int tn = t + 1;
        int idn0 = 0, idn1 = 0;
        float gn0 = 0.f, gn1 = 0.f;
        uint4 hn0 = uint4{0u, 0u, 0u, 0u}, hn1 = hn0;
        if (tn < tend) {
            idn0 = eidx[(long)tn * 128 + lane]; idn1 = eidx[(long)tn * 128 + 64 + lane];
            gn0 = gate[(long)tn * 128 + lane]; gn1 = gate[(long)tn * 128 + 64 + lane];
            hn0 = *(const uint4*)(hbuf + (long)tn * 1024 + lane * 16);
            hn1 = *(const uint4*)(hbuf + (long)tn * 1024 + lane * 16 + 8);
        }
        float dq0 = 0.f, dq1 = 0.f, dq2 = 0.f, dq3 = 0.f;
        for (int gq = 0; gq < 4; ++gq) {
            const int e = 32 * gq;
            float pp[32];
#pragma unroll
            for (int q4 = 0; q4 < 32; q4 += 8) {
                PE_LD(ubq, ub, e + q4 + 4);
                PE_DOT(ua, q4);
                if (q4 + 8 < 32 || gq < 3) PE_LD(ua, ub, e + q4 + 8);
                else PE_LD(ua, vb, 0);
                PE_DOT(ubq, q4 + 4);
            }
            const float r = reduce32(pp, lane);
            dq0 = gq == 0 ? r : dq0;
            dq1 = gq == 1 ? r : dq1;
            dq2 = gq == 2 ? r : dq2;
            dq3 = gq == 3 ? r : dq3;
        }
        const float act0 = gelu_tanh((lane < 32 ? dq0 : dq1) * (s0 * rs1)) * g0;
        const float act1 = gelu_tanh((lane < 32 ? dq2 : dq3) * (s1 * rs1)) * g1;
        f32x2_t acc2[8];
#pragma unroll
        for (int i = 0; i < 8; ++i) acc2[i] = f32x2_t{0.f, 0.f};
        for (int b = 0; b < 32; b += 2) {
            PE_LD(ubq, vb, 4 * (b + 1));
            PE_AXPY(ua, 4 * b);
            if (b + 2 < 32) {
                PE_LD(ua, vb, 4 * (b + 2));
            } else if (tn < tend) {
                id0 = idn0; id1 = idn1;
                PE_LD(ua, ub, 0);
            }
            PE_AXPY(ubq, 4 * (b + 1));
        }
        float ss = 0.f;
        u32 pk[8];
#pragma unroll
        for (int i = 0; i < 4; ++i) {
            float4 a = *(const float4*)(xr + 4 * i);
            a.x += acc2[2 * i][0]; a.y += acc2[2 * i][1]; a.z += acc2[2 * i + 1][0]; a.w += acc2[2 * i + 1][1];
            *(float4*)(xr + 4 * i) = a;
            ss += a.x * a.x + a.y * a.y + a.z * a.z + a.w * a.w;
            pk[2 * i] = pack2(a.x, a.y);
            pk[2 * i + 1] = pack2(a.z, a.w);
        }
        u16* hw = (u16*)(ws + OFF_YAB) + (long)t * 1024 + lane * 16;
        *(uint4*)hw = uint4{pk[0], pk[1], pk[2], pk[3]};
        *(uint4*)(hw + 8) = uint4{pk[4], pk[5], pk[6], pk[7]};
        ss = wsum(ss);
        if (lane == 0) ((float*)(ws + OFF_RSTDE))[t] = rsqrtf(ss * (1.0f / 1024.0f) + EPS);
        t = tn; id0 = idn0; id1 = idn1; gr0 = gn0; gr1 = gn1; h0 = hn0; h1 = hn1;
    }
}

__device__ __forceinline__ u32 search_bounds(u32 lanemax, int& hb) {
    const u32 U = row_max16u(lanemax), L = row_min16u(lanemax);
    const u32 d = U ^ L;
    hb = d ? 31 - __clz((int)d) : -1;
    return d ? (U & ~((2u << hb) - 1u)) : U;
}
__device__ __forceinline__ void peer_route(unsigned char* ws, float* xout, const float* ffn_g, int layer, unsigned char* smem, unsigned long long& tacc) {
    const int tid = tidx(), lane = tid & 63, w = tid >> 6;
    const int grp = lane >> 4, k = lane & 15;
    const u32 ltk = (1u << k) - 1u;
    float* tvc = (float*)(smem + w * 4096);
    int* tic = (int*)(smem + w * 4096 + 2048);
    unsigned* rctr = (unsigned*)(ws + OFF_CTR) + (layer * 8 + 3) * 8;
    for (int unit; (unit = grab_wave(rctr, NTOK / 16)) >= 0;) {
        const int tok0 = unit * 16;
        unsigned char* wsu = opq(ws);
        const u16* pq = (const u16*)(wsu + OFF_PQ);
        const u16* skb = (const u16*)(wsu + OFF_W + layer * W_LAYER + WO_SK);
        int* eidx = (int*)(wsu + OFF_EIDX);
        float* gate = (float*)(wsu + OFF_GATE);
        for (int h = 0; h < 8; ++h) {
            for (int half = 0; half < 2; ++half) {
                unsigned long long tr0 = SEC_T();
                bf16x8 af[4];
#pragma unroll
                for (int ks = 0; ks < 4; ++ks)
                    af[ks] = *(const bf16x8*)(pq + (long)(tok0 + k) * 2048 + h * 256 + half * 128 + ks * 32 + grp * 8);
                float sc[8][4];
                u32 u[8][4];
#pragma unroll
                for (int nt = 0; nt < 8; ++nt) {
                    f32x4 acc = f32x4{0.f, 0.f, 0.f, 0.f};
#pragma unroll
                    for (int ks = 0; ks < 4; ++ks) {
                        bf16x8 bfr = *(const bf16x8*)(skb + (size_t)half * 128 * 128 + (size_t)(nt * 16 + k) * 128 + ks * 32 + grp * 8);
                        acc = __builtin_amdgcn_mfma_f32_16x16x32_bf16(af[ks], bfr, acc, 0, 0, 0);
                    }
#pragma unroll
                    for (int i = 0; i < 4; ++i) { sc[nt][i] = acc[i]; u[nt][i] = sortkey(acc[i]); }
                }
                SEC_ADD(11, tr0);
                tr0 = SEC_T();
                u32 K[4];
                bool dn[4] = {false, false, false, false};
                int hbm = -1;
#pragma unroll
                for (int i = 0; i < 4; ++i) {
                    u32 lm = u[0][i];
#pragma unroll
                    for (int nt = 1; nt < 8; ++nt) lm = max(lm, u[nt][i]);
                    int hb;
                    K[i] = search_bounds(lm, hb);
                    hbm = max(hbm, hb);
                }
                const int bit0 = (int)wmax((float)hbm);
                for (int bit = bit0; bit >= 0; --bit) {
                    int packed = 0;
#pragma unroll
                    for (int i = 0; i < 4; ++i) {
                        const u32 cand = K[i] | (1u << bit);
                        int c = 0;
#pragma unroll
                        for (int nt = 0; nt < 8; ++nt) c += (u[nt][i] >= cand) ? 1 : 0;
                        packed |= c << (8 * i);
                    }
                    packed = row_sum16i(packed);
#pragma unroll
                    for (int i = 0; i < 4; ++i)
                        if (((packed >> (8 * i)) & 0xFF) >= 16) K[i] |= (1u << bit);
                    bool done = true;
#pragma unroll
                    for (int i = 0; i < 4; ++i) {
                        const int ci = (packed >> (8 * i)) & 0xFF;
                        done = done && (ci == 16 || dn[i]);
                        dn[i] = dn[i] || (ci == 16);
                    }
                    if (__all(done)) break;
                }
                SEC_ADD(12, tr0);
                tr0 = SEC_T();
                int need[4];
                {
                    int packed = 0;
#pragma unroll
                    for (int i = 0; i < 4; ++i) {
                        int c = 0;
#pragma unroll
                        for (int nt = 0; nt < 8; ++nt) c += (u[nt][i] > K[i]) ? 1 : 0;
                        packed |= c << (8 * i);
                    }
                    packed = row_sum16i(packed);
#pragma unroll
                    for (int i = 0; i < 4; ++i) need[i] = 16 - ((packed >> (8 * i)) & 0xFF);
                }
#pragma unroll
                for (int i = 0; i < 4; ++i) {
                    int ebase = 0, pbase = 0;
                    const int tok = 4 * grp + i;
#pragma unroll
                    for (int nt = 0; nt < 8; ++nt) {
                        const bool eq = (u[nt][i] == K[i]);
                        const u32 emg = (u32)(__ballot(eq) >> (lane & 48)) & 0xFFFFu;
                        const int erank = ebase + __popc(emg & ltk);
                        const bool take = (u[nt][i] > K[i]) || (eq && erank < need[i]);
                        ebase += __popc(emg);
                        const u32 tmg = (u32)(__ballot(take) >> (lane & 48)) & 0xFFFFu;
                        const int pos = pbase + __popc(tmg & ltk);
                        if (take) {
                            tvc[(half * 16 + tok) * 16 + pos] = sc[nt][i];
                            tic[(half * 16 + tok) * 16 + pos] = nt * 16 + k;
                        }
                        pbase += __popc(tmg);
                    }
                }
                SEC_ADD(13, tr0);
            }
            WAVE_SYNC();
            unsigned long long tr2 = SEC_T();
            for (int pass = 0; pass < 4; ++pass) {
                const int tok = 4 * pass + grp;
                const float v1 = tvc[(0 * 16 + tok) * 16 + k];
                const int i1 = tic[(0 * 16 + tok) * 16 + k];
                float c[16];
                u32 uc[16];
#pragma unroll
                for (int r4 = 0; r4 < 4; ++r4) {
                    float4 v2 = *(const float4*)(tvc + (1 * 16 + tok) * 16 + r4 * 4);
                    c[r4 * 4 + 0] = v1 + v2.x;
                    c[r4 * 4 + 1] = v1 + v2.y;
                    c[r4 * 4 + 2] = v1 + v2.z;
                    c[r4 * 4 + 3] = v1 + v2.w;
                }
                float mxl = c[0];
#pragma unroll
                for (int r = 0; r < 16; ++r) { uc[r] = sortkey(c[r]); mxl = fmaxf(mxl, c[r]); }
                const float mx = row_max16f(mxl);
                int hbc;
                u32 Kc = search_bounds(sortkey(mxl), hbc);
                bool dnc = false;
                const int bitc0 = (int)wmax((float)hbc);
                for (int bit = bitc0; bit >= 0; --bit) {
                    const u32 cand = Kc | (1u << bit);
                    int cn = 0;
#pragma unroll
                    for (int r = 0; r < 16; ++r) cn += (uc[r] >= cand) ? 1 : 0;
                    cn = row_sum16i(cn);
                    if (cn >= 16) Kc = cand;
                    dnc = dnc || (cn == 16);
                    if (__all(dnc)) break;
                }
                int cgl = 0, cel = 0;
#pragma unroll
                for (int r = 0; r < 16; ++r) { cgl += (uc[r] > Kc) ? 1 : 0; cel += (uc[r] == Kc) ? 1 : 0; }
                const int needc = 16 - row_sum16i(cgl);
                const int ebefore = row_xscan16i(cel);
                int tl_ = 0, el_ = 0;
                u32 takem = 0u;
                float ex[16];
                float sl = 0.f;
#pragma unroll
                for (int r = 0; r < 16; ++r) {
                    const bool eq = (uc[r] == Kc);
                    const bool tk = (uc[r] > Kc) || (eq && (ebefore + el_) < needc);
                    el_ += eq ? 1 : 0;
                    tl_ += tk ? 1 : 0;
                    takem |= tk ? (1u << r) : 0u;
                    ex[r] = tk ? __expf(c[r] - mx) : 0.f;
                    sl += ex[r];
                }
                const float inv = 1.0f / row_sum16f(sl);
                int pos = row_xscan16i(tl_);
                const long obase = (long)(tok0 + tok) * 128 + h * 16;
                int i2v[16];
#pragma unroll
                for (int r4 = 0; r4 < 4; ++r4) {
                    const int4 q = *(const int4*)(tic + (1 * 16 + tok) * 16 + r4 * 4);
                    i2v[r4 * 4 + 0] = q.x; i2v[r4 * 4 + 1] = q.y; i2v[r4 * 4 + 2] = q.z; i2v[r4 * 4 + 3] = q.w;
                }
#pragma unroll
                for (int r = 0; r < 16; ++r) {
                    if ((takem >> r) & 1u) {
                        const int eid = i1 * 128 + i2v[r];
                        eidx[obase + pos] = eid;
                        gate[obase + pos] = ex[r] * inv;
                        ++pos;
                    }
                }
            }
            SEC_ADD(14, tr2);
            WAVE_SYNC();
        }
        asm volatile("s_waitcnt vmcnt(0)" ::: "memory");
        peer_experts_range(ws, xout, ffn_g, tok0, tok0 + 16);
    }
}

__device__ __forceinline__ void phase_prep(const Params& P, unsigned char* smem) {
    unsigned char* ws = opq(P.ws);
    const long gtid = (long)bidx() * 256 + tidx();
    const long gthreads = (long)gdim() * 256;
    for (int l = 0; l < 2; ++l) {
        unsigned char* wl = ws + OFF_W + l * W_LAYER;
        float* tile = (float*)smem;
        transpose_cvt<true>(P.w_in + (size_t)l * 1024 * IN_COLS, (u16*)(wl + WO_WIN), 1024, IN_COLS, tile, P.attn_norm + l * 1024);
        for (int c = 0; c < 2; ++c) {
            transpose_cvt(P.cmp_w1 + ((size_t)l * 2 + c) * 2048 * 256, (u16*)(wl + WO_W1) + (size_t)c * 256 * 2048, 2048, 256, tile);
            transpose_cvt(P.cmp_w2 + ((size_t)l * 2 + c) * 256 * 64, (u16*)(wl + WO_W2) + (size_t)c * 64 * 256, 256, 64, tile);
        }
        transpose_cvt(P.w_a + (size_t)l * 512 * 1024, (u16*)(wl + WO_WA), 512, 1024, tile);
        transpose_cvt(P.w_b + (size_t)l * 512 * 1024, (u16*)(wl + WO_WB), 512, 1024, tile);
        transpose_cvt(P.w_out + (size_t)l * 1024 * 1024, (u16*)(wl + WO_WO), 1024, 1024, tile);
        transpose_cvt(P.peer_wq + (size_t)l * 1024 * 2048, (u16*)(wl + WO_WQ), 1024, 2048, tile, P.ffn_norm + l * 1024);
        transpose_cvt(P.ple_w + (size_t)l * 256 * 1024, (u16*)(wl + WO_PW), 256, 1024, tile);
        transpose_cvt(P.ple_gw + (size_t)l * 1024 * 1024, (u16*)(wl + WO_PG), 1024, 1024, tile);
        cvt_f32_bf16(P.peer_sk + (size_t)l * 2 * 128 * 128, (u16*)(wl + WO_SK), 2 * 128 * 128);
    }
    for (int u = bidx(); u < 64; u += gdim()) {
        const int l = u >> 5, c = (u >> 4) & 1, kq = u & 15, col = tidx();
        const float* pos = P.cmp_pos + ((size_t)l * 2 + c) * 2048 + kq * 128;
        const float* w1 = P.cmp_w1 + ((size_t)l * 2 + c) * 2048 * 256 + (size_t)kq * 128 * 256;
        float s = 0.f;
#pragma unroll 16
        for (int k = 0; k < 128; ++k) s += pos[k] * w1[(size_t)k * 256 + col];
        ((float*)(ws + OFF_CHID))[(size_t)u * 256 + col] = s;
    }
    {
        float* ropec = (float*)(ws + OFF_ROPE);
        float* ropes = ropec + (size_t)NTOK * 8;
        for (long i = gtid; i < (long)NTOK * 8; i += gthreads) {
            int t = (int)(i >> 3), k = (int)(i & 7);
            double inv = pow(500000.0, -(double)k / 8.0);
            double ang = (double)P.positions[t] * inv;
            ropec[i] = (float)cos(ang);
            ropes[i] = (float)sin(ang);
        }
    }
    {
        const int lane = tidx() & 63;
        u16* xb = (u16*)(ws + OFF_H);
        float* ssa = (float*)(ws + OFF_SSA);
        for (int row = bidx() * 4 + (tidx() >> 6); row < NTOK; row += gdim() * 4) {
            const float* xr = P.x + (long)row * 1024;
            float ss = 0.f;
#pragma unroll
            for (int i = 0; i < 4; ++i) {
                const float4 v = *(const float4*)(xr + i * 256 + lane * 4);
                ss += v.x * v.x + v.y * v.y + v.z * v.z + v.w * v.w;
                *(uint2*)(xb + (long)row * 1024 + i * 256 + lane * 4) = uint2{pack2(v.x, v.y), pack2(v.z, v.w)};
            }
            ss = wsum(ss);
            if (lane < 16) ssa[(long)row * 16 + lane] = lane == 0 ? ss : 0.f;
        }
    }
}

__device__ __forceinline__ void phase_g1(const Params& P, int layer, unsigned char* smem) {
    unsigned char* ws = opq(P.ws);
    u16* proj = (u16*)(ws + OFF_PROJ);
    const float* ropec = (const float*)(ws + OFF_ROPE);
    const float* ropes = ropec + (size_t)NTOK * 8;
    const float* ng = P.nsa_gain + layer * 256;
    const float* dg = P.dsa_gain + layer * 128;
    if (layer == 0 && bidx() < 4) {
        const int l = bidx() >> 1, c = bidx() & 1, col = tidx();
        const float* part = (const float*)(ws + OFF_CHID) + (size_t)(l * 32 + c * 16) * 256 + col;
        float sacc = 0.f;
#pragma unroll
        for (int kq = 0; kq < 16; ++kq) sacc += part[kq * 256];
        ((float*)(ws + OFF_W + l * W_LAYER + WO_CB))[c * 256 + col] = sacc;
    }
    const float* ssa = (const float*)(ws + OFF_SSA) + (size_t)layer * NTOK * 16;
    gemm_phase_rs<0, true>((const u16*)(ws + OFF_H), 1024, (const u16*)(ws + OFF_W + layer * W_LAYER + WO_WIN), 1024, NTOK, IN_COLS, 1024, smem,
                  [=](int row) { return float2{rsqrtf(sum16(ssa + (long)row * 16) * (1.0f / 1024.0f) + EPS), 0.f}; },
                  [=](int row, int col, const float (&v)[8], float2 rs) {
                      const int c64 = __builtin_amdgcn_readfirstlane(col >> 6), cc = (col >> 3) & 7;
                      const float rsx = rs.x;
                      float o[8];
#pragma unroll
                      for (int j = 0; j < 8; ++j) o[j] = v[j] * rsx;
                      const float* gain = nullptr;
                      bool rope = false, sig = false;
                      float scale = 1.0f;
                      if (c64 < 8) { gain = ng; rope = true; scale = 0.125f * 1.4426950408889634f; }
                      else if (c64 < 20) { const int c = (c64 - 8) >> 1; if (c == 2) { gain = ng + 128; rope = true; } else if (c == 4) { gain = ng + 192; rope = true; } }
                      else if (c64 < 28) { gain = dg; rope = true; scale = 0.125f * 1.4426950408889634f; }
                      else if (c64 == 28) { gain = dg + 64; rope = true; }
                      else if (c64 == 29) { }
                      else if (c64 < 38) { rope = true; scale = 0.125f; }
                      else if (c64 == 38) { rope = true; }
                      else if (c64 < 71) { sig = true; }
                      else { sig = (col < C_IW); }
                      if (gain) {
                          float ss = 0.f;
#pragma unroll
                          for (int j = 0; j < 8; ++j) ss += o[j] * o[j];
                          ss += dpp_qf<0xB1>(ss);
                          ss += dpp_qf<0x4E>(ss);
                          ss += __shfl_xor(ss, 4);
                          const float rstd = rsqrtf(ss * (1.0f / 64.0f) + EPS);
                          const float4 g0 = *(const float4*)(gain + cc * 8), g1 = *(const float4*)(gain + cc * 8 + 4);
                          o[0] *= rstd * g0.x; o[1] *= rstd * g0.y; o[2] *= rstd * g0.z; o[3] *= rstd * g0.w;
                          o[4] *= rstd * g1.x; o[5] *= rstd * g1.y; o[6] *= rstd * g1.z; o[7] *= rstd * g1.w;
                      }
                      if (rope) {
                          float pr[8];
#pragma unroll
                          for (int j = 0; j < 8; ++j) pr[j] = dpp_qf<0xB1>(o[j]);
                          if (cc < 2) {
                              const float4 c0 = *(const float4*)(ropec + (long)row * 8), c1 = *(const float4*)(ropec + (long)row * 8 + 4);
                              const float4 s0 = *(const float4*)(ropes + (long)row * 8), s1 = *(const float4*)(ropes + (long)row * 8 + 4);
                              const float cs[8] = {c0.x, c0.y, c0.z, c0.w, c1.x, c1.y, c1.z, c1.w};
                              const float sn[8] = {s0.x, s0.y, s0.z, s0.w, s1.x, s1.y, s1.z, s1.w};
#pragma unroll
                              for (int j = 0; j < 8; ++j) o[j] = (cc == 0) ? (o[j] * cs[j] - pr[j] * sn[j]) : (o[j] * cs[j] + pr[j] * sn[j]);
                          }
                      }
                      if (sig) {
#pragma unroll
                          for (int j = 0; j < 8; ++j) o[j] = sigmoidf(o[j]);
                      }
#pragma unroll
                      for (int j = 0; j < 8; ++j) o[j] *= scale;
                      st_bf8(proj + (long)row * IN_COLS + col, o);
                  });
}

__device__ __forceinline__ void phase_c1(const Params& P, int layer, unsigned char* smem) {
    unsigned char* ws = opq(P.ws);
    unsigned char* wl = ws + OFF_W + layer * W_LAYER;
    const u16* proj = (const u16*)(ws + OFF_PROJ);
    u16* chid = (u16*)(ws + OFF_CHID);
    const float* cbias = (const float*)(wl + WO_CB);
    for (int c = 0; c < 2; ++c) {
        u16* ch = chid + (size_t)c * CROWS * 256;
        const float* cb = cbias + c * 256;
        gemm_phase<1>(proj + C_NKV + c * 128, 0, (const u16*)(wl + WO_W1) + (size_t)c * 256 * 2048, 2048, CROWS, 256, 2048, smem,
                      [=](int row, int col, const float (&v)[8]) {
                          float o[8];
#pragma unroll
                          for (int j = 0; j < 8; ++j) o[j] = gelu_tanh(v[j] + cb[col + j]);
                          st_bf8(ch + (long)row * 256 + col, o);
                      });
    }
}

__device__ __forceinline__ void phase_c2(const Params& P, int layer, unsigned char* smem) {
    unsigned char* ws = opq(P.ws);
    unsigned char* wl = ws + OFF_W + layer * W_LAYER;
    const u16* chid = (const u16*)(ws + OFF_CHID);
    u16* kcb = (u16*)(ws + OFF_KCB);
    u16* vcb = (u16*)(ws + OFF_VCB);
    const float* ropec = (const float*)(ws + OFF_ROPE);
    const float* ropes = ropec + (size_t)NTOK * 8;
    const float* gain = P.nsa_gain + layer * 256 + 64;
    for (int c = 0; c < 2; ++c) {
        u16* dst = c == 0 ? kcb : vcb;
        gemm_phase<0>(chid + (size_t)c * CROWS * 256, 256, (const u16*)(wl + WO_W2) + (size_t)c * 64 * 256, 256, CROWS, 64, 256, smem,
                      [=](int row, int col, const float (&v)[8]) {
                          const int b = row / (NCMP * 2);
                          const int rem = row - b * (NCMP * 2);
                          const int n = rem >> 1, g = rem & 1;
                          const int cc = col >> 3;
                          float o[8];
#pragma unroll
                          for (int j = 0; j < 8; ++j) o[j] = v[j];
                          if (c == 0) {
                              float ss = 0.f;
#pragma unroll
                              for (int j = 0; j < 8; ++j) ss += o[j] * o[j];
                              ss += dpp_qf<0xB1>(ss);
                              ss += dpp_qf<0x4E>(ss);
                              ss += __shfl_xor(ss, 4);
                              const float rstd = rsqrtf(ss * (1.0f / 64.0f) + EPS);
#pragma unroll
                              for (int j = 0; j < 8; ++j) o[j] *= rstd * gain[cc * 8 + j];
                              float pr[8];
#pragma unroll
                              for (int j = 0; j < 8; ++j) pr[j] = dpp_qf<0xB1>(o[j]);
                              if (cc < 2) {
                                  const long tt = (long)b * SEQ + 31 + 16 * n;
#pragma unroll
                                  for (int j = 0; j < 8; ++j) {
                                      const float cs = ropec[tt * 8 + j], sn = ropes[tt * 8 + j];
                                      o[j] = (cc == 0) ? (o[j] * cs - pr[j] * sn) : (o[j] * cs + pr[j] * sn);
                                  }
                              }
                          }
                          st_bf8(dst + ((size_t)(b * 2 + g) * 256 + n) * 64 + col, o);
                      });
    }
}

__device__ __forceinline__ int balance4(int x, int seg) {
    const int k = x / seg, r = x - k * seg;
    return k == 0 ? r : (k == 1 ? 4 * seg - 1 - r : (k == 2 ? seg + r : 3 * seg - 1 - r));
}
__device__ __forceinline__ void phase_att_a(const Params& P, int layer, unsigned char* smem, unsigned long long& tacc) {
    unsigned char* ws = opq(P.ws);
    unsigned* ctr = (unsigned*)(ws + OFF_CTR) + (layer * 8 + 0) * 8;
    const int label = bidx() & 7;
    for (int s8 = 0; s8 < 8; ++s8) {
        const int q = (label + s8) & 7;
        int idx;
        while ((idx = grab_block(ctr + q, 1024, smem)) >= 0) dsa_select_unit(ws, q * 1024 + (1023 - idx), smem, tacc);
    }
}
__device__ __forceinline__ void phase_att_b(const Params& P, int layer, unsigned char* smem) {
    const int label = bidx() & 7;
    {
        unsigned char* ws = opq(P.ws);
        unsigned* ctr = (unsigned*)(ws + OFF_CTR) + (layer * 8 + 1) * 8;
        for (int s8 = 0; s8 < 8; ++s8) {
            const int q = (label + s8) & 7;
            int idx;
            while ((idx = grab_block(ctr + q, 256, smem)) >= 0) dsa_attn_unit(ws, q, 255 - idx, smem);
        }
    }
    {
        unsigned char* ws = opq(P.ws);
        unsigned* ctr = (unsigned*)(ws + OFF_CTR) + (layer * 8 + 2) * 8;
        for (int s8 = 0; s8 < 8; ++s8) {
            const int q = (label + s8) & 7;
            int idx;
            while ((idx = grab_block(ctr + q, 256, smem)) >= 0) {
                const int ub = q + 8 * (idx & 1);
                nsa_unit(ws, ub >> 1, ub & 1, 127 - (idx >> 1), smem);
            }
        }
    }
}

__device__ __forceinline__ void phase_merge(const Params& P, int layer, unsigned char* smem) {
    unsigned char* ws = opq(P.ws);
    unsigned char* wl = ws + OFF_W + layer * W_LAYER;
    const u16* proj = (const u16*)(ws + OFF_PROJ);
    u16* hbuf = (u16*)(ws + OFF_H);
    const u16* ya = (const u16*)(ws + OFF_YAB);
    const u16* yb = ya + (size_t)NTOK * 512;
    gemm_phase<0>(ya, 512, (const u16*)(wl + WO_WA), 512, NTOK, 1024, 512, smem, [=](int row, int col, const float (&v)[8]) {
        float ga[8], o[8];
        ld_bf8(proj + (long)row * IN_COLS + C_MG + col, ga);
#pragma unroll
        for (int j = 0; j < 8; ++j) o[j] = ga[j] * v[j];
        st_bf8(hbuf + (long)row * 1024 + col, o);
    });
    gemm_phase<0>(yb, 512, (const u16*)(wl + WO_WB), 512, NTOK, 1024, 512, smem, [=](int row, int col, const float (&v)[8]) {
        float gb[8], o[8];
        ld_bf8(proj + (long)row * IN_COLS + C_MG + 1024 + col, gb);
        ld_bf8(hbuf + (long)row * 1024 + col, o);
#pragma unroll
        for (int j = 0; j < 8; ++j) o[j] += gb[j] * v[j];
        st_bf8(hbuf + (long)row * 1024 + col, o);
    });
}

__device__ __forceinline__ void phase_outproj(const Params& P, int layer, unsigned char* smem) {
    unsigned char* ws = opq(P.ws);
    unsigned char* wl = ws + OFF_W + layer * W_LAYER;
    float* out = opq(P.out);
    const float* xin = (layer == 0) ? P.x : (const float*)out;
    const bool gemm_first = bidx() < (gdim() >> 1);
    for (int step = 0; step < 2; ++step) {
        if ((step == 0) == gemm_first) {
            u16* xb1 = (u16*)(ws + OFF_YAB);
            float* ss1 = (float*)(ws + OFF_SS1);
            gemm_phase<0>((const u16*)(ws + OFF_H), 1024, (const u16*)(wl + WO_WO), 1024, NTOK, 1024, 1024, smem, [=](int row, int col, const float (&v)[8]) {
                const long o = (long)row * 1024 + col;
                const float4 x0 = *(const float4*)(xin + o), x1 = *(const float4*)(xin + o + 4);
                const float y[8] = {x0.x + v[0], x0.y + v[1], x0.z + v[2], x0.w + v[3], x1.x + v[4], x1.y + v[5], x1.z + v[6], x1.w + v[7]};
                *(float4*)(out + o) = float4{y[0], y[1], y[2], y[3]};
                *(float4*)(out + o + 4) = float4{y[4], y[5], y[6], y[7]};
                st_bf8(xb1 + o, y);
                float ss = 0.f;
#pragma unroll
                for (int j = 0; j < 8; ++j) ss += y[j] * y[j];
                ss += dpp_qf<0xB1>(ss);
                ss += dpp_qf<0x4E>(ss);
                ss += __shfl_xor(ss, 4);
                if ((col & 63) == 0) ss1[(long)row * 16 + (col >> 6)] = ss;
            });
        } else {
            cvt_f32_bf16(P.p + (size_t)layer * NTOK * 256, (u16*)(ws + OFF_PBF), (long)NTOK * 256);
            cvt_rows_fp8(P.peer_u + (size_t)layer * NEXP * 1024, ws + OFF_UB, (float*)(ws + OFF_ESC), NEXP, P.ffn_norm + layer * 1024);
            cvt_rows_fp8(P.peer_v + (size_t)layer * NEXP * 1024, ws + OFF_VB, (float*)(ws + OFF_ESC) + NEXP, NEXP);
        }
    }
}

__device__ __forceinline__ void phase_pq(const Params& P, int layer, unsigned char* smem) {
    unsigned char* ws = opq(P.ws);
    unsigned char* wl = ws + OFF_W + layer * W_LAYER;
    u16* pq = (u16*)(ws + OFF_PQ);
    u16* eb = (u16*)(ws + OFF_H);
    const float* ss1 = (const float*)(ws + OFF_SS1);
    gemm_phase_rs<0, true>((const u16*)(ws + OFF_YAB), 1024, (const u16*)(wl + WO_WQ), 1024, NTOK, 2048, 1024, smem,
                  [=](int row) { return float2{rsqrtf(sum16(ss1 + (long)row * 16) * (1.0f / 1024.0f) + EPS), 0.f}; },
                  [=](int row, int col, const float (&v)[8], float2 rs) {
                      float o[8];
#pragma unroll
                      for (int j = 0; j < 8; ++j) o[j] = v[j] * rs.x;
                      st_bf8(pq + (long)row * 2048 + col, o);
                  });
    float* sse = (float*)(ws + OFF_SSE) + (size_t)layer * NTOK * 16;
    gemm_phase<0>((const u16*)(ws + OFF_PBF), 256, (const u16*)(wl + WO_PW), 256, NTOK, 1024, 256, smem,
                  [=](int row, int col, const float (&v)[8]) {
                      st_bf8(eb + (long)row * 1024 + col, v);
                      float ss = 0.f;
#pragma unroll
                      for (int j = 0; j < 8; ++j) ss += v[j] * v[j];
                      ss += dpp_qf<0xB1>(ss);
                      ss += dpp_qf<0x4E>(ss);
                      ss += __shfl_xor(ss, 4);
                      if ((col & 63) == 0) sse[(long)row * 16 + (col >> 6)] = ss;
                  });
}

__device__ __forceinline__ void phase_final(const Params& P, int layer, unsigned char* smem) {
    unsigned char* ws = opq(P.ws);
    unsigned char* wl = ws + OFF_W + layer * W_LAYER;
    float* out = opq(P.out);
    u16* eb = (u16*)(ws + OFF_H);
    const float* rstd2 = (const float*)(ws + OFF_RSTDE);
    const float* sse = (const float*)(ws + OFF_SSE) + (size_t)layer * NTOK * 16;
    float* ssn = (float*)(ws + OFF_SSA) + (size_t)NTOK * 16;
    const float* pn = P.ple_norm + layer * 1024;
    const bool more = layer == 0;
    gemm_phase_rs<0, true>((const u16*)(ws + OFF_YAB), 1024, (const u16*)(wl + WO_PG), 1024, NTOK, 1024, 1024, smem,
        [=](int row) { return float2{rstd2[row], rsqrtf(sum16(sse + (long)row * 16) * (1.0f / 1024.0f) + EPS)}; },
        [=](int row, int col, const float (&v)[8], float2 rs) {
        const long o = (long)row * 1024 + col;
        float e[8];
        ld_bf8(eb + o, e);
        const float rx = rs.x;
        const float re = rs.y;
        const float4 x0 = *(const float4*)(out + o), x1 = *(const float4*)(out + o + 4);
        const float4 p0 = *(const float4*)(pn + col), p1 = *(const float4*)(pn + col + 4);
        const float xs[8] = {x0.x, x0.y, x0.z, x0.w, x1.x, x1.y, x1.z, x1.w};
        const float ps[8] = {p0.x, p0.y, p0.z, p0.w, p1.x, p1.y, p1.z, p1.w};
        float y[8];
        float ss = 0.f;
#pragma unroll
        for (int j = 0; j < 8; ++j) {
            y[j] = xs[j] + sigmoidf(v[j] * rx) * (e[j] * re * ps[j]);
            ss += y[j] * y[j];
        }
        *(float4*)(out + o) = float4{y[0], y[1], y[2], y[3]};
        *(float4*)(out + o + 4) = float4{y[4], y[5], y[6], y[7]};
        if (more) {
            st_bf8(eb + o, y);
            ss += dpp_qf<0xB1>(ss);
            ss += dpp_qf<0x4E>(ss);
            ss += __shfl_xor(ss, 4);
            if ((col & 63) == 0) ssn[(long)row * 16 + (col >> 6)] = ss;
        }
    });
}


#define XB_TMO      128
#define XB_XCNT(j)  (256  + 64 * (j))
#define XB_XSUB(j)  (1280 + 64 * (j))
#define XB_XGEN(j)  (2304 + 64 * (j))
#define XB_TOP      3328
#define XB_TOPGEN   3392
#define XCD_BAR_WORDS 3456
#define XB_SPIN_CAP (1u << 22)
#define LAS __attribute__((address_space(3)))
__device__ __forceinline__ unsigned xb_ld(unsigned* p) { return __hip_atomic_load(p, __ATOMIC_RELAXED, __HIP_MEMORY_SCOPE_AGENT); }
__device__ __forceinline__ unsigned xb_add(unsigned* p, unsigned v) { return __hip_atomic_fetch_add(p, v, __ATOMIC_RELAXED, __HIP_MEMORY_SCOPE_AGENT); }
__device__ __forceinline__ unsigned xb_xcc_id() { return (unsigned)__builtin_amdgcn_s_getreg((3 << 11) | 20) & 0xFu; }
#define XB_SPIN(cond, bar) do { unsigned _sp = 0; while (cond) { __builtin_amdgcn_s_sleep(1); \
    if ((++_sp & 255u) == 0u) { if (xb_ld(&(bar)[XB_TMO])) break; if (_sp > XB_SPIN_CAP) { atomicAdd(&(bar)[XB_TMO], 1u); break; } } } } while (0)
struct XcdBarrier {
    unsigned* bar; unsigned x;
    volatile LAS unsigned* st;
};
__device__ __forceinline__ XcdBarrier xcd_barrier_post(unsigned* bar, volatile LAS unsigned* st) {
    XcdBarrier b; b.bar = bar; b.x = xb_xcc_id(); b.st = st;
    if (threadIdx.x == 0) (void)xb_add(&bar[XB_XCNT(b.x)], 1u);
    return b;
}
__device__ __forceinline__ void xcd_barrier_complete(unsigned* bar, unsigned x, unsigned& nloc, unsigned& nx) {
    const unsigned G = gridDim.x * gridDim.y * gridDim.z;
    unsigned sum, cnt, mine, sp = 0u;
    for (;;) {
        sum = 0u; cnt = 0u; mine = 0u;
#pragma unroll
        for (unsigned j = 0; j < 16; ++j) { const unsigned c = xb_ld(&bar[XB_XCNT(j)]); sum += c; cnt += (c > 0u) ? 1u : 0u; mine = (j == x) ? c : mine; }
        if (sum == G) break;
        __builtin_amdgcn_s_sleep(1);
        if ((++sp & 255u) == 0u) { if (xb_ld(&bar[XB_TMO])) break; if (sp > XB_SPIN_CAP) { atomicAdd(&bar[XB_TMO], 1u); break; } }
    }
    nloc = mine > 0u ? mine : 1u; nx = cnt > 0u ? cnt : 1u;
}
__device__ __forceinline__ void xcd_barrier(const XcdBarrier& b) {
    asm volatile("s_waitcnt vmcnt(0)" ::: "memory");
    __syncthreads();
    if (threadIdx.x == 0) {
        unsigned* bar = b.bar;
        __builtin_amdgcn_s_waitcnt(0);
        unsigned nloc = b.st[0], nx = b.st[1];
        if (nloc == 0u) { xcd_barrier_complete(bar, b.x, nloc, nx); b.st[0] = nloc; b.st[1] = nx; }
        const unsigned old = xb_add(&bar[XB_XSUB(b.x)], 1u);
        const unsigned gen = old / nloc;
        if (old + 1u == (gen + 1u) * nloc) {
            __builtin_amdgcn_fence(__ATOMIC_RELEASE, "agent");
            asm volatile("s_waitcnt vmcnt(0)" ::: "memory");
            const unsigned og = xb_add(&bar[XB_TOP], 1u);
            const unsigned tg = og / nx;
            if (og + 1u == (tg + 1u) * nx) xb_add(&bar[XB_TOPGEN], 1u);
            else XB_SPIN(xb_ld(&bar[XB_TOPGEN]) == tg, bar);
            __builtin_amdgcn_fence(__ATOMIC_ACQUIRE, "agent");
            xb_add(&bar[XB_XGEN(b.x)], 1u);
            asm volatile("s_waitcnt vmcnt(0)" ::: "memory");
        } else {
            XB_SPIN(xb_ld(&bar[XB_XGEN(b.x)]) == gen, bar);
            __builtin_amdgcn_fence(__ATOMIC_ACQUIRE, "agent");
            asm volatile("s_waitcnt vmcnt(0)" ::: "memory");
        }
    }
    __syncthreads();
}

#ifndef PROBE_MASK
#define PROBE_MASK 0ull
#endif
#ifndef PROBE_MULT
#define PROBE_MULT 4
#endif
#define GSYNC(id)                                                                          \
    do {                                                                                   \
        xcd_barrier(xb);                                                                   \
        if (PROBE_MASK != 0ull) {                                                          \
            unsigned long long now_ = __builtin_amdgcn_s_memrealtime();                    \
            if ((PROBE_MASK >> (id)) & 1ull) tsel += now_ - tprev;                         \
            tprev = now_;                                                                  \
        }                                                                                  \
    } while (0)

__global__ void __launch_bounds__(256, 2)
fwd_kernel(const float* a_x, const float* a_p, const int* a_pos, const float* a_an, const float* a_win, const float* a_ng, const float* a_cp,
           const float* a_cw1, const float* a_cw2, const float* a_dg, const float* a_wa, const float* a_wb, const float* a_wo, const float* a_fn,
           const float* a_wq, const float* a_sk, const float* a_pu, const float* a_pv, const float* a_pw, const float* a_pgw, const float* a_pn,
           float* a_out, unsigned char* a_ws) {
    Params P;
    P.x = a_x; P.p = a_p; P.positions = a_pos; P.attn_norm = a_an; P.w_in = a_win; P.nsa_gain = a_ng; P.cmp_pos = a_cp; P.cmp_w1 = a_cw1;
    P.cmp_w2 = a_cw2; P.dsa_gain = a_dg; P.w_a = a_wa; P.w_b = a_wb; P.w_out = a_wo; P.ffn_norm = a_fn; P.peer_wq = a_wq; P.peer_sk = a_sk;
    P.peer_u = a_pu; P.peer_v = a_pv; P.ple_w = a_pw; P.ple_gw = a_pgw; P.ple_norm = a_pn; P.out = a_out; P.ws = a_ws;
    cg::grid_group grid = cg::this_grid();
    extern __shared__ __attribute__((aligned(16))) unsigned char smem[];
    unsigned long long tprev = 0, tsel = 0;
    if (PROBE_MASK != 0ull) tprev = __builtin_amdgcn_s_memrealtime();
    volatile LAS unsigned* xst = (volatile LAS unsigned*)(smem + LDS_BYTES);
    if (threadIdx.x == 0) { xst[0] = 0u; xst[1] = 0u; xst[2] = 0u; xst[3] = 0u; }
    __syncthreads();
    XcdBarrier xb = xcd_barrier_post((unsigned*)(P.ws + OFF_BAR), xst);
    phase_prep(P, smem);
    grid.sync();
    if (PROBE_MASK != 0ull) {
        unsigned long long now_ = __builtin_amdgcn_s_memrealtime();
        if (PROBE_MASK & 1ull) tsel += now_ - tprev;
        tprev = now_;
    }
    for (int layer = 0; layer < 2; ++layer) {
        const int pb = 1 + 16 * layer;
        phase_g1(P, layer, smem);
        GSYNC(pb + 0);
        phase_c1(P, layer, smem);
        phase_att_a(P, layer, smem, tsel);
        GSYNC(pb + 15);
        phase_c2(P, layer, smem);
        GSYNC(pb + 3);
        phase_att_b(P, layer, smem);
        GSYNC(pb + 5);
        phase_merge(P, layer, smem);
        GSYNC(pb + 6);
        phase_outproj(P, layer, smem);
        GSYNC(pb + 7);
        phase_pq(P, layer, smem);
        GSYNC(pb + 9);
        peer_route(opq(P.ws), opq(P.out), P.ffn_norm + layer * 1024, layer, smem, tsel);
        GSYNC(pb + 11);
        phase_final(P, layer, smem);
        GSYNC(pb + 13);
    }
#ifndef PROBE_BLOCK
#define PROBE_BLOCK 0
#endif
    if (PROBE_MASK != 0ull || PROBE_SEC != 0) {
        if (blockIdx.x == PROBE_BLOCK && threadIdx.x == 0) {
            unsigned long long t0 = __builtin_amdgcn_s_memrealtime();
            while (__builtin_amdgcn_s_memrealtime() - t0 < (unsigned long long)PROBE_MULT * tsel) __builtin_amdgcn_s_sleep(32);
        }
    }
}

extern "C" void kernel_launch(void* const* d_in, const int* in_sizes, int n_in, void* d_out, int out_size, void* d_ws, size_t ws_size,
                              hipStream_t stream) {
    static int grid_blocks = 0;
    if (!grid_blocks) {
        int dev = 0, cus = 0, per_cu = 0;
        (void)hipGetDevice(&dev);
        (void)hipDeviceGetAttribute(&cus, hipDeviceAttributeMultiprocessorCount, dev);
        (void)hipFuncSetAttribute((const void*)fwd_kernel, hipFuncAttributeMaxDynamicSharedMemorySize, LDS_BYTES + 16);
        (void)hipOccupancyMaxActiveBlocksPerMultiprocessor(&per_cu, fwd_kernel, 256, LDS_BYTES + 16);
        if (per_cu > 2) per_cu = 2;
        if (per_cu < 1) per_cu = 1;
        grid_blocks = cus * per_cu;
        if (ws_size < WS_END) fprintf(stderr, "kernel_launch: workspace too small: %zu < %zu\n", ws_size, (size_t)WS_END);
    }
    Params P{};
    P.x = (const float*)d_in[0];
    P.p = (const float*)d_in[1];
    P.positions = (const int*)d_in[2];
    P.attn_norm = (const float*)d_in[3];
    P.w_in = (const float*)d_in[4];
    P.nsa_gain = (const float*)d_in[5];
    P.cmp_pos = (const float*)d_in[6];
    P.cmp_w1 = (const float*)d_in[7];
    P.cmp_w2 = (const float*)d_in[8];
    P.dsa_gain = (const float*)d_in[9];
    P.w_a = (const float*)d_in[10];
    P.w_b = (const float*)d_in[11];
    P.w_out = (const float*)d_in[12];
    P.ffn_norm = (const float*)d_in[13];
    P.peer_wq = (const float*)d_in[14];
    P.peer_sk = (const float*)d_in[15];
    P.peer_u = (const float*)d_in[16];
    P.peer_v = (const float*)d_in[17];
    P.ple_w = (const float*)d_in[18];
    P.ple_gw = (const float*)d_in[19];
    P.ple_norm = (const float*)d_in[20];
    P.out = (float*)d_out;
    P.ws = (unsigned char*)d_ws;
    void* args[] = {(void*)&P.x, (void*)&P.p, (void*)&P.positions, (void*)&P.attn_norm, (void*)&P.w_in, (void*)&P.nsa_gain, (void*)&P.cmp_pos,
                    (void*)&P.cmp_w1, (void*)&P.cmp_w2, (void*)&P.dsa_gain, (void*)&P.w_a, (void*)&P.w_b, (void*)&P.w_out, (void*)&P.ffn_norm,
                    (void*)&P.peer_wq, (void*)&P.peer_sk, (void*)&P.peer_u, (void*)&P.peer_v, (void*)&P.ple_w, (void*)&P.ple_gw,
                    (void*)&P.ple_norm, (void*)&P.out, (void*)&P.ws};
    (void)hipMemsetAsync((unsigned char*)d_ws + OFF_BAR, 0, 3456 * 4 + N_CTR * 4, stream);
    hipError_t e = hipLaunchCooperativeKernel((void*)fwd_kernel, dim3(grid_blocks), dim3(256), args, LDS_BYTES + 16, stream);
    if (e != hipSuccess) fprintf(stderr, "cooperative launch failed: %s (grid %d)\n", hipGetErrorString(e), grid_blocks);
}
```

```cpp
#include <hip/hip_runtime.h>
#include <hip/hip_cooperative_groups.h>
#include <cstdio>
#include <cstdint>
namespace cg = cooperative_groups;
#ifndef PROBE_SEC
#define PROBE_SEC 0
#endif
#define SEC_T() (PROBE_SEC ? __builtin_amdgcn_s_memrealtime() : 0ull)
#define SEC_ADD(k, t0) do { if (PROBE_SEC == (k)) { unsigned long long n_ = SEC_T(); tacc += n_ - (t0); } } while (0)

typedef unsigned short u16;
typedef unsigned int u32;
typedef unsigned long long u64;
using bf16x8 = __attribute__((ext_vector_type(8))) short;
using f32x4 = __attribute__((ext_vector_type(4))) float;
using f32x16 = __attribute__((ext_vector_type(16))) float;
typedef __bf16 bf16x2_t __attribute__((ext_vector_type(2)));

constexpr int D_MODEL = 1024, BATCH = 8, SEQ = 4096, NTOK = BATCH * SEQ;
constexpr int IN_COLS = 4576;
constexpr int C_NQ = 0, C_NKV = 512, C_DQ = 1280, C_DKV = 1792, C_IQ = 1920, C_IK = 2432, C_MG = 2496, C_NG = 4544, C_IW = 4568;
__host__ __device__ constexpr int perm_col(int n) {
    return n < 1280 ? n : n < 1304 ? 4544 + (n - 1280) : n < 1816 ? 1280 + (n - 1304) : n < 1944 ? 1792 + (n - 1816)
         : n < 2456 ? 1920 + (n - 1944) : n < 2520 ? 2432 + (n - 2456) : n < 2528 ? 4568 + (n - 2520) : 2496 + (n - 2528);
}
constexpr int NCMP = 255;
constexpr int CROWS = BATCH * NCMP * 2;
constexpr int NEXP = 16384;
constexpr float EPS = 1e-6f;

constexpr size_t AL(size_t x) { return (x + 255) & ~(size_t)255; }
constexpr size_t WO_WIN = 0;
constexpr size_t WO_W1 = WO_WIN + AL((size_t)IN_COLS * 1024 * 2);
constexpr size_t WO_W2 = WO_W1 + AL((size_t)2 * 256 * 2048 * 2);
constexpr size_t WO_WA = WO_W2 + AL((size_t)2 * 64 * 256 * 2);
constexpr size_t WO_WB = WO_WA + AL((size_t)1024 * 512 * 2);
constexpr size_t WO_WO = WO_WB + AL((size_t)1024 * 512 * 2);
constexpr size_t WO_WQ = WO_WO + AL((size_t)1024 * 1024 * 2);
constexpr size_t WO_PW = WO_WQ + AL((size_t)2048 * 1024 * 2);
constexpr size_t WO_PG = WO_PW + AL((size_t)1024 * 256 * 2);
constexpr size_t WO_SK = WO_PG + AL((size_t)1024 * 1024 * 2);
constexpr size_t WO_CB = WO_SK + AL((size_t)2 * 128 * 128 * 2);
constexpr size_t W_LAYER = WO_CB + AL((size_t)2 * 256 * 4);

constexpr size_t OFF_W = 0;
constexpr size_t OFF_ROPE = OFF_W + 2 * W_LAYER;
constexpr size_t OFF_H = OFF_ROPE + AL((size_t)NTOK * 16 * 4);
constexpr size_t OFF_PROJ = OFF_H + AL((size_t)NTOK * 1024 * 2);
constexpr size_t OFF_YAB = OFF_PROJ + AL((size_t)NTOK * IN_COLS * 2);
constexpr size_t OFF_CHID = OFF_YAB + AL((size_t)NTOK * 1024 * 2);
constexpr size_t OFF_CBUF = OFF_CHID + AL((size_t)2 * CROWS * 256 * 2);
constexpr size_t OFF_KCB = OFF_CBUF + AL((size_t)2 * CROWS * 64 * 4);
constexpr size_t OFF_VCB = OFF_KCB + AL((size_t)BATCH * 2 * 256 * 64 * 2);
constexpr size_t OFF_RSTDE = OFF_VCB + AL((size_t)BATCH * 2 * 256 * 64 * 2);
constexpr size_t OFF_SSA = OFF_RSTDE + AL((size_t)NTOK * 4);
constexpr size_t OFF_SSE = OFF_SSA + AL((size_t)2 * NTOK * 16 * 4);
constexpr size_t OFF_SS1 = OFF_SSE + AL((size_t)2 * NTOK * 16 * 4);
constexpr size_t OFF_BITS = OFF_SS1 + AL((size_t)NTOK * 16 * 4);
__device__ __forceinline__ float sum16(const float* p) {
    const float4 a = *(const float4*)p, b = *(const float4*)(p + 4), c = *(const float4*)(p + 8), d = *(const float4*)(p + 12);
    return ((a.x + a.y) + (a.z + a.w)) + ((b.x + b.y) + (b.z + b.w)) + (((c.x + c.y) + (c.z + c.w)) + ((d.x + d.y) + (d.z + d.w)));
}
constexpr size_t OFF_BAR = OFF_BITS + AL((size_t)NTOK * 64 * 8);
constexpr size_t OFF_CTR = OFF_BAR + 3456 * 4;
constexpr int N_CTR = 512;
constexpr size_t WS_END = OFF_CTR + AL(N_CTR * 4);
constexpr size_t OFF_PQ = OFF_PROJ;
constexpr size_t OFF_UB = OFF_PQ + (size_t)NTOK * 2048 * 2;
constexpr size_t OFF_VB = OFF_UB + (size_t)NEXP * 1024 * 2;
constexpr size_t OFF_EIDX = OFF_VB + (size_t)NEXP * 1024 * 2;
constexpr size_t OFF_GATE = OFF_EIDX + (size_t)NTOK * 128 * 4;
constexpr size_t OFF_ESC = OFF_GATE + (size_t)NTOK * 128 * 4;
constexpr size_t OFF_PBF = OFF_ESC + (size_t)2 * NEXP * 4;
constexpr size_t OFF_ESU = OFF_PBF + (size_t)NTOK * 256 * 2;
static_assert(OFF_ESU + (size_t)NTOK * 128 * 4 <= OFF_YAB, "alias overflow");

constexpr int LDS_BYTES = 65536 + 2048;

struct Params {
    const float* x; const float* p; const int* positions;
    const float* attn_norm; const float* w_in; const float* nsa_gain; const float* cmp_pos; const float* cmp_w1; const float* cmp_w2;
    const float* dsa_gain; const float* w_a; const float* w_b; const float* w_out; const float* ffn_norm; const float* peer_wq;
    const float* peer_sk; const float* peer_u; const float* peer_v; const float* ple_w; const float* ple_gw; const float* ple_norm;
    float* out; unsigned char* ws;
};

__device__ __forceinline__ u16 f2bf(float f) {
    u32 u = __float_as_uint(f);
    u32 r = u + 0x7FFFu + ((u >> 16) & 1u);
    return (u16)(r >> 16);
}
__device__ __forceinline__ float bf2f(u16 h) { return __uint_as_float(((u32)h) << 16); }
__device__ __forceinline__ float bf_lo(u32 w) { return __uint_as_float(w << 16); }
__device__ __forceinline__ float bf_hi(u32 w) { return __uint_as_float(w & 0xFFFF0000u); }
__device__ __forceinline__ u32 pack2(float a, float b) {
    u32 r;
    asm("v_cvt_pk_bf16_f32 %0, %1, %2" : "=v"(r) : "v"(a), "v"(b));
    return r;
}
__device__ __forceinline__ float dot2(u32 a, u32 b, float c) {
    return __builtin_amdgcn_fdot2_f32_bf16(__builtin_bit_cast(bf16x2_t, a), __builtin_bit_cast(bf16x2_t, b), c, false);
}
template <int CTRL>
__device__ __forceinline__ int dppi(int x) { return __builtin_amdgcn_update_dpp(x, x, CTRL, 0xF, 0xF, false); }
template <int CTRL>
__device__ __forceinline__ float dppf(float x) { return __int_as_float(dppi<CTRL>(__float_as_int(x))); }
__device__ __forceinline__ int row_sum16i(int x) {
    x += dppi<0x128>(x);
    x += dppi<0x124>(x);
    x += dppi<0x122>(x);
    x += dppi<0x121>(x);
    return x;
}
template <int CTRL>
__device__ __forceinline__ int dppi0(int x) { return __builtin_amdgcn_update_dpp(0, x, CTRL, 0xF, 0xF, true); }
__device__ __forceinline__ int row_xscan16i(int x) {
    int s = x;
    s += dppi0<0x111>(s);
    s += dppi0<0x112>(s);
    s += dppi0<0x114>(s);
    s += dppi0<0x118>(s);
    return s - x;
}
__device__ __forceinline__ float row_sum16f(float x) {
    x += dppf<0x128>(x);
    x += dppf<0x124>(x);
    x += dppf<0x122>(x);
    x += dppf<0x121>(x);
    return x;
}
__device__ __forceinline__ float row_max16f(float x) {
    x = fmaxf(x, dppf<0x128>(x));
    x = fmaxf(x, dppf<0x124>(x));
    x = fmaxf(x, dppf<0x122>(x));
    x = fmaxf(x, dppf<0x121>(x));
    return x;
}

__device__ __forceinline__ u32 row_max16u(u32 x) {
    x = max(x, (u32)dppi<0x128>((int)x));
    x = max(x, (u32)dppi<0x124>((int)x));
    x = max(x, (u32)dppi<0x122>((int)x));
    x = max(x, (u32)dppi<0x121>((int)x));
    return x;
}
__device__ __forceinline__ u32 row_min16u(u32 x) {
    x = min(x, (u32)dppi<0x128>((int)x));
    x = min(x, (u32)dppi<0x124>((int)x));
    x = min(x, (u32)dppi<0x122>((int)x));
    x = min(x, (u32)dppi<0x121>((int)x));
    return x;
}
template <int CTRL>
__device__ __forceinline__ float dpp_qf(float x) { return __int_as_float(__builtin_amdgcn_update_dpp(0, __float_as_int(x), CTRL, 0xF, 0xF, false)); }
__device__ __forceinline__ float wsum(float v) {
    v = row_sum16f(v);
    const float a = __int_as_float(__builtin_amdgcn_readlane(__float_as_int(v), 0));
    const float b = __int_as_float(__builtin_amdgcn_readlane(__float_as_int(v), 16));
    const float c = __int_as_float(__builtin_amdgcn_readlane(__float_as_int(v), 32));
    const float d = __int_as_float(__builtin_amdgcn_readlane(__float_as_int(v), 48));
    return (a + b) + (c + d);
}
__device__ __forceinline__ float wmax(float v) {
    v = row_max16f(v);
    const float a = __int_as_float(__builtin_amdgcn_readlane(__float_as_int(v), 0));
    const float b = __int_as_float(__builtin_amdgcn_readlane(__float_as_int(v), 16));
    const float c = __int_as_float(__builtin_amdgcn_readlane(__float_as_int(v), 32));
    const float d = __int_as_float(__builtin_amdgcn_readlane(__float_as_int(v), 48));
    return fmaxf(fmaxf(a, b), fmaxf(c, d));
}
__device__ __forceinline__ int wsumi(int v) {
    v = row_sum16i(v);
    return __builtin_amdgcn_readlane(v, 0) + __builtin_amdgcn_readlane(v, 16) + __builtin_amdgcn_readlane(v, 32) + __builtin_amdgcn_readlane(v, 48);
}
__device__ __forceinline__ float sigmoidf(float x) { return 1.0f / (1.0f + __expf(-x)); }
__device__ __forceinline__ float gelu_tanh(float x) {
    float u = 0.7978845608028654f * (x + 0.044715f * x * x * x);
    return 0.5f * x * (1.0f + tanhf(u));
}
__device__ __forceinline__ u32 sortkey(float f) {
    u32 b = __float_as_uint(f);
    return b ^ ((b >> 31) ? 0xFFFFFFFFu : 0x80000000u);
}
#define WAVE_SYNC() asm volatile("s_waitcnt lgkmcnt(0)" ::: "memory")
template <class T>
__device__ __forceinline__ T* opq(T* p) {
    long z = 0;
    asm volatile("" : "+s"(z));
    return (T*)((char*)p + z);
}
__device__ __forceinline__ int tidx() {
    int t = threadIdx.x;
    asm volatile("" : "+v"(t));
    return t;
}
__device__ __forceinline__ int bidx() {
    int b = blockIdx.x;
    asm volatile("" : "+s"(b));
    return b;
}
__device__ __forceinline__ int gdim() {
    int g = gridDim.x;
    asm volatile("" : "+s"(g));
    return g;
}

template <int AMODE, bool HAS_RS, class RowFn, class Epi>
__device__ __forceinline__ void gemm_tile(const u16* __restrict__ Ap, long lda, const u16* __restrict__ BT, long ldb, int M, int N, int K, int m0,
                                          int n0, unsigned char* lds, RowFn rowfn, Epi epi) {
    const int tid = tidx(), lane = tid & 63, w = tid >> 6;
    const int wm = w >> 1, wn = w & 1;
    f32x4 acc[4][4];
#pragma unroll
    for (int i = 0; i < 4; ++i)
#pragma unroll
        for (int j = 0; j < 4; ++j) acc[i][j] = f32x4{0.f, 0.f, 0.f, 0.f};
    long aoff[4], boff[4];
#pragma unroll
    for (int i = 0; i < 4; ++i) {
        const int row = (w * 4 + i) * 8 + (lane >> 3);
        const int kc = (lane & 7) ^ ((row >> 1) & 7);
        int gr = m0 + row;
        if (gr > M - 1) gr = M - 1;
        if (AMODE == 1) {
            int b = gr / (NCMP * 2);
            int rem = gr - b * (NCMP * 2);
            aoff[i] = ((long)b * SEQ + 16 * (rem >> 1)) * IN_COLS + (rem & 1) * 64 + kc * 8;
        } else {
            aoff[i] = (long)gr * lda + kc * 8;
        }
        int gn = n0 + row;
        if (gn > N - 1) gn = N - 1;
        boff[i] = (long)gn * ldb + kc * 8;
    }
    const int nk = K / 64;
#define GEMM_STAGE(kt, bufsel)                                                                                                        \
    do {                                                                                                                              \
        unsigned char* ab_ = lds + (bufsel) * 32768 + w * 4096 + lane * 16;                                                           \
        const long ka_ = (AMODE == 1) ? (long)(kt) * IN_COLS : (long)(kt) * 64;                                                       \
        _Pragma("unroll") for (int i_ = 0; i_ < 4; ++i_) {                                                                            \
            __builtin_amdgcn_global_load_lds((const unsigned*)(Ap + aoff[i_] + ka_), (unsigned*)(ab_ + i_ * 1024), 16, 0, 0);        \
            __builtin_amdgcn_global_load_lds((const unsigned*)(BT + boff[i_] + (long)(kt) * 64), (unsigned*)(ab_ + 16384 + i_ * 1024), 16, 0, 0); \
        }                                                                                                                             \
    } while (0)
    GEMM_STAGE(0, 0);
    asm volatile("s_waitcnt vmcnt(0)" ::: "memory");
    __syncthreads();
    int fa[4], fb[4];
#pragma unroll
    for (int i = 0; i < 4; ++i) {
        const int ra = wm * 64 + i * 16 + (lane & 15), rb = wn * 64 + i * 16 + (lane & 15);
        fa[i] = ra * 128 + ((ra >> 1) & 7) * 16;
        fb[i] = rb * 128 + ((rb >> 1) & 7) * 16;
    }
    for (int kt = 0; kt < nk; ++kt) {
        if (kt + 1 < nk) GEMM_STAGE(kt + 1, (kt + 1) & 1);
        const unsigned char* Ab = lds + (kt & 1) * 32768;
        const unsigned char* Bb = Ab + 16384;
#pragma unroll
        for (int ks = 0; ks < 2; ++ks) {
            const int kc16 = (ks * 4 + (lane >> 4)) * 16;
            bf16x8 af[4], bfr[4];
#pragma unroll
            for (int i = 0; i < 4; ++i) {
                af[i] = *(const bf16x8*)(Ab + ((fa[i] & ~127) | ((fa[i] & 127) ^ kc16)));
                bfr[i] = *(const bf16x8*)(Bb + ((fb[i] & ~127) | ((fb[i] & 127) ^ kc16)));
            }
#pragma unroll
            for (int i = 0; i < 4; ++i)
#pragma unroll
                for (int j = 0; j < 4; ++j) acc[i][j] = __builtin_amdgcn_mfma_f32_16x16x32_bf16(af[i], bfr[j], acc[i][j], 0, 0, 0);
        }
        asm volatile("s_waitcnt vmcnt(0)" ::: "memory");
        __syncthreads();
    }
#undef GEMM_STAGE
    float2* rsl = (float2*)(lds + 34816);
    if (HAS_RS) {
        if (tid < 128) {
            int gr = m0 + tid;
            if (gr > M - 1) gr = M - 1;
            rsl[tid] = rowfn(gr);
        }
        __syncthreads();
    }
    float* st = (float*)(lds + w * 8704);
#pragma unroll
    for (int hh = 0; hh < 2; ++hh) {
#pragma unroll
        for (int m2 = 0; m2 < 2; ++m2)
#pragma unroll
            for (int j = 0; j < 4; ++j)
#pragma unroll
                for (int r = 0; r < 4; ++r) st[(m2 * 16 + (lane >> 4) * 4 + r) * 68 + j * 16 + (lane & 15)] = acc[hh * 2 + m2][j][r];
        WAVE_SYNC();
#pragma unroll
        for (int c = 0; c < 4; ++c) {
            const int id = c * 64 + lane;
            const int rr = id >> 3, cc = id & 7;
            const float4 v0 = *(const float4*)(st + rr * 68 + cc * 8);
            const float4 v1 = *(const float4*)(st + rr * 68 + cc * 8 + 4);
            const float v[8] = {v0.x, v0.y, v0.z, v0.w, v1.x, v1.y, v1.z, v1.w};
            const int row = m0 + wm * 64 + hh * 32 + rr;
            const int col0 = n0 + wn * 64 + cc * 8;
            const float2 rs = HAS_RS ? rsl[wm * 64 + hh * 32 + rr] : float2{1.f, 1.f};
            if (row < M && col0 < N) epi(row, col0, v, rs);
        }
        WAVE_SYNC();
    }
    __syncthreads();
}

template <int AMODE, bool HAS_RS, class RowFn, class Epi>
__device__ __forceinline__ void gemm_phase_rs(const u16* Ap, long lda, const u16* BT, long ldb, int M, int N, int K, unsigned char* lds, RowFn rowfn, Epi epi) {
    const int tm = (M + 127) / 128, tn = (N + 127) / 128;
    const int SW = (tn % 9 == 0) ? 9 : ((tn % 8 == 0) ? 8 : 0);
    const int G = gdim();
    if (SW != 0 && (tm % 8) == 0 && (G % 8) == 0 && (((tm / 8) * (tn / SW)) % 8) == 0) {
        const int nsc = tn / SW;
        const int per = 8 * SW;
        const int nst_x = (tm / 8) * nsc / 8;
        const int x = bidx() & 7, j0 = bidx() >> 3, nper = G >> 3;
        for (int q = j0; q < nst_x * per; q += nper) {
            const int st = (q / per) * 8 + x;
            const int r = q % per;
            const int im = (st / nsc) * 8 + (r % 8), in = (st % nsc) * SW + (r / 8);
            gemm_tile<AMODE, HAS_RS>(Ap, lda, BT, ldb, M, N, K, im * 128, in * 128, lds, rowfn, epi);
        }
    } else {
        for (int t = bidx(); t < tm * tn; t += G) {
            int im = t / tn, in = t - im * tn;
            gemm_tile<AMODE, HAS_RS>(Ap, lda, BT, ldb, M, N, K, im * 128, in * 128, lds, rowfn, epi);
        }
    }
}
template <int AMODE, class Epi>
__device__ __forceinline__ void gemm_phase(const u16* Ap, long lda, const u16* BT, long ldb, int M, int N, int K, unsigned char* lds, Epi epi) {
    gemm_phase_rs<AMODE, false>(Ap, lda, BT, ldb, M, N, K, lds, [](int) { return float2{1.f, 1.f}; },
                                [=](int row, int col, const float (&v)[8], float2) { epi(row, col, v); });
}
__device__ __forceinline__ void st_bf8(u16* p, const float (&v)[8]) {
    *(uint4*)p = uint4{pack2(v[0], v[1]), pack2(v[2], v[3]), pack2(v[4], v[5]), pack2(v[6], v[7])};
}
__device__ __forceinline__ void ld_bf8(const u16* p, float (&v)[8]) {
    const uint4 q = *(const uint4*)p;
    v[0] = bf_lo(q.x); v[1] = bf_hi(q.x); v[2] = bf_lo(q.y); v[3] = bf_hi(q.y);
    v[4] = bf_lo(q.z); v[5] = bf_hi(q.z); v[6] = bf_lo(q.w); v[7] = bf_hi(q.w);
}

template <bool PERM = false>
__device__ __forceinline__ void transpose_cvt(const float* __restrict__ src, u16* __restrict__ dst, int K, int N, float* tile, const float* kgain = nullptr) {
    const int tk = K / 64, tn = (N + 63) / 64;
    const int tid = tidx();
    for (int t = bidx(); t < tk * tn; t += gdim()) {
        const int k0 = (t / tn) * 64, n0 = (t % tn) * 64;
        {
            const int tx = tid & 15, ty = tid >> 4;
#pragma unroll
            for (int i = 0; i < 4; ++i) {
                const int k = ty * 4 + i, n = n0 + tx * 4;
                float4 v = float4{0.f, 0.f, 0.f, 0.f};
                if (n < N) v = *(const float4*)(src + (long)(k0 + k) * N + n);
                const float g = kgain ? kgain[k0 + k] : 1.0f;
                float* trow = tile + k * 65 + tx * 4;
                trow[0] = v.x * g; trow[1] = v.y * g; trow[2] = v.z * g; trow[3] = v.w * g;
            }
        }
        __syncthreads();
        {
            const int kc = tid & 7, nl = tid >> 3;
#pragma unroll
            for (int j = 0; j < 2; ++j) {
                const int nn = nl + 32 * j, n = n0 + nn;
                float v[8];
#pragma unroll
                for (int q = 0; q < 8; ++q) v[q] = tile[(kc * 8 + q) * 65 + nn];
                if (n < N) st_bf8(dst + (long)(PERM ? perm_col(n) : n) * K + k0 + kc * 8, v);
            }
        }
        __syncthreads();
    }
}

__device__ __forceinline__ void cvt_f32_bf16(const float* __restrict__ src, u16* __restrict__ dst, long n) {
    long i = ((long)bidx() * 256 + tidx()) * 8;
    const long stride = (long)gdim() * 256 * 8;
    for (; i < n; i += stride) {
        float4 a = *(const float4*)(src + i);
        float4 b = *(const float4*)(src + i + 4);
        *(uint4*)(dst + i) = uint4{pack2(a.x, a.y), pack2(a.z, a.w), pack2(b.x, b.y), pack2(b.z, b.w)};
    }
}

typedef float f32x2_t __attribute__((ext_vector_type(2)));
typedef u32 u32x3_t __attribute__((ext_vector_type(3)));
typedef u32x3_t u32x3_a4 __attribute__((aligned(4)));
constexpr int EROW = 768;
__device__ __forceinline__ u32 enc_e2m3(float y) {
    const float a = fabsf(y);
    const float m = a < 2.f ? 8.f : (a < 4.f ? 4.f : 2.f);
    const int off = a < 2.f ? 0 : (a < 4.f ? 8 : 16);
    int c = (int)rintf(a * m) + off;
    c = c > 31 ? 31 : c;
    return (u32)c | (y < 0.f ? 32u : 0u);
}
__device__ __forceinline__ void cvt_rows_fp6(const float* __restrict__ src, unsigned char* __restrict__ dst, float* __restrict__ scales, int nrows, const float* colgain = nullptr) {
    const int lane = tidx() & 63;
    const int wid = bidx() * 4 + (tidx() >> 6);
    const int nw = gdim() * 4;
    for (int row = wid; row < nrows; row += nw) {
        const float* r = src + (long)row * 1024 + lane * 16;
        float4 q[4];
#pragma unroll
        for (int i = 0; i < 4; ++i) {
            q[i] = *(const float4*)(r + 4 * i);
            if (colgain) {
                const float4 g = *(const float4*)(colgain + lane * 16 + 4 * i);
                q[i].x *= g.x; q[i].y *= g.y; q[i].z *= g.z; q[i].w *= g.w;
            }
        }
        float am = 0.f;
#pragma unroll
        for (int i = 0; i < 4; ++i) am = fmaxf(am, fmaxf(fmaxf(fabsf(q[i].x), fabsf(q[i].y)), fmaxf(fabsf(q[i].z), fabsf(q[i].w))));
        am = wmax(am);
        const float inv = am > 0.f ? 7.5f / am : 0.f;
        if (lane == 0) scales[row] = am > 0.f ? am * (1.0f / 7.5f) : 0.f;
        u32 c[16];
#pragma unroll
        for (int i = 0; i < 4; ++i) {
            c[4 * i] = enc_e2m3(q[i].x * inv); c[4 * i + 1] = enc_e2m3(q[i].y * inv);
            c[4 * i + 2] = enc_e2m3(q[i].z * inv); c[4 * i + 3] = enc_e2m3(q[i].w * inv);
        }
        const u32 w0 = c[0] | (c[1] << 6) | (c[2] << 12) | (c[3] << 18) | (c[4] << 24) | (c[5] << 30);
        const u32 w1 = (c[5] >> 2) | (c[6] << 4) | (c[7] << 10) | (c[8] << 16) | (c[9] << 22) | (c[10] << 28);
        const u32 w2 = (c[10] >> 4) | (c[11] << 2) | (c[12] << 8) | (c[13] << 14) | (c[14] << 20) | (c[15] << 26);
        *(u32x3_a4*)(dst + (long)row * EROW + lane * 12) = u32x3_t{w0, w1, w2};
    }
}

__device__ __forceinline__ void rms_rows(const float* __restrict__ x, const float* __restrict__ g, u16* __restrict__ dst, const u16* __restrict__ e,
                         float* __restrict__ rstd_e) {
    const int lane = tidx() & 63;
    const int wid = bidx() * 4 + (tidx() >> 6);
    const int nw = gdim() * 4;
    for (int row = wid; row < NTOK; row += nw) {
        const float* xr = x + (long)row * 1024;
        float4 v[4];
        float ss = 0.f;
#pragma unroll
        for (int i = 0; i < 4; ++i) {
            v[i] = *(const float4*)(xr + i * 256 + lane * 4);
            ss += v[i].x * v[i].x + v[i].y * v[i].y + v[i].z * v[i].z + v[i].w * v[i].w;
        }
        ss = wsum(ss);
        float rstd = rsqrtf(ss * (1.0f / 1024.0f) + EPS);
#pragma unroll
        for (int i = 0; i < 4; ++i) {
            float4 gg = g ? *(const float4*)(g + i * 256 + lane * 4) : float4{1.f, 1.f, 1.f, 1.f};
            uint2 o = uint2{pack2(v[i].x * rstd * gg.x, v[i].y * rstd * gg.y), pack2(v[i].z * rstd * gg.z, v[i].w * rstd * gg.w)};
            *(uint2*)(dst + (long)row * 1024 + i * 256 + lane * 4) = o;
        }
        if (e) {
            const uint4* er = (const uint4*)(e + (long)row * 1024);
            float es = 0.f;
#pragma unroll
            for (int i = 0; i < 2; ++i) {
                uint4 q = er[i * 64 + lane];
                float a;
                a = bf_lo(q.x); es += a * a; a = bf_hi(q.x); es += a * a;
                a = bf_lo(q.y); es += a * a; a = bf_hi(q.y); es += a * a;
                a = bf_lo(q.z); es += a * a; a = bf_hi(q.z); es += a * a;
                a = bf_lo(q.w); es += a * a; a = bf_hi(q.w); es += a * a;
            }
            es = wsum(es);
            if (lane == 0) rstd_e[row] = rsqrtf(es * (1.0f / 1024.0f) + EPS);
        }
    }
}

__device__ __forceinline__ void head_chunk(u16* ptr, float gain, bool do_norm, float scale, float c, float sn, int lane) {
    float v = bf2f(ptr[lane]);
    if (do_norm) {
        float ss = wsum(v * v);
        v = v * rsqrtf(ss * (1.0f / 64.0f) + EPS) * gain;
    }
    float pv = __shfl_xor(v, 8);
    if (lane < 16) v = (lane < 8) ? (v * c - pv * sn) : (v * c + pv * sn);
    ptr[lane] = f2bf(v * scale);
}
__device__ __forceinline__ u32 sig2(u32 w) { return pack2(sigmoidf(bf_lo(w)), sigmoidf(bf_hi(w))); }

__device__ __forceinline__ void post_proj(unsigned char* ws, const float* ng, const float* dg, unsigned char* smem) {
    u16* proj = (u16*)(ws + OFF_PROJ);
    const float* ropec = (const float*)(ws + OFF_ROPE);
    const float* ropes = ropec + (size_t)NTOK * 8;
    const int lane = tidx() & 63, w = tidx() >> 6;
    u16* lrow = (u16*)(smem + w * 9216);
    const float g_q = ng[lane], g_ks = ng[128 + lane], g_kw = ng[192 + lane], g_dq = dg[lane], g_kb = dg[64 + lane];
    const int wid = bidx() * 4 + w;
    const int nw = gdim() * 4;
    for (int t = wid; t < NTOK; t += nw) {
        uint4* grow = (uint4*)(proj + (long)t * IN_COLS);
        const float c = ropec[(long)t * 8 + (lane & 7)], sn = ropes[(long)t * 8 + (lane & 7)];
#pragma unroll
        for (int i = 0; i < 8; ++i) ((uint4*)lrow)[i * 64 + lane] = grow[i * 64 + lane];
        if (lane < 60) ((uint4*)lrow)[512 + lane] = grow[512 + lane];
        WAVE_SYNC();
        for (int h = 0; h < 8; ++h) head_chunk(lrow + C_NQ + h * 64, g_q, true, 0.125f * 1.4426950408889634f, c, sn, lane);
        for (int g = 0; g < 2; ++g) head_chunk(lrow + C_NKV + (2 * 2 + g) * 64, g_ks, true, 1.0f, c, sn, lane);
        for (int g = 0; g < 2; ++g) head_chunk(lrow + C_NKV + (4 * 2 + g) * 64, g_kw, true, 1.0f, c, sn, lane);
        for (int h = 0; h < 8; ++h) head_chunk(lrow + C_DQ + h * 64, g_dq, true, 0.125f * 1.4426950408889634f, c, sn, lane);
        head_chunk(lrow + C_DKV, g_kb, true, 1.0f, c, sn, lane);
        for (int h = 0; h < 8; ++h) head_chunk(lrow + C_IQ + h * 64, 1.0f, false, 0.125f, c, sn, lane);
        head_chunk(lrow + C_IK, 1.0f, false, 1.0f, c, sn, lane);
        WAVE_SYNC();
#pragma unroll
        for (int i = 0; i < 9; ++i) {
            int idx = i * 64 + lane;
            if (idx < 572) {
                uint4 v = ((const uint4*)lrow)[idx];
                if (idx >= 316 || (idx >= 160 && idx < 163)) v = uint4{sig2(v.x), sig2(v.y), sig2(v.z), sig2(v.w)};
                grow[idx] = v;
            }
        }
        WAVE_SYNC();
    }
}

template <int NH>
__device__ __forceinline__ void qk_chunk(const u16* krow, const u32* qlds, float (&s)[NH]) {
    asm volatile("" ::: "memory");
    uint4 kr[8];
#pragma unroll
    for (int i = 0; i < 8; ++i) kr[i] = ((const uint4*)krow)[i];
#pragma unroll
    for (int h = 0; h < NH; ++h) s[h] = 0.f;
#pragma unroll
    for (int i = 0; i < 8; ++i)
#pragma unroll
        for (int h = 0; h < NH; ++h) {
            uint4 q = *(const uint4*)(qlds + h * 32 + i * 4);
            s[h] = dot2(kr[i].x, q.x, s[h]);
            s[h] = dot2(kr[i].y, q.y, s[h]);
            s[h] = dot2(kr[i].z, q.z, s[h]);
            s[h] = dot2(kr[i].w, q.w, s[h]);
        }
}

template <int NH, class VRow>
__device__ __forceinline__ void pv_chunk(const float* plds, VRow vrow, float (&o)[NH][4], int lane) {
    const int sub = lane >> 4, dq = lane & 15;
#pragma unroll 4
    for (int kk = 0; kk < 16; ++kk) {
        int key = kk * 4 + sub;
        const u16* vp = vrow(key);
        uint2 vv = *(const uint2*)(vp + dq * 4);
        float v0 = bf_lo(vv.x), v1 = bf_hi(vv.x), v2 = bf_lo(vv.y), v3 = bf_hi(vv.y);
#pragma unroll
        for (int h = 0; h < NH; ++h) {
            float ph = plds[key * NH + h];
            o[h][0] += ph * v0;
            o[h][1] += ph * v1;
            o[h][2] += ph * v2;
            o[h][3] += ph * v3;
        }
    }
}

template <int NH, class VRow>
__device__ __forceinline__ void attn_chunk(float (&s)[NH], bool valid, float (&m)[NH], float (&l)[NH], float (&o)[NH][4], float* plds, VRow vrow,
                                           int lane) {
#pragma unroll
    for (int h = 0; h < NH; ++h) {
        float sv = valid ? s[h] : -1e30f;
        float cm = wmax(sv);
        float mn = fmaxf(m[h], cm);
        float alpha = __expf(m[h] - mn);
        float p = valid ? __expf(sv - mn) : 0.f;
        l[h] = l[h] * alpha + wsum(p);
        m[h] = mn;
#pragma unroll
        for (int j = 0; j < 4; ++j) o[h][j] *= alpha;
        plds[lane * NH + h] = p;
    }
    WAVE_SYNC();
    pv_chunk<NH>(plds, vrow, o, lane);
    WAVE_SYNC();
}

#define MFMA32(a, b, c) __builtin_amdgcn_mfma_f32_32x32x16_bf16(a, b, c, 0, 0, 0)
typedef __attribute__((address_space(3))) const char* lds_cptr;
typedef short v4i16_t __attribute__((ext_vector_type(4)));
using s16x4 = __attribute__((ext_vector_type(4))) short;
__device__ __forceinline__ s16x4 vtr(lds_cptr p) {
    return __builtin_bit_cast(s16x4, __builtin_amdgcn_ds_read_tr16_b64_v4i16((__attribute__((address_space(3))) v4i16_t*)p));
}
__device__ __forceinline__ float xhalf_sum(float v) {
    auto r = __builtin_amdgcn_permlane32_swap(__float_as_uint(v), __float_as_uint(v), false, false);
    return __uint_as_float(r[0]) + __uint_as_float(r[1]);
}
__device__ __forceinline__ float xhalf_max(float v) {
    auto r = __builtin_amdgcn_permlane32_swap(__float_as_uint(v), __float_as_uint(v), false, false);
    return fmaxf(__uint_as_float(r[0]), __uint_as_float(r[1]));
}

using u32x4 = __attribute__((ext_vector_type(4))) unsigned;
struct TileRegs { u32x4 k0, k1, v0, v1; };
template <class RowPtr>
__device__ __forceinline__ void tile_load(u32x4& k0, u32x4& k1, u32x4& v0, u32x4& v1, RowPtr rowptr, int w, int lane) {
    const u16 *kp, *vp, *kp2, *vp2;
    rowptr(lane, kp, vp2);
    rowptr(16 * w + (lane >> 2), kp2, vp);
    k0 = *(const u32x4*)(kp + w * 8);
    k1 = *(const u32x4*)(kp + (w + 4) * 8);
    v0 = *(const u32x4*)(vp + (lane & 3) * 8);
    v1 = *(const u32x4*)(vp + 32 + (lane & 3) * 8);
}
__device__ __forceinline__ void tile_store(const u32x4& k0, const u32x4& k1, const u32x4& v0, const u32x4& v1, unsigned char* buf, int w, int lane) {
    *(u32x4*)(buf + w * 1024 + lane * 16) = k0;
    *(u32x4*)(buf + (w + 4) * 1024 + lane * 16) = k1;
    *(u32x4*)(buf + 8192 + (16 * w + (lane >> 2)) * 64 + (lane & 3) * 16) = v0;
    *(u32x4*)(buf + 8192 + 4096 + (16 * w + (lane >> 2)) * 64 + (lane & 3) * 16) = v1;
}
__device__ __forceinline__ void glds16(const void* g, unsigned lds_base) {
    unsigned sv;
    asm volatile("s_mov_b32 %0, m0\n\ts_mov_b32 m0, %2\n\ts_nop 0\n\tglobal_load_lds_dwordx4 %1, off\n\ts_mov_b32 m0, %0"
                 : "=&s"(sv)
                 : "v"(g), "s"(lds_base)
                 : "memory");
}
template <class RowPtr>
__device__ __forceinline__ void tile_dma(RowPtr rowptr, unsigned char* buf, int w, int lane) {
    const u16 *kp, *vp, *kp2, *vp2;
    rowptr(lane, kp, vp2);
    rowptr(16 * w + (lane >> 2), kp2, vp);
    const unsigned kd = (unsigned)__builtin_amdgcn_readfirstlane((int)((unsigned)(uintptr_t)buf + (unsigned)(w * 1024)));
    const unsigned vd = kd + 8192u;
    glds16(kp + w * 8, kd);
    glds16(kp + (w + 4) * 8, kd + 4096u);
    glds16(vp + (lane & 3) * 8, vd);
    glds16(vp + 32 + (lane & 3) * 8, vd + 4096u);
}
__device__ __forceinline__ void qk_tile(const unsigned char* buf, const bf16x8 (&qr)[4], const f32x16& zero16, f32x16& s0, f32x16& s1, int lane) {
    const int r32 = lane & 31, hi = lane >> 5;
    lds_cptr kp = (lds_cptr)buf + hi * 1024 + r32 * 16;
#pragma unroll
    for (int d0 = 0; d0 < 4; ++d0) {
        bf16x8 k0 = *(const __attribute__((address_space(3))) bf16x8*)(kp + d0 * 2048);
        bf16x8 k1 = *(const __attribute__((address_space(3))) bf16x8*)(kp + d0 * 2048 + 512);
        s0 = MFMA32(k0, qr[d0], d0 == 0 ? zero16 : s0);
        s1 = MFMA32(k1, qr[d0], d0 == 0 ? zero16 : s1);
    }
}
__device__ __forceinline__ bf16x8 pack8(const f32x16& p, int s) {
    u32 a = pack2(p[8 * s + 0], p[8 * s + 1]), b = pack2(p[8 * s + 2], p[8 * s + 3]);
    u32 c = pack2(p[8 * s + 4], p[8 * s + 5]), d = pack2(p[8 * s + 6], p[8 * s + 7]);
    u32x4 v = u32x4{a, b, c, d};
    return __builtin_bit_cast(bf16x8, v);
}
__device__ __forceinline__ void pv_tile(const unsigned char* buf, const f32x16& p0, const f32x16& p1, f32x16 (&o)[2], int lane) {
    const int hi = lane >> 5;
    lds_cptr vp = (lds_cptr)buf + 8192 + ((lane >> 4) & 1) * 32 + (lane & 3) * 8 + (4 * hi + ((lane & 15) >> 2)) * 64;
    bf16x8 pf[4];
    pf[0] = pack8(p0, 0);
    pf[1] = pack8(p0, 1);
    pf[2] = pack8(p1, 0);
    pf[3] = pack8(p1, 1);
#pragma unroll
    for (int dh = 0; dh < 2; ++dh) {
        bf16x8 vf[4];
#pragma unroll
        for (int ks = 0; ks < 4; ++ks) {
            const uint2 vlo = __builtin_bit_cast(uint2, vtr(vp + dh * 4096 + ks * 1024));
            const uint2 vhi = __builtin_bit_cast(uint2, vtr(vp + dh * 4096 + ks * 1024 + 512));
            const u32x4 vq = u32x4{vlo.x, vlo.y, vhi.x, vhi.y};
            vf[ks] = __builtin_bit_cast(bf16x8, vq);
        }
        __builtin_amdgcn_sched_barrier(0);
#pragma unroll
        for (int ks = 0; ks < 4; ++ks) o[dh] = MFMA32(vf[ks], pf[ks], o[dh]);
        __builtin_amdgcn_sched_barrier(0);
    }
}
template <bool BITS>
__device__ __forceinline__ void apply_mask(f32x16& s0, f32x16& s1, int lo, int hi_lim, u64 word, int hi) {
    const u32 wlo = (u32)(word >> (4 * hi)), whi = (u32)(word >> (32 + 4 * hi));
#pragma unroll
    for (int i = 0; i < 16; ++i) {
        const int kc = (i & 3) + 8 * (i >> 2);
        bool v0, v1;
        if (BITS) {
            v0 = (wlo >> kc) & 1u;
            v1 = (whi >> kc) & 1u;
        } else {
            const int kk = kc + 4 * hi;
            v0 = (kk >= lo) && (kk <= hi_lim);
            v1 = (kk + 32 >= lo) && (kk + 32 <= hi_lim);
        }
        s0[i] = v0 ? s0[i] : -1e30f;
        s1[i] = v1 ? s1[i] : -1e30f;
    }
}
__device__ __forceinline__ void softmax_step(f32x16& s0, f32x16& s1, float& m, float& l, f32x16 (&o)[2]) {
    float mx = fmaxf(s0[0], s1[0]);
#pragma unroll
    for (int i = 1; i < 16; ++i) mx = fmaxf(fmaxf(mx, s0[i]), s1[i]);
    mx = xhalf_max(mx);
    if (__any(mx > m + 8.0f)) {
        const float mn = fmaxf(m, mx);
        const float alpha = __builtin_amdgcn_exp2f(m - mn);
        l *= alpha;
        m = mn;
#pragma unroll
        for (int i = 0; i < 16; ++i) { o[0][i] *= alpha; o[1][i] *= alpha; }
    }
    const float ms = fmaxf(m, -1e29f);
    float sum = 0.f;
#pragma unroll
    for (int i = 0; i < 16; ++i) {
        s0[i] = __builtin_amdgcn_exp2f(s0[i] - ms);
        s1[i] = __builtin_amdgcn_exp2f(s1[i] - ms);
        sum += s0[i] + s1[i];
    }
    l += xhalf_sum(sum);
}

template <int MODE, bool BITS, class Next, class RowPtr, class MaskFn, class Extra>
__device__ __forceinline__ void flash_run(int first, Next next, RowPtr rowptr, MaskFn maskfn, Extra extra, const bf16x8 (&qr)[4], float& m, float& l,
                                          f32x16 (&o)[2], unsigned char* bufs, int w, int lane) {
    if (first < 0) return;
    int cur = first;
    int nxt = next(cur);
    asm volatile("" ::"v"(qr[0]), "v"(qr[1]), "v"(qr[2]), "v"(qr[3]));
    __syncthreads();
    tile_dma([&](int r, const u16*& kp, const u16*& vp) { rowptr(cur, r, kp, vp); }, bufs, w, lane);
    if (nxt >= 0) tile_dma([&](int r, const u16*& kp, const u16*& vp) { rowptr(nxt, r, kp, vp); }, bufs + 16384, w, lane);
    int pb = 0, pb2 = 2;
    f32x16 zero16;
#pragma unroll
    for (int i = 0; i < 16; ++i) zero16[i] = 0.f;
    while (cur >= 0) {
        if (nxt >= 0) asm volatile("s_waitcnt vmcnt(4)" ::: "memory");
        else asm volatile("s_waitcnt vmcnt(0)" ::: "memory");
        asm volatile("s_waitcnt lgkmcnt(0)" ::: "memory");
        __builtin_amdgcn_s_barrier();
        const int nn = nxt >= 0 ? next(nxt) : -1;
        if (nn >= 0) tile_dma([&](int r, const u16*& kp, const u16*& vp) { rowptr(nn, r, kp, vp); }, bufs + pb2 * 16384, w, lane);
        const unsigned char* buf = bufs + pb * 16384;
        f32x16 s0, s1;
        qk_tile(buf, qr, zero16, s0, s1, lane);
        int lo, hl;
        u64 word;
        maskfn(cur, lo, hl, word);
        if (BITS || !__all(lo <= 0 && hl >= 63)) apply_mask<BITS>(s0, s1, lo, hl, word, lane >> 5);
        if (MODE == 0) {
            softmax_step(s0, s1, m, l, o);
            pv_tile(buf, s0, s1, o, lane);
        } else if (MODE == 1) {
            f32x16 od[2];
#pragma unroll
            for (int i = 0; i < 16; ++i) { od[0][i] = 0.f; od[1][i] = 0.f; }
            softmax_step(s0, s1, m, l, od);
        } else {
            const float ms2 = fmaxf(m, -1e29f);
#pragma unroll
            for (int i = 0; i < 16; ++i) {
                s0[i] = __builtin_amdgcn_exp2f(s0[i] - ms2) * l;
                s1[i] = __builtin_amdgcn_exp2f(s1[i] - ms2) * l;
            }
            extra(cur, s0, s1);
            pv_tile(buf, s0, s1, o, lane);
        }
        pb = (pb == 2) ? 0 : pb + 1;
        pb2 = (pb2 == 2) ? 0 : pb2 + 1;
        cur = nxt;
        nxt = nn;
    }
}

__device__ __forceinline__ void nsa_unit(unsigned char* ws, int b, int g, int qt, unsigned char* smem) {
    const int tid = tidx(), lane = tid & 63, w = tid >> 6;
    const int r32 = lane & 31, hi = lane >> 5;
    const int q0 = qt * 32;
    const int tl = q0 + 8 * w + (r32 >> 2);
    const int rep = r32 & 3;
    const u16* proj = (const u16*)(ws + OFF_PROJ);
    const u16* brow = proj + (long)b * SEQ * IN_COLS;
    const u16* kcb = (const u16*)(ws + OFF_KCB) + (size_t)(b * 2 + g) * 256 * 64;
    const u16* vcb = (const u16*)(ws + OFF_VCB) + (size_t)(b * 2 + g) * 256 * 64;
    u16* ya = (u16*)(ws + OFF_YAB);
    unsigned char* bufs = smem;
    float* imp = (float*)(smem + 49152);
    u64* selm = (u64*)(smem + 49152 + 8192);
    const u16* trow = brow + (long)tl * IN_COLS;
    bf16x8 qr[4];
#pragma unroll
    for (int d0 = 0; d0 < 4; ++d0) qr[d0] = *(const bf16x8*)(trow + C_NQ + (g * 4 + rep) * 64 + d0 * 16 + hi * 8);
    const float gate_c = bf2f(trow[C_NG + 0 * 8 + g * 4 + rep]);
    const float gate_s = bf2f(trow[C_NG + 1 * 8 + g * 4 + rep]);
    const float gate_w = bf2f(trow[C_NG + 2 * 8 + g * 4 + rep]);
    for (int i = tid; i < 32 * 64; i += 256) imp[i] = 0.f;
    f32x16 tot[2];
#pragma unroll
    for (int i = 0; i < 16; ++i) { tot[0][i] = 0.f; tot[1][i] = 0.f; }

    const int nvalid = tl >= 31 ? ((tl - 31) >> 4) + 1 : 0;
    const int nv_max = (q0 + 31 >= 31) ? ((q0 + 31 - 31) >> 4) + 1 : 0;
    const int ntile_c = (nv_max + 63) >> 6;
    auto crows = [&](int tile, int r, const u16*& kp, const u16*& vp) {
        int n = tile * 64 + r;
        n = n < 254 ? n : 254;
        kp = kcb + (size_t)n * 64;
        vp = vcb + (size_t)n * 64;
    };
    auto cnext = [&](int c) { return (c + 1 < ntile_c) ? c + 1 : -1; };
    auto cmask = [&](int tile, int& lo, int& hl, u64& word) { lo = 0; hl = nvalid - 64 * tile - 1; word = 0; };
    {
        float m = -1e30f, l = 0.f;
        f32x16 o[2];
#pragma unroll
        for (int i = 0; i < 16; ++i) { o[0][i] = 0.f; o[1][i] = 0.f; }
        flash_run<1, false>(ntile_c > 0 ? 0 : -1, cnext, crows, cmask, [&](int, f32x16&, f32x16&) {}, qr, m, l, o, bufs, w, lane);
        float invl = l > 0.f ? 1.0f / l : 0.f;
        const int qloc = 8 * w + (r32 >> 2);
        flash_run<2, false>(ntile_c > 0 ? 0 : -1, cnext, crows, cmask,
                            [&](int tile, f32x16& p0, f32x16& p1) {
#pragma unroll
                                for (int a = 0; a < 4; ++a) {
                                    float g0 = p0[4 * a] + p0[4 * a + 1] + p0[4 * a + 2] + p0[4 * a + 3], e0 = p0[4 * a + 3];
                                    float g1 = p1[4 * a] + p1[4 * a + 1] + p1[4 * a + 2] + p1[4 * a + 3], e1 = p1[4 * a + 3];
                                    g0 += __shfl_xor(g0, 1); g0 += __shfl_xor(g0, 2);
                                    e0 += __shfl_xor(e0, 1); e0 += __shfl_xor(e0, 2);
                                    g1 += __shfl_xor(g1, 1); g1 += __shfl_xor(g1, 2);
                                    e1 += __shfl_xor(e1, 1); e1 += __shfl_xor(e1, 2);
                                    if (rep == 0) {
                                        int j0 = 16 * tile + 2 * a + hi, j1 = j0 + 8;
                                        atomicAdd(&imp[qloc * 64 + j0], g0);
                                        if (j0 + 1 < 64) atomicAdd(&imp[qloc * 64 + j0 + 1], e0);
                                        if (j1 < 64) atomicAdd(&imp[qloc * 64 + j1], g1);
                                        if (j1 + 1 < 64) atomicAdd(&imp[qloc * 64 + j1 + 1], e1);
                                    }
                                }
                            },
                            qr, m, invl, o, bufs, w, lane);
#pragma unroll
        for (int i = 0; i < 16; ++i) { tot[0][i] += gate_c * o[0][i]; tot[1][i] += gate_c * o[1][i]; }
    }
    __syncthreads();
    for (int qq = 0; qq < 8; ++qq) {
        const int qi = 8 * w + qq;
        const int tq = q0 + qi;
        const int cur = tq >> 6;
        const int j = lane;
        float v = imp[qi * 64 + j];
        if (j == 0 || j == cur || j == cur - 1) v = __builtin_inff();
        if (j > cur) v = -__builtin_inff();
        const u32 key = sortkey(v);
        u32 Kq = 0u;
        for (int bit = 31; bit >= 0; --bit) {
            const u32 cand = Kq | (1u << bit);
            const int cnt = __popcll(__ballot(key >= cand));
            if (cnt >= 16) Kq = cand;
            if (cnt == 16) break;
        }
        const int needq = 16 - __popcll(__ballot(key > Kq));
        const u64 emq = __ballot(key == Kq);
        const bool takeq = (key > Kq) || (key == Kq && __popcll(emq & ((1ull << lane) - 1ull)) < needq);
        u64 sm = __ballot(takeq && j <= cur);
        if (lane == 0) selm[qi] = sm;
    }
    __syncthreads();
    const u64 mymask = selm[8 * w + (r32 >> 2)];
    u64 unionm = 0;
    for (int i = 0; i < 32; ++i) unionm |= selm[i];
    unionm = __builtin_amdgcn_readfirstlane((u32)unionm) | ((u64)__builtin_amdgcn_readfirstlane((u32)(unionm >> 32)) << 32);
    {
        float m = -1e30f, l = 0.f;
        f32x16 o[2];
#pragma unroll
        for (int i = 0; i < 16; ++i) { o[0][i] = 0.f; o[1][i] = 0.f; }
        auto snext = [&](int c) {
            u64 rest = (c >= 63) ? 0ull : (unionm >> (c + 1));
            return rest ? (c + 1 + (__ffsll((long long)rest) - 1)) : -1;
        };
        const int first = unionm ? (__ffsll((long long)unionm) - 1) : -1;
        flash_run<0, false>(first, snext,
                            [&](int j, int r, const u16*& kp, const u16*& vp) {
                                const u16* rp = brow + (long)(64 * j + r) * IN_COLS + C_NKV;
                                kp = rp + (2 * 2 + g) * 64;
                                vp = rp + (3 * 2 + g) * 64;
                            },
                            [&](int j, int& lo, int& hl, u64& word) { lo = 0; hl = ((mymask >> j) & 1ull) ? (tl - 64 * j) : -1; word = 0; },
                            [&](int, f32x16&, f32x16&) {}, qr, m, l, o, bufs, w, lane);
        const float sc = l > 0.f ? gate_s / l : 0.f;
#pragma unroll
        for (int i = 0; i < 16; ++i) { tot[0][i] += sc * o[0][i]; tot[1][i] += sc * o[1][i]; }
    }
    {
        float m = -1e30f, l = 0.f;
        f32x16 o[2];
#pragma unroll
        for (int i = 0; i < 16; ++i) { o[0][i] = 0.f; o[1][i] = 0.f; }
        const int jfirst = (q0 - 511) > 0 ? ((q0 - 511) >> 6) : 0;
        const int jlast = (q0 + 31) >> 6;
        flash_run<0, false>(jfirst, [&](int c) { return c + 1 <= jlast ? c + 1 : -1; },
                            [&](int j, int r, const u16*& kp, const u16*& vp) {
                                const u16* rp = brow + (long)(64 * j + r) * IN_COLS + C_NKV;
                                kp = rp + (4 * 2 + g) * 64;
                                vp = rp + (5 * 2 + g) * 64;
                            },
                            [&](int j, int& lo, int& hl, u64& word) { lo = tl - 511 - 64 * j; hl = tl - 64 * j; word = 0; },
                            [&](int, f32x16&, f32x16&) {}, qr, m, l, o, bufs, w, lane);
        const float sc = l > 0.f ? gate_w / l : 0.f;
#pragma unroll
        for (int i = 0; i < 16; ++i) { tot[0][i] += sc * o[0][i]; tot[1][i] += sc * o[1][i]; }
    }
    {
        u16* orow = ya + ((long)b * SEQ + tl) * 512 + (g * 4 + rep) * 64;
#pragma unroll
        for (int dh = 0; dh < 2; ++dh)
#pragma unroll
            for (int a = 0; a < 4; ++a) {
                uint2 v = uint2{pack2(tot[dh][4 * a], tot[dh][4 * a + 1]), pack2(tot[dh][4 * a + 2], tot[dh][4 * a + 3])};
                *(uint2*)(orow + dh * 32 + 8 * a + 4 * hi) = v;
            }
    }
}

__device__ __forceinline__ void dsa_select_unit(unsigned char* ws, int unit, unsigned char* smem, unsigned long long& tacc) {
    const int tid = tidx(), lane = tid & 63, w = tid >> 6;
    const int t0 = unit * 4;
    const int b = t0 / SEQ, tl0 = t0 - b * SEQ;
    const u16* proj = (const u16*)(ws + OFF_PROJ);
    const u16* brow = proj + (long)b * SEQ * IN_COLS;
    u64* bits = (u64*)(ws + OFF_BITS);
    float* sc = (float*)smem;
    __syncthreads();
    unsigned long long ts0 = SEC_T();
#ifndef ATTA_REP_IDX
#define ATTA_REP_IDX 1
#endif
#ifndef ATTA_REP_TOPK
#define ATTA_REP_TOPK 1
#endif
    for (int rep_ = 0; rep_ < ATTA_REP_IDX; ++rep_) {
        const int r16 = lane & 15, g4 = lane >> 4;
        bf16x8 af[2][2];
#pragma unroll
        for (int rb = 0; rb < 2; ++rb)
#pragma unroll
            for (int ks = 0; ks < 2; ++ks)
                af[rb][ks] = *(const bf16x8*)(proj + (long)(t0 + 2 * rb + (r16 >> 3)) * IN_COLS + C_IQ + (r16 & 7) * 64 + ks * 32 + g4 * 8);
        float wq[2][4];
#pragma unroll
        for (int rb = 0; rb < 2; ++rb)
#pragma unroll
            for (int i = 0; i < 4; ++i)
                wq[rb][i] = bf2f(proj[(long)(t0 + 2 * rb + (g4 >> 1)) * IN_COLS + C_IW + (g4 & 1) * 4 + i]) * 0.35355339059327373f;
        const int ntiles = (tl0 + 4 + 31) >> 5;
#define IDX_LD(T, B)                                                                                         \
    do {                                                                                                     \
        _Pragma("unroll") for (int kt = 0; kt < 2; ++kt) {                                                   \
            int key_ = (T) * 32 + kt * 16 + r16;                                                             \
            key_ = key_ < SEQ ? key_ : SEQ - 1;                                                              \
            _Pragma("unroll") for (int ks = 0; ks < 2; ++ks)                                                 \
                B[kt][ks] = *(const bf16x8*)(brow + (long)key_ * IN_COLS + C_IK + ks * 32 + g4 * 8);         \
        }                                                                                                    \
    } while (0)
        asm volatile("" ::"v"(af[0][0]), "v"(af[0][1]), "v"(af[1][0]), "v"(af[1][1]));
        asm volatile("" ::"v"(wq[0][0]), "v"(wq[0][1]), "v"(wq[0][2]), "v"(wq[0][3]), "v"(wq[1][0]), "v"(wq[1][1]), "v"(wq[1][2]), "v"(wq[1][3]));
        bf16x8 bn[2][2];
        if (w < ntiles) IDX_LD(w, bn);
        for (int tile = w; tile < ntiles; tile += 4) {
            bf16x8 bc[2][2];
#pragma unroll
            for (int kt = 0; kt < 2; ++kt)
#pragma unroll
                for (int ks = 0; ks < 2; ++ks) bc[kt][ks] = bn[kt][ks];
            if (tile + 4 < ntiles) IDX_LD(tile + 4, bn);
#pragma unroll
            for (int rb = 0; rb < 2; ++rb)
#pragma unroll
                for (int kt = 0; kt < 2; ++kt) {
                    f32x4 acc = f32x4{0.f, 0.f, 0.f, 0.f};
                    acc = __builtin_amdgcn_mfma_f32_16x16x32_bf16(af[rb][0], bc[kt][0], acc, 0, 0, 0);
                    acc = __builtin_amdgcn_mfma_f32_16x16x32_bf16(af[rb][1], bc[kt][1], acc, 0, 0, 0);
                    float part = 0.f;
#pragma unroll
                    for (int i = 0; i < 4; ++i) part += wq[rb][i] * fmaxf(acc[i], 0.f);
                    auto sw = __builtin_amdgcn_permlane16_swap(__float_as_uint(part), __float_as_uint(part), false, false);
                    const float tot = __uint_as_float(sw[0]) + __uint_as_float(sw[1]);
                    if ((g4 & 1) == 0) sc[(2 * rb + (g4 >> 1)) * 4096 + tile * 32 + kt * 16 + r16] = tot;
                }
        }
#undef IDX_LD
    }
    __syncthreads();
    SEC_ADD(1, ts0);
    ts0 = SEC_T();
    const int t = t0 + w;
    const int tl = tl0 + w;
    const int nvalid = tl + 1;
    for (int rep_ = 0; rep_ < ATTA_REP_TOPK; ++rep_) {
        u32 u[64];
        const float* scq = sc + w * 4096;
#pragma unroll
        for (int j = 0; j < 64; ++j) {
            const int key = j * 64 + lane;
            const u32 kk = sortkey(scq[key]);
            u[j] = (key <= tl) ? kk : 0u;
        }
        SEC_ADD(2, ts0);
        ts0 = SEC_T();
        u32 K = 0;
        int need = 0, ceq = 0;
        if (nvalid > 256) {
            u32 lm0 = u[0], lm1 = u[1], lm2 = u[2], lm3 = u[3];
#pragma unroll
            for (int j = 4; j < 64; j += 4) { lm0 = max(lm0, u[j]); lm1 = max(lm1, u[j + 1]); lm2 = max(lm2, u[j + 2]); lm3 = max(lm3, u[j + 3]); }
            u32 lo = min(min(lm0, lm1), min(lm2, lm3)), hiu = max(max(lm0, lm1), max(lm2, lm3));
            lo = row_min16u(lo);
            hiu = row_max16u(hiu);
            const u32 L = min(min((u32)__builtin_amdgcn_readlane((int)lo, 0), (u32)__builtin_amdgcn_readlane((int)lo, 16)),
                              min((u32)__builtin_amdgcn_readlane((int)lo, 32), (u32)__builtin_amdgcn_readlane((int)lo, 48)));
            const u32 U = max(max((u32)__builtin_amdgcn_readlane((int)hiu, 0), (u32)__builtin_amdgcn_readlane((int)hiu, 16)),
                              max((u32)__builtin_amdgcn_readlane((int)hiu, 32), (u32)__builtin_amdgcn_readlane((int)hiu, 48)));
            const u32 dd = U ^ L;
            const int hb = dd ? 31 - __clz((int)dd) : -1;
            K = dd ? (U & ~((2u << hb) - 1u)) : U;
            bool exact = false;
            for (int bit = hb; bit >= 0; --bit) {
                const u32 cand = K | (1u << bit);
                int cl = 0;
#pragma unroll
                for (int j = 0; j < 64; ++j) cl += (u[j] >= cand) ? 1 : 0;
                const int cnt = wsumi(cl);
                if (cnt >= 256) K = cand;
                if (cnt == 256) { exact = true; break; }
            }
            if (exact) {
                need = 1; ceq = 1;
            } else {
                int cgt = 0, ce = 0;
#pragma unroll
                for (int j = 0; j < 64; ++j) { cgt += __popcll(__ballot(u[j] > K)); ce += __popcll(__ballot(u[j] == K)); }
                need = 256 - cgt;
                ceq = ce;
            }
        }
        SEC_ADD(3, ts0);
        ts0 = SEC_T();
        const u64 ltmask = (1ull << lane) - 1ull;
        u64 myword = 0;
        if (nvalid <= 256 || need == ceq) {
            const u32 Kt = (nvalid > 256) ? K : 1u;
#pragma unroll
            for (int j = 0; j < 64; ++j) {
                const u64 sm = __ballot(u[j] >= Kt);
                myword = (lane == j) ? sm : myword;
            }
        } else {
            int ebase = 0;
#pragma unroll
            for (int j = 0; j < 64; ++j) {
                bool eq = (u[j] == K);
                u64 em = __ballot(eq);
                int erank = ebase + __popcll(em & ltmask);
                bool take = (u[j] > K) || (eq && erank < need);
                ebase += __popcll(em);
                u64 sm = __ballot(take);
                myword = (lane == j) ? sm : myword;
            }
        }
        bits[(long)t * 64 + lane] = myword;
        SEC_ADD(4, ts0);
    }
}

__device__ __forceinline__ void dsa_attn_unit(unsigned char* ws, int b, int qt, unsigned char* smem) {
    const int tid = tidx(), lane = tid & 63, w = tid >> 6;
    const int r32 = lane & 31, hi = lane >> 5;
    const int q0 = qt * 16;
    const int qloc = 4 * w + (r32 >> 3);
    const int tl = q0 + qloc;
    const int head = r32 & 7;
    const u16* proj = (const u16*)(ws + OFF_PROJ);
    const u16* brow = proj + (long)b * SEQ * IN_COLS;
    const u64* bits = (const u64*)(ws + OFF_BITS) + ((long)b * SEQ + q0) * 64;
    u16* yb = (u16*)(ws + OFF_YAB) + (size_t)NTOK * 512;
    unsigned char* bufs = smem;
    u64* lbits = (u64*)(smem + 49152);
    __syncthreads();
    for (int i = tid; i < 16 * 64; i += 256) lbits[i] = bits[i];
    const u16* trow = brow + (long)tl * IN_COLS;
    bf16x8 qr[4];
#pragma unroll
    for (int d0 = 0; d0 < 4; ++d0) qr[d0] = *(const bf16x8*)(trow + C_DQ + head * 64 + d0 * 16 + hi * 8);
    float m = -1e30f, l = 0.f;
    f32x16 o[2];
#pragma unroll
    for (int i = 0; i < 16; ++i) { o[0][i] = 0.f; o[1][i] = 0.f; }
    const int jlast = (q0 + 15) >> 6;
    flash_run<0, true>(0, [&](int c) { return c + 1 <= jlast ? c + 1 : -1; },
                       [&](int j, int r, const u16*& kp, const u16*& vp) {
                           const u16* rp = brow + (long)(64 * j + r) * IN_COLS + C_DKV;
                           kp = rp;
                           vp = rp + 64;
                       },
                       [&](int j, int& lo, int& hl, u64& word) { lo = 0; hl = 0; word = lbits[qloc * 64 + j]; },
                       [&](int, f32x16&, f32x16&) {}, qr, m, l, o, bufs, w, lane);
    const float inv = l > 0.f ? 1.0f / l : 0.f;
    u16* orow = yb + ((long)b * SEQ + tl) * 512 + head * 64;
#pragma unroll
    for (int dh = 0; dh < 2; ++dh)
#pragma unroll
        for (int a = 0; a < 4; ++a) {
            uint2 v = uint2{pack2(o[dh][4 * a] * inv, o[dh][4 * a + 1] * inv), pack2(o[dh][4 * a + 2] * inv, o[dh][4 * a + 3] * inv)};
            *(uint2*)(orow + dh * 32 + 8 * a + 4 * hi) = v;
        }
}

__device__ __forceinline__ int grab_block(unsigned* ctr, int limit, unsigned char* smem) {
    volatile int* slot = (volatile int*)(smem + LDS_BYTES + 8);
    __syncthreads();
    if (threadIdx.x == 0) *slot = (int)__hip_atomic_fetch_add(ctr, 1u, __ATOMIC_RELAXED, __HIP_MEMORY_SCOPE_AGENT);
    __syncthreads();
    const int v = *slot;
    return v < limit ? v : -1;
}
__device__ __forceinline__ int grab_wave(unsigned* ctr, int limit) {
    int v = 0;
    if ((threadIdx.x & 63) == 0) v = (int)__hip_atomic_fetch_add(ctr, 1u, __ATOMIC_RELAXED, __HIP_MEMORY_SCOPE_AGENT);
    v = __builtin_amdgcn_readfirstlane(v);
    return v < limit ? v : -1;
}

typedef u32 u32x6_t __attribute__((ext_vector_type(6)));
typedef float f32x32_t __attribute__((ext_vector_type(32)));
typedef __bf16 bf16x32_t __attribute__((ext_vector_type(32)));
typedef __bf16 bf16x2_t __attribute__((ext_vector_type(2)));
#define PE_LD(Q, TB, E0)                                                                      \
    do {                                                                                      \
        asm volatile("" ::: "memory");                                                        \
        const int idv_ = ((E0) < 64) ? id0 : id1;     \
        _Pragma("unroll") for (int k_ = 0; k_ < 4; ++k_) {                                    \
            const int id_ = __builtin_amdgcn_readlane(idv_, ((E0) + k_) & 63);                \
            Q[k_] = *(const u32x3_a4*)((TB) + (long)id_ * EROW + lane * 12);                  \
        }                                                                                     \
        asm volatile("" ::: "memory");                                                        \
    } while (0)
#define PE_NOPA "s_nop 1\n\t"
#define PE_NOPB "s_nop 7\n\t"
#define PE_DOT(Q, PB)                                                                         \
    do {                                                                                      \
        _Pragma("unroll") for (int k_ = 0; k_ < 4; k_ += 2) {                                 \
            const u32x6_t ab_ = {Q[k_][0], Q[k_][1], Q[k_][2], Q[k_ + 1][0], Q[k_ + 1][1], Q[k_ + 1][2]}; \
            f32x2_t d0_, d1_;                                                                 \
            asm volatile(PE_NOPA "v_cvt_scalef32_pk32_f32_fp6 v[200:231], %[ab], 1.0\n\t" PE_NOPB \
                "v_pk_mul_f32 %[d0], %[h0], v[200:201]\n\t" \
                "v_pk_fma_f32 %[d0], %[h1], v[202:203], %[d0]\n\t" \
                "v_pk_fma_f32 %[d0], %[h2], v[204:205], %[d0]\n\t" \
                "v_pk_fma_f32 %[d0], %[h3], v[206:207], %[d0]\n\t" \
                "v_pk_fma_f32 %[d0], %[h4], v[208:209], %[d0]\n\t" \
                "v_pk_fma_f32 %[d0], %[h5], v[210:211], %[d0]\n\t" \
                "v_pk_fma_f32 %[d0], %[h6], v[212:213], %[d0]\n\t" \
                "v_pk_fma_f32 %[d0], %[h7], v[214:215], %[d0]\n\t" \
                "v_pk_mul_f32 %[d1], %[h0], v[216:217]\n\t" \
                "v_pk_fma_f32 %[d1], %[h1], v[218:219], %[d1]\n\t" \
                "v_pk_fma_f32 %[d1], %[h2], v[220:221], %[d1]\n\t" \
                "v_pk_fma_f32 %[d1], %[h3], v[222:223], %[d1]\n\t" \
                "v_pk_fma_f32 %[d1], %[h4], v[224:225], %[d1]\n\t" \
                "v_pk_fma_f32 %[d1], %[h5], v[226:227], %[d1]\n\t" \
                "v_pk_fma_f32 %[d1], %[h6], v[228:229], %[d1]\n\t" \
                "v_pk_fma_f32 %[d1], %[h7], v[230:231], %[d1]\n\t" \
                ""                                                     \
                : [d0] "=&v"(d0_), [d1] "=&v"(d1_)                                            \
                : [ab] "v"(ab_), [h0] "v"(hf2[0]), [h1] "v"(hf2[1]), [h2] "v"(hf2[2]), [h3] "v"(hf2[3]), \
                  [h4] "v"(hf2[4]), [h5] "v"(hf2[5]), [h6] "v"(hf2[6]), [h7] "v"(hf2[7])      \
                : "v200", "v201", "v202", "v203", "v204", "v205", "v206", "v207", "v208", "v209", "v210", "v211", "v212", "v213", "v214", "v215", "v216", "v217", "v218", "v219", "v220", "v221", "v222", "v223", "v224", "v225", "v226", "v227", "v228", "v229", "v230", "v231");                                                         \
            pp[(PB) + k_] = d0_[0] + d0_[1];                                                  \
            pp[(PB) + k_ + 1] = d1_[0] + d1_[1];                                              \
        }                                                                                     \
    } while (0)
#define PE_AXPY(Q, E0)                                                                        \
    do {                                                                                      \
        const int av_ = __float_as_int(((E0) < 64) ? act0 : act1);                            \
        _Pragma("unroll") for (int k_ = 0; k_ < 4; k_ += 2) {                                 \
            const unsigned long long a_ = (u32)__builtin_amdgcn_readlane(av_, ((E0) + k_) & 63);      \
            const unsigned long long b_ = (u32)__builtin_amdgcn_readlane(av_, ((E0) + k_ + 1) & 63);  \
            const u32x6_t ab_ = {Q[k_][0], Q[k_][1], Q[k_][2], Q[k_ + 1][0], Q[k_ + 1][1], Q[k_ + 1][2]}; \
            asm volatile(PE_NOPA "v_cvt_scalef32_pk32_f32_fp6 v[200:231], %[ab], 1.0\n\t" PE_NOPB \
                "v_pk_fma_f32 %[c0], v[200:201], %[a], %[c0] op_sel_hi:[1,0,1]\n\t" \
                "v_pk_fma_f32 %[c1], v[202:203], %[a], %[c1] op_sel_hi:[1,0,1]\n\t" \
                "v_pk_fma_f32 %[c2], v[204:205], %[a], %[c2] op_sel_hi:[1,0,1]\n\t" \
                "v_pk_fma_f32 %[c3], v[206:207], %[a], %[c3] op_sel_hi:[1,0,1]\n\t" \
                "v_pk_fma_f32 %[c4], v[208:209], %[a], %[c4] op_sel_hi:[1,0,1]\n\t" \
                "v_pk_fma_f32 %[c5], v[210:211], %[a], %[c5] op_sel_hi:[1,0,1]\n\t" \
                "v_pk_fma_f32 %[c6], v[212:213], %[a], %[c6] op_sel_hi:[1,0,1]\n\t" \
                "v_pk_fma_f32 %[c7], v[214:215], %[a], %[c7] op_sel_hi:[1,0,1]\n\t" \
                "v_pk_fma_f32 %[c0], v[216:217], %[b], %[c0] op_sel_hi:[1,0,1]\n\t" \
                "v_pk_fma_f32 %[c1], v[218:219], %[b], %[c1] op_sel_hi:[1,0,1]\n\t" \
                "v_pk_fma_f32 %[c2], v[220:221], %[b], %[c2] op_sel_hi:[1,0,1]\n\t" \
                "v_pk_fma_f32 %[c3], v[222:223], %[b], %[c3] op_sel_hi:[1,0,1]\n\t" \
                "v_pk_fma_f32 %[c4], v[224:225], %[b], %[c4] op_sel_hi:[1,0,1]\n\t" \
                "v_pk_fma_f32 %[c5], v[226:227], %[b], %[c5] op_sel_hi:[1,0,1]\n\t" \
                "v_pk_fma_f32 %[c6], v[228:229], %[b], %[c6] op_sel_hi:[1,0,1]\n\t" \
                "v_pk_fma_f32 %[c7], v[230:231], %[b], %[c7] op_sel_hi:[1,0,1]\n\t" \
                ""                                                   \
                : [c0] "+v"(acc2[0]), [c1] "+v"(acc2[1]), [c2] "+v"(acc2[2]), [c3] "+v"(acc2[3]), \
                  [c4] "+v"(acc2[4]), [c5] "+v"(acc2[5]), [c6] "+v"(acc2[6]), [c7] "+v"(acc2[7]) \
                : [ab] "v"(ab_), [a] "s"(a_), [b] "s"(b_)                                     \
                : "v200", "v201", "v202", "v203", "v204", "v205", "v206", "v207", "v208", "v209", "v210", "v211", "v212", "v213", "v214", "v215", "v216", "v217", "v218", "v219", "v220", "v221", "v222", "v223", "v224", "v225", "v226", "v227", "v228", "v229", "v230", "v231");                                                         \
        }                                                                                     \
    } while (0)
template <int CTRL>
__device__ __forceinline__ float comb_q(float A, float B, bool bit) {
    const float keep = bit ? B : A, send = bit ? A : B;
    return keep + dpp_qf<CTRL>(send);
}
__device__ __forceinline__ float comb_x(float A, float B, bool bit, int xr) {
    const float keep = bit ? B : A, send = bit ? A : B;
    return keep + __shfl_xor(send, xr);
}
__device__ __forceinline__ float reduce32(float (&pp)[32], int lane) {
    const bool b0 = lane & 1, b1 = lane & 2, b2 = lane & 4, b3 = lane & 8;
#pragma unroll
    for (int j = 0; j < 16; ++j) pp[j] = comb_q<0xB1>(pp[2 * j], pp[2 * j + 1], b0);
#pragma unroll
    for (int j = 0; j < 8; ++j) pp[j] = comb_q<0x4E>(pp[2 * j], pp[2 * j + 1], b1);
#pragma unroll
    for (int j = 0; j < 4; ++j) pp[j] = comb_x(pp[2 * j], pp[2 * j + 1], b2, 4);
#pragma unroll
    for (int j = 0; j < 2; ++j) pp[j] = comb_x(pp[2 * j], pp[2 * j + 1], b3, 8);
    auto sw = __builtin_amdgcn_permlane16_swap(__float_as_uint(pp[0]), __float_as_uint(pp[1]), false, false);
    return xhalf_sum(__uint_as_float(sw[0]) + __uint_as_float(sw[1]));
}
__device__ __forceinline__ void peer_experts_range(unsigned char* ws_, float* xout_, const float* ffn_g, int tbeg, int tend) {
    unsigned char* ws = opq(ws_);
    float* xout = opq(xout_);
    const int lane = tidx() & 63;
    const u16* hbuf = (const u16*)(ws + OFF_YAB);
    const float* ss1 = (const float*)(ws + OFF_SS1);
    const unsigned char* ub = ws + OFF_UB;
    const unsigned char* vb = ws + OFF_VB;
    const int* eidx = (const int*)(ws + OFF_EIDX);
    const float* gate = (const float*)(ws + OFF_GATE);
    const float* usc = (const float*)(ws + OFF_ESC);
    const float* vsc = usc + NEXP;
    int t = tbeg;
    int id0 = 0, id1 = 0;
    float gr0 = 0.f, gr1 = 0.f;
    uint4 h0 = uint4{0u, 0u, 0u, 0u}, h1 = h0;
    u32x3_t ua[4], ubq[4];
    if (t < tend) {
        id0 = eidx[(long)t * 128 + lane]; id1 = eidx[(long)t * 128 + 64 + lane];
        gr0 = gate[(long)t * 128 + lane]; gr1 = gate[(long)t * 128 + 64 + lane];
        h0 = *(const uint4*)(hbuf + (long)t * 1024 + lane * 16);
        h1 = *(const uint4*)(hbuf + (long)t * 1024 + lane * 16 + 8);
        PE_LD(ua, ub, 0);
    }
    while (t < tend) {
        const float g0 = gr0 * vsc[id0], g1 = gr1 * vsc[id1];
        const float s0 = usc[id0], s1 = usc[id1];
        float* xr = xout + (long)t * 1024 + lane * 16;
        const float rs1 = rsqrtf(sum16(ss1 + (long)t * 16) * (1.0f / 1024.0f) + EPS);
        f32x2_t hf2[8];
        hf2[0] = f32x2_t{bf_lo(h0.x), bf_hi(h0.x)}; hf2[1] = f32x2_t{bf_lo(h0.y), bf_hi(h0.y)};
        hf2[2] = f32x2_t{bf_lo(h0.z), bf_hi(h0.z)}; hf2[3] = f32x2_t{bf_lo(h0.w), bf_hi(h0.w)};
        hf2[4] = f32x2_t{bf_lo(h1.x), bf_hi(h1.x)}; hf2[5] = f32x2_t{bf_lo(h1.y), bf_hi(h1.y)};
        hf2[6] = f32x2_t{bf_lo(h1.z), bf_hi(h1.z)}; hf2[7] = f32x2_t{bf_lo(h1.w), bf_hi(h1.w)};
        const int tn = t + 1;
        int idn0 = 0, idn1 = 0;
        float gn0 = 0.f, gn1 = 0.f;
        if (tn < tend) {
            idn0 = eidx[(long)tn * 128 + lane]; idn1 = eidx[(long)tn * 128 + 64 + lane];
            gn0 = gate[(long)tn * 128 + lane]; gn1 = gate[(long)tn * 128 + 64 + lane];
        }
        float dq0 = 0.f, dq1 = 0.f, dq2 = 0.f, dq3 = 0.f;
        for (int gq = 0; gq < 4; ++gq) {
            const int e = 32 * gq;
            float pp[32];
#pragma unroll
            for (int q4 = 0; q4 < 32; q4 += 8) {
                PE_LD(ubq, ub, e + q4 + 4);
                PE_DOT(ua, q4);
                if (q4 + 8 < 32 || gq < 3) PE_LD(ua, ub, e + q4 + 8);
                else PE_LD(ua, vb, 0);
                PE_DOT(ubq, q4 + 4);
            }
            const float r = reduce32(pp, lane);
            dq0 = gq == 0 ? r : dq0;
            dq1 = gq == 1 ? r : dq1;
            dq2 = gq == 2 ? r : dq2;
            dq3 = gq == 3 ? r : dq3;
        }
        const float act0 = gelu_tanh((lane < 32 ? dq0 : dq1) * (s0 * rs1)) * g0;
        const float act1 = gelu_tanh((lane < 32 ? dq2 : dq3) * (s1 * rs1)) * g1;
        f32x2_t acc2[8];
#pragma unroll
        for (int i = 0; i < 8; ++i) acc2[i] = f32x2_t{0.f, 0.f};
        for (int b = 0; b < 32; b += 2) {
            PE_LD(ubq, vb, 4 * (b + 1));
            PE_AXPY(ua, 4 * b);
            if (b + 2 < 32) {
                PE_LD(ua, vb, 4 * (b + 2));
            } else if (tn < tend) {
                id0 = idn0; id1 = idn1;
                PE_LD(ua, ub, 0);
            }
            PE_AXPY(ubq, 4 * (b + 1));
        }
        float ss = 0.f;
        u32 pk[8];
#pragma unroll
        for (int i = 0; i < 4; ++i) {
            float4 a = *(const float4*)(xr + 4 * i);
            a.x += acc2[2 * i][0]; a.y += acc2[2 * i][1]; a.z += acc2[2 * i + 1][0]; a.w += acc2[2 * i + 1][1];
            *(float4*)(xr + 4 * i) = a;
            ss += a.x * a.x + a.y * a.y + a.z * a.z + a.w * a.w;
            pk[2 * i] = pack2(a.x, a.y);
            pk[2 * i + 1] = pack2(a.z, a.w);
        }
        u16* hw = (u16*)(ws + OFF_YAB) + (long)t * 1024 + lane * 16;
        *(uint4*)hw = uint4{pk[0], pk[1], pk[2], pk[3]};
        *(uint4*)(hw + 8) = uint4{pk[4], pk[5], pk[6], pk[7]};
        ss = wsum(ss);
        if (lane == 0) ((float*)(ws + OFF_RSTDE))[t] = rsqrtf(ss * (1.0f / 1024.0f) + EPS);
        t = tn; id0 = idn0; id1 = idn1; gr0 = gn0; gr1 = gn1;
        if (t < tend) {
            h0 = *(const uint4*)(hbuf + (long)t * 1024 + lane * 16);
            h1 = *(const uint4*)(hbuf + (long)t * 1024 + lane * 16 + 8);
        }
    }
}

__device__ __forceinline__ u32 search_bounds(u32 lanemax, int& hb) {
    const u32 U = row_max16u(lanemax), L = row_min16u(lanemax);
    const u32 d = U ^ L;
    hb = d ? 31 - __clz((int)d) : -1;
    return d ? (U & ~((2u << hb) - 1u)) : U;
}
__device__ __forceinline__ void peer_route(unsigned char* ws, float* xout, const float* ffn_g, int layer, unsigned char* smem, unsigned long long& tacc) {
    const int tid = tidx(), lane = tid & 63, w = tid >> 6;
    const int grp = lane >> 4, k = lane & 15;
    const u32 ltk = (1u << k) - 1u;
    float* tvc = (float*)(smem + w * 4096);
    int* tic = (int*)(smem + w * 4096 + 2048);
    unsigned* rctr = (unsigned*)(ws + OFF_CTR) + (layer * 8 + 3) * 8;
    for (int unit; (unit = grab_wave(rctr, NTOK / 16)) >= 0;) {
        const int tok0 = unit * 16;
        unsigned char* wsu = opq(ws);
        const u16* pq = (const u16*)(wsu + OFF_PQ);
        const u16* skb = (const u16*)(wsu + OFF_W + layer * W_LAYER + WO_SK);
        int* eidx = (int*)(wsu + OFF_EIDX);
        float* gate = (float*)(wsu + OFF_GATE);
        for (int h = 0; h < 8; ++h) {
            for (int half = 0; half < 2; ++half) {
                unsigned long long tr0 = SEC_T();
                bf16x8 af[4];
#pragma unroll
                for (int ks = 0; ks < 4; ++ks)
                    af[ks] = *(const bf16x8*)(pq + (long)(tok0 + k) * 2048 + h * 256 + half * 128 + ks * 32 + grp * 8);
                float sc[8][4];
                u32 u[8][4];
#pragma unroll
                for (int nt = 0; nt < 8; ++nt) {
                    f32x4 acc = f32x4{0.f, 0.f, 0.f, 0.f};
#pragma unroll
                    for (int ks = 0; ks < 4; ++ks) {
                        bf16x8 bfr = *(const bf16x8*)(skb + (size_t)half * 128 * 128 + (size_t)(nt * 16 + k) * 128 + ks * 32 + grp * 8);
                        acc = __builtin_amdgcn_mfma_f32_16x16x32_bf16(af[ks], bfr, acc, 0, 0, 0);
                    }
#pragma unroll
                    for (int i = 0; i < 4; ++i) { sc[nt][i] = acc[i]; u[nt][i] = sortkey(acc[i]); }
                }
                SEC_ADD(11, tr0);
                tr0 = SEC_T();
                u32 K[4];
                bool dn[4] = {false, false, false, false};
                int hbm = -1;
#pragma unroll
                for (int i = 0; i < 4; ++i) {
                    u32 lm = u[0][i];
#pragma unroll
                    for (int nt = 1; nt < 8; ++nt) lm = max(lm, u[nt][i]);
                    int hb;
                    K[i] = search_bounds(lm, hb);
                    hbm = max(hbm, hb);
                }
                const int bit0 = (int)wmax((float)hbm);
                for (int bit = bit0; bit >= 0; --bit) {
                    int packed = 0;
#pragma unroll
                    for (int i = 0; i < 4; ++i) {
                        const u32 cand = K[i] | (1u << bit);
                        int c = 0;
#pragma unroll
                        for (int nt = 0; nt < 8; ++nt) c += (u[nt][i] >= cand) ? 1 : 0;
                        packed |= c << (8 * i);
                    }
                    packed = row_sum16i(packed);
#pragma unroll
                    for (int i = 0; i < 4; ++i)
                        if (((packed >> (8 * i)) & 0xFF) >= 16) K[i] |= (1u << bit);
                    bool done = true;
#pragma unroll
                    for (int i = 0; i < 4; ++i) {
                        const int ci = (packed >> (8 * i)) & 0xFF;
                        done = done && (ci == 16 || dn[i]);
                        dn[i] = dn[i] || (ci == 16);
                    }
                    if (__all(done)) break;
                }
                SEC_ADD(12, tr0);
                tr0 = SEC_T();
                int need[4];
                {
                    int packed = 0;
#pragma unroll
                    for (int i = 0; i < 4; ++i) {
                        int c = 0;
#pragma unroll
                        for (int nt = 0; nt < 8; ++nt) c += (u[nt][i] > K[i]) ? 1 : 0;
                        packed |= c << (8 * i);
                    }
                    packed = row_sum16i(packed);
#pragma unroll
                    for (int i = 0; i < 4; ++i) need[i] = 16 - ((packed >> (8 * i)) & 0xFF);
                }
#pragma unroll
                for (int i = 0; i < 4; ++i) {
                    int ebase = 0, pbase = 0;
                    const int tok = 4 * grp + i;
#pragma unroll
                    for (int nt = 0; nt < 8; ++nt) {
                        const bool eq = (u[nt][i] == K[i]);
                        const u32 emg = (u32)(__ballot(eq) >> (lane & 48)) & 0xFFFFu;
                        const int erank = ebase + __popc(emg & ltk);
                        const bool take = (u[nt][i] > K[i]) || (eq && erank < need[i]);
                        ebase += __popc(emg);
                        const u32 tmg = (u32)(__ballot(take) >> (lane & 48)) & 0xFFFFu;
                        const int pos = pbase + __popc(tmg & ltk);
                        if (take) {
                            tvc[(half * 16 + tok) * 16 + pos] = sc[nt][i];
                            tic[(half * 16 + tok) * 16 + pos] = nt * 16 + k;
                        }
                        pbase += __popc(tmg);
                    }
                }
                SEC_ADD(13, tr0);
            }
            WAVE_SYNC();
            unsigned long long tr2 = SEC_T();
            for (int pass = 0; pass < 4; ++pass) {
                const int tok = 4 * pass + grp;
                const float v1 = tvc[(0 * 16 + tok) * 16 + k];
                const int i1 = tic[(0 * 16 + tok) * 16 + k];
                float c[16];
                u32 uc[16];
#pragma unroll
                for (int r4 = 0; r4 < 4; ++r4) {
                    float4 v2 = *(const float4*)(tvc + (1 * 16 + tok) * 16 + r4 * 4);
                    c[r4 * 4 + 0] = v1 + v2.x;
                    c[r4 * 4 + 1] = v1 + v2.y;
                    c[r4 * 4 + 2] = v1 + v2.z;
                    c[r4 * 4 + 3] = v1 + v2.w;
                }
                float mxl = c[0];
#pragma unroll
                for (int r = 0; r < 16; ++r) { uc[r] = sortkey(c[r]); mxl = fmaxf(mxl, c[r]); }
                const float mx = row_max16f(mxl);
                int hbc;
                u32 Kc = search_bounds(sortkey(mxl), hbc);
                bool dnc = false;
                const int bitc0 = (int)wmax((float)hbc);
                for (int bit = bitc0; bit >= 0; --bit) {
                    const u32 cand = Kc | (1u << bit);
                    int cn = 0;
#pragma unroll
                    for (int r = 0; r < 16; ++r) cn += (uc[r] >= cand) ? 1 : 0;
                    cn = row_sum16i(cn);
                    if (cn >= 16) Kc = cand;
                    dnc = dnc || (cn == 16);
                    if (__all(dnc)) break;
                }
                int cgl = 0, cel = 0;
#pragma unroll
                for (int r = 0; r < 16; ++r) { cgl += (uc[r] > Kc) ? 1 : 0; cel += (uc[r] == Kc) ? 1 : 0; }
                const int needc = 16 - row_sum16i(cgl);
                const int ebefore = row_xscan16i(cel);
                int tl_ = 0, el_ = 0;
                u32 takem = 0u;
                float ex[16];
                float sl = 0.f;
#pragma unroll
                for (int r = 0; r < 16; ++r) {
                    const bool eq = (uc[r] == Kc);
                    const bool tk = (uc[r] > Kc) || (eq && (ebefore + el_) < needc);
                    el_ += eq ? 1 : 0;
                    tl_ += tk ? 1 : 0;
                    takem |= tk ? (1u << r) : 0u;
                    ex[r] = tk ? __expf(c[r] - mx) : 0.f;
                    sl += ex[r];
                }
                const float inv = 1.0f / row_sum16f(sl);
                int pos = row_xscan16i(tl_);
                const long obase = (long)(tok0 + tok) * 128 + h * 16;
                int i2v[16];
#pragma unroll
                for (int r4 = 0; r4 < 4; ++r4) {
                    const int4 q = *(const int4*)(tic + (1 * 16 + tok) * 16 + r4 * 4);
                    i2v[r4 * 4 + 0] = q.x; i2v[r4 * 4 + 1] = q.y; i2v[r4 * 4 + 2] = q.z; i2v[r4 * 4 + 3] = q.w;
                }
#pragma unroll
                for (int r = 0; r < 16; ++r) {
                    if ((takem >> r) & 1u) {
                        const int eid = i1 * 128 + i2v[r];
                        eidx[obase + pos] = eid;
                        gate[obase + pos] = ex[r] * inv;
                        ++pos;
                    }
                }
            }
            SEC_ADD(14, tr2);
            WAVE_SYNC();
        }
        asm volatile("s_waitcnt vmcnt(0)" ::: "memory");
        peer_experts_range(ws, xout, ffn_g, tok0, tok0 + 16);
    }
}

__device__ __forceinline__ void phase_prep(const Params& P, unsigned char* smem) {
    unsigned char* ws = opq(P.ws);
    const long gtid = (long)bidx() * 256 + tidx();
    const long gthreads = (long)gdim() * 256;
    for (int l = 0; l < 2; ++l) {
        unsigned char* wl = ws + OFF_W + l * W_LAYER;
        float* tile = (float*)smem;
        transpose_cvt<true>(P.w_in + (size_t)l * 1024 * IN_COLS, (u16*)(wl + WO_WIN), 1024, IN_COLS, tile, P.attn_norm + l * 1024);
        for (int c = 0; c < 2; ++c) {
            transpose_cvt(P.cmp_w1 + ((size_t)l * 2 + c) * 2048 * 256, (u16*)(wl + WO_W1) + (size_t)c * 256 * 2048, 2048, 256, tile);
            transpose_cvt(P.cmp_w2 + ((size_t)l * 2 + c) * 256 * 64, (u16*)(wl + WO_W2) + (size_t)c * 64 * 256, 256, 64, tile);
        }
        transpose_cvt(P.w_a + (size_t)l * 512 * 1024, (u16*)(wl + WO_WA), 512, 1024, tile);
        transpose_cvt(P.w_b + (size_t)l * 512 * 1024, (u16*)(wl + WO_WB), 512, 1024, tile);
        transpose_cvt(P.w_out + (size_t)l * 1024 * 1024, (u16*)(wl + WO_WO), 1024, 1024, tile);
        transpose_cvt(P.peer_wq + (size_t)l * 1024 * 2048, (u16*)(wl + WO_WQ), 1024, 2048, tile, P.ffn_norm + l * 1024);
        transpose_cvt(P.ple_w + (size_t)l * 256 * 1024, (u16*)(wl + WO_PW), 256, 1024, tile);
        transpose_cvt(P.ple_gw + (size_t)l * 1024 * 1024, (u16*)(wl + WO_PG), 1024, 1024, tile);
        cvt_f32_bf16(P.peer_sk + (size_t)l * 2 * 128 * 128, (u16*)(wl + WO_SK), 2 * 128 * 128);
    }
    for (int u = bidx(); u < 64; u += gdim()) {
        const int l = u >> 5, c = (u >> 4) & 1, kq = u & 15, col = tidx();
        const float* pos = P.cmp_pos + ((size_t)l * 2 + c) * 2048 + kq * 128;
        const float* w1 = P.cmp_w1 + ((size_t)l * 2 + c) * 2048 * 256 + (size_t)kq * 128 * 256;
        float s = 0.f;
#pragma unroll 16
        for (int k = 0; k < 128; ++k) s += pos[k] * w1[(size_t)k * 256 + col];
        ((float*)(ws + OFF_CHID))[(size_t)u * 256 + col] = s;
    }
    {
        float* ropec = (float*)(ws + OFF_ROPE);
        float* ropes = ropec + (size_t)NTOK * 8;
        for (long i = gtid; i < (long)NTOK * 8; i += gthreads) {
            int t = (int)(i >> 3), k = (int)(i & 7);
            double inv = pow(500000.0, -(double)k / 8.0);
            double ang = (double)P.positions[t] * inv;
            ropec[i] = (float)cos(ang);
            ropes[i] = (float)sin(ang);
        }
    }
    {
        const int lane = tidx() & 63;
        u16* xb = (u16*)(ws + OFF_H);
        float* ssa = (float*)(ws + OFF_SSA);
        for (int row = bidx() * 4 + (tidx() >> 6); row < NTOK; row += gdim() * 4) {
            const float* xr = P.x + (long)row * 1024;
            float ss = 0.f;
#pragma unroll
            for (int i = 0; i < 4; ++i) {
                const float4 v = *(const float4*)(xr + i * 256 + lane * 4);
                ss += v.x * v.x + v.y * v.y + v.z * v.z + v.w * v.w;
                *(uint2*)(xb + (long)row * 1024 + i * 256 + lane * 4) = uint2{pack2(v.x, v.y), pack2(v.z, v.w)};
            }
            ss = wsum(ss);
            if (lane < 16) ssa[(long)row * 16 + lane] = lane == 0 ? ss : 0.f;
        }
    }
}

__device__ __forceinline__ void phase_g1(const Params& P, int layer, unsigned char* smem) {
    unsigned char* ws = opq(P.ws);
    u16* proj = (u16*)(ws + OFF_PROJ);
    const float* ropec = (const float*)(ws + OFF_ROPE);
    const float* ropes = ropec + (size_t)NTOK * 8;
    const float* ng = P.nsa_gain + layer * 256;
    const float* dg = P.dsa_gain + layer * 128;
    if (layer == 0 && bidx() < 4) {
        const int l = bidx() >> 1, c = bidx() & 1, col = tidx();
        const float* part = (const float*)(ws + OFF_CHID) + (size_t)(l * 32 + c * 16) * 256 + col;
        float sacc = 0.f;
#pragma unroll
        for (int kq = 0; kq < 16; ++kq) sacc += part[kq * 256];
        ((float*)(ws + OFF_W + l * W_LAYER + WO_CB))[c * 256 + col] = sacc;
    }
    const float* ssa = (const float*)(ws + OFF_SSA) + (size_t)layer * NTOK * 16;
    gemm_phase_rs<0, true>((const u16*)(ws + OFF_H), 1024, (const u16*)(ws + OFF_W + layer * W_LAYER + WO_WIN), 1024, NTOK, IN_COLS, 1024, smem,
                  [=](int row) { return float2{rsqrtf(sum16(ssa + (long)row * 16) * (1.0f / 1024.0f) + EPS), 0.f}; },
                  [=](int row, int col, const float (&v)[8], float2 rs) {
                      const int c64 = __builtin_amdgcn_readfirstlane(col >> 6), cc = (col >> 3) & 7;
                      const float rsx = rs.x;
                      float o[8];
#pragma unroll
                      for (int j = 0; j < 8; ++j) o[j] = v[j] * rsx;
                      const float* gain = nullptr;
                      bool rope = false, sig = false;
                      float scale = 1.0f;
                      if (c64 < 8) { gain = ng; rope = true; scale = 0.125f * 1.4426950408889634f; }
                      else if (c64 < 20) { const int c = (c64 - 8) >> 1; if (c == 2) { gain = ng + 128; rope = true; } else if (c == 4) { gain = ng + 192; rope = true; } }
                      else if (c64 < 28) { gain = dg; rope = true; scale = 0.125f * 1.4426950408889634f; }
                      else if (c64 == 28) { gain = dg + 64; rope = true; }
                      else if (c64 == 29) { }
                      else if (c64 < 38) { rope = true; scale = 0.125f; }
                      else if (c64 == 38) { rope = true; }
                      else if (c64 < 71) { sig = true; }
                      else { sig = (col < C_IW); }
                      if (gain) {
                          float ss = 0.f;
#pragma unroll
                          for (int j = 0; j < 8; ++j) ss += o[j] * o[j];
                          ss += dpp_qf<0xB1>(ss);
                          ss += dpp_qf<0x4E>(ss);
                          ss += __shfl_xor(ss, 4);
                          const float rstd = rsqrtf(ss * (1.0f / 64.0f) + EPS);
                          const float4 g0 = *(const float4*)(gain + cc * 8), g1 = *(const float4*)(gain + cc * 8 + 4);
                          o[0] *= rstd * g0.x; o[1] *= rstd * g0.y; o[2] *= rstd * g0.z; o[3] *= rstd * g0.w;
                          o[4] *= rstd * g1.x; o[5] *= rstd * g1.y; o[6] *= rstd * g1.z; o[7] *= rstd * g1.w;
                      }
                      if (rope) {
                          float pr[8];
#pragma unroll
                          for (int j = 0; j < 8; ++j) pr[j] = dpp_qf<0xB1>(o[j]);
                          if (cc < 2) {
                              const float4 c0 = *(const float4*)(ropec + (long)row * 8), c1 = *(const float4*)(ropec + (long)row * 8 + 4);
                              const float4 s0 = *(const float4*)(ropes + (long)row * 8), s1 = *(const float4*)(ropes + (long)row * 8 + 4);
                              const float cs[8] = {c0.x, c0.y, c0.z, c0.w, c1.x, c1.y, c1.z, c1.w};
                              const float sn[8] = {s0.x, s0.y, s0.z, s0.w, s1.x, s1.y, s1.z, s1.w};
#pragma unroll
                              for (int j = 0; j < 8; ++j) o[j] = (cc == 0) ? (o[j] * cs[j] - pr[j] * sn[j]) : (o[j] * cs[j] + pr[j] * sn[j]);
                          }
                      }
                      if (sig) {
#pragma unroll
                          for (int j = 0; j < 8; ++j) o[j] = sigmoidf(o[j]);
                      }
#pragma unroll
                      for (int j = 0; j < 8; ++j) o[j] *= scale;
                      st_bf8(proj + (long)row * IN_COLS + col, o);
                  });
}

__device__ __forceinline__ void phase_c1(const Params& P, int layer, unsigned char* smem) {
    unsigned char* ws = opq(P.ws);
    unsigned char* wl = ws + OFF_W + layer * W_LAYER;
    const u16* proj = (const u16*)(ws + OFF_PROJ);
    u16* chid = (u16*)(ws + OFF_CHID);
    const float* cbias = (const float*)(wl + WO_CB);
    for (int c = 0; c < 2; ++c) {
        u16* ch = chid + (size_t)c * CROWS * 256;
        const float* cb = cbias + c * 256;
        gemm_phase<1>(proj + C_NKV + c * 128, 0, (const u16*)(wl + WO_W1) + (size_t)c * 256 * 2048, 2048, CROWS, 256, 2048, smem,
                      [=](int row, int col, const float (&v)[8]) {
                          float o[8];
#pragma unroll
                          for (int j = 0; j < 8; ++j) o[j] = gelu_tanh(v[j] + cb[col + j]);
                          st_bf8(ch + (long)row * 256 + col, o);
                      });
    }
}

__device__ __forceinline__ void phase_c2(const Params& P, int layer, unsigned char* smem) {
    unsigned char* ws = opq(P.ws);
    unsigned char* wl = ws + OFF_W + layer * W_LAYER;
    const u16* chid = (const u16*)(ws + OFF_CHID);
    u16* kcb = (u16*)(ws + OFF_KCB);
    u16* vcb = (u16*)(ws + OFF_VCB);
    const float* ropec = (const float*)(ws + OFF_ROPE);
    const float* ropes = ropec + (size_t)NTOK * 8;
    const float* gain = P.nsa_gain + layer * 256 + 64;
    for (int c = 0; c < 2; ++c) {
        u16* dst = c == 0 ? kcb : vcb;
        gemm_phase<0>(chid + (size_t)c * CROWS * 256, 256, (const u16*)(wl + WO_W2) + (size_t)c * 64 * 256, 256, CROWS, 64, 256, smem,
                      [=](int row, int col, const float (&v)[8]) {
                          const int b = row / (NCMP * 2);
                          const int rem = row - b * (NCMP * 2);
                          const int n = rem >> 1, g = rem & 1;
                          const int cc = col >> 3;
                          float o[8];
#pragma unroll
                          for (int j = 0; j < 8; ++j) o[j] = v[j];
                          if (c == 0) {
                              float ss = 0.f;
#pragma unroll
                              for (int j = 0; j < 8; ++j) ss += o[j] * o[j];
                              ss += dpp_qf<0xB1>(ss);
                              ss += dpp_qf<0x4E>(ss);
                              ss += __shfl_xor(ss, 4);
                              const float rstd = rsqrtf(ss * (1.0f / 64.0f) + EPS);
#pragma unroll
                              for (int j = 0; j < 8; ++j) o[j] *= rstd * gain[cc * 8 + j];
                              float pr[8];
#pragma unroll
                              for (int j = 0; j < 8; ++j) pr[j] = dpp_qf<0xB1>(o[j]);
                              if (cc < 2) {
                                  const long tt = (long)b * SEQ + 31 + 16 * n;
#pragma unroll
                                  for (int j = 0; j < 8; ++j) {
                                      const float cs = ropec[tt * 8 + j], sn = ropes[tt * 8 + j];
                                      o[j] = (cc == 0) ? (o[j] * cs - pr[j] * sn) : (o[j] * cs + pr[j] * sn);
                                  }
                              }
                          }
                          st_bf8(dst + ((size_t)(b * 2 + g) * 256 + n) * 64 + col, o);
                      });
    }
}

__device__ __forceinline__ int balance4(int x, int seg) {
    const int k = x / seg, r = x - k * seg;
    return k == 0 ? r : (k == 1 ? 4 * seg - 1 - r : (k == 2 ? seg + r : 3 * seg - 1 - r));
}
__device__ __forceinline__ void phase_att_a(const Params& P, int layer, unsigned char* smem, unsigned long long& tacc) {
    unsigned char* ws = opq(P.ws);
    unsigned* ctr = (unsigned*)(ws + OFF_CTR) + (layer * 8 + 0) * 8;
    const int label = bidx() & 7;
    for (int s8 = 0; s8 < 8; ++s8) {
        const int q = (label + s8) & 7;
        int idx;
        while ((idx = grab_block(ctr + q, 1024, smem)) >= 0) dsa_select_unit(ws, q * 1024 + (1023 - idx), smem, tacc);
    }
}
__device__ __forceinline__ void phase_att_b(const Params& P, int layer, unsigned char* smem) {
    const int label = bidx() & 7;
    {
        unsigned char* ws = opq(P.ws);
        unsigned* ctr = (unsigned*)(ws + OFF_CTR) + (layer * 8 + 1) * 8;
        for (int s8 = 0; s8 < 8; ++s8) {
            const int q = (label + s8) & 7;
            int idx;
            while ((idx = grab_block(ctr + q, 256, smem)) >= 0) dsa_attn_unit(ws, q, 255 - idx, smem);
        }
    }
    {
        unsigned char* ws = opq(P.ws);
        unsigned* ctr = (unsigned*)(ws + OFF_CTR) + (layer * 8 + 2) * 8;
        for (int s8 = 0; s8 < 8; ++s8) {
            const int q = (label + s8) & 7;
            int idx;
            while ((idx = grab_block(ctr + q, 256, smem)) >= 0) {
                const int ub = q + 8 * (idx & 1);
                nsa_unit(ws, ub >> 1, ub & 1, 127 - (idx >> 1), smem);
            }
        }
    }
}

__device__ __forceinline__ void phase_merge(const Params& P, int layer, unsigned char* smem) {
    unsigned char* ws = opq(P.ws);
    unsigned char* wl = ws + OFF_W + layer * W_LAYER;
    const u16* proj = (const u16*)(ws + OFF_PROJ);
    u16* hbuf = (u16*)(ws + OFF_H);
    const u16* ya = (const u16*)(ws + OFF_YAB);
    const u16* yb = ya + (size_t)NTOK * 512;
    gemm_phase<0>(ya, 512, (const u16*)(wl + WO_WA), 512, NTOK, 1024, 512, smem, [=](int row, int col, const float (&v)[8]) {
        float ga[8], o[8];
        ld_bf8(proj + (long)row * IN_COLS + C_MG + col, ga);
#pragma unroll
        for (int j = 0; j < 8; ++j) o[j] = ga[j] * v[j];
        st_bf8(hbuf + (long)row * 1024 + col, o);
    });
    gemm_phase<0>(yb, 512, (const u16*)(wl + WO_WB), 512, NTOK, 1024, 512, smem, [=](int row, int col, const float (&v)[8]) {
        float gb[8], o[8];
        ld_bf8(proj + (long)row * IN_COLS + C_MG + 1024 + col, gb);
        ld_bf8(hbuf + (long)row * 1024 + col, o);
#pragma unroll
        for (int j = 0; j < 8; ++j) o[j] += gb[j] * v[j];
        st_bf8(hbuf + (long)row * 1024 + col, o);
    });
}

__device__ __forceinline__ void phase_outproj(const Params& P, int layer, unsigned char* smem) {
    unsigned char* ws = opq(P.ws);
    unsigned char* wl = ws + OFF_W + layer * W_LAYER;
    float* out = opq(P.out);
    const float* xin = (layer == 0) ? P.x : (const float*)out;
    const bool gemm_first = bidx() < (gdim() >> 1);
    for (int step = 0; step < 2; ++step) {
        if ((step == 0) == gemm_first) {
            u16* xb1 = (u16*)(ws + OFF_YAB);
            float* ss1 = (float*)(ws + OFF_SS1);
            gemm_phase<0>((const u16*)(ws + OFF_H), 1024, (const u16*)(wl + WO_WO), 1024, NTOK, 1024, 1024, smem, [=](int row, int col, const float (&v)[8]) {
                const long o = (long)row * 1024 + col;
                const float4 x0 = *(const float4*)(xin + o), x1 = *(const float4*)(xin + o + 4);
                const float y[8] = {x0.x + v[0], x0.y + v[1], x0.z + v[2], x0.w + v[3], x1.x + v[4], x1.y + v[5], x1.z + v[6], x1.w + v[7]};
                *(float4*)(out + o) = float4{y[0], y[1], y[2], y[3]};
                *(float4*)(out + o + 4) = float4{y[4], y[5], y[6], y[7]};
                st_bf8(xb1 + o, y);
                float ss = 0.f;
#pragma unroll
                for (int j = 0; j < 8; ++j) ss += y[j] * y[j];
                ss += dpp_qf<0xB1>(ss);
                ss += dpp_qf<0x4E>(ss);
                ss += __shfl_xor(ss, 4);
                if ((col & 63) == 0) ss1[(long)row * 16 + (col >> 6)] = ss;
            });
        } else {
            cvt_f32_bf16(P.p + (size_t)layer * NTOK * 256, (u16*)(ws + OFF_PBF), (long)NTOK * 256);
            cvt_rows_fp6(P.peer_u + (size_t)layer * NEXP * 1024, ws + OFF_UB, (float*)(ws + OFF_ESC), NEXP, P.ffn_norm + layer * 1024);
            cvt_rows_fp6(P.peer_v + (size_t)layer * NEXP * 1024, ws + OFF_VB, (float*)(ws + OFF_ESC) + NEXP, NEXP);
        }
    }
}

__device__ __forceinline__ void phase_pq(const Params& P, int layer, unsigned char* smem) {
    unsigned char* ws = opq(P.ws);
    unsigned char* wl = ws + OFF_W + layer * W_LAYER;
    u16* pq = (u16*)(ws + OFF_PQ);
    u16* eb = (u16*)(ws + OFF_H);
    const float* ss1 = (const float*)(ws + OFF_SS1);
    gemm_phase_rs<0, true>((const u16*)(ws + OFF_YAB), 1024, (const u16*)(wl + WO_WQ), 1024, NTOK, 2048, 1024, smem,
                  [=](int row) { return float2{rsqrtf(sum16(ss1 + (long)row * 16) * (1.0f / 1024.0f) + EPS), 0.f}; },
                  [=](int row, int col, const float (&v)[8], float2 rs) {
                      float o[8];
#pragma unroll
                      for (int j = 0; j < 8; ++j) o[j] = v[j] * rs.x;
                      st_bf8(pq + (long)row * 2048 + col, o);
                  });
    float* sse = (float*)(ws + OFF_SSE) + (size_t)layer * NTOK * 16;
    gemm_phase<0>((const u16*)(ws + OFF_PBF), 256, (const u16*)(wl + WO_PW), 256, NTOK, 1024, 256, smem,
                  [=](int row, int col, const float (&v)[8]) {
                      st_bf8(eb + (long)row * 1024 + col, v);
                      float ss = 0.f;
#pragma unroll
                      for (int j = 0; j < 8; ++j) ss += v[j] * v[j];
                      ss += dpp_qf<0xB1>(ss);
                      ss += dpp_qf<0x4E>(ss);
                      ss += __shfl_xor(ss, 4);
                      if ((col & 63) == 0) sse[(long)row * 16 + (col >> 6)] = ss;
                  });
}

__device__ __forceinline__ void phase_final(const Params& P, int layer, unsigned char* smem) {
    unsigned char* ws = opq(P.ws);
    unsigned char* wl = ws + OFF_W + layer * W_LAYER;
    float* out = opq(P.out);
    u16* eb = (u16*)(ws + OFF_H);
    const float* rstd2 = (const float*)(ws + OFF_RSTDE);
    const float* sse = (const float*)(ws + OFF_SSE) + (size_t)layer * NTOK * 16;
    float* ssn = (float*)(ws + OFF_SSA) + (size_t)NTOK * 16;
    const float* pn = P.ple_norm + layer * 1024;
    const bool more = layer == 0;
    gemm_phase_rs<0, true>((const u16*)(ws + OFF_YAB), 1024, (const u16*)(wl + WO_PG), 1024, NTOK, 1024, 1024, smem,
        [=](int row) { return float2{rstd2[row], rsqrtf(sum16(sse + (long)row * 16) * (1.0f / 1024.0f) + EPS)}; },
        [=](int row, int col, const float (&v)[8], float2 rs) {
        const long o = (long)row * 1024 + col;
        float e[8];
        ld_bf8(eb + o, e);
        const float rx = rs.x;
        const float re = rs.y;
        const float4 x0 = *(const float4*)(out + o), x1 = *(const float4*)(out + o + 4);
        const float4 p0 = *(const float4*)(pn + col), p1 = *(const float4*)(pn + col + 4);
        const float xs[8] = {x0.x, x0.y, x0.z, x0.w, x1.x, x1.y, x1.z, x1.w};
        const float ps[8] = {p0.x, p0.y, p0.z, p0.w, p1.x, p1.y, p1.z, p1.w};
        float y[8];
        float ss = 0.f;
#pragma unroll
        for (int j = 0; j < 8; ++j) {
            y[j] = xs[j] + sigmoidf(v[j] * rx) * (e[j] * re * ps[j]);
            ss += y[j] * y[j];
        }
        *(float4*)(out + o) = float4{y[0], y[1], y[2], y[3]};
        *(float4*)(out + o + 4) = float4{y[4], y[5], y[6], y[7]};
        if (more) {
            st_bf8(eb + o, y);
            ss += dpp_qf<0xB1>(ss);
            ss += dpp_qf<0x4E>(ss);
            ss += __shfl_xor(ss, 4);
            if ((col & 63) == 0) ssn[(long)row * 16 + (col >> 6)] = ss;
        }
    });
}


#define XB_TMO      128
#define XB_XCNT(j)  (256  + 64 * (j))
#define XB_XSUB(j)  (1280 + 64 * (j))
#define XB_XGEN(j)  (2304 + 64 * (j))
#define XB_TOP      3328
#define XB_TOPGEN   3392
#define XCD_BAR_WORDS 3456
#define XB_SPIN_CAP (1u << 22)
#define LAS __attribute__((address_space(3)))
__device__ __forceinline__ unsigned xb_ld(unsigned* p) { return __hip_atomic_load(p, __ATOMIC_RELAXED, __HIP_MEMORY_SCOPE_AGENT); }
__device__ __forceinline__ unsigned xb_add(unsigned* p, unsigned v) { return __hip_atomic_fetch_add(p, v, __ATOMIC_RELAXED, __HIP_MEMORY_SCOPE_AGENT); }
__device__ __forceinline__ unsigned xb_xcc_id() { return (unsigned)__builtin_amdgcn_s_getreg((3 << 11) | 20) & 0xFu; }
#define XB_SPIN(cond, bar) do { unsigned _sp = 0; while (cond) { __builtin_amdgcn_s_sleep(1); \
    if ((++_sp & 255u) == 0u) { if (xb_ld(&(bar)[XB_TMO])) break; if (_sp > XB_SPIN_CAP) { atomicAdd(&(bar)[XB_TMO], 1u); break; } } } } while (0)
struct XcdBarrier {
    unsigned* bar; unsigned x;
    volatile LAS unsigned* st;
};
__device__ __forceinline__ XcdBarrier xcd_barrier_post(unsigned* bar, volatile LAS unsigned* st) {
    XcdBarrier b; b.bar = bar; b.x = xb_xcc_id(); b.st = st;
    if (threadIdx.x == 0) (void)xb_add(&bar[XB_XCNT(b.x)], 1u);
    return b;
}
__device__ __forceinline__ void xcd_barrier_complete(unsigned* bar, unsigned x, unsigned& nloc, unsigned& nx) {
    const unsigned G = gridDim.x * gridDim.y * gridDim.z;
    unsigned sum, cnt, mine, sp = 0u;
    for (;;) {
        sum = 0u; cnt = 0u; mine = 0u;
#pragma unroll
        for (unsigned j = 0; j < 16; ++j) { const unsigned c = xb_ld(&bar[XB_XCNT(j)]); sum += c; cnt += (c > 0u) ? 1u : 0u; mine = (j == x) ? c : mine; }
        if (sum == G) break;
        __builtin_amdgcn_s_sleep(1);
        if ((++sp & 255u) == 0u) { if (xb_ld(&bar[XB_TMO])) break; if (sp > XB_SPIN_CAP) { atomicAdd(&bar[XB_TMO], 1u); break; } }
    }
    nloc = mine > 0u ? mine : 1u; nx = cnt > 0u ? cnt : 1u;
}
__device__ __forceinline__ void xcd_barrier(const XcdBarrier& b) {
    asm volatile("s_waitcnt vmcnt(0)" ::: "memory");
    __syncthreads();
    if (threadIdx.x == 0) {
        unsigned* bar = b.bar;
        __builtin_amdgcn_s_waitcnt(0);
        unsigned nloc = b.st[0], nx = b.st[1];
        if (nloc == 0u) { xcd_barrier_complete(bar, b.x, nloc, nx); b.st[0] = nloc; b.st[1] = nx; }
        const unsigned old = xb_add(&bar[XB_XSUB(b.x)], 1u);
        const unsigned gen = old / nloc;
        if (old + 1u == (gen + 1u) * nloc) {
            __builtin_amdgcn_fence(__ATOMIC_RELEASE, "agent");
            asm volatile("s_waitcnt vmcnt(0)" ::: "memory");
            const unsigned og = xb_add(&bar[XB_TOP], 1u);
            const unsigned tg = og / nx;
            if (og + 1u == (tg + 1u) * nx) xb_add(&bar[XB_TOPGEN], 1u);
            else XB_SPIN(xb_ld(&bar[XB_TOPGEN]) == tg, bar);
            __builtin_amdgcn_fence(__ATOMIC_ACQUIRE, "agent");
            xb_add(&bar[XB_XGEN(b.x)], 1u);
            asm volatile("s_waitcnt vmcnt(0)" ::: "memory");
        } else {
            XB_SPIN(xb_ld(&bar[XB_XGEN(b.x)]) == gen, bar);
            __builtin_amdgcn_fence(__ATOMIC_ACQUIRE, "agent");
            asm volatile("s_waitcnt vmcnt(0)" ::: "memory");
        }
    }
    __syncthreads();
}

#ifndef PROBE_MASK
#define PROBE_MASK 0ull
#endif
#ifndef PROBE_MULT
#define PROBE_MULT 4
#endif
#define GSYNC(id)                                                                          \
    do {                                                                                   \
        xcd_barrier(xb);                                                                   \
        if (PROBE_MASK != 0ull) {                                                          \
            unsigned long long now_ = __builtin_amdgcn_s_memrealtime();                    \
            if ((PROBE_MASK >> (id)) & 1ull) tsel += now_ - tprev;                         \
            tprev = now_;                                                                  \
        }                                                                                  \
    } while (0)

__global__ void __launch_bounds__(256, 2)
fwd_kernel(const float* a_x, const float* a_p, const int* a_pos, const float* a_an, const float* a_win, const float* a_ng, const float* a_cp,
           const float* a_cw1, const float* a_cw2, const float* a_dg, const float* a_wa, const float* a_wb, const float* a_wo, const float* a_fn,
           const float* a_wq, const float* a_sk, const float* a_pu, const float* a_pv, const float* a_pw, const float* a_pgw, const float* a_pn,
           float* a_out, unsigned char* a_ws) {
    Params P;
    P.x = a_x; P.p = a_p; P.positions = a_pos; P.attn_norm = a_an; P.w_in = a_win; P.nsa_gain = a_ng; P.cmp_pos = a_cp; P.cmp_w1 = a_cw1;
    P.cmp_w2 = a_cw2; P.dsa_gain = a_dg; P.w_a = a_wa; P.w_b = a_wb; P.w_out = a_wo; P.ffn_norm = a_fn; P.peer_wq = a_wq; P.peer_sk = a_sk;
    P.peer_u = a_pu; P.peer_v = a_pv; P.ple_w = a_pw; P.ple_gw = a_pgw; P.ple_norm = a_pn; P.out = a_out; P.ws = a_ws;
    cg::grid_group grid = cg::this_grid();
    extern __shared__ __attribute__((aligned(16))) unsigned char smem[];
    unsigned long long tprev = 0, tsel = 0;
    if (PROBE_MASK != 0ull) tprev = __builtin_amdgcn_s_memrealtime();
    volatile LAS unsigned* xst = (volatile LAS unsigned*)(smem + LDS_BYTES);
    if (threadIdx.x == 0) { xst[0] = 0u; xst[1] = 0u; xst[2] = 0u; xst[3] = 0u; }
    __syncthreads();
    XcdBarrier xb = xcd_barrier_post((unsigned*)(P.ws + OFF_BAR), xst);
    phase_prep(P, smem);
    grid.sync();
    if (PROBE_MASK != 0ull) {
        unsigned long long now_ = __builtin_amdgcn_s_memrealtime();
        if (PROBE_MASK & 1ull) tsel += now_ - tprev;
        tprev = now_;
    }
    for (int layer = 0; layer < 2; ++layer) {
        const int pb = 1 + 16 * layer;
        phase_g1(P, layer, smem);
        GSYNC(pb + 0);
        phase_c1(P, layer, smem);
        phase_att_a(P, layer, smem, tsel);
        GSYNC(pb + 15);
        phase_c2(P, layer, smem);
        GSYNC(pb + 3);
        phase_att_b(P, layer, smem);
        GSYNC(pb + 5);
        phase_merge(P, layer, smem);
        GSYNC(pb + 6);
        phase_outproj(P, layer, smem);
        GSYNC(pb + 7);
        phase_pq(P, layer, smem);
        GSYNC(pb + 9);
        peer_route(opq(P.ws), opq(P.out), P.ffn_norm + layer * 1024, layer, smem, tsel);
        GSYNC(pb + 11);
        phase_final(P, layer, smem);
        GSYNC(pb + 13);
    }
#ifndef PROBE_BLOCK
#define PROBE_BLOCK 0
#endif
    if (PROBE_MASK != 0ull || PROBE_SEC != 0) {
        if (blockIdx.x == PROBE_BLOCK && threadIdx.x == 0) {
            unsigned long long t0 = __builtin_amdgcn_s_memrealtime();
            while (__builtin_amdgcn_s_memrealtime() - t0 < (unsigned long long)PROBE_MULT * tsel) __builtin_amdgcn_s_sleep(32);
        }
    }
}

extern "C" void kernel_launch(void* const* d_in, const int* in_sizes, int n_in, void* d_out, int out_size, void* d_ws, size_t ws_size,
                              hipStream_t stream) {
    static int grid_blocks = 0;
    if (!grid_blocks) {
        int dev = 0, cus = 0, per_cu = 0;
        (void)hipGetDevice(&dev);
        (void)hipDeviceGetAttribute(&cus, hipDeviceAttributeMultiprocessorCount, dev);
        (void)hipFuncSetAttribute((const void*)fwd_kernel, hipFuncAttributeMaxDynamicSharedMemorySize, LDS_BYTES + 16);
        (void)hipOccupancyMaxActiveBlocksPerMultiprocessor(&per_cu, fwd_kernel, 256, LDS_BYTES + 16);
        if (per_cu > 2) per_cu = 2;
        if (per_cu < 1) per_cu = 1;
        grid_blocks = cus * per_cu;
        if (ws_size < WS_END) fprintf(stderr, "kernel_launch: workspace too small: %zu < %zu\n", ws_size, (size_t)WS_END);
    }
    Params P{};
    P.x = (const float*)d_in[0];
    P.p = (const float*)d_in[1];
    P.positions = (const int*)d_in[2];
    P.attn_norm = (const float*)d_in[3];
    P.w_in = (const float*)d_in[4];
    P.nsa_gain = (const float*)d_in[5];
    P.cmp_pos = (const float*)d_in[6];
    P.cmp_w1 = (const float*)d_in[7];
    P.cmp_w2 = (const float*)d_in[8];
    P.dsa_gain = (const float*)d_in[9];
    P.w_a = (const float*)d_in[10];
    P.w_b = (const float*)d_in[11];
    P.w_out = (const float*)d_in[12];
    P.ffn_norm = (const float*)d_in[13];
    P.peer_wq = (const float*)d_in[14];
    P.peer_sk = (const float*)d_in[15];
    P.peer_u = (const float*)d_in[16];
    P.peer_v = (const float*)d_in[17];
    P.ple_w = (const float*)d_in[18];
    P.ple_gw = (const float*)d_in[19];
    P.ple_norm = (const float*)d_in[20];
    P.out = (float*)d_out;
    P.ws = (unsigned char*)d_ws;
    void* args[] = {(void*)&P.x, (void*)&P.p, (void*)&P.positions, (void*)&P.attn_norm, (void*)&P.w_in, (void*)&P.nsa_gain, (void*)&P.cmp_pos,
                    (void*)&P.cmp_w1, (void*)&P.cmp_w2, (void*)&P.dsa_gain, (void*)&P.w_a, (void*)&P.w_b, (void*)&P.w_out, (void*)&P.ffn_norm,
                    (void*)&P.peer_wq, (void*)&P.peer_sk, (void*)&P.peer_u, (void*)&P.peer_v, (void*)&P.ple_w, (void*)&P.ple_gw,
                    (void*)&P.ple_norm, (void*)&P.out, (void*)&P.ws};
    (void)hipMemsetAsync((unsigned char*)d_ws + OFF_BAR, 0, 3456 * 4 + N_CTR * 4, stream);
    hipError_t e = hipLaunchCooperativeKernel((void*)fwd_kernel, dim3(grid_blocks), dim3(256), args, LDS_BYTES + 16, stream);
    if (e != hipSuccess) fprintf(stderr, "cooperative launch failed: %s (grid %d)\n", hipGetErrorString(e), grid_blocks);
}
```

```cpp
#include <hip/hip_runtime.h>
#include <hip/hip_cooperative_groups.h>
#include <cstdio>
#include <cstdint>
namespace cg = cooperative_groups;
#ifndef PROBE_SEC
#define PROBE_SEC 0
#endif
#define SEC_T() (PROBE_SEC ? __builtin_amdgcn_s_memrealtime() : 0ull)
#define SEC_ADD(k, t0) do { if (PROBE_SEC == (k)) { unsigned long long n_ = SEC_T(); tacc += n_ - (t0); } } while (0)

typedef unsigned short u16;
typedef unsigned int u32;
typedef unsigned long long u64;
using bf16x8 = __attribute__((ext_vector_type(8))) short;
using f32x4 = __attribute__((ext_vector_type(4))) float;
using f32x16 = __attribute__((ext_vector_type(16))) float;
typedef __bf16 bf16x2_t __attribute__((ext_vector_type(2)));

constexpr int D_MODEL = 1024, BATCH = 8, SEQ = 4096, NTOK = BATCH * SEQ;
constexpr int IN_COLS = 4576;
constexpr int C_NQ = 0, C_NKV = 512, C_DQ = 1280, C_DKV = 1792, C_IQ = 1920, C_IK = 2432, C_MG = 2496, C_NG = 4544, C_IW = 4568;
__host__ __device__ constexpr int perm_col(int n) {
    return n < 1280 ? n : n < 1304 ? 4544 + (n - 1280) : n < 1816 ? 1280 + (n - 1304) : n < 1944 ? 1792 + (n - 1816)
         : n < 2456 ? 1920 + (n - 1944) : n < 2520 ? 2432 + (n - 2456) : n < 2528 ? 4568 + (n - 2520) : 2496 + (n - 2528);
}
constexpr int NCMP = 255;
constexpr int CROWS = BATCH * NCMP * 2;
constexpr int NEXP = 16384;
constexpr float EPS = 1e-6f;

constexpr size_t AL(size_t x) { return (x + 255) & ~(size_t)255; }
constexpr size_t WO_WIN = 0;
constexpr size_t WO_W1 = WO_WIN + AL((size_t)IN_COLS * 1024 * 2);
constexpr size_t WO_W2 = WO_W1 + AL((size_t)2 * 256 * 2048 * 2);
constexpr size_t WO_WA = WO_W2 + AL((size_t)2 * 64 * 256 * 2);
constexpr size_t WO_WB = WO_WA + AL((size_t)1024 * 512 * 2);
constexpr size_t WO_WO = WO_WB + AL((size_t)1024 * 512 * 2);
constexpr size_t WO_WQ = WO_WO + AL((size_t)1024 * 1024 * 2);
constexpr size_t WO_PW = WO_WQ + AL((size_t)2048 * 1024 * 2);
constexpr size_t WO_PG = WO_PW + AL((size_t)1024 * 256 * 2);
constexpr size_t WO_SK = WO_PG + AL((size_t)1024 * 1024 * 2);
constexpr size_t WO_CB = WO_SK + AL((size_t)2 * 128 * 128 * 2);
constexpr size_t W_LAYER = WO_CB + AL((size_t)2 * 256 * 4);

constexpr size_t OFF_W = 0;
constexpr size_t OFF_ROPE = OFF_W + 2 * W_LAYER;
constexpr size_t OFF_H = OFF_ROPE + AL((size_t)NTOK * 16 * 4);
constexpr size_t OFF_PROJ = OFF_H + AL((size_t)NTOK * 1024 * 2);
constexpr size_t OFF_YAB = OFF_PROJ + AL((size_t)NTOK * IN_COLS * 2);
constexpr size_t OFF_CHID = OFF_YAB + AL((size_t)NTOK * 1024 * 2);
constexpr size_t OFF_CBUF = OFF_CHID + AL((size_t)2 * CROWS * 256 * 2);
constexpr size_t OFF_KCB = OFF_CBUF + AL((size_t)2 * CROWS * 64 * 4);
constexpr size_t OFF_VCB = OFF_KCB + AL((size_t)BATCH * 2 * 256 * 64 * 2);
constexpr size_t OFF_RSTDE = OFF_VCB + AL((size_t)BATCH * 2 * 256 * 64 * 2);
constexpr size_t OFF_SSA = OFF_RSTDE + AL((size_t)NTOK * 4);
constexpr size_t OFF_SSE = OFF_SSA + AL((size_t)2 * NTOK * 16 * 4);
constexpr size_t OFF_SS1 = OFF_SSE + AL((size_t)2 * NTOK * 16 * 4);
constexpr size_t OFF_BITS = OFF_SS1 + AL((size_t)NTOK * 16 * 4);
__device__ __forceinline__ float sum16(const float* p) {
    const float4 a = *(const float4*)p, b = *(const float4*)(p + 4), c = *(const float4*)(p + 8), d = *(const float4*)(p + 12);
    return ((a.x + a.y) + (a.z + a.w)) + ((b.x + b.y) + (b.z + b.w)) + (((c.x + c.y) + (c.z + c.w)) + ((d.x + d.y) + (d.z + d.w)));
}
constexpr size_t OFF_BAR = OFF_BITS + AL((size_t)NTOK * 64 * 8);
constexpr size_t OFF_CTR = OFF_BAR + 3456 * 4;
constexpr int N_CTR = 512;
constexpr size_t WS_END = OFF_CTR + AL(N_CTR * 4);
constexpr size_t OFF_PQ = OFF_PROJ;
constexpr size_t OFF_UB = OFF_PQ + (size_t)NTOK * 2048 * 2;
constexpr size_t OFF_VB = OFF_UB + (size_t)NEXP * 1024 * 2;
constexpr size_t OFF_EIDX = OFF_VB + (size_t)NEXP * 1024 * 2;
constexpr size_t OFF_GATE = OFF_EIDX + (size_t)NTOK * 128 * 4;
constexpr size_t OFF_ESC = OFF_GATE + (size_t)NTOK * 128 * 4;
constexpr size_t OFF_PBF = OFF_ESC + (size_t)2 * NEXP * 4;
constexpr size_t OFF_ESU = OFF_PBF + (size_t)NTOK * 256 * 2;
static_assert(OFF_ESU + (size_t)NTOK * 128 * 4 <= OFF_YAB, "alias overflow");

constexpr int LDS_BYTES = 65536 + 2048;

struct Params {
    const float* x; const float* p; const int* positions;
    const float* attn_norm; const float* w_in; const float* nsa_gain; const float* cmp_pos; const float* cmp_w1; const float* cmp_w2;
    const float* dsa_gain; const float* w_a; const float* w_b; const float* w_out; const float* ffn_norm; const float* peer_wq;
    const float* peer_sk; const float* peer_u; const float* peer_v; const float* ple_w; const float* ple_gw; const float* ple_norm;
    float* out; unsigned char* ws;
};

__device__ __forceinline__ u16 f2bf(float f) {
    u32 u = __float_as_uint(f);
    u32 r = u + 0x7FFFu + ((u >> 16) & 1u);
    return (u16)(r >> 16);
}
__device__ __forceinline__ float bf2f(u16 h) { return __uint_as_float(((u32)h) << 16); }
__device__ __forceinline__ float bf_lo(u32 w) { return __uint_as_float(w << 16); }
__device__ __forceinline__ float bf_hi(u32 w) { return __uint_as_float(w & 0xFFFF0000u); }
__device__ __forceinline__ u32 pack2(float a, float b) {
    u32 r;
    asm("v_cvt_pk_bf16_f32 %0, %1, %2" : "=v"(r) : "v"(a), "v"(b));
    return r;
}
__device__ __forceinline__ float dot2(u32 a, u32 b, float c) {
    return __builtin_amdgcn_fdot2_f32_bf16(__builtin_bit_cast(bf16x2_t, a), __builtin_bit_cast(bf16x2_t, b), c, false);
}
template <int CTRL>
__device__ __forceinline__ int dppi(int x) { return __builtin_amdgcn_update_dpp(x, x, CTRL, 0xF, 0xF, false); }
template <int CTRL>
__device__ __forceinline__ float dppf(float x) { return __int_as_float(dppi<CTRL>(__float_as_int(x))); }
__device__ __forceinline__ int row_sum16i(int x) {
    x += dppi<0x128>(x);
    x += dppi<0x124>(x);
    x += dppi<0x122>(x);
    x += dppi<0x121>(x);
    return x;
}
template <int CTRL>
__device__ __forceinline__ int dppi0(int x) { return __builtin_amdgcn_update_dpp(0, x, CTRL, 0xF, 0xF, true); }
__device__ __forceinline__ int row_xscan16i(int x) {
    int s = x;
    s += dppi0<0x111>(s);
    s += dppi0<0x112>(s);
    s += dppi0<0x114>(s);
    s += dppi0<0x118>(s);
    return s - x;
}
__device__ __forceinline__ float row_sum16f(float x) {
    x += dppf<0x128>(x);
    x += dppf<0x124>(x);
    x += dppf<0x122>(x);
    x += dppf<0x121>(x);
    return x;
}
__device__ __forceinline__ float row_max16f(float x) {
    x = fmaxf(x, dppf<0x128>(x));
    x = fmaxf(x, dppf<0x124>(x));
    x = fmaxf(x, dppf<0x122>(x));
    x = fmaxf(x, dppf<0x121>(x));
    return x;
}

__device__ __forceinline__ u32 row_max16u(u32 x) {
    x = max(x, (u32)dppi<0x128>((int)x));
    x = max(x, (u32)dppi<0x124>((int)x));
    x = max(x, (u32)dppi<0x122>((int)x));
    x = max(x, (u32)dppi<0x121>((int)x));
    return x;
}
__device__ __forceinline__ u32 row_min16u(u32 x) {
    x = min(x, (u32)dppi<0x128>((int)x));
    x = min(x, (u32)dppi<0x124>((int)x));
    x = min(x, (u32)dppi<0x122>((int)x));
    x = min(x, (u32)dppi<0x121>((int)x));
    return x;
}
template <int CTRL>
__device__ __forceinline__ float dpp_qf(float x) { return __int_as_float(__builtin_amdgcn_update_dpp(0, __float_as_int(x), CTRL, 0xF, 0xF, false)); }
__device__ __forceinline__ float wsum(float v) {
    v = row_sum16f(v);
    const float a = __int_as_float(__builtin_amdgcn_readlane(__float_as_int(v), 0));
    const float b = __int_as_float(__builtin_amdgcn_readlane(__float_as_int(v), 16));
    const float c = __int_as_float(__builtin_amdgcn_readlane(__float_as_int(v), 32));
    const float d = __int_as_float(__builtin_amdgcn_readlane(__float_as_int(v), 48));
    return (a + b) + (c + d);
}
__device__ __forceinline__ float wmax(float v) {
    v = row_max16f(v);
    const float a = __int_as_float(__builtin_amdgcn_readlane(__float_as_int(v), 0));
    const float b = __int_as_float(__builtin_amdgcn_readlane(__float_as_int(v), 16));
    const float c = __int_as_float(__builtin_amdgcn_readlane(__float_as_int(v), 32));
    const float d = __int_as_float(__builtin_amdgcn_readlane(__float_as_int(v), 48));
    return fmaxf(fmaxf(a, b), fmaxf(c, d));
}
__device__ __forceinline__ int wsumi(int v) {
    v = row_sum16i(v);
    return __builtin_amdgcn_readlane(v, 0) + __builtin_amdgcn_readlane(v, 16) + __builtin_amdgcn_readlane(v, 32) + __builtin_amdgcn_readlane(v, 48);
}
__device__ __forceinline__ float sigmoidf(float x) { return 1.0f / (1.0f + __expf(-x)); }
__device__ __forceinline__ float gelu_tanh(float x) {
    float u = 0.7978845608028654f * (x + 0.044715f * x * x * x);
    return 0.5f * x * (1.0f + tanhf(u));
}
__device__ __forceinline__ u32 sortkey(float f) {
    u32 b = __float_as_uint(f);
    return b ^ ((b >> 31) ? 0xFFFFFFFFu : 0x80000000u);
}
#define WAVE_SYNC() asm volatile("s_waitcnt lgkmcnt(0)" ::: "memory")
template <class T>
__device__ __forceinline__ T* opq(T* p) {
    long z = 0;
    asm volatile("" : "+s"(z));
    return (T*)((char*)p + z);
}
__device__ __forceinline__ int tidx() {
    int t = threadIdx.x;
    asm volatile("" : "+v"(t));
    return t;
}
__device__ __forceinline__ int bidx() {
    int b = blockIdx.x;
    asm volatile("" : "+s"(b));
    return b;
}
__device__ __forceinline__ int gdim() {
    int g = gridDim.x;
    asm volatile("" : "+s"(g));
    return g;
}

template <int AMODE, bool HAS_RS, class RowFn, class Epi>
__device__ __forceinline__ void gemm_tile(const u16* __restrict__ Ap, long lda, const u16* __restrict__ BT, long ldb, int M, int N, int K, int m0,
                                          int n0, unsigned char* lds, RowFn rowfn, Epi epi) {
    const int tid = tidx(), lane = tid & 63, w = tid >> 6;
    const int wm = w >> 1, wn = w & 1;
    f32x4 acc[4][4];
#pragma unroll
    for (int i = 0; i < 4; ++i)
#pragma unroll
        for (int j = 0; j < 4; ++j) acc[i][j] = f32x4{0.f, 0.f, 0.f, 0.f};
    long aoff[4], boff[4];
#pragma unroll
    for (int i = 0; i < 4; ++i) {
        const int row = (w * 4 + i) * 8 + (lane >> 3);
        const int kc = (lane & 7) ^ ((row >> 1) & 7);
        int gr = m0 + row;
        if (gr > M - 1) gr = M - 1;
        if (AMODE == 1) {
            int b = gr / (NCMP * 2);
            int rem = gr - b * (NCMP * 2);
            aoff[i] = ((long)b * SEQ + 16 * (rem >> 1)) * IN_COLS + (rem & 1) * 64 + kc * 8;
        } else {
            aoff[i] = (long)gr * lda + kc * 8;
        }
        int gn = n0 + row;
        if (gn > N - 1) gn = N - 1;
        boff[i] = (long)gn * ldb + kc * 8;
    }
    const int nk = K / 64;
#define GEMM_STAGE(kt, bufsel)                                                                                                        \
    do {                                                                                                                              \
        unsigned char* ab_ = lds + (bufsel) * 32768 + w * 4096 + lane * 16;                                                           \
        const long ka_ = (AMODE == 1) ? (long)(kt) * IN_COLS : (long)(kt) * 64;                                                       \
        _Pragma("unroll") for (int i_ = 0; i_ < 4; ++i_) {                                                                            \
            __builtin_amdgcn_global_load_lds((const unsigned*)(Ap + aoff[i_] + ka_), (unsigned*)(ab_ + i_ * 1024), 16, 0, 0);        \
            __builtin_amdgcn_global_load_lds((const unsigned*)(BT + boff[i_] + (long)(kt) * 64), (unsigned*)(ab_ + 16384 + i_ * 1024), 16, 0, 0); \
        }                                                                                                                             \
    } while (0)
    GEMM_STAGE(0, 0);
    asm volatile("s_waitcnt vmcnt(0)" ::: "memory");
    __syncthreads();
    int fa[4], fb[4];
#pragma unroll
    for (int i = 0; i < 4; ++i) {
        const int ra = wm * 64 + i * 16 + (lane & 15), rb = wn * 64 + i * 16 + (lane & 15);
        fa[i] = ra * 128 + ((ra >> 1) & 7) * 16;
        fb[i] = rb * 128 + ((rb >> 1) & 7) * 16;
    }
    for (int kt = 0; kt < nk; ++kt) {
        if (kt + 1 < nk) GEMM_STAGE(kt + 1, (kt + 1) & 1);
        const unsigned char* Ab = lds + (kt & 1) * 32768;
        const unsigned char* Bb = Ab + 16384;
#pragma unroll
        for (int ks = 0; ks < 2; ++ks) {
            const int kc16 = (ks * 4 + (lane >> 4)) * 16;
            bf16x8 af[4], bfr[4];
#pragma unroll
            for (int i = 0; i < 4; ++i) {
                af[i] = *(const bf16x8*)(Ab + ((fa[i] & ~127) | ((fa[i] & 127) ^ kc16)));
                bfr[i] = *(const bf16x8*)(Bb + ((fb[i] & ~127) | ((fb[i] & 127) ^ kc16)));
            }
#pragma unroll
            for (int i = 0; i < 4; ++i)
#pragma unroll
                for (int j = 0; j < 4; ++j) acc[i][j] = __builtin_amdgcn_mfma_f32_16x16x32_bf16(af[i], bfr[j], acc[i][j], 0, 0, 0);
        }
        asm volatile("s_waitcnt vmcnt(0)" ::: "memory");
        __syncthreads();
    }
#undef GEMM_STAGE
    float2* rsl = (float2*)(lds + 34816);
    if (HAS_RS) {
        if (tid < 128) {
            int gr = m0 + tid;
            if (gr > M - 1) gr = M - 1;
            rsl[tid] = rowfn(gr);
        }
        __syncthreads();
    }
    float* st = (float*)(lds + w * 8704);
#pragma unroll
    for (int hh = 0; hh < 2; ++hh) {
#pragma unroll
        for (int m2 = 0; m2 < 2; ++m2)
#pragma unroll
            for (int j = 0; j < 4; ++j)
#pragma unroll
                for (int r = 0; r < 4; ++r) st[(m2 * 16 + (lane >> 4) * 4 + r) * 68 + j * 16 + (lane & 15)] = acc[hh * 2 + m2][j][r];
        WAVE_SYNC();
#pragma unroll
        for (int c = 0; c < 4; ++c) {
            const int id = c * 64 + lane;
            const int rr = id >> 3, cc = id & 7;
            const float4 v0 = *(const float4*)(st + rr * 68 + cc * 8);
            const float4 v1 = *(const float4*)(st + rr * 68 + cc * 8 + 4);
            const float v[8] = {v0.x, v0.y, v0.z, v0.w, v1.x, v1.y, v1.z, v1.w};
            const int row = m0 + wm * 64 + hh * 32 + rr;
            const int col0 = n0 + wn * 64 + cc * 8;
            const float2 rs = HAS_RS ? rsl[wm * 64 + hh * 32 + rr] : float2{1.f, 1.f};
            if (row < M && col0 < N) epi(row, col0, v, rs);
        }
        WAVE_SYNC();
    }
    __syncthreads();
}

template <int AMODE, bool HAS_RS, class RowFn, class Epi>
__device__ __forceinline__ void gemm_phase_rs(const u16* Ap, long lda, const u16* BT, long ldb, int M, int N, int K, unsigned char* lds, RowFn rowfn, Epi epi) {
    const int tm = (M + 127) / 128, tn = (N + 127) / 128;
    const int SW = (tn % 9 == 0) ? 9 : ((tn % 8 == 0) ? 8 : 0);
    const int G = gdim();
    if (SW != 0 && (tm % 8) == 0 && (G % 8) == 0 && (((tm / 8) * (tn / SW)) % 8) == 0) {
        const int nsc = tn / SW;
        const int per = 8 * SW;
        const int nst_x = (tm / 8) * nsc / 8;
        const int x = bidx() & 7, j0 = bidx() >> 3, nper = G >> 3;
        for (int q = j0; q < nst_x * per; q += nper) {
            const int st = (q / per) * 8 + x;
            const int r = q % per;
            const int im = (st / nsc) * 8 + (r % 8), in = (st % nsc) * SW + (r / 8);
            gemm_tile<AMODE, HAS_RS>(Ap, lda, BT, ldb, M, N, K, im * 128, in * 128, lds, rowfn, epi);
        }
    } else {
        for (int t = bidx(); t < tm * tn; t += G) {
            int im = t / tn, in = t - im * tn;
            gemm_tile<AMODE, HAS_RS>(Ap, lda, BT, ldb, M, N, K, im * 128, in * 128, lds, rowfn, epi);
        }
    }
}
template <int AMODE, class Epi>
__device__ __forceinline__ void gemm_phase(const u16* Ap, long lda, const u16* BT, long ldb, int M, int N, int K, unsigned char* lds, Epi epi) {
    gemm_phase_rs<AMODE, false>(Ap, lda, BT, ldb, M, N, K, lds, [](int) { return float2{1.f, 1.f}; },
                                [=](int row, int col, const float (&v)[8], float2) { epi(row, col, v); });
}
__device__ __forceinline__ void st_bf8(u16* p, const float (&v)[8]) {
    *(uint4*)p = uint4{pack2(v[0], v[1]), pack2(v[2], v[3]), pack2(v[4], v[5]), pack2(v[6], v[7])};
}
__device__ __forceinline__ void ld_bf8(const u16* p, float (&v)[8]) {
    const uint4 q = *(const uint4*)p;
    v[0] = bf_lo(q.x); v[1] = bf_hi(q.x); v[2] = bf_lo(q.y); v[3] = bf_hi(q.y);
    v[4] = bf_lo(q.z); v[5] = bf_hi(q.z); v[6] = bf_lo(q.w); v[7] = bf_hi(q.w);
}

template <bool PERM = false>
__device__ __forceinline__ void transpose_cvt(const float* __restrict__ src, u16* __restrict__ dst, int K, int N, float* tile, const float* kgain = nullptr) {
    const int tk = K / 64, tn = (N + 63) / 64;
    const int tid = tidx();
    for (int t = bidx(); t < tk * tn; t += gdim()) {
        const int k0 = (t / tn) * 64, n0 = (t % tn) * 64;
        {
            const int tx = tid & 15, ty = tid >> 4;
#pragma unroll
            for (int i = 0; i < 4; ++i) {
                const int k = ty * 4 + i, n = n0 + tx * 4;
                float4 v = float4{0.f, 0.f, 0.f, 0.f};
                if (n < N) v = *(const float4*)(src + (long)(k0 + k) * N + n);
                const float g = kgain ? kgain[k0 + k] : 1.0f;
                float* trow = tile + k * 65 + tx * 4;
                trow[0] = v.x * g; trow[1] = v.y * g; trow[2] = v.z * g; trow[3] = v.w * g;
            }
        }
        __syncthreads();
        {
            const int kc = tid & 7, nl = tid >> 3;
#pragma unroll
            for (int j = 0; j < 2; ++j) {
                const int nn = nl + 32 * j, n = n0 + nn;
                float v[8];
#pragma unroll
                for (int q = 0; q < 8; ++q) v[q] = tile[(kc * 8 + q) * 65 + nn];
                if (n < N) st_bf8(dst + (long)(PERM ? perm_col(n) : n) * K + k0 + kc * 8, v);
            }
        }
        __syncthreads();
    }
}

__device__ __forceinline__ void cvt_f32_bf16(const float* __restrict__ src, u16* __restrict__ dst, long n) {
    long i = ((long)bidx() * 256 + tidx()) * 8;
    const long stride = (long)gdim() * 256 * 8;
    for (; i < n; i += stride) {
        float4 a = *(const float4*)(src + i);
        float4 b = *(const float4*)(src + i + 4);
        *(uint4*)(dst + i) = uint4{pack2(a.x, a.y), pack2(a.z, a.w), pack2(b.x, b.y), pack2(b.z, b.w)};
    }
}

typedef float f32x2_t __attribute__((ext_vector_type(2)));
typedef u32 u32x3_t __attribute__((ext_vector_type(3)));
typedef u32x3_t u32x3_a4 __attribute__((aligned(4)));
constexpr int EROW = 768;
__device__ __forceinline__ u32 enc_e2m3(float y) {
    const float a = fabsf(y);
    const float m = a < 2.f ? 8.f : (a < 4.f ? 4.f : 2.f);
    const int off = a < 2.f ? 0 : (a < 4.f ? 8 : 16);
    int c = (int)rintf(a * m) + off;
    c = c > 31 ? 31 : c;
    return (u32)c | (y < 0.f ? 32u : 0u);
}
__device__ __forceinline__ void cvt_rows_fp6(const float* __restrict__ src, unsigned char* __restrict__ dst, float* __restrict__ scales, int nrows, const float* colgain = nullptr) {
    const int lane = tidx() & 63;
    const int wid = bidx() * 4 + (tidx() >> 6);
    const int nw = gdim() * 4;
    for (int row = wid; row < nrows; row += nw) {
        const float* r = src + (long)row * 1024 + lane * 16;
        float4 q[4];
#pragma unroll
        for (int i = 0; i < 4; ++i) {
            q[i] = *(const float4*)(r + 4 * i);
            if (colgain) {
                const float4 g = *(const float4*)(colgain + lane * 16 + 4 * i);
                q[i].x *= g.x; q[i].y *= g.y; q[i].z *= g.z; q[i].w *= g.w;
            }
        }
        float am = 0.f;
#pragma unroll
        for (int i = 0; i < 4; ++i) am = fmaxf(am, fmaxf(fmaxf(fabsf(q[i].x), fabsf(q[i].y)), fmaxf(fabsf(q[i].z), fabsf(q[i].w))));
        am = wmax(am);
        const float inv = am > 0.f ? 7.5f / am : 0.f;
        if (lane == 0) scales[row] = am > 0.f ? am * (1.0f / 7.5f) : 0.f;
        u32 c[16];
#pragma unroll
        for (int i = 0; i < 4; ++i) {
            c[4 * i] = enc_e2m3(q[i].x * inv); c[4 * i + 1] = enc_e2m3(q[i].y * inv);
            c[4 * i + 2] = enc_e2m3(q[i].z * inv); c[4 * i + 3] = enc_e2m3(q[i].w * inv);
        }
        const u32 w0 = c[0] | (c[1] << 6) | (c[2] << 12) | (c[3] << 18) | (c[4] << 24) | (c[5] << 30);
        const u32 w1 = (c[5] >> 2) | (c[6] << 4) | (c[7] << 10) | (c[8] << 16) | (c[9] << 22) | (c[10] << 28);
        const u32 w2 = (c[10] >> 4) | (c[11] << 2) | (c[12] << 8) | (c[13] << 14) | (c[14] << 20) | (c[15] << 26);
        *(u32x3_a4*)(dst + (long)row * EROW + lane * 12) = u32x3_t{w0, w1, w2};
    }
}

__device__ __forceinline__ void rms_rows(const float* __restrict__ x, const float* __restrict__ g, u16* __restrict__ dst, const u16* __restrict__ e,
                         float* __restrict__ rstd_e) {
    const int lane = tidx() & 63;
    const int wid = bidx() * 4 + (tidx() >> 6);
    const int nw = gdim() * 4;
    for (int row = wid; row < NTOK; row += nw) {
        const float* xr = x + (long)row * 1024;
        float4 v[4];
        float ss = 0.f;
#pragma unroll
        for (int i = 0; i < 4; ++i) {
            v[i] = *(const float4*)(xr + i * 256 + lane * 4);
            ss += v[i].x * v[i].x + v[i].y * v[i].y + v[i].z * v[i].z + v[i].w * v[i].w;
        }
        ss = wsum(ss);
        float rstd = rsqrtf(ss * (1.0f / 1024.0f) + EPS);
#pragma unroll
        for (int i = 0; i < 4; ++i) {
            float4 gg = g ? *(const float4*)(g + i * 256 + lane * 4) : float4{1.f, 1.f, 1.f, 1.f};
            uint2 o = uint2{pack2(v[i].x * rstd * gg.x, v[i].y * rstd * gg.y), pack2(v[i].z * rstd * gg.z, v[i].w * rstd * gg.w)};
            *(uint2*)(dst + (long)row * 1024 + i * 256 + lane * 4) = o;
        }
        if (e) {
            const uint4* er = (const uint4*)(e + (long)row * 1024);
            float es = 0.f;
#pragma unroll
            for (int i = 0; i < 2; ++i) {
                uint4 q = er[i * 64 + lane];
                float a;
                a = bf_lo(q.x); es += a * a; a = bf_hi(q.x); es += a * a;
                a = bf_lo(q.y); es += a * a; a = bf_hi(q.y); es += a * a;
                a = bf_lo(q.z); es += a * a; a = bf_hi(q.z); es += a * a;
                a = bf_lo(q.w); es += a * a; a = bf_hi(q.w); es += a * a;
            }
            es = wsum(es);
            if (lane == 0) rstd_e[row] = rsqrtf(es * (1.0f / 1024.0f) + EPS);
        }
    }
}

__device__ __forceinline__ void head_chunk(u16* ptr, float gain, bool do_norm, float scale, float c, float sn, int lane) {
    float v = bf2f(ptr[lane]);
    if (do_norm) {
        float ss = wsum(v * v);
        v = v * rsqrtf(ss * (1.0f / 64.0f) + EPS) * gain;
    }
    float pv = __shfl_xor(v, 8);
    if (lane < 16) v = (lane < 8) ? (v * c - pv * sn) : (v * c + pv * sn);
    ptr[lane] = f2bf(v * scale);
}
__device__ __forceinline__ u32 sig2(u32 w) { return pack2(sigmoidf(bf_lo(w)), sigmoidf(bf_hi(w))); }

__device__ __forceinline__ void post_proj(unsigned char* ws, const float* ng, const float* dg, unsigned char* smem) {
    u16* proj = (u16*)(ws + OFF_PROJ);
    const float* ropec = (const float*)(ws + OFF_ROPE);
    const float* ropes = ropec + (size_t)NTOK * 8;
    const int lane = tidx() & 63, w = tidx() >> 6;
    u16* lrow = (u16*)(smem + w * 9216);
    const float g_q = ng[lane], g_ks = ng[128 + lane], g_kw = ng[192 + lane], g_dq = dg[lane], g_kb = dg[64 + lane];
    const int wid = bidx() * 4 + w;
    const int nw = gdim() * 4;
    for (int t = wid; t < NTOK; t += nw) {
        uint4* grow = (uint4*)(proj + (long)t * IN_COLS);
        const float c = ropec[(long)t * 8 + (lane & 7)], sn = ropes[(long)t * 8 + (lane & 7)];
#pragma unroll
        for (int i = 0; i < 8; ++i) ((uint4*)lrow)[i * 64 + lane] = grow[i * 64 + lane];
        if (lane < 60) ((uint4*)lrow)[512 + lane] = grow[512 + lane];
        WAVE_SYNC();
        for (int h = 0; h < 8; ++h) head_chunk(lrow + C_NQ + h * 64, g_q, true, 0.125f * 1.4426950408889634f, c, sn, lane);
        for (int g = 0; g < 2; ++g) head_chunk(lrow + C_NKV + (2 * 2 + g) * 64, g_ks, true, 1.0f, c, sn, lane);
        for (int g = 0; g < 2; ++g) head_chunk(lrow + C_NKV + (4 * 2 + g) * 64, g_kw, true, 1.0f, c, sn, lane);
        for (int h = 0; h < 8; ++h) head_chunk(lrow + C_DQ + h * 64, g_dq, true, 0.125f * 1.4426950408889634f, c, sn, lane);
        head_chunk(lrow + C_DKV, g_kb, true, 1.0f, c, sn, lane);
        for (int h = 0; h < 8; ++h) head_chunk(lrow + C_IQ + h * 64, 1.0f, false, 0.125f, c, sn, lane);
        head_chunk(lrow + C_IK, 1.0f, false, 1.0f, c, sn, lane);
        WAVE_SYNC();
#pragma unroll
        for (int i = 0; i < 9; ++i) {
            int idx = i * 64 + lane;
            if (idx < 572) {
                uint4 v = ((const uint4*)lrow)[idx];
                if (idx >= 316 || (idx >= 160 && idx < 163)) v = uint4{sig2(v.x), sig2(v.y), sig2(v.z), sig2(v.w)};
                grow[idx] = v;
            }
        }
        WAVE_SYNC();
    }
}

template <int NH>
__device__ __forceinline__ void qk_chunk(const u16* krow, const u32* qlds, float (&s)[NH]) {
    asm volatile("" ::: "memory");
    uint4 kr[8];
#pragma unroll
    for (int i = 0; i < 8; ++i) kr[i] = ((const uint4*)krow)[i];
#pragma unroll
    for (int h = 0; h < NH; ++h) s[h] = 0.f;
#pragma unroll
    for (int i = 0; i < 8; ++i)
#pragma unroll
        for (int h = 0; h < NH; ++h) {
            uint4 q = *(const uint4*)(qlds + h * 32 + i * 4);
            s[h] = dot2(kr[i].x, q.x, s[h]);
            s[h] = dot2(kr[i].y, q.y, s[h]);
            s[h] = dot2(kr[i].z, q.z, s[h]);
            s[h] = dot2(kr[i].w, q.w, s[h]);
        }
}

template <int NH, class VRow>
__device__ __forceinline__ void pv_chunk(const float* plds, VRow vrow, float (&o)[NH][4], int lane) {
    const int sub = lane >> 4, dq = lane & 15;
#pragma unroll 4
    for (int kk = 0; kk < 16; ++kk) {
        int key = kk * 4 + sub;
        const u16* vp = vrow(key);
        uint2 vv = *(const uint2*)(vp + dq * 4);
        float v0 = bf_lo(vv.x), v1 = bf_hi(vv.x), v2 = bf_lo(vv.y), v3 = bf_hi(vv.y);
#pragma unroll
        for (int h = 0; h < NH; ++h) {
            float ph = plds[key * NH + h];
            o[h][0] += ph * v0;
            o[h][1] += ph * v1;
            o[h][2] += ph * v2;
            o[h][3] += ph * v3;
        }
    }
}

template <int NH, class VRow>
__device__ __forceinline__ void attn_chunk(float (&s)[NH], bool valid, float (&m)[NH], float (&l)[NH], float (&o)[NH][4], float* plds, VRow vrow,
                                           int lane) {
#pragma unroll
    for (int h = 0; h < NH; ++h) {
        float sv = valid ? s[h] : -1e30f;
        float cm = wmax(sv);
        float mn = fmaxf(m[h], cm);
        float alpha = __expf(m[h] - mn);
        float p = valid ? __expf(sv - mn) : 0.f;
        l[h] = l[h] * alpha + wsum(p);
        m[h] = mn;
#pragma unroll
        for (int j = 0; j < 4; ++j) o[h][j] *= alpha;
        plds[lane * NH + h] = p;
    }
    WAVE_SYNC();
    pv_chunk<NH>(plds, vrow, o, lane);
    WAVE_SYNC();
}

#define MFMA32(a, b, c) __builtin_amdgcn_mfma_f32_32x32x16_bf16(a, b, c, 0, 0, 0)
typedef __attribute__((address_space(3))) const char* lds_cptr;
typedef short v4i16_t __attribute__((ext_vector_type(4)));
using s16x4 = __attribute__((ext_vector_type(4))) short;
__device__ __forceinline__ s16x4 vtr(lds_cptr p) {
    return __builtin_bit_cast(s16x4, __builtin_amdgcn_ds_read_tr16_b64_v4i16((__attribute__((address_space(3))) v4i16_t*)p));
}
__device__ __forceinline__ float xhalf_sum(float v) {
    auto r = __builtin_amdgcn_permlane32_swap(__float_as_uint(v), __float_as_uint(v), false, false);
    return __uint_as_float(r[0]) + __uint_as_float(r[1]);
}
__device__ __forceinline__ float xhalf_max(float v) {
    auto r = __builtin_amdgcn_permlane32_swap(__float_as_uint(v), __float_as_uint(v), false, false);
    return fmaxf(__uint_as_float(r[0]), __uint_as_float(r[1]));
}

using u32x4 = __attribute__((ext_vector_type(4))) unsigned;
struct TileRegs { u32x4 k0, k1, v0, v1; };
template <class RowPtr>
__device__ __forceinline__ void tile_load(u32x4& k0, u32x4& k1, u32x4& v0, u32x4& v1, RowPtr rowptr, int w, int lane) {
    const u16 *kp, *vp, *kp2, *vp2;
    rowptr(lane, kp, vp2);
    rowptr(16 * w + (lane >> 2), kp2, vp);
    k0 = *(const u32x4*)(kp + w * 8);
    k1 = *(const u32x4*)(kp + (w + 4) * 8);
    v0 = *(const u32x4*)(vp + (lane & 3) * 8);
    v1 = *(const u32x4*)(vp + 32 + (lane & 3) * 8);
}
__device__ __forceinline__ void tile_store(const u32x4& k0, const u32x4& k1, const u32x4& v0, const u32x4& v1, unsigned char* buf, int w, int lane) {
    *(u32x4*)(buf + w * 1024 + lane * 16) = k0;
    *(u32x4*)(buf + (w + 4) * 1024 + lane * 16) = k1;
    *(u32x4*)(buf + 8192 + (16 * w + (lane >> 2)) * 64 + (lane & 3) * 16) = v0;
    *(u32x4*)(buf + 8192 + 4096 + (16 * w + (lane >> 2)) * 64 + (lane & 3) * 16) = v1;
}
__device__ __forceinline__ void glds16(const void* g, unsigned lds_base) {
    unsigned sv;
    asm volatile("s_mov_b32 %0, m0\n\ts_mov_b32 m0, %2\n\ts_nop 0\n\tglobal_load_lds_dwordx4 %1, off\n\ts_mov_b32 m0, %0"
                 : "=&s"(sv)
                 : "v"(g), "s"(lds_base)
                 : "memory");
}
template <class RowPtr>
__device__ __forceinline__ void tile_dma(RowPtr rowptr, unsigned char* buf, int w, int lane) {
    const u16 *kp, *vp, *kp2, *vp2;
    rowptr(lane, kp, vp2);
    rowptr(16 * w + (lane >> 2), kp2, vp);
    const unsigned kd = (unsigned)__builtin_amdgcn_readfirstlane((int)((unsigned)(uintptr_t)buf + (unsigned)(w * 1024)));
    const unsigned vd = kd + 8192u;
    glds16(kp + w * 8, kd);
    glds16(kp + (w + 4) * 8, kd + 4096u);
    glds16(vp + (lane & 3) * 8, vd);
    glds16(vp + 32 + (lane & 3) * 8, vd + 4096u);
}
__device__ __forceinline__ void qk_tile(const unsigned char* buf, const bf16x8 (&qr)[4], const f32x16& zero16, f32x16& s0, f32x16& s1, int lane) {
    const int r32 = lane & 31, hi = lane >> 5;
    lds_cptr kp = (lds_cptr)buf + hi * 1024 + r32 * 16;
#pragma unroll
    for (int d0 = 0; d0 < 4; ++d0) {
        bf16x8 k0 = *(const __attribute__((address_space(3))) bf16x8*)(kp + d0 * 2048);
        bf16x8 k1 = *(const __attribute__((address_space(3))) bf16x8*)(kp + d0 * 2048 + 512);
        s0 = MFMA32(k0, qr[d0], d0 == 0 ? zero16 : s0);
        s1 = MFMA32(k1, qr[d0], d0 == 0 ? zero16 : s1);
    }
}
__device__ __forceinline__ bf16x8 pack8(const f32x16& p, int s) {
    u32 a = pack2(p[8 * s + 0], p[8 * s + 1]), b = pack2(p[8 * s + 2], p[8 * s + 3]);
    u32 c = pack2(p[8 * s + 4], p[8 * s + 5]), d = pack2(p[8 * s + 6], p[8 * s + 7]);
    u32x4 v = u32x4{a, b, c, d};
    return __builtin_bit_cast(bf16x8, v);
}
__device__ __forceinline__ void pv_tile(const unsigned char* buf, const f32x16& p0, const f32x16& p1, f32x16 (&o)[2], int lane) {
    const int hi = lane >> 5;
    lds_cptr vp = (lds_cptr)buf + 8192 + ((lane >> 4) & 1) * 32 + (lane & 3) * 8 + (4 * hi + ((lane & 15) >> 2)) * 64;
    bf16x8 pf[4];
    pf[0] = pack8(p0, 0);
    pf[1] = pack8(p0, 1);
    pf[2] = pack8(p1, 0);
    pf[3] = pack8(p1, 1);
#pragma unroll
    for (int dh = 0; dh < 2; ++dh) {
        bf16x8 vf[4];
#pragma unroll
        for (int ks = 0; ks < 4; ++ks) {
            const uint2 vlo = __builtin_bit_cast(uint2, vtr(vp + dh * 4096 + ks * 1024));
            const uint2 vhi = __builtin_bit_cast(uint2, vtr(vp + dh * 4096 + ks * 1024 + 512));
            const u32x4 vq = u32x4{vlo.x, vlo.y, vhi.x, vhi.y};
            vf[ks] = __builtin_bit_cast(bf16x8, vq);
        }
        __builtin_amdgcn_sched_barrier(0);
#pragma unroll
        for (int ks = 0; ks < 4; ++ks) o[dh] = MFMA32(vf[ks], pf[ks], o[dh]);
        __builtin_amdgcn_sched_barrier(0);
    }
}
template <bool BITS>
__device__ __forceinline__ void apply_mask(f32x16& s0, f32x16& s1, int lo, int hi_lim, u64 word, int hi) {
    const u32 wlo = (u32)(word >> (4 * hi)), whi = (u32)(word >> (32 + 4 * hi));
#pragma unroll
    for (int i = 0; i < 16; ++i) {
        const int kc = (i & 3) + 8 * (i >> 2);
        bool v0, v1;
        if (BITS) {
            v0 = (wlo >> kc) & 1u;
            v1 = (whi >> kc) & 1u;
        } else {
            const int kk = kc + 4 * hi;
            v0 = (kk >= lo) && (kk <= hi_lim);
            v1 = (kk + 32 >= lo) && (kk + 32 <= hi_lim);
        }
        s0[i] = v0 ? s0[i] : -1e30f;
        s1[i] = v1 ? s1[i] : -1e30f;
    }
}
__device__ __forceinline__ void softmax_step(f32x16& s0, f32x16& s1, float& m, float& l, f32x16 (&o)[2]) {
    float mx = fmaxf(s0[0], s1[0]);
#pragma unroll
    for (int i = 1; i < 16; ++i) mx = fmaxf(fmaxf(mx, s0[i]), s1[i]);
    mx = xhalf_max(mx);
    if (__any(mx > m + 8.0f)) {
        const float mn = fmaxf(m, mx);
        const float alpha = __builtin_amdgcn_exp2f(m - mn);
        l *= alpha;
        m = mn;
#pragma unroll
        for (int i = 0; i < 16; ++i) { o[0][i] *= alpha; o[1][i] *= alpha; }
    }
    const float ms = fmaxf(m, -1e29f);
    float sum = 0.f;
#pragma unroll
    for (int i = 0; i < 16; ++i) {
        s0[i] = __builtin_amdgcn_exp2f(s0[i] - ms);
        s1[i] = __builtin_amdgcn_exp2f(s1[i] - ms);
        sum += s0[i] + s1[i];
    }
    l += xhalf_sum(sum);
}

template <int MODE, bool BITS, class Next, class RowPtr, class MaskFn, class Extra>
__device__ __forceinline__ void flash_run(int first, Next next, RowPtr rowptr, MaskFn maskfn, Extra extra, const bf16x8 (&qr)[4], float& m, float& l,
                                          f32x16 (&o)[2], unsigned char* bufs, int w, int lane) {
    if (first < 0) return;
    int cur = first;
    int nxt = next(cur);
    asm volatile("" ::"v"(qr[0]), "v"(qr[1]), "v"(qr[2]), "v"(qr[3]));
    __syncthreads();
    tile_dma([&](int r, const u16*& kp, const u16*& vp) { rowptr(cur, r, kp, vp); }, bufs, w, lane);
    if (nxt >= 0) tile_dma([&](int r, const u16*& kp, const u16*& vp) { rowptr(nxt, r, kp, vp); }, bufs + 16384, w, lane);
    int pb = 0, pb2 = 2;
    f32x16 zero16;
#pragma unroll
    for (int i = 0; i < 16; ++i) zero16[i] = 0.f;
    while (cur >= 0) {
        if (nxt >= 0) asm volatile("s_waitcnt vmcnt(4)" ::: "memory");
        else asm volatile("s_waitcnt vmcnt(0)" ::: "memory");
        asm volatile("s_waitcnt lgkmcnt(0)" ::: "memory");
        __builtin_amdgcn_s_barrier();
        const int nn = nxt >= 0 ? next(nxt) : -1;
        if (nn >= 0) tile_dma([&](int r, const u16*& kp, const u16*& vp) { rowptr(nn, r, kp, vp); }, bufs + pb2 * 16384, w, lane);
        const unsigned char* buf = bufs + pb * 16384;
        f32x16 s0, s1;
        qk_tile(buf, qr, zero16, s0, s1, lane);
        int lo, hl;
        u64 word;
        maskfn(cur, lo, hl, word);
        if (BITS || !__all(lo <= 0 && hl >= 63)) apply_mask<BITS>(s0, s1, lo, hl, word, lane >> 5);
        if (MODE == 0) {
            softmax_step(s0, s1, m, l, o);
            pv_tile(buf, s0, s1, o, lane);
        } else if (MODE == 1) {
            f32x16 od[2];
#pragma unroll
            for (int i = 0; i < 16; ++i) { od[0][i] = 0.f; od[1][i] = 0.f; }
            softmax_step(s0, s1, m, l, od);
        } else {
            const float ms2 = fmaxf(m, -1e29f);
#pragma unroll
            for (int i = 0; i < 16; ++i) {
                s0[i] = __builtin_amdgcn_exp2f(s0[i] - ms2) * l;
                s1[i] = __builtin_amdgcn_exp2f(s1[i] - ms2) * l;
            }
            extra(cur, s0, s1);
            pv_tile(buf, s0, s1, o, lane);
        }
        pb = (pb == 2) ? 0 : pb + 1;
        pb2 = (pb2 == 2) ? 0 : pb2 + 1;
        cur = nxt;
        nxt = nn;
    }
}

__device__ __forceinline__ void nsa_unit(unsigned char* ws, int b, int g, int qt, unsigned char* smem) {
    const int tid = tidx(), lane = tid & 63, w = tid >> 6;
    const int r32 = lane & 31, hi = lane >> 5;
    const int q0 = qt * 32;
    const int tl = q0 + 8 * w + (r32 >> 2);
    const int rep = r32 & 3;
    const u16* proj = (const u16*)(ws + OFF_PROJ);
    const u16* brow = proj + (long)b * SEQ * IN_COLS;
    const u16* kcb = (const u16*)(ws + OFF_KCB) + (size_t)(b * 2 + g) * 256 * 64;
    const u16* vcb = (const u16*)(ws + OFF_VCB) + (size_t)(b * 2 + g) * 256 * 64;
    u16* ya = (u16*)(ws + OFF_YAB);
    unsigned char* bufs = smem;
    float* imp = (float*)(smem + 49152);
    u64* selm = (u64*)(smem + 49152 + 8192);
    const u16* trow = brow + (long)tl * IN_COLS;
    bf16x8 qr[4];
#pragma unroll
    for (int d0 = 0; d0 < 4; ++d0) qr[d0] = *(const bf16x8*)(trow + C_NQ + (g * 4 + rep) * 64 + d0 * 16 + hi * 8);
    const float gate_c = bf2f(trow[C_NG + 0 * 8 + g * 4 + rep]);
    const float gate_s = bf2f(trow[C_NG + 1 * 8 + g * 4 + rep]);
    const float gate_w = bf2f(trow[C_NG + 2 * 8 + g * 4 + rep]);
    for (int i = tid; i < 32 * 64; i += 256) imp[i] = 0.f;
    f32x16 tot[2];
#pragma unroll
    for (int i = 0; i < 16; ++i) { tot[0][i] = 0.f; tot[1][i] = 0.f; }

    const int nvalid = tl >= 31 ? ((tl - 31) >> 4) + 1 : 0;
    const int nv_max = (q0 + 31 >= 31) ? ((q0 + 31 - 31) >> 4) + 1 : 0;
    const int ntile_c = (nv_max + 63) >> 6;
    auto crows = [&](int tile, int r, const u16*& kp, const u16*& vp) {
        int n = tile * 64 + r;
        n = n < 254 ? n : 254;
        kp = kcb + (size_t)n * 64;
        vp = vcb + (size_t)n * 64;
    };
    auto cnext = [&](int c) { return (c + 1 < ntile_c) ? c + 1 : -1; };
    auto cmask = [&](int tile, int& lo, int& hl, u64& word) { lo = 0; hl = nvalid - 64 * tile - 1; word = 0; };
    {
        float m = -1e30f, l = 0.f;
        f32x16 o[2];
#pragma unroll
        for (int i = 0; i < 16; ++i) { o[0][i] = 0.f; o[1][i] = 0.f; }
        flash_run<1, false>(ntile_c > 0 ? 0 : -1, cnext, crows, cmask, [&](int, f32x16&, f32x16&) {}, qr, m, l, o, bufs, w, lane);
        float invl = l > 0.f ? 1.0f / l : 0.f;
        const int qloc = 8 * w + (r32 >> 2);
        flash_run<2, false>(ntile_c > 0 ? 0 : -1, cnext, crows, cmask,
                            [&](int tile, f32x16& p0, f32x16& p1) {
#pragma unroll
                                for (int a = 0; a < 4; ++a) {
                                    float g0 = p0[4 * a] + p0[4 * a + 1] + p0[4 * a + 2] + p0[4 * a + 3], e0 = p0[4 * a + 3];
                                    float g1 = p1[4 * a] + p1[4 * a + 1] + p1[4 * a + 2] + p1[4 * a + 3], e1 = p1[4 * a + 3];
                                    g0 += __shfl_xor(g0, 1); g0 += __shfl_xor(g0, 2);
                                    e0 += __shfl_xor(e0, 1); e0 += __shfl_xor(e0, 2);
                                    g1 += __shfl_xor(g1, 1); g1 += __shfl_xor(g1, 2);
                                    e1 += __shfl_xor(e1, 1); e1 += __shfl_xor(e1, 2);
                                    if (rep == 0) {
                                        int j0 = 16 * tile + 2 * a + hi, j1 = j0 + 8;
                                        atomicAdd(&imp[qloc * 64 + j0], g0);
                                        if (j0 + 1 < 64) atomicAdd(&imp[qloc * 64 + j0 + 1], e0);
                                        if (j1 < 64) atomicAdd(&imp[qloc * 64 + j1], g1);
                                        if (j1 + 1 < 64) atomicAdd(&imp[qloc * 64 + j1 + 1], e1);
                                    }
                                }
                            },
                            qr, m, invl, o, bufs, w, lane);
#pragma unroll
        for (int i = 0; i < 16; ++i) { tot[0][i] += gate_c * o[0][i]; tot[1][i] += gate_c * o[1][i]; }
    }
    __syncthreads();
    for (int qq = 0; qq < 8; ++qq) {
        const int qi = 8 * w + qq;
        const int tq = q0 + qi;
        const int cur = tq >> 6;
        const int j = lane;
        float v = imp[qi * 64 + j];
        if (j == 0 || j == cur || j == cur - 1) v = __builtin_inff();
        if (j > cur) v = -__builtin_inff();
        const u32 key = sortkey(v);
        u32 Kq = 0u;
        for (int bit = 31; bit >= 0; --bit) {
            const u32 cand = Kq | (1u << bit);
            const int cnt = __popcll(__ballot(key >= cand));
            if (cnt >= 16) Kq = cand;
            if (cnt == 16) break;
        }
        const int needq = 16 - __popcll(__ballot(key > Kq));
        const u64 emq = __ballot(key == Kq);
        const bool takeq = (key > Kq) || (key == Kq && __popcll(emq & ((1ull << lane) - 1ull)) < needq);
        u64 sm = __ballot(takeq && j <= cur);
        if (lane == 0) selm[qi] = sm;
    }
    __syncthreads();
    const u64 mymask = selm[8 * w + (r32 >> 2)];
    u64 unionm = 0;
    for (int i = 0; i < 32; ++i) unionm |= selm[i];
    unionm = __builtin_amdgcn_readfirstlane((u32)unionm) | ((u64)__builtin_amdgcn_readfirstlane((u32)(unionm >> 32)) << 32);
    {
        float m = -1e30f, l = 0.f;
        f32x16 o[2];
#pragma unroll
        for (int i = 0; i < 16; ++i) { o[0][i] = 0.f; o[1][i] = 0.f; }
        auto snext = [&](int c) {
            u64 rest = (c >= 63) ? 0ull : (unionm >> (c + 1));
            return rest ? (c + 1 + (__ffsll((long long)rest) - 1)) : -1;
        };
        const int first = unionm ? (__ffsll((long long)unionm) - 1) : -1;
        flash_run<0, false>(first, snext,
                            [&](int j, int r, const u16*& kp, const u16*& vp) {
                                const u16* rp = brow + (long)(64 * j + r) * IN_COLS + C_NKV;
                                kp = rp + (2 * 2 + g) * 64;
                                vp = rp + (3 * 2 + g) * 64;
                            },
                            [&](int j, int& lo, int& hl, u64& word) { lo = 0; hl = ((mymask >> j) & 1ull) ? (tl - 64 * j) : -1; word = 0; },
                            [&](int, f32x16&, f32x16&) {}, qr, m, l, o, bufs, w, lane);
        const float sc = l > 0.f ? gate_s / l : 0.f;
#pragma unroll
        for (int i = 0; i < 16; ++i) { tot[0][i] += sc * o[0][i]; tot[1][i] += sc * o[1][i]; }
    }
    {
        float m = -1e30f, l = 0.f;
        f32x16 o[2];
#pragma unroll
        for (int i = 0; i < 16; ++i) { o[0][i] = 0.f; o[1][i] = 0.f; }
        const int jfirst = (q0 - 511) > 0 ? ((q0 - 511) >> 6) : 0;
        const int jlast = (q0 + 31) >> 6;
        flash_run<0, false>(jfirst, [&](int c) { return c + 1 <= jlast ? c + 1 : -1; },
                            [&](int j, int r, const u16*& kp, const u16*& vp) {
                                const u16* rp = brow + (long)(64 * j + r) * IN_COLS + C_NKV;
                                kp = rp + (4 * 2 + g) * 64;
                                vp = rp + (5 * 2 + g) * 64;
                            },
                            [&](int j, int& lo, int& hl, u64& word) { lo = tl - 511 - 64 * j; hl = tl - 64 * j; word = 0; },
                            [&](int, f32x16&, f32x16&) {}, qr, m, l, o, bufs, w, lane);
        const float sc = l > 0.f ? gate_w / l : 0.f;
#pragma unroll
        for (int i = 0; i < 16; ++i) { tot[0][i] += sc * o[0][i]; tot[1][i] += sc * o[1][i]; }
    }
    {
        u16* orow = ya + ((long)b * SEQ + tl) * 512 + (g * 4 + rep) * 64;
#pragma unroll
        for (int dh = 0; dh < 2; ++dh)
#pragma unroll
            for (int a = 0; a < 4; ++a) {
                uint2 v = uint2{pack2(tot[dh][4 * a], tot[dh][4 * a + 1]), pack2(tot[dh][4 * a + 2], tot[dh][4 * a + 3])};
                *(uint2*)(orow + dh * 32 + 8 * a + 4 * hi) = v;
            }
    }
}

__device__ __forceinline__ void dsa_select_unit(unsigned char* ws, int unit, unsigned char* smem, unsigned long long& tacc) {
    const int tid = tidx(), lane = tid & 63, w = tid >> 6;
    const int t0 = unit * 4;
    const int b = t0 / SEQ, tl0 = t0 - b * SEQ;
    const u16* proj = (const u16*)(ws + OFF_PROJ);
    const u16* brow = proj + (long)b * SEQ * IN_COLS;
    u64* bits = (u64*)(ws + OFF_BITS);
    float* sc = (float*)smem;
    __syncthreads();
    unsigned long long ts0 = SEC_T();
#ifndef ATTA_REP_IDX
#define ATTA_REP_IDX 1
#endif
#ifndef ATTA_REP_TOPK
#define ATTA_REP_TOPK 1
#endif
    for (int rep_ = 0; rep_ < ATTA_REP_IDX; ++rep_) {
        const int r16 = lane & 15, g4 = lane >> 4;
        bf16x8 af[2][2];
#pragma unroll
        for (int rb = 0; rb < 2; ++rb)
#pragma unroll
            for (int ks = 0; ks < 2; ++ks)
                af[rb][ks] = *(const bf16x8*)(proj + (long)(t0 + 2 * rb + (r16 >> 3)) * IN_COLS + C_IQ + (r16 & 7) * 64 + ks * 32 + g4 * 8);
        float wq[2][4];
#pragma unroll
        for (int rb = 0; rb < 2; ++rb)
#pragma unroll
            for (int i = 0; i < 4; ++i)
                wq[rb][i] = bf2f(proj[(long)(t0 + 2 * rb + (g4 >> 1)) * IN_COLS + C_IW + (g4 & 1) * 4 + i]) * 0.35355339059327373f;
        const int ntiles = (tl0 + 4 + 31) >> 5;
#define IDX_LD(T, B)                                                                                         \
    do {                                                                                                     \
        _Pragma("unroll") for (int kt = 0; kt < 2; ++kt) {                                                   \
            int key_ = (T) * 32 + kt * 16 + r16;                                                             \
            key_ = key_ < SEQ ? key_ : SEQ - 1;                                                              \
            _Pragma("unroll") for (int ks = 0; ks < 2; ++ks)                                                 \
                B[kt][ks] = *(const bf16x8*)(brow + (long)key_ * IN_COLS + C_IK + ks * 32 + g4 * 8);         \
        }                                                                                                    \
    } while (0)
        asm volatile("" ::"v"(af[0][0]), "v"(af[0][1]), "v"(af[1][0]), "v"(af[1][1]));
        asm volatile("" ::"v"(wq[0][0]), "v"(wq[0][1]), "v"(wq[0][2]), "v"(wq[0][3]), "v"(wq[1][0]), "v"(wq[1][1]), "v"(wq[1][2]), "v"(wq[1][3]));
        bf16x8 bn[2][2];
        if (w < ntiles) IDX_LD(w, bn);
        for (int tile = w; tile < ntiles; tile += 4) {
            bf16x8 bc[2][2];
#pragma unroll
            for (int kt = 0; kt < 2; ++kt)
#pragma unroll
                for (int ks = 0; ks < 2; ++ks) bc[kt][ks] = bn[kt][ks];
            if (tile + 4 < ntiles) IDX_LD(tile + 4, bn);
#pragma unroll
            for (int rb = 0; rb < 2; ++rb)
#pragma unroll
                for (int kt = 0; kt < 2; ++kt) {
                    f32x4 acc = f32x4{0.f, 0.f, 0.f, 0.f};
                    acc = __builtin_amdgcn_mfma_f32_16x16x32_bf16(af[rb][0], bc[kt][0], acc, 0, 0, 0);
                    acc = __builtin_amdgcn_mfma_f32_16x16x32_bf16(af[rb][1], bc[kt][1], acc, 0, 0, 0);
                    float part = 0.f;
#pragma unroll
                    for (int i = 0; i < 4; ++i) part += wq[rb][i] * fmaxf(acc[i], 0.f);
                    auto sw = __builtin_amdgcn_permlane16_swap(__float_as_uint(part), __float_as_uint(part), false, false);
                    const float tot = __uint_as_float(sw[0]) + __uint_as_float(sw[1]);
                    if ((g4 & 1) == 0) sc[(2 * rb + (g4 >> 1)) * 4096 + tile * 32 + kt * 16 + r16] = tot;
                }
        }
#undef IDX_LD
    }
    __syncthreads();
    SEC_ADD(1, ts0);
    ts0 = SEC_T();
    const int t = t0 + w;
    const int tl = tl0 + w;
    const int nvalid = tl + 1;
    for (int rep_ = 0; rep_ < ATTA_REP_TOPK; ++rep_) {
        u32 u[64];
        const float* scq = sc + w * 4096;
#pragma unroll
        for (int j = 0; j < 64; ++j) {
            const int key = j * 64 + lane;
            const u32 kk = sortkey(scq[key]);
            u[j] = (key <= tl) ? kk : 0u;
        }
        SEC_ADD(2, ts0);
        ts0 = SEC_T();
        u32 K = 0;
        int need = 0, ceq = 0;
        if (nvalid > 256) {
            u32 lm0 = u[0], lm1 = u[1], lm2 = u[2], lm3 = u[3];
#pragma unroll
            for (int j = 4; j < 64; j += 4) { lm0 = max(lm0, u[j]); lm1 = max(lm1, u[j + 1]); lm2 = max(lm2, u[j + 2]); lm3 = max(lm3, u[j + 3]); }
            u32 lo = min(min(lm0, lm1), min(lm2, lm3)), hiu = max(max(lm0, lm1), max(lm2, lm3));
            lo = row_min16u(lo);
            hiu = row_max16u(hiu);
            const u32 L = min(min((u32)__builtin_amdgcn_readlane((int)lo, 0), (u32)__builtin_amdgcn_readlane((int)lo, 16)),
                              min((u32)__builtin_amdgcn_readlane((int)lo, 32), (u32)__builtin_amdgcn_readlane((int)lo, 48)));
            const u32 U = max(max((u32)__builtin_amdgcn_readlane((int)hiu, 0), (u32)__builtin_amdgcn_readlane((int)hiu, 16)),
                              max((u32)__builtin_amdgcn_readlane((int)hiu, 32), (u32)__builtin_amdgcn_readlane((int)hiu, 48)));
            const u32 dd = U ^ L;
            const int hb = dd ? 31 - __clz((int)dd) : -1;
            K = dd ? (U & ~((2u << hb) - 1u)) : U;
            bool exact = false;
            for (int bit = hb; bit >= 0; --bit) {
                const u32 cand = K | (1u << bit);
                int cl = 0;
#pragma unroll
                for (int j = 0; j < 64; ++j) cl += (u[j] >= cand) ? 1 : 0;
                const int cnt = wsumi(cl);
                if (cnt >= 256) K = cand;
                if (cnt == 256) { exact = true; break; }
            }
            if (exact) {
                need = 1; ceq = 1;
            } else {
                int cgt = 0, ce = 0;
#pragma unroll
                for (int j = 0; j < 64; ++j) { cgt += __popcll(__ballot(u[j] > K)); ce += __popcll(__ballot(u[j] == K)); }
                need = 256 - cgt;
                ceq = ce;
            }
        }
        SEC_ADD(3, ts0);
        ts0 = SEC_T();
        const u64 ltmask = (1ull << lane) - 1ull;
        u64 myword = 0;
        if (nvalid <= 256 || need == ceq) {
            const u32 Kt = (nvalid > 256) ? K : 1u;
#pragma unroll
            for (int j = 0; j < 64; ++j) {
                const u64 sm = __ballot(u[j] >= Kt);
                myword = (lane == j) ? sm : myword;
            }
        } else {
            int ebase = 0;
#pragma unroll
            for (int j = 0; j < 64; ++j) {
                bool eq = (u[j] == K);
                u64 em = __ballot(eq);
                int erank = ebase + __popcll(em & ltmask);
                bool take = (u[j] > K) || (eq && erank < need);
                ebase += __popcll(em);
                u64 sm = __ballot(take);
                myword = (lane == j) ? sm : myword;
            }
        }
        bits[(long)t * 64 + lane] = myword;
        SEC_ADD(4, ts0);
    }
}

__device__ __forceinline__ void dsa_attn_unit(unsigned char* ws, int b, int qt, unsigned char* smem) {
    const int tid = tidx(), lane = tid & 63, w = tid >> 6;
    const int r32 = lane & 31, hi = lane >> 5;
    const int q0 = qt * 16;
    const int qloc = 4 * w + (r32 >> 3);
    const int tl = q0 + qloc;
    const int head = r32 & 7;
    const u16* proj = (const u16*)(ws + OFF_PROJ);
    const u16* brow = proj + (long)b * SEQ * IN_COLS;
    const u64* bits = (const u64*)(ws + OFF_BITS) + ((long)b * SEQ + q0) * 64;
    u16* yb = (u16*)(ws + OFF_YAB) + (size_t)NTOK * 512;
    unsigned char* bufs = smem;
    u64* lbits = (u64*)(smem + 49152);
    __syncthreads();
    for (int i = tid; i < 16 * 64; i += 256) lbits[i] = bits[i];
    const u16* trow = brow + (long)tl * IN_COLS;
    bf16x8 qr[4];
#pragma unroll
    for (int d0 = 0; d0 < 4; ++d0) qr[d0] = *(const bf16x8*)(trow + C_DQ + head * 64 + d0 * 16 + hi * 8);
    float m = -1e30f, l = 0.f;
    f32x16 o[2];
#pragma unroll
    for (int i = 0; i < 16; ++i) { o[0][i] = 0.f; o[1][i] = 0.f; }
    const int jlast = (q0 + 15) >> 6;
    flash_run<0, true>(0, [&](int c) { return c + 1 <= jlast ? c + 1 : -1; },
                       [&](int j, int r, const u16*& kp, const u16*& vp) {
                           const u16* rp = brow + (long)(64 * j + r) * IN_COLS + C_DKV;
                           kp = rp;
                           vp = rp + 64;
                       },
                       [&](int j, int& lo, int& hl, u64& word) { lo = 0; hl = 0; word = lbits[qloc * 64 + j]; },
                       [&](int, f32x16&, f32x16&) {}, qr, m, l, o, bufs, w, lane);
    const float inv = l > 0.f ? 1.0f / l : 0.f;
    u16* orow = yb + ((long)b * SEQ + tl) * 512 + head * 64;
#pragma unroll
    for (int dh = 0; dh < 2; ++dh)
#pragma unroll
        for (int a = 0; a < 4; ++a) {
            uint2 v = uint2{pack2(o[dh][4 * a] * inv, o[dh][4 * a + 1] * inv), pack2(o[dh][4 * a + 2] * inv, o[dh][4 * a + 3] * inv)};
            *(uint2*)(orow + dh * 32 + 8 * a + 4 * hi) = v;
        }
}

__device__ __forceinline__ int grab_block(unsigned* ctr, int limit, unsigned char* smem) {
    volatile int* slot = (volatile int*)(smem + LDS_BYTES + 8);
    __syncthreads();
    if (threadIdx.x == 0) *slot = (int)__hip_atomic_fetch_add(ctr, 1u, __ATOMIC_RELAXED, __HIP_MEMORY_SCOPE_AGENT);
    __syncthreads();
    const int v = *slot;
    return v < limit ? v : -1;
}
__device__ __forceinline__ int grab_wave(unsigned* ctr, int limit) {
    int v = 0;
    if ((threadIdx.x & 63) == 0) v = (int)__hip_atomic_fetch_add(ctr, 1u, __ATOMIC_RELAXED, __HIP_MEMORY_SCOPE_AGENT);
    v = __builtin_amdgcn_readfirstlane(v);
    return v < limit ? v : -1;
}

typedef u32 u32x6_t __attribute__((ext_vector_type(6)));
typedef float f32x32_t __attribute__((ext_vector_type(32)));
typedef __bf16 bf16x32_t __attribute__((ext_vector_type(32)));
typedef __bf16 bf16x2_t __attribute__((ext_vector_type(2)));
#define PE_LD(Q, TB, E0)                                                                      \
    do {                                                                                      \
        asm volatile("" ::: "memory");                                                        \
        const int idv_ = ((E0) < 64) ? id0 : id1;     \
        _Pragma("unroll") for (int k_ = 0; k_ < 4; ++k_) {                                    \
            const int id_ = __builtin_amdgcn_readlane(idv_, ((E0) + k_) & 63);                \
            Q[k_] = *(const u32x3_a4*)((TB) + (long)id_ * EROW + lane * 12);                  \
        }                                                                                     \
        asm volatile("" ::: "memory");                                                        \
    } while (0)
#define PE_NOPA "s_nop 3\n\t"
#define PE_NOPB "s_nop 7\n\t"
#define PE_DOT(Q, PB)                                                                         \
    do {                                                                                      \
        _Pragma("unroll") for (int k_ = 0; k_ < 4; k_ += 2) {                                 \
            const u32x6_t ab_ = {Q[k_][0], Q[k_][1], Q[k_][2], Q[k_ + 1][0], Q[k_ + 1][1], Q[k_ + 1][2]}; \
            f32x2_t d0_, d1_;                                                                 \
            asm volatile(PE_NOPA "v_cvt_scalef32_pk32_f32_fp6 v[200:231], %[ab], 1.0\n\t" PE_NOPB \
                "v_pk_mul_f32 %[d0], %[h0], v[200:201]\n\t" \
                "v_pk_mul_f32 %[d1], %[h0], v[216:217]\n\t" \
                "v_pk_fma_f32 %[d0], %[h1], v[202:203], %[d0]\n\t" \
                "v_pk_fma_f32 %[d1], %[h1], v[218:219], %[d1]\n\t" \
                "v_pk_fma_f32 %[d0], %[h2], v[204:205], %[d0]\n\t" \
                "v_pk_fma_f32 %[d1], %[h2], v[220:221], %[d1]\n\t" \
                "v_pk_fma_f32 %[d0], %[h3], v[206:207], %[d0]\n\t" \
                "v_pk_fma_f32 %[d1], %[h3], v[222:223], %[d1]\n\t" \
                "v_pk_fma_f32 %[d0], %[h4], v[208:209], %[d0]\n\t" \
                "v_pk_fma_f32 %[d1], %[h4], v[224:225], %[d1]\n\t" \
                "v_pk_fma_f32 %[d0], %[h5], v[210:211], %[d0]\n\t" \
                "v_pk_fma_f32 %[d1], %[h5], v[226:227], %[d1]\n\t" \
                "v_pk_fma_f32 %[d0], %[h6], v[212:213], %[d0]\n\t" \
                "v_pk_fma_f32 %[d1], %[h6], v[228:229], %[d1]\n\t" \
                "v_pk_fma_f32 %[d0], %[h7], v[214:215], %[d0]\n\t" \
                "v_pk_fma_f32 %[d1], %[h7], v[230:231], %[d1]\n\t" \
                ""                                                            \
                : [d0] "=&v"(d0_), [d1] "=&v"(d1_)                                            \
                : [ab] "v"(ab_), [h0] "v"(hf2[0]), [h1] "v"(hf2[1]), [h2] "v"(hf2[2]), [h3] "v"(hf2[3]), \
                  [h4] "v"(hf2[4]), [h5] "v"(hf2[5]), [h6] "v"(hf2[6]), [h7] "v"(hf2[7])      \
                : "v200", "v201", "v202", "v203", "v204", "v205", "v206", "v207", "v208", "v209", "v210", "v211", "v212", "v213", "v214", "v215", "v216", "v217", "v218", "v219", "v220", "v221", "v222", "v223", "v224", "v225", "v226", "v227", "v228", "v229", "v230", "v231");                                                         \
            pp[(PB) + k_] = d0_[0] + d0_[1];                                                  \
            pp[(PB) + k_ + 1] = d1_[0] + d1_[1];                                              \
        }                                                                                     \
    } while (0)
#define PE_AXPY(Q, E0)                                                                        \
    do {                                                                                      \
        const int av_ = __float_as_int(((E0) < 64) ? act0 : act1);                            \
        _Pragma("unroll") for (int k_ = 0; k_ < 4; k_ += 2) {                                 \
            const unsigned long long a_ = (u32)__builtin_amdgcn_readlane(av_, ((E0) + k_) & 63);      \
            const unsigned long long b_ = (u32)__builtin_amdgcn_readlane(av_, ((E0) + k_ + 1) & 63);  \
            const u32x6_t ab_ = {Q[k_][0], Q[k_][1], Q[k_][2], Q[k_ + 1][0], Q[k_ + 1][1], Q[k_ + 1][2]}; \
            asm volatile(PE_NOPA "v_cvt_scalef32_pk32_f32_fp6 v[200:231], %[ab], 1.0\n\t" PE_NOPB \
                "v_pk_fma_f32 %[c0], v[200:201], %[a], %[c0] op_sel_hi:[1,0,1]\n\t" \
                "v_pk_fma_f32 %[c1], v[202:203], %[a], %[c1] op_sel_hi:[1,0,1]\n\t" \
                "v_pk_fma_f32 %[c2], v[204:205], %[a], %[c2] op_sel_hi:[1,0,1]\n\t" \
                "v_pk_fma_f32 %[c3], v[206:207], %[a], %[c3] op_sel_hi:[1,0,1]\n\t" \
                "v_pk_fma_f32 %[c4], v[208:209], %[a], %[c4] op_sel_hi:[1,0,1]\n\t" \
                "v_pk_fma_f32 %[c5], v[210:211], %[a], %[c5] op_sel_hi:[1,0,1]\n\t" \
                "v_pk_fma_f32 %[c6], v[212:213], %[a], %[c6] op_sel_hi:[1,0,1]\n\t" \
                "v_pk_fma_f32 %[c7], v[214:215], %[a], %[c7] op_sel_hi:[1,0,1]\n\t" \
                "v_pk_fma_f32 %[c0], v[216:217], %[b], %[c0] op_sel_hi:[1,0,1]\n\t" \
                "v_pk_fma_f32 %[c1], v[218:219], %[b], %[c1] op_sel_hi:[1,0,1]\n\t" \
                "v_pk_fma_f32 %[c2], v[220:221], %[b], %[c2] op_sel_hi:[1,0,1]\n\t" \
                "v_pk_fma_f32 %[c3], v[222:223], %[b], %[c3] op_sel_hi:[1,0,1]\n\t" \
                "v_pk_fma_f32 %[c4], v[224:225], %[b], %[c4] op_sel_hi:[1,0,1]\n\t" \
                "v_pk_fma_f32 %[c5], v[226:227], %[b], %[c5] op_sel_hi:[1,0,1]\n\t" \
                "v_pk_fma_f32 %[c6], v[228:229], %[b], %[c6] op_sel_hi:[1,0,1]\n\t" \
                "v_pk_fma_f32 %[c7], v[230:231], %[b], %[c7] op_sel_hi:[1,0,1]\n\t" \
                ""                                                   \
                : [c0] "+v"(acc2[0]), [c1] "+v"(acc2[1]), [c2] "+v"(acc2[2]), [c3] "+v"(acc2[3]), \
                  [c4] "+v"(acc2[4]), [c5] "+v"(acc2[5]), [c6] "+v"(acc2[6]), [c7] "+v"(acc2[7]) \
                : [ab] "v"(ab_), [a] "s"(a_), [b] "s"(b_)                                     \
                : "v200", "v201", "v202", "v203", "v204", "v205", "v206", "v207", "v208", "v209", "v210", "v211", "v212", "v213", "v214", "v215", "v216", "v217", "v218", "v219", "v220", "v221", "v222", "v223", "v224", "v225", "v226", "v227", "v228", "v229", "v230", "v231");                                                         \
        }                                                                                     \
    } while (0)
template <int CTRL>
__device__ __forceinline__ float comb_q(float A, float B, bool bit) {
    const float keep = bit ? B : A, send = bit ? A : B;
    return keep + dpp_qf<CTRL>(send);
}
__device__ __forceinline__ float comb_x(float A, float B, bool bit, int xr) {
    const float keep = bit ? B : A, send = bit ? A : B;
    return keep + __shfl_xor(send, xr);
}
__device__ __forceinline__ float reduce32(float (&pp)[32], int lane) {
    const bool b0 = lane & 1, b1 = lane & 2, b2 = lane & 4, b3 = lane & 8;
#pragma unroll
    for (int j = 0; j < 16; ++j) pp[j] = comb_q<0xB1>(pp[2 * j], pp[2 * j + 1], b0);
#pragma unroll
    for (int j = 0; j < 8; ++j) pp[j] = comb_q<0x4E>(pp[2 * j], pp[2 * j + 1], b1);
#pragma unroll
    for (int j = 0; j < 4; ++j) pp[j] = comb_x(pp[2 * j], pp[2 * j + 1], b2, 4);
#pragma unroll
    for (int j = 0; j < 2; ++j) pp[j] = comb_x(pp[2 * j], pp[2 * j + 1], b3, 8);
    auto sw = __builtin_amdgcn_permlane16_swap(__float_as_uint(pp[0]), __float_as_uint(pp[1]), false, false);
    return xhalf_sum(__uint_as_float(sw[0]) + __uint_as_float(sw[1]));
}
__device__ __forceinline__ void peer_experts_range(unsigned char* ws_, float* xout_, const float* ffn_g, int tbeg, int tend) {
    unsigned char* ws = opq(ws_);
    float* xout = opq(xout_);
    const int lane = tidx() & 63;
    const u16* hbuf = (const u16*)(ws + OFF_YAB);
    const float* ss1 = (const float*)(ws + OFF_SS1);
    const unsigned char* ub = ws + OFF_UB;
    const unsigned char* vb = ws + OFF_VB;
    const int* eidx = (const int*)(ws + OFF_EIDX);
    const float* gate = (const float*)(ws + OFF_GATE);
    const float* usc = (const float*)(ws + OFF_ESC);
    const float* vsc = usc + NEXP;
    int t = tbeg;
    int id0 = 0, id1 = 0;
    float gr0 = 0.f, gr1 = 0.f;
    uint4 h0 = uint4{0u, 0u, 0u, 0u}, h1 = h0;
    u32x3_t ua[4], ubq[4];
    if (t < tend) {
        id0 = eidx[(long)t * 128 + lane]; id1 = eidx[(long)t * 128 + 64 + lane];
        gr0 = gate[(long)t * 128 + lane]; gr1 = gate[(long)t * 128 + 64 + lane];
        h0 = *(const uint4*)(hbuf + (long)t * 1024 + lane * 16);
        h1 = *(const uint4*)(hbuf + (long)t * 1024 + lane * 16 + 8);
        PE_LD(ua, ub, 0);
    }
    while (t < tend) {
        const float g0 = gr0 * vsc[id0], g1 = gr1 * vsc[id1];
        const float s0 = usc[id0], s1 = usc[id1];
        float* xr = xout + (long)t * 1024 + lane * 16;
        const float rs1 = rsqrtf(sum16(ss1 + (long)t * 16) * (1.0f / 1024.0f) + EPS);
        f32x2_t hf2[8];
        hf2[0] = f32x2_t{bf_lo(h0.x), bf_hi(h0.x)}; hf2[1] = f32x2_t{bf_lo(h0.y), bf_hi(h0.y)};
        hf2[2] = f32x2_t{bf_lo(h0.z), bf_hi(h0.z)}; hf2[3] = f32x2_t{bf_lo(h0.w), bf_hi(h0.w)};
        hf2[4] = f32x2_t{bf_lo(h1.x), bf_hi(h1.x)}; hf2[5] = f32x2_t{bf_lo(h1.y), bf_hi(h1.y)};
        hf2[6] = f32x2_t{bf_lo(h1.z), bf_hi(h1.z)}; hf2[7] = f32x2_t{bf_lo(h1.w), bf_hi(h1.w)};
        const int tn = t + 1;
        int idn0 = 0, idn1 = 0;
        float gn0 = 0.f, gn1 = 0.f;
        uint4 hn0 = uint4{0u, 0u, 0u, 0u}, hn1 = hn0;
        if (tn < tend) {
            idn0 = eidx[(long)tn * 128 + lane]; idn1 = eidx[(long)tn * 128 + 64 + lane];
            gn0 = gate[(long)tn * 128 + lane]; gn1 = gate[(long)tn * 128 + 64 + lane];
            hn0 = *(const uint4*)(hbuf + (long)tn * 1024 + lane * 16);
            hn1 = *(const uint4*)(hbuf + (long)tn * 1024 + lane * 16 + 8);
        }
        float dq0 = 0.f, dq1 = 0.f, dq2 = 0.f, dq3 = 0.f;
        for (int gq = 0; gq < 4; ++gq) {
            const int e = 32 * gq;
            float pp[32];
#pragma unroll
            for (int q4 = 0; q4 < 32; q4 += 8) {
                PE_LD(ubq, ub, e + q4 + 4);
                PE_DOT(ua, q4);
                if (q4 + 8 < 32 || gq < 3) PE_LD(ua, ub, e + q4 + 8);
                else PE_LD(ua, vb, 0);
                PE_DOT(ubq, q4 + 4);
            }
            const float r = reduce32(pp, lane);
            dq0 = gq == 0 ? r : dq0;
            dq1 = gq == 1 ? r : dq1;
            dq2 = gq == 2 ? r : dq2;
            dq3 = gq == 3 ? r : dq3;
        }
        const float act0 = gelu_tanh((lane < 32 ? dq0 : dq1) * (s0 * rs1)) * g0;
        const float act1 = gelu_tanh((lane < 32 ? dq2 : dq3) * (s1 * rs1)) * g1;
        f32x2_t acc2[8];
#pragma unroll
        for (int i = 0; i < 8; ++i) acc2[i] = f32x2_t{0.f, 0.f};
        for (int b = 0; b < 32; b += 2) {
            PE_LD(ubq, vb, 4 * (b + 1));
            PE_AXPY(ua, 4 * b);
            if (b + 2 < 32) {
                PE_LD(ua, vb, 4 * (b + 2));
            } else if (tn < tend) {
                id0 = idn0; id1 = idn1;
                PE_LD(ua, ub, 0);
            }
            PE_AXPY(ubq, 4 * (b + 1));
        }
        float ss = 0.f;
        u32 pk[8];
#pragma unroll
        for (int i = 0; i < 4; ++i) {
            float4 a = *(const float4*)(xr + 4 * i);
            a.x += acc2[2 * i][0]; a.y += acc2[2 * i][1]; a.z += acc2[2 * i + 1][0]; a.w += acc2[2 * i + 1][1];
            *(float4*)(xr + 4 * i) = a;
            ss += a.x * a.x + a.y * a.y + a.z * a.z + a.w * a.w;
            pk[2 * i] = pack2(a.x, a.y);
            pk[2 * i + 1] = pack2(a.z, a.w);
        }
        u16* hw = (u16*)(ws + OFF_YAB) + (long)t * 1024 + lane * 16;
        *(uint4*)hw = uint4{pk[0], pk[1], pk[2], pk[3]};
        *(uint4*)(hw + 8) = uint4{pk[4], pk[5], pk[6], pk[7]};
        ss = wsum(ss);
        if (lane == 0) ((float*)(ws + OFF_RSTDE))[t] = rsqrtf(ss * (1.0f / 1024.0f) + EPS);
        t = tn; id0 = idn0; id1 = idn1; gr0 = gn0; gr1 = gn1; h0 = hn0; h1 = hn1;
    }
}

__device__ __forceinline__ u32 search_bounds(u32 lanemax, int& hb) {
    const u32 U = row_max16u(lanemax), L = row_min16u(lanemax);
    const u32 d = U ^ L;
    hb = d ? 31 - __clz((int)d) : -1;
    return d ? (U & ~((2u << hb) - 1u)) : U;
}
__device__ __forceinline__ void peer_route(unsigned char* ws, float* xout, const float* ffn_g, int layer, unsigned char* smem, unsigned long long& tacc) {
    const int tid = tidx(), lane = tid & 63, w = tid >> 6;
    const int grp = lane >> 4, k = lane & 15;
    const u32 ltk = (1u << k) - 1u;
    float* tvc = (float*)(smem + w * 4096);
    int* tic = (int*)(smem + w * 4096 + 2048);
    unsigned* rctr = (unsigned*)(ws + OFF_CTR) + (layer * 8 + 3) * 8;
    for (int unit; (unit = grab_wave(rctr, NTOK / 16)) >= 0;) {
        const int tok0 = unit * 16;
        unsigned char* wsu = opq(ws);
        const u16* pq = (const u16*)(wsu + OFF_PQ);
        const u16* skb = (const u16*)(wsu + OFF_W + layer * W_LAYER + WO_SK);
        int* eidx = (int*)(wsu + OFF_EIDX);
        float* gate = (float*)(wsu + OFF_GATE);
        for (int h = 0; h < 8; ++h) {
            for (int half = 0; half < 2; ++half) {
                unsigned long long tr0 = SEC_T();
                bf16x8 af[4];
#pragma unroll
                for (int ks = 0; ks < 4; ++ks)
                    af[ks] = *(const bf16x8*)(pq + (long)(tok0 + k) * 2048 + h * 256 + half * 128 + ks * 32 + grp * 8);
                float sc[8][4];
                u32 u[8][4];
#pragma unroll
                for (int nt = 0; nt < 8; ++nt) {
                    f32x4 acc = f32x4{0.f, 0.f, 0.f, 0.f};
#pragma unroll
                    for (int ks = 0; ks < 4; ++ks) {
                        bf16x8 bfr = *(const bf16x8*)(skb + (size_t)half * 128 * 128 + (size_t)(nt * 16 + k) * 128 + ks * 32 + grp * 8);
                        acc = __builtin_amdgcn_mfma_f32_16x16x32_bf16(af[ks], bfr, acc, 0, 0, 0);
                    }
#pragma unroll
                    for (int i = 0; i < 4; ++i) { sc[nt][i] = acc[i]; u[nt][i] = sortkey(acc[i]); }
                }
                SEC_ADD(11, tr0);
                tr0 = SEC_T();
                u32 K[4];
                bool dn[4] = {false, false, false, false};
                int hbm = -1;
#pragma unroll
                for (int i = 0; i < 4; ++i) {
                    u32 lm = u[0][i];
#pragma unroll
                    for (int nt = 1; nt < 8; ++nt) lm = max(lm, u[nt][i]);
                    int hb;
                    K[i] = search_bounds(lm, hb);
                    hbm = max(hbm, hb);
                }
                const int bit0 = (int)wmax((float)hbm);
                for (int bit = bit0; bit >= 0; --bit) {
                    int packed = 0;
#pragma unroll
                    for (int i = 0; i < 4; ++i) {
                        const u32 cand = K[i] | (1u << bit);
                        int c = 0;
#pragma unroll
                        for (int nt = 0; nt < 8; ++nt) c += (u[nt][i] >= cand) ? 1 : 0;
                        packed |= c << (8 * i);
                    }
                    packed = row_sum16i(packed);
#pragma unroll
                    for (int i = 0; i < 4; ++i)
                        if (((packed >> (8 * i)) & 0xFF) >= 16) K[i] |= (1u << bit);
                    bool done = true;
#pragma unroll
                    for (int i = 0; i < 4; ++i) {
                        const int ci = (packed >> (8 * i)) & 0xFF;
                        done = done && (ci == 16 || dn[i]);
                        dn[i] = dn[i] || (ci == 16);
                    }
                    if (__all(done)) break;
                }
                SEC_ADD(12, tr0);
                tr0 = SEC_T();
                int need[4];
                {
                    int packed = 0;
#pragma unroll
                    for (int i = 0; i < 4; ++i) {
                        int c = 0;
#pragma unroll
                        for (int nt = 0; nt < 8; ++nt) c += (u[nt][i] > K[i]) ? 1 : 0;
                        packed |= c << (8 * i);
                    }
                    packed = row_sum16i(packed);
#pragma unroll
                    for (int i = 0; i < 4; ++i) need[i] = 16 - ((packed >> (8 * i)) & 0xFF);
                }
#pragma unroll
                for (int i = 0; i < 4; ++i) {
                    int ebase = 0, pbase = 0;
                    const int tok = 4 * grp + i;
#pragma unroll
                    for (int nt = 0; nt < 8; ++nt) {
                        const bool eq = (u[nt][i] == K[i]);
                        const u32 emg = (u32)(__ballot(eq) >> (lane & 48)) & 0xFFFFu;
                        const int erank = ebase + __popc(emg & ltk);
                        const bool take = (u[nt][i] > K[i]) || (eq && erank < need[i]);
                        ebase += __popc(emg);
                        const u32 tmg = (u32)(__ballot(take) >> (lane & 48)) & 0xFFFFu;
                        const int pos = pbase + __popc(tmg & ltk);
                        if (take) {
                            tvc[(half * 16 + tok) * 16 + pos] = sc[nt][i];
                            tic[(half * 16 + tok) * 16 + pos] = nt * 16 + k;
                        }
                        pbase += __popc(tmg);
                    }
                }
                SEC_ADD(13, tr0);
            }
            WAVE_SYNC();
            unsigned long long tr2 = SEC_T();
            for (int pass = 0; pass < 4; ++pass) {
                const int tok = 4 * pass + grp;
                const float v1 = tvc[(0 * 16 + tok) * 16 + k];
                const int i1 = tic[(0 * 16 + tok) * 16 + k];
                float c[16];
                u32 uc[16];
#pragma unroll
                for (int r4 = 0; r4 < 4; ++r4) {
                    float4 v2 = *(const float4*)(tvc + (1 * 16 + tok) * 16 + r4 * 4);
                    c[r4 * 4 + 0] = v1 + v2.x;
                    c[r4 * 4 + 1] = v1 + v2.y;
                    c[r4 * 4 + 2] = v1 + v2.z;
                    c[r4 * 4 + 3] = v1 + v2.w;
                }
                float mxl = c[0];
#pragma unroll
                for (int r = 0; r < 16; ++r) { uc[r] = sortkey(c[r]); mxl = fmaxf(mxl, c[r]); }
                const float mx = row_max16f(mxl);
                int hbc;
                u32 Kc = search_bounds(sortkey(mxl), hbc);
                bool dnc = false;
                const int bitc0 = (int)wmax((float)hbc);
                for (int bit = bitc0; bit >= 0; --bit) {
                    const u32 cand = Kc | (1u << bit);
                    int cn = 0;
#pragma unroll
                    for (int r = 0; r < 16; ++r) cn += (uc[r] >= cand) ? 1 : 0;
                    cn = row_sum16i(cn);
                    if (cn >= 16) Kc = cand;
                    dnc = dnc || (cn == 16);
                    if (__all(dnc)) break;
                }
                int cgl = 0, cel = 0;
#pragma unroll
                for (int r = 0; r < 16; ++r) { cgl += (uc[r] > Kc) ? 1 : 0; cel += (uc[r] == Kc) ? 1 : 0; }
                const int needc = 16 - row_sum16i(cgl);
                const int ebefore = row_xscan16i(cel);
                int tl_ = 0, el_ = 0;
                u32 takem = 0u;
                float ex[16];
                float sl = 0.f;
#pragma unroll
                for (int r = 0; r < 16; ++r) {
                    const bool eq = (uc[r] == Kc);
                    const bool tk = (uc[r] > Kc) || (eq && (ebefore + el_) < needc);
                    el_ += eq ? 1 : 0;
                    tl_ += tk ? 1 : 0;
                    takem |= tk ? (1u << r) : 0u;
                    ex[r] = tk ? __expf(c[r] - mx) : 0.f;
                    sl += ex[r];
                }
                const float inv = 1.0f / row_sum16f(sl);
                int pos = row_xscan16i(tl_);
                const long obase = (long)(tok0 + tok) * 128 + h * 16;
                int i2v[16];
#pragma unroll
                for (int r4 = 0; r4 < 4; ++r4) {
                    const int4 q = *(const int4*)(tic + (1 * 16 + tok) * 16 + r4 * 4);
                    i2v[r4 * 4 + 0] = q.x; i2v[r4 * 4 + 1] = q.y; i2v[r4 * 4 + 2] = q.z; i2v[r4 * 4 + 3] = q.w;
                }
#pragma unroll
                for (int r = 0; r < 16; ++r) {
                    if ((takem >> r) & 1u) {
                        const int eid = i1 * 128 + i2v[r];
                        eidx[obase + pos] = eid;
                        gate[obase + pos] = ex[r] * inv;
                        ++pos;
                    }
                }
            }
            SEC_ADD(14, tr2);
            WAVE_SYNC();
        }
        asm volatile("s_waitcnt vmcnt(0)" ::: "memory");
        peer_experts_range(ws, xout, ffn_g, tok0, tok0 + 16);
    }
}

__device__ __forceinline__ void phase_prep(const Params& P, unsigned char* smem) {
    unsigned char* ws = opq(P.ws);
    const long gtid = (long)bidx() * 256 + tidx();
    const long gthreads = (long)gdim() * 256;
    for (int l = 0; l < 2; ++l) {
        unsigned char* wl = ws + OFF_W + l * W_LAYER;
        float* tile = (float*)smem;
        transpose_cvt<true>(P.w_in + (size_t)l * 1024 * IN_COLS, (u16*)(wl + WO_WIN), 1024, IN_COLS, tile, P.attn_norm + l * 1024);
        for (int c = 0; c < 2; ++c) {
            transpose_cvt(P.cmp_w1 + ((size_t)l * 2 + c) * 2048 * 256, (u16*)(wl + WO_W1) + (size_t)c * 256 * 2048, 2048, 256, tile);
            transpose_cvt(P.cmp_w2 + ((size_t)l * 2 + c) * 256 * 64, (u16*)(wl + WO_W2) + (size_t)c * 64 * 256, 256, 64, tile);
        }
        transpose_cvt(P.w_a + (size_t)l * 512 * 1024, (u16*)(wl + WO_WA), 512, 1024, tile);
        transpose_cvt(P.w_b + (size_t)l * 512 * 1024, (u16*)(wl + WO_WB), 512, 1024, tile);
        transpose_cvt(P.w_out + (size_t)l * 1024 * 1024, (u16*)(wl + WO_WO), 1024, 1024, tile);
        transpose_cvt(P.peer_wq + (size_t)l * 1024 * 2048, (u16*)(wl + WO_WQ), 1024, 2048, tile, P.ffn_norm + l * 1024);
        transpose_cvt(P.ple_w + (size_t)l * 256 * 1024, (u16*)(wl + WO_PW), 256, 1024, tile);
        transpose_cvt(P.ple_gw + (size_t)l * 1024 * 1024, (u16*)(wl + WO_PG), 1024, 1024, tile);
        cvt_f32_bf16(P.peer_sk + (size_t)l * 2 * 128 * 128, (u16*)(wl + WO_SK), 2 * 128 * 128);
    }
    for (int u = bidx(); u < 64; u += gdim()) {
        const int l = u >> 5, c = (u >> 4) & 1, kq = u & 15, col = tidx();
        const float* pos = P.cmp_pos + ((size_t)l * 2 + c) * 2048 + kq * 128;
        const float* w1 = P.cmp_w1 + ((size_t)l * 2 + c) * 2048 * 256 + (size_t)kq * 128 * 256;
        float s = 0.f;
#pragma unroll 16
        for (int k = 0; k < 128; ++k) s += pos[k] * w1[(size_t)k * 256 + col];
        ((float*)(ws + OFF_CHID))[(size_t)u * 256 + col] = s;
    }
    {
        float* ropec = (float*)(ws + OFF_ROPE);
        float* ropes = ropec + (size_t)NTOK * 8;
        for (long i = gtid; i < (long)NTOK * 8; i += gthreads) {
            int t = (int)(i >> 3), k = (int)(i & 7);
            double inv = pow(500000.0, -(double)k / 8.0);
            double ang = (double)P.positions[t] * inv;
            ropec[i] = (float)cos(ang);
            ropes[i] = (float)sin(ang);
        }
    }
    {
        const int lane = tidx() & 63;
        u16* xb = (u16*)(ws + OFF_H);
        float* ssa = (float*)(ws + OFF_SSA);
        for (int row = bidx() * 4 + (tidx() >> 6); row < NTOK; row += gdim() * 4) {
            const float* xr = P.x + (long)row * 1024;
            float ss = 0.f;
#pragma unroll
            for (int i = 0; i < 4; ++i) {
                const float4 v = *(const float4*)(xr + i * 256 + lane * 4);
                ss += v.x * v.x + v.y * v.y + v.z * v.z + v.w * v.w;
                *(uint2*)(xb + (long)row * 1024 + i * 256 + lane * 4) = uint2{pack2(v.x, v.y), pack2(v.z, v.w)};
            }
            ss = wsum(ss);
            if (lane < 16) ssa[(long)row * 16 + lane] = lane == 0 ? ss : 0.f;
        }
    }
}

__device__ __forceinline__ void phase_g1(const Params& P, int layer, unsigned char* smem) {
    unsigned char* ws = opq(P.ws);
    u16* proj = (u16*)(ws + OFF_PROJ);
    const float* ropec = (const float*)(ws + OFF_ROPE);
    const float* ropes = ropec + (size_t)NTOK * 8;
    const float* ng = P.nsa_gain + layer * 256;
    const float* dg = P.dsa_gain + layer * 128;
    if (layer == 0 && bidx() < 4) {
        const int l = bidx() >> 1, c = bidx() & 1, col = tidx();
        const float* part = (const float*)(ws + OFF_CHID) + (size_t)(l * 32 + c * 16) * 256 + col;
        float sacc = 0.f;
#pragma unroll
        for (int kq = 0; kq < 16; ++kq) sacc += part[kq * 256];
        ((float*)(ws + OFF_W + l * W_LAYER + WO_CB))[c * 256 + col] = sacc;
    }
    const float* ssa = (const float*)(ws + OFF_SSA) + (size_t)layer * NTOK * 16;
    gemm_phase_rs<0, true>((const u16*)(ws + OFF_H), 1024, (const u16*)(ws + OFF_W + layer * W_LAYER + WO_WIN), 1024, NTOK, IN_COLS, 1024, smem,
                  [=](int row) { return float2{rsqrtf(sum16(ssa + (long)row * 16) * (1.0f / 1024.0f) + EPS), 0.f}; },
                  [=](int row, int col, const float (&v)[8], float2 rs) {
                      const int c64 = __builtin_amdgcn_readfirstlane(col >> 6), cc = (col >> 3) & 7;
                      const float rsx = rs.x;
                      float o[8];
#pragma unroll
                      for (int j = 0; j < 8; ++j) o[j] = v[j] * rsx;
                      const float* gain = nullptr;
                      bool rope = false, sig = false;
                      float scale = 1.0f;
                      if (c64 < 8) { gain = ng; rope = true; scale = 0.125f * 1.4426950408889634f; }
                      else if (c64 < 20) { const int c = (c64 - 8) >> 1; if (c == 2) { gain = ng + 128; rope = true; } else if (c == 4) { gain = ng + 192; rope = true; } }
                      else if (c64 < 28) { gain = dg; rope = true; scale = 0.125f * 1.4426950408889634f; }
                      else if (c64 == 28) { gain = dg + 64; rope = true; }
                      else if (c64 == 29) { }
                      else if (c64 < 38) { rope = true; scale = 0.125f; }
                      else if (c64 == 38) { rope = true; }
                      else if (c64 < 71) { sig = true; }
                      else { sig = (col < C_IW); }
                      if (gain) {
                          float ss = 0.f;
#pragma unroll
                          for (int j = 0; j < 8; ++j) ss += o[j] * o[j];
                          ss += dpp_qf<0xB1>(ss);
                          ss += dpp_qf<0x4E>(ss);
                          ss += __shfl_xor(ss, 4);
                          const float rstd = rsqrtf(ss * (1.0f / 64.0f) + EPS);
                          const float4 g0 = *(const float4*)(gain + cc * 8), g1 = *(const float4*)(gain + cc * 8 + 4);
                          o[0] *= rstd * g0.x; o[1] *= rstd * g0.y; o[2] *= rstd * g0.z; o[3] *= rstd * g0.w;
                          o[4] *= rstd * g1.x; o[5] *= rstd * g1.y; o[6] *= rstd * g1.z; o[7] *= rstd * g1.w;
                      }
                      if (rope) {
                          float pr[8];
#pragma unroll
                          for (int j = 0; j < 8; ++j) pr[j] = dpp_qf<0xB1>(o[j]);
                          if (cc < 2) {
                              const float4 c0 = *(const float4*)(ropec + (long)row * 8), c1 = *(const float4*)(ropec + (long)row * 8 + 4);
                              const float4 s0 = *(const float4*)(ropes + (long)row * 8), s1 = *(const float4*)(ropes + (long)row * 8 + 4);
                              const float cs[8] = {c0.x, c0.y, c0.z, c0.w, c1.x, c1.y, c1.z, c1.w};
                              const float sn[8] = {s0.x, s0.y, s0.z, s0.w, s1.x, s1.y, s1.z, s1.w};
#pragma unroll
                              for (int j = 0; j < 8; ++j) o[j] = (cc == 0) ? (o[j] * cs[j] - pr[j] * sn[j]) : (o[j] * cs[j] + pr[j] * sn[j]);
                          }
                      }
                      if (sig) {
#pragma unroll
                          for (int j = 0; j < 8; ++j) o[j] = sigmoidf(o[j]);
                      }
#pragma unroll
                      for (int j = 0; j < 8; ++j) o[j] *= scale;
                      st_bf8(proj + (long)row * IN_COLS + col, o);
                  });
}

__device__ __forceinline__ void phase_c1(const Params& P, int layer, unsigned char* smem) {
    unsigned char* ws = opq(P.ws);
    unsigned char* wl = ws + OFF_W + layer * W_LAYER;
    const u16* proj = (const u16*)(ws + OFF_PROJ);
    u16* chid = (u16*)(ws + OFF_CHID);
    const float* cbias = (const float*)(wl + WO_CB);
    for (int c = 0; c < 2; ++c) {
        u16* ch = chid + (size_t)c * CROWS * 256;
        const float* cb = cbias + c * 256;
        gemm_phase<1>(proj + C_NKV + c * 128, 0, (const u16*)(wl + WO_W1) + (size_t)c * 256 * 2048, 2048, CROWS, 256, 2048, smem,
                      [=](int row, int col, const float (&v)[8]) {
                          float o[8];
#pragma unroll
                          for (int j = 0; j < 8; ++j) o[j] = gelu_tanh(v[j] + cb[col + j]);
                          st_bf8(ch + (long)row * 256 + col, o);
                      });
    }
}

__device__ __forceinline__ void phase_c2(const Params& P, int layer, unsigned char* smem) {
    unsigned char* ws = opq(P.ws);
    unsigned char* wl = ws + OFF_W + layer * W_LAYER;
    const u16* chid = (const u16*)(ws + OFF_CHID);
    u16* kcb = (u16*)(ws + OFF_KCB);
    u16* vcb = (u16*)(ws + OFF_VCB);
    const float* ropec = (const float*)(ws + OFF_ROPE);
    const float* ropes = ropec + (size_t)NTOK * 8;
    const float* gain = P.nsa_gain + layer * 256 + 64;
    for (int c = 0; c < 2; ++c) {
        u16* dst = c == 0 ? kcb : vcb;
        gemm_phase<0>(chid + (size_t)c * CROWS * 256, 256, (const u16*)(wl + WO_W2) + (size_t)c * 64 * 256, 256, CROWS, 64, 256, smem,
                      [=](int row, int col, const float (&v)[8]) {
                          const int b = row / (NCMP * 2);
                          const int rem = row - b * (NCMP * 2);
                          const int n = rem >> 1, g = rem & 1;
                          const int cc = col >> 3;
                          float o[8];
#pragma unroll
                          for (int j = 0; j < 8; ++j) o[j] = v[j];
                          if (c == 0) {
                              float ss = 0.f;
#pragma unroll
                              for (int j = 0; j < 8; ++j) ss += o[j] * o[j];
                              ss += dpp_qf<0xB1>(ss);
                              ss += dpp_qf<0x4E>(ss);
                              ss += __shfl_xor(ss, 4);
                              const float rstd = rsqrtf(ss * (1.0f / 64.0f) + EPS);
#pragma unroll
                              for (int j = 0; j < 8; ++j) o[j] *= rstd * gain[cc * 8 + j];
                              float pr[8];
#pragma unroll
                              for (int j = 0; j < 8; ++j) pr[j] = dpp_qf<0xB1>(o[j]);
                              if (cc < 2) {
                                  const long tt = (long)b * SEQ + 31 + 16 * n;
#pragma unroll
                                  for (int j = 0; j < 8; ++j) {
                                      const float cs = ropec[tt * 8 + j], sn = ropes[tt * 8 + j];
                                      o[j] = (cc == 0) ? (o[j] * cs - pr[j] * sn) : (o[j] * cs + pr[j] * sn);
                                  }
                              }
                          }
                          st_bf8(dst + ((size_t)(b * 2 + g) * 256 + n) * 64 + col, o);
                      });
    }
}

__device__ __forceinline__ int balance4(int x, int seg) {
    const int k = x / seg, r = x - k * seg;
    return k == 0 ? r : (k == 1 ? 4 * seg - 1 - r : (k == 2 ? seg + r : 3 * seg - 1 - r));
}
__device__ __forceinline__ void phase_att_a(const Params& P, int layer, unsigned char* smem, unsigned long long& tacc) {
    unsigned char* ws = opq(P.ws);
    unsigned* ctr = (unsigned*)(ws + OFF_CTR) + (layer * 8 + 0) * 8;
    const int label = bidx() & 7;
    for (int s8 = 0; s8 < 8; ++s8) {
        const int q = (label + s8) & 7;
        int idx;
        while ((idx = grab_block(ctr + q, 1024, smem)) >= 0) dsa_select_unit(ws, q * 1024 + (1023 - idx), smem, tacc);
    }
}
__device__ __forceinline__ void phase_att_b(const Params& P, int layer, unsigned char* smem) {
    const int label = bidx() & 7;
    {
        unsigned char* ws = opq(P.ws);
        unsigned* ctr = (unsigned*)(ws + OFF_CTR) + (layer * 8 + 1) * 8;
        for (int s8 = 0; s8 < 8; ++s8) {
            const int q = (label + s8) & 7;
            int idx;
            while ((idx = grab_block(ctr + q, 256, smem)) >= 0) dsa_attn_unit(ws, q, 255 - idx, smem);
        }
    }
    {
        unsigned char* ws = opq(P.ws);
        unsigned* ctr = (unsigned*)(ws + OFF_CTR) + (layer * 8 + 2) * 8;
        for (int s8 = 0; s8 < 8; ++s8) {
            const int q = (label + s8) & 7;
            int idx;
            while ((idx = grab_block(ctr + q, 256, smem)) >= 0) {
                const int ub = q + 8 * (idx & 1);
                nsa_unit(ws, ub >> 1, ub & 1, 127 - (idx >> 1), smem);
            }
        }
    }
}

__device__ __forceinline__ void phase_merge(const Params& P, int layer, unsigned char* smem) {
    unsigned char* ws = opq(P.ws);
    unsigned char* wl = ws + OFF_W + layer * W_LAYER;
    const u16* proj = (const u16*)(ws + OFF_PROJ);
    u16* hbuf = (u16*)(ws + OFF_H);
    const u16* ya = (const u16*)(ws + OFF_YAB);
    const u16* yb = ya + (size_t)NTOK * 512;
    gemm_phase<0>(ya, 512, (const u16*)(wl + WO_WA), 512, NTOK, 1024, 512, smem, [=](int row, int col, const float (&v)[8]) {
        float ga[8], o[8];
        ld_bf8(proj + (long)row * IN_COLS + C_MG + col, ga);
#pragma unroll
        for (int j = 0; j < 8; ++j) o[j] = ga[j] * v[j];
        st_bf8(hbuf + (long)row * 1024 + col, o);
    });
    gemm_phase<0>(yb, 512, (const u16*)(wl + WO_WB), 512, NTOK, 1024, 512, smem, [=](int row, int col, const float (&v)[8]) {
        float gb[8], o[8];
        ld_bf8(proj + (long)row * IN_COLS + C_MG + 1024 + col, gb);
        ld_bf8(hbuf + (long)row * 1024 + col, o);
#pragma unroll
        for (int j = 0; j < 8; ++j) o[j] += gb[j] * v[j];
        st_bf8(hbuf + (long)row * 1024 + col, o);
    });
}

__device__ __forceinline__ void phase_outproj(const Params& P, int layer, unsigned char* smem) {
    unsigned char* ws = opq(P.ws);
    unsigned char* wl = ws + OFF_W + layer * W_LAYER;
    float* out = opq(P.out);
    const float* xin = (layer == 0) ? P.x : (const float*)out;
    const bool gemm_first = bidx() < (gdim() >> 1);
    for (int step = 0; step < 2; ++step) {
        if ((step == 0) == gemm_first) {
            u16* xb1 = (u16*)(ws + OFF_YAB);
            float* ss1 = (float*)(ws + OFF_SS1);
            gemm_phase<0>((const u16*)(ws + OFF_H), 1024, (const u16*)(wl + WO_WO), 1024, NTOK, 1024, 1024, smem, [=](int row, int col, const float (&v)[8]) {
                const long o = (long)row * 1024 + col;
                const float4 x0 = *(const float4*)(xin + o), x1 = *(const float4*)(xin + o + 4);
                const float y[8] = {x0.x + v[0], x0.y + v[1], x0.z + v[2], x0.w + v[3], x1.x + v[4], x1.y + v[5], x1.z + v[6], x1.w + v[7]};
                *(float4*)(out + o) = float4{y[0], y[1], y[2], y[3]};
                *(float4*)(out + o + 4) = float4{y[4], y[5], y[6], y[7]};
                st_bf8(xb1 + o, y);
                float ss = 0.f;
#pragma unroll
                for (int j = 0; j < 8; ++j) ss += y[j] * y[j];
                ss += dpp_qf<0xB1>(ss);
                ss += dpp_qf<0x4E>(ss);
                ss += __shfl_xor(ss, 4);
                if ((col & 63) == 0) ss1[(long)row * 16 + (col >> 6)] = ss;
            });
        } else {
            cvt_f32_bf16(P.p + (size_t)layer * NTOK * 256, (u16*)(ws + OFF_PBF), (long)NTOK * 256);
            cvt_rows_fp6(P.peer_u + (size_t)layer * NEXP * 1024, ws + OFF_UB, (float*)(ws + OFF_ESC), NEXP, P.ffn_norm + layer * 1024);
            cvt_rows_fp6(P.peer_v + (size_t)layer * NEXP * 1024, ws + OFF_VB, (float*)(ws + OFF_ESC) + NEXP, NEXP);
        }
    }
}

__device__ __forceinline__ void phase_pq(const Params& P, int layer, unsigned char* smem) {
    unsigned char* ws = opq(P.ws);
    unsigned char* wl = ws + OFF_W + layer * W_LAYER;
    u16* pq = (u16*)(ws + OFF_PQ);
    u16* eb = (u16*)(ws + OFF_H);
    const float* ss1 = (const float*)(ws + OFF_SS1);
    gemm_phase_rs<0, true>((const u16*)(ws + OFF_YAB), 1024, (const u16*)(wl + WO_WQ), 1024, NTOK, 2048, 1024, smem,
                  [=](int row) { return float2{rsqrtf(sum16(ss1 + (long)row * 16) * (1.0f / 1024.0f) + EPS), 0.f}; },
                  [=](int row, int col, const float (&v)[8], float2 rs) {
                      float o[8];
#pragma unroll
                      for (int j = 0; j < 8; ++j) o[j] = v[j] * rs.x;
                      st_bf8(pq + (long)row * 2048 + col, o);
                  });
    float* sse = (float*)(ws + OFF_SSE) + (size_t)layer * NTOK * 16;
    gemm_phase<0>((const u16*)(ws + OFF_PBF), 256, (const u16*)(wl + WO_PW), 256, NTOK, 1024, 256, smem,
                  [=](int row, int col, const float (&v)[8]) {
                      st_bf8(eb + (long)row * 1024 + col, v);
                      float ss = 0.f;
#pragma unroll
                      for (int j = 0; j < 8; ++j) ss += v[j] * v[j];
                      ss += dpp_qf<0xB1>(ss);
                      ss += dpp_qf<0x4E>(ss);
                      ss += __shfl_xor(ss, 4);
                      if ((col & 63) == 0) sse[(long)row * 16 + (col >> 6)] = ss;
                  });
}

__device__ __forceinline__ void phase_final(const Params& P, int layer, unsigned char* smem) {
    unsigned char* ws = opq(P.ws);
    unsigned char* wl = ws + OFF_W + layer * W_LAYER;
    float* out = opq(P.out);
    u16* eb = (u16*)(ws + OFF_H);
    const float* rstd2 = (const float*)(ws + OFF_RSTDE);
    const float* sse = (const float*)(ws + OFF_SSE) + (size_t)layer * NTOK * 16;
    float* ssn = (float*)(ws + OFF_SSA) + (size_t)NTOK * 16;
    const float* pn = P.ple_norm + layer * 1024;
    const bool more = layer == 0;
    gemm_phase_rs<0, true>((const u16*)(ws + OFF_YAB), 1024, (const u16*)(wl + WO_PG), 1024, NTOK, 1024, 1024, smem,
        [=](int row) { return float2{rstd2[row], rsqrtf(sum16(sse + (long)row * 16) * (1.0f / 1024.0f) + EPS)}; },
        [=](int row, int col, const float (&v)[8], float2 rs) {
        const long o = (long)row * 1024 + col;
        float e[8];
        ld_bf8(eb + o, e);
        const float rx = rs.x;
        const float re = rs.y;
        const float4 x0 = *(const float4*)(out + o), x1 = *(const float4*)(out + o + 4);
        const float4 p0 = *(const float4*)(pn + col), p1 = *(const float4*)(pn + col + 4);
        const float xs[8] = {x0.x, x0.y, x0.z, x0.w, x1.x, x1.y, x1.z, x1.w};
        const float ps[8] = {p0.x, p0.y, p0.z, p0.w, p1.x, p1.y, p1.z, p1.w};
        float y[8];
        float ss = 0.f;
#pragma unroll
        for (int j = 0; j < 8; ++j) {
            y[j] = xs[j] + sigmoidf(v[j] * rx) * (e[j] * re * ps[j]);
            ss += y[j] * y[j];
        }
        *(float4*)(out + o) = float4{y[0], y[1], y[2], y[3]};
        *(float4*)(out + o + 4) = float4{y[4], y[5], y[6], y[7]};
        if (more) {
            st_bf8(eb + o, y);
            ss += dpp_qf<0xB1>(ss);
            ss += dpp_qf<0x4E>(ss);
            ss += __shfl_xor(ss, 4);
            if ((col & 63) == 0) ssn[(long)row * 16 + (col >> 6)] = ss;
        }
    });
}


#define XB_TMO      128
#define XB_XCNT(j)  (256  + 64 * (j))
#define XB_XSUB(j)  (1280 + 64 * (j))
#define XB_XGEN(j)  (2304 + 64 * (j))
#define XB_TOP      3328
#define XB_TOPGEN   3392
#define XCD_BAR_WORDS 3456
#define XB_SPIN_CAP (1u << 22)
#define LAS __attribute__((address_space(3)))
__device__ __forceinline__ unsigned xb_ld(unsigned* p) { return __hip_atomic_load(p, __ATOMIC_RELAXED, __HIP_MEMORY_SCOPE_AGENT); }
__device__ __forceinline__ unsigned xb_add(unsigned* p, unsigned v) { return __hip_atomic_fetch_add(p, v, __ATOMIC_RELAXED, __HIP_MEMORY_SCOPE_AGENT); }
__device__ __forceinline__ unsigned xb_xcc_id() { return (unsigned)__builtin_amdgcn_s_getreg((3 << 11) | 20) & 0xFu; }
#define XB_SPIN(cond, bar) do { unsigned _sp = 0; while (cond) { __builtin_amdgcn_s_sleep(1); \
    if ((++_sp & 255u) == 0u) { if (xb_ld(&(bar)[XB_TMO])) break; if (_sp > XB_SPIN_CAP) { atomicAdd(&(bar)[XB_TMO], 1u); break; } } } } while (0)
struct XcdBarrier {
    unsigned* bar; unsigned x;
    volatile LAS unsigned* st;
};
__device__ __forceinline__ XcdBarrier xcd_barrier_post(unsigned* bar, volatile LAS unsigned* st) {
    XcdBarrier b; b.bar = bar; b.x = xb_xcc_id(); b.st = st;
    if (threadIdx.x == 0) (void)xb_add(&bar[XB_XCNT(b.x)], 1u);
    return b;
}
__device__ __forceinline__ void xcd_barrier_complete(unsigned* bar, unsigned x, unsigned& nloc, unsigned& nx) {
    const unsigned G = gridDim.x * gridDim.y * gridDim.z;
    unsigned sum, cnt, mine, sp = 0u;
    for (;;) {
        sum = 0u; cnt = 0u; mine = 0u;
#pragma unroll
        for (unsigned j = 0; j < 16; ++j) { const unsigned c = xb_ld(&bar[XB_XCNT(j)]); sum += c; cnt += (c > 0u) ? 1u : 0u; mine = (j == x) ? c : mine; }
        if (sum == G) break;
        __builtin_amdgcn_s_sleep(1);
        if ((++sp & 255u) == 0u) { if (xb_ld(&bar[XB_TMO])) break; if (sp > XB_SPIN_CAP) { atomicAdd(&bar[XB_TMO], 1u); break; } }
    }
    nloc = mine > 0u ? mine : 1u; nx = cnt > 0u ? cnt : 1u;
}
__device__ __forceinline__ void xcd_barrier(const XcdBarrier& b) {
    asm volatile("s_waitcnt vmcnt(0)" ::: "memory");
    __syncthreads();
    if (threadIdx.x == 0) {
        unsigned* bar = b.bar;
        __builtin_amdgcn_s_waitcnt(0);
        unsigned nloc = b.st[0], nx = b.st[1];
        if (nloc == 0u) { xcd_barrier_complete(bar, b.x, nloc, nx); b.st[0] = nloc; b.st[1] = nx; }
        const unsigned old = xb_add(&bar[XB_XSUB(b.x)], 1u);
        const unsigned gen = old / nloc;
        if (old + 1u == (gen + 1u) * nloc) {
            __builtin_amdgcn_fence(__ATOMIC_RELEASE, "agent");
            asm volatile("s_waitcnt vmcnt(0)" ::: "memory");
            const unsigned og = xb_add(&bar[XB_TOP], 1u);
            const unsigned tg = og / nx;
            if (og + 1u == (tg + 1u) * nx) xb_add(&bar[XB_TOPGEN], 1u);
            else XB_SPIN(xb_ld(&bar[XB_TOPGEN]) == tg, bar);
            __builtin_amdgcn_fence(__ATOMIC_ACQUIRE, "agent");
            xb_add(&bar[XB_XGEN(b.x)], 1u);
            asm volatile("s_waitcnt vmcnt(0)" ::: "memory");
        } else {
            XB_SPIN(xb_ld(&bar[XB_XGEN(b.x)]) == gen, bar);
            __builtin_amdgcn_fence(__ATOMIC_ACQUIRE, "agent");
            asm volatile("s_waitcnt vmcnt(0)" ::: "memory");
        }
    }
    __syncthreads();
}

#ifndef PROBE_MASK
#define PROBE_MASK 0ull
#endif
#ifndef PROBE_MULT
#define PROBE_MULT 4
#endif
#define GSYNC(id)                                                                          \
    do {                                                                                   \
        xcd_barrier(xb);                                                                   \
        if (PROBE_MASK != 0ull) {                                                          \
            unsigned long long now_ = __builtin_amdgcn_s_memrealtime();                    \
            if ((PROBE_MASK >> (id)) & 1ull) tsel += now_ - tprev;                         \
            tprev = now_;                                                                  \
        }                                                                                  \
    } while (0)

__global__ void __launch_bounds__(256, 2)
fwd_kernel(const float* a_x, const float* a_p, const int* a_pos, const float* a_an, const float* a_win, const float* a_ng, const float* a_cp,
           const float* a_cw1, const float* a_cw2, const float* a_dg, const float* a_wa, const float* a_wb, const float* a_wo, const float* a_fn,
           const float* a_wq, const float* a_sk, const float* a_pu, const float* a_pv, const float* a_pw, const float* a_pgw, const float* a_pn,
           float* a_out, unsigned char* a_ws) {
    Params P;
    P.x = a_x; P.p = a_p; P.positions = a_pos; P.attn_norm = a_an; P.w_in = a_win; P.nsa_gain = a_ng; P.cmp_pos = a_cp; P.cmp_w1 = a_cw1;
    P.cmp_w2 = a_cw2; P.dsa_gain = a_dg; P.w_a = a_wa; P.w_b = a_wb; P.w_out = a_wo; P.ffn_norm = a_fn; P.peer_wq = a_wq; P.peer_sk = a_sk;
    P.peer_u = a_pu; P.peer_v = a_pv; P.ple_w = a_pw; P.ple_gw = a_pgw; P.ple_norm = a_pn; P.out = a_out; P.ws = a_ws;
    cg::grid_group grid = cg::this_grid();
    extern __shared__ __attribute__((aligned(16))) unsigned char smem[];
    unsigned long long tprev = 0, tsel = 0;
    if (PROBE_MASK != 0ull) tprev = __builtin_amdgcn_s_memrealtime();
    volatile LAS unsigned* xst = (volatile LAS unsigned*)(smem + LDS_BYTES);
    if (threadIdx.x == 0) { xst[0] = 0u; xst[1] = 0u; xst[2] = 0u; xst[3] = 0u; }
    __syncthreads();
    XcdBarrier xb = xcd_barrier_post((unsigned*)(P.ws + OFF_BAR), xst);
    phase_prep(P, smem);
    grid.sync();
    if (PROBE_MASK != 0ull) {
        unsigned long long now_ = __builtin_amdgcn_s_memrealtime();
        if (PROBE_MASK & 1ull) tsel += now_ - tprev;
        tprev = now_;
    }
    for (int layer = 0; layer < 2; ++layer) {
        const int pb = 1 + 16 * layer;
        phase_g1(P, layer, smem);
        GSYNC(pb + 0);
        phase_c1(P, layer, smem);
        phase_att_a(P, layer, smem, tsel);
        GSYNC(pb + 15);
        phase_c2(P, layer, smem);
        GSYNC(pb + 3);
        phase_att_b(P, layer, smem);
        GSYNC(pb + 5);
        phase_merge(P, layer, smem);
        GSYNC(pb + 6);
        phase_outproj(P, layer, smem);
        GSYNC(pb + 7);
        phase_pq(P, layer, smem);
        GSYNC(pb + 9);
        peer_route(opq(P.ws), opq(P.out), P.ffn_norm + layer * 1024, layer, smem, tsel);
        GSYNC(pb + 11);
        phase_final(P, layer, smem);
        GSYNC(pb + 13);
    }
#ifndef PROBE_BLOCK
#define PROBE_BLOCK 0
#endif
    if (PROBE_MASK != 0ull || PROBE_SEC != 0) {
        if (blockIdx.x == PROBE_BLOCK && threadIdx.x == 0) {
            unsigned long long t0 = __builtin_amdgcn_s_memrealtime();
            while (__builtin_amdgcn_s_memrealtime() - t0 < (unsigned long long)PROBE_MULT * tsel) __builtin_amdgcn_s_sleep(32);
        }
    }
}

extern "C" void kernel_launch(void* const* d_in, const int* in_sizes, int n_in, void* d_out, int out_size, void* d_ws, size_t ws_size,
                              hipStream_t stream) {
    static int grid_blocks = 0;
    if (!grid_blocks) {
        int dev = 0, cus = 0, per_cu = 0;
        (void)hipGetDevice(&dev);
        (void)hipDeviceGetAttribute(&cus, hipDeviceAttributeMultiprocessorCount, dev);
        (void)hipFuncSetAttribute((const void*)fwd_kernel, hipFuncAttributeMaxDynamicSharedMemorySize, LDS_BYTES + 16);
        (void)hipOccupancyMaxActiveBlocksPerMultiprocessor(&per_cu, fwd_kernel, 256, LDS_BYTES + 16);
        if (per_cu > 2) per_cu = 2;
        if (per_cu < 1) per_cu = 1;
        grid_blocks = cus * per_cu;
        if (ws_size < WS_END) fprintf(stderr, "kernel_launch: workspace too small: %zu < %zu\n", ws_size, (size_t)WS_END);
    }
    Params P{};
    P.x = (const float*)d_in[0];
    P.p = (const float*)d_in[1];
    P.positions = (const int*)d_in[2];
    P.attn_norm = (const float*)d_in[3];
    P.w_in = (const float*)d_in[4];
    P.nsa_gain = (const float*)d_in[5];
    P.cmp_pos = (const float*)d_in[6];
    P.cmp_w1 = (const float*)d_in[7];
    P.cmp_w2 = (const float*)d_in[8];
    P.dsa_gain = (const float*)d_in[9];
    P.w_a = (const float*)d_in[10];
    P.w_b = (const float*)d_in[11];
    P.w_out = (const float*)d_in[12];
    P.ffn_norm = (const float*)d_in[13];
    P.peer_wq = (const float*)d_in[14];
    P.peer_sk = (const float*)d_in[15];
    P.peer_u = (const float*)d_in[16];
    P.peer_v = (const float*)d_in[17];
    P.ple_w = (const float*)d_in[18];
    P.ple_gw = (const float*)d_in[19];
    P.ple_norm = (const float*)d_in[20];
    P.out = (float*)d_out;
    P.ws = (unsigned char*)d_ws;
    void* args[] = {(void*)&P.x, (void*)&P.p, (void*)&P.positions, (void*)&P.attn_norm, (void*)&P.w_in, (void*)&P.nsa_gain, (void*)&P.cmp_pos,
                    (void*)&P.cmp_w1, (void*)&P.cmp_w2, (void*)&P.dsa_gain, (void*)&P.w_a, (void*)&P.w_b, (void*)&P.w_out, (void*)&P.ffn_norm,
                    (void*)&P.peer_wq, (void*)&P.peer_sk, (void*)&P.peer_u, (void*)&P.peer_v, (void*)&P.ple_w, (void*)&P.ple_gw,
                    (void*)&P.ple_norm, (void*)&P.out, (void*)&P.ws};
    (void)hipMemsetAsync((unsigned char*)d_ws + OFF_BAR, 0, 3456 * 4 + N_CTR * 4, stream);
    hipError_t e = hipLaunchCooperativeKernel((void*)fwd_kernel, dim3(grid_blocks), dim3(256), args, LDS_BYTES + 16, stream);
    if (e != hipSuccess) fprintf(stderr, "cooperative launch failed: %s (grid %d)\n", hipGetErrorString(e), grid_blocks);
}
```

```cpp
#include <hip/hip_runtime.h>
#include <hip/hip_cooperative_groups.h>
#include <cstdio>
#include <cstdint>
namespace cg = cooperative_groups;
#ifndef PROBE_SEC
#define PROBE_SEC 0
#endif
#define SEC_T() (PROBE_SEC ? __builtin_amdgcn_s_memrealtime() : 0ull)
#define SEC_ADD(k, t0) do { if (PROBE_SEC == (k)) { unsigned long long n_ = SEC_T(); tacc += n_ - (t0); } } while (0)

typedef unsigned short u16;
typedef unsigned int u32;
typedef unsigned long long u64;
using bf16x8 = __attribute__((ext_vector_type(8))) short;
using f32x4 = __attribute__((ext_vector_type(4))) float;
using f32x16 = __attribute__((ext_vector_type(16))) float;
typedef __bf16 bf16x2_t __attribute__((ext_vector_type(2)));

constexpr int D_MODEL = 1024, BATCH = 8, SEQ = 4096, NTOK = BATCH * SEQ;
constexpr int IN_COLS = 4576;
constexpr int C_NQ = 0, C_NKV = 512, C_DQ = 1280, C_DKV = 1792, C_IQ = 1920, C_IK = 2432, C_MG = 2496, C_NG = 4544, C_IW = 4568;
__host__ __device__ constexpr int perm_col(int n) {
    return n < 1280 ? n : n < 1304 ? 4544 + (n - 1280) : n < 1816 ? 1280 + (n - 1304) : n < 1944 ? 1792 + (n - 1816)
         : n < 2456 ? 1920 + (n - 1944) : n < 2520 ? 2432 + (n - 2456) : n < 2528 ? 4568 + (n - 2520) : 2496 + (n - 2528);
}
constexpr int NCMP = 255;
constexpr int CROWS = BATCH * NCMP * 2;
constexpr int NEXP = 16384;
constexpr float EPS = 1e-6f;

constexpr size_t AL(size_t x) { return (x + 255) & ~(size_t)255; }
constexpr size_t WO_WIN = 0;
constexpr size_t WO_W1 = WO_WIN + AL((size_t)IN_COLS * 1024 * 2);
constexpr size_t WO_W2 = WO_W1 + AL((size_t)2 * 256 * 2048 * 2);
constexpr size_t WO_WA = WO_W2 + AL((size_t)2 * 64 * 256 * 2);
constexpr size_t WO_WB = WO_WA + AL((size_t)1024 * 512 * 2);
constexpr size_t WO_WO = WO_WB + AL((size_t)1024 * 512 * 2);
constexpr size_t WO_WQ = WO_WO + AL((size_t)1024 * 1024 * 2);
constexpr size_t WO_PW = WO_WQ + AL((size_t)2048 * 1024 * 2);
constexpr size_t WO_PG = WO_PW + AL((size_t)1024 * 256 * 2);
constexpr size_t WO_SK = WO_PG + AL((size_t)1024 * 1024 * 2);
constexpr size_t WO_CB = WO_SK + AL((size_t)2 * 128 * 128 * 2);
constexpr size_t W_LAYER = WO_CB + AL((size_t)2 * 256 * 4);

constexpr size_t OFF_W = 0;
constexpr size_t OFF_ROPE = OFF_W + 2 * W_LAYER;
constexpr size_t OFF_H = OFF_ROPE + AL((size_t)NTOK * 16 * 4);
constexpr size_t OFF_PROJ = OFF_H + AL((size_t)NTOK * 1024 * 2);
constexpr size_t OFF_YAB = OFF_PROJ + AL((size_t)NTOK * IN_COLS * 2);
constexpr size_t OFF_CHID = OFF_YAB + AL((size_t)NTOK * 1024 * 2);
constexpr size_t OFF_CBUF = OFF_CHID + AL((size_t)2 * CROWS * 256 * 2);
constexpr size_t OFF_KCB = OFF_CBUF + AL((size_t)2 * CROWS * 64 * 4);
constexpr size_t OFF_VCB = OFF_KCB + AL((size_t)BATCH * 2 * 256 * 64 * 2);
constexpr size_t OFF_RSTDE = OFF_VCB + AL((size_t)BATCH * 2 * 256 * 64 * 2);
constexpr size_t OFF_SSA = OFF_RSTDE + AL((size_t)NTOK * 4);
constexpr size_t OFF_SSE = OFF_SSA + AL((size_t)2 * NTOK * 16 * 4);
constexpr size_t OFF_SS1 = OFF_SSE + AL((size_t)2 * NTOK * 16 * 4);
constexpr int N_CTR = 512;
constexpr size_t OFF_BAR = OFF_SS1 + AL((size_t)NTOK * 16 * 4);
constexpr size_t OFF_CTR = OFF_BAR + 3456 * 4;
constexpr size_t OFF_BITS = OFF_CTR + AL(N_CTR * 4);
constexpr size_t OFF_A8 = OFF_BITS;
constexpr size_t WS_END = OFF_BITS + AL((size_t)NTOK * 1024);
__device__ __forceinline__ float sum16(const float* p) {
    const float4 a = *(const float4*)p, b = *(const float4*)(p + 4), c = *(const float4*)(p + 8), d = *(const float4*)(p + 12);
    return ((a.x + a.y) + (a.z + a.w)) + ((b.x + b.y) + (b.z + b.w)) + (((c.x + c.y) + (c.z + c.w)) + ((d.x + d.y) + (d.z + d.w)));
}
constexpr size_t OFF_W8O = OFF_CBUF;
static_assert((size_t)1024 * 1024 <= (size_t)2 * CROWS * 64 * 4, "W8O does not fit");
constexpr size_t OFF_PQ = OFF_PROJ;
constexpr size_t OFF_UB = OFF_PQ + (size_t)NTOK * 2048 * 2;
constexpr size_t OFF_VB = OFF_UB + (size_t)NEXP * 1024 * 2;
constexpr size_t OFF_EIDX = OFF_VB + (size_t)NEXP * 1024 * 2;
constexpr size_t OFF_GATE = OFF_EIDX + (size_t)NTOK * 128 * 4;
constexpr size_t OFF_ESC = OFF_GATE + (size_t)NTOK * 128 * 4;
constexpr size_t OFF_PBF = OFF_ESC + (size_t)2 * NEXP * 4;
constexpr size_t OFF_ESU = OFF_PBF + (size_t)NTOK * 256 * 2;
static_assert(OFF_ESU + (size_t)NTOK * 128 * 4 <= OFF_YAB, "alias overflow");

constexpr int LDS_BYTES = 65536 + 2048;
constexpr int G1_F8LO = 20, G1_F8HI = 35;
static_assert(G1_F8LO * 128 >= C_MG && G1_F8HI * 128 <= C_NG, "fp8 tiles must lie inside the merge-gate columns");

struct Params {
    const float* x; const float* p; const int* positions;
    const float* attn_norm; const float* w_in; const float* nsa_gain; const float* cmp_pos; const float* cmp_w1; const float* cmp_w2;
    const float* dsa_gain; const float* w_a; const float* w_b; const float* w_out; const float* ffn_norm; const float* peer_wq;
    const float* peer_sk; const float* peer_u; const float* peer_v; const float* ple_w; const float* ple_gw; const float* ple_norm;
    float* out; unsigned char* ws;
};

__device__ __forceinline__ u16 f2bf(float f) {
    u32 u = __float_as_uint(f);
    u32 r = u + 0x7FFFu + ((u >> 16) & 1u);
    return (u16)(r >> 16);
}
__device__ __forceinline__ float bf2f(u16 h) { return __uint_as_float(((u32)h) << 16); }
__device__ __forceinline__ float bf_lo(u32 w) { return __uint_as_float(w << 16); }
__device__ __forceinline__ float bf_hi(u32 w) { return __uint_as_float(w & 0xFFFF0000u); }
__device__ __forceinline__ u32 pack2(float a, float b) {
    u32 r;
    asm("v_cvt_pk_bf16_f32 %0, %1, %2" : "=v"(r) : "v"(a), "v"(b));
    return r;
}
__device__ __forceinline__ float dot2(u32 a, u32 b, float c) {
    return __builtin_amdgcn_fdot2_f32_bf16(__builtin_bit_cast(bf16x2_t, a), __builtin_bit_cast(bf16x2_t, b), c, false);
}
template <int CTRL>
__device__ __forceinline__ int dppi(int x) { return __builtin_amdgcn_update_dpp(x, x, CTRL, 0xF, 0xF, false); }
template <int CTRL>
__device__ __forceinline__ float dppf(float x) { return __int_as_float(dppi<CTRL>(__float_as_int(x))); }
__device__ __forceinline__ int row_sum16i(int x) {
    x += dppi<0x128>(x);
    x += dppi<0x124>(x);
    x += dppi<0x122>(x);
    x += dppi<0x121>(x);
    return x;
}
template <int CTRL>
__device__ __forceinline__ int dppi0(int x) { return __builtin_amdgcn_update_dpp(0, x, CTRL, 0xF, 0xF, true); }
__device__ __forceinline__ int row_xscan16i(int x) {
    int s = x;
    s += dppi0<0x111>(s);
    s += dppi0<0x112>(s);
    s += dppi0<0x114>(s);
    s += dppi0<0x118>(s);
    return s - x;
}
__device__ __forceinline__ float row_sum16f(float x) {
    x += dppf<0x128>(x);
    x += dppf<0x124>(x);
    x += dppf<0x122>(x);
    x += dppf<0x121>(x);
    return x;
}
__device__ __forceinline__ float row_max16f(float x) {
    x = fmaxf(x, dppf<0x128>(x));
    x = fmaxf(x, dppf<0x124>(x));
    x = fmaxf(x, dppf<0x122>(x));
    x = fmaxf(x, dppf<0x121>(x));
    return x;
}

__device__ __forceinline__ u32 row_max16u(u32 x) {
    x = max(x, (u32)dppi<0x128>((int)x));
    x = max(x, (u32)dppi<0x124>((int)x));
    x = max(x, (u32)dppi<0x122>((int)x));
    x = max(x, (u32)dppi<0x121>((int)x));
    return x;
}
__device__ __forceinline__ u32 row_min16u(u32 x) {
    x = min(x, (u32)dppi<0x128>((int)x));
    x = min(x, (u32)dppi<0x124>((int)x));
    x = min(x, (u32)dppi<0x122>((int)x));
    x = min(x, (u32)dppi<0x121>((int)x));
    return x;
}
template <int CTRL>
__device__ __forceinline__ float dpp_qf(float x) { return __int_as_float(__builtin_amdgcn_update_dpp(0, __float_as_int(x), CTRL, 0xF, 0xF, false)); }
__device__ __forceinline__ float wsum(float v) {
    v = row_sum16f(v);
    const float a = __int_as_float(__builtin_amdgcn_readlane(__float_as_int(v), 0));
    const float b = __int_as_float(__builtin_amdgcn_readlane(__float_as_int(v), 16));
    const float c = __int_as_float(__builtin_amdgcn_readlane(__float_as_int(v), 32));
    const float d = __int_as_float(__builtin_amdgcn_readlane(__float_as_int(v), 48));
    return (a + b) + (c + d);
}
__device__ __forceinline__ float wmax(float v) {
    v = row_max16f(v);
    const float a = __int_as_float(__builtin_amdgcn_readlane(__float_as_int(v), 0));
    const float b = __int_as_float(__builtin_amdgcn_readlane(__float_as_int(v), 16));
    const float c = __int_as_float(__builtin_amdgcn_readlane(__float_as_int(v), 32));
    const float d = __int_as_float(__builtin_amdgcn_readlane(__float_as_int(v), 48));
    return fmaxf(fmaxf(a, b), fmaxf(c, d));
}
__device__ __forceinline__ int wsumi(int v) {
    v = row_sum16i(v);
    return __builtin_amdgcn_readlane(v, 0) + __builtin_amdgcn_readlane(v, 16) + __builtin_amdgcn_readlane(v, 32) + __builtin_amdgcn_readlane(v, 48);
}
__device__ __forceinline__ float sigmoidf(float x) { return __builtin_amdgcn_rcpf(1.0f + __expf(-x)); }
__device__ __forceinline__ float gelu_tanh(float x) {
    float u = 0.7978845608028654f * (x + 0.044715f * x * x * x);
    return x * sigmoidf(2.0f * u);
}
__device__ __forceinline__ u32 sortkey(float f) {
    u32 b = __float_as_uint(f);
    return b ^ ((b >> 31) ? 0xFFFFFFFFu : 0x80000000u);
}
#define WAVE_SYNC() asm volatile("s_waitcnt lgkmcnt(0)" ::: "memory")
template <class T>
__device__ __forceinline__ T* opq(T* p) {
    long z = 0;
    asm volatile("" : "+s"(z));
    return (T*)((char*)p + z);
}
__device__ __forceinline__ int tidx() {
    int t = threadIdx.x;
    asm volatile("" : "+v"(t));
    return t;
}
__device__ __forceinline__ int bidx() {
    int b = blockIdx.x;
    asm volatile("" : "+s"(b));
    return b;
}
__device__ __forceinline__ int gdim() {
    int g = gridDim.x;
    asm volatile("" : "+s"(g));
    return g;
}

typedef int i32x8_t __attribute__((ext_vector_type(8)));
template <int AMODE, bool HAS_RS, int DT, class RowFn, class Epi>
__device__ __forceinline__ void gemm_tile(const u16* __restrict__ Ap, long lda, const u16* __restrict__ BT, long ldb, int M, int N, int K, int m0,
                                          int n0, unsigned char* lds, RowFn rowfn, Epi epi) {
    const int tid = tidx(), lane = tid & 63, w = tid >> 6;
    const int wm = w >> 1, wn = w & 1;
    f32x4 acc[4][4];
#pragma unroll
    for (int i = 0; i < 4; ++i)
#pragma unroll
        for (int j = 0; j < 4; ++j) acc[i][j] = f32x4{0.f, 0.f, 0.f, 0.f};
    long aoff[4], boff[4];
#pragma unroll
    for (int i = 0; i < 4; ++i) {
        const int row = (w * 4 + i) * 8 + (lane >> 3);
        const int kc = (lane & 7) ^ ((row >> 1) & 7);
        int gr = m0 + row;
        if (gr > M - 1) gr = M - 1;
        if (AMODE == 1) {
            int b = gr / (NCMP * 2);
            int rem = gr - b * (NCMP * 2);
            aoff[i] = ((long)b * SEQ + 16 * (rem >> 1)) * IN_COLS + (rem & 1) * 64 + kc * 8;
        } else {
            aoff[i] = (long)gr * lda + kc * 8;
        }
        int gn = n0 + row;
        if (gn > N - 1) gn = N - 1;
        boff[i] = (long)gn * ldb + kc * 8;
    }
    const int nk = K / 64;
#define GEMM_STAGE(kt, bufsel)                                                                                                        \
    do {                                                                                                                              \
        unsigned char* ab_ = lds + (bufsel) * 32768 + w * 4096 + lane * 16;                                                           \
        const long ka_ = (AMODE == 1) ? (long)(kt) * IN_COLS : (long)(kt) * 64;                                                       \
        _Pragma("unroll") for (int i_ = 0; i_ < 4; ++i_) {                                                                            \
            __builtin_amdgcn_global_load_lds((const unsigned*)(Ap + aoff[i_] + ka_), (unsigned*)(ab_ + i_ * 1024), 16, 0, 0);        \
            __builtin_amdgcn_global_load_lds((const unsigned*)(BT + boff[i_] + (long)(kt) * 64), (unsigned*)(ab_ + 16384 + i_ * 1024), 16, 0, 0); \
        }                                                                                                                             \
    } while (0)
    GEMM_STAGE(0, 0);
    asm volatile("s_waitcnt vmcnt(0)" ::: "memory");
    __syncthreads();
    int fa[4], fb[4];
#pragma unroll
    for (int i = 0; i < 4; ++i) {
        const int ra = wm * 64 + i * 16 + (lane & 15), rb = wn * 64 + i * 16 + (lane & 15);
        fa[i] = ra * 128 + ((ra >> 1) & 7) * 16;
        fb[i] = rb * 128 + ((rb >> 1) & 7) * 16;
    }
    for (int kt = 0; kt < nk; ++kt) {
        if (kt + 1 < nk) GEMM_STAGE(kt + 1, (kt + 1) & 1);
        const unsigned char* Ab = lds + (kt & 1) * 32768;
        const unsigned char* Bb = Ab + 16384;
        if (DT == 1) {
            bf16x8 af[2][4], bfr[2][4];
#pragma unroll
            for (int ks = 0; ks < 2; ++ks) {
                const int kc16 = (ks * 4 + (lane >> 4)) * 16;
#pragma unroll
                for (int i = 0; i < 4; ++i) {
                    af[ks][i] = *(const bf16x8*)(Ab + ((fa[i] & ~127) | ((fa[i] & 127) ^ kc16)));
                    bfr[ks][i] = *(const bf16x8*)(Bb + ((fb[i] & ~127) | ((fb[i] & 127) ^ kc16)));
                }
            }
            typedef int i32x4_t __attribute__((ext_vector_type(4)));
#pragma unroll
            for (int i = 0; i < 4; ++i) {
                const i32x4_t a0 = __builtin_bit_cast(i32x4_t, af[0][i]), a1 = __builtin_bit_cast(i32x4_t, af[1][i]);
                const i32x8_t a8 = {a0[0], a0[1], a0[2], a0[3], a1[0], a1[1], a1[2], a1[3]};
#pragma unroll
                for (int j = 0; j < 4; ++j) {
                    const i32x4_t b0 = __builtin_bit_cast(i32x4_t, bfr[0][j]), b1 = __builtin_bit_cast(i32x4_t, bfr[1][j]);
                    const i32x8_t b8 = {b0[0], b0[1], b0[2], b0[3], b1[0], b1[1], b1[2], b1[3]};
                    acc[i][j] = __builtin_amdgcn_mfma_scale_f32_16x16x128_f8f6f4(a8, b8, acc[i][j], 0, 0, 0, 0x7F7F7F7F, 0, 0x77777777);
                }
            }
        } else
#pragma unroll
        for (int ks = 0; ks < 2; ++ks) {
            const int kc16 = (ks * 4 + (lane >> 4)) * 16;
            bf16x8 af[4], bfr[4];
#pragma unroll
            for (int i = 0; i < 4; ++i) {
                af[i] = *(const bf16x8*)(Ab + ((fa[i] & ~127) | ((fa[i] & 127) ^ kc16)));
                bfr[i] = *(const bf16x8*)(Bb + ((fb[i] & ~127) | ((fb[i] & 127) ^ kc16)));
            }
#pragma unroll
            for (int i = 0; i < 4; ++i)
#pragma unroll
                for (int j = 0; j < 4; ++j) acc[i][j] = __builtin_amdgcn_mfma_f32_16x16x32_bf16(af[i], bfr[j], acc[i][j], 0, 0, 0);
        }
        asm volatile("s_waitcnt vmcnt(0)" ::: "memory");
        __syncthreads();
    }
#undef GEMM_STAGE
    float2* rsl = (float2*)(lds + 34816);
    if (HAS_RS) {
        if (tid < 128) {
            int gr = m0 + tid;
            if (gr > M - 1) gr = M - 1;
            rsl[tid] = rowfn(gr);
        }
        __syncthreads();
    }
    float* st = (float*)(lds + w * 8704);
#pragma unroll
    for (int hh = 0; hh < 2; ++hh) {
#pragma unroll
        for (int m2 = 0; m2 < 2; ++m2)
#pragma unroll
            for (int j = 0; j < 4; ++j)
#pragma unroll
                for (int r = 0; r < 4; ++r) st[(m2 * 16 + (lane >> 4) * 4 + r) * 68 + j * 16 + (lane & 15)] = acc[hh * 2 + m2][j][r];
        WAVE_SYNC();
#pragma unroll
        for (int c = 0; c < 4; ++c) {
            const int id = c * 64 + lane;
            const int rr = id >> 3, cc = id & 7;
            const float4 v0 = *(const float4*)(st + rr * 68 + cc * 8);
            const float4 v1 = *(const float4*)(st + rr * 68 + cc * 8 + 4);
            const float v[8] = {v0.x, v0.y, v0.z, v0.w, v1.x, v1.y, v1.z, v1.w};
            const int row = m0 + wm * 64 + hh * 32 + rr;
            const int col0 = n0 + wn * 64 + cc * 8;
            const float2 rs = HAS_RS ? rsl[wm * 64 + hh * 32 + rr] : float2{1.f, 1.f};
            if (row < M && col0 < N) epi(row, col0, v, rs);
        }
        WAVE_SYNC();
    }
    __syncthreads();
}

template <class Epi1, class Epi2>
__device__ __forceinline__ void gemm_tile_dual8(const u16* __restrict__ A1, const u16* __restrict__ B1, const u16* __restrict__ A2, const u16* __restrict__ B2,
                                                long lda, long ldb, int M, int N, int K, int m0, int n0, unsigned char* lds, Epi1 epi1, Epi2 epi2) {
    const int tid = tidx(), lane = tid & 63, w = tid >> 6;
    const int wm = w >> 1, wn = w & 1;
    long aoff[4], boff[4];
#pragma unroll
    for (int i = 0; i < 4; ++i) {
        const int row = (w * 4 + i) * 8 + (lane >> 3);
        const int kc = (lane & 7) ^ ((row >> 1) & 7);
        int gr = m0 + row;
        if (gr > M - 1) gr = M - 1;
        aoff[i] = (long)gr * lda + kc * 8;
        int gn = n0 + row;
        if (gn > N - 1) gn = N - 1;
        boff[i] = (long)gn * ldb + kc * 8;
    }
    int fa[4], fb[4];
#pragma unroll
    for (int i = 0; i < 4; ++i) {
        const int ra = wm * 64 + i * 16 + (lane & 15), rb = wn * 64 + i * 16 + (lane & 15);
        fa[i] = ra * 128 + ((ra >> 1) & 7) * 16;
        fb[i] = rb * 128 + ((rb >> 1) & 7) * 16;
    }
    const int nk = K / 64;
    u32 keep[2][4][4];
    float* st = (float*)(lds + w * 8704);
#pragma unroll
    for (int pass = 0; pass < 2; ++pass) {
        const u16* Ap = pass ? A2 : A1;
        const u16* BT = pass ? B2 : B1;
        f32x4 acc[4][4];
#pragma unroll
        for (int i = 0; i < 4; ++i)
#pragma unroll
            for (int j = 0; j < 4; ++j) acc[i][j] = f32x4{0.f, 0.f, 0.f, 0.f};
#define GEMM_STAGE2(kt, bufsel)                                                                                                       \
    do {                                                                                                                              \
        unsigned char* ab_ = lds + (bufsel) * 32768 + w * 4096 + lane * 16;                                                           \
        _Pragma("unroll") for (int i_ = 0; i_ < 4; ++i_) {                                                                            \
            __builtin_amdgcn_global_load_lds((const unsigned*)(Ap + aoff[i_] + (long)(kt) * 64), (unsigned*)(ab_ + i_ * 1024), 16, 0, 0); \
            __builtin_amdgcn_global_load_lds((const unsigned*)(BT + boff[i_] + (long)(kt) * 64), (unsigned*)(ab_ + 16384 + i_ * 1024), 16, 0, 0); \
        }                                                                                                                             \
    } while (0)
        GEMM_STAGE2(0, 0);
        asm volatile("s_waitcnt vmcnt(0)" ::: "memory");
        __syncthreads();
        for (int kt = 0; kt < nk; ++kt) {
            if (kt + 1 < nk) GEMM_STAGE2(kt + 1, (kt + 1) & 1);
            const unsigned char* Ab = lds + (kt & 1) * 32768;
            const unsigned char* Bb = Ab + 16384;
            bf16x8 af[2][4], bfr[2][4];
#pragma unroll
            for (int ks = 0; ks < 2; ++ks) {
                const int kc16 = (ks * 4 + (lane >> 4)) * 16;
#pragma unroll
                for (int i = 0; i < 4; ++i) {
                    af[ks][i] = *(const bf16x8*)(Ab + ((fa[i] & ~127) | ((fa[i] & 127) ^ kc16)));
                    bfr[ks][i] = *(const bf16x8*)(Bb + ((fb[i] & ~127) | ((fb[i] & 127) ^ kc16)));
                }
            }
            typedef int i32x4_t __attribute__((ext_vector_type(4)));
#pragma unroll
            for (int i = 0; i < 4; ++i) {
                const i32x4_t a0 = __builtin_bit_cast(i32x4_t, af[0][i]), a1 = __builtin_bit_cast(i32x4_t, af[1][i]);
                const i32x8_t a8 = {a0[0], a0[1], a0[2], a0[3], a1[0], a1[1], a1[2], a1[3]};
#pragma unroll
                for (int j = 0; j < 4; ++j) {
                    const i32x4_t b0 = __builtin_bit_cast(i32x4_t, bfr[0][j]), b1 = __builtin_bit_cast(i32x4_t, bfr[1][j]);
                    const i32x8_t b8 = {b0[0], b0[1], b0[2], b0[3], b1[0], b1[1], b1[2], b1[3]};
                    acc[i][j] = __builtin_amdgcn_mfma_scale_f32_16x16x128_f8f6f4(a8, b8, acc[i][j], 0, 0, 0, 0x7F7F7F7F, 0, 0x77777777);
                }
            }
            asm volatile("s_waitcnt vmcnt(0)" ::: "memory");
            __syncthreads();
        }
#undef GEMM_STAGE2
#pragma unroll
        for (int hh = 0; hh < 2; ++hh) {
#pragma unroll
            for (int m2 = 0; m2 < 2; ++m2)
#pragma unroll
                for (int j = 0; j < 4; ++j)
#pragma unroll
                    for (int r = 0; r < 4; ++r) st[(m2 * 16 + (lane >> 4) * 4 + r) * 68 + j * 16 + (lane & 15)] = acc[hh * 2 + m2][j][r];
            WAVE_SYNC();
#pragma unroll
            for (int c = 0; c < 4; ++c) {
                const int id = c * 64 + lane;
                const int rr = id >> 3, cc = id & 7;
                const float4 v0 = *(const float4*)(st + rr * 68 + cc * 8);
                const float4 v1 = *(const float4*)(st + rr * 68 + cc * 8 + 4);
                const float v[8] = {v0.x, v0.y, v0.z, v0.w, v1.x, v1.y, v1.z, v1.w};
                const int row = m0 + wm * 64 + hh * 32 + rr;
                const int col0 = n0 + wn * 64 + cc * 8;
                if (pass == 0) epi1(row, col0, v, keep[hh][c]);
                else epi2(row, col0, v, keep[hh][c]);
            }
            WAVE_SYNC();
        }
        __syncthreads();
    }
}
__device__ __forceinline__ int grab_block(unsigned* ctr, int limit, unsigned char* smem);
template <int AMODE, bool HAS_RS, int DT = 0, class RowFn, class Epi>
__device__ __forceinline__ void gemm_phase_rs(const u16* Ap, long lda, const u16* BT, long ldb, int M, int N, int K, unsigned char* lds, RowFn rowfn, Epi epi,
                                              const u16* A8 = nullptr, long lda8 = 0, int K8 = 0, int f8lo = 0, int f8hi = 0, unsigned* qctr = nullptr) {
    const int tm = (M + 127) / 128, tn = (N + 127) / 128;
    const int SW = (tn % 9 == 0) ? 9 : ((tn % 8 == 0) ? 8 : 0);
    const int G = gdim();
    if (SW != 0 && (tm % 8) == 0 && (G % 8) == 0 && (((tm / 8) * (tn / SW)) % 8) == 0) {
        const int nsc = tn / SW;
        const int per = 8 * SW;
        const int nst_x = (tm / 8) * nsc / 8;
        const int x = bidx() & 7, j0 = bidx() >> 3, nper = G >> 3;
        for (int q = qctr ? grab_block(qctr + x, nst_x * per, lds) : j0; q >= 0 && q < nst_x * per;
             q = qctr ? grab_block(qctr + x, nst_x * per, lds) : q + nper) {
            const int st = (q / per) * 8 + x;
            const int r = q % per;
            const int nrs = tm / 8;
            const int im = (st % nrs) * 8 + (r % 8), in = (st / nrs) * SW + (r / 8);
            if (in >= f8lo && in < f8hi) gemm_tile<AMODE, HAS_RS, 1>(A8, lda8, BT, ldb, M, N, K8, im * 128, in * 128, lds, rowfn, epi);
            else gemm_tile<AMODE, HAS_RS, DT>(Ap, lda, BT, ldb, M, N, K, im * 128, in * 128, lds, rowfn, epi);
        }
    } else {
        for (int t = bidx(); t < tm * tn; t += G) {
            int im = t / tn, in = t - im * tn;
            if (in >= f8lo && in < f8hi) gemm_tile<AMODE, HAS_RS, 1>(A8, lda8, BT, ldb, M, N, K8, im * 128, in * 128, lds, rowfn, epi);
            else gemm_tile<AMODE, HAS_RS, DT>(Ap, lda, BT, ldb, M, N, K, im * 128, in * 128, lds, rowfn, epi);
        }
    }
}
template <int AMODE, int DT = 0, class Epi>
__device__ __forceinline__ void gemm_phase(const u16* Ap, long lda, const u16* BT, long ldb, int M, int N, int K, unsigned char* lds, Epi epi) {
    gemm_phase_rs<AMODE, false, DT>(Ap, lda, BT, ldb, M, N, K, lds, [](int) { return float2{1.f, 1.f}; },
                                [=](int row, int col, const float (&v)[8], float2) { epi(row, col, v); });
}
__device__ __forceinline__ void st_bf8(u16* p, const float (&v)[8]) {
    *(uint4*)p = uint4{pack2(v[0], v[1]), pack2(v[2], v[3]), pack2(v[4], v[5]), pack2(v[6], v[7])};
}
__device__ __forceinline__ void ld_bf8(const u16* p, float (&v)[8]) {
    const uint4 q = *(const uint4*)p;
    v[0] = bf_lo(q.x); v[1] = bf_hi(q.x); v[2] = bf_lo(q.y); v[3] = bf_hi(q.y);
    v[4] = bf_lo(q.z); v[5] = bf_hi(q.z); v[6] = bf_lo(q.w); v[7] = bf_hi(q.w);
}

__device__ __forceinline__ int fp8x4(float a, float b, float c, float d) {
    int x = 0;
    x = __builtin_amdgcn_cvt_pk_fp8_f32(a, b, x, false);
    x = __builtin_amdgcn_cvt_pk_fp8_f32(c, d, x, true);
    return x;
}
__device__ __forceinline__ void st_fp8(unsigned char* p, const float (&v)[8]) {
    int x0 = 0, x1 = 0;
    x0 = __builtin_amdgcn_cvt_pk_fp8_f32(v[0], v[1], x0, false);
    x0 = __builtin_amdgcn_cvt_pk_fp8_f32(v[2], v[3], x0, true);
    x1 = __builtin_amdgcn_cvt_pk_fp8_f32(v[4], v[5], x1, false);
    x1 = __builtin_amdgcn_cvt_pk_fp8_f32(v[6], v[7], x1, true);
    *(uint2*)p = uint2{(u32)x0, (u32)x1};
}
__device__ __forceinline__ void ld_fp8(const unsigned char* p, float (&v)[8]) {
    typedef float f2_t __attribute__((ext_vector_type(2)));
    const uint2 q = *(const uint2*)p;
    const f2_t a = __builtin_amdgcn_cvt_pk_f32_fp8((int)q.x, false), b = __builtin_amdgcn_cvt_pk_f32_fp8((int)q.x, true);
    const f2_t c = __builtin_amdgcn_cvt_pk_f32_fp8((int)q.y, false), d = __builtin_amdgcn_cvt_pk_f32_fp8((int)q.y, true);
    v[0] = a[0]; v[1] = a[1]; v[2] = b[0]; v[3] = b[1]; v[4] = c[0]; v[5] = c[1]; v[6] = d[0]; v[7] = d[1];
}
template <bool PERM = false>
__device__ __forceinline__ void transpose_cvt(const float* __restrict__ src, u16* __restrict__ dst, int K, int N, float* tile, int& rot, const float* kgain = nullptr,
                                              int n8lo = 0, int n8hi = 0) {
    const int tk = K / 64, tn = (N + 63) / 64;
    const int tid = tidx();
    const int G_ = gdim();
    int t0_ = (bidx() - rot % G_ + G_) % G_;
    rot += tk * tn;
    for (int t = t0_; t < tk * tn; t += G_) {
        const int k0 = (t / tn) * 64, n0 = (t % tn) * 64;
        {
            const int tx = tid & 15, ty = tid >> 4;
#pragma unroll
            for (int i = 0; i < 4; ++i) {
                const int k = ty * 4 + i, n = n0 + tx * 4;
                float4 v = float4{0.f, 0.f, 0.f, 0.f};
                if (n < N) v = *(const float4*)(src + (long)(k0 + k) * N + n);
                const float g = kgain ? kgain[k0 + k] : 1.0f;
                float* trow = tile + k * 65 + tx * 4;
                trow[0] = v.x * g; trow[1] = v.y * g; trow[2] = v.z * g; trow[3] = v.w * g;
            }
        }
        __syncthreads();
        {
            const int kc = tid & 7, nl = tid >> 3;
#pragma unroll
            for (int j = 0; j < 2; ++j) {
                const int nn = nl + 32 * j, n = n0 + nn;
                float v[8];
#pragma unroll
                for (int q = 0; q < 8; ++q) v[q] = tile[(kc * 8 + q) * 65 + nn];
                if (n < N) {
                    const int pn = PERM ? perm_col(n) : n;
                    if (pn >= n8lo && pn < n8hi) {
#pragma unroll
                        for (int q = 0; q < 8; ++q) v[q] *= 256.0f;
                        st_fp8((unsigned char*)(dst + (long)pn * K) + k0 + kc * 8, v);
                    } else {
                        st_bf8(dst + (long)pn * K + k0 + kc * 8, v);
                    }
                }
            }
        }
        __syncthreads();
    }
}

__device__ __forceinline__ void cvt_f32_fp8(const float* __restrict__ src, unsigned char* __restrict__ dst, long n) {
    long i = ((long)bidx() * 256 + tidx()) * 8;
    const long stride = (long)gdim() * 256 * 8;
    for (; i < n; i += stride) {
        float4 a = *(const float4*)(src + i);
        float4 b = *(const float4*)(src + i + 4);
        *(uint2*)(dst + i) = uint2{(u32)fp8x4(a.x, a.y, a.z, a.w), (u32)fp8x4(b.x, b.y, b.z, b.w)};
    }
}
__device__ __forceinline__ void cvt_f32_bf16(const float* __restrict__ src, u16* __restrict__ dst, long n) {
    long i = ((long)bidx() * 256 + tidx()) * 8;
    const long stride = (long)gdim() * 256 * 8;
    for (; i < n; i += stride) {
        float4 a = *(const float4*)(src + i);
        float4 b = *(const float4*)(src + i + 4);
        *(uint4*)(dst + i) = uint4{pack2(a.x, a.y), pack2(a.z, a.w), pack2(b.x, b.y), pack2(b.z, b.w)};
    }
}

typedef float f32x2_t __attribute__((ext_vector_type(2)));
typedef u32 u32x3_t __attribute__((ext_vector_type(3)));
typedef u32x3_t u32x3_a4 __attribute__((aligned(4)));
constexpr int EROW = 768;
__device__ __forceinline__ u32 enc_e2m3(float y) {
    const float a = fabsf(y);
    const float m = a < 2.f ? 8.f : (a < 4.f ? 4.f : 2.f);
    const int off = a < 2.f ? 0 : (a < 4.f ? 8 : 16);
    int c = (int)rintf(a * m) + off;
    c = c > 31 ? 31 : c;
    return (u32)c | (y < 0.f ? 32u : 0u);
}
__device__ __forceinline__ void cvt_rows_fp6(const float* __restrict__ src, unsigned char* __restrict__ dst, float* __restrict__ scales, int nrows, const float* colgain = nullptr) {
    const int lane = tidx() & 63;
    const int wid = bidx() * 4 + (tidx() >> 6);
    const int nw = gdim() * 4;
    for (int row = wid; row < nrows; row += nw) {
        const float* r = src + (long)row * 1024 + lane * 16;
        float4 q[4];
#pragma unroll
        for (int i = 0; i < 4; ++i) {
            q[i] = *(const float4*)(r + 4 * i);
            if (colgain) {
                const float4 g = *(const float4*)(colgain + lane * 16 + 4 * i);
                q[i].x *= g.x; q[i].y *= g.y; q[i].z *= g.z; q[i].w *= g.w;
            }
        }
        float am = 0.f;
#pragma unroll
        for (int i = 0; i < 4; ++i) am = fmaxf(am, fmaxf(fmaxf(fabsf(q[i].x), fabsf(q[i].y)), fmaxf(fabsf(q[i].z), fabsf(q[i].w))));
        am = wmax(am);
        const float inv = am > 0.f ? 7.5f / am : 0.f;
        if (lane == 0) scales[row] = am > 0.f ? am * (1.0f / 7.5f) : 0.f;
        u32 c[16];
#pragma unroll
        for (int i = 0; i < 4; ++i) {
            c[4 * i] = enc_e2m3(q[i].x * inv); c[4 * i + 1] = enc_e2m3(q[i].y * inv);
            c[4 * i + 2] = enc_e2m3(q[i].z * inv); c[4 * i + 3] = enc_e2m3(q[i].w * inv);
        }
        const u32 w0 = c[0] | (c[1] << 6) | (c[2] << 12) | (c[3] << 18) | (c[4] << 24) | (c[5] << 30);
        const u32 w1 = (c[5] >> 2) | (c[6] << 4) | (c[7] << 10) | (c[8] << 16) | (c[9] << 22) | (c[10] << 28);
        const u32 w2 = (c[10] >> 4) | (c[11] << 2) | (c[12] << 8) | (c[13] << 14) | (c[14] << 20) | (c[15] << 26);
        *(u32x3_a4*)(dst + (long)row * EROW + lane * 12) = u32x3_t{w0, w1, w2};
    }
}

constexpr int VROW = 512;
__device__ __forceinline__ u32 enc_e2m1(float y) {
    const float a = fabsf(y);
    const float m = a < 2.f ? 2.f : (a < 4.f ? 1.f : 0.5f);
    const int off = a < 2.f ? 0 : (a < 4.f ? 2 : 4);
    int c = (int)rintf(a * m) + off;
    c = c > 7 ? 7 : c;
    return (u32)c | (y < 0.f ? 8u : 0u);
}
__device__ __forceinline__ void cvt_rows_fp4(const float* __restrict__ src, unsigned char* __restrict__ dst, float* __restrict__ scales, int nrows, const float* colgain = nullptr) {
    const int lane = tidx() & 63;
    const int wid = bidx() * 4 + (tidx() >> 6);
    const int nw = gdim() * 4;
    for (int row = wid; row < nrows; row += nw) {
        const float* r = src + (long)row * 1024 + lane * 16;
        float4 q[4];
#pragma unroll
        for (int i = 0; i < 4; ++i) {
            q[i] = *(const float4*)(r + 4 * i);
            if (colgain) {
                const float4 g = *(const float4*)(colgain + lane * 16 + 4 * i);
                q[i].x *= g.x; q[i].y *= g.y; q[i].z *= g.z; q[i].w *= g.w;
            }
        }
        float am = 0.f;
#pragma unroll
        for (int i = 0; i < 4; ++i) am = fmaxf(am, fmaxf(fmaxf(fabsf(q[i].x), fabsf(q[i].y)), fmaxf(fabsf(q[i].z), fabsf(q[i].w))));
        am = wmax(am);
        const float inv = am > 0.f ? 6.0f / am : 0.f;
        if (lane == 0) scales[row] = am > 0.f ? am * (1.0f / 6.0f) : 0.f;
        u32 wv[2];
#pragma unroll
        for (int h = 0; h < 2; ++h) {
            const float4 lo = q[2 * h], hi = q[2 * h + 1];
            wv[h] = enc_e2m1(lo.x * inv) | (enc_e2m1(lo.y * inv) << 4) | (enc_e2m1(lo.z * inv) << 8) | (enc_e2m1(lo.w * inv) << 12) |
                    (enc_e2m1(hi.x * inv) << 16) | (enc_e2m1(hi.y * inv) << 20) | (enc_e2m1(hi.z * inv) << 24) | (enc_e2m1(hi.w * inv) << 28);
        }
        *(uint2*)(dst + (long)row * VROW + lane * 8) = uint2{wv[0], wv[1]};
    }
}

__device__ __forceinline__ void rms_rows(const float* __restrict__ x, const float* __restrict__ g, u16* __restrict__ dst, const u16* __restrict__ e,
                         float* __restrict__ rstd_e) {
    const int lane = tidx() & 63;
    const int wid = bidx() * 4 + (tidx() >> 6);
    const int nw = gdim() * 4;
    for (int row = wid; row < NTOK; row += nw) {
        const float* xr = x + (long)row * 1024;
        float4 v[4];
        float ss = 0.f;
#pragma unroll
        for (int i = 0; i < 4; ++i) {
            v[i] = *(const float4*)(xr + i * 256 + lane * 4);
            ss += v[i].x * v[i].x + v[i].y * v[i].y + v[i].z * v[i].z + v[i].w * v[i].w;
        }
        ss = wsum(ss);
        float rstd = rsqrtf(ss * (1.0f / 1024.0f) + EPS);
#pragma unroll
        for (int i = 0; i < 4; ++i) {
            float4 gg = g ? *(const float4*)(g + i * 256 + lane * 4) : float4{1.f, 1.f, 1.f, 1.f};
            uint2 o = uint2{pack2(v[i].x * rstd * gg.x, v[i].y * rstd * gg.y), pack2(v[i].z * rstd * gg.z, v[i].w * rstd * gg.w)};
            *(uint2*)(dst + (long)row * 1024 + i * 256 + lane * 4) = o;
        }
        if (e) {
            const uint4* er = (const uint4*)(e + (long)row * 1024);
            float es = 0.f;
#pragma unroll
            for (int i = 0; i < 2; ++i) {
                uint4 q = er[i * 64 + lane];
                float a;
                a = bf_lo(q.x); es += a * a; a = bf_hi(q.x); es += a * a;
                a = bf_lo(q.y); es += a * a; a = bf_hi(q.y); es += a * a;
                a = bf_lo(q.z); es += a * a; a = bf_hi(q.z); es += a * a;
                a = bf_lo(q.w); es += a * a; a = bf_hi(q.w); es += a * a;
            }
            es = wsum(es);
            if (lane == 0) rstd_e[row] = rsqrtf(es * (1.0f / 1024.0f) + EPS);
        }
    }
}

__device__ __forceinline__ void head_chunk(u16* ptr, float gain, bool do_norm, float scale, float c, float sn, int lane) {
    float v = bf2f(ptr[lane]);
    if (do_norm) {
        float ss = wsum(v * v);
        v = v * rsqrtf(ss * (1.0f / 64.0f) + EPS) * gain;
    }
    float pv = __shfl_xor(v, 8);
    if (lane < 16) v = (lane < 8) ? (v * c - pv * sn) : (v * c + pv * sn);
    ptr[lane] = f2bf(v * scale);
}
__device__ __forceinline__ u32 sig2(u32 w) { return pack2(sigmoidf(bf_lo(w)), sigmoidf(bf_hi(w))); }

__device__ __forceinline__ void post_proj(unsigned char* ws, const float* ng, const float* dg, unsigned char* smem) {
    u16* proj = (u16*)(ws + OFF_PROJ);
    const float* ropec = (const float*)(ws + OFF_ROPE);
    const float* ropes = ropec + (size_t)NTOK * 8;
    const int lane = tidx() & 63, w = tidx() >> 6;
    u16* lrow = (u16*)(smem + w * 9216);
    const float g_q = ng[lane], g_ks = ng[128 + lane], g_kw = ng[192 + lane], g_dq = dg[lane], g_kb = dg[64 + lane];
    const int wid = bidx() * 4 + w;
    const int nw = gdim() * 4;
    for (int t = wid; t < NTOK; t += nw) {
        uint4* grow = (uint4*)(proj + (long)t * IN_COLS);
        const float c = ropec[(long)t * 8 + (lane & 7)], sn = ropes[(long)t * 8 + (lane & 7)];
#pragma unroll
        for (int i = 0; i < 8; ++i) ((uint4*)lrow)[i * 64 + lane] = grow[i * 64 + lane];
        if (lane < 60) ((uint4*)lrow)[512 + lane] = grow[512 + lane];
        WAVE_SYNC();
        for (int h = 0; h < 8; ++h) head_chunk(lrow + C_NQ + h * 64, g_q, true, 0.125f * 1.4426950408889634f, c, sn, lane);
        for (int g = 0; g < 2; ++g) head_chunk(lrow + C_NKV + (2 * 2 + g) * 64, g_ks, true, 1.0f, c, sn, lane);
        for (int g = 0; g < 2; ++g) head_chunk(lrow + C_NKV + (4 * 2 + g) * 64, g_kw, true, 1.0f, c, sn, lane);
        for (int h = 0; h < 8; ++h) head_chunk(lrow + C_DQ + h * 64, g_dq, true, 0.125f * 1.4426950408889634f, c, sn, lane);
        head_chunk(lrow + C_DKV, g_kb, true, 1.0f, c, sn, lane);
        for (int h = 0; h < 8; ++h) head_chunk(lrow + C_IQ + h * 64, 1.0f, false, 0.125f, c, sn, lane);
        head_chunk(lrow + C_IK, 1.0f, false, 1.0f, c, sn, lane);
        WAVE_SYNC();
#pragma unroll
        for (int i = 0; i < 9; ++i) {
            int idx = i * 64 + lane;
            if (idx < 572) {
                uint4 v = ((const uint4*)lrow)[idx];
                if (idx >= 316 || (idx >= 160 && idx < 163)) v = uint4{sig2(v.x), sig2(v.y), sig2(v.z), sig2(v.w)};
                grow[idx] = v;
            }
        }
        WAVE_SYNC();
    }
}

template <int NH>
__device__ __forceinline__ void qk_chunk(const u16* krow, const u32* qlds, float (&s)[NH]) {
    asm volatile("" ::: "memory");
    uint4 kr[8];
#pragma unroll
    for (int i = 0; i < 8; ++i) kr[i] = ((const uint4*)krow)[i];
#pragma unroll
    for (int h = 0; h < NH; ++h) s[h] = 0.f;
#pragma unroll
    for (int i = 0; i < 8; ++i)
#pragma unroll
        for (int h = 0; h < NH; ++h) {
            uint4 q = *(const uint4*)(qlds + h * 32 + i * 4);
            s[h] = dot2(kr[i].x, q.x, s[h]);
            s[h] = dot2(kr[i].y, q.y, s[h]);
            s[h] = dot2(kr[i].z, q.z, s[h]);
            s[h] = dot2(kr[i].w, q.w, s[h]);
        }
}

template <int NH, class VRow>
__device__ __forceinline__ void pv_chunk(const float* plds, VRow vrow, float (&o)[NH][4], int lane) {
    const int sub = lane >> 4, dq = lane & 15;
#pragma unroll 4
    for (int kk = 0; kk < 16; ++kk) {
        int key = kk * 4 + sub;
        const u16* vp = vrow(key);
        uint2 vv = *(const uint2*)(vp + dq * 4);
        float v0 = bf_lo(vv.x), v1 = bf_hi(vv.x), v2 = bf_lo(vv.y), v3 = bf_hi(vv.y);
#pragma unroll
        for (int h = 0; h < NH; ++h) {
            float ph = plds[key * NH + h];
            o[h][0] += ph * v0;
            o[h][1] += ph * v1;
            o[h][2] += ph * v2;
            o[h][3] += ph * v3;
        }
    }
}

template <int NH, class VRow>
__device__ __forceinline__ void attn_chunk(float (&s)[NH], bool valid, float (&m)[NH], float (&l)[NH], float (&o)[NH][4], float* plds, VRow vrow,
                                           int lane) {
#pragma unroll
    for (int h = 0; h < NH; ++h) {
        float sv = valid ? s[h] : -1e30f;
        float cm = wmax(sv);
        float mn = fmaxf(m[h], cm);
        float alpha = __expf(m[h] - mn);
        float p = valid ? __expf(sv - mn) : 0.f;
        l[h] = l[h] * alpha + wsum(p);
        m[h] = mn;
#pragma unroll
        for (int j = 0; j < 4; ++j) o[h][j] *= alpha;
        plds[lane * NH + h] = p;
    }
    WAVE_SYNC();
    pv_chunk<NH>(plds, vrow, o, lane);
    WAVE_SYNC();
}

#define MFMA32(a, b, c) __builtin_amdgcn_mfma_f32_32x32x16_bf16(a, b, c, 0, 0, 0)
typedef __attribute__((address_space(3))) const char* lds_cptr;
typedef short v4i16_t __attribute__((ext_vector_type(4)));
using s16x4 = __attribute__((ext_vector_type(4))) short;
__device__ __forceinline__ s16x4 vtr(lds_cptr p) {
    return __builtin_bit_cast(s16x4, __builtin_amdgcn_ds_read_tr16_b64_v4i16((__attribute__((address_space(3))) v4i16_t*)p));
}
__device__ __forceinline__ float xhalf_sum(float v) {
    auto r = __builtin_amdgcn_permlane32_swap(__float_as_uint(v), __float_as_uint(v), false, false);
    return __uint_as_float(r[0]) + __uint_as_float(r[1]);
}
__device__ __forceinline__ float xhalf_max(float v) {
    auto r = __builtin_amdgcn_permlane32_swap(__float_as_uint(v), __float_as_uint(v), false, false);
    return fmaxf(__uint_as_float(r[0]), __uint_as_float(r[1]));
}

using u32x4 = __attribute__((ext_vector_type(4))) unsigned;
struct TileRegs { u32x4 k0, k1, v0, v1; };
template <class RowPtr>
__device__ __forceinline__ void tile_load(u32x4& k0, u32x4& k1, u32x4& v0, u32x4& v1, RowPtr rowptr, int w, int lane) {
    const u16 *kp, *vp, *kp2, *vp2;
    rowptr(lane, kp, vp2);
    rowptr(16 * w + (lane >> 2), kp2, vp);
    k0 = *(const u32x4*)(kp + w * 8);
    k1 = *(const u32x4*)(kp + (w + 4) * 8);
    v0 = *(const u32x4*)(vp + (lane & 3) * 8);
    v1 = *(const u32x4*)(vp + 32 + (lane & 3) * 8);
}
__device__ __forceinline__ void tile_store(const u32x4& k0, const u32x4& k1, const u32x4& v0, const u32x4& v1, unsigned char* buf, int w, int lane) {
    *(u32x4*)(buf + w * 1024 + lane * 16) = k0;
    *(u32x4*)(buf + (w + 4) * 1024 + lane * 16) = k1;
    *(u32x4*)(buf + 8192 + (16 * w + (lane >> 2)) * 64 + (lane & 3) * 16) = v0;
    *(u32x4*)(buf + 8192 + 4096 + (16 * w + (lane >> 2)) * 64 + (lane & 3) * 16) = v1;
}
__device__ __forceinline__ void glds16(const void* g, unsigned lds_base) {
    unsigned sv;
    asm volatile("s_mov_b32 %0, m0\n\ts_mov_b32 m0, %2\n\ts_nop 0\n\tglobal_load_lds_dwordx4 %1, off\n\ts_mov_b32 m0, %0"
                 : "=&s"(sv)
                 : "v"(g), "s"(lds_base)
                 : "memory");
}
template <class RowPtr>
__device__ __forceinline__ void tile_dma(RowPtr rowptr, unsigned char* buf, int w, int lane) {
    const u16 *kp, *vp, *kp2, *vp2;
    rowptr(lane, kp, vp2);
    rowptr(16 * w + (lane >> 2), kp2, vp);
    const unsigned kd = (unsigned)__builtin_amdgcn_readfirstlane((int)((unsigned)(uintptr_t)buf + (unsigned)(w * 1024)));
    const unsigned vd = kd + 8192u;
    glds16(kp + w * 8, kd);
    glds16(kp + (w + 4) * 8, kd + 4096u);
    glds16(vp + (lane & 3) * 8, vd);
    glds16(vp + 32 + (lane & 3) * 8, vd + 4096u);
}
__device__ __forceinline__ void qk_tile(const unsigned char* buf, const bf16x8 (&qr)[4], const f32x16& zero16, f32x16& s0, f32x16& s1, int lane) {
    const int r32 = lane & 31, hi = lane >> 5;
    lds_cptr kp = (lds_cptr)buf + hi * 1024 + r32 * 16;
#pragma unroll
    for (int d0 = 0; d0 < 4; ++d0) {
        bf16x8 k0 = *(const __attribute__((address_space(3))) bf16x8*)(kp + d0 * 2048);
        bf16x8 k1 = *(const __attribute__((address_space(3))) bf16x8*)(kp + d0 * 2048 + 512);
        s0 = MFMA32(k0, qr[d0], d0 == 0 ? zero16 : s0);
        s1 = MFMA32(k1, qr[d0], d0 == 0 ? zero16 : s1);
    }
}
__device__ __forceinline__ bf16x8 pack8(const f32x16& p, int s) {
    u32 a = pack2(p[8 * s + 0], p[8 * s + 1]), b = pack2(p[8 * s + 2], p[8 * s + 3]);
    u32 c = pack2(p[8 * s + 4], p[8 * s + 5]), d = pack2(p[8 * s + 6], p[8 * s + 7]);
    u32x4 v = u32x4{a, b, c, d};
    return __builtin_bit_cast(bf16x8, v);
}
__device__ __forceinline__ void pv_tile(const unsigned char* buf, const f32x16& p0, const f32x16& p1, f32x16 (&o)[2], int lane) {
    const int hi = lane >> 5;
    lds_cptr vp = (lds_cptr)buf + 8192 + ((lane >> 4) & 1) * 32 + (lane & 3) * 8 + (4 * hi + ((lane & 15) >> 2)) * 64;
    bf16x8 pf[4];
    pf[0] = pack8(p0, 0);
    pf[1] = pack8(p0, 1);
    pf[2] = pack8(p1, 0);
    pf[3] = pack8(p1, 1);
#pragma unroll
    for (int dh = 0; dh < 2; ++dh) {
        bf16x8 vf[4];
#pragma unroll
        for (int ks = 0; ks < 4; ++ks) {
            const uint2 vlo = __builtin_bit_cast(uint2, vtr(vp + dh * 4096 + ks * 1024));
            const uint2 vhi = __builtin_bit_cast(uint2, vtr(vp + dh * 4096 + ks * 1024 + 512));
            const u32x4 vq = u32x4{vlo.x, vlo.y, vhi.x, vhi.y};
            vf[ks] = __builtin_bit_cast(bf16x8, vq);
        }
        __builtin_amdgcn_sched_barrier(0);
#pragma unroll
        for (int ks = 0; ks < 4; ++ks) o[dh] = MFMA32(vf[ks], pf[ks], o[dh]);
        __builtin_amdgcn_sched_barrier(0);
    }
}
template <bool BITS>
__device__ __forceinline__ void apply_mask(f32x16& s0, f32x16& s1, int lo, int hi_lim, u64 word, int hi) {
    const u32 wlo = (u32)(word >> (4 * hi)), whi = (u32)(word >> (32 + 4 * hi));
#pragma unroll
    for (int i = 0; i < 16; ++i) {
        const int kc = (i & 3) + 8 * (i >> 2);
        bool v0, v1;
        if (BITS) {
            v0 = (wlo >> kc) & 1u;
            v1 = (whi >> kc) & 1u;
        } else {
            const int kk = kc + 4 * hi;
            v0 = (kk >= lo) && (kk <= hi_lim);
            v1 = (kk + 32 >= lo) && (kk + 32 <= hi_lim);
        }
        s0[i] = v0 ? s0[i] : -1e30f;
        s1[i] = v1 ? s1[i] : -1e30f;
    }
}
__device__ __forceinline__ void softmax_step(f32x16& s0, f32x16& s1, float& m, float& l, f32x16 (&o)[2]) {
    float mx = fmaxf(s0[0], s1[0]);
#pragma unroll
    for (int i = 1; i < 16; ++i) mx = fmaxf(fmaxf(mx, s0[i]), s1[i]);
    mx = xhalf_max(mx);
    if (__any(mx > m + 8.0f)) {
        const float mn = fmaxf(m, mx);
        const float alpha = __builtin_amdgcn_exp2f(m - mn);
        l *= alpha;
        m = mn;
#pragma unroll
        for (int i = 0; i < 16; ++i) { o[0][i] *= alpha; o[1][i] *= alpha; }
    }
    const float ms = fmaxf(m, -1e29f);
    float sum = 0.f;
#pragma unroll
    for (int i = 0; i < 16; ++i) {
        s0[i] = __builtin_amdgcn_exp2f(s0[i] - ms);
        s1[i] = __builtin_amdgcn_exp2f(s1[i] - ms);
        sum += s0[i] + s1[i];
    }
    l += xhalf_sum(sum);
}

template <int MODE, bool BITS, class Next, class RowPtr, class MaskFn, class Extra>
__device__ __forceinline__ void flash_run(int first, Next next, RowPtr rowptr, MaskFn maskfn, Extra extra, const bf16x8 (&qr)[4], float& m, float& l,
                                          f32x16 (&o)[2], unsigned char* bufs, int w, int lane) {
    if (first < 0) return;
    int cur = first;
    int nxt = next(cur);
    asm volatile("" ::"v"(qr[0]), "v"(qr[1]), "v"(qr[2]), "v"(qr[3]));
    __syncthreads();
    tile_dma([&](int r, const u16*& kp, const u16*& vp) { rowptr(cur, r, kp, vp); }, bufs, w, lane);
    if (nxt >= 0) tile_dma([&](int r, const u16*& kp, const u16*& vp) { rowptr(nxt, r, kp, vp); }, bufs + 16384, w, lane);
    int pb = 0, pb2 = 2;
    f32x16 zero16;
#pragma unroll
    for (int i = 0; i < 16; ++i) zero16[i] = 0.f;
    while (cur >= 0) {
        if (nxt >= 0) asm volatile("s_waitcnt vmcnt(4)" ::: "memory");
        else asm volatile("s_waitcnt vmcnt(0)" ::: "memory");
        asm volatile("s_waitcnt lgkmcnt(0)" ::: "memory");
        __builtin_amdgcn_s_barrier();
        const int nn = nxt >= 0 ? next(nxt) : -1;
        if (nn >= 0) tile_dma([&](int r, const u16*& kp, const u16*& vp) { rowptr(nn, r, kp, vp); }, bufs + pb2 * 16384, w, lane);
        const unsigned char* buf = bufs + pb * 16384;
        f32x16 s0, s1;
        qk_tile(buf, qr, zero16, s0, s1, lane);
        int lo, hl;
        u64 word;
        maskfn(cur, lo, hl, word);
        if (BITS || !__all(lo <= 0 && hl >= 63)) apply_mask<BITS>(s0, s1, lo, hl, word, lane >> 5);
        if (MODE == 0) {
            softmax_step(s0, s1, m, l, o);
            pv_tile(buf, s0, s1, o, lane);
        } else if (MODE == 1) {
            f32x16 od[2];
#pragma unroll
            for (int i = 0; i < 16; ++i) { od[0][i] = 0.f; od[1][i] = 0.f; }
            softmax_step(s0, s1, m, l, od);
        } else {
            const float ms2 = fmaxf(m, -1e29f);
#pragma unroll
            for (int i = 0; i < 16; ++i) {
                s0[i] = __builtin_amdgcn_exp2f(s0[i] - ms2) * l;
                s1[i] = __builtin_amdgcn_exp2f(s1[i] - ms2) * l;
            }
            extra(cur, s0, s1);
            pv_tile(buf, s0, s1, o, lane);
        }
        pb = (pb == 2) ? 0 : pb + 1;
        pb2 = (pb2 == 2) ? 0 : pb2 + 1;
        cur = nxt;
        nxt = nn;
    }
}

__device__ __forceinline__ void nsa_unit(unsigned char* ws, int b, int g, int qt, unsigned char* smem) {
    const int tid = tidx(), lane = tid & 63, w = tid >> 6;
    const int r32 = lane & 31, hi = lane >> 5;
    const int q0 = qt * 32;
    const int tl = q0 + 8 * w + (r32 >> 2);
    const int rep = r32 & 3;
    const u16* proj = (const u16*)(ws + OFF_PROJ);
    const u16* brow = proj + (long)b * SEQ * IN_COLS;
    const u16* kcb = (const u16*)(ws + OFF_KCB) + (size_t)(b * 2 + g) * 256 * 64;
    const u16* vcb = (const u16*)(ws + OFF_VCB) + (size_t)(b * 2 + g) * 256 * 64;
    u16* ya = (u16*)(ws + OFF_YAB);
    unsigned char* bufs = smem;
    float* imp = (float*)(smem + 49152);
    u64* selm = (u64*)(smem + 49152 + 8192);
    const u16* trow = brow + (long)tl * IN_COLS;
    bf16x8 qr[4];
#pragma unroll
    for (int d0 = 0; d0 < 4; ++d0) qr[d0] = *(const bf16x8*)(trow + C_NQ + (g * 4 + rep) * 64 + d0 * 16 + hi * 8);
    const float gate_c = bf2f(trow[C_NG + 0 * 8 + g * 4 + rep]);
    const float gate_s = bf2f(trow[C_NG + 1 * 8 + g * 4 + rep]);
    const float gate_w = bf2f(trow[C_NG + 2 * 8 + g * 4 + rep]);
    for (int i = tid; i < 32 * 64; i += 256) imp[i] = 0.f;
    f32x16 tot[2];
#pragma unroll
    for (int i = 0; i < 16; ++i) { tot[0][i] = 0.f; tot[1][i] = 0.f; }

    const int nvalid = tl >= 31 ? ((tl - 31) >> 4) + 1 : 0;
    const int nv_max = (q0 + 31 >= 31) ? ((q0 + 31 - 31) >> 4) + 1 : 0;
    const int ntile_c = (nv_max + 63) >> 6;
    auto crows = [&](int tile, int r, const u16*& kp, const u16*& vp) {
        int n = tile * 64 + r;
        n = n < 254 ? n : 254;
        kp = kcb + (size_t)n * 64;
        vp = vcb + (size_t)n * 64;
    };
    auto cnext = [&](int c) { return (c + 1 < ntile_c) ? c + 1 : -1; };
    auto cmask = [&](int tile, int& lo, int& hl, u64& word) { lo = 0; hl = nvalid - 64 * tile - 1; word = 0; };
    {
        float m = -1e30f, l = 0.f;
        f32x16 o[2];
#pragma unroll
        for (int i = 0; i < 16; ++i) { o[0][i] = 0.f; o[1][i] = 0.f; }
        flash_run<1, false>(ntile_c > 0 ? 0 : -1, cnext, crows, cmask, [&](int, f32x16&, f32x16&) {}, qr, m, l, o, bufs, w, lane);
        float invl = l > 0.f ? 1.0f / l : 0.f;
        const int qloc = 8 * w + (r32 >> 2);
        flash_run<2, false>(ntile_c > 0 ? 0 : -1, cnext, crows, cmask,
                            [&](int tile, f32x16& p0, f32x16& p1) {
#pragma unroll
                                for (int a = 0; a < 4; ++a) {
                                    float g0 = p0[4 * a] + p0[4 * a + 1] + p0[4 * a + 2] + p0[4 * a + 3], e0 = p0[4 * a + 3];
                                    float g1 = p1[4 * a] + p1[4 * a + 1] + p1[4 * a + 2] + p1[4 * a + 3], e1 = p1[4 * a + 3];
                                    g0 += __shfl_xor(g0, 1); g0 += __shfl_xor(g0, 2);
                                    e0 += __shfl_xor(e0, 1); e0 += __shfl_xor(e0, 2);
                                    g1 += __shfl_xor(g1, 1); g1 += __shfl_xor(g1, 2);
                                    e1 += __shfl_xor(e1, 1); e1 += __shfl_xor(e1, 2);
                                    if (rep == 0) {
                                        int j0 = 16 * tile + 2 * a + hi, j1 = j0 + 8;
                                        atomicAdd(&imp[qloc * 64 + j0], g0);
                                        if (j0 + 1 < 64) atomicAdd(&imp[qloc * 64 + j0 + 1], e0);
                                        if (j1 < 64) atomicAdd(&imp[qloc * 64 + j1], g1);
                                        if (j1 + 1 < 64) atomicAdd(&imp[qloc * 64 + j1 + 1], e1);
                                    }
                                }
                            },
                            qr, m, invl, o, bufs, w, lane);
#pragma unroll
        for (int i = 0; i < 16; ++i) { tot[0][i] += gate_c * o[0][i]; tot[1][i] += gate_c * o[1][i]; }
    }
    __syncthreads();
    for (int qq = 0; qq < 8; ++qq) {
        const int qi = 8 * w + qq;
        const int tq = q0 + qi;
        const int cur = tq >> 6;
        const int j = lane;
        float v = imp[qi * 64 + j];
        if (j == 0 || j == cur || j == cur - 1) v = __builtin_inff();
        if (j > cur) v = -__builtin_inff();
        const u32 key = sortkey(v);
        u32 Kq = 0u;
        for (int bit = 31; bit >= 0; --bit) {
            const u32 cand = Kq | (1u << bit);
            const int cnt = __popcll(__ballot(key >= cand));
            if (cnt >= 16) Kq = cand;
            if (cnt == 16) break;
        }
        const int needq = 16 - __popcll(__ballot(key > Kq));
        const u64 emq = __ballot(key == Kq);
        const bool takeq = (key > Kq) || (key == Kq && __popcll(emq & ((1ull << lane) - 1ull)) < needq);
        u64 sm = __ballot(takeq && j <= cur);
        if (lane == 0) selm[qi] = sm;
    }
    __syncthreads();
    const u64 mymask = selm[8 * w + (r32 >> 2)];
    u64 unionm = 0;
    for (int i = 0; i < 32; ++i) unionm |= selm[i];
    unionm = __builtin_amdgcn_readfirstlane((u32)unionm) | ((u64)__builtin_amdgcn_readfirstlane((u32)(unionm >> 32)) << 32);
    {
        float m = -1e30f, l = 0.f;
        f32x16 o[2];
#pragma unroll
        for (int i = 0; i < 16; ++i) { o[0][i] = 0.f; o[1][i] = 0.f; }
        auto snext = [&](int c) {
            u64 rest = (c >= 63) ? 0ull : (unionm >> (c + 1));
            return rest ? (c + 1 + (__ffsll((long long)rest) - 1)) : -1;
        };
        const int first = unionm ? (__ffsll((long long)unionm) - 1) : -1;
        flash_run<0, false>(first, snext,
                            [&](int j, int r, const u16*& kp, const u16*& vp) {
                                const u16* rp = brow + (long)(64 * j + r) * IN_COLS + C_NKV;
                                kp = rp + (2 * 2 + g) * 64;
                                vp = rp + (3 * 2 + g) * 64;
                            },
                            [&](int j, int& lo, int& hl, u64& word) { lo = 0; hl = ((mymask >> j) & 1ull) ? (tl - 64 * j) : -1; word = 0; },
                            [&](int, f32x16&, f32x16&) {}, qr, m, l, o, bufs, w, lane);
        const float sc = l > 0.f ? gate_s / l : 0.f;
#pragma unroll
        for (int i = 0; i < 16; ++i) { tot[0][i] += sc * o[0][i]; tot[1][i] += sc * o[1][i]; }
    }
    {
        float m = -1e30f, l = 0.f;
        f32x16 o[2];
#pragma unroll
        for (int i = 0; i < 16; ++i) { o[0][i] = 0.f; o[1][i] = 0.f; }
        const int jfirst = (q0 - 511) > 0 ? ((q0 - 511) >> 6) : 0;
        const int jlast = (q0 + 31) >> 6;
        flash_run<0, false>(jfirst, [&](int c) { return c + 1 <= jlast ? c + 1 : -1; },
                            [&](int j, int r, const u16*& kp, const u16*& vp) {
                                const u16* rp = brow + (long)(64 * j + r) * IN_COLS + C_NKV;
                                kp = rp + (4 * 2 + g) * 64;
                                vp = rp + (5 * 2 + g) * 64;
                            },
                            [&](int j, int& lo, int& hl, u64& word) { lo = tl - 511 - 64 * j; hl = tl - 64 * j; word = 0; },
                            [&](int, f32x16&, f32x16&) {}, qr, m, l, o, bufs, w, lane);
        const float sc = l > 0.f ? gate_w / l : 0.f;
#pragma unroll
        for (int i = 0; i < 16; ++i) { tot[0][i] += sc * o[0][i]; tot[1][i] += sc * o[1][i]; }
    }
    {
        unsigned char* orow = (unsigned char*)ya + ((long)b * SEQ + tl) * 512 + (g * 4 + rep) * 64;
#pragma unroll
        for (int dh = 0; dh < 2; ++dh)
#pragma unroll
            for (int a = 0; a < 4; ++a)
                *(int*)(orow + dh * 32 + 8 * a + 4 * hi) = fp8x4(tot[dh][4 * a], tot[dh][4 * a + 1], tot[dh][4 * a + 2], tot[dh][4 * a + 3]);
    }
}

__device__ __forceinline__ void dsa_select_unit(unsigned char* ws, int unit, unsigned char* smem, unsigned long long& tacc) {
    const int tid = tidx(), lane = tid & 63, w = tid >> 6;
    const int t0 = unit * 4;
    const int b = t0 / SEQ, tl0 = t0 - b * SEQ;
    const u16* proj = (const u16*)(ws + OFF_PROJ);
    const u16* brow = proj + (long)b * SEQ * IN_COLS;
    u64* bits = (u64*)(ws + OFF_BITS);
    float* sc = (float*)smem;
    __syncthreads();
    unsigned long long ts0 = SEC_T();
#ifndef ATTA_REP_IDX
#define ATTA_REP_IDX 1
#endif
#ifndef ATTA_REP_TOPK
#define ATTA_REP_TOPK 1
#endif
    for (int rep_ = 0; rep_ < ATTA_REP_IDX; ++rep_) {
        const int r16 = lane & 15, g4 = lane >> 4;
        bf16x8 af[2][2];
#pragma unroll
        for (int rb = 0; rb < 2; ++rb)
#pragma unroll
            for (int ks = 0; ks < 2; ++ks)
                af[rb][ks] = *(const bf16x8*)(proj + (long)(t0 + 2 * rb + (r16 >> 3)) * IN_COLS + C_IQ + (r16 & 7) * 64 + ks * 32 + g4 * 8);
        float wq[2][4];
#pragma unroll
        for (int rb = 0; rb < 2; ++rb)
#pragma unroll
            for (int i = 0; i < 4; ++i)
                wq[rb][i] = bf2f(proj[(long)(t0 + 2 * rb + (g4 >> 1)) * IN_COLS + C_IW + (g4 & 1) * 4 + i]) * 0.35355339059327373f;
        const int ntiles = (tl0 + 4 + 31) >> 5;
#define IDX_LD(T, B)                                                                                         \
    do {                                                                                                     \
        _Pragma("unroll") for (int kt = 0; kt < 2; ++kt) {                                                   \
            int key_ = (T) * 32 + kt * 16 + r16;                                                             \
            key_ = key_ < SEQ ? key_ : SEQ - 1;                                                              \
            _Pragma("unroll") for (int ks = 0; ks < 2; ++ks)                                                 \
                B[kt][ks] = *(const bf16x8*)(brow + (long)key_ * IN_COLS + C_IK + ks * 32 + g4 * 8);         \
        }                                                                                                    \
    } while (0)
        asm volatile("" ::"v"(af[0][0]), "v"(af[0][1]), "v"(af[1][0]), "v"(af[1][1]));
        asm volatile("" ::"v"(wq[0][0]), "v"(wq[0][1]), "v"(wq[0][2]), "v"(wq[0][3]), "v"(wq[1][0]), "v"(wq[1][1]), "v"(wq[1][2]), "v"(wq[1][3]));
        bf16x8 bn[2][2];
        if (w < ntiles) IDX_LD(w, bn);
        for (int tile = w; tile < ntiles; tile += 4) {
            bf16x8 bc[2][2];
#pragma unroll
            for (int kt = 0; kt < 2; ++kt)
#pragma unroll
                for (int ks = 0; ks < 2; ++ks) bc[kt][ks] = bn[kt][ks];
            if (tile + 4 < ntiles) IDX_LD(tile + 4, bn);
#pragma unroll
            for (int rb = 0; rb < 2; ++rb)
#pragma unroll
                for (int kt = 0; kt < 2; ++kt) {
                    f32x4 acc = f32x4{0.f, 0.f, 0.f, 0.f};
                    acc = __builtin_amdgcn_mfma_f32_16x16x32_bf16(af[rb][0], bc[kt][0], acc, 0, 0, 0);
                    acc = __builtin_amdgcn_mfma_f32_16x16x32_bf16(af[rb][1], bc[kt][1], acc, 0, 0, 0);
                    float part = 0.f;
#pragma unroll
                    for (int i = 0; i < 4; ++i) part += wq[rb][i] * fmaxf(acc[i], 0.f);
                    auto sw = __builtin_amdgcn_permlane16_swap(__float_as_uint(part), __float_as_uint(part), false, false);
                    const float tot = __uint_as_float(sw[0]) + __uint_as_float(sw[1]);
                    if ((g4 & 1) == 0) sc[(2 * rb + (g4 >> 1)) * 4096 + tile * 32 + kt * 16 + r16] = tot;
                }
        }
#undef IDX_LD
    }
    __syncthreads();
    SEC_ADD(1, ts0);
    ts0 = SEC_T();
    const int t = t0 + w;
    const int tl = tl0 + w;
    const int nvalid = tl + 1;
    for (int rep_ = 0; rep_ < ATTA_REP_TOPK; ++rep_) {
        u32 u[64];
        const float* scq = sc + w * 4096;
#pragma unroll
        for (int j = 0; j < 64; ++j) {
            const int key = j * 64 + lane;
            const u32 kk = sortkey(scq[key]);
            u[j] = (key <= tl) ? kk : 0u;
        }
        SEC_ADD(2, ts0);
        ts0 = SEC_T();
        u32 K = 0;
        int need = 0, ceq = 0;
        if (nvalid > 256) {
            u32 lm0 = u[0], lm1 = u[1], lm2 = u[2], lm3 = u[3];
#pragma unroll
            for (int j = 4; j < 64; j += 4) { lm0 = max(lm0, u[j]); lm1 = max(lm1, u[j + 1]); lm2 = max(lm2, u[j + 2]); lm3 = max(lm3, u[j + 3]); }
            u32 lo = min(min(lm0, lm1), min(lm2, lm3)), hiu = max(max(lm0, lm1), max(lm2, lm3));
            lo = row_min16u(lo);
            hiu = row_max16u(hiu);
            const u32 L = min(min((u32)__builtin_amdgcn_readlane((int)lo, 0), (u32)__builtin_amdgcn_readlane((int)lo, 16)),
                              min((u32)__builtin_amdgcn_readlane((int)lo, 32), (u32)__builtin_amdgcn_readlane((int)lo, 48)));
            const u32 U = max(max((u32)__builtin_amdgcn_readlane((int)hiu, 0), (u32)__builtin_amdgcn_readlane((int)hiu, 16)),
                              max((u32)__builtin_amdgcn_readlane((int)hiu, 32), (u32)__builtin_amdgcn_readlane((int)hiu, 48)));
            const u32 dd = U ^ L;
            const int hb = dd ? 31 - __clz((int)dd) : -1;
            K = dd ? (U & ~((2u << hb) - 1u)) : U;
            bool exact = false;
            for (int bit = hb; bit >= 0; --bit) {
                const u32 cand = K | (1u << bit);
                int cl = 0;
#pragma unroll
                for (int j = 0; j < 64; ++j) cl += (u[j] >= cand) ? 1 : 0;
                const int cnt = wsumi(cl);
                if (cnt >= 256) K = cand;
                if (cnt == 256) { exact = true; break; }
            }
            if (exact) {
                need = 1; ceq = 1;
            } else {
                int cgt = 0, ce = 0;
#pragma unroll
                for (int j = 0; j < 64; ++j) { cgt += __popcll(__ballot(u[j] > K)); ce += __popcll(__ballot(u[j] == K)); }
                need = 256 - cgt;
                ceq = ce;
            }
        }
        SEC_ADD(3, ts0);
        ts0 = SEC_T();
        const u64 ltmask = (1ull << lane) - 1ull;
        u64 myword = 0;
        if (nvalid <= 256 || need == ceq) {
            const u32 Kt = (nvalid > 256) ? K : 1u;
#pragma unroll
            for (int j = 0; j < 64; ++j) {
                const u64 sm = __ballot(u[j] >= Kt);
                myword = (lane == j) ? sm : myword;
            }
        } else {
            int ebase = 0;
#pragma unroll
            for (int j = 0; j < 64; ++j) {
                bool eq = (u[j] == K);
                u64 em = __ballot(eq);
                int erank = ebase + __popcll(em & ltmask);
                bool take = (u[j] > K) || (eq && erank < need);
                ebase += __popcll(em);
                u64 sm = __ballot(take);
                myword = (lane == j) ? sm : myword;
            }
        }
        bits[(long)t * 64 + lane] = myword;
        SEC_ADD(4, ts0);
    }
}

__device__ __forceinline__ void dsa_attn_unit(unsigned char* ws, int b, int qt, unsigned char* smem) {
    const int tid = tidx(), lane = tid & 63, w = tid >> 6;
    const int r32 = lane & 31, hi = lane >> 5;
    const int q0 = qt * 16;
    const int qloc = 4 * w + (r32 >> 3);
    const int tl = q0 + qloc;
    const int head = r32 & 7;
    const u16* proj = (const u16*)(ws + OFF_PROJ);
    const u16* brow = proj + (long)b * SEQ * IN_COLS;
    const u64* bits = (const u64*)(ws + OFF_BITS) + ((long)b * SEQ + q0) * 64;
    u16* yb = (u16*)(ws + OFF_YAB) + (size_t)NTOK * 512;
    unsigned char* bufs = smem;
    u64* lbits = (u64*)(smem + 49152);
    __syncthreads();
    for (int i = tid; i < 16 * 64; i += 256) lbits[i] = bits[i];
    const u16* trow = brow + (long)tl * IN_COLS;
    bf16x8 qr[4];
#pragma unroll
    for (int d0 = 0; d0 < 4; ++d0) qr[d0] = *(const bf16x8*)(trow + C_DQ + head * 64 + d0 * 16 + hi * 8);
    float m = -1e30f, l = 0.f;
    f32x16 o[2];
#pragma unroll
    for (int i = 0; i < 16; ++i) { o[0][i] = 0.f; o[1][i] = 0.f; }
    const int jlast = (q0 + 15) >> 6;
    flash_run<0, true>(0, [&](int c) { return c + 1 <= jlast ? c + 1 : -1; },
                       [&](int j, int r, const u16*& kp, const u16*& vp) {
                           const u16* rp = brow + (long)(64 * j + r) * IN_COLS + C_DKV;
                           kp = rp;
                           vp = rp + 64;
                       },
                       [&](int j, int& lo, int& hl, u64& word) { lo = 0; hl = 0; word = lbits[qloc * 64 + j]; },
                       [&](int, f32x16&, f32x16&) {}, qr, m, l, o, bufs, w, lane);
    const float inv = l > 0.f ? 1.0f / l : 0.f;
    unsigned char* orow = (unsigned char*)yb + ((long)b * SEQ + tl) * 512 + head * 64;
#pragma unroll
    for (int dh = 0; dh < 2; ++dh)
#pragma unroll
        for (int a = 0; a < 4; ++a)
            *(int*)(orow + dh * 32 + 8 * a + 4 * hi) = fp8x4(o[dh][4 * a] * inv, o[dh][4 * a + 1] * inv, o[dh][4 * a + 2] * inv, o[dh][4 * a + 3] * inv);
}

__device__ __forceinline__ int grab_block(unsigned* ctr, int limit, unsigned char* smem) {
    volatile int* slot = (volatile int*)(smem + LDS_BYTES + 8);
    __syncthreads();
    if (threadIdx.x == 0) *slot = (int)__hip_atomic_fetch_add(ctr, 1u, __ATOMIC_RELAXED, __HIP_MEMORY_SCOPE_AGENT);
    __syncthreads();
    const int v = *slot;
    return v < limit ? v : -1;
}
__device__ __forceinline__ int grab_wave(unsigned* ctr, int limit) {
    int v = 0;
    if ((threadIdx.x & 63) == 0) v = (int)__hip_atomic_fetch_add(ctr, 1u, __ATOMIC_RELAXED, __HIP_MEMORY_SCOPE_AGENT);
    v = __builtin_amdgcn_readfirstlane(v);
    return v < limit ? v : -1;
}

typedef u32 u32x6_t __attribute__((ext_vector_type(6)));
typedef float f32x32_t __attribute__((ext_vector_type(32)));
typedef __bf16 bf16x32_t __attribute__((ext_vector_type(32)));
typedef __bf16 bf16x2_t __attribute__((ext_vector_type(2)));
#define PE_NBV 8
typedef u32 u32x2_t __attribute__((ext_vector_type(2)));
#define PE_LD(Q, TB, E0)                                                                      \
    do {                                                                                      \
        asm volatile("" ::: "memory");                                                        \
        const int idv_ = ((E0) < 64) ? id0 : id1;     \
        _Pragma("unroll") for (int k_ = 0; k_ < PE_NBV; ++k_) {                               \
            const int id_ = __builtin_amdgcn_readlane(idv_, ((E0) + k_) & 63);                \
            Q[k_] = *(const u32x2_t*)((TB) + (long)id_ * VROW + lane * 8);                    \
        }                                                                                     \
        asm volatile("" ::: "memory");                                                        \
    } while (0)
#define PE_DOT(Q, PB)                                                                         \
    do {                                                                                      \
        _Pragma("unroll") for (int k_ = 0; k_ < PE_NBV; ++k_) {                               \
            f32x2_t da_ = {0.f, 0.f}, db_ = {0.f, 0.f};                                       \
            da_ += hf2[0] * __builtin_amdgcn_cvt_scalef32_pk_f32_fp4(Q[k_][0], 1.0f, 0);      \
            db_ += hf2[4] * __builtin_amdgcn_cvt_scalef32_pk_f32_fp4(Q[k_][1], 1.0f, 0);      \
            da_ += hf2[1] * __builtin_amdgcn_cvt_scalef32_pk_f32_fp4(Q[k_][0], 1.0f, 1);      \
            db_ += hf2[5] * __builtin_amdgcn_cvt_scalef32_pk_f32_fp4(Q[k_][1], 1.0f, 1);      \
            da_ += hf2[2] * __builtin_amdgcn_cvt_scalef32_pk_f32_fp4(Q[k_][0], 1.0f, 2);      \
            db_ += hf2[6] * __builtin_amdgcn_cvt_scalef32_pk_f32_fp4(Q[k_][1], 1.0f, 2);      \
            da_ += hf2[3] * __builtin_amdgcn_cvt_scalef32_pk_f32_fp4(Q[k_][0], 1.0f, 3);      \
            db_ += hf2[7] * __builtin_amdgcn_cvt_scalef32_pk_f32_fp4(Q[k_][1], 1.0f, 3);      \
            da_ += db_;                                                                       \
            pp[(PB) + k_] = da_[0] + da_[1];                                                  \
        }                                                                                     \
    } while (0)
                 \
#define PE_LDV(Q, TB, E0) PE_LD(Q, TB, E0)
#define PE_AXPY(Q, E0)                                                                        \
    do {                                                                                      \
        const int av_ = __float_as_int(((E0) < 64) ? act0 : act1);                            \
        _Pragma("unroll") for (int k_ = 0; k_ < PE_NBV; ++k_) {                               \
            const float a_ = __int_as_float(__builtin_amdgcn_readlane(av_, ((E0) + k_) & 63)); \
            const f32x2_t a2_ = {a_, a_};                                                     \
            _Pragma("unroll") for (int d_ = 0; d_ < 2; ++d_) {                                \
                acc2[4 * d_ + 0] += a2_ * __builtin_amdgcn_cvt_scalef32_pk_f32_fp4(Q[k_][d_], 1.0f, 0); \
                acc2[4 * d_ + 1] += a2_ * __builtin_amdgcn_cvt_scalef32_pk_f32_fp4(Q[k_][d_], 1.0f, 1); \
                acc2[4 * d_ + 2] += a2_ * __builtin_amdgcn_cvt_scalef32_pk_f32_fp4(Q[k_][d_], 1.0f, 2); \
                acc2[4 * d_ + 3] += a2_ * __builtin_amdgcn_cvt_scalef32_pk_f32_fp4(Q[k_][d_], 1.0f, 3); \
            }                                                                                 \
        }                                                                                     \
    } while (0)
template <int CTRL>
__device__ __forceinline__ float comb_q(float A, float B, bool bit) {
    const float keep = bit ? B : A, send = bit ? A : B;
    return keep + dpp_qf<CTRL>(send);
}
__device__ __forceinline__ float comb_x(float A, float B, bool bit, int xr) {
    const float keep = bit ? B : A, send = bit ? A : B;
    return keep + __shfl_xor(send, xr);
}
__device__ __forceinline__ float reduce32(float (&pp)[32], int lane) {
    const bool b0 = lane & 1, b1 = lane & 2, b2 = lane & 4, b3 = lane & 8;
#pragma unroll
    for (int j = 0; j < 16; ++j) pp[j] = comb_q<0xB1>(pp[2 * j], pp[2 * j + 1], b0);
#pragma unroll
    for (int j = 0; j < 8; ++j) pp[j] = comb_q<0x4E>(pp[2 * j], pp[2 * j + 1], b1);
#pragma unroll
    for (int j = 0; j < 4; ++j) pp[j] = comb_x(pp[2 * j], pp[2 * j + 1], b2, 4);
#pragma unroll
    for (int j = 0; j < 2; ++j) pp[j] = comb_x(pp[2 * j], pp[2 * j + 1], b3, 8);
    auto sw = __builtin_amdgcn_permlane16_swap(__float_as_uint(pp[0]), __float_as_uint(pp[1]), false, false);
    return xhalf_sum(__uint_as_float(sw[0]) + __uint_as_float(sw[1]));
}
__device__ __forceinline__ void peer_experts_range(unsigned char* ws_, float* xout_, const float* ffn_g, int tbeg, int tend) {
    unsigned char* ws = opq(ws_);
    float* xout = opq(xout_);
    const int lane = tidx() & 63;
    const u16* hbuf = (const u16*)(ws + OFF_YAB);
    const float* ss1 = (const float*)(ws + OFF_SS1);
    const unsigned char* ub = ws + OFF_UB;
    const unsigned char* vb = ws + OFF_VB;
    const int* eidx = (const int*)(ws + OFF_EIDX);
    const float* gate = (const float*)(ws + OFF_GATE);
    const float* usc = (const float*)(ws + OFF_ESC);
    const float* vsc = usc + NEXP;
    int t = tbeg;
    int id0 = 0, id1 = 0;
    float gr0 = 0.f, gr1 = 0.f;
    uint4 h0 = uint4{0u, 0u, 0u, 0u}, h1 = h0;
    u32x2_t ua[PE_NBV], ubq[PE_NBV];
    if (t < tend) {
        id0 = eidx[(long)t * 128 + lane]; id1 = eidx[(long)t * 128 + 64 + lane];
        gr0 = gate[(long)t * 128 + lane]; gr1 = gate[(long)t * 128 + 64 + lane];
        h0 = *(const uint4*)(hbuf + (long)t * 1024 + lane * 16);
        h1 = *(const uint4*)(hbuf + (long)t * 1024 + lane * 16 + 8);
        PE_LD(ua, ub, 0);
    }
    while (t < tend) {
        const float g0 = gr0 * vsc[id0], g1 = gr1 * vsc[id1];
        const float s0 = usc[id0], s1 = usc[id1];
        float* xr = xout + (long)t * 1024 + lane * 16;
        const float rs1 = rsqrtf(sum16(ss1 + (long)t * 16) * (1.0f / 1024.0f) + EPS);
        f32x2_t hf2[8];
        hf2[0] = f32x2_t{bf_lo(h0.x), bf_hi(h0.x)}; hf2[1] = f32x2_t{bf_lo(h0.y), bf_hi(h0.y)};
        hf2[2] = f32x2_t{bf_lo(h0.z), bf_hi(h0.z)}; hf2[3] = f32x2_t{bf_lo(h0.w), bf_hi(h0.w)};
        hf2[4] = f32x2_t{bf_lo(h1.x), bf_hi(h1.x)}; hf2[5] = f32x2_t{bf_lo(h1.y), bf_hi(h1.y)};
        hf2[6] = f32x2_t{bf_lo(h1.z), bf_hi(h1.z)}; hf2[7] = f32x2_t{bf_lo(h1.w), bf_hi(h1.w)};
        const int tn = t + 1;
        int idn0 = 0, idn1 = 0;
        float gn0 = 0.f, gn1 = 0.f;
        uint4 hn0 = uint4{0u, 0u, 0u, 0u}, hn1 = hn0;
        if (tn < tend) {
            idn0 = eidx[(long)tn * 128 + lane]; idn1 = eidx[(long)tn * 128 + 64 + lane];
            gn0 = gate[(long)tn * 128 + lane]; gn1 = gate[(long)tn * 128 + 64 + lane];
            hn0 = *(const uint4*)(hbuf + (long)tn * 1024 + lane * 16);
            hn1 = *(const uint4*)(hbuf + (long)tn * 1024 + lane * 16 + 8);
        }
        float dq0 = 0.f, dq1 = 0.f, dq2 = 0.f, dq3 = 0.f;
        for (int gq = 0; gq < 4; ++gq) {
            const int e = 32 * gq;
            float pp[32];
#pragma unroll
            for (int q4 = 0; q4 < 32; q4 += 2 * PE_NBV) {
                PE_LD(ubq, ub, e + q4 + PE_NBV);
                PE_DOT(ua, q4);
                if (q4 + 2 * PE_NBV < 32 || gq < 3) PE_LD(ua, ub, e + q4 + 2 * PE_NBV);
                else PE_LDV(ua, vb, 0);
                PE_DOT(ubq, q4 + PE_NBV);
            }
            const float r = reduce32(pp, lane);
            dq0 = gq == 0 ? r : dq0;
            dq1 = gq == 1 ? r : dq1;
            dq2 = gq == 2 ? r : dq2;
            dq3 = gq == 3 ? r : dq3;
        }
        const float act0 = gelu_tanh((lane < 32 ? dq0 : dq1) * (s0 * rs1)) * g0;
        const float act1 = gelu_tanh((lane < 32 ? dq2 : dq3) * (s1 * rs1)) * g1;
        f32x2_t acc2[8];
#pragma unroll
        for (int i = 0; i < 8; ++i) acc2[i] = f32x2_t{0.f, 0.f};
        for (int b = 0; b < 128 / PE_NBV; b += 2) {
            PE_LDV(ubq, vb, PE_NBV * (b + 1));
            PE_AXPY(ua, PE_NBV * b);
            if (b + 2 < 128 / PE_NBV) {
                PE_LDV(ua, vb, PE_NBV * (b + 2));
            } else if (tn < tend) {
                id0 = idn0; id1 = idn1;
                PE_LD(ua, ub, 0);
            }
            PE_AXPY(ubq, PE_NBV * (b + 1));
        }
        float ss = 0.f;
        u32 pk[4], pkb[8];
        const u32 hw32[8] = {h0.x, h0.y, h0.z, h0.w, h1.x, h1.y, h1.z, h1.w};
#pragma unroll
        for (int i = 0; i < 4; ++i) {
            float4 a = float4{bf_lo(hw32[2 * i]), bf_hi(hw32[2 * i]), bf_lo(hw32[2 * i + 1]), bf_hi(hw32[2 * i + 1])};
            a.x += acc2[2 * i][0]; a.y += acc2[2 * i][1]; a.z += acc2[2 * i + 1][0]; a.w += acc2[2 * i + 1][1];
            pkb[2 * i] = pack2(a.x, a.y);
            pkb[2 * i + 1] = pack2(a.z, a.w);
            ss += a.x * a.x + a.y * a.y + a.z * a.z + a.w * a.w;
            pk[i] = (u32)fp8x4(a.x, a.y, a.z, a.w);
        }
        u16* x2b = (u16*)(ws + OFF_PQ) + (long)t * 2048 + lane * 16;
        *(uint4*)x2b = uint4{pkb[0], pkb[1], pkb[2], pkb[3]};
        *(uint4*)(x2b + 8) = uint4{pkb[4], pkb[5], pkb[6], pkb[7]};
        unsigned char* hw = ws + OFF_YAB + (long)t * 2048 + lane * 16;
        *(uint4*)hw = uint4{pk[0], pk[1], pk[2], pk[3]};
        ss = wsum(ss);
        if (lane == 0) ((float*)(ws + OFF_RSTDE))[t] = rsqrtf(ss * (1.0f / 1024.0f) + EPS);
        t = tn; id0 = idn0; id1 = idn1; gr0 = gn0; gr1 = gn1; h0 = hn0; h1 = hn1;
    }
}

__device__ __forceinline__ u32 search_bounds(u32 lanemax, int& hb) {
    const u32 U = row_max16u(lanemax), L = row_min16u(lanemax);
    const u32 d = U ^ L;
    hb = d ? 31 - __clz((int)d) : -1;
    return d ? (U & ~((2u << hb) - 1u)) : U;
}
__device__ __forceinline__ void peer_route(unsigned char* ws, float* xout, const float* ffn_g, int layer, unsigned char* smem, unsigned long long& tacc) {
    const int tid = tidx(), lane = tid & 63, w = tid >> 6;
    const int grp = lane >> 4, k = lane & 15;
    const u32 ltk = (1u << k) - 1u;
    float* tvc = (float*)(smem + w * 4096);
    int* tic = (int*)(smem + w * 4096 + 2048);
    unsigned* rctr = (unsigned*)(ws + OFF_CTR) + (layer * 8 + 3) * 8;
    unsigned char* skl = smem + 16384;
    {
        const u16* sk0 = (const u16*)(opq(ws) + OFF_W + layer * W_LAYER + WO_SK);
#pragma unroll
        for (int j = 0; j < 8; ++j) {
            const int q = tid + 256 * j, key = q >> 4, c = q & 15;
            *(uint4*)(skl + key * 256 + ((c ^ (key & 15)) * 16)) = *(const uint4*)(sk0 + (size_t)key * 128 + c * 8);
        }
        __syncthreads();
    }
    for (int unit; (unit = grab_wave(rctr, NTOK / 16)) >= 0;) {
        const int tok0 = unit * 16;
        unsigned char* wsu = opq(ws);
        const u16* pq = (const u16*)(wsu + OFF_PQ);
        const u16* skb = (const u16*)(wsu + OFF_W + layer * W_LAYER + WO_SK);
        int* eidx = (int*)(wsu + OFF_EIDX);
        float* gate = (float*)(wsu + OFF_GATE);
        for (int h = 0; h < 8; ++h) {
            for (int half = 0; half < 2; ++half) {
                unsigned long long tr0 = SEC_T();
                bf16x8 af[4];
#pragma unroll
                for (int ks = 0; ks < 4; ++ks)
                    af[ks] = *(const bf16x8*)(pq + (long)(tok0 + k) * 2048 + h * 256 + half * 128 + ks * 32 + grp * 8);
                float sc[8][4];
                u32 u[8][4];
                if (half == 0) {
#pragma unroll
                    for (int nt = 0; nt < 8; ++nt) {
                        f32x4 acc = f32x4{0.f, 0.f, 0.f, 0.f};
#pragma unroll
                        for (int ks = 0; ks < 4; ++ks) {
                            bf16x8 bfr = *(const bf16x8*)(skl + (nt * 16 + k) * 256 + (((ks * 4 + grp) ^ k) * 16));
                            acc = __builtin_amdgcn_mfma_f32_16x16x32_bf16(af[ks], bfr, acc, 0, 0, 0);
                        }
#pragma unroll
                        for (int i = 0; i < 4; ++i) { sc[nt][i] = acc[i]; u[nt][i] = sortkey(acc[i]); }
                    }
                } else {
#pragma unroll
                    for (int nt = 0; nt < 8; ++nt) {
                        f32x4 acc = f32x4{0.f, 0.f, 0.f, 0.f};
#pragma unroll
                        for (int ks = 0; ks < 4; ++ks) {
                            bf16x8 bfr = *(const bf16x8*)(skb + (size_t)128 * 128 + (size_t)(nt * 16 + k) * 128 + ks * 32 + grp * 8);
                            acc = __builtin_amdgcn_mfma_f32_16x16x32_bf16(af[ks], bfr, acc, 0, 0, 0);
                        }
#pragma unroll
                        for (int i = 0; i < 4; ++i) { sc[nt][i] = acc[i]; u[nt][i] = sortkey(acc[i]); }
                    }
                }
                SEC_ADD(11, tr0);
                tr0 = SEC_T();
                u32 K[4];
                bool dn[4] = {false, false, false, false};
                int hbm = -1;
#pragma unroll
                for (int i = 0; i < 4; ++i) {
                    u32 lm = u[0][i];
#pragma unroll
                    for (int nt = 1; nt < 8; ++nt) lm = max(lm, u[nt][i]);
                    int hb;
                    K[i] = search_bounds(lm, hb);
                    hbm = max(hbm, hb);
                }
                const int bit0 = (int)wmax((float)hbm);
                for (int bit = bit0; bit >= 0; --bit) {
                    int packed = 0;
#pragma unroll
                    for (int i = 0; i < 4; ++i) {
                        const u32 cand = K[i] | (1u << bit);
                        int c = 0;
#pragma unroll
                        for (int nt = 0; nt < 8; ++nt) c += (u[nt][i] >= cand) ? 1 : 0;
                        packed |= c << (8 * i);
                    }
                    packed = row_sum16i(packed);
#pragma unroll
                    for (int i = 0; i < 4; ++i)
                        if (((packed >> (8 * i)) & 0xFF) >= 16) K[i] |= (1u << bit);
                    bool done = true;
#pragma unroll
                    for (int i = 0; i < 4; ++i) {
                        const int ci = (packed >> (8 * i)) & 0xFF;
                        done = done && (ci == 16 || dn[i]);
                        dn[i] = dn[i] || (ci == 16);
                    }
                    if (__all(done)) break;
                }
                SEC_ADD(12, tr0);
                tr0 = SEC_T();
                int need[4];
                {
                    int packed = 0;
#pragma unroll
                    for (int i = 0; i < 4; ++i) {
                        int c = 0;
#pragma unroll
                        for (int nt = 0; nt < 8; ++nt) c += (u[nt][i] > K[i]) ? 1 : 0;
                        packed |= c << (8 * i);
                    }
                    packed = row_sum16i(packed);
#pragma unroll
                    for (int i = 0; i < 4; ++i) need[i] = 16 - ((packed >> (8 * i)) & 0xFF);
                }
#pragma unroll
                for (int i = 0; i < 4; ++i) {
                    int ebase = 0, pbase = 0;
                    const int tok = 4 * grp + i;
#pragma unroll
                    for (int nt = 0; nt < 8; ++nt) {
                        const bool eq = (u[nt][i] == K[i]);
                        const u32 emg = (u32)(__ballot(eq) >> (lane & 48)) & 0xFFFFu;
                        const int erank = ebase + __popc(emg & ltk);
                        const bool take = (u[nt][i] > K[i]) || (eq && erank < need[i]);
                        ebase += __popc(emg);
                        const u32 tmg = (u32)(__ballot(take) >> (lane & 48)) & 0xFFFFu;
                        const int pos = pbase + __popc(tmg & ltk);
                        if (take) {
                            tvc[(half * 16 + tok) * 16 + pos] = sc[nt][i];
                            tic[(half * 16 + tok) * 16 + pos] = nt * 16 + k;
                        }
                        pbase += __popc(tmg);
                    }
                }
                SEC_ADD(13, tr0);
            }
            WAVE_SYNC();
            unsigned long long tr2 = SEC_T();
            for (int pass = 0; pass < 4; ++pass) {
                const int tok = 4 * pass + grp;
                const float v1 = tvc[(0 * 16 + tok) * 16 + k];
                const int i1 = tic[(0 * 16 + tok) * 16 + k];
                float c[16];
                u32 uc[16];
#pragma unroll
                for (int r4 = 0; r4 < 4; ++r4) {
                    float4 v2 = *(const float4*)(tvc + (1 * 16 + tok) * 16 + r4 * 4);
                    c[r4 * 4 + 0] = v1 + v2.x;
                    c[r4 * 4 + 1] = v1 + v2.y;
                    c[r4 * 4 + 2] = v1 + v2.z;
                    c[r4 * 4 + 3] = v1 + v2.w;
                }
                float mxl = c[0];
#pragma unroll
                for (int r = 0; r < 16; ++r) { uc[r] = sortkey(c[r]); mxl = fmaxf(mxl, c[r]); }
                const float mx = row_max16f(mxl);
                int hbc;
                u32 Kc = search_bounds(sortkey(mxl), hbc);
                bool dnc = false;
                const int bitc0 = (int)wmax((float)hbc);
                for (int bit = bitc0; bit >= 0; --bit) {
                    const u32 cand = Kc | (1u << bit);
                    int cn = 0;
#pragma unroll
                    for (int r = 0; r < 16; ++r) cn += (uc[r] >= cand) ? 1 : 0;
                    cn = row_sum16i(cn);
                    if (cn >= 16) Kc = cand;
                    dnc = dnc || (cn == 16);
                    if (__all(dnc)) break;
                }
                int cgl = 0, cel = 0;
#pragma unroll
                for (int r = 0; r < 16; ++r) { cgl += (uc[r] > Kc) ? 1 : 0; cel += (uc[r] == Kc) ? 1 : 0; }
                const int needc = 16 - row_sum16i(cgl);
                const int ebefore = row_xscan16i(cel);
                int tl_ = 0, el_ = 0;
                u32 takem = 0u;
                float ex[16];
                float sl = 0.f;
#pragma unroll
                for (int r = 0; r < 16; ++r) {
                    const bool eq = (uc[r] == Kc);
                    const bool tk = (uc[r] > Kc) || (eq && (ebefore + el_) < needc);
                    el_ += eq ? 1 : 0;
                    tl_ += tk ? 1 : 0;
                    takem |= tk ? (1u << r) : 0u;
                    ex[r] = tk ? __expf(c[r] - mx) : 0.f;
                    sl += ex[r];
                }
                const float inv = __builtin_amdgcn_rcpf(row_sum16f(sl));
                int pos = row_xscan16i(tl_);
                const long obase = (long)(tok0 + tok) * 128 + h * 16;
                int i2v[16];
#pragma unroll
                for (int r4 = 0; r4 < 4; ++r4) {
                    const int4 q = *(const int4*)(tic + (1 * 16 + tok) * 16 + r4 * 4);
                    i2v[r4 * 4 + 0] = q.x; i2v[r4 * 4 + 1] = q.y; i2v[r4 * 4 + 2] = q.z; i2v[r4 * 4 + 3] = q.w;
                }
#pragma unroll
                for (int r = 0; r < 16; ++r) {
                    if ((takem >> r) & 1u) {
                        const int eid = i1 * 128 + i2v[r];
                        eidx[obase + pos] = eid;
                        gate[obase + pos] = ex[r] * inv;
                        ++pos;
                    }
                }
            }
            SEC_ADD(14, tr2);
            WAVE_SYNC();
        }
        asm volatile("s_waitcnt vmcnt(0)" ::: "memory");
        peer_experts_range(ws, xout, ffn_g, tok0, tok0 + 16);
    }
}

__device__ __forceinline__ void phase_prep(const Params& P, unsigned char* smem) {
    unsigned char* ws = opq(P.ws);
    const long gtid = (long)bidx() * 256 + tidx();
    const long gthreads = (long)gdim() * 256;
    int rot = 0;
    for (int l = 0; l < 2; ++l) {
        unsigned char* wl = ws + OFF_W + l * W_LAYER;
        float* tile = (float*)smem;
        transpose_cvt<true>(P.w_in + (size_t)l * 1024 * IN_COLS, (u16*)(wl + WO_WIN), 1024, IN_COLS, tile, rot, P.attn_norm + l * 1024,
                            G1_F8LO * 128, G1_F8HI * 128);
        for (int c = 0; c < 2; ++c) {
            transpose_cvt(P.cmp_w1 + ((size_t)l * 2 + c) * 2048 * 256, (u16*)(wl + WO_W1) + (size_t)c * 256 * 2048, 2048, 256, tile, rot);
            transpose_cvt(P.cmp_w2 + ((size_t)l * 2 + c) * 256 * 64, (u16*)(wl + WO_W2) + (size_t)c * 64 * 256, 256, 64, tile, rot);
        }
        transpose_cvt(P.w_a + (size_t)l * 512 * 1024, (u16*)(wl + WO_WA), 512, 1024, tile, rot, nullptr, 0, 1024);
        transpose_cvt(P.w_b + (size_t)l * 512 * 1024, (u16*)(wl + WO_WB), 512, 1024, tile, rot, nullptr, 0, 1024);
        transpose_cvt(P.w_out + (size_t)l * 1024 * 1024, (u16*)(wl + WO_WO), 1024, 1024, tile, rot);
        transpose_cvt(P.peer_wq + (size_t)l * 1024 * 2048, (u16*)(wl + WO_WQ), 1024, 2048, tile, rot, P.ffn_norm + l * 1024);
        transpose_cvt(P.ple_w + (size_t)l * 256 * 1024, (u16*)(wl + WO_PW), 256, 1024, tile, rot, nullptr, 0, 1024);
        transpose_cvt(P.ple_gw + (size_t)l * 1024 * 1024, (u16*)(wl + WO_PG), 1024, 1024, tile, rot, nullptr, 0, 1024);
        cvt_f32_bf16(P.peer_sk + (size_t)l * 2 * 128 * 128, (u16*)(wl + WO_SK), 2 * 128 * 128);
    }
    for (int u = gdim() - 1 - bidx(); u < 64; u += gdim()) {
        const int l = u >> 5, c = (u >> 4) & 1, kq = u & 15, col = tidx();
        const float* pos = P.cmp_pos + ((size_t)l * 2 + c) * 2048 + kq * 128;
        const float* w1 = P.cmp_w1 + ((size_t)l * 2 + c) * 2048 * 256 + (size_t)kq * 128 * 256;
        float s = 0.f;
#pragma unroll 16
        for (int k = 0; k < 128; ++k) s += pos[k] * w1[(size_t)k * 256 + col];
        ((float*)(ws + OFF_CHID))[(size_t)u * 256 + col] = s;
    }
    {
        float* ropec = (float*)(ws + OFF_ROPE);
        float* ropes = ropec + (size_t)NTOK * 8;
        for (long i = gtid; i < (long)NTOK * 8; i += gthreads) {
            int t = (int)(i >> 3), k = (int)(i & 7);
            const double inv = k == 0 ? 1.0 : k == 1 ? 0.19392274474868576 : k == 2 ? 0.03760603093086393 : k == 3 ? 0.007292664737217109
                             : k == 4 ? 0.001414213562373095 : k == 5 ? 0.0002742481756762073 : k == 6 ? 5.318295896944988e-05 : 1.031338537721246e-05;
            double rev = (double)P.positions[t] * inv * 0.15915494309189535;
            rev -= rint(rev);
            const float rf = (float)rev;
            ropec[i] = __builtin_amdgcn_cosf(rf);
            ropes[i] = __builtin_amdgcn_sinf(rf);
        }
    }
    {
        const int lane = tidx() & 63;
        u16* xb = (u16*)(ws + OFF_H);
        unsigned char* x8b = ws + OFF_A8;
        float* ssa = (float*)(ws + OFF_SSA);
        for (int row = bidx() * 4 + (tidx() >> 6); row < NTOK; row += gdim() * 4) {
            const float* xr = P.x + (long)row * 1024;
            float ss = 0.f;
#pragma unroll
            for (int i = 0; i < 4; ++i) {
                const float4 v = *(const float4*)(xr + i * 256 + lane * 4);
                ss += v.x * v.x + v.y * v.y + v.z * v.z + v.w * v.w;
                *(uint2*)(xb + (long)row * 1024 + i * 256 + lane * 4) = uint2{pack2(v.x, v.y), pack2(v.z, v.w)};
                int x8 = 0;
                x8 = __builtin_amdgcn_cvt_pk_fp8_f32(v.x, v.y, x8, false);
                x8 = __builtin_amdgcn_cvt_pk_fp8_f32(v.z, v.w, x8, true);
                *(int*)(x8b + (long)row * 1024 + i * 256 + lane * 4) = x8;
            }
            ss = wsum(ss);
            if (lane < 16) ssa[(long)row * 16 + lane] = lane == 0 ? ss : 0.f;
        }
    }
}

__device__ __forceinline__ void phase_g1(const Params& P, int layer, unsigned char* smem) {
    unsigned char* ws = opq(P.ws);
    u16* proj = (u16*)(ws + OFF_PROJ);
    const float* ropec = (const float*)(ws + OFF_ROPE);
    const float* ropes = ropec + (size_t)NTOK * 8;
    const float* ng = P.nsa_gain + layer * 256;
    const float* dg = P.dsa_gain + layer * 128;
    if (layer == 0 && bidx() < 4) {
        const int l = bidx() >> 1, c = bidx() & 1, col = tidx();
        const float* part = (const float*)(ws + OFF_CHID) + (size_t)(l * 32 + c * 16) * 256 + col;
        float sacc = 0.f;
#pragma unroll
        for (int kq = 0; kq < 16; ++kq) sacc += part[kq * 256];
        ((float*)(ws + OFF_W + l * W_LAYER + WO_CB))[c * 256 + col] = sacc;
    }
    {
        const u16* wsrc = (const u16*)(ws + OFF_W + layer * W_LAYER + WO_WO);
        unsigned char* wdst = ws + OFF_W8O;
        for (long i = ((long)bidx() * 256 + tidx()) * 8; i < (long)1024 * 1024; i += (long)gdim() * 256 * 8) {
            float wv[8];
            ld_bf8(wsrc + i, wv);
#pragma unroll
            for (int j = 0; j < 8; ++j) wv[j] *= 256.0f;
            st_fp8(wdst + i, wv);
        }
    }
    const float* ssa = (const float*)(ws + OFF_SSA) + (size_t)layer * NTOK * 16;
    int k2 = 512;
    asm volatile("" : "+s"(k2));
    gemm_phase_rs<0, true>((const u16*)(ws + OFF_H), 1024, (const u16*)(ws + OFF_W + layer * W_LAYER + WO_WIN), 1024, NTOK, IN_COLS, 1024, smem,
                  [=](int row) { return float2{rsqrtf(sum16(ssa + (long)row * 16) * (1.0f / 1024.0f) + EPS), 0.f}; },
                  [=](int row, int col, const float (&v)[8], float2 rs) {
                      const int c64 = __builtin_amdgcn_readfirstlane(col >> 6), cc = (col >> 3) & 7;
                      const float rsx = rs.x;
                      float o[8];
#pragma unroll
                      for (int j = 0; j < 8; ++j) o[j] = v[j] * rsx;
                      const float* gain = nullptr;
                      bool rope = false, sig = false;
                      float scale = 1.0f;
                      if (c64 < 8) { gain = ng; rope = true; scale = 0.125f * 1.4426950408889634f; }
                      else if (c64 < 20) { const int c = (c64 - 8) >> 1; if (c == 2) { gain = ng + 128; rope = true; } else if (c == 4) { gain = ng + 192; rope = true; } }
                      else if (c64 < 28) { gain = dg; rope = true; scale = 0.125f * 1.4426950408889634f; }
                      else if (c64 == 28) { gain = dg + 64; rope = true; }
                      else if (c64 == 29) { }
                      else if (c64 < 38) { rope = true; scale = 0.125f; }
                      else if (c64 == 38) { rope = true; }
                      else if (c64 < 71) { sig = true; }
                      else { sig = (col < C_IW); }
                      if (gain) {
                          float ss = 0.f;
#pragma unroll
                          for (int j = 0; j < 8; ++j) ss += o[j] * o[j];
                          ss += dpp_qf<0xB1>(ss);
                          ss += dpp_qf<0x4E>(ss);
                          ss += __shfl_xor(ss, 4);
                          const float rstd = rsqrtf(ss * (1.0f / 64.0f) + EPS);
                          const float4 g0 = *(const float4*)(gain + cc * 8), g1 = *(const float4*)(gain + cc * 8 + 4);
                          o[0] *= rstd * g0.x; o[1] *= rstd * g0.y; o[2] *= rstd * g0.z; o[3] *= rstd * g0.w;
                          o[4] *= rstd * g1.x; o[5] *= rstd * g1.y; o[6] *= rstd * g1.z; o[7] *= rstd * g1.w;
                      }
                      if (rope) {
                          float pr[8];
#pragma unroll
                          for (int j = 0; j < 8; ++j) pr[j] = dpp_qf<0xB1>(o[j]);
                          if (cc < 2) {
                              const float4 c0 = *(const float4*)(ropec + (long)row * 8), c1 = *(const float4*)(ropec + (long)row * 8 + 4);
                              const float4 s0 = *(const float4*)(ropes + (long)row * 8), s1 = *(const float4*)(ropes + (long)row * 8 + 4);
                              const float cs[8] = {c0.x, c0.y, c0.z, c0.w, c1.x, c1.y, c1.z, c1.w};
                              const float sn[8] = {s0.x, s0.y, s0.z, s0.w, s1.x, s1.y, s1.z, s1.w};
#pragma unroll
                              for (int j = 0; j < 8; ++j) o[j] = (cc == 0) ? (o[j] * cs[j] - pr[j] * sn[j]) : (o[j] * cs[j] + pr[j] * sn[j]);
                          }
                      }
                      if (sig) {
#pragma unroll
                          for (int j = 0; j < 8; ++j) o[j] = sigmoidf(o[j]);
                      }
#pragma unroll
                      for (int j = 0; j < 8; ++j) o[j] *= scale;
                      if (c64 >= C_MG / 64 && c64 < C_NG / 64) {
#pragma unroll
                          for (int j = 0; j < 8; ++j) o[j] = 2.0f * o[j] - 1.0f;
                          st_fp8((unsigned char*)(proj + (long)row * IN_COLS + C_MG) + (col - C_MG), o);
                      } else {
                          st_bf8(proj + (long)row * IN_COLS + col, o);
                      }
                  },
                  (const u16*)(ws + OFF_A8), 512, k2, G1_F8LO, G1_F8HI, (unsigned*)(ws + OFF_CTR) + (layer * 8 + 4) * 8);
}

__device__ __forceinline__ void phase_c1(const Params& P, int layer, unsigned char* smem) {
    unsigned char* ws = opq(P.ws);
    unsigned char* wl = ws + OFF_W + layer * W_LAYER;
    const u16* proj = (const u16*)(ws + OFF_PROJ);
    u16* chid = (u16*)(ws + OFF_CHID);
    const float* cbias = (const float*)(wl + WO_CB);
    for (int c = 0; c < 2; ++c) {
        u16* ch = chid + (size_t)c * CROWS * 256;
        const float* cb = cbias + c * 256;
        gemm_phase<1>(proj + C_NKV + c * 128, 0, (const u16*)(wl + WO_W1) + (size_t)c * 256 * 2048, 2048, CROWS, 256, 2048, smem,
                      [=](int row, int col, const float (&v)[8]) {
                          float o[8];
#pragma unroll
                          for (int j = 0; j < 8; ++j) o[j] = gelu_tanh(v[j] + cb[col + j]);
                          st_bf8(ch + (long)row * 256 + col, o);
                      });
    }
}

__device__ __forceinline__ void phase_c2(const Params& P, int layer, unsigned char* smem) {
    unsigned char* ws = opq(P.ws);
    unsigned char* wl = ws + OFF_W + layer * W_LAYER;
    const u16* chid = (const u16*)(ws + OFF_CHID);
    u16* kcb = (u16*)(ws + OFF_KCB);
    u16* vcb = (u16*)(ws + OFF_VCB);
    const float* ropec = (const float*)(ws + OFF_ROPE);
    const float* ropes = ropec + (size_t)NTOK * 8;
    const float* gain = P.nsa_gain + layer * 256 + 64;
    for (int c = 0; c < 2; ++c) {
        u16* dst = c == 0 ? kcb : vcb;
        gemm_phase<0>(chid + (size_t)c * CROWS * 256, 256, (const u16*)(wl + WO_W2) + (size_t)c * 64 * 256, 256, CROWS, 64, 256, smem,
                      [=](int row, int col, const float (&v)[8]) {
                          const int b = row / (NCMP * 2);
                          const int rem = row - b * (NCMP * 2);
                          const int n = rem >> 1, g = rem & 1;
                          const int cc = col >> 3;
                          float o[8];
#pragma unroll
                          for (int j = 0; j < 8; ++j) o[j] = v[j];
                          if (c == 0) {
                              float ss = 0.f;
#pragma unroll
                              for (int j = 0; j < 8; ++j) ss += o[j] * o[j];
                              ss += dpp_qf<0xB1>(ss);
                              ss += dpp_qf<0x4E>(ss);
                              ss += __shfl_xor(ss, 4);
                              const float rstd = rsqrtf(ss * (1.0f / 64.0f) + EPS);
#pragma unroll
                              for (int j = 0; j < 8; ++j) o[j] *= rstd * gain[cc * 8 + j];
                              float pr[8];
#pragma unroll
                              for (int j = 0; j < 8; ++j) pr[j] = dpp_qf<0xB1>(o[j]);
                              if (cc < 2) {
                                  const long tt = (long)b * SEQ + 31 + 16 * n;
#pragma unroll
                                  for (int j = 0; j < 8; ++j) {
                                      const float cs = ropec[tt * 8 + j], sn = ropes[tt * 8 + j];
                                      o[j] = (cc == 0) ? (o[j] * cs - pr[j] * sn) : (o[j] * cs + pr[j] * sn);
                                  }
                              }
                          }
                          st_bf8(dst + ((size_t)(b * 2 + g) * 256 + n) * 64 + col, o);
                      });
    }
}

__device__ __forceinline__ int balance4(int x, int seg) {
    const int k = x / seg, r = x - k * seg;
    return k == 0 ? r : (k == 1 ? 4 * seg - 1 - r : (k == 2 ? seg + r : 3 * seg - 1 - r));
}
__device__ __forceinline__ void phase_att_a(const Params& P, int layer, unsigned char* smem, unsigned long long& tacc) {
    unsigned char* ws = opq(P.ws);
    unsigned* ctr = (unsigned*)(ws + OFF_CTR) + (layer * 8 + 0) * 8;
    const int label = bidx() & 7;
    for (int s8 = 0; s8 < 8; ++s8) {
        const int q = (label + s8) & 7;
        int idx;
        while ((idx = grab_block(ctr + q, 1024, smem)) >= 0) dsa_select_unit(ws, q * 1024 + (1023 - idx), smem, tacc);
    }
}
__device__ __forceinline__ void phase_att_b(const Params& P, int layer, unsigned char* smem) {
    const int label = bidx() & 7;
    constexpr int C2_BLOCKS = 32;
    static_assert((CROWS + 127) / 128 == C2_BLOCKS, "c2 tile count");
    unsigned* c2done = (unsigned*)(opq(P.ws) + OFF_CTR) + (layer * 8 + 5) * 8;
    phase_c2(P, layer, smem);
    if (bidx() < C2_BLOCKS) {
        asm volatile("s_waitcnt vmcnt(0)" ::: "memory");
        __syncthreads();
        if (tidx() == 0) {
            __builtin_amdgcn_fence(__ATOMIC_RELEASE, "agent");
            (void)__hip_atomic_fetch_add(c2done, 1u, __ATOMIC_RELAXED, __HIP_MEMORY_SCOPE_AGENT);
        }
    }
    {
        unsigned char* ws = opq(P.ws);
        unsigned* ctr = (unsigned*)(ws + OFF_CTR) + (layer * 8 + 1) * 8;
        for (int s8 = 0; s8 < 8; ++s8) {
            const int q = (label + s8) & 7;
            int idx;
            while ((idx = grab_block(ctr + q, 256, smem)) >= 0) dsa_attn_unit(ws, q, 255 - idx, smem);
        }
    }
    {
        if (tidx() == 0) {
            unsigned sp = 0;
            while (__hip_atomic_load(c2done, __ATOMIC_RELAXED, __HIP_MEMORY_SCOPE_AGENT) < (unsigned)C2_BLOCKS) {
                __builtin_amdgcn_s_sleep(1);
                if (++sp > (1u << 24)) break;
            }
            __builtin_amdgcn_fence(__ATOMIC_ACQUIRE, "agent");
        }
        __syncthreads();
    }
    {
        unsigned char* ws = opq(P.ws);
        unsigned* ctr = (unsigned*)(ws + OFF_CTR) + (layer * 8 + 2) * 8;
        for (int s8 = 0; s8 < 8; ++s8) {
            const int q = (label + s8) & 7;
            int idx;
            while ((idx = grab_block(ctr + q, 256, smem)) >= 0) {
                const int ub = q + 8 * (idx & 1);
                nsa_unit(ws, ub >> 1, ub & 1, 127 - (idx >> 1), smem);
            }
        }
    }
}

__device__ __forceinline__ void phase_merge(const Params& P, int layer, unsigned char* smem) {
    unsigned char* ws = opq(P.ws);
    unsigned char* wl = ws + OFF_W + layer * W_LAYER;
    const u16* proj = (const u16*)(ws + OFF_PROJ);
    u16* hbuf = (u16*)(ws + OFF_H);
    unsigned char* a8 = ws + OFF_A8;
    const u16* ya = (const u16*)(ws + OFF_YAB);
    const u16* yb = ya + (size_t)NTOK * 512;
    int k2 = 256;
    asm volatile("" : "+s"(k2));
    {
        const int x = bidx() & 7, j0 = bidx() >> 3, nper = gdim() >> 3;
        for (int q = j0; q < 32 * 8; q += nper) {
            const int im = x + 8 * (q >> 3), in = q & 7;
            gemm_tile_dual8(ya, (const u16*)(wl + WO_WA), yb, (const u16*)(wl + WO_WB), 256, 512, NTOK, 1024, k2, im * 128, in * 128, smem,
                [=](int row, int col, const float (&v)[8], u32 (&keep)[4]) {
                    float ga[8];
                    ld_fp8((const unsigned char*)(proj + (long)row * IN_COLS + C_MG) + col, ga);
#pragma unroll
                    for (int j = 0; j < 8; ++j) ga[j] = 0.5f * ga[j] + 0.5f;
#pragma unroll
                    for (int j = 0; j < 4; ++j) keep[j] = pack2(ga[2 * j] * v[2 * j], ga[2 * j + 1] * v[2 * j + 1]);
                },
                [=](int row, int col, const float (&v)[8], u32 (&keep)[4]) {
                    float gb[8], o[8];
                    ld_fp8((const unsigned char*)(proj + (long)row * IN_COLS + C_MG) + 1024 + col, gb);
#pragma unroll
                    for (int j = 0; j < 8; ++j) gb[j] = 0.5f * gb[j] + 0.5f;
#pragma unroll
                    for (int j = 0; j < 8; ++j) o[j] = ((j & 1) ? bf_hi(keep[j >> 1]) : bf_lo(keep[j >> 1])) + gb[j] * v[j];
                    st_fp8(a8 + (long)row * 1024 + col, o);
                });
        }
    }
}

__device__ __forceinline__ void phase_outproj(const Params& P, int layer, unsigned char* smem) {
    unsigned char* ws = opq(P.ws);
    unsigned char* wl = ws + OFF_W + layer * W_LAYER;
    float* out = opq(P.out);
    const bool gemm_first = bidx() < (gdim() >> 1);
    for (int step = 0; step < 2; ++step) {
        if ((step == 0) == gemm_first) {
            u16* xb1 = (u16*)(ws + OFF_YAB);
            const u16* xh = (const u16*)(ws + OFF_H);
            float* ss1 = (float*)(ws + OFF_SS1);
            int k2 = 512;
            asm volatile("" : "+s"(k2));
            gemm_phase<0, 1>((const u16*)(ws + OFF_A8), 512, (const u16*)(ws + OFF_W8O), 512, NTOK, 1024, k2, smem, [=](int row, int col, const float (&v)[8]) {
                const long o = (long)row * 1024 + col;
                float xi[8];
                ld_bf8(xh + o, xi);
                const float y[8] = {xi[0] + v[0], xi[1] + v[1], xi[2] + v[2], xi[3] + v[3], xi[4] + v[4], xi[5] + v[5], xi[6] + v[6], xi[7] + v[7]};
                st_bf8(xb1 + o, y);
                float ss = 0.f;
#pragma unroll
                for (int j = 0; j < 8; ++j) ss += y[j] * y[j];
                ss += dpp_qf<0xB1>(ss);
                ss += dpp_qf<0x4E>(ss);
                ss += __shfl_xor(ss, 4);
                if ((col & 63) == 0) ss1[(long)row * 16 + (col >> 6)] = ss;
            });
        } else {
            cvt_f32_fp8(P.p + (size_t)layer * NTOK * 256, ws + OFF_PBF, (long)NTOK * 256);
            cvt_rows_fp4(P.peer_u + (size_t)layer * NEXP * 1024, ws + OFF_UB, (float*)(ws + OFF_ESC), NEXP, P.ffn_norm + layer * 1024);
            cvt_rows_fp4(P.peer_v + (size_t)layer * NEXP * 1024, ws + OFF_VB, (float*)(ws + OFF_ESC) + NEXP, NEXP);
        }
    }
}

__device__ __forceinline__ void phase_pq(const Params& P, int layer, unsigned char* smem) {
    unsigned char* ws = opq(P.ws);
    unsigned char* wl = ws + OFF_W + layer * W_LAYER;
    u16* pq = (u16*)(ws + OFF_PQ);
    u16* eb = (u16*)(ws + OFF_H);
    const float* ss1 = (const float*)(ws + OFF_SS1);
    gemm_phase_rs<0, true>((const u16*)(ws + OFF_YAB), 1024, (const u16*)(wl + WO_WQ), 1024, NTOK, 2048, 1024, smem,
                  [=](int row) { return float2{rsqrtf(sum16(ss1 + (long)row * 16) * (1.0f / 1024.0f) + EPS), 0.f}; },
                  [=](int row, int col, const float (&v)[8], float2 rs) {
                      float o[8];
#pragma unroll
                      for (int j = 0; j < 8; ++j) o[j] = v[j] * rs.x;
                      st_bf8(pq + (long)row * 2048 + col, o);
                  });
    float* sse = (float*)(ws + OFF_SSE) + (size_t)layer * NTOK * 16;
    int k2e = 128;
    asm volatile("" : "+s"(k2e));
    gemm_phase<0, 1>((const u16*)(ws + OFF_PBF), 128, (const u16*)(wl + WO_PW), 256, NTOK, 1024, k2e, smem,
                  [=](int row, int col, const float (&v)[8]) {
                      st_bf8(eb + (long)row * 1024 + col, v);
                      float ss = 0.f;
#pragma unroll
                      for (int j = 0; j < 8; ++j) ss += v[j] * v[j];
                      ss += dpp_qf<0xB1>(ss);
                      ss += dpp_qf<0x4E>(ss);
                      ss += __shfl_xor(ss, 4);
                      if ((col & 63) == 0) sse[(long)row * 16 + (col >> 6)] = ss;
                  });
}

__device__ __forceinline__ void phase_final(const Params& P, int layer, unsigned char* smem) {
    unsigned char* ws = opq(P.ws);
    unsigned char* wl = ws + OFF_W + layer * W_LAYER;
    float* out = opq(P.out);
    u16* eb = (u16*)(ws + OFF_H);
    unsigned char* x8b = ws + OFF_A8;
    const u16* x2b = (const u16*)(ws + OFF_PQ);
    const float* rstd2 = (const float*)(ws + OFF_RSTDE);
    const float* sse = (const float*)(ws + OFF_SSE) + (size_t)layer * NTOK * 16;
    float* ssn = (float*)(ws + OFF_SSA) + (size_t)NTOK * 16;
    const float* pn = P.ple_norm + layer * 1024;
    const bool more = layer == 0;
    int k2 = 512;
    asm volatile("" : "+s"(k2));
    gemm_phase_rs<0, true, 1>((const u16*)(ws + OFF_YAB), 1024, (const u16*)(wl + WO_PG), 1024, NTOK, 1024, k2, smem,
        [=](int row) { return float2{rstd2[row], rsqrtf(sum16(sse + (long)row * 16) * (1.0f / 1024.0f) + EPS)}; },
        [=](int row, int col, const float (&v)[8], float2 rs) {
        const long o = (long)row * 1024 + col;
        float e[8];
        ld_bf8(eb + o, e);
        const float rx = rs.x;
        const float re = rs.y;
        const float4 p0 = *(const float4*)(pn + col), p1 = *(const float4*)(pn + col + 4);
        float xs[8];
        ld_bf8(x2b + (long)row * 2048 + col, xs);
        const float ps[8] = {p0.x, p0.y, p0.z, p0.w, p1.x, p1.y, p1.z, p1.w};
        float y[8];
        float ss = 0.f;
#pragma unroll
        for (int j = 0; j < 8; ++j) {
            y[j] = xs[j] + sigmoidf(v[j] * rx) * (e[j] * re * ps[j]);
            ss += y[j] * y[j];
        }
        if (more) {
            st_bf8(eb + o, y);
            st_fp8(x8b + o, y);
            ss += dpp_qf<0xB1>(ss);
            ss += dpp_qf<0x4E>(ss);
            ss += __shfl_xor(ss, 4);
            if ((col & 63) == 0) ssn[(long)row * 16 + (col >> 6)] = ss;
        } else {
            *(float4*)(out + o) = float4{y[0], y[1], y[2], y[3]};
            *(float4*)(out + o + 4) = float4{y[4], y[5], y[6], y[7]};
        }
    });
}


#define XB_TMO      128
#define XB_XCNT(j)  (256  + 64 * (j))
#define XB_XSUB(j)  (1280 + 64 * (j))
#define XB_XGEN(j)  (2304 + 64 * (j))
#define XB_TOP      3328
#define XB_TOPGEN   3392
#define XCD_BAR_WORDS 3456
#define XB_SPIN_CAP (1u << 22)
#define LAS __attribute__((address_space(3)))
__device__ __forceinline__ unsigned xb_ld(unsigned* p) { return __hip_atomic_load(p, __ATOMIC_RELAXED, __HIP_MEMORY_SCOPE_AGENT); }
__device__ __forceinline__ unsigned xb_add(unsigned* p, unsigned v) { return __hip_atomic_fetch_add(p, v, __ATOMIC_RELAXED, __HIP_MEMORY_SCOPE_AGENT); }
__device__ __forceinline__ unsigned xb_xcc_id() { return (unsigned)__builtin_amdgcn_s_getreg((3 << 11) | 20) & 0xFu; }
#define XB_SPIN(cond, bar) do { unsigned _sp = 0; while (cond) { __builtin_amdgcn_s_sleep(1); \
    if ((++_sp & 255u) == 0u) { if (xb_ld(&(bar)[XB_TMO])) break; if (_sp > XB_SPIN_CAP) { atomicAdd(&(bar)[XB_TMO], 1u); break; } } } } while (0)
struct XcdBarrier {
    unsigned* bar; unsigned x;
    volatile LAS unsigned* st;
};
__device__ __forceinline__ XcdBarrier xcd_barrier_post(unsigned* bar, volatile LAS unsigned* st) {
    XcdBarrier b; b.bar = bar; b.x = xb_xcc_id(); b.st = st;
    if (threadIdx.x == 0) (void)xb_add(&bar[XB_XCNT(b.x)], 1u);
    return b;
}
__device__ __forceinline__ void xcd_barrier_complete(unsigned* bar, unsigned x, unsigned& nloc, unsigned& nx) {
    const unsigned G = gridDim.x * gridDim.y * gridDim.z;
    unsigned sum, cnt, mine, sp = 0u;
    for (;;) {
        sum = 0u; cnt = 0u; mine = 0u;
#pragma unroll
        for (unsigned j = 0; j < 16; ++j) { const unsigned c = xb_ld(&bar[XB_XCNT(j)]); sum += c; cnt += (c > 0u) ? 1u : 0u; mine = (j == x) ? c : mine; }
        if (sum == G) break;
        __builtin_amdgcn_s_sleep(1);
        if ((++sp & 255u) == 0u) { if (xb_ld(&bar[XB_TMO])) break; if (sp > XB_SPIN_CAP) { atomicAdd(&bar[XB_TMO], 1u); break; } }
    }
    nloc = mine > 0u ? mine : 1u; nx = cnt > 0u ? cnt : 1u;
}
__device__ __forceinline__ void xcd_barrier(const XcdBarrier& b) {
    asm volatile("s_waitcnt vmcnt(0)" ::: "memory");
    __syncthreads();
    if (threadIdx.x == 0) {
        unsigned* bar = b.bar;
        __builtin_amdgcn_s_waitcnt(0);
        unsigned nloc = b.st[0], nx = b.st[1];
        if (nloc == 0u) { xcd_barrier_complete(bar, b.x, nloc, nx); b.st[0] = nloc; b.st[1] = nx; }
        const unsigned old = xb_add(&bar[XB_XSUB(b.x)], 1u);
        const unsigned gen = old / nloc;
        if (old + 1u == (gen + 1u) * nloc) {
            __builtin_amdgcn_fence(__ATOMIC_RELEASE, "agent");
            asm volatile("s_waitcnt vmcnt(0)" ::: "memory");
            const unsigned og = xb_add(&bar[XB_TOP], 1u);
            const unsigned tg = og / nx;
            if (og + 1u == (tg + 1u) * nx) xb_add(&bar[XB_TOPGEN], 1u);
            else XB_SPIN(xb_ld(&bar[XB_TOPGEN]) == tg, bar);
            __builtin_amdgcn_fence(__ATOMIC_ACQUIRE, "agent");
            xb_add(&bar[XB_XGEN(b.x)], 1u);
            asm volatile("s_waitcnt vmcnt(0)" ::: "memory");
        } else {
            XB_SPIN(xb_ld(&bar[XB_XGEN(b.x)]) == gen, bar);
            __builtin_amdgcn_fence(__ATOMIC_ACQUIRE, "agent");
            asm volatile("s_waitcnt vmcnt(0)" ::: "memory");
        }
    }
    __syncthreads();
}

#ifndef PROBE_MASK
#define PROBE_MASK 0ull
#endif
#ifndef PROBE_MULT
#define PROBE_MULT 4
#endif
#define GSYNC(id)                                                                          \
    do {                                                                                   \
        xcd_barrier(xb);                                                                   \
        if (PROBE_MASK != 0ull) {                                                          \
            unsigned long long now_ = __builtin_amdgcn_s_memrealtime();                    \
            if ((PROBE_MASK >> (id)) & 1ull) tsel += now_ - tprev;                         \
            tprev = now_;                                                                  \
        }                                                                                  \
    } while (0)

__global__ void __launch_bounds__(256, 2)
fwd_kernel(const float* a_x, const float* a_p, const int* a_pos, const float* a_an, const float* a_win, const float* a_ng, const float* a_cp,
           const float* a_cw1, const float* a_cw2, const float* a_dg, const float* a_wa, const float* a_wb, const float* a_wo, const float* a_fn,
           const float* a_wq, const float* a_sk, const float* a_pu, const float* a_pv, const float* a_pw, const float* a_pgw, const float* a_pn,
           float* a_out, unsigned char* a_ws) {
    Params P;
    P.x = a_x; P.p = a_p; P.positions = a_pos; P.attn_norm = a_an; P.w_in = a_win; P.nsa_gain = a_ng; P.cmp_pos = a_cp; P.cmp_w1 = a_cw1;
    P.cmp_w2 = a_cw2; P.dsa_gain = a_dg; P.w_a = a_wa; P.w_b = a_wb; P.w_out = a_wo; P.ffn_norm = a_fn; P.peer_wq = a_wq; P.peer_sk = a_sk;
    P.peer_u = a_pu; P.peer_v = a_pv; P.ple_w = a_pw; P.ple_gw = a_pgw; P.ple_norm = a_pn; P.out = a_out; P.ws = a_ws;
    cg::grid_group grid = cg::this_grid();
    extern __shared__ __attribute__((aligned(16))) unsigned char smem[];
    unsigned long long tprev = 0, tsel = 0;
    if (PROBE_MASK != 0ull) tprev = __builtin_amdgcn_s_memrealtime();
    volatile LAS unsigned* xst = (volatile LAS unsigned*)(smem + LDS_BYTES);
    if (threadIdx.x == 0) { xst[0] = 0u; xst[1] = 0u; xst[2] = 0u; xst[3] = 0u; }
    __syncthreads();
    XcdBarrier xb = xcd_barrier_post((unsigned*)(P.ws + OFF_BAR), xst);
    phase_prep(P, smem);
    xcd_barrier(xb);
    {
        int never = 0;
        asm volatile("" : "+s"(never));
        if (never) grid.sync();
    }
    if (PROBE_MASK != 0ull) {
        unsigned long long now_ = __builtin_amdgcn_s_memrealtime();
        if (PROBE_MASK & 1ull) tsel += now_ - tprev;
        tprev = now_;
    }
    for (int layer = 0; layer < 2; ++layer) {
        const int pb = 1 + 16 * layer;
        phase_g1(P, layer, smem);
        GSYNC(pb + 0);
        phase_c1(P, layer, smem);
        phase_att_a(P, layer, smem, tsel);
        GSYNC(pb + 15);
        phase_att_b(P, layer, smem);
        GSYNC(pb + 5);
        phase_merge(P, layer, smem);
        GSYNC(pb + 6);
        phase_outproj(P, layer, smem);
        GSYNC(pb + 7);
        phase_pq(P, layer, smem);
        GSYNC(pb + 9);
        peer_route(opq(P.ws), opq(P.out), P.ffn_norm + layer * 1024, layer, smem, tsel);
        GSYNC(pb + 11);
        phase_final(P, layer, smem);
        if (layer == 0) GSYNC(pb + 13);
    }
#ifndef PROBE_BLOCK
#define PROBE_BLOCK 0
#endif
    if (PROBE_MASK != 0ull || PROBE_SEC != 0) {
        if (blockIdx.x == PROBE_BLOCK && threadIdx.x == 0) {
            unsigned long long t0 = __builtin_amdgcn_s_memrealtime();
            while (__builtin_amdgcn_s_memrealtime() - t0 < (unsigned long long)PROBE_MULT * tsel) __builtin_amdgcn_s_sleep(32);
        }
    }
}

extern "C" void kernel_launch(void* const* d_in, const int* in_sizes, int n_in, void* d_out, int out_size, void* d_ws, size_t ws_size,
                              hipStream_t stream) {
    static int grid_blocks = 0;
    if (!grid_blocks) {
        int dev = 0, cus = 0, per_cu = 0;
        (void)hipGetDevice(&dev);
        (void)hipDeviceGetAttribute(&cus, hipDeviceAttributeMultiprocessorCount, dev);
        (void)hipFuncSetAttribute((const void*)fwd_kernel, hipFuncAttributeMaxDynamicSharedMemorySize, LDS_BYTES + 16);
        (void)hipOccupancyMaxActiveBlocksPerMultiprocessor(&per_cu, fwd_kernel, 256, LDS_BYTES + 16);
        if (per_cu > 2) per_cu = 2;
        if (per_cu < 1) per_cu = 1;
        grid_blocks = cus * per_cu;
        if (ws_size < WS_END) fprintf(stderr, "kernel_launch: workspace too small: %zu < %zu\n", ws_size, (size_t)WS_END);
    }
    Params P{};
    P.x = (const float*)d_in[0];
    P.p = (const float*)d_in[1];
    P.positions = (const int*)d_in[2];
    P.attn_norm = (const float*)d_in[3];
    P.w_in = (const float*)d_in[4];
    P.nsa_gain = (const float*)d_in[5];
    P.cmp_pos = (const float*)d_in[6];
    P.cmp_w1 = (const float*)d_in[7];
    P.cmp_w2 = (const float*)d_in[8];
    P.dsa_gain = (const float*)d_in[9];
    P.w_a = (const float*)d_in[10];
    P.w_b = (const float*)d_in[11];
    P.w_out = (const float*)d_in[12];
    P.ffn_norm = (const float*)d_in[13];
    P.peer_wq = (const float*)d_in[14];
    P.peer_sk = (const float*)d_in[15];
    P.peer_u = (const float*)d_in[16];
    P.peer_v = (const float*)d_in[17];
    P.ple_w = (const float*)d_in[18];
    P.ple_gw = (const float*)d_in[19];
    P.ple_norm = (const float*)d_in[20];
    P.out = (float*)d_out;
    P.ws = (unsigned char*)d_ws;
    void* args[] = {(void*)&P.x, (void*)&P.p, (void*)&P.positions, (void*)&P.attn_norm, (void*)&P.w_in, (void*)&P.nsa_gain, (void*)&P.cmp_pos,
                    (void*)&P.cmp_w1, (void*)&P.cmp_w2, (void*)&P.dsa_gain, (void*)&P.w_a, (void*)&P.w_b, (void*)&P.w_out, (void*)&P.ffn_norm,
                    (void*)&P.peer_wq, (void*)&P.peer_sk, (void*)&P.peer_u, (void*)&P.peer_v, (void*)&P.ple_w, (void*)&P.ple_gw,
                    (void*)&P.ple_norm, (void*)&P.out, (void*)&P.ws};
    (void)hipMemsetAsync((unsigned char*)d_ws + OFF_BAR, 0, 3456 * 4 + N_CTR * 4, stream);
    hipError_t e = hipLaunchCooperativeKernel((void*)fwd_kernel, dim3(grid_blocks), dim3(256), args, LDS_BYTES + 16, stream);
    if (e != hipSuccess) fprintf(stderr, "cooperative launch failed: %s (grid %d)\n", hipGetErrorString(e), grid_blocks);
}
```
